# Optimizing an MI355X kernel written in HIP

```python
import jax, jax.numpy as jnp
from jax import lax
import numpy as np

D_MODEL = 1024
BATCH = 2
SEQ = 8192
DEPTH = 2

GRID_W = 64
CTX_LEN = 256
N_DIR = 2
LRU_WIDTH = 512
LRU_HEADS = 8
LRU_HEAD_DIM = LRU_WIDTH // LRU_HEADS
LRU_CONV = 4
LRU_C = 8.0
CONV_WIDTH = 512
CONV_GROUPS = 8
CONV_K = 31
CONV_PAD = CONV_K // 2
MIX_WIDTH = LRU_WIDTH + CONV_WIDTH
IN_WIDTH = 2 * LRU_WIDTH + 3 * CONV_WIDTH
EPS = 1e-6

kernel_name = "hybrid_rglru_conformer_prefix_block"


def rms_norm(x, g):
    xf = x.astype(jnp.float32)
    y = xf * lax.rsqrt(jnp.mean(xf * xf, axis=-1, keepdims=True) + EPS)
    return (y * g.astype(jnp.float32)).astype(x.dtype)


def layer_norm(x, g, b):
    xf = x.astype(jnp.float32)
    xc = xf - jnp.mean(xf, axis=-1, keepdims=True)
    var = jnp.mean(xc * xc, axis=-1, keepdims=True)
    return (xc * lax.rsqrt(var + EPS) * g.astype(jnp.float32) + b.astype(jnp.float32)).astype(x.dtype)


def depthwise_conv1d(u, taps, pad):
    return lax.conv_general_dilated(
        u, taps[:, None, :].astype(u.dtype), window_strides=(1,), padding=[pad],
        dimension_numbers=('NWC', 'WIO', 'NWC'), feature_group_count=u.shape[-1])


def rglru_coeffs(v, w_r, b_r, w_i, b_i, lam):
    bn, t, _ = v.shape
    vh = v.reshape(bn, t, LRU_HEADS, LRU_HEAD_DIM)
    r = jax.nn.sigmoid((jnp.einsum('bthi,hij->bthj', vh, w_r).reshape(bn, t, LRU_WIDTH) + b_r).astype(jnp.float32))
    i = jax.nn.sigmoid((jnp.einsum('bthi,hij->bthj', vh, w_i).reshape(bn, t, LRU_WIDTH) + b_i).astype(jnp.float32))
    log_a = -LRU_C * r * jax.nn.softplus(-lam.astype(jnp.float32))
    a = jnp.exp(log_a)
    b = jnp.sqrt(-jnp.expm1(2.0 * log_a)) * (i * v.astype(jnp.float32))
    return a, b


def linear_scan(a, b, h0, reverse):
    if reverse:
        a = jnp.flip(a, axis=1)
        b = jnp.flip(b, axis=1)

    def combine(left, right):
        return (left[0] * right[0], right[0] * left[1] + right[1])

    a_cum, h = lax.associative_scan(combine, (a, b), axis=1)
    h = h + a_cum * h0[:, None, :]
    h_last = h[:, -1]
    if reverse:
        h = jnp.flip(h, axis=1)
    return h, h_last


def rglru_branch(vc_in, vx_in, conv_w, conv_b, w_r, b_r, w_i, b_i, lam):
    out_c = jnp.zeros(vc_in.shape, jnp.float32)
    out_x = jnp.zeros(vx_in.shape, jnp.float32)
    for d in range(N_DIR):
        pad = (LRU_CONV - 1, 0) if d == 0 else (0, LRU_CONV - 1)
        vc = depthwise_conv1d(vc_in, conv_w[d], pad) + conv_b[d]
        ac, bc = rglru_coeffs(vc, w_r[d], b_r[d], w_i[d], b_i[d], lam[d])
        h0 = jnp.zeros((vc.shape[0], LRU_WIDTH), jnp.float32)
        hc, hc_last = linear_scan(ac, bc, h0, reverse=(d == 1))
        vx = depthwise_conv1d(vx_in, conv_w[d], pad) + conv_b[d]
        ax, bx = rglru_coeffs(vx, w_r[d], b_r[d], w_i[d], b_i[d], lam[d])
        hx, _ = linear_scan(ax, bx, hc_last, reverse=(d == 1))
        out_c = out_c + hc
        out_x = out_x + hx
    return out_c, out_x


def conformer_latent(val, glu, dw_w, dw_b, ln_g, ln_b, rows):
    v = val * jax.nn.sigmoid(glu)
    bn = v.shape[0]
    half = CONV_WIDTH // 2
    grid = v.reshape(bn, rows, GRID_W, CONV_WIDTH)
    taps_h = dw_w[:, :half][None, :, None, :].astype(v.dtype)
    taps_v = dw_w[:, half:][:, None, None, :].astype(v.dtype)
    yh = lax.conv_general_dilated(grid[..., :half], taps_h, (1, 1), [(0, 0), (CONV_PAD, CONV_PAD)],
                                  dimension_numbers=('NHWC', 'HWIO', 'NHWC'), feature_group_count=half)
    yv = lax.conv_general_dilated(grid[..., half:], taps_v, (1, 1), [(CONV_PAD, CONV_PAD), (0, 0)],
                                  dimension_numbers=('NHWC', 'HWIO', 'NHWC'), feature_group_count=half)
    y = jnp.concatenate([yh, yv], axis=-1).reshape(bn, rows * GRID_W, CONV_WIDTH) + dw_b
    return jax.nn.silu(layer_norm(y, ln_g, ln_b))


def conformer_context(val, glu, dw_w, dw_b, ln_g, ln_b):
    v = val * jax.nn.sigmoid(glu)
    y = depthwise_conv1d(v, dw_w, (CONV_PAD, CONV_PAD)) + dw_b
    return jax.nn.silu(layer_norm(y, ln_g, ln_b))


def hybrid_layer(x, xc, c_act, cctx_act, w_mod, b_mod, g_pre, g_post, w_in, conv_a_w, conv_a_b,
                 w_rgate, b_rgate, w_igate, b_igate, lru_lambda, dw_w, dw_b, ln_g, ln_b, w_out,
                 rows, update_ctx):
    mod_x = (c_act @ w_mod + b_mod)[:, None, :]
    mod_c = (cctx_act @ w_mod + b_mod)[None, None, :]
    shift_x, scale_x, gate_x = jnp.split(mod_x, 3, axis=-1)
    shift_c, scale_c, gate_c = jnp.split(mod_c, 3, axis=-1)

    hx = rms_norm(x, g_pre) * (1.0 + scale_x) + shift_x
    hc = rms_norm(xc, g_pre) * (1.0 + scale_c) + shift_c

    splits = [LRU_WIDTH, 2 * LRU_WIDTH, 2 * LRU_WIDTH + CONV_WIDTH, 2 * LRU_WIDTH + 2 * CONV_WIDTH]
    ux = hx @ w_in
    a_val_x, a_gate_x, b_val_x, b_glu_x, b_gate_x = jnp.split(ux, splits, axis=-1)
    if update_ctx:
        uc = hc @ w_in
        a_val_c, a_gate_c, b_val_c, b_glu_c, b_gate_c = jnp.split(uc, splits, axis=-1)
    else:
        a_val_c = hc @ w_in[:, :LRU_WIDTH]

    rec_c, rec_x = rglru_branch(a_val_c, a_val_x, conv_a_w, conv_a_b, w_rgate, b_rgate,
                                w_igate, b_igate, lru_lambda)
    conv_x = conformer_latent(b_val_x, b_glu_x, dw_w, dw_b, ln_g, ln_b, rows)

    mix_x = jnp.concatenate([rec_x.astype(x.dtype) * jax.nn.silu(a_gate_x),
                             conv_x * jax.nn.silu(b_gate_x)], axis=-1) @ w_out
    x = x + gate_x * rms_norm(mix_x, g_post)

    if update_ctx:
        conv_c = conformer_context(b_val_c, b_glu_c, dw_w, dw_b, ln_g, ln_b)
        mix_c = jnp.concatenate([rec_c.astype(xc.dtype) * jax.nn.silu(a_gate_c),
                                 conv_c * jax.nn.silu(b_gate_c)], axis=-1) @ w_out
        xc = xc + gate_c * rms_norm(mix_c, g_post)
    return x, xc


def setup_inputs(seed: int = 0) -> dict:
    key = jax.random.key(seed)
    ks = jax.random.split(key, 24)
    D = D_MODEL
    f32 = jnp.float32
    nrm = lambda k, shape, s: jax.random.normal(k, shape, f32) * s
    x = nrm(ks[0], (BATCH, SEQ, D), 1.0)
    c = nrm(ks[1], (BATCH, D), 1.0)
    ctx = nrm(ks[2], (BATCH, CTX_LEN, D), 1.0)
    c_ctx = nrm(ks[3], (D,), 1.0)
    w_mod = nrm(ks[4], (DEPTH, D, 3 * D), 0.5 * D ** -0.5)
    b_mod = nrm(ks[5], (DEPTH, 3 * D), 0.02)
    g_pre = 1.0 + nrm(ks[6], (DEPTH, D), 0.02)
    g_post = 1.0 + nrm(ks[7], (DEPTH, D), 0.02)
    w_in = nrm(ks[8], (DEPTH, D, IN_WIDTH), D ** -0.5)
    conv_a_w = nrm(ks[9], (DEPTH, N_DIR, LRU_CONV, LRU_WIDTH), LRU_CONV ** -0.5)
    conv_a_b = nrm(ks[10], (DEPTH, N_DIR, LRU_WIDTH), 0.02)
    w_rgate = nrm(ks[11], (DEPTH, N_DIR, LRU_HEADS, LRU_HEAD_DIM, LRU_HEAD_DIM), LRU_HEAD_DIM ** -0.5)
    b_rgate = nrm(ks[12], (DEPTH, N_DIR, LRU_WIDTH), 0.02)
    w_igate = nrm(ks[13], (DEPTH, N_DIR, LRU_HEADS, LRU_HEAD_DIM, LRU_HEAD_DIM), LRU_HEAD_DIM ** -0.5)
    b_igate = nrm(ks[14], (DEPTH, N_DIR, LRU_WIDTH), 0.02)
    u = jax.random.uniform(ks[15], (DEPTH, N_DIR, LRU_WIDTH), f32, 0.9, 0.999)
    a0 = u ** (1.0 / LRU_C)
    lru_lambda = jnp.log(a0) - jnp.log1p(-a0)
    dw_w = nrm(ks[16], (DEPTH, CONV_K, CONV_WIDTH), CONV_K ** -0.5)
    dw_b = nrm(ks[17], (DEPTH, CONV_WIDTH), 0.02)
    ln_g = 1.0 + nrm(ks[18], (DEPTH, CONV_WIDTH), 0.02)
    ln_b = nrm(ks[19], (DEPTH, CONV_WIDTH), 0.02)
    w_out = nrm(ks[20], (DEPTH, MIX_WIDTH, D), MIX_WIDTH ** -0.5)
    return {"x": x, "c": c, "ctx": ctx, "c_ctx": c_ctx, "w_mod": w_mod, "b_mod": b_mod,
            "g_pre": g_pre, "g_post": g_post, "w_in": w_in, "conv_a_w": conv_a_w,
            "conv_a_b": conv_a_b, "w_rgate": w_rgate, "b_rgate": b_rgate, "w_igate": w_igate,
            "b_igate": b_igate, "lru_lambda": lru_lambda, "dw_w": dw_w, "dw_b": dw_b,
            "ln_g": ln_g, "ln_b": ln_b, "w_out": w_out}


def reference(x, c, ctx, c_ctx, w_mod, b_mod, g_pre, g_post, w_in, conv_a_w, conv_a_b,
              w_rgate, b_rgate, w_igate, b_igate, lru_lambda, dw_w, dw_b, ln_g, ln_b, w_out):
    rows = x.shape[1] // GRID_W
    c_act = jax.nn.silu(c)
    cctx_act = jax.nn.silu(c_ctx)
    xc = ctx
    for l in range(DEPTH):
        x, xc = hybrid_layer(x, xc, c_act, cctx_act, w_mod[l], b_mod[l], g_pre[l], g_post[l], w_in[l],
                             conv_a_w[l], conv_a_b[l], w_rgate[l], b_rgate[l], w_igate[l], b_igate[l],
                             lru_lambda[l], dw_w[l], dw_b[l], ln_g[l], ln_b[l], w_out[l],
                             rows, update_ctx=(l < DEPTH - 1))
    return x
```

```cpp
#include <hip/hip_runtime.h>
#include <hip/hip_cooperative_groups.h>
#include <cstdio>
#include <cstdint>
namespace cg = cooperative_groups;
#define MK_PER_PHASE 1
namespace pg8 {
#define PG8_LAS __attribute__((address_space(3)))
typedef unsigned short bf16_t;
typedef short bf16x8 __attribute__((ext_vector_type(8)));
typedef float f32x4 __attribute__((ext_vector_type(4)));
typedef unsigned u32x4 __attribute__((ext_vector_type(4)));
constexpr int BM = 256, BK = 64, HALF = 128, HTB = HALF * BK * 2  , STAGE_BYTES = 8 * HTB, NXCD = 8, WGM = 8;

__host__ __device__ __forceinline__ int lds_byte(int r, int c) { const int st = (r >> 4) * 2 + (c >> 5), rr = r & 15, cc = c & 31, ob = rr * 64 + cc * 2; return st * 1024 + (ob ^ (((ob >> 9) & 1) << 5)); }
__host__ __device__ __forceinline__ void stage_rc(int b, int& R, int& C) { const int st = b / 1024, sb = b % 1024, swz = sb ^ (((sb >> 9) & 1) << 5); R = (st >> 1) * 16 + swz / 64; C = (st & 1) * 32 + (swz % 64) / 2; }
__host__ __device__ __forceinline__ int perm32(int rho) { const int n = rho >> 4, i = rho & 15; return 8 * (i >> 2) + 4 * n + (i & 3); }

struct Unit { int pm, pn; };
struct Gemm { const bf16_t* A; const bf16_t* Bt; int M, N, K; };

struct StaticOrder {
    int nM, nN, nwg, G, c;
    __host__ __device__ void init(int M, int N, int G_, int c_) { nM = M / BM; nN = N / BM; nwg = nM * nN; G = G_; c = c_; }
    __host__ __device__ bool next(int i, Unit& u) const {
        const long L = (long)i * G + c; if (L >= nwg) return false;
        int wgid = (int)L; { const int q = nwg / NXCD, r = nwg % NXCD, xcd = wgid % NXCD, off = wgid / NXCD; wgid = (xcd < r ? xcd * (q + 1) : r * (q + 1) + (xcd - r) * q) + off; }
        const int nig = WGM * nN, gid = wgid / nig, fm = gid * WGM, gsz = (nM - fm) < WGM ? (nM - fm) : WGM;
        u.pm = fm + ((wgid % nig) % gsz); u.pn = (wgid % nig) / gsz; return true;
    }
    __device__ __forceinline__ void a_ready(const Unit&) const {}
    __device__ __forceinline__ void done(const Unit&) const {}
};
__device__ __forceinline__ unsigned cvt_pk_bf16(float lo, float hi) { unsigned r; asm volatile("v_cvt_pk_bf16_f32 %0, %1, %2" : "=v"(r) : "v"(lo), "v"(hi)); return r; }
typedef float f32x2 __attribute__((ext_vector_type(2)));
template <class Epi, class Sched, bool ALIGN_EPI = false, bool SP2 = false>
__device__ __forceinline__ void gemm_phase(PG8_LAS unsigned char* lds, const Gemm g, const Sched& S, const Epi& E) {
    const int tid = threadIdx.x, wid = __builtin_amdgcn_readfirstlane(tid >> 6), lane = tid & 63, wr = wid >> 2, wc = wid & 3, fr = lane & 15, fq = lane >> 4;
    const int K = g.K, nt = K / BK;
    unsigned voffA[2], voffB[2];
#pragma unroll
    for (int i = 0; i < 2; ++i) { int R, C; stage_rc(tid * 16 + i * 8192, R, C); const int Rb = Epi::PERM ? ((R & ~31) + perm32(R & 31)) : R;
        voffA[i] = (unsigned)(R * K + C) * 2u; voffB[i] = (unsigned)(Rb * K + C) * 2u; }
    const size_t kstep = (size_t)(BK * 2);
    const size_t hstep = (size_t)HALF * K * 2;
    const size_t tstep = 2 * hstep;
    const unsigned ldsw = (unsigned)wid * 1024u;
    const int aoff = lds_byte(wr * 64 + fr, fq * 8), boff = lds_byte(wc * 32 + fr, fq * 8);
#define PG8_SA(b, h) (((b) * 2 + (h)) * HTB)
#define PG8_SB(b, h) ((4 + (b) * 2 + (h)) * HTB)
#define PG8_STAGE(bufoff, gbase, voff) do { _Pragma("unroll") for (int _i = 0; _i < 2; ++_i) \
        __builtin_amdgcn_global_load_lds((const unsigned*)((const char*)(gbase) + (voff)[_i]), (PG8_LAS unsigned*)(lds + (bufoff) + ldsw + _i * 8192), 16, 0, 0); } while (0)
#define PG8_LDA(dst, b, h) do { _Pragma("unroll") for (int m = 0; m < 4; ++m) _Pragma("unroll") for (int k = 0; k < 2; ++k) dst[m][k] = *(const PG8_LAS bf16x8*)(lds + PG8_SA(b, h) + aoff + m * 2048 + k * 1024); } while (0)
#define PG8_LDB(dst, b, h) do { _Pragma("unroll") for (int n = 0; n < 2; ++n) _Pragma("unroll") for (int k = 0; k < 2; ++k) dst[n][k] = *(const PG8_LAS bf16x8*)(lds + PG8_SB(b, h) + boff + n * 2048 + k * 1024); } while (0)
#define PG8_MMA(ai, bj, At, Bt) do { __builtin_amdgcn_s_setprio(1); _Pragma("unroll") for (int m = 0; m < 4; ++m) _Pragma("unroll") for (int n = 0; n < 2; ++n) _Pragma("unroll") for (int k = 0; k < 2; ++k) \
        acc[ai][bj][m][n] = __builtin_amdgcn_mfma_f32_16x16x32_bf16(Bt[n][k], At[m][k], acc[ai][bj][m][n], 0, 0, 0); __builtin_amdgcn_s_setprio(0); } while (0)
#define PG8_WAIT_V(n) asm volatile("s_waitcnt vmcnt(" #n ")" ::: "memory")
#define PG8_WAIT_L(n) asm volatile("s_waitcnt lgkmcnt(" #n ")" ::: "memory")
#define PG8_BAR __builtin_amdgcn_s_barrier()
#define PG8_SCHED __builtin_amdgcn_sched_barrier(0)
    Unit cur, nxt; int ui = 0;
    if (!S.next(0, cur)) return;
    f32x4 acc[2][2][4][2];
#pragma unroll
    for (int a = 0; a < 2; ++a)
#pragma unroll
        for (int b = 0; b < 2; ++b)
#pragma unroll
            for (int m = 0; m < 4; ++m)
#pragma unroll
                for (int n = 0; n < 2; ++n) acc[a][b][m][n] = (f32x4){0.f, 0.f, 0.f, 0.f};
    bf16x8 At[4][2], B0[2][2], B1[2][2];
    const char* cA = (const char*)g.A + (size_t)cur.pm * tstep; const char* cB = (const char*)g.Bt + (size_t)cur.pn * tstep;
    S.a_ready(cur);
    if constexpr (SP2) {
        PG8_STAGE(PG8_SB(0, 0), cB, voffB); PG8_STAGE(PG8_SB(0, 1), cB + hstep, voffB); PG8_STAGE(PG8_SA(0, 0), cA, voffA); PG8_STAGE(PG8_SA(0, 1), cA + hstep, voffA);
        if (wr == 1) PG8_BAR;
        PG8_WAIT_V(2); PG8_BAR;
        PG8_STAGE(PG8_SB(1, 0), cB + kstep, voffB); PG8_STAGE(PG8_SA(1, 0), cA + kstep, voffA); PG8_STAGE(PG8_SB(1, 1), cB + hstep + kstep, voffB);
        PG8_WAIT_V(6); PG8_BAR;
    } else {
        PG8_STAGE(PG8_SB(0, 0), cB, voffB); PG8_STAGE(PG8_SA(0, 0), cA, voffA); PG8_STAGE(PG8_SB(0, 1), cB + hstep, voffB); PG8_STAGE(PG8_SA(0, 1), cA + hstep, voffA);
        if (wr == 1) PG8_BAR;
        PG8_WAIT_V(4); PG8_BAR;
        PG8_STAGE(PG8_SB(1, 0), cB + kstep, voffB); PG8_STAGE(PG8_SA(1, 0), cA + kstep, voffA); PG8_STAGE(PG8_SB(1, 1), cB + hstep + kstep, voffB);
        PG8_WAIT_V(6); PG8_BAR;
    }
    for (;;) {
        const bool has_next = S.next(ui + 1, nxt);
        const char* nA = has_next ? (const char*)g.A + (size_t)nxt.pm * tstep : cA; const char* nB = has_next ? (const char*)g.Bt + (size_t)nxt.pn * tstep : cB;
        for (int t = 0; t < nt; t += 2) {
            const bool last = (t == nt - 2);
            const char* a1 = cA + (size_t)(t + 1) * kstep;
            const char* a2 = last ? nA : cA + (size_t)(t + 2) * kstep; const char* b2 = last ? nB : cB + (size_t)(t + 2) * kstep;
            const char* a3 = a2 + kstep; const char* b3 = b2 + kstep;
            if (last && has_next) S.a_ready(nxt);
            if constexpr (SP2) {
            PG8_LDB(B0, 0, 0); PG8_LDB(B1, 0, 1); PG8_SCHED; PG8_LDA(At, 0, 0); PG8_STAGE(PG8_SA(1, 1), a1 + hstep, voffA);
            PG8_WAIT_V(8); PG8_WAIT_L(0); PG8_BAR; PG8_MMA(0, 0, At, B0); PG8_MMA(0, 1, At, B1); PG8_BAR; PG8_SCHED;
            PG8_LDA(At, 0, 1); PG8_STAGE(PG8_SB(0, 0), b2, voffB); PG8_STAGE(PG8_SB(0, 1), b2 + hstep, voffB); PG8_STAGE(PG8_SA(0, 0), a2, voffA);
            PG8_WAIT_V(8); PG8_WAIT_L(0); PG8_BAR; PG8_MMA(1, 0, At, B0); PG8_MMA(1, 1, At, B1); PG8_BAR; PG8_SCHED;
            PG8_LDB(B0, 1, 0); PG8_LDB(B1, 1, 1); PG8_SCHED; PG8_LDA(At, 1, 0); PG8_STAGE(PG8_SA(0, 1), a2 + hstep, voffA);
            PG8_WAIT_V(8); PG8_WAIT_L(0); PG8_BAR; PG8_MMA(0, 0, At, B0); PG8_MMA(0, 1, At, B1); PG8_BAR; PG8_SCHED;
            PG8_LDA(At, 1, 1); PG8_STAGE(PG8_SB(1, 0), b3, voffB); PG8_STAGE(PG8_SB(1, 1), b3 + hstep, voffB); PG8_STAGE(PG8_SA(1, 0), a3, voffA);
            PG8_WAIT_V(8); PG8_WAIT_L(0); PG8_BAR; PG8_MMA(1, 0, At, B0); PG8_MMA(1, 1, At, B1); PG8_BAR; PG8_SCHED;
            } else {
            PG8_LDB(B0, 0, 0); PG8_SCHED; PG8_LDA(At, 0, 0); PG8_STAGE(PG8_SA(1, 1), a1 + hstep, voffA);
            PG8_WAIT_L(8); PG8_BAR; PG8_WAIT_L(0); PG8_MMA(0, 0, At, B0); PG8_BAR; PG8_SCHED;
            PG8_LDB(B1, 0, 1); PG8_STAGE(PG8_SB(0, 0), b2, voffB);
            PG8_BAR; PG8_WAIT_L(0); PG8_MMA(0, 1, At, B1); PG8_BAR;
            PG8_LDA(At, 0, 1); PG8_STAGE(PG8_SA(0, 0), a2, voffA);
            PG8_BAR; PG8_WAIT_L(0); PG8_MMA(1, 0, At, B0); PG8_BAR; PG8_SCHED;
            PG8_STAGE(PG8_SB(0, 1), b2 + hstep, voffB);
            PG8_WAIT_V(6); PG8_BAR; PG8_MMA(1, 1, At, B1); PG8_BAR;
            PG8_LDB(B0, 1, 0); PG8_SCHED; PG8_LDA(At, 1, 0); PG8_STAGE(PG8_SA(0, 1), a2 + hstep, voffA);
            PG8_WAIT_L(8); PG8_BAR; PG8_WAIT_L(0); PG8_MMA(0, 0, At, B0); PG8_BAR; PG8_SCHED;
            PG8_LDB(B1, 1, 1); PG8_STAGE(PG8_SB(1, 0), b3, voffB);
            PG8_BAR; PG8_WAIT_L(0); PG8_MMA(0, 1, At, B1); PG8_BAR;
            PG8_LDA(At, 1, 1); PG8_STAGE(PG8_SA(1, 0), a3, voffA);
            PG8_BAR; PG8_WAIT_L(0); PG8_MMA(1, 0, At, B0); PG8_BAR; PG8_SCHED;
            PG8_STAGE(PG8_SB(1, 1), b3 + hstep, voffB);
            PG8_WAIT_V(6); PG8_BAR; PG8_MMA(1, 1, At, B1); PG8_BAR;
            }
        }
        if constexpr (ALIGN_EPI) { if (wr == 0) PG8_BAR; }
        if constexpr (!Epi::AFTER_DRAIN) { E(acc, cur, wr, wc, fr, fq); S.done(cur); }
        if (!has_next) break;
#pragma unroll
        for (int a = 0; a < 2; ++a)
#pragma unroll
            for (int b = 0; b < 2; ++b)
#pragma unroll
                for (int m = 0; m < 4; ++m)
#pragma unroll
                    for (int n = 0; n < 2; ++n) acc[a][b][m][n] = (f32x4){0.f, 0.f, 0.f, 0.f};
        cur = nxt; cA = nA; cB = nB; ++ui;
        if constexpr (ALIGN_EPI) { if (wr == 1) PG8_BAR; }
    }
    PG8_WAIT_V(0);
    if constexpr (!ALIGN_EPI) { if (wr == 0) PG8_BAR; }
    PG8_BAR;
    if constexpr (Epi::AFTER_DRAIN) { E.fused(acc, cur, wr, wc, fr, fq, lds, wid, lane); S.done(cur); }
#undef PG8_SA
#undef PG8_SB
#undef PG8_STAGE
#undef PG8_LDA
#undef PG8_LDB
#undef PG8_MMA
#undef PG8_WAIT_V
#undef PG8_WAIT_L
#undef PG8_BAR
#undef PG8_SCHED
}
}

constexpr int DM = 1024, NB = 2, SEQ = 8192, CTXL = 256, MLAT = NB * SEQ, MCTX = NB * CTXL, MROWS = MLAT + MCTX;
constexpr int NIN = 2560, NCHUNK = MROWS / 64  , NPJ = 132  ;
constexpr float EPSF = 1e-6f;
constexpr int NWAVES = 8, NTHR = 512;

constexpr size_t MiB = 1u << 20;
constexpr size_t WS_CTL = 0, CTL_ZERO_BYTES = 64 * 1024;
constexpr size_t WS_MOD = 1 * MiB;
constexpr size_t WS_GWF = 1 * MiB + 256 * 1024;
constexpr size_t WS_BT1 = 2 * MiB;
constexpr size_t WS_BT2 = 12 * MiB;
constexpr size_t WS_AGGA = 16 * MiB;
constexpr size_t WS_AGGB = 16 * MiB + 1536 * 1024;
constexpr size_t WS_SSQ = 19 * MiB;
constexpr size_t WS_XC1 = 21 * MiB;
constexpr size_t WS_H = 23 * MiB;
constexpr size_t WS_Y = 56 * MiB;
constexpr size_t WS_MIXIN = 73 * MiB;
constexpr size_t WS_U = 106 * MiB;
constexpr size_t WS_MIX = 189 * MiB;
constexpr size_t WS_END = 255 * MiB;

constexpr int LDS_BYTES = 135168;

#define LAS __attribute__((address_space(3)))
typedef unsigned short bf16;
typedef unsigned v4u __attribute__((ext_vector_type(4)));
typedef unsigned v2u __attribute__((ext_vector_type(2)));
typedef float f32x4 __attribute__((ext_vector_type(4)));
typedef short bf16x8 __attribute__((ext_vector_type(8)));
#define LDS_WAIT() asm volatile("s_waitcnt lgkmcnt(0)" ::: "memory")

__device__ __forceinline__ unsigned f2bf(float f) { unsigned u = __builtin_bit_cast(unsigned, f); return (u + 0x7fffu + ((u >> 16) & 1u)) >> 16; }
__device__ __forceinline__ unsigned pk2(float lo, float hi) { return f2bf(lo) | (f2bf(hi) << 16); }
__device__ __forceinline__ float bflo(unsigned u) { return __builtin_bit_cast(float, u << 16); }
__device__ __forceinline__ float bfhi(unsigned u) { return __builtin_bit_cast(float, u & 0xffff0000u); }
__device__ __forceinline__ float sigmoidf_(float x) { return 1.0f / (1.0f + __expf(-x)); }
__device__ __forceinline__ float siluf_(float x) { return x / (1.0f + __expf(-x)); }
__device__ __forceinline__ float wave_sum(float v) {
#pragma unroll
    for (int o = 1; o < 64; o <<= 1) v += __shfl_xor(v, o);
    return v;
}

struct Args {
    const float* in[21]; float* out; unsigned char* ws; int ph_lo, ph_hi, coop, pad;
};
enum { I_X = 0, I_C, I_CTX, I_CCTX, I_WMOD, I_BMOD, I_GPRE, I_GPOST, I_WIN, I_CAW, I_CAB, I_WR, I_BR, I_WI, I_BI, I_LAM, I_DWW, I_DWB, I_LNG, I_LNB, I_WOUT };

namespace pg8 {
struct EpiU {
    static constexpr bool PERM = true, AFTER_DRAIN = false;
    bf16_t* O;
    __device__ __forceinline__ void operator()(const f32x4 (&acc)[2][2][4][2], const Unit& u, int wr, int wc, int fr, int fq) const {
        const int row0 = u.pm * BM + wr * 64 + fr, col0 = u.pn * BM + wc * 32 + 8 * fq;
        const bool act = (u.pn == 2 || u.pn == 3 || u.pn >= 8);
#pragma unroll
        for (int ai = 0; ai < 2; ++ai)
#pragma unroll
            for (int m = 0; m < 4; ++m) { bf16_t* rowp = O + (size_t)(row0 + ai * HALF + m * 16) * 2560 + col0;
#pragma unroll
                for (int bj = 0; bj < 2; ++bj) { f32x4 v0 = acc[ai][bj][m][0], v1 = acc[ai][bj][m][1];
                    if (act) {
#pragma unroll
                        for (int e = 0; e < 4; ++e) { v0[e] = v0[e] / (1.0f + __expf(-v0[e])); v1[e] = v1[e] / (1.0f + __expf(-v1[e])); }
                    }
                    u32x4 w; w.x = cvt_pk_bf16(v0[0], v0[1]); w.y = cvt_pk_bf16(v0[2], v0[3]); w.z = cvt_pk_bf16(v1[0], v1[1]); w.w = cvt_pk_bf16(v1[2], v1[3]);
                    *(u32x4*)(rowp + bj * HALF) = w; } }
    }
};
struct EpiMix {
    static constexpr bool PERM = false, AFTER_DRAIN = false;
    float* O; float* ssq;
    __device__ __forceinline__ void operator()(const f32x4 (&acc)[2][2][4][2], const Unit& u, int wr, int wc, int fr, int fq) const {
        const int col0 = u.pn * BM + wc * 32 + 4 * fq;
#pragma unroll
        for (int ai = 0; ai < 2; ++ai)
#pragma unroll
            for (int m = 0; m < 4; ++m) { const int r = u.pm * BM + ai * HALF + wr * 64 + m * 16 + fr; float* rowp = O + (size_t)r * 1024 + col0; float s = 0.f;
#pragma unroll
                for (int bj = 0; bj < 2; ++bj)
#pragma unroll
                    for (int n = 0; n < 2; ++n) { const f32x4 v = acc[ai][bj][m][n]; s += (v[0] * v[0] + v[1] * v[1]) + (v[2] * v[2] + v[3] * v[3]); *(f32x4*)(rowp + bj * HALF + n * 16) = v; }
                s += __shfl_xor(s, 16); s += __shfl_xor(s, 32);
                if (fq == 0) ssq[(size_t)r * 16 + u.pn * 4 + wc] = s; }
    }
};
}

__device__ __forceinline__ void p0_transpose_item(const float* W, int K, int N, bf16* WT, LAS float* scr, int item, int lane) {
    const int nblk = N / 32, kb = item / nblk, nb = item % nblk, k0 = 64 * kb, n0 = 32 * nb;
#pragma unroll 8
    for (int i = 0; i < 32; ++i) { const int kk = 2 * i + (lane >> 5); scr[kk * 33 + (lane & 31)] = W[(size_t)(k0 + kk) * N + n0 + (lane & 31)]; }
    LDS_WAIT(); asm volatile("" ::: "memory");
    const int c = lane & 7;
#pragma unroll
    for (int j = 0; j < 4; ++j) { const int n = (lane >> 3) + 8 * j; const LAS float* s = scr + (8 * c) * 33 + n;
        v4u o; o.x = pk2(s[0 * 33], s[1 * 33]); o.y = pk2(s[2 * 33], s[3 * 33]); o.z = pk2(s[4 * 33], s[5 * 33]); o.w = pk2(s[6 * 33], s[7 * 33]);
        *(v4u*)(WT + (size_t)(n0 + n) * K + k0 + 8 * c) = o; }
    LDS_WAIT(); asm volatile("" ::: "memory");
}

__device__ __forceinline__ void p0_prologue(const Args& a, LAS unsigned char* lds, int tid, int lane, int wave) {
    const int G = gridDim.x, bx = blockIdx.x;
    unsigned char* ws = a.ws;
    {
        LAS float* part = (LAS float*)lds;
        float* MOD = (float*)(ws + WS_MOD);
        const float* c = a.in[I_C]; const float* cctx = a.in[I_CCTX];
        for (int un = bx; un < 192; un += G) {
            const int l = un / 96, n0 = (un % 96) * 32, cq = tid & 7, ks = tid >> 3;
            const float* wm = a.in[I_WMOD] + (size_t)l * 1024 * 3072 + n0 + cq * 4;
            f32x4 acc0 = {0.f, 0.f, 0.f, 0.f}, acc1 = acc0, acc2 = acc0;
#pragma unroll 4
            for (int kk = 0; kk < 16; ++kk) { const int k = ks * 16 + kk; const f32x4 w = *(const f32x4*)(wm + (size_t)k * 3072);
                const float a0 = siluf_(c[k]), a1 = siluf_(c[1024 + k]), a2 = siluf_(cctx[k]);
                acc0 += w * a0; acc1 += w * a1; acc2 += w * a2; }
            *(LAS f32x4*)(part + (0 * 64 + ks) * 32 + cq * 4) = acc0;
            *(LAS f32x4*)(part + (1 * 64 + ks) * 32 + cq * 4) = acc1;
            *(LAS f32x4*)(part + (2 * 64 + ks) * 32 + cq * 4) = acc2;
            __syncthreads();
            if (tid < 96) { const int v = tid >> 5, col = tid & 31; float s = a.in[I_BMOD][l * 3072 + n0 + col];
                for (int k2 = 0; k2 < 64; ++k2) s += part[(v * 64 + k2) * 32 + col];
                MOD[(l * 3 + v) * 3072 + n0 + col] = s; }
            __syncthreads();
        }
    }
    {
        v4u* GWF = (v4u*)(ws + WS_GWF);
        for (int idx = bx * NTHR + tid; idx < 32768; idx += G * NTHR) {
            const int ln = idx & 63, kk = (idx >> 6) & 1, ct = (idx >> 7) & 3, h = (idx >> 9) & 7, g = (idx >> 12) & 1, d = (idx >> 13) & 1, l = idx >> 14;
            const float* W = (g == 0 ? a.in[I_WR] : a.in[I_WI]) + (size_t)(((l * 2 + d) * 8 + h) * 64) * 64;
            const int k0 = 32 * kk + 8 * (ln >> 4), col = 16 * ct + (ln & 15);
            float e[8];
#pragma unroll
            for (int j = 0; j < 8; ++j) e[j] = W[(k0 + j) * 64 + col];
            v4u o; o.x = pk2(e[0], e[1]); o.y = pk2(e[2], e[3]); o.z = pk2(e[4], e[5]); o.w = pk2(e[6], e[7]);
            GWF[idx] = o;
        }
    }
    {
        LAS float* scr = (LAS float*)(lds + wave * 16384);
        const int gw = bx * NWAVES + wave, NGW = G * NWAVES;
        constexpr int I_1 = (1024 / 64) * (NIN / 32), I_2 = (1024 / 64) * (1024 / 32), NITEMS = 2 * (I_1 + I_2);
        bf16* BT1 = (bf16*)(ws + WS_BT1); bf16* BT2 = (bf16*)(ws + WS_BT2);
        for (int it = gw; it < NITEMS; it += NGW) {
            int r = it;
            if (r < I_1) { p0_transpose_item(a.in[I_WIN], 1024, NIN, BT1, scr, r, lane); continue; } r -= I_1;
            if (r < I_1) { p0_transpose_item(a.in[I_WIN] + (size_t)1024 * NIN, 1024, NIN, BT1 + (size_t)NIN * 1024, scr, r, lane); continue; } r -= I_1;
            if (r < I_2) { p0_transpose_item(a.in[I_WOUT], 1024, 1024, BT2, scr, r, lane); continue; } r -= I_2;
            p0_transpose_item(a.in[I_WOUT] + (size_t)1024 * 1024, 1024, 1024, BT2 + (size_t)1024 * 1024, scr, r, lane);
        }
    }
}

__device__ __forceinline__ void norm_phase(const Args& a, int mode, int lane, int wave) {
    unsigned char* ws = a.ws;
    const float* MOD = (const float*)(ws + WS_MOD); const float* MIX = (const float*)(ws + WS_MIX); const float* SSQ = (const float*)(ws + WS_SSQ);
    float* XC1 = (float*)(ws + WS_XC1); bf16* H = (bf16*)(ws + WS_H);
    const int gw = blockIdx.x * NWAVES + wave, NGW = gridDim.x * NWAVES;
    const int nrows = (mode == 2) ? MLAT : MROWS, lu = (mode == 1) ? 0 : 1, ln = (mode == 0) ? 0 : 1;
    for (int row = gw; row < nrows; row += NGW) {
        const int vsel = row < MLAT ? (row >> 13) : 2;
        const float* src;
        if (mode == 2) src = a.out + (size_t)row * 1024;
        else src = row < MLAT ? a.in[I_X] + (size_t)row * 1024 : a.in[I_CTX] + (size_t)(row - MLAT) * 1024;
        f32x4 v[4];
#pragma unroll
        for (int j = 0; j < 4; ++j) v[j] = *((const f32x4*)src + lane + 64 * j);
        if (mode >= 1) {
            const float sp = lane < 16 ? SSQ[(size_t)row * 16 + lane] : 0.f;
            const float rstd = rsqrtf(wave_sum(sp) * (1.0f / 1024.0f) + EPSF);
            const float* gate = MOD + (lu * 3 + vsel) * 3072 + 2048; const float* gp = a.in[I_GPOST] + lu * 1024;
#pragma unroll
            for (int j = 0; j < 4; ++j) { const f32x4 mx = *((const f32x4*)(MIX + (size_t)row * 1024) + lane + 64 * j);
                const f32x4 gt = *((const f32x4*)gate + lane + 64 * j), gv = *((const f32x4*)gp + lane + 64 * j);
                v[j] += gt * (mx * rstd * gv); }
            float* dst = row < MLAT ? a.out + (size_t)row * 1024 : XC1 + (size_t)(row - MLAT) * 1024;
#pragma unroll
            for (int j = 0; j < 4; ++j) *((f32x4*)dst + lane + 64 * j) = v[j];
        }
        if (mode <= 1) {
            float s = 0.f;
#pragma unroll
            for (int j = 0; j < 4; ++j) s += (v[j].x * v[j].x + v[j].y * v[j].y) + (v[j].z * v[j].z + v[j].w * v[j].w);
            const float r = rsqrtf(wave_sum(s) * (1.0f / 1024.0f) + EPSF);
            const float* shift = MOD + (ln * 3 + vsel) * 3072; const float* scale = shift + 1024; const float* gpre = a.in[I_GPRE] + ln * 1024;
            v2u* o8 = (v2u*)(H + (size_t)row * 1024);
#pragma unroll
            for (int j = 0; j < 4; ++j) { const f32x4 sh = *((const f32x4*)shift + lane + 64 * j), sc = *((const f32x4*)scale + lane + 64 * j), gv = *((const f32x4*)gpre + lane + 64 * j);
                const f32x4 hv = v[j] * r * gv * (sc + 1.0f) + sh;
                v2u w; w.x = pk2(hv.x, hv.y); w.y = pk2(hv.z, hv.w); o8[lane + 64 * j] = w; }
        }
    }
}

__device__ __forceinline__ void conv16(const LAS unsigned* vt, const float (&w0)[31], const float (&w1)[31], float b0, float b1, float (&o0)[16], float (&o1)[16]) {
#pragma unroll
    for (int t = 0; t < 16; ++t) { o0[t] = b0; o1[t] = b1; }
#pragma unroll
    for (int rr = 0; rr < 46; ++rr) { const unsigned u = vt[rr * 128]; const float lo = bflo(u), hi = bfhi(u);
#pragma unroll
        for (int t = 0; t < 16; ++t) { const int k = rr - t; if (k >= 0 && k < 31) { o0[t] += w0[k] * lo; o1[t] += w1[k] * hi; } }
        if ((rr & 3) == 3) asm volatile("" ::: "memory"); }
}
__device__ __forceinline__ v4u glu8(const v4u vq, const v4u gq) {
    v4u o;
    o.x = pk2(bflo(vq.x) * sigmoidf_(bflo(gq.x)), bfhi(vq.x) * sigmoidf_(bfhi(gq.x)));
    o.y = pk2(bflo(vq.y) * sigmoidf_(bflo(gq.y)), bfhi(vq.y) * sigmoidf_(bfhi(gq.y)));
    o.z = pk2(bflo(vq.z) * sigmoidf_(bflo(gq.z)), bfhi(vq.z) * sigmoidf_(bfhi(gq.z)));
    o.w = pk2(bflo(vq.w) * sigmoidf_(bflo(gq.w)), bfhi(vq.w) * sigmoidf_(bfhi(gq.w)));
    return o;
}
__device__ __forceinline__ void hconv_unit(const Args& a, LAS unsigned char* lds, int l, int r0, int g, int vlo, int vhi, int tid) {
    const bf16* U = (const bf16*)(a.ws + WS_U); bf16* Y = (bf16*)(a.ws + WS_Y);
    LAS unsigned* VT = (LAS unsigned*)lds;
    for (int i = tid; i < 94 * 32; i += NTHR) { const int rr = i >> 5, ch = i & 31, row = r0 - 15 + rr;
        v4u o = {0u, 0u, 0u, 0u};
        if (row >= vlo && row < vhi) { const bf16* up = U + (size_t)row * NIN + g * 256 + ch * 8; o = glu8(*(const v4u*)(up + 1024), *(const v4u*)(up + 1536)); }
        *(LAS v4u*)(VT + rr * 128 + ch * 4) = o; }
    __syncthreads();
    int p = tid & 127; asm volatile("" : "+v"(p));
    const int tg = tid >> 7, c0 = g * 256 + 2 * p;
    float w0[31], w1[31];
#pragma unroll
    for (int k = 0; k < 31; ++k) { const float2 w = *(const float2*)(a.in[I_DWW] + (size_t)(l * 31 + k) * 512 + c0); w0[k] = w.x; w1[k] = w.y; }
    const float2 bb = *(const float2*)(a.in[I_DWB] + l * 512 + c0);
    float o0[16], o1[16];
    conv16(VT + (tg * 16) * 128 + p, w0, w1, bb.x, bb.y, o0, o1);
#pragma unroll
    for (int t = 0; t < 16; ++t) *(unsigned*)(Y + (size_t)(r0 + tg * 16 + t) * 512 + c0) = pk2(o0[t], o1[t]);
    __syncthreads();
}
__device__ __forceinline__ void vconv_unit(const Args& a, LAS unsigned char* lds, int l, int b, int w, int tid) {
    const bf16* U = (const bf16*)(a.ws + WS_U); bf16* Y = (bf16*)(a.ws + WS_Y);
    LAS unsigned* VT = (LAS unsigned*)lds;
    for (int i = tid; i < 158 * 32; i += NTHR) { const int rr = i >> 5, ch = i & 31, gr = rr - 15;
        v4u o = {0u, 0u, 0u, 0u};
        if (gr >= 0 && gr < 128) { const bf16* up = U + (size_t)(b * SEQ + gr * 64 + w) * NIN + 256 + ch * 8; o = glu8(*(const v4u*)(up + 1024), *(const v4u*)(up + 1536)); }
        *(LAS v4u*)(VT + rr * 128 + ch * 4) = o; }
    __syncthreads();
    int p = tid & 127; asm volatile("" : "+v"(p));
    const int tg = tid >> 7, c0 = 256 + 2 * p;
    float w0[31], w1[31];
#pragma unroll
    for (int k = 0; k < 31; ++k) { const float2 wv = *(const float2*)(a.in[I_DWW] + (size_t)(l * 31 + k) * 512 + c0); w0[k] = wv.x; w1[k] = wv.y; }
    const float2 bb = *(const float2*)(a.in[I_DWB] + l * 512 + c0);
#pragma unroll 1
    for (int half = 0; half < 2; ++half) {
        const int tb = tg * 32 + half * 16;
        float o0[16], o1[16];
        conv16(VT + tb * 128 + p, w0, w1, bb.x, bb.y, o0, o1);
#pragma unroll
        for (int t = 0; t < 16; ++t) *(unsigned*)(Y + (size_t)(b * SEQ + (tb + t) * 64 + w) * 512 + c0) = pk2(o0[t], o1[t]);
    }
    __syncthreads();
}
__device__ __forceinline__ void ln_rows(const Args& a, int l, int nrows, int lane, int wave) {
    const bf16* U = (const bf16*)(a.ws + WS_U); const bf16* Y = (const bf16*)(a.ws + WS_Y); bf16* MIXIN = (bf16*)(a.ws + WS_MIXIN);
    const int gw = blockIdx.x * NWAVES + wave, NGW = gridDim.x * NWAVES, c0 = lane * 8;
    float lg[8], lb[8];
#pragma unroll
    for (int e = 0; e < 8; ++e) { lg[e] = a.in[I_LNG][l * 512 + c0 + e]; lb[e] = a.in[I_LNB][l * 512 + c0 + e]; }
    for (int row = gw; row < nrows; row += NGW) {
        const v4u yq = *(const v4u*)(Y + (size_t)row * 512 + c0); const v4u gq = *(const v4u*)(U + (size_t)row * NIN + 2048 + c0);
        float y[8] = {bflo(yq.x), bfhi(yq.x), bflo(yq.y), bfhi(yq.y), bflo(yq.z), bfhi(yq.z), bflo(yq.w), bfhi(yq.w)};
        const float gt[8] = {bflo(gq.x), bfhi(gq.x), bflo(gq.y), bfhi(gq.y), bflo(gq.z), bfhi(gq.z), bflo(gq.w), bfhi(gq.w)};
        float s = 0.f;
#pragma unroll
        for (int e = 0; e < 8; ++e) s += y[e];
        const float mean = wave_sum(s) * (1.0f / 512.0f); float q = 0.f;
#pragma unroll
        for (int e = 0; e < 8; ++e) { y[e] -= mean; q += y[e] * y[e]; }
        const float rstd = rsqrtf(wave_sum(q) * (1.0f / 512.0f) + EPSF);
        float o[8];
#pragma unroll
        for (int e = 0; e < 8; ++e) o[e] = siluf_(y[e] * rstd * lg[e] + lb[e]) * gt[e];
        v4u w; w.x = pk2(o[0], o[1]); w.y = pk2(o[2], o[3]); w.z = pk2(o[4], o[5]); w.w = pk2(o[6], o[7]);
        *(v4u*)(MIXIN + (size_t)row * 1024 + 512 + c0) = w;
    }
}

__device__ __forceinline__ void rglru_unit(const Args& a, LAS unsigned char* lds, int l, int ck, int h, bool final_pass, int tid, int lane, int wave) {
    const bf16* U = (const bf16*)(a.ws + WS_U); bf16* MIXIN = (bf16*)(a.ws + WS_MIXIN);
    float* AGGA = (float*)(a.ws + WS_AGGA); float* AGGB = (float*)(a.ws + WS_AGGB);
    const v4u* GWF = (const v4u*)(a.ws + WS_GWF);
    const int r0 = ck * 64; int seg_lo, seg_hi, b, pjf, pjb;
    if (ck < 256) { b = ck >> 7; const int j = ck & 127; seg_lo = b * SEQ; seg_hi = seg_lo + SEQ; pjf = 4 + j; pjb = 4 + 127 - j; }
    else { const int cc = ck - 256; b = cc >> 2; const int j = cc & 3; seg_lo = MLAT + b * CTXL; seg_hi = seg_lo + CTXL; pjf = j; pjb = 3 - j; }
    LAS float* AVT = (LAS float*)lds;
    LAS float* VC = (LAS float*)(lds + 17920);
    LAS float* AS = (LAS float*)(lds + 17920 + 34816);
    LAS float* FA = (LAS float*)(lds + 17920 + 2 * 34816);
    LAS float* FB = FA + 512;
    for (int i = tid; i < 70 * 8; i += NTHR) { const int rr = i >> 3, ch = i & 7, row = r0 - 3 + rr;
        f32x4 f0 = {0.f, 0.f, 0.f, 0.f}, f1 = f0;
        if (row >= seg_lo && row < seg_hi) { const v4u q = *(const v4u*)(U + (size_t)row * NIN + 64 * h + ch * 8);
            f0 = (f32x4){bflo(q.x), bfhi(q.x), bflo(q.y), bfhi(q.y)}; f1 = (f32x4){bflo(q.z), bfhi(q.z), bflo(q.w), bfhi(q.w)}; }
        *(LAS f32x4*)(AVT + rr * 64 + ch * 8) = f0; *(LAS f32x4*)(AVT + rr * 64 + ch * 8 + 4) = f1; }
    if (final_pass) {
        const int seg = tid >> 7, dc = tid & 127, d = dc >> 6, c = dc & 63, pj = d ? pjb : pjf, lo = (pj * seg) >> 2, hi = (pj * (seg + 1)) >> 2;
        const size_t base = (size_t)((b * 2 + d) * NPJ) * 512 + 64 * h + c; float A = 1.f, Bv = 0.f;
#pragma unroll 4
        for (int i = lo; i < hi; ++i) { const float ai = AGGA[base + (size_t)i * 512], bi = AGGB[base + (size_t)i * 512]; Bv = ai * Bv + bi; A *= ai; }
        FA[seg * 128 + dc] = A; FB[seg * 128 + dc] = Bv;
    }
    __syncthreads();
    { const int d = tid >> 8, rem = tid & 255, tt = rem >> 2, cg4 = rem & 3, ro = tt + (d ? 3 : 0);
      const float* cw = a.in[I_CAW] + (size_t)((l * 2 + d) * 4) * 512 + 64 * h + cg4 * 16; const float* cb = a.in[I_CAB] + (l * 2 + d) * 512 + 64 * h + cg4 * 16;
#pragma unroll
      for (int c4 = 0; c4 < 4; ++c4) { f32x4 acc = *(const f32x4*)(cb + c4 * 4);
#pragma unroll
          for (int k = 0; k < 4; ++k) { const f32x4 w = *(const f32x4*)(cw + k * 512 + c4 * 4); const f32x4 x = *(const LAS f32x4*)(AVT + (ro + k) * 64 + cg4 * 16 + c4 * 4); acc += w * x; }
          *(LAS f32x4*)(VC + (d * 64 + tt) * 68 + cg4 * 16 + c4 * 4) = acc; } }
    __syncthreads();
    { const int d = wave >> 2, q = wave & 3, fr = lane & 15, fq = lane >> 4;
      bf16x8 af[2];
#pragma unroll
      for (int kk = 0; kk < 2; ++kk) { const LAS float* vp = VC + (d * 64 + 16 * q + fr) * 68 + 32 * kk + 8 * fq; const f32x4 x0 = *(const LAS f32x4*)vp, x1 = *(const LAS f32x4*)(vp + 4);
          v4u pk; pk.x = pk2(x0.x, x0.y); pk.y = pk2(x0.z, x0.w); pk.z = pk2(x1.x, x1.y); pk.w = pk2(x1.z, x1.w); af[kk] = __builtin_bit_cast(bf16x8, pk); }
      f32x4 accr[4], acci[4];
      const v4u* gr = GWF + (size_t)((((l * 2 + d) * 2 + 0) * 8 + h) * 8) * 64 + lane; const v4u* gi = GWF + (size_t)((((l * 2 + d) * 2 + 1) * 8 + h) * 8) * 64 + lane;
#pragma unroll
      for (int ct = 0; ct < 4; ++ct) { accr[ct] = (f32x4){0.f, 0.f, 0.f, 0.f}; acci[ct] = accr[ct];
#pragma unroll
          for (int kk = 0; kk < 2; ++kk) { const bf16x8 br = __builtin_bit_cast(bf16x8, gr[(ct * 2 + kk) * 64]), bi = __builtin_bit_cast(bf16x8, gi[(ct * 2 + kk) * 64]);
              accr[ct] = __builtin_amdgcn_mfma_f32_16x16x32_bf16(af[kk], br, accr[ct], 0, 0, 0); acci[ct] = __builtin_amdgcn_mfma_f32_16x16x32_bf16(af[kk], bi, acci[ct], 0, 0, 0); } }
#pragma unroll
      for (int ct = 0; ct < 4; ++ct) { const int c = 16 * ct + fr, pidx = (l * 2 + d) * 512 + 64 * h + c;
          const float brv = a.in[I_BR][pidx], biv = a.in[I_BI][pidx], lam = a.in[I_LAM][pidx], sp8 = -8.0f * log1pf(__expf(-lam));
#pragma unroll
          for (int jj = 0; jj < 4; ++jj) { const int tt = 16 * q + 4 * fq + jj; const int li = (d * 64 + tt) * 68 + c;
              const float r = sigmoidf_(accr[ct][jj] + brv), ig = sigmoidf_(acci[ct][jj] + biv), la = sp8 * r, aa = __expf(la);
              const float bb = sqrtf(-expm1f(2.0f * la)) * (ig * VC[li]);
              AS[li] = aa; VC[li] = bb; } } }
    __syncthreads();
    if (tid < 128) { const int d = tid >> 6, c = tid & 63; float hh = 0.f, A = 1.f;
        if (final_pass) {
#pragma unroll
            for (int s = 0; s < 4; ++s) hh = FA[s * 128 + tid] * hh + FB[s * 128 + tid];
        }
#pragma unroll 8
        for (int p = 0; p < 64; ++p) { const int tt = d ? 63 - p : p, li = (d * 64 + tt) * 68 + c; const float aa = AS[li], bb = VC[li]; hh = aa * hh + bb; A *= aa; if (final_pass) VC[li] = hh; }
        if (!final_pass) { const size_t idx = (size_t)((b * 2 + d) * NPJ + (d ? pjb : pjf)) * 512 + 64 * h + c; AGGA[idx] = A; AGGB[idx] = hh; } }
    __syncthreads();
    if (final_pass) { const int tt = tid >> 3, c0 = (tid & 7) * 8, row = r0 + tt;
        const v4u gq = *(const v4u*)(U + (size_t)row * NIN + 512 + 64 * h + c0);
        const float gt[8] = {bflo(gq.x), bfhi(gq.x), bflo(gq.y), bfhi(gq.y), bflo(gq.z), bfhi(gq.z), bflo(gq.w), bfhi(gq.w)};
        float o[8];
#pragma unroll
        for (int e = 0; e < 8; ++e) o[e] = (VC[tt * 68 + c0 + e] + VC[(64 + tt) * 68 + c0 + e]) * gt[e];
        v4u w; w.x = pk2(o[0], o[1]); w.y = pk2(o[2], o[3]); w.z = pk2(o[4], o[5]); w.w = pk2(o[6], o[7]);
        *(v4u*)(MIXIN + (size_t)row * 1024 + 64 * h + c0) = w;
        __syncthreads(); }
}

#define RLX_AGENT __ATOMIC_RELAXED, __HIP_MEMORY_SCOPE_AGENT


#define XB_TMO      128
#define XB_XCNT(j)  (256  + 64 * (j))
#define XB_XSUB(j)  (1280 + 64 * (j))
#define XB_XGEN(j)  (2304 + 64 * (j))
#define XB_TOP      3328
#define XB_TOPGEN   3392
#define XCD_BAR_WORDS 3456
#define XB_SPIN_CAP (1u << 18)

__device__ __forceinline__ unsigned xb_ld(unsigned* p)              { return __hip_atomic_load(p, __ATOMIC_RELAXED, __HIP_MEMORY_SCOPE_AGENT); }
__device__ __forceinline__ unsigned xb_add(unsigned* p, unsigned v) { return __hip_atomic_fetch_add(p, v, __ATOMIC_RELAXED, __HIP_MEMORY_SCOPE_AGENT); }
__device__ __forceinline__ unsigned xb_xcc_id() { return (unsigned)__builtin_amdgcn_s_getreg((3 << 11) | 20) & 0xFu; }
#define XB_SPIN(cond, bar) do { unsigned _sp = 0; while (cond) { __builtin_amdgcn_s_sleep(1); \
    if ((++_sp & 255u) == 0u) { if (xb_ld(&(bar)[XB_TMO])) break; if (_sp > XB_SPIN_CAP) { atomicAdd(&(bar)[XB_TMO], 1u); break; } } } } while (0)

struct XcdBarrier {
    unsigned* bar; unsigned x;
    volatile LAS unsigned* st;
};

__device__ __forceinline__ XcdBarrier xcd_barrier_post(unsigned* bar, volatile LAS unsigned* st) {
    XcdBarrier b; b.bar = bar; b.x = xb_xcc_id(); b.st = st;
    if (threadIdx.x == 0) (void)xb_add(&bar[XB_XCNT(b.x)], 1u);
    return b;
}
__device__ __forceinline__ void xcd_barrier_complete(unsigned* bar, unsigned x, unsigned& nloc, unsigned& nx) {
    const unsigned G = gridDim.x * gridDim.y * gridDim.z;
    unsigned sum, cnt, mine, sp = 0u;
    for (;;) {
        sum = 0u; cnt = 0u; mine = 0u;
#pragma unroll
        for (unsigned j = 0; j < 16; ++j) { const unsigned c = xb_ld(&bar[XB_XCNT(j)]); sum += c; cnt += (c > 0u) ? 1u : 0u; mine = (j == x) ? c : mine; }
        if (sum == G) break;
        __builtin_amdgcn_s_sleep(1);
        if ((++sp & 255u) == 0u) { if (xb_ld(&bar[XB_TMO])) break; if (sp > XB_SPIN_CAP) { atomicAdd(&bar[XB_TMO], 1u); break; } }
    }
    nloc = mine > 0u ? mine : 1u; nx = cnt > 0u ? cnt : 1u;
}

__device__ __forceinline__ void xcd_barrier(const XcdBarrier& b) {
    asm volatile("s_waitcnt vmcnt(0)" ::: "memory");
    __syncthreads();
    if (threadIdx.x == 0) {
        unsigned* bar = b.bar;
        __builtin_amdgcn_s_waitcnt(0);
        unsigned nloc = b.st[0], nx = b.st[1];
        if (nloc == 0u) { xcd_barrier_complete(bar, b.x, nloc, nx); b.st[0] = nloc; b.st[1] = nx; }
        const unsigned old = xb_add(&bar[XB_XSUB(b.x)], 1u);
        const unsigned gen = old / nloc;
        if (old + 1u == (gen + 1u) * nloc) {
            __builtin_amdgcn_fence(__ATOMIC_RELEASE, "agent");
            asm volatile("s_waitcnt vmcnt(0)" ::: "memory");
            const unsigned og = xb_add(&bar[XB_TOP], 1u);
            const unsigned tg = og / nx;
            if (og + 1u == (tg + 1u) * nx) xb_add(&bar[XB_TOPGEN], 1u);
            else XB_SPIN(xb_ld(&bar[XB_TOPGEN]) == tg, bar);
            __builtin_amdgcn_fence(__ATOMIC_ACQUIRE, "agent");
            xb_add(&bar[XB_XGEN(b.x)], 1u);
            asm volatile("s_waitcnt vmcnt(0)" ::: "memory");
        } else {
            XB_SPIN(xb_ld(&bar[XB_XGEN(b.x)]) == gen, bar);
            __builtin_amdgcn_fence(__ATOMIC_ACQUIRE, "agent");
            asm volatile("s_waitcnt vmcnt(0)" ::: "memory");
        }
    }
    __syncthreads();
}

template <int l>
__device__ __forceinline__ void layer_phases(const Args& args, LAS unsigned char* lds, const int tid, const int lane, const int wave, const int lo, const int hi, const XcdBarrier& xbar) {
    const int G = gridDim.x, bx = blockIdx.x; unsigned char* ws = args.ws;
    constexpr int pb = 1 + 5 * l;
#define IN(k) (lo <= (k) && (k) < hi)
#define SEAM(k) do { if (IN(k) && IN((k) + 1)) { xcd_barrier(xbar); } } while (0)
        if (IN(pb)) { norm_phase(args, l, lane, wave); }
        SEAM(pb);
        if (IN(pb + 1)) {
            pg8::Gemm g{(const pg8::bf16_t*)(ws + WS_H), (const pg8::bf16_t*)(ws + WS_BT1) + (size_t)l * NIN * 1024, MROWS, NIN, 1024};
            pg8::StaticOrder S; S.init(MROWS, NIN, G, bx);
            pg8::EpiU E{(pg8::bf16_t*)(ws + WS_U)};
            pg8::gemm_phase<pg8::EpiU, pg8::StaticOrder, true, true>(lds, g, S, E);
        }
        SEAM(pb + 1);
        if (IN(pb + 2)) {
            const int n_h = 256 + (l == 0 ? 16 : 0), n_conv = 128 + n_h, n_units = n_conv + NCHUNK * 8;
            for (int un = bx; un < n_units; un += G) {
                if (un < 128) { vconv_unit(args, lds, l, un >> 6, un & 63, tid); }
                else if (un < n_conv) { const int hu = un - 128;
                    if (hu < 256) hconv_unit(args, lds, l, hu * 64, 0, hu * 64, hu * 64 + 64, tid);
                    else { const int cu = hu - 256, cc = cu >> 1, g = cu & 1, bb = cc >> 2; hconv_unit(args, lds, l, MLAT + cc * 64, g, MLAT + bb * CTXL, MLAT + bb * CTXL + CTXL, tid); } }
                else { const int ru = un - n_conv; rglru_unit(args, lds, l, ru >> 3, ru & 7, false, tid, lane, wave); }
            }
        }
        SEAM(pb + 2);
        if (IN(pb + 3)) {
            const int nck = (l == 0) ? NCHUNK : 256;
            for (int un = bx; un < nck * 8; un += G) rglru_unit(args, lds, l, un >> 3, un & 7, true, tid, lane, wave);
            ln_rows(args, l, (l == 0) ? MROWS : MLAT, lane, wave);
        }
        SEAM(pb + 3);
        if (IN(pb + 4)) {
            const int M2 = (l == 0) ? MROWS : MLAT;
            pg8::Gemm g{(const pg8::bf16_t*)(ws + WS_MIXIN), (const pg8::bf16_t*)(ws + WS_BT2) + (size_t)l * 1024 * 1024, M2, 1024, 1024};
            pg8::StaticOrder S; S.init(M2, 1024, G, bx);
            pg8::EpiMix E{(float*)(ws + WS_MIX), (float*)(ws + WS_SSQ)};
            pg8::gemm_phase<pg8::EpiMix, pg8::StaticOrder, true, true>(lds, g, S, E);
        }
        SEAM(pb + 4);
#undef IN
#undef SEAM
}

__global__ void __launch_bounds__(NTHR, 2) fwd_megakernel(Args args) {
    extern __shared__ __attribute__((aligned(16))) unsigned char lds_raw[];
    LAS unsigned char* lds = (LAS unsigned char*)lds_raw;
    const int tid = threadIdx.x, lane = tid & 63, wave = __builtin_amdgcn_readfirstlane(tid >> 6);
    const int G = gridDim.x, bx = blockIdx.x;
    unsigned char* ws = args.ws;
    const int lo = args.ph_lo, hi = args.ph_hi;
    if (args.coop == 2) cg::this_grid().sync();
    volatile LAS unsigned* MISC = (volatile LAS unsigned*)(lds + 131072);
    if (tid < 64) MISC[tid] = 0u;
    __syncthreads();
    XcdBarrier xbar; xbar.bar = (unsigned*)(ws + WS_CTL); xbar.x = 0; xbar.st = nullptr;
    if (args.coop == 1) xbar = xcd_barrier_post((unsigned*)(ws + WS_CTL), MISC + 8);
#define IN(k) (lo <= (k) && (k) < hi)
#define SEAM(k) do { if (IN(k) && IN((k) + 1)) { xcd_barrier(xbar); } } while (0)

    if (IN(0)) { p0_prologue(args, lds, tid, lane, wave); }
    SEAM(0);
    layer_phases<0>(args, lds, tid, lane, wave, lo, hi, xbar);
    layer_phases<1>(args, lds, tid, lane, wave, lo, hi, xbar);
    if (IN(11)) { norm_phase(args, 2, lane, wave); }
#undef IN
#undef SEAM
}

#ifndef MK_PER_PHASE
#define MK_PER_PHASE 0
#endif
extern "C" void kernel_launch(void* const* d_in, const int* in_sizes, int n_in, void* d_out, int out_size, void* d_ws, size_t ws_size, hipStream_t stream) {
    static int grid = 0;
    if (grid == 0) {
        if (n_in != 21 || out_size != MLAT * DM || ws_size < WS_END) { fprintf(stderr, "kernel_launch: unexpected shapes (n_in %d, out %d, ws %zu)\n", n_in, out_size, ws_size); grid = -1; return; }
        int dev = 0, cus = 0, per_cu = 0;
        if (hipGetDevice(&dev) != hipSuccess || hipDeviceGetAttribute(&cus, hipDeviceAttributeMultiprocessorCount, dev) != hipSuccess) { grid = -1; return; }
        if (hipFuncSetAttribute((const void*)fwd_megakernel, hipFuncAttributeMaxDynamicSharedMemorySize, LDS_BYTES) != hipSuccess) { fprintf(stderr, "kernel_launch: hipFuncSetAttribute failed\n"); grid = -1; return; }
        if (hipOccupancyMaxActiveBlocksPerMultiprocessor(&per_cu, (const void*)fwd_megakernel, NTHR, LDS_BYTES) != hipSuccess || per_cu < 1) { fprintf(stderr, "kernel_launch: occupancy query says %d\n", per_cu); per_cu = 1; }
        (void)hipGetLastError();
        grid = cus;
    }
    if (grid < 0) return;
    if (hipMemsetAsync((char*)d_ws + WS_CTL, 0, CTL_ZERO_BYTES, stream) != hipSuccess) { fprintf(stderr, "kernel_launch: memset failed\n"); return; }
    Args a{};
    for (int i = 0; i < 21; ++i) a.in[i] = (const float*)d_in[i];
    a.out = (float*)d_out; a.ws = (unsigned char*)d_ws;
#if MK_PER_PHASE
    for (int ph = 0; ph < 12; ++ph) { a.ph_lo = ph; a.ph_hi = ph + 1; a.coop = 0;
        hipLaunchKernelGGL(fwd_megakernel, dim3(grid), dim3(NTHR), LDS_BYTES, stream, a); }
#else
    a.ph_lo = 0; a.ph_hi = 12; a.coop = 1;
    void* kargs[] = {&a};
    hipError_t e = hipLaunchCooperativeKernel((const void*)fwd_megakernel, dim3(grid), dim3(NTHR), kargs, LDS_BYTES, stream);
    if (e != hipSuccess) fprintf(stderr, "cooperative launch failed: %s (grid %d)\n", hipGetErrorString(e), grid);
#endif
}
```

```cpp
#include <hip/hip_runtime.h>
#include <hip/hip_cooperative_groups.h>
#include <cstdio>
#include <cstdint>
namespace cg = cooperative_groups;
#define MK_PER_PHASE 0
namespace pg8 {
#define PG8_LAS __attribute__((address_space(3)))
typedef unsigned short bf16_t;
typedef short bf16x8 __attribute__((ext_vector_type(8)));
typedef float f32x4 __attribute__((ext_vector_type(4)));
typedef unsigned u32x4 __attribute__((ext_vector_type(4)));
constexpr int BM = 256, BK = 64, HALF = 128, HTB = HALF * BK * 2  , STAGE_BYTES = 8 * HTB, NXCD = 8, WGM = 8;

__host__ __device__ __forceinline__ int lds_byte(int r, int c) { const int st = (r >> 4) * 2 + (c >> 5), rr = r & 15, cc = c & 31, ob = rr * 64 + cc * 2; return st * 1024 + (ob ^ (((ob >> 9) & 1) << 5)); }
__host__ __device__ __forceinline__ void stage_rc(int b, int& R, int& C) { const int st = b / 1024, sb = b % 1024, swz = sb ^ (((sb >> 9) & 1) << 5); R = (st >> 1) * 16 + swz / 64; C = (st & 1) * 32 + (swz % 64) / 2; }
__host__ __device__ __forceinline__ int perm32(int rho) { const int n = rho >> 4, i = rho & 15; return 8 * (i >> 2) + 4 * n + (i & 3); }

struct Unit { int pm, pn; };
struct Gemm { const bf16_t* A; const bf16_t* Bt; int M, N, K; };

struct StaticOrder {
    int nM, nN, nwg, G, c;
    __host__ __device__ void init(int M, int N, int G_, int c_) { nM = M / BM; nN = N / BM; nwg = nM * nN; G = G_; c = c_; }
    __host__ __device__ bool next(int i, Unit& u) const {
        const long L = (long)i * G + c; if (L >= nwg) return false;
        int wgid = (int)L; { const int q = nwg / NXCD, r = nwg % NXCD, xcd = wgid % NXCD, off = wgid / NXCD; wgid = (xcd < r ? xcd * (q + 1) : r * (q + 1) + (xcd - r) * q) + off; }
        const int nig = WGM * nN, gid = wgid / nig, fm = gid * WGM, gsz = (nM - fm) < WGM ? (nM - fm) : WGM;
        u.pm = fm + ((wgid % nig) % gsz); u.pn = (wgid % nig) / gsz; return true;
    }
    __device__ __forceinline__ void a_ready(const Unit&) const {}
    __device__ __forceinline__ void done(const Unit&) const {}
};
__device__ __forceinline__ unsigned cvt_pk_bf16(float lo, float hi) { unsigned r; asm volatile("v_cvt_pk_bf16_f32 %0, %1, %2" : "=v"(r) : "v"(lo), "v"(hi)); return r; }
typedef float f32x2 __attribute__((ext_vector_type(2)));
template <class Epi, class Sched, bool ALIGN_EPI = false, bool SP2 = false>
__device__ __forceinline__ void gemm_phase(PG8_LAS unsigned char* lds, const Gemm g, const Sched& S, const Epi& E) {
    const int tid = threadIdx.x, wid = __builtin_amdgcn_readfirstlane(tid >> 6), lane = tid & 63, wr = wid >> 2, wc = wid & 3, fr = lane & 15, fq = lane >> 4;
    const int K = g.K, nt = K / BK;
    unsigned voffA[2], voffB[2];
#pragma unroll
    for (int i = 0; i < 2; ++i) { int R, C; stage_rc(tid * 16 + i * 8192, R, C); const int Rb = Epi::PERM ? ((R & ~31) + perm32(R & 31)) : R;
        voffA[i] = (unsigned)(R * K + C) * 2u; voffB[i] = (unsigned)(Rb * K + C) * 2u; }
    const size_t kstep = (size_t)(BK * 2);
    const size_t hstep = (size_t)HALF * K * 2;
    const size_t tstep = 2 * hstep;
    const unsigned ldsw = (unsigned)wid * 1024u;
    const int aoff = lds_byte(wr * 64 + fr, fq * 8), boff = lds_byte(wc * 32 + fr, fq * 8);
#define PG8_SA(b, h) (((b) * 2 + (h)) * HTB)
#define PG8_SB(b, h) ((4 + (b) * 2 + (h)) * HTB)
#define PG8_STAGE(bufoff, gbase, voff) do { _Pragma("unroll") for (int _i = 0; _i < 2; ++_i) \
        __builtin_amdgcn_global_load_lds((const unsigned*)((const char*)(gbase) + (voff)[_i]), (PG8_LAS unsigned*)(lds + (bufoff) + ldsw + _i * 8192), 16, 0, 0); } while (0)
#define PG8_LDA(dst, b, h) do { _Pragma("unroll") for (int m = 0; m < 4; ++m) _Pragma("unroll") for (int k = 0; k < 2; ++k) dst[m][k] = *(const PG8_LAS bf16x8*)(lds + PG8_SA(b, h) + aoff + m * 2048 + k * 1024); } while (0)
#define PG8_LDB(dst, b, h) do { _Pragma("unroll") for (int n = 0; n < 2; ++n) _Pragma("unroll") for (int k = 0; k < 2; ++k) dst[n][k] = *(const PG8_LAS bf16x8*)(lds + PG8_SB(b, h) + boff + n * 2048 + k * 1024); } while (0)
#define PG8_MMA(ai, bj, At, Bt) do { __builtin_amdgcn_s_setprio(1); _Pragma("unroll") for (int m = 0; m < 4; ++m) _Pragma("unroll") for (int n = 0; n < 2; ++n) _Pragma("unroll") for (int k = 0; k < 2; ++k) \
        acc[ai][bj][m][n] = __builtin_amdgcn_mfma_f32_16x16x32_bf16(Bt[n][k], At[m][k], acc[ai][bj][m][n], 0, 0, 0); __builtin_amdgcn_s_setprio(0); } while (0)
#define PG8_WAIT_V(n) asm volatile("s_waitcnt vmcnt(" #n ")" ::: "memory")
#define PG8_WAIT_L(n) asm volatile("s_waitcnt lgkmcnt(" #n ")" ::: "memory")
#define PG8_BAR __builtin_amdgcn_s_barrier()
#define PG8_SCHED __builtin_amdgcn_sched_barrier(0)
    Unit cur, nxt; int ui = 0;
    if (!S.next(0, cur)) return;
    f32x4 acc[2][2][4][2];
#pragma unroll
    for (int a = 0; a < 2; ++a)
#pragma unroll
        for (int b = 0; b < 2; ++b)
#pragma unroll
            for (int m = 0; m < 4; ++m)
#pragma unroll
                for (int n = 0; n < 2; ++n) acc[a][b][m][n] = (f32x4){0.f, 0.f, 0.f, 0.f};
    bf16x8 At[4][2], B0[2][2], B1[2][2];
    const char* cA = (const char*)g.A + (size_t)cur.pm * tstep; const char* cB = (const char*)g.Bt + (size_t)cur.pn * tstep;
    S.a_ready(cur);
    if constexpr (SP2) {
        PG8_STAGE(PG8_SB(0, 0), cB, voffB); PG8_STAGE(PG8_SB(0, 1), cB + hstep, voffB); PG8_STAGE(PG8_SA(0, 0), cA, voffA); PG8_STAGE(PG8_SA(0, 1), cA + hstep, voffA);
        if (wr == 1) PG8_BAR;
        PG8_WAIT_V(2); PG8_BAR;
        PG8_STAGE(PG8_SB(1, 0), cB + kstep, voffB); PG8_STAGE(PG8_SA(1, 0), cA + kstep, voffA); PG8_STAGE(PG8_SB(1, 1), cB + hstep + kstep, voffB);
        PG8_WAIT_V(6); PG8_BAR;
    } else {
        PG8_STAGE(PG8_SB(0, 0), cB, voffB); PG8_STAGE(PG8_SA(0, 0), cA, voffA); PG8_STAGE(PG8_SB(0, 1), cB + hstep, voffB); PG8_STAGE(PG8_SA(0, 1), cA + hstep, voffA);
        if (wr == 1) PG8_BAR;
        PG8_WAIT_V(4); PG8_BAR;
        PG8_STAGE(PG8_SB(1, 0), cB + kstep, voffB); PG8_STAGE(PG8_SA(1, 0), cA + kstep, voffA); PG8_STAGE(PG8_SB(1, 1), cB + hstep + kstep, voffB);
        PG8_WAIT_V(6); PG8_BAR;
    }
    for (;;) {
        const bool has_next = S.next(ui + 1, nxt);
        const char* nA = has_next ? (const char*)g.A + (size_t)nxt.pm * tstep : cA; const char* nB = has_next ? (const char*)g.Bt + (size_t)nxt.pn * tstep : cB;
        for (int t = 0; t < nt; t += 2) {
            const bool last = (t == nt - 2);
            const char* a1 = cA + (size_t)(t + 1) * kstep;
            const char* a2 = last ? nA : cA + (size_t)(t + 2) * kstep; const char* b2 = last ? nB : cB + (size_t)(t + 2) * kstep;
            const char* a3 = a2 + kstep; const char* b3 = b2 + kstep;
            if (last && has_next) S.a_ready(nxt);
            if constexpr (SP2) {
            PG8_LDB(B0, 0, 0); PG8_LDB(B1, 0, 1); PG8_SCHED; PG8_LDA(At, 0, 0); PG8_STAGE(PG8_SA(1, 1), a1 + hstep, voffA);
            PG8_WAIT_V(8); PG8_WAIT_L(0); PG8_BAR; PG8_MMA(0, 0, At, B0); PG8_MMA(0, 1, At, B1); PG8_BAR; PG8_SCHED;
            PG8_LDA(At, 0, 1); PG8_STAGE(PG8_SB(0, 0), b2, voffB); PG8_STAGE(PG8_SB(0, 1), b2 + hstep, voffB); PG8_STAGE(PG8_SA(0, 0), a2, voffA);
            PG8_WAIT_V(8); PG8_WAIT_L(0); PG8_BAR; PG8_MMA(1, 0, At, B0); PG8_MMA(1, 1, At, B1); PG8_BAR; PG8_SCHED;
            PG8_LDB(B0, 1, 0); PG8_LDB(B1, 1, 1); PG8_SCHED; PG8_LDA(At, 1, 0); PG8_STAGE(PG8_SA(0, 1), a2 + hstep, voffA);
            PG8_WAIT_V(8); PG8_WAIT_L(0); PG8_BAR; PG8_MMA(0, 0, At, B0); PG8_MMA(0, 1, At, B1); PG8_BAR; PG8_SCHED;
            PG8_LDA(At, 1, 1); PG8_STAGE(PG8_SB(1, 0), b3, voffB); PG8_STAGE(PG8_SB(1, 1), b3 + hstep, voffB); PG8_STAGE(PG8_SA(1, 0), a3, voffA);
            PG8_WAIT_V(8); PG8_WAIT_L(0); PG8_BAR; PG8_MMA(1, 0, At, B0); PG8_MMA(1, 1, At, B1); PG8_BAR; PG8_SCHED;
            } else {
            PG8_LDB(B0, 0, 0); PG8_SCHED; PG8_LDA(At, 0, 0); PG8_STAGE(PG8_SA(1, 1), a1 + hstep, voffA);
            PG8_WAIT_L(8); PG8_BAR; PG8_WAIT_L(0); PG8_MMA(0, 0, At, B0); PG8_BAR; PG8_SCHED;
            PG8_LDB(B1, 0, 1); PG8_STAGE(PG8_SB(0, 0), b2, voffB);
            PG8_BAR; PG8_WAIT_L(0); PG8_MMA(0, 1, At, B1); PG8_BAR;
            PG8_LDA(At, 0, 1); PG8_STAGE(PG8_SA(0, 0), a2, voffA);
            PG8_BAR; PG8_WAIT_L(0); PG8_MMA(1, 0, At, B0); PG8_BAR; PG8_SCHED;
            PG8_STAGE(PG8_SB(0, 1), b2 + hstep, voffB);
            PG8_WAIT_V(6); PG8_BAR; PG8_MMA(1, 1, At, B1); PG8_BAR;
            PG8_LDB(B0, 1, 0); PG8_SCHED; PG8_LDA(At, 1, 0); PG8_STAGE(PG8_SA(0, 1), a2 + hstep, voffA);
            PG8_WAIT_L(8); PG8_BAR; PG8_WAIT_L(0); PG8_MMA(0, 0, At, B0); PG8_BAR; PG8_SCHED;
            PG8_LDB(B1, 1, 1); PG8_STAGE(PG8_SB(1, 0), b3, voffB);
            PG8_BAR; PG8_WAIT_L(0); PG8_MMA(0, 1, At, B1); PG8_BAR;
            PG8_LDA(At, 1, 1); PG8_STAGE(PG8_SA(1, 0), a3, voffA);
            PG8_BAR; PG8_WAIT_L(0); PG8_MMA(1, 0, At, B0); PG8_BAR; PG8_SCHED;
            PG8_STAGE(PG8_SB(1, 1), b3 + hstep, voffB);
            PG8_WAIT_V(6); PG8_BAR; PG8_MMA(1, 1, At, B1); PG8_BAR;
            }
        }
        if constexpr (ALIGN_EPI) { if (wr == 0) PG8_BAR; }
        if constexpr (!Epi::AFTER_DRAIN) { E(acc, cur, wr, wc, fr, fq); S.done(cur); }
        if (!has_next) break;
#pragma unroll
        for (int a = 0; a < 2; ++a)
#pragma unroll
            for (int b = 0; b < 2; ++b)
#pragma unroll
                for (int m = 0; m < 4; ++m)
#pragma unroll
                    for (int n = 0; n < 2; ++n) acc[a][b][m][n] = (f32x4){0.f, 0.f, 0.f, 0.f};
        cur = nxt; cA = nA; cB = nB; ++ui;
        if constexpr (ALIGN_EPI) { if (wr == 1) PG8_BAR; }
    }
    PG8_WAIT_V(0);
    if constexpr (!ALIGN_EPI) { if (wr == 0) PG8_BAR; }
    PG8_BAR;
    if constexpr (Epi::AFTER_DRAIN) { E.fused(acc, cur, wr, wc, fr, fq, lds, wid, lane); S.done(cur); }
#undef PG8_SA
#undef PG8_SB
#undef PG8_STAGE
#undef PG8_LDA
#undef PG8_LDB
#undef PG8_MMA
#undef PG8_WAIT_V
#undef PG8_WAIT_L
#undef PG8_BAR
#undef PG8_SCHED
}
}

constexpr int DM = 1024, NB = 2, SEQ = 8192, CTXL = 256, MLAT = NB * SEQ, MCTX = NB * CTXL, MROWS = MLAT + MCTX;
constexpr int NIN = 2560, NCHUNK = MROWS / 64  , NPJ = 132  ;
constexpr float EPSF = 1e-6f;
constexpr int NWAVES = 8, NTHR = 512;

constexpr size_t MiB = 1u << 20;
constexpr size_t WS_CTL = 0, CTL_ZERO_BYTES = 64 * 1024;
constexpr size_t WS_MOD = 1 * MiB;
constexpr size_t WS_GWF = 1 * MiB + 256 * 1024;
constexpr size_t WS_BT1 = 2 * MiB;
constexpr size_t WS_BT2 = 12 * MiB;
constexpr size_t WS_AGGA = 16 * MiB;
constexpr size_t WS_AGGB = 16 * MiB + 1536 * 1024;
constexpr size_t WS_SSQ = 19 * MiB;
constexpr size_t WS_XC1 = 21 * MiB;
constexpr size_t WS_H = 23 * MiB;
constexpr size_t WS_Y = 56 * MiB;
constexpr size_t WS_MIXIN = 73 * MiB;
constexpr size_t WS_U = 106 * MiB;
constexpr size_t WS_MIX = 189 * MiB;
constexpr size_t WS_END = 255 * MiB;

constexpr int LDS_BYTES = 135168;

#define LAS __attribute__((address_space(3)))
typedef unsigned short bf16;
typedef unsigned v4u __attribute__((ext_vector_type(4)));
typedef unsigned v2u __attribute__((ext_vector_type(2)));
typedef float f32x4 __attribute__((ext_vector_type(4)));
typedef short bf16x8 __attribute__((ext_vector_type(8)));
#define LDS_WAIT() asm volatile("s_waitcnt lgkmcnt(0)" ::: "memory")

__device__ __forceinline__ unsigned f2bf(float f) { unsigned u = __builtin_bit_cast(unsigned, f); return (u + 0x7fffu + ((u >> 16) & 1u)) >> 16; }
__device__ __forceinline__ unsigned pk2(float lo, float hi) { return f2bf(lo) | (f2bf(hi) << 16); }
__device__ __forceinline__ float bflo(unsigned u) { return __builtin_bit_cast(float, u << 16); }
__device__ __forceinline__ float bfhi(unsigned u) { return __builtin_bit_cast(float, u & 0xffff0000u); }
__device__ __forceinline__ float sigmoidf_(float x) { return 1.0f / (1.0f + __expf(-x)); }
__device__ __forceinline__ float siluf_(float x) { return x / (1.0f + __expf(-x)); }
__device__ __forceinline__ float wave_sum(float v) {
#pragma unroll
    for (int o = 1; o < 64; o <<= 1) v += __shfl_xor(v, o);
    return v;
}

struct Args {
    const float* in[21]; float* out; unsigned char* ws; int ph_lo, ph_hi, coop, pad;
};
enum { I_X = 0, I_C, I_CTX, I_CCTX, I_WMOD, I_BMOD, I_GPRE, I_GPOST, I_WIN, I_CAW, I_CAB, I_WR, I_BR, I_WI, I_BI, I_LAM, I_DWW, I_DWB, I_LNG, I_LNB, I_WOUT };

namespace pg8 {
struct EpiU {
    static constexpr bool PERM = true, AFTER_DRAIN = false;
    bf16_t* O;
    __device__ __forceinline__ void operator()(const f32x4 (&acc)[2][2][4][2], const Unit& u, int wr, int wc, int fr, int fq) const {
        const int row0 = u.pm * BM + wr * 64 + fr, col0 = u.pn * BM + wc * 32 + 8 * fq;
        const bool act = (u.pn == 2 || u.pn == 3 || u.pn >= 8);
#pragma unroll
        for (int ai = 0; ai < 2; ++ai)
#pragma unroll
            for (int m = 0; m < 4; ++m) { bf16_t* rowp = O + (size_t)(row0 + ai * HALF + m * 16) * 2560 + col0;
#pragma unroll
                for (int bj = 0; bj < 2; ++bj) { f32x4 v0 = acc[ai][bj][m][0], v1 = acc[ai][bj][m][1];
                    if (act) {
#pragma unroll
                        for (int e = 0; e < 4; ++e) { v0[e] = v0[e] / (1.0f + __expf(-v0[e])); v1[e] = v1[e] / (1.0f + __expf(-v1[e])); }
                    }
                    u32x4 w; w.x = cvt_pk_bf16(v0[0], v0[1]); w.y = cvt_pk_bf16(v0[2], v0[3]); w.z = cvt_pk_bf16(v1[0], v1[1]); w.w = cvt_pk_bf16(v1[2], v1[3]);
                    *(u32x4*)(rowp + bj * HALF) = w; } }
    }
};
struct EpiMix {
    static constexpr bool PERM = false, AFTER_DRAIN = false;
    float* O; float* ssq;
    __device__ __forceinline__ void operator()(const f32x4 (&acc)[2][2][4][2], const Unit& u, int wr, int wc, int fr, int fq) const {
        const int col0 = u.pn * BM + wc * 32 + 4 * fq;
#pragma unroll
        for (int ai = 0; ai < 2; ++ai)
#pragma unroll
            for (int m = 0; m < 4; ++m) { const int r = u.pm * BM + ai * HALF + wr * 64 + m * 16 + fr; float* rowp = O + (size_t)r * 1024 + col0; float s = 0.f;
#pragma unroll
                for (int bj = 0; bj < 2; ++bj)
#pragma unroll
                    for (int n = 0; n < 2; ++n) { const f32x4 v = acc[ai][bj][m][n]; s += (v[0] * v[0] + v[1] * v[1]) + (v[2] * v[2] + v[3] * v[3]); *(f32x4*)(rowp + bj * HALF + n * 16) = v; }
                s += __shfl_xor(s, 16); s += __shfl_xor(s, 32);
                if (fq == 0) ssq[(size_t)r * 16 + u.pn * 4 + wc] = s; }
    }
};
}

__device__ __forceinline__ void p0_transpose_item(const float* W, int K, int N, bf16* WT, LAS float* scr, int item, int lane) {
    const int nblk = N / 32, kb = item / nblk, nb = item % nblk, k0 = 64 * kb, n0 = 32 * nb;
#pragma unroll 8
    for (int i = 0; i < 32; ++i) { const int kk = 2 * i + (lane >> 5); scr[kk * 33 + (lane & 31)] = W[(size_t)(k0 + kk) * N + n0 + (lane & 31)]; }
    LDS_WAIT(); asm volatile("" ::: "memory");
    const int c = lane & 7;
#pragma unroll
    for (int j = 0; j < 4; ++j) { const int n = (lane >> 3) + 8 * j; const LAS float* s = scr + (8 * c) * 33 + n;
        v4u o; o.x = pk2(s[0 * 33], s[1 * 33]); o.y = pk2(s[2 * 33], s[3 * 33]); o.z = pk2(s[4 * 33], s[5 * 33]); o.w = pk2(s[6 * 33], s[7 * 33]);
        *(v4u*)(WT + (size_t)(n0 + n) * K + k0 + 8 * c) = o; }
    LDS_WAIT(); asm volatile("" ::: "memory");
}

__device__ __forceinline__ void p0_prologue(const Args& a, LAS unsigned char* lds, int tid, int lane, int wave) {
    const int G = gridDim.x, bx = blockIdx.x;
    unsigned char* ws = a.ws;
    {
        LAS float* part = (LAS float*)lds;
        float* MOD = (float*)(ws + WS_MOD);
        const float* c = a.in[I_C]; const float* cctx = a.in[I_CCTX];
        for (int un = bx; un < 192; un += G) {
            const int l = un / 96, n0 = (un % 96) * 32, cq = tid & 7, ks = tid >> 3;
            const float* wm = a.in[I_WMOD] + (size_t)l * 1024 * 3072 + n0 + cq * 4;
            f32x4 acc0 = {0.f, 0.f, 0.f, 0.f}, acc1 = acc0, acc2 = acc0;
#pragma unroll 4
            for (int kk = 0; kk < 16; ++kk) { const int k = ks * 16 + kk; const f32x4 w = *(const f32x4*)(wm + (size_t)k * 3072);
                const float a0 = siluf_(c[k]), a1 = siluf_(c[1024 + k]), a2 = siluf_(cctx[k]);
                acc0 += w * a0; acc1 += w * a1; acc2 += w * a2; }
            *(LAS f32x4*)(part + (0 * 64 + ks) * 32 + cq * 4) = acc0;
            *(LAS f32x4*)(part + (1 * 64 + ks) * 32 + cq * 4) = acc1;
            *(LAS f32x4*)(part + (2 * 64 + ks) * 32 + cq * 4) = acc2;
            __syncthreads();
            if (tid < 96) { const int v = tid >> 5, col = tid & 31; float s = a.in[I_BMOD][l * 3072 + n0 + col];
                for (int k2 = 0; k2 < 64; ++k2) s += part[(v * 64 + k2) * 32 + col];
                MOD[(l * 3 + v) * 3072 + n0 + col] = s; }
            __syncthreads();
        }
    }
    {
        v4u* GWF = (v4u*)(ws + WS_GWF);
        for (int idx = bx * NTHR + tid; idx < 32768; idx += G * NTHR) {
            const int ln = idx & 63, kk = (idx >> 6) & 1, ct = (idx >> 7) & 3, h = (idx >> 9) & 7, g = (idx >> 12) & 1, d = (idx >> 13) & 1, l = idx >> 14;
            const float* W = (g == 0 ? a.in[I_WR] : a.in[I_WI]) + (size_t)(((l * 2 + d) * 8 + h) * 64) * 64;
            const int k0 = 32 * kk + 8 * (ln >> 4), col = 16 * ct + (ln & 15);
            float e[8];
#pragma unroll
            for (int j = 0; j < 8; ++j) e[j] = W[(k0 + j) * 64 + col];
            v4u o; o.x = pk2(e[0], e[1]); o.y = pk2(e[2], e[3]); o.z = pk2(e[4], e[5]); o.w = pk2(e[6], e[7]);
            GWF[idx] = o;
        }
    }
    {
        LAS float* scr = (LAS float*)(lds + wave * 16384);
        const int gw = bx * NWAVES + wave, NGW = G * NWAVES;
        constexpr int I_1 = (1024 / 64) * (NIN / 32), I_2 = (1024 / 64) * (1024 / 32), NITEMS = 2 * (I_1 + I_2);
        bf16* BT1 = (bf16*)(ws + WS_BT1); bf16* BT2 = (bf16*)(ws + WS_BT2);
        for (int it = gw; it < NITEMS; it += NGW) {
            int r = it;
            if (r < I_1) { p0_transpose_item(a.in[I_WIN], 1024, NIN, BT1, scr, r, lane); continue; } r -= I_1;
            if (r < I_1) { p0_transpose_item(a.in[I_WIN] + (size_t)1024 * NIN, 1024, NIN, BT1 + (size_t)NIN * 1024, scr, r, lane); continue; } r -= I_1;
            if (r < I_2) { p0_transpose_item(a.in[I_WOUT], 1024, 1024, BT2, scr, r, lane); continue; } r -= I_2;
            p0_transpose_item(a.in[I_WOUT] + (size_t)1024 * 1024, 1024, 1024, BT2 + (size_t)1024 * 1024, scr, r, lane);
        }
    }
}

__device__ __forceinline__ void norm_phase(const Args& a, int mode, int lane, int wave) {
    unsigned char* ws = a.ws;
    const float* MOD = (const float*)(ws + WS_MOD); const float* MIX = (const float*)(ws + WS_MIX); const float* SSQ = (const float*)(ws + WS_SSQ);
    float* XC1 = (float*)(ws + WS_XC1); bf16* H = (bf16*)(ws + WS_H);
    const int gw = blockIdx.x * NWAVES + wave, NGW = gridDim.x * NWAVES;
    const int nrows = (mode == 2) ? MLAT : MROWS, lu = (mode == 1) ? 0 : 1, ln = (mode == 0) ? 0 : 1;
    for (int row = gw; row < nrows; row += NGW) {
        const int vsel = row < MLAT ? (row >> 13) : 2;
        const float* src;
        if (mode == 2) src = a.out + (size_t)row * 1024;
        else src = row < MLAT ? a.in[I_X] + (size_t)row * 1024 : a.in[I_CTX] + (size_t)(row - MLAT) * 1024;
        f32x4 v[4];
#pragma unroll
        for (int j = 0; j < 4; ++j) v[j] = *((const f32x4*)src + lane + 64 * j);
        if (mode >= 1) {
            const float sp = lane < 16 ? SSQ[(size_t)row * 16 + lane] : 0.f;
            const float rstd = rsqrtf(wave_sum(sp) * (1.0f / 1024.0f) + EPSF);
            const float* gate = MOD + (lu * 3 + vsel) * 3072 + 2048; const float* gp = a.in[I_GPOST] + lu * 1024;
#pragma unroll
            for (int j = 0; j < 4; ++j) { const f32x4 mx = *((const f32x4*)(MIX + (size_t)row * 1024) + lane + 64 * j);
                const f32x4 gt = *((const f32x4*)gate + lane + 64 * j), gv = *((const f32x4*)gp + lane + 64 * j);
                v[j] += gt * (mx * rstd * gv); }
            float* dst = row < MLAT ? a.out + (size_t)row * 1024 : XC1 + (size_t)(row - MLAT) * 1024;
#pragma unroll
            for (int j = 0; j < 4; ++j) *((f32x4*)dst + lane + 64 * j) = v[j];
        }
        if (mode <= 1) {
            float s = 0.f;
#pragma unroll
            for (int j = 0; j < 4; ++j) s += (v[j].x * v[j].x + v[j].y * v[j].y) + (v[j].z * v[j].z + v[j].w * v[j].w);
            const float r = rsqrtf(wave_sum(s) * (1.0f / 1024.0f) + EPSF);
            const float* shift = MOD + (ln * 3 + vsel) * 3072; const float* scale = shift + 1024; const float* gpre = a.in[I_GPRE] + ln * 1024;
            v2u* o8 = (v2u*)(H + (size_t)row * 1024);
#pragma unroll
            for (int j = 0; j < 4; ++j) { const f32x4 sh = *((const f32x4*)shift + lane + 64 * j), sc = *((const f32x4*)scale + lane + 64 * j), gv = *((const f32x4*)gpre + lane + 64 * j);
                const f32x4 hv = v[j] * r * gv * (sc + 1.0f) + sh;
                v2u w; w.x = pk2(hv.x, hv.y); w.y = pk2(hv.z, hv.w); o8[lane + 64 * j] = w; }
        }
    }
}

__device__ __forceinline__ void conv16(const LAS unsigned* vt, const float (&w0)[31], const float (&w1)[31], float b0, float b1, float (&o0)[16], float (&o1)[16]) {
#pragma unroll
    for (int t = 0; t < 16; ++t) { o0[t] = b0; o1[t] = b1; }
#pragma unroll
    for (int rr = 0; rr < 46; ++rr) { const unsigned u = vt[rr * 128]; const float lo = bflo(u), hi = bfhi(u);
#pragma unroll
        for (int t = 0; t < 16; ++t) { const int k = rr - t; if (k >= 0 && k < 31) { o0[t] += w0[k] * lo; o1[t] += w1[k] * hi; } }
        if ((rr & 3) == 3) asm volatile("" ::: "memory"); }
}
__device__ __forceinline__ v4u glu8(const v4u vq, const v4u gq) {
    v4u o;
    o.x = pk2(bflo(vq.x) * sigmoidf_(bflo(gq.x)), bfhi(vq.x) * sigmoidf_(bfhi(gq.x)));
    o.y = pk2(bflo(vq.y) * sigmoidf_(bflo(gq.y)), bfhi(vq.y) * sigmoidf_(bfhi(gq.y)));
    o.z = pk2(bflo(vq.z) * sigmoidf_(bflo(gq.z)), bfhi(vq.z) * sigmoidf_(bfhi(gq.z)));
    o.w = pk2(bflo(vq.w) * sigmoidf_(bflo(gq.w)), bfhi(vq.w) * sigmoidf_(bfhi(gq.w)));
    return o;
}
__device__ __forceinline__ void hconv_unit(const Args& a, LAS unsigned char* lds, int l, int r0, int g, int vlo, int vhi, int tid) {
    const bf16* U = (const bf16*)(a.ws + WS_U); bf16* Y = (bf16*)(a.ws + WS_Y);
    LAS unsigned* VT = (LAS unsigned*)lds;
    for (int i = tid; i < 94 * 32; i += NTHR) { const int rr = i >> 5, ch = i & 31, row = r0 - 15 + rr;
        v4u o = {0u, 0u, 0u, 0u};
        if (row >= vlo && row < vhi) { const bf16* up = U + (size_t)row * NIN + g * 256 + ch * 8; o = glu8(*(const v4u*)(up + 1024), *(const v4u*)(up + 1536)); }
        *(LAS v4u*)(VT + rr * 128 + ch * 4) = o; }
    __syncthreads();
    int p = tid & 127; asm volatile("" : "+v"(p));
    const int tg = tid >> 7, c0 = g * 256 + 2 * p;
    float w0[31], w1[31];
#pragma unroll
    for (int k = 0; k < 31; ++k) { const float2 w = *(const float2*)(a.in[I_DWW] + (size_t)(l * 31 + k) * 512 + c0); w0[k] = w.x; w1[k] = w.y; }
    const float2 bb = *(const float2*)(a.in[I_DWB] + l * 512 + c0);
    float o0[16], o1[16];
    conv16(VT + (tg * 16) * 128 + p, w0, w1, bb.x, bb.y, o0, o1);
#pragma unroll
    for (int t = 0; t < 16; ++t) *(unsigned*)(Y + (size_t)(r0 + tg * 16 + t) * 512 + c0) = pk2(o0[t], o1[t]);
    __syncthreads();
}
__device__ __forceinline__ void vconv_unit(const Args& a, LAS unsigned char* lds, int l, int b, int w, int tid) {
    const bf16* U = (const bf16*)(a.ws + WS_U); bf16* Y = (bf16*)(a.ws + WS_Y);
    LAS unsigned* VT = (LAS unsigned*)lds;
    for (int i = tid; i < 158 * 32; i += NTHR) { const int rr = i >> 5, ch = i & 31, gr = rr - 15;
        v4u o = {0u, 0u, 0u, 0u};
        if (gr >= 0 && gr < 128) { const bf16* up = U + (size_t)(b * SEQ + gr * 64 + w) * NIN + 256 + ch * 8; o = glu8(*(const v4u*)(up + 1024), *(const v4u*)(up + 1536)); }
        *(LAS v4u*)(VT + rr * 128 + ch * 4) = o; }
    __syncthreads();
    int p = tid & 127; asm volatile("" : "+v"(p));
    const int tg = tid >> 7, c0 = 256 + 2 * p;
    float w0[31], w1[31];
#pragma unroll
    for (int k = 0; k < 31; ++k) { const float2 wv = *(const float2*)(a.in[I_DWW] + (size_t)(l * 31 + k) * 512 + c0); w0[k] = wv.x; w1[k] = wv.y; }
    const float2 bb = *(const float2*)(a.in[I_DWB] + l * 512 + c0);
#pragma unroll 1
    for (int half = 0; half < 2; ++half) {
        const int tb = tg * 32 + half * 16;
        float o0[16], o1[16];
        conv16(VT + tb * 128 + p, w0, w1, bb.x, bb.y, o0, o1);
#pragma unroll
        for (int t = 0; t < 16; ++t) *(unsigned*)(Y + (size_t)(b * SEQ + (tb + t) * 64 + w) * 512 + c0) = pk2(o0[t], o1[t]);
    }
    __syncthreads();
}
__device__ __forceinline__ void ln_rows(const Args& a, int l, int nrows, int lane, int wave) {
    const bf16* U = (const bf16*)(a.ws + WS_U); const bf16* Y = (const bf16*)(a.ws + WS_Y); bf16* MIXIN = (bf16*)(a.ws + WS_MIXIN);
    const int gw = blockIdx.x * NWAVES + wave, NGW = gridDim.x * NWAVES, c0 = lane * 8;
    float lg[8], lb[8];
#pragma unroll
    for (int e = 0; e < 8; ++e) { lg[e] = a.in[I_LNG][l * 512 + c0 + e]; lb[e] = a.in[I_LNB][l * 512 + c0 + e]; }
    for (int row = gw; row < nrows; row += NGW) {
        const v4u yq = *(const v4u*)(Y + (size_t)row * 512 + c0); const v4u gq = *(const v4u*)(U + (size_t)row * NIN + 2048 + c0);
        float y[8] = {bflo(yq.x), bfhi(yq.x), bflo(yq.y), bfhi(yq.y), bflo(yq.z), bfhi(yq.z), bflo(yq.w), bfhi(yq.w)};
        const float gt[8] = {bflo(gq.x), bfhi(gq.x), bflo(gq.y), bfhi(gq.y), bflo(gq.z), bfhi(gq.z), bflo(gq.w), bfhi(gq.w)};
        float s = 0.f;
#pragma unroll
        for (int e = 0; e < 8; ++e) s += y[e];
        const float mean = wave_sum(s) * (1.0f / 512.0f); float q = 0.f;
#pragma unroll
        for (int e = 0; e < 8; ++e) { y[e] -= mean; q += y[e] * y[e]; }
        const float rstd = rsqrtf(wave_sum(q) * (1.0f / 512.0f) + EPSF);
        float o[8];
#pragma unroll
        for (int e = 0; e < 8; ++e) o[e] = siluf_(y[e] * rstd * lg[e] + lb[e]) * gt[e];
        v4u w; w.x = pk2(o[0], o[1]); w.y = pk2(o[2], o[3]); w.z = pk2(o[4], o[5]); w.w = pk2(o[6], o[7]);
        *(v4u*)(MIXIN + (size_t)row * 1024 + 512 + c0) = w;
    }
}

__device__ __forceinline__ void rglru_unit(const Args& a, LAS unsigned char* lds, int l, int ck, int h, bool final_pass, int tid, int lane, int wave) {
    const bf16* U = (const bf16*)(a.ws + WS_U); bf16* MIXIN = (bf16*)(a.ws + WS_MIXIN);
    float* AGGA = (float*)(a.ws + WS_AGGA); float* AGGB = (float*)(a.ws + WS_AGGB);
    const v4u* GWF = (const v4u*)(a.ws + WS_GWF);
    const int r0 = ck * 64; int seg_lo, seg_hi, b, pjf, pjb;
    if (ck < 256) { b = ck >> 7; const int j = ck & 127; seg_lo = b * SEQ; seg_hi = seg_lo + SEQ; pjf = 4 + j; pjb = 4 + 127 - j; }
    else { const int cc = ck - 256; b = cc >> 2; const int j = cc & 3; seg_lo = MLAT + b * CTXL; seg_hi = seg_lo + CTXL; pjf = j; pjb = 3 - j; }
    LAS float* AVT = (LAS float*)lds;
    LAS float* VC = (LAS float*)(lds + 17920);
    LAS float* AS = (LAS float*)(lds + 17920 + 34816);
    LAS float* FA = (LAS float*)(lds + 17920 + 2 * 34816);
    LAS float* FB = FA + 512;
    for (int i = tid; i < 70 * 8; i += NTHR) { const int rr = i >> 3, ch = i & 7, row = r0 - 3 + rr;
        f32x4 f0 = {0.f, 0.f, 0.f, 0.f}, f1 = f0;
        if (row >= seg_lo && row < seg_hi) { const v4u q = *(const v4u*)(U + (size_t)row * NIN + 64 * h + ch * 8);
            f0 = (f32x4){bflo(q.x), bfhi(q.x), bflo(q.y), bfhi(q.y)}; f1 = (f32x4){bflo(q.z), bfhi(q.z), bflo(q.w), bfhi(q.w)}; }
        *(LAS f32x4*)(AVT + rr * 64 + ch * 8) = f0; *(LAS f32x4*)(AVT + rr * 64 + ch * 8 + 4) = f1; }
    if (final_pass) {
        const int seg = tid >> 7, dc = tid & 127, d = dc >> 6, c = dc & 63, pj = d ? pjb : pjf, lo = (pj * seg) >> 2, hi = (pj * (seg + 1)) >> 2;
        const size_t base = (size_t)((b * 2 + d) * NPJ) * 512 + 64 * h + c; float A = 1.f, Bv = 0.f;
#pragma unroll 4
        for (int i = lo; i < hi; ++i) { const float ai = AGGA[base + (size_t)i * 512], bi = AGGB[base + (size_t)i * 512]; Bv = ai * Bv + bi; A *= ai; }
        FA[seg * 128 + dc] = A; FB[seg * 128 + dc] = Bv;
    }
    __syncthreads();
    { const int d = tid >> 8, rem = tid & 255, tt = rem >> 2, cg4 = rem & 3, ro = tt + (d ? 3 : 0);
      const float* cw = a.in[I_CAW] + (size_t)((l * 2 + d) * 4) * 512 + 64 * h + cg4 * 16; const float* cb = a.in[I_CAB] + (l * 2 + d) * 512 + 64 * h + cg4 * 16;
#pragma unroll
      for (int c4 = 0; c4 < 4; ++c4) { f32x4 acc = *(const f32x4*)(cb + c4 * 4);
#pragma unroll
          for (int k = 0; k < 4; ++k) { const f32x4 w = *(const f32x4*)(cw + k * 512 + c4 * 4); const f32x4 x = *(const LAS f32x4*)(AVT + (ro + k) * 64 + cg4 * 16 + c4 * 4); acc += w * x; }
          *(LAS f32x4*)(VC + (d * 64 + tt) * 68 + cg4 * 16 + c4 * 4) = acc; } }
    __syncthreads();
    { const int d = wave >> 2, q = wave & 3, fr = lane & 15, fq = lane >> 4;
      bf16x8 af[2];
#pragma unroll
      for (int kk = 0; kk < 2; ++kk) { const LAS float* vp = VC + (d * 64 + 16 * q + fr) * 68 + 32 * kk + 8 * fq; const f32x4 x0 = *(const LAS f32x4*)vp, x1 = *(const LAS f32x4*)(vp + 4);
          v4u pk; pk.x = pk2(x0.x, x0.y); pk.y = pk2(x0.z, x0.w); pk.z = pk2(x1.x, x1.y); pk.w = pk2(x1.z, x1.w); af[kk] = __builtin_bit_cast(bf16x8, pk); }
      f32x4 accr[4], acci[4];
      const v4u* gr = GWF + (size_t)((((l * 2 + d) * 2 + 0) * 8 + h) * 8) * 64 + lane; const v4u* gi = GWF + (size_t)((((l * 2 + d) * 2 + 1) * 8 + h) * 8) * 64 + lane;
#pragma unroll
      for (int ct = 0; ct < 4; ++ct) { accr[ct] = (f32x4){0.f, 0.f, 0.f, 0.f}; acci[ct] = accr[ct];
#pragma unroll
          for (int kk = 0; kk < 2; ++kk) { const bf16x8 br = __builtin_bit_cast(bf16x8, gr[(ct * 2 + kk) * 64]), bi = __builtin_bit_cast(bf16x8, gi[(ct * 2 + kk) * 64]);
              accr[ct] = __builtin_amdgcn_mfma_f32_16x16x32_bf16(af[kk], br, accr[ct], 0, 0, 0); acci[ct] = __builtin_amdgcn_mfma_f32_16x16x32_bf16(af[kk], bi, acci[ct], 0, 0, 0); } }
#pragma unroll
      for (int ct = 0; ct < 4; ++ct) { const int c = 16 * ct + fr, pidx = (l * 2 + d) * 512 + 64 * h + c;
          const float brv = a.in[I_BR][pidx], biv = a.in[I_BI][pidx], lam = a.in[I_LAM][pidx], sp8 = -8.0f * log1pf(__expf(-lam));
#pragma unroll
          for (int jj = 0; jj < 4; ++jj) { const int tt = 16 * q + 4 * fq + jj; const int li = (d * 64 + tt) * 68 + c;
              const float r = sigmoidf_(accr[ct][jj] + brv), ig = sigmoidf_(acci[ct][jj] + biv), la = sp8 * r, aa = __expf(la);
              const float bb = sqrtf(-expm1f(2.0f * la)) * (ig * VC[li]);
              AS[li] = aa; VC[li] = bb; } } }
    __syncthreads();
    if (tid < 128) { const int d = tid >> 6, c = tid & 63; float hh = 0.f, A = 1.f;
        if (final_pass) {
#pragma unroll
            for (int s = 0; s < 4; ++s) hh = FA[s * 128 + tid] * hh + FB[s * 128 + tid];
        }
#pragma unroll 8
        for (int p = 0; p < 64; ++p) { const int tt = d ? 63 - p : p, li = (d * 64 + tt) * 68 + c; const float aa = AS[li], bb = VC[li]; hh = aa * hh + bb; A *= aa; if (final_pass) VC[li] = hh; }
        if (!final_pass) { const size_t idx = (size_t)((b * 2 + d) * NPJ + (d ? pjb : pjf)) * 512 + 64 * h + c; AGGA[idx] = A; AGGB[idx] = hh; } }
    __syncthreads();
    if (final_pass) { const int tt = tid >> 3, c0 = (tid & 7) * 8, row = r0 + tt;
        const v4u gq = *(const v4u*)(U + (size_t)row * NIN + 512 + 64 * h + c0);
        const float gt[8] = {bflo(gq.x), bfhi(gq.x), bflo(gq.y), bfhi(gq.y), bflo(gq.z), bfhi(gq.z), bflo(gq.w), bfhi(gq.w)};
        float o[8];
#pragma unroll
        for (int e = 0; e < 8; ++e) o[e] = (VC[tt * 68 + c0 + e] + VC[(64 + tt) * 68 + c0 + e]) * gt[e];
        v4u w; w.x = pk2(o[0], o[1]); w.y = pk2(o[2], o[3]); w.z = pk2(o[4], o[5]); w.w = pk2(o[6], o[7]);
        *(v4u*)(MIXIN + (size_t)row * 1024 + 64 * h + c0) = w;
        __syncthreads(); }
}

#define RLX_AGENT __ATOMIC_RELAXED, __HIP_MEMORY_SCOPE_AGENT


#define XB_TMO      128
#define XB_XCNT(j)  (256  + 64 * (j))
#define XB_XSUB(j)  (1280 + 64 * (j))
#define XB_XGEN(j)  (2304 + 64 * (j))
#define XB_TOP      3328
#define XB_TOPGEN   3392
#define XCD_BAR_WORDS 3456
#define XB_SPIN_CAP (1u << 18)

__device__ __forceinline__ unsigned xb_ld(unsigned* p)              { return __hip_atomic_load(p, __ATOMIC_RELAXED, __HIP_MEMORY_SCOPE_AGENT); }
__device__ __forceinline__ unsigned xb_add(unsigned* p, unsigned v) { return __hip_atomic_fetch_add(p, v, __ATOMIC_RELAXED, __HIP_MEMORY_SCOPE_AGENT); }
__device__ __forceinline__ unsigned xb_xcc_id() { return (unsigned)__builtin_amdgcn_s_getreg((3 << 11) | 20) & 0xFu; }
#define XB_SPIN(cond, bar) do { unsigned _sp = 0; while (cond) { __builtin_amdgcn_s_sleep(1); \
    if ((++_sp & 255u) == 0u) { if (xb_ld(&(bar)[XB_TMO])) break; if (_sp > XB_SPIN_CAP) { atomicAdd(&(bar)[XB_TMO], 1u); break; } } } } while (0)

struct XcdBarrier {
    unsigned* bar; unsigned x;
    volatile LAS unsigned* st;
};

__device__ __forceinline__ XcdBarrier xcd_barrier_post(unsigned* bar, volatile LAS unsigned* st) {
    XcdBarrier b; b.bar = bar; b.x = xb_xcc_id(); b.st = st;
    if (threadIdx.x == 0) (void)xb_add(&bar[XB_XCNT(b.x)], 1u);
    return b;
}
__device__ __forceinline__ void xcd_barrier_complete(unsigned* bar, unsigned x, unsigned& nloc, unsigned& nx) {
    const unsigned G = gridDim.x * gridDim.y * gridDim.z;
    unsigned sum, cnt, mine, sp = 0u;
    for (;;) {
        sum = 0u; cnt = 0u; mine = 0u;
#pragma unroll
        for (unsigned j = 0; j < 16; ++j) { const unsigned c = xb_ld(&bar[XB_XCNT(j)]); sum += c; cnt += (c > 0u) ? 1u : 0u; mine = (j == x) ? c : mine; }
        if (sum == G) break;
        __builtin_amdgcn_s_sleep(1);
        if ((++sp & 255u) == 0u) { if (xb_ld(&bar[XB_TMO])) break; if (sp > XB_SPIN_CAP) { atomicAdd(&bar[XB_TMO], 1u); break; } }
    }
    nloc = mine > 0u ? mine : 1u; nx = cnt > 0u ? cnt : 1u;
}

__device__ __forceinline__ void xcd_barrier(const XcdBarrier& b) {
    asm volatile("s_waitcnt vmcnt(0)" ::: "memory");
    __syncthreads();
    if (threadIdx.x == 0) {
        unsigned* bar = b.bar;
        __builtin_amdgcn_s_waitcnt(0);
        unsigned nloc = b.st[0], nx = b.st[1];
        if (nloc == 0u) { xcd_barrier_complete(bar, b.x, nloc, nx); b.st[0] = nloc; b.st[1] = nx; }
        const unsigned old = xb_add(&bar[XB_XSUB(b.x)], 1u);
        const unsigned gen = old / nloc;
        if (old + 1u == (gen + 1u) * nloc) {
            __builtin_amdgcn_fence(__ATOMIC_RELEASE, "agent");
            asm volatile("s_waitcnt vmcnt(0)" ::: "memory");
            const unsigned og = xb_add(&bar[XB_TOP], 1u);
            const unsigned tg = og / nx;
            if (og + 1u == (tg + 1u) * nx) xb_add(&bar[XB_TOPGEN], 1u);
            else XB_SPIN(xb_ld(&bar[XB_TOPGEN]) == tg, bar);
            __builtin_amdgcn_fence(__ATOMIC_ACQUIRE, "agent");
            xb_add(&bar[XB_XGEN(b.x)], 1u);
            asm volatile("s_waitcnt vmcnt(0)" ::: "memory");
        } else {
            XB_SPIN(xb_ld(&bar[XB_XGEN(b.x)]) == gen, bar);
            __builtin_amdgcn_fence(__ATOMIC_ACQUIRE, "agent");
            asm volatile("s_waitcnt vmcnt(0)" ::: "memory");
        }
    }
    __syncthreads();
}

template <int l>
__device__ __forceinline__ void layer_phases(const Args& args, LAS unsigned char* lds, const int tid, const int lane, const int wave, const int lo, const int hi, const XcdBarrier& xbar) {
    const int G = gridDim.x, bx = blockIdx.x; unsigned char* ws = args.ws;
    constexpr int pb = 1 + 5 * l;
#define IN(k) (lo <= (k) && (k) < hi)
#define SEAM(k) do { if (IN(k) && IN((k) + 1)) { xcd_barrier(xbar); } } while (0)
        if (IN(pb)) { norm_phase(args, l, lane, wave); }
        SEAM(pb);
        if (IN(pb + 1)) {
            pg8::Gemm g{(const pg8::bf16_t*)(ws + WS_H), (const pg8::bf16_t*)(ws + WS_BT1) + (size_t)l * NIN * 1024, MROWS, NIN, 1024};
            pg8::StaticOrder S; S.init(MROWS, NIN, G, bx);
            pg8::EpiU E{(pg8::bf16_t*)(ws + WS_U)};
            pg8::gemm_phase<pg8::EpiU, pg8::StaticOrder, true, true>(lds, g, S, E);
        }
        SEAM(pb + 1);
        if (IN(pb + 2)) {
            const int n_h = 256 + (l == 0 ? 16 : 0), n_conv = 128 + n_h, n_units = n_conv + NCHUNK * 8;
            for (int un = bx; un < n_units; un += G) {
                if (un < 128) { vconv_unit(args, lds, l, un >> 6, un & 63, tid); }
                else if (un < n_conv) { const int hu = un - 128;
                    if (hu < 256) hconv_unit(args, lds, l, hu * 64, 0, hu * 64, hu * 64 + 64, tid);
                    else { const int cu = hu - 256, cc = cu >> 1, g = cu & 1, bb = cc >> 2; hconv_unit(args, lds, l, MLAT + cc * 64, g, MLAT + bb * CTXL, MLAT + bb * CTXL + CTXL, tid); } }
                else { const int ru = un - n_conv; rglru_unit(args, lds, l, ru >> 3, ru & 7, false, tid, lane, wave); }
            }
        }
        SEAM(pb + 2);
        if (IN(pb + 3)) {
            const int nck = (l == 0) ? NCHUNK : 256;
            for (int un = bx; un < nck * 8; un += G) rglru_unit(args, lds, l, un >> 3, un & 7, true, tid, lane, wave);
            ln_rows(args, l, (l == 0) ? MROWS : MLAT, lane, wave);
        }
        SEAM(pb + 3);
        if (IN(pb + 4)) {
            const int M2 = (l == 0) ? MROWS : MLAT;
            pg8::Gemm g{(const pg8::bf16_t*)(ws + WS_MIXIN), (const pg8::bf16_t*)(ws + WS_BT2) + (size_t)l * 1024 * 1024, M2, 1024, 1024};
            pg8::StaticOrder S; S.init(M2, 1024, G, bx);
            pg8::EpiMix E{(float*)(ws + WS_MIX), (float*)(ws + WS_SSQ)};
            pg8::gemm_phase<pg8::EpiMix, pg8::StaticOrder, true, true>(lds, g, S, E);
        }
        SEAM(pb + 4);
#undef IN
#undef SEAM
}

__global__ void __launch_bounds__(NTHR, 2) fwd_megakernel(Args args) {
    extern __shared__ __attribute__((aligned(16))) unsigned char lds_raw[];
    LAS unsigned char* lds = (LAS unsigned char*)lds_raw;
    const int tid = threadIdx.x, lane = tid & 63, wave = __builtin_amdgcn_readfirstlane(tid >> 6);
    const int G = gridDim.x, bx = blockIdx.x;
    unsigned char* ws = args.ws;
    const int lo = args.ph_lo, hi = args.ph_hi;
    if (args.coop == 2) cg::this_grid().sync();
    volatile LAS unsigned* MISC = (volatile LAS unsigned*)(lds + 131072);
    if (tid < 64) MISC[tid] = 0u;
    __syncthreads();
    XcdBarrier xbar; xbar.bar = (unsigned*)(ws + WS_CTL); xbar.x = 0; xbar.st = nullptr;
    if (args.coop == 1) xbar = xcd_barrier_post((unsigned*)(ws + WS_CTL), MISC + 8);
#define IN(k) (lo <= (k) && (k) < hi)
#define SEAM(k) do { if (IN(k) && IN((k) + 1)) { xcd_barrier(xbar); } } while (0)

    if (IN(0)) { p0_prologue(args, lds, tid, lane, wave); }
    SEAM(0);
    layer_phases<0>(args, lds, tid, lane, wave, lo, hi, xbar);
    layer_phases<1>(args, lds, tid, lane, wave, lo, hi, xbar);
    if (IN(11)) { norm_phase(args, 2, lane, wave); }
#undef IN
#undef SEAM
}

#ifndef MK_PER_PHASE
#define MK_PER_PHASE 0
#endif
extern "C" void kernel_launch(void* const* d_in, const int* in_sizes, int n_in, void* d_out, int out_size, void* d_ws, size_t ws_size, hipStream_t stream) {
    static int grid = 0;
    if (grid == 0) {
        if (n_in != 21 || out_size != MLAT * DM || ws_size < WS_END) { fprintf(stderr, "kernel_launch: unexpected shapes (n_in %d, out %d, ws %zu)\n", n_in, out_size, ws_size); grid = -1; return; }
        int dev = 0, cus = 0, per_cu = 0;
        if (hipGetDevice(&dev) != hipSuccess || hipDeviceGetAttribute(&cus, hipDeviceAttributeMultiprocessorCount, dev) != hipSuccess) { grid = -1; return; }
        if (hipFuncSetAttribute((const void*)fwd_megakernel, hipFuncAttributeMaxDynamicSharedMemorySize, LDS_BYTES) != hipSuccess) { fprintf(stderr, "kernel_launch: hipFuncSetAttribute failed\n"); grid = -1; return; }
        if (hipOccupancyMaxActiveBlocksPerMultiprocessor(&per_cu, (const void*)fwd_megakernel, NTHR, LDS_BYTES) != hipSuccess || per_cu < 1) { fprintf(stderr, "kernel_launch: occupancy query says %d\n", per_cu); per_cu = 1; }
        (void)hipGetLastError();
        grid = cus;
    }
    if (grid < 0) return;
    if (hipMemsetAsync((char*)d_ws + WS_CTL, 0, CTL_ZERO_BYTES, stream) != hipSuccess) { fprintf(stderr, "kernel_launch: memset failed\n"); return; }
    Args a{};
    for (int i = 0; i < 21; ++i) a.in[i] = (const float*)d_in[i];
    a.out = (float*)d_out; a.ws = (unsigned char*)d_ws;
#if MK_PER_PHASE
    for (int ph = 0; ph < 12; ++ph) { a.ph_lo = ph; a.ph_hi = ph + 1; a.coop = 0;
        hipLaunchKernelGGL(fwd_megakernel, dim3(grid), dim3(NTHR), LDS_BYTES, stream, a); }
#else
    a.ph_lo = 0; a.ph_hi = 12; a.coop = 1;
    void* kargs[] = {&a};
    hipError_t e = hipLaunchCooperativeKernel((const void*)fwd_megakernel, dim3(grid), dim3(NTHR), kargs, LDS_BYTES, stream);
    if (e != hipSuccess) fprintf(stderr, "cooperative launch failed: %s (grid %d)\n", hipGetErrorString(e), grid);
#endif
}
```

```cpp
#include <hip/hip_runtime.h>
#include <hip/hip_cooperative_groups.h>
#include <cstdio>
#include <cstdint>
namespace cg = cooperative_groups;
#define MK_PER_PHASE 0
namespace pg8 {
#define PG8_LAS __attribute__((address_space(3)))
typedef unsigned short bf16_t;
typedef short bf16x8 __attribute__((ext_vector_type(8)));
typedef float f32x4 __attribute__((ext_vector_type(4)));
typedef unsigned u32x4 __attribute__((ext_vector_type(4)));
constexpr int BM = 256, BK = 64, HALF = 128, HTB = HALF * BK * 2  , STAGE_BYTES = 8 * HTB, NXCD = 8, WGM = 8;

__host__ __device__ __forceinline__ int lds_byte(int r, int c) { const int st = (r >> 4) * 2 + (c >> 5), rr = r & 15, cc = c & 31, ob = rr * 64 + cc * 2; return st * 1024 + (ob ^ (((ob >> 9) & 1) << 5)); }
__host__ __device__ __forceinline__ void stage_rc(int b, int& R, int& C) { const int st = b / 1024, sb = b % 1024, swz = sb ^ (((sb >> 9) & 1) << 5); R = (st >> 1) * 16 + swz / 64; C = (st & 1) * 32 + (swz % 64) / 2; }
__host__ __device__ __forceinline__ int perm32(int rho) { const int n = rho >> 4, i = rho & 15; return 8 * (i >> 2) + 4 * n + (i & 3); }

struct Unit { int pm, pn; };
struct Gemm { const bf16_t* A; const bf16_t* Bt; int M, N, K; };

struct StaticOrder {
    int nM, nN, nwg, G, c;
    __host__ __device__ void init(int M, int N, int G_, int c_) { nM = M / BM; nN = N / BM; nwg = nM * nN; G = G_; c = c_; }
    __host__ __device__ bool next(int i, Unit& u) const {
        const long L = (long)i * G + c; if (L >= nwg) return false;
        int wgid = (int)L; { const int q = nwg / NXCD, r = nwg % NXCD, xcd = wgid % NXCD, off = wgid / NXCD; wgid = (xcd < r ? xcd * (q + 1) : r * (q + 1) + (xcd - r) * q) + off; }
        const int nig = WGM * nN, gid = wgid / nig, fm = gid * WGM, gsz = (nM - fm) < WGM ? (nM - fm) : WGM;
        u.pm = fm + ((wgid % nig) % gsz); u.pn = (wgid % nig) / gsz; return true;
    }
    __device__ __forceinline__ void a_ready(const Unit&) const {}
    __device__ __forceinline__ void done(const Unit&) const {}
};
__device__ __forceinline__ unsigned cvt_pk_bf16(float lo, float hi) { unsigned r; asm volatile("v_cvt_pk_bf16_f32 %0, %1, %2" : "=v"(r) : "v"(lo), "v"(hi)); return r; }
typedef float f32x2 __attribute__((ext_vector_type(2)));
template <class Epi, class Sched, bool ALIGN_EPI = false, bool SP2 = false>
__device__ __forceinline__ void gemm_phase(PG8_LAS unsigned char* lds, const Gemm g, const Sched& S, const Epi& E) {
    const int tid = threadIdx.x, wid = __builtin_amdgcn_readfirstlane(tid >> 6), lane = tid & 63, wr = wid >> 2, wc = wid & 3, fr = lane & 15, fq = lane >> 4;
    const int K = g.K, nt = K / BK;
    unsigned voffA[2], voffB[2];
#pragma unroll
    for (int i = 0; i < 2; ++i) { int R, C; stage_rc(tid * 16 + i * 8192, R, C); const int Rb = Epi::PERM ? ((R & ~31) + perm32(R & 31)) : R;
        voffA[i] = (unsigned)(R * K + C) * 2u; voffB[i] = (unsigned)(Rb * K + C) * 2u; }
    const size_t kstep = (size_t)(BK * 2);
    const size_t hstep = (size_t)HALF * K * 2;
    const size_t tstep = 2 * hstep;
    const unsigned ldsw = (unsigned)wid * 1024u;
    const int aoff = lds_byte(wr * 64 + fr, fq * 8), boff = lds_byte(wc * 32 + fr, fq * 8);
#define PG8_SA(b, h) (((b) * 2 + (h)) * HTB)
#define PG8_SB(b, h) ((4 + (b) * 2 + (h)) * HTB)
#define PG8_STAGE(bufoff, gbase, voff) do { _Pragma("unroll") for (int _i = 0; _i < 2; ++_i) \
        __builtin_amdgcn_global_load_lds((const unsigned*)((const char*)(gbase) + (voff)[_i]), (PG8_LAS unsigned*)(lds + (bufoff) + ldsw + _i * 8192), 16, 0, 0); } while (0)
#define PG8_LDA(dst, b, h) do { _Pragma("unroll") for (int m = 0; m < 4; ++m) _Pragma("unroll") for (int k = 0; k < 2; ++k) dst[m][k] = *(const PG8_LAS bf16x8*)(lds + PG8_SA(b, h) + aoff + m * 2048 + k * 1024); } while (0)
#define PG8_LDB(dst, b, h) do { _Pragma("unroll") for (int n = 0; n < 2; ++n) _Pragma("unroll") for (int k = 0; k < 2; ++k) dst[n][k] = *(const PG8_LAS bf16x8*)(lds + PG8_SB(b, h) + boff + n * 2048 + k * 1024); } while (0)
#define PG8_MMA(ai, bj, At, Bt) do { __builtin_amdgcn_s_setprio(1); _Pragma("unroll") for (int m = 0; m < 4; ++m) _Pragma("unroll") for (int n = 0; n < 2; ++n) _Pragma("unroll") for (int k = 0; k < 2; ++k) \
        acc[ai][bj][m][n] = __builtin_amdgcn_mfma_f32_16x16x32_bf16(Bt[n][k], At[m][k], acc[ai][bj][m][n], 0, 0, 0); __builtin_amdgcn_s_setprio(0); } while (0)
#define PG8_WAIT_V(n) asm volatile("s_waitcnt vmcnt(" #n ")" ::: "memory")
#define PG8_WAIT_L(n) asm volatile("s_waitcnt lgkmcnt(" #n ")" ::: "memory")
#define PG8_BAR __builtin_amdgcn_s_barrier()
#define PG8_SCHED __builtin_amdgcn_sched_barrier(0)
    Unit cur, nxt; int ui = 0;
    if (!S.next(0, cur)) return;
    f32x4 acc[2][2][4][2];
#pragma unroll
    for (int a = 0; a < 2; ++a)
#pragma unroll
        for (int b = 0; b < 2; ++b)
#pragma unroll
            for (int m = 0; m < 4; ++m)
#pragma unroll
                for (int n = 0; n < 2; ++n) acc[a][b][m][n] = (f32x4){0.f, 0.f, 0.f, 0.f};
    bf16x8 At[4][2], B0[2][2], B1[2][2];
    const char* cA = (const char*)g.A + (size_t)cur.pm * tstep; const char* cB = (const char*)g.Bt + (size_t)cur.pn * tstep;
    S.a_ready(cur);
    if constexpr (SP2) {
        PG8_STAGE(PG8_SB(0, 0), cB, voffB); PG8_STAGE(PG8_SB(0, 1), cB + hstep, voffB); PG8_STAGE(PG8_SA(0, 0), cA, voffA); PG8_STAGE(PG8_SA(0, 1), cA + hstep, voffA);
        if (wr == 1) PG8_BAR;
        PG8_WAIT_V(2); PG8_BAR;
        PG8_STAGE(PG8_SB(1, 0), cB + kstep, voffB); PG8_STAGE(PG8_SA(1, 0), cA + kstep, voffA); PG8_STAGE(PG8_SB(1, 1), cB + hstep + kstep, voffB);
        PG8_WAIT_V(6); PG8_BAR;
    } else {
        PG8_STAGE(PG8_SB(0, 0), cB, voffB); PG8_STAGE(PG8_SA(0, 0), cA, voffA); PG8_STAGE(PG8_SB(0, 1), cB + hstep, voffB); PG8_STAGE(PG8_SA(0, 1), cA + hstep, voffA);
        if (wr == 1) PG8_BAR;
        PG8_WAIT_V(4); PG8_BAR;
        PG8_STAGE(PG8_SB(1, 0), cB + kstep, voffB); PG8_STAGE(PG8_SA(1, 0), cA + kstep, voffA); PG8_STAGE(PG8_SB(1, 1), cB + hstep + kstep, voffB);
        PG8_WAIT_V(6); PG8_BAR;
    }
    for (;;) {
        const bool has_next = S.next(ui + 1, nxt);
        const char* nA = has_next ? (const char*)g.A + (size_t)nxt.pm * tstep : cA; const char* nB = has_next ? (const char*)g.Bt + (size_t)nxt.pn * tstep : cB;
        for (int t = 0; t < nt; t += 2) {
            const bool last = (t == nt - 2);
            const char* a1 = cA + (size_t)(t + 1) * kstep;
            const char* a2 = last ? nA : cA + (size_t)(t + 2) * kstep; const char* b2 = last ? nB : cB + (size_t)(t + 2) * kstep;
            const char* a3 = a2 + kstep; const char* b3 = b2 + kstep;
            if (last && has_next) S.a_ready(nxt);
            if constexpr (SP2) {
            PG8_LDB(B0, 0, 0); PG8_LDB(B1, 0, 1); PG8_SCHED; PG8_LDA(At, 0, 0); PG8_STAGE(PG8_SA(1, 1), a1 + hstep, voffA);
            PG8_WAIT_V(8); PG8_WAIT_L(0); PG8_BAR; PG8_MMA(0, 0, At, B0); PG8_MMA(0, 1, At, B1); PG8_BAR; PG8_SCHED;
            PG8_LDA(At, 0, 1); PG8_STAGE(PG8_SB(0, 0), b2, voffB); PG8_STAGE(PG8_SB(0, 1), b2 + hstep, voffB); PG8_STAGE(PG8_SA(0, 0), a2, voffA);
            PG8_WAIT_V(8); PG8_WAIT_L(0); PG8_BAR; PG8_MMA(1, 0, At, B0); PG8_MMA(1, 1, At, B1); PG8_BAR; PG8_SCHED;
            PG8_LDB(B0, 1, 0); PG8_LDB(B1, 1, 1); PG8_SCHED; PG8_LDA(At, 1, 0); PG8_STAGE(PG8_SA(0, 1), a2 + hstep, voffA);
            PG8_WAIT_V(8); PG8_WAIT_L(0); PG8_BAR; PG8_MMA(0, 0, At, B0); PG8_MMA(0, 1, At, B1); PG8_BAR; PG8_SCHED;
            PG8_LDA(At, 1, 1); PG8_STAGE(PG8_SB(1, 0), b3, voffB); PG8_STAGE(PG8_SB(1, 1), b3 + hstep, voffB); PG8_STAGE(PG8_SA(1, 0), a3, voffA);
            PG8_WAIT_V(8); PG8_WAIT_L(0); PG8_BAR; PG8_MMA(1, 0, At, B0); PG8_MMA(1, 1, At, B1); PG8_BAR; PG8_SCHED;
            } else {
            PG8_LDB(B0, 0, 0); PG8_SCHED; PG8_LDA(At, 0, 0); PG8_STAGE(PG8_SA(1, 1), a1 + hstep, voffA);
            PG8_WAIT_L(8); PG8_BAR; PG8_WAIT_L(0); PG8_MMA(0, 0, At, B0); PG8_BAR; PG8_SCHED;
            PG8_LDB(B1, 0, 1); PG8_STAGE(PG8_SB(0, 0), b2, voffB);
            PG8_BAR; PG8_WAIT_L(0); PG8_MMA(0, 1, At, B1); PG8_BAR;
            PG8_LDA(At, 0, 1); PG8_STAGE(PG8_SA(0, 0), a2, voffA);
            PG8_BAR; PG8_WAIT_L(0); PG8_MMA(1, 0, At, B0); PG8_BAR; PG8_SCHED;
            PG8_STAGE(PG8_SB(0, 1), b2 + hstep, voffB);
            PG8_WAIT_V(6); PG8_BAR; PG8_MMA(1, 1, At, B1); PG8_BAR;
            PG8_LDB(B0, 1, 0); PG8_SCHED; PG8_LDA(At, 1, 0); PG8_STAGE(PG8_SA(0, 1), a2 + hstep, voffA);
            PG8_WAIT_L(8); PG8_BAR; PG8_WAIT_L(0); PG8_MMA(0, 0, At, B0); PG8_BAR; PG8_SCHED;
            PG8_LDB(B1, 1, 1); PG8_STAGE(PG8_SB(1, 0), b3, voffB);
            PG8_BAR; PG8_WAIT_L(0); PG8_MMA(0, 1, At, B1); PG8_BAR;
            PG8_LDA(At, 1, 1); PG8_STAGE(PG8_SA(1, 0), a3, voffA);
            PG8_BAR; PG8_WAIT_L(0); PG8_MMA(1, 0, At, B0); PG8_BAR; PG8_SCHED;
            PG8_STAGE(PG8_SB(1, 1), b3 + hstep, voffB);
            PG8_WAIT_V(6); PG8_BAR; PG8_MMA(1, 1, At, B1); PG8_BAR;
            }
        }
        if constexpr (ALIGN_EPI) { if (wr == 0) PG8_BAR; }
        if constexpr (!Epi::AFTER_DRAIN) { E(acc, cur, wr, wc, fr, fq); S.done(cur); }
        if (!has_next) break;
#pragma unroll
        for (int a = 0; a < 2; ++a)
#pragma unroll
            for (int b = 0; b < 2; ++b)
#pragma unroll
                for (int m = 0; m < 4; ++m)
#pragma unroll
                    for (int n = 0; n < 2; ++n) acc[a][b][m][n] = (f32x4){0.f, 0.f, 0.f, 0.f};
        cur = nxt; cA = nA; cB = nB; ++ui;
        if constexpr (ALIGN_EPI) { if (wr == 1) PG8_BAR; }
    }
    PG8_WAIT_V(0);
    if constexpr (!ALIGN_EPI) { if (wr == 0) PG8_BAR; }
    PG8_BAR;
    if constexpr (Epi::AFTER_DRAIN) { E.fused(acc, cur, wr, wc, fr, fq, lds, wid, lane); S.done(cur); }
#undef PG8_SA
#undef PG8_SB
#undef PG8_STAGE
#undef PG8_LDA
#undef PG8_LDB
#undef PG8_MMA
#undef PG8_WAIT_V
#undef PG8_WAIT_L
#undef PG8_BAR
#undef PG8_SCHED
}
}

constexpr int DM = 1024, NB = 2, SEQ = 8192, CTXL = 256, MLAT = NB * SEQ, MCTX = NB * CTXL, MROWS = MLAT + MCTX;
constexpr int NIN = 2560, NCHUNK = MROWS / 64  , NPJ = 132  ;
constexpr float EPSF = 1e-6f;
constexpr int NWAVES = 8, NTHR = 512;

constexpr size_t MiB = 1u << 20;
constexpr size_t WS_CTL = 0, CTL_ZERO_BYTES = 64 * 1024;
constexpr size_t WS_MOD = 1 * MiB;
constexpr size_t WS_GWF = 1 * MiB + 256 * 1024;
constexpr size_t WS_BT1 = 2 * MiB;
constexpr size_t WS_BT2 = 12 * MiB;
constexpr size_t WS_AGGA = 16 * MiB;
constexpr size_t WS_AGGB = 16 * MiB + 1536 * 1024;
constexpr size_t WS_SSQ = 19 * MiB;
constexpr size_t WS_XC1 = 21 * MiB;
constexpr size_t WS_A16 = 23 * MiB;
constexpr size_t WS_B16 = 28 * MiB;
constexpr size_t WS_H = 73 * MiB;
constexpr size_t WS_Y = 56 * MiB;
constexpr size_t WS_MIXIN = 73 * MiB;
constexpr size_t WS_U = 106 * MiB;
constexpr size_t WS_MIX = 189 * MiB;
constexpr size_t WS_END = 255 * MiB;

constexpr int LDS_BYTES = 158720;
constexpr int MISC_OFF = 157696;

#define LAS __attribute__((address_space(3)))
typedef unsigned short bf16;
typedef unsigned v4u __attribute__((ext_vector_type(4)));
typedef unsigned v2u __attribute__((ext_vector_type(2)));
typedef float f32x4 __attribute__((ext_vector_type(4)));
typedef short bf16x8 __attribute__((ext_vector_type(8)));
typedef float f32x2v __attribute__((ext_vector_type(2)));
#define LDS_WAIT() asm volatile("s_waitcnt lgkmcnt(0)" ::: "memory")

__device__ __forceinline__ unsigned f2bf(float f) { unsigned u = __builtin_bit_cast(unsigned, f); return (u + 0x7fffu + ((u >> 16) & 1u)) >> 16; }
__device__ __forceinline__ unsigned pk2(float lo, float hi) { return f2bf(lo) | (f2bf(hi) << 16); }
__device__ __forceinline__ unsigned cvtpk(float lo, float hi) { unsigned r; asm volatile("v_cvt_pk_bf16_f32 %0, %1, %2" : "=v"(r) : "v"(lo), "v"(hi)); return r; }
__device__ __forceinline__ float bflo(unsigned u) { return __builtin_bit_cast(float, u << 16); }
__device__ __forceinline__ float bfhi(unsigned u) { return __builtin_bit_cast(float, u & 0xffff0000u); }
__device__ __forceinline__ float sigmoidf_(float x) { return 1.0f / (1.0f + __expf(-x)); }
__device__ __forceinline__ float siluf_(float x) { return x / (1.0f + __expf(-x)); }
__device__ __forceinline__ float wave_sum(float v) {
#pragma unroll
    for (int o = 1; o < 64; o <<= 1) v += __shfl_xor(v, o);
    return v;
}

struct Args {
    const float* in[21]; float* out; unsigned char* ws; int ph_lo, ph_hi, coop, pad;
};
enum { I_X = 0, I_C, I_CTX, I_CCTX, I_WMOD, I_BMOD, I_GPRE, I_GPOST, I_WIN, I_CAW, I_CAB, I_WR, I_BR, I_WI, I_BI, I_LAM, I_DWW, I_DWB, I_LNG, I_LNB, I_WOUT };

namespace pg8 {
struct EpiU {
    static constexpr bool PERM = true, AFTER_DRAIN = false;
    bf16_t* O;
    __device__ __forceinline__ void operator()(const f32x4 (&acc)[2][2][4][2], const Unit& u, int wr, int wc, int fr, int fq) const {
        const int row0 = u.pm * BM + wr * 64 + fr, col0 = u.pn * BM + wc * 32 + 8 * fq;
        const bool act = (u.pn == 2 || u.pn == 3 || u.pn >= 8);
#pragma unroll
        for (int ai = 0; ai < 2; ++ai)
#pragma unroll
            for (int m = 0; m < 4; ++m) { bf16_t* rowp = O + (size_t)(row0 + ai * HALF + m * 16) * 2560 + col0;
#pragma unroll
                for (int bj = 0; bj < 2; ++bj) { f32x4 v0 = acc[ai][bj][m][0], v1 = acc[ai][bj][m][1];
                    if (act) {
#pragma unroll
                        for (int e = 0; e < 4; ++e) { v0[e] = v0[e] / (1.0f + __expf(-v0[e])); v1[e] = v1[e] / (1.0f + __expf(-v1[e])); }
                    }
                    u32x4 w; w.x = cvt_pk_bf16(v0[0], v0[1]); w.y = cvt_pk_bf16(v0[2], v0[3]); w.z = cvt_pk_bf16(v1[0], v1[1]); w.w = cvt_pk_bf16(v1[2], v1[3]);
                    *(u32x4*)(rowp + bj * HALF) = w; } }
    }
};
struct EpiMix {
    static constexpr bool PERM = false, AFTER_DRAIN = false;
    float* O; float* ssq;
    __device__ __forceinline__ void operator()(const f32x4 (&acc)[2][2][4][2], const Unit& u, int wr, int wc, int fr, int fq) const {
        const int col0 = u.pn * BM + wc * 32 + 4 * fq;
#pragma unroll
        for (int ai = 0; ai < 2; ++ai)
#pragma unroll
            for (int m = 0; m < 4; ++m) { const int r = u.pm * BM + ai * HALF + wr * 64 + m * 16 + fr; float* rowp = O + (size_t)r * 1024 + col0; float s = 0.f;
#pragma unroll
                for (int bj = 0; bj < 2; ++bj)
#pragma unroll
                    for (int n = 0; n < 2; ++n) { const f32x4 v = acc[ai][bj][m][n]; s += (v[0] * v[0] + v[1] * v[1]) + (v[2] * v[2] + v[3] * v[3]); *(f32x4*)(rowp + bj * HALF + n * 16) = v; }
                s += __shfl_xor(s, 16); s += __shfl_xor(s, 32);
                if (fq == 0) ssq[(size_t)r * 16 + u.pn * 4 + wc] = s; }
    }
};
}

__device__ __forceinline__ void p0_transpose_item(const float* W, int K, int N, bf16* WT, LAS float* scr, int item, int lane) {
    const int nblk = N / 32, kb = item / nblk, nb = item % nblk, k0 = 64 * kb, n0 = 32 * nb;
#pragma unroll 8
    for (int i = 0; i < 32; ++i) { const int kk = 2 * i + (lane >> 5); scr[kk * 33 + (lane & 31)] = W[(size_t)(k0 + kk) * N + n0 + (lane & 31)]; }
    LDS_WAIT(); asm volatile("" ::: "memory");
    const int c = lane & 7;
#pragma unroll
    for (int j = 0; j < 4; ++j) { const int n = (lane >> 3) + 8 * j; const LAS float* s = scr + (8 * c) * 33 + n;
        v4u o; o.x = pk2(s[0 * 33], s[1 * 33]); o.y = pk2(s[2 * 33], s[3 * 33]); o.z = pk2(s[4 * 33], s[5 * 33]); o.w = pk2(s[6 * 33], s[7 * 33]);
        *(v4u*)(WT + (size_t)(n0 + n) * K + k0 + 8 * c) = o; }
    LDS_WAIT(); asm volatile("" ::: "memory");
}

__device__ __forceinline__ void p0_prologue(const Args& a, LAS unsigned char* lds, int tid, int lane, int wave) {
    const int G = gridDim.x, bx = blockIdx.x;
    unsigned char* ws = a.ws;
    {
        LAS float* part = (LAS float*)lds;
        float* MOD = (float*)(ws + WS_MOD);
        const float* c = a.in[I_C]; const float* cctx = a.in[I_CCTX];
        for (int un = bx; un < 192; un += G) {
            const int l = un / 96, n0 = (un % 96) * 32, cq = tid & 7, ks = tid >> 3;
            const float* wm = a.in[I_WMOD] + (size_t)l * 1024 * 3072 + n0 + cq * 4;
            f32x4 acc0 = {0.f, 0.f, 0.f, 0.f}, acc1 = acc0, acc2 = acc0;
#pragma unroll 4
            for (int kk = 0; kk < 16; ++kk) { const int k = ks * 16 + kk; const f32x4 w = *(const f32x4*)(wm + (size_t)k * 3072);
                const float a0 = siluf_(c[k]), a1 = siluf_(c[1024 + k]), a2 = siluf_(cctx[k]);
                acc0 += w * a0; acc1 += w * a1; acc2 += w * a2; }
            *(LAS f32x4*)(part + (0 * 64 + ks) * 32 + cq * 4) = acc0;
            *(LAS f32x4*)(part + (1 * 64 + ks) * 32 + cq * 4) = acc1;
            *(LAS f32x4*)(part + (2 * 64 + ks) * 32 + cq * 4) = acc2;
            __syncthreads();
            if (tid < 96) { const int v = tid >> 5, col = tid & 31; float s = a.in[I_BMOD][l * 3072 + n0 + col];
                for (int k2 = 0; k2 < 64; ++k2) s += part[(v * 64 + k2) * 32 + col];
                MOD[(l * 3 + v) * 3072 + n0 + col] = s; }
            __syncthreads();
        }
    }
    {
        v4u* GWF = (v4u*)(ws + WS_GWF);
        for (int idx = bx * NTHR + tid; idx < 32768; idx += G * NTHR) {
            const int ln = idx & 63, kk = (idx >> 6) & 1, ct = (idx >> 7) & 3, h = (idx >> 9) & 7, g = (idx >> 12) & 1, d = (idx >> 13) & 1, l = idx >> 14;
            const float* W = (g == 0 ? a.in[I_WR] : a.in[I_WI]) + (size_t)(((l * 2 + d) * 8 + h) * 64) * 64;
            const int k0 = 32 * kk + 8 * (ln >> 4), col = 16 * ct + (ln & 15);
            float e[8];
#pragma unroll
            for (int j = 0; j < 8; ++j) e[j] = W[(k0 + j) * 64 + col];
            v4u o; o.x = pk2(e[0], e[1]); o.y = pk2(e[2], e[3]); o.z = pk2(e[4], e[5]); o.w = pk2(e[6], e[7]);
            GWF[idx] = o;
        }
    }
    {
        LAS float* scr = (LAS float*)(lds + wave * 16384);
        const int gw = bx * NWAVES + wave, NGW = G * NWAVES;
        constexpr int I_1 = (1024 / 64) * (NIN / 32), I_2 = (1024 / 64) * (1024 / 32), NITEMS = 2 * (I_1 + I_2);
        bf16* BT1 = (bf16*)(ws + WS_BT1); bf16* BT2 = (bf16*)(ws + WS_BT2);
        for (int it = gw; it < NITEMS; it += NGW) {
            int r = it;
            if (r < I_1) { p0_transpose_item(a.in[I_WIN], 1024, NIN, BT1, scr, r, lane); continue; } r -= I_1;
            if (r < I_1) { p0_transpose_item(a.in[I_WIN] + (size_t)1024 * NIN, 1024, NIN, BT1 + (size_t)NIN * 1024, scr, r, lane); continue; } r -= I_1;
            if (r < I_2) { p0_transpose_item(a.in[I_WOUT], 1024, 1024, BT2, scr, r, lane); continue; } r -= I_2;
            p0_transpose_item(a.in[I_WOUT] + (size_t)1024 * 1024, 1024, 1024, BT2 + (size_t)1024 * 1024, scr, r, lane);
        }
    }
}

__device__ __forceinline__ void norm_phase(const Args& a, int mode, int lane, int wave) {
    unsigned char* ws = a.ws;
    const float* MOD = (const float*)(ws + WS_MOD); const float* MIX = (const float*)(ws + WS_MIX); const float* SSQ = (const float*)(ws + WS_SSQ);
    float* XC1 = (float*)(ws + WS_XC1); bf16* H = (bf16*)(ws + WS_H);
    const int gw = blockIdx.x * NWAVES + wave, NGW = gridDim.x * NWAVES;
    const int nrows = (mode == 2) ? MLAT : MROWS, lu = (mode == 1) ? 0 : 1, ln = (mode == 0) ? 0 : 1;
    for (int row = gw; row < nrows; row += NGW) {
        const int vsel = row < MLAT ? (row >> 13) : 2;
        const float* src;
        if (mode == 2) src = a.out + (size_t)row * 1024;
        else src = row < MLAT ? a.in[I_X] + (size_t)row * 1024 : a.in[I_CTX] + (size_t)(row - MLAT) * 1024;
        f32x4 v[4];
#pragma unroll
        for (int j = 0; j < 4; ++j) v[j] = *((const f32x4*)src + lane + 64 * j);
        if (mode >= 1) {
            const float sp = lane < 16 ? SSQ[(size_t)row * 16 + lane] : 0.f;
            const float rstd = rsqrtf(wave_sum(sp) * (1.0f / 1024.0f) + EPSF);
            const float* gate = MOD + (lu * 3 + vsel) * 3072 + 2048; const float* gp = a.in[I_GPOST] + lu * 1024;
#pragma unroll
            for (int j = 0; j < 4; ++j) { const f32x4 mx = *((const f32x4*)(MIX + (size_t)row * 1024) + lane + 64 * j);
                const f32x4 gt = *((const f32x4*)gate + lane + 64 * j), gv = *((const f32x4*)gp + lane + 64 * j);
                v[j] += gt * (mx * rstd * gv); }
            float* dst = row < MLAT ? a.out + (size_t)row * 1024 : XC1 + (size_t)(row - MLAT) * 1024;
#pragma unroll
            for (int j = 0; j < 4; ++j) *((f32x4*)dst + lane + 64 * j) = v[j];
        }
        if (mode <= 1) {
            float s = 0.f;
#pragma unroll
            for (int j = 0; j < 4; ++j) s += (v[j].x * v[j].x + v[j].y * v[j].y) + (v[j].z * v[j].z + v[j].w * v[j].w);
            const float r = rsqrtf(wave_sum(s) * (1.0f / 1024.0f) + EPSF);
            const float* shift = MOD + (ln * 3 + vsel) * 3072; const float* scale = shift + 1024; const float* gpre = a.in[I_GPRE] + ln * 1024;
            v2u* o8 = (v2u*)(H + (size_t)row * 1024);
#pragma unroll
            for (int j = 0; j < 4; ++j) { const f32x4 sh = *((const f32x4*)shift + lane + 64 * j), sc = *((const f32x4*)scale + lane + 64 * j), gv = *((const f32x4*)gpre + lane + 64 * j);
                const f32x4 hv = v[j] * r * gv * (sc + 1.0f) + sh;
                v2u w; w.x = pk2(hv.x, hv.y); w.y = pk2(hv.z, hv.w); o8[lane + 64 * j] = w; }
        }
    }
}

__device__ __forceinline__ void conv16(const LAS unsigned* vt, const float (&w0)[31], const float (&w1)[31], float b0, float b1, float (&o0)[16], float (&o1)[16]) {
#pragma unroll
    for (int t = 0; t < 16; ++t) { o0[t] = b0; o1[t] = b1; }
#pragma unroll
    for (int rr = 0; rr < 46; ++rr) { const unsigned u = vt[rr * 128]; const float lo = bflo(u), hi = bfhi(u);
#pragma unroll
        for (int t = 0; t < 16; ++t) { const int k = rr - t; if (k >= 0 && k < 31) { o0[t] += w0[k] * lo; o1[t] += w1[k] * hi; } }
        if ((rr & 3) == 3) asm volatile("" ::: "memory"); }
}
__device__ __forceinline__ v4u glu8(const v4u vq, const v4u gq) {
    v4u o;
    o.x = pk2(bflo(vq.x) * sigmoidf_(bflo(gq.x)), bfhi(vq.x) * sigmoidf_(bfhi(gq.x)));
    o.y = pk2(bflo(vq.y) * sigmoidf_(bflo(gq.y)), bfhi(vq.y) * sigmoidf_(bfhi(gq.y)));
    o.z = pk2(bflo(vq.z) * sigmoidf_(bflo(gq.z)), bfhi(vq.z) * sigmoidf_(bfhi(gq.z)));
    o.w = pk2(bflo(vq.w) * sigmoidf_(bflo(gq.w)), bfhi(vq.w) * sigmoidf_(bfhi(gq.w)));
    return o;
}
__device__ __forceinline__ void hconv_unit(const Args& a, LAS unsigned char* lds, int l, int r0, int g, int vlo, int vhi, int tid) {
    const bf16* U = (const bf16*)(a.ws + WS_U); bf16* Y = (bf16*)(a.ws + WS_Y);
    LAS unsigned* VT = (LAS unsigned*)lds;
    for (int i = tid; i < 94 * 32; i += NTHR) { const int rr = i >> 5, ch = i & 31, row = r0 - 15 + rr;
        v4u o = {0u, 0u, 0u, 0u};
        if (row >= vlo && row < vhi) { const bf16* up = U + (size_t)row * NIN + g * 256 + ch * 8; o = glu8(*(const v4u*)(up + 1024), *(const v4u*)(up + 1536)); }
        *(LAS v4u*)(VT + rr * 128 + ch * 4) = o; }
    __syncthreads();
    int p = tid & 127; asm volatile("" : "+v"(p));
    const int tg = tid >> 7, c0 = g * 256 + 2 * p;
    float w0[31], w1[31];
#pragma unroll
    for (int k = 0; k < 31; ++k) { const float2 w = *(const float2*)(a.in[I_DWW] + (size_t)(l * 31 + k) * 512 + c0); w0[k] = w.x; w1[k] = w.y; }
    const float2 bb = *(const float2*)(a.in[I_DWB] + l * 512 + c0);
    float o0[16], o1[16];
    conv16(VT + (tg * 16) * 128 + p, w0, w1, bb.x, bb.y, o0, o1);
#pragma unroll
    for (int t = 0; t < 16; ++t) *(unsigned*)(Y + (size_t)(r0 + tg * 16 + t) * 512 + c0) = pk2(o0[t], o1[t]);
    __syncthreads();
}
__device__ __forceinline__ void vconv_unit(const Args& a, LAS unsigned char* lds, int l, int b, int w, int tid) {
    const bf16* U = (const bf16*)(a.ws + WS_U); bf16* Y = (bf16*)(a.ws + WS_Y);
    LAS unsigned* VT = (LAS unsigned*)lds;
    for (int i = tid; i < 158 * 32; i += NTHR) { const int rr = i >> 5, ch = i & 31, gr = rr - 15;
        v4u o = {0u, 0u, 0u, 0u};
        if (gr >= 0 && gr < 128) { const bf16* up = U + (size_t)(b * SEQ + gr * 64 + w) * NIN + 256 + ch * 8; o = glu8(*(const v4u*)(up + 1024), *(const v4u*)(up + 1536)); }
        *(LAS v4u*)(VT + rr * 128 + ch * 4) = o; }
    __syncthreads();
    int p = tid & 127; asm volatile("" : "+v"(p));
    const int tg = tid >> 7, c0 = 256 + 2 * p;
    float w0[31], w1[31];
#pragma unroll
    for (int k = 0; k < 31; ++k) { const float2 wv = *(const float2*)(a.in[I_DWW] + (size_t)(l * 31 + k) * 512 + c0); w0[k] = wv.x; w1[k] = wv.y; }
    const float2 bb = *(const float2*)(a.in[I_DWB] + l * 512 + c0);
#pragma unroll 1
    for (int half = 0; half < 2; ++half) {
        const int tb = tg * 32 + half * 16;
        float o0[16], o1[16];
        conv16(VT + tb * 128 + p, w0, w1, bb.x, bb.y, o0, o1);
#pragma unroll
        for (int t = 0; t < 16; ++t) *(unsigned*)(Y + (size_t)(b * SEQ + (tb + t) * 64 + w) * 512 + c0) = pk2(o0[t], o1[t]);
    }
    __syncthreads();
}
__device__ __forceinline__ void ln_rows(const Args& a, int l, int nrows, int lane, int wave) {
    const bf16* U = (const bf16*)(a.ws + WS_U); const bf16* Y = (const bf16*)(a.ws + WS_Y); bf16* MIXIN = (bf16*)(a.ws + WS_MIXIN);
    const int gw = blockIdx.x * NWAVES + wave, NGW = gridDim.x * NWAVES, c0 = lane * 8;
    float lg[8], lb[8];
#pragma unroll
    for (int e = 0; e < 8; ++e) { lg[e] = a.in[I_LNG][l * 512 + c0 + e]; lb[e] = a.in[I_LNB][l * 512 + c0 + e]; }
    for (int row = gw; row < nrows; row += NGW) {
        const v4u yq = *(const v4u*)(Y + (size_t)row * 512 + c0); const v4u gq = *(const v4u*)(U + (size_t)row * NIN + 2048 + c0);
        float y[8] = {bflo(yq.x), bfhi(yq.x), bflo(yq.y), bfhi(yq.y), bflo(yq.z), bfhi(yq.z), bflo(yq.w), bfhi(yq.w)};
        const float gt[8] = {bflo(gq.x), bfhi(gq.x), bflo(gq.y), bfhi(gq.y), bflo(gq.z), bfhi(gq.z), bflo(gq.w), bfhi(gq.w)};
        float s = 0.f;
#pragma unroll
        for (int e = 0; e < 8; ++e) s += y[e];
        const float mean = wave_sum(s) * (1.0f / 512.0f); float q = 0.f;
#pragma unroll
        for (int e = 0; e < 8; ++e) { y[e] -= mean; q += y[e] * y[e]; }
        const float rstd = rsqrtf(wave_sum(q) * (1.0f / 512.0f) + EPSF);
        float o[8];
#pragma unroll
        for (int e = 0; e < 8; ++e) o[e] = siluf_(y[e] * rstd * lg[e] + lb[e]) * gt[e];
        v4u w; w.x = pk2(o[0], o[1]); w.y = pk2(o[2], o[3]); w.z = pk2(o[4], o[5]); w.w = pk2(o[6], o[7]);
        *(v4u*)(MIXIN + (size_t)row * 1024 + 512 + c0) = w;
    }
}

constexpr int RG_GW = 0, RG_FOLD = 32768, RG_F8 = 36864, RG_CAR = 40960, RG_WAVE = 57344, RG_WAVE_BYTES = 12544;
constexpr int NP16 = 4 * NPJ;
__device__ __forceinline__ float fsig(float x) { return __builtin_amdgcn_rcpf(1.0f + __expf(-x)); }

template <bool FINAL, int D>
__device__ __forceinline__ void rg_sweep(const Args& a, LAS unsigned char* lds, LAS unsigned char* wl, int l, int b, int h, int r0, int pj, bool is_ctx, int w, int lane,
                                         unsigned (&WA)[2][22], const float2 (&cw)[4], const float2 cbv, const float (&brv)[4], const float (&biv)[4], const float (&lmv)[4]) {
    const bf16* U = (const bf16*)(a.ws + WS_U); bf16* MIXIN = (bf16*)(a.ws + WS_MIXIN);
    float* AGGA = (float*)(a.ws + WS_AGGA); float* AGGB = (float*)(a.ws + WS_AGGB); float* A16 = (float*)(a.ws + WS_A16); float* B16 = (float*)(a.ws + WS_B16);
    LAS float* VCW = (LAS float*)wl; LAS unsigned* HBW = (LAS unsigned*)(wl + 4352);
    const LAS v4u* GWL = (const LAS v4u*)(lds + RG_GW) + (D * 2) * 8 * 64 + lane;
    const LAS float* CAR = (const LAS float*)(lds + RG_CAR);
    const int fr = lane & 15, fq = lane >> 4, cp = lane & 31, rh = lane >> 5;
    float sp8[4], Hc[4], Ac[4];
    const int p16own = 4 * pj + (D ? 3 - fq : fq);
#pragma unroll
    for (int ct = 0; ct < 4; ++ct) { const int c = 16 * ct + fr;
        sp8[ct] = -8.0f * log1pf(__expf(-lmv[ct]));
        Hc[ct] = 0.f; Ac[ct] = 1.f;
        if (FINAL) {
            if (is_ctx) { const size_t base = (size_t)((b * 2 + D) * NP16) * 512 + 64 * h + c; float S = 0.f;
                for (int i = 0; i < p16own; ++i) S = A16[base + (size_t)i * 512] * S + B16[base + (size_t)i * 512];
                Hc[ct] = S; }
            else Hc[ct] = CAR[(D * 32 + (D ? 31 - (4 * w + fq) : 4 * w + fq)) * 64 + c];
        } }
    const bool fastp = !__any((sp8[0] < -0.25f) | (sp8[1] < -0.25f) | (sp8[2] < -0.25f) | (sp8[3] < -0.25f));
#pragma unroll 1
    for (int ti = 0; ti < 4; ++ti) {
        const int tile = D ? 3 - ti : ti;
        int zo = 0; asm volatile("" : "+v"(zo));
        const LAS v4u* GWLt = GWL + zo;
        v4u g0 = {0u, 0u, 0u, 0u}, g1 = g0; size_t orow = 0;
        if (FINAL && D == 0) { orow = (size_t)(r0 + 16 * (fr >> 2) + 4 * tile + (fr & 3)); const bf16* gp = U + orow * NIN + 512 + 64 * h + 16 * fq; g0 = *(const v4u*)gp; g1 = *(const v4u*)(gp + 8); }
#pragma unroll
        for (int q = 0; q < 2; ++q)
#pragma unroll
            for (int jj = 0; jj < 4; ++jj) { float v0 = cbv.x, v1 = cbv.y;
#pragma unroll
                for (int k = 0; k < 4; ++k) { const unsigned u = WA[q][D ? 15 + jj + k : (16 + jj + k) % 22]; v0 += cw[k].x * bflo(u); v1 += cw[k].y * bfhi(u); }
                *(LAS f32x2v*)(VCW + (4 * (2 * rh + q) + jj) * 68 + 2 * cp) = (f32x2v){v0, v1}; }
        bf16x8 af[2];
#pragma unroll
        for (int kk = 0; kk < 2; ++kk) { const LAS float* vp = VCW + fr * 68 + 32 * kk + 8 * fq; const f32x4 x0 = *(const LAS f32x4*)vp, x1 = *(const LAS f32x4*)(vp + 4);
            v4u pk; pk.x = cvtpk(x0.x, x0.y); pk.y = cvtpk(x0.z, x0.w); pk.z = cvtpk(x1.x, x1.y); pk.w = cvtpk(x1.z, x1.w); af[kk] = __builtin_bit_cast(bf16x8, pk); }
        float vcv[4][4];
#pragma unroll
        for (int ct = 0; ct < 4; ++ct)
#pragma unroll
            for (int jj = 0; jj < 4; ++jj) vcv[ct][jj] = VCW[(4 * fq + jj) * 68 + 16 * ct + fr];
        f32x4 accr[4], acci[4];
#pragma unroll
        for (int ct = 0; ct < 4; ++ct) { accr[ct] = (f32x4){0.f, 0.f, 0.f, 0.f}; acci[ct] = accr[ct];
#pragma unroll
            for (int kk = 0; kk < 2; ++kk) { const bf16x8 br = __builtin_bit_cast(bf16x8, GWLt[(ct * 2 + kk) * 64]), bi = __builtin_bit_cast(bf16x8, GWLt[(8 + ct * 2 + kk) * 64]);
                accr[ct] = __builtin_amdgcn_mfma_f32_16x16x32_bf16(af[kk], br, accr[ct], 0, 0, 0); acci[ct] = __builtin_amdgcn_mfma_f32_16x16x32_bf16(af[kk], bi, acci[ct], 0, 0, 0); } }
        float hsum[4][4];
#pragma unroll
        for (int ct = 0; ct < 4; ++ct) { float aa[4], bb[4];
            const float nbr = -1.44269504f * brv[ct], nbi = -1.44269504f * biv[ct];
#pragma unroll
            for (int p = 0; p < 2; ++p) {
                f32x2v xr = (f32x2v){accr[ct][2 * p], accr[ct][2 * p + 1]} * -1.44269504f + nbr, xi = (f32x2v){acci[ct][2 * p], acci[ct][2 * p + 1]} * -1.44269504f + nbi;
                xr = __builtin_elementwise_min(xr, (f32x2v){60.f, 60.f}); xi = __builtin_elementwise_min(xi, (f32x2v){60.f, 60.f});
                f32x2v d1, d2; d1.x = __builtin_amdgcn_exp2f(xr.x); d1.y = __builtin_amdgcn_exp2f(xr.y); d2.x = __builtin_amdgcn_exp2f(xi.x); d2.y = __builtin_amdgcn_exp2f(xi.y);
                d1 = d1 + 1.0f; d2 = d2 + 1.0f; const f32x2v m = d1 * d2; f32x2v inv; inv.x = __builtin_amdgcn_rcpf(m.x); inv.y = __builtin_amdgcn_rcpf(m.y);
                const f32x2v r = d2 * inv, ig = d1 * inv, la = r * sp8[ct], x2 = la + la;
                const f32x2v pom = -x2 * (x2 * (x2 * (x2 * (x2 * 0.0083333338f + 0.041666668f) + 0.16666667f) + 0.5f) + 1.0f);
                f32x2v av, om;
                if (fastp) { av = la * (la * (la * (la * (la * 0.0083333338f + 0.041666668f) + 0.16666667f) + 0.5f) + 1.0f) + 1.0f; om = pom; }
                else { av.x = __builtin_amdgcn_exp2f(la.x * 1.44269504f); av.y = __builtin_amdgcn_exp2f(la.y * 1.44269504f); const f32x2v o2 = 1.0f - av * av; om.x = x2.x > -0.25f ? pom.x : o2.x; om.y = x2.y > -0.25f ? pom.y : o2.y; }
                om = __builtin_elementwise_max(om, (f32x2v){0.f, 0.f});
                f32x2v sq; sq.x = __builtin_amdgcn_sqrtf(om.x); sq.y = __builtin_amdgcn_sqrtf(om.y);
                const f32x2v bv = sq * (ig * (f32x2v){vcv[ct][2 * p], vcv[ct][2 * p + 1]});
                aa[2 * p] = av.x; aa[2 * p + 1] = av.y; bb[2 * p] = bv.x; bb[2 * p + 1] = bv.y; }
            float hh = Hc[ct], A4 = 1.f;
#pragma unroll
            for (int ji = 0; ji < 4; ++ji) { const int jj = D ? 3 - ji : ji; hh = aa[jj] * hh + bb[jj]; A4 *= aa[jj]; hsum[ct][jj] = hh; }
            Hc[ct] = hh; if (!FINAL) Ac[ct] *= A4; }
        if (FINAL) {
            if (D == 1) {
#pragma unroll
                for (int ct = 0; ct < 4; ++ct)
#pragma unroll
                    for (int jp = 0; jp < 2; ++jp) HBW[(tile * 8 + ct * 2 + jp) * 64 + lane] = cvtpk(hsum[ct][2 * jp], hsum[ct][2 * jp + 1]);
            } else {
#pragma unroll
                for (int ct = 0; ct < 4; ++ct)
#pragma unroll
                    for (int jp = 0; jp < 2; ++jp) { const unsigned hb = HBW[(tile * 8 + ct * 2 + jp) * 64 + lane];
                        VCW[(4 * fq + 2 * jp) * 68 + 16 * ct + fr] = hsum[ct][2 * jp] + bflo(hb); VCW[(4 * fq + 2 * jp + 1) * 68 + 16 * ct + fr] = hsum[ct][2 * jp + 1] + bfhi(hb); }
                const size_t row = orow;
                const f32x4 s0 = *(const LAS f32x4*)(VCW + fr * 68 + 16 * fq), s1 = *(const LAS f32x4*)(VCW + fr * 68 + 16 * fq + 4), s2 = *(const LAS f32x4*)(VCW + fr * 68 + 16 * fq + 8), s3 = *(const LAS f32x4*)(VCW + fr * 68 + 16 * fq + 12);
                v4u o0, o1;
                o0.x = cvtpk(s0.x * bflo(g0.x), s0.y * bfhi(g0.x)); o0.y = cvtpk(s0.z * bflo(g0.y), s0.w * bfhi(g0.y)); o0.z = cvtpk(s1.x * bflo(g0.z), s1.y * bfhi(g0.z)); o0.w = cvtpk(s1.z * bflo(g0.w), s1.w * bfhi(g0.w));
                o1.x = cvtpk(s2.x * bflo(g1.x), s2.y * bfhi(g1.x)); o1.y = cvtpk(s2.z * bflo(g1.y), s2.w * bfhi(g1.y)); o1.z = cvtpk(s3.x * bflo(g1.z), s3.y * bfhi(g1.z)); o1.w = cvtpk(s3.z * bflo(g1.w), s3.w * bfhi(g1.w));
                bf16* op = MIXIN + row * 1024 + 64 * h + 16 * fq; *(v4u*)op = o0; *(v4u*)(op + 8) = o1;
            }
        }
#pragma unroll
        for (int q = 0; q < 2; ++q) {
            if (D) { const unsigned t0 = WA[q][18], t1 = WA[q][19], t2 = WA[q][20], t3 = WA[q][21];
#pragma unroll
                for (int p = 21; p >= 4; --p) WA[q][p] = WA[q][p - 4];
                WA[q][0] = t0; WA[q][1] = t1; WA[q][2] = t2; WA[q][3] = t3; }
            else { const unsigned t0 = WA[q][0], t1 = WA[q][1], t2 = WA[q][2], t3 = WA[q][3];
#pragma unroll
                for (int p = 0; p < 18; ++p) WA[q][p] = WA[q][p + 4];
                WA[q][18] = t0; WA[q][19] = t1; WA[q][20] = t2; WA[q][21] = t3; } }
    }
    if (!FINAL) {
#pragma unroll
        for (int ct = 0; ct < 4; ++ct) { const int c = 16 * ct + fr;
            const size_t i16 = (size_t)((b * 2 + D) * NP16 + p16own) * 512 + 64 * h + c; A16[i16] = Ac[ct]; B16[i16] = Hc[ct];
            float Ag[4], Bg[4];
#pragma unroll
            for (int g = 0; g < 4; ++g) { Ag[g] = __shfl(Ac[ct], fr + 16 * g); Bg[g] = __shfl(Hc[ct], fr + 16 * g); }
            float run = 0.f;
#pragma unroll
            for (int gi = 0; gi < 4; ++gi) { const int g = D ? 3 - gi : gi; run = Ag[g] * run + Bg[g]; }
            if (fq == 0) { const size_t idx = (size_t)((b * 2 + D) * NPJ + pj) * 512 + 64 * h + c; AGGA[idx] = (Ag[0] * Ag[1]) * (Ag[2] * Ag[3]); AGGB[idx] = run; } }
    }
}

template <bool FINAL>
__device__ __forceinline__ void rg_run(const Args& a, LAS unsigned char* lds, int l, int rn, int tid, int lane, int wave) {
    const bool is_ctx = rn >= 256; const int bh = is_ctx ? rn - 256 : rn >> 4, b = bh >> 3, h = bh & 7, cgp = is_ctx ? 0 : (rn & 15);
    { const v4u* GWF = (const v4u*)(a.ws + WS_GWF); LAS v4u* GWL = (LAS v4u*)(lds + RG_GW);
#pragma unroll
      for (int i = tid; i < 2048; i += NTHR) { const int d = i >> 10, g = (i >> 9) & 1, rest = i & 511; GWL[i] = GWF[(size_t)((((l * 2 + d) * 2 + g) * 8 + h) * 8) * 64 + rest]; } }
    const bool active = wave < (is_ctx ? 4 : 8);
    const int jw = active ? wave : 0, j = is_ctx ? jw : 8 * cgp + jw;
    const int seg_lo = is_ctx ? MLAT + b * CTXL : b * SEQ, seg_hi = seg_lo + (is_ctx ? CTXL : SEQ), r0 = seg_lo + 64 * j;
    const int pjf = is_ctx ? j : 4 + j, pjb = is_ctx ? 3 - j : 131 - j;
    unsigned WA[2][22]; float2 cwv[2][4], cbv2[2]; float brv[2][4], biv[2][4], lmv[2][4];
    { const int cp = lane & 31, rh = lane >> 5, fr = lane & 15; const bf16* ub = (const bf16*)(a.ws + WS_U) + 64 * h + 2 * cp;
#pragma unroll
      for (int q = 0; q < 2; ++q)
#pragma unroll
          for (int jr = 0; jr < 22; ++jr) { const int row = r0 + 16 * (2 * rh + q) - 3 + jr; const bool ok = row >= seg_lo && row < seg_hi; const int rc = ok ? row : r0;
              const unsigned v = *(const unsigned*)(ub + (size_t)rc * NIN); WA[q][jr] = ok ? v : 0u; }
#pragma unroll
      for (int d = 0; d < 2; ++d) {
#pragma unroll
          for (int k = 0; k < 4; ++k) cwv[d][k] = *(const float2*)(a.in[I_CAW] + (size_t)((l * 2 + d) * 4 + k) * 512 + 64 * h + 2 * cp);
          cbv2[d] = *(const float2*)(a.in[I_CAB] + (l * 2 + d) * 512 + 64 * h + 2 * cp);
#pragma unroll
          for (int ct = 0; ct < 4; ++ct) { const int pidx = (l * 2 + d) * 512 + 64 * h + 16 * ct + fr; brv[d][ct] = a.in[I_BR][pidx]; biv[d][ct] = a.in[I_BI][pidx]; lmv[d][ct] = a.in[I_LAM][pidx]; } } }
    const int P0f = 4 + 8 * cgp, P0b = 124 - 8 * cgp;
    if (FINAL && !is_ctx) {
        const float* AGGA = (const float*)(a.ws + WS_AGGA); const float* AGGB = (const float*)(a.ws + WS_AGGB); const float* A16 = (const float*)(a.ws + WS_A16); const float* B16 = (const float*)(a.ws + WS_B16);
        const int d = tid >> 8, s = (tid >> 6) & 3, c = tid & 63, P0 = d ? P0b : P0f, lo = (P0 * s) >> 2, hi = (P0 * (s + 1)) >> 2;
        const size_t b16 = (size_t)((b * 2 + d) * NP16 + 4 * P0 + 8 * s) * 512 + 64 * h + c; float ai8[8], bi8[8];
#pragma unroll
        for (int i = 0; i < 8; ++i) { ai8[i] = A16[b16 + (size_t)i * 512]; bi8[i] = B16[b16 + (size_t)i * 512]; }
        const size_t base = (size_t)((b * 2 + d) * NPJ) * 512 + 64 * h + c; float A = 1.f, Bv = 0.f;
#pragma unroll 8
        for (int i = lo; i < hi; ++i) { const float ai = AGGA[base + (size_t)i * 512], bi = AGGB[base + (size_t)i * 512]; Bv = ai * Bv + bi; A *= ai; }
        LAS float* FO = (LAS float*)(lds + RG_FOLD); LAS float* F8 = (LAS float*)(lds + RG_F8); LAS float* CAR = (LAS float*)(lds + RG_CAR);
        FO[((d * 4 + s) * 64 + c) * 2] = A; FO[((d * 4 + s) * 64 + c) * 2 + 1] = Bv;
        float A8 = 1.f, B8 = 0.f;
#pragma unroll
        for (int i = 0; i < 8; ++i) { B8 = ai8[i] * B8 + bi8[i]; A8 *= ai8[i]; }
        F8[((d * 4 + s) * 64 + c) * 2] = A8; F8[((d * 4 + s) * 64 + c) * 2 + 1] = B8;
        __syncthreads();
        float S = 0.f;
#pragma unroll
        for (int s2 = 0; s2 < 4; ++s2) S = FO[((d * 4 + s2) * 64 + c) * 2] * S + FO[((d * 4 + s2) * 64 + c) * 2 + 1];
#pragma unroll
        for (int s2 = 0; s2 < 3; ++s2) if (s2 < s) S = F8[((d * 4 + s2) * 64 + c) * 2] * S + F8[((d * 4 + s2) * 64 + c) * 2 + 1];
#pragma unroll
        for (int i = 0; i < 8; ++i) { CAR[(d * 32 + 8 * s + i) * 64 + c] = S; S = ai8[i] * S + bi8[i]; }
    }
    __syncthreads();
    if (active) {
        LAS unsigned char* wl = lds + RG_WAVE + wave * RG_WAVE_BYTES;
        rg_sweep<FINAL, 1>(a, lds, wl, l, b, h, r0, pjb, is_ctx, wave, lane, WA, cwv[1], cbv2[1], brv[1], biv[1], lmv[1]);
        rg_sweep<FINAL, 0>(a, lds, wl, l, b, h, r0, pjf, is_ctx, wave, lane, WA, cwv[0], cbv2[0], brv[0], biv[0], lmv[0]);
    }
    __syncthreads();
}

#define RLX_AGENT __ATOMIC_RELAXED, __HIP_MEMORY_SCOPE_AGENT


#define XB_TMO      128
#define XB_XCNT(j)  (256  + 64 * (j))
#define XB_XSUB(j)  (1280 + 64 * (j))
#define XB_XGEN(j)  (2304 + 64 * (j))
#define XB_TOP      3328
#define XB_TOPGEN   3392
#define XCD_BAR_WORDS 3456
#define XB_SPIN_CAP (1u << 18)

__device__ __forceinline__ unsigned xb_ld(unsigned* p)              { return __hip_atomic_load(p, __ATOMIC_RELAXED, __HIP_MEMORY_SCOPE_AGENT); }
__device__ __forceinline__ unsigned xb_add(unsigned* p, unsigned v) { return __hip_atomic_fetch_add(p, v, __ATOMIC_RELAXED, __HIP_MEMORY_SCOPE_AGENT); }
__device__ __forceinline__ unsigned xb_xcc_id() { return (unsigned)__builtin_amdgcn_s_getreg((3 << 11) | 20) & 0xFu; }
#define XB_SPIN(cond, bar) do { unsigned _sp = 0; while (cond) { __builtin_amdgcn_s_sleep(1); \
    if ((++_sp & 255u) == 0u) { if (xb_ld(&(bar)[XB_TMO])) break; if (_sp > XB_SPIN_CAP) { atomicAdd(&(bar)[XB_TMO], 1u); break; } } } } while (0)

struct XcdBarrier {
    unsigned* bar; unsigned x;
    volatile LAS unsigned* st;
};

__device__ __forceinline__ XcdBarrier xcd_barrier_post(unsigned* bar, volatile LAS unsigned* st) {
    XcdBarrier b; b.bar = bar; b.x = xb_xcc_id(); b.st = st;
    if (threadIdx.x == 0) (void)xb_add(&bar[XB_XCNT(b.x)], 1u);
    return b;
}
__device__ __forceinline__ void xcd_barrier_complete(unsigned* bar, unsigned x, unsigned& nloc, unsigned& nx) {
    const unsigned G = gridDim.x * gridDim.y * gridDim.z;
    unsigned sum, cnt, mine, sp = 0u;
    for (;;) {
        sum = 0u; cnt = 0u; mine = 0u;
#pragma unroll
        for (unsigned j = 0; j < 16; ++j) { const unsigned c = xb_ld(&bar[XB_XCNT(j)]); sum += c; cnt += (c > 0u) ? 1u : 0u; mine = (j == x) ? c : mine; }
        if (sum == G) break;
        __builtin_amdgcn_s_sleep(1);
        if ((++sp & 255u) == 0u) { if (xb_ld(&bar[XB_TMO])) break; if (sp > XB_SPIN_CAP) { atomicAdd(&bar[XB_TMO], 1u); break; } }
    }
    nloc = mine > 0u ? mine : 1u; nx = cnt > 0u ? cnt : 1u;
}

__device__ __forceinline__ void xcd_barrier(const XcdBarrier& b) {
    asm volatile("s_waitcnt vmcnt(0)" ::: "memory");
    __syncthreads();
    if (threadIdx.x == 0) {
        unsigned* bar = b.bar;
        __builtin_amdgcn_s_waitcnt(0);
        unsigned nloc = b.st[0], nx = b.st[1];
        if (nloc == 0u) { xcd_barrier_complete(bar, b.x, nloc, nx); b.st[0] = nloc; b.st[1] = nx; }
        const unsigned old = xb_add(&bar[XB_XSUB(b.x)], 1u);
        const unsigned gen = old / nloc;
        if (old + 1u == (gen + 1u) * nloc) {
            __builtin_amdgcn_fence(__ATOMIC_RELEASE, "agent");
            asm volatile("s_waitcnt vmcnt(0)" ::: "memory");
            const unsigned og = xb_add(&bar[XB_TOP], 1u);
            const unsigned tg = og / nx;
            if (og + 1u == (tg + 1u) * nx) xb_add(&bar[XB_TOPGEN], 1u);
            else XB_SPIN(xb_ld(&bar[XB_TOPGEN]) == tg, bar);
            __builtin_amdgcn_fence(__ATOMIC_ACQUIRE, "agent");
            xb_add(&bar[XB_XGEN(b.x)], 1u);
            asm volatile("s_waitcnt vmcnt(0)" ::: "memory");
        } else {
            XB_SPIN(xb_ld(&bar[XB_XGEN(b.x)]) == gen, bar);
            __builtin_amdgcn_fence(__ATOMIC_ACQUIRE, "agent");
            asm volatile("s_waitcnt vmcnt(0)" ::: "memory");
        }
    }
    __syncthreads();
}

template <int l>
__device__ __forceinline__ void layer_phases(const Args& args, LAS unsigned char* lds, const int tid, const int lane, const int wave, const int lo, const int hi, const XcdBarrier& xbar) {
    const int G = gridDim.x, bx = blockIdx.x; unsigned char* ws = args.ws;
    constexpr int pb = 1 + 5 * l;
#define IN(k) (lo <= (k) && (k) < hi)
#define SEAM(k) do { if (IN(k) && IN((k) + 1)) { xcd_barrier(xbar); } } while (0)
        if (IN(pb)) { norm_phase(args, l, lane, wave); }
        SEAM(pb);
        if (IN(pb + 1)) {
            pg8::Gemm g{(const pg8::bf16_t*)(ws + WS_H), (const pg8::bf16_t*)(ws + WS_BT1) + (size_t)l * NIN * 1024, MROWS, NIN, 1024};
            pg8::StaticOrder S; S.init(MROWS, NIN, G, bx);
            pg8::EpiU E{(pg8::bf16_t*)(ws + WS_U)};
            pg8::gemm_phase<pg8::EpiU, pg8::StaticOrder, true, true>(lds, g, S, E);
        }
        SEAM(pb + 1);
        if (IN(pb + 2)) {
            rg_run<false>(args, lds, l, bx, tid, lane, wave);
            const int n_h = 256 + (l == 0 ? 16 : 0), n_conv = 128 + n_h;
            for (int un = bx; un < n_conv; un += G) {
                if (un < 128) { vconv_unit(args, lds, l, un >> 6, un & 63, tid); }
                else { const int hu = un - 128;
                    if (hu < 256) hconv_unit(args, lds, l, hu * 64, 0, hu * 64, hu * 64 + 64, tid);
                    else { const int cu = hu - 256, cc = cu >> 1, g = cu & 1, bb = cc >> 2; hconv_unit(args, lds, l, MLAT + cc * 64, g, MLAT + bb * CTXL, MLAT + bb * CTXL + CTXL, tid); } }
            }
            if (bx >= G - 16) rg_run<false>(args, lds, l, 256 + (G - 1 - bx), tid, lane, wave);
        }
        SEAM(pb + 2);
        if (IN(pb + 3)) {
            rg_run<true>(args, lds, l, bx, tid, lane, wave);
            if (l == 0 && bx >= G - 16) rg_run<true>(args, lds, l, 256 + (G - 1 - bx), tid, lane, wave);
            ln_rows(args, l, (l == 0) ? MROWS : MLAT, lane, wave);
        }
        SEAM(pb + 3);
        if (IN(pb + 4)) {
            const int M2 = (l == 0) ? MROWS : MLAT;
            pg8::Gemm g{(const pg8::bf16_t*)(ws + WS_MIXIN), (const pg8::bf16_t*)(ws + WS_BT2) + (size_t)l * 1024 * 1024, M2, 1024, 1024};
            pg8::StaticOrder S; S.init(M2, 1024, G, bx);
            pg8::EpiMix E{(float*)(ws + WS_MIX), (float*)(ws + WS_SSQ)};
            pg8::gemm_phase<pg8::EpiMix, pg8::StaticOrder, true, true>(lds, g, S, E);
        }
        SEAM(pb + 4);
#undef IN
#undef SEAM
}

__global__ void __launch_bounds__(NTHR, 2) fwd_megakernel(Args args) {
    extern __shared__ __attribute__((aligned(16))) unsigned char lds_raw[];
    LAS unsigned char* lds = (LAS unsigned char*)lds_raw;
    const int tid = threadIdx.x, lane = tid & 63, wave = __builtin_amdgcn_readfirstlane(tid >> 6);
    const int G = gridDim.x, bx = blockIdx.x;
    unsigned char* ws = args.ws;
    const int lo = args.ph_lo, hi = args.ph_hi;
    if (args.coop == 2) cg::this_grid().sync();
    volatile LAS unsigned* MISC = (volatile LAS unsigned*)(lds + MISC_OFF);
    if (tid < 64) MISC[tid] = 0u;
    __syncthreads();
    XcdBarrier xbar; xbar.bar = (unsigned*)(ws + WS_CTL); xbar.x = 0; xbar.st = nullptr;
    if (args.coop == 1) xbar = xcd_barrier_post((unsigned*)(ws + WS_CTL), MISC + 8);
#define IN(k) (lo <= (k) && (k) < hi)
#define SEAM(k) do { if (IN(k) && IN((k) + 1)) { xcd_barrier(xbar); } } while (0)

    if (IN(0)) { p0_prologue(args, lds, tid, lane, wave); }
    SEAM(0);
    layer_phases<0>(args, lds, tid, lane, wave, lo, hi, xbar);
    layer_phases<1>(args, lds, tid, lane, wave, lo, hi, xbar);
    if (IN(11)) { norm_phase(args, 2, lane, wave); }
#undef IN
#undef SEAM
}

#ifndef MK_PER_PHASE
#define MK_PER_PHASE 0
#endif
extern "C" void kernel_launch(void* const* d_in, const int* in_sizes, int n_in, void* d_out, int out_size, void* d_ws, size_t ws_size, hipStream_t stream) {
    static int grid = 0;
    if (grid == 0) {
        if (n_in != 21 || out_size != MLAT * DM || ws_size < WS_END) { fprintf(stderr, "kernel_launch: unexpected shapes (n_in %d, out %d, ws %zu)\n", n_in, out_size, ws_size); grid = -1; return; }
        int dev = 0, cus = 0, per_cu = 0;
        if (hipGetDevice(&dev) != hipSuccess || hipDeviceGetAttribute(&cus, hipDeviceAttributeMultiprocessorCount, dev) != hipSuccess) { grid = -1; return; }
        if (hipFuncSetAttribute((const void*)fwd_megakernel, hipFuncAttributeMaxDynamicSharedMemorySize, LDS_BYTES) != hipSuccess) { fprintf(stderr, "kernel_launch: hipFuncSetAttribute failed\n"); grid = -1; return; }
        if (hipOccupancyMaxActiveBlocksPerMultiprocessor(&per_cu, (const void*)fwd_megakernel, NTHR, LDS_BYTES) != hipSuccess || per_cu < 1) { fprintf(stderr, "kernel_launch: occupancy query says %d\n", per_cu); per_cu = 1; }
        (void)hipGetLastError();
        grid = cus;
    }
    if (grid < 0) return;
    if (hipMemsetAsync((char*)d_ws + WS_CTL, 0, CTL_ZERO_BYTES, stream) != hipSuccess) { fprintf(stderr, "kernel_launch: memset failed\n"); return; }
    Args a{};
    for (int i = 0; i < 21; ++i) a.in[i] = (const float*)d_in[i];
    a.out = (float*)d_out; a.ws = (unsigned char*)d_ws;
#if MK_PER_PHASE
    for (int ph = 0; ph < 12; ++ph) { a.ph_lo = ph; a.ph_hi = ph + 1; a.coop = 0;
        hipLaunchKernelGGL(fwd_megakernel, dim3(grid), dim3(NTHR), LDS_BYTES, stream, a); }
#else
    a.ph_lo = 0; a.ph_hi = 12; a.coop = 1;
    void* kargs[] = {&a};
    hipError_t e = hipLaunchCooperativeKernel((const void*)fwd_megakernel, dim3(grid), dim3(NTHR), kargs, LDS_BYTES, stream);
    if (e != hipSuccess) fprintf(stderr, "cooperative launch failed: %s (grid %d)\n", hipGetErrorString(e), grid);
#endif
}
```

```cpp
#include <hip/hip_runtime.h>
#include <hip/hip_cooperative_groups.h>
#include <cstdio>
#include <cstdint>
namespace cg = cooperative_groups;
#define MK_PER_PHASE 0
namespace pg8 {
#define PG8_LAS __attribute__((address_space(3)))
typedef unsigned short bf16_t;
typedef short bf16x8 __attribute__((ext_vector_type(8)));
typedef float f32x4 __attribute__((ext_vector_type(4)));
typedef unsigned u32x4 __attribute__((ext_vector_type(4)));
constexpr int BM = 256, BK = 64, HALF = 128, HTB = HALF * BK * 2  , STAGE_BYTES = 8 * HTB, NXCD = 8, WGM = 8;

__host__ __device__ __forceinline__ int lds_byte(int r, int c) { const int st = (r >> 4) * 2 + (c >> 5), rr = r & 15, cc = c & 31, ob = rr * 64 + cc * 2; return st * 1024 + (ob ^ (((ob >> 9) & 1) << 5)); }
__host__ __device__ __forceinline__ void stage_rc(int b, int& R, int& C) { const int st = b / 1024, sb = b % 1024, swz = sb ^ (((sb >> 9) & 1) << 5); R = (st >> 1) * 16 + swz / 64; C = (st & 1) * 32 + (swz % 64) / 2; }
__host__ __device__ __forceinline__ int perm32(int rho) { const int n = rho >> 4, i = rho & 15; return 8 * (i >> 2) + 4 * n + (i & 3); }

struct Unit { int pm, pn; };
struct Gemm { const bf16_t* A; const bf16_t* Bt; int M, N, K; };

struct StaticOrder {
    int nM, nN, nwg, G, c;
    __host__ __device__ void init(int M, int N, int G_, int c_) { nM = M / BM; nN = N / BM; nwg = nM * nN; G = G_; c = c_; }
    __host__ __device__ bool next(int i, Unit& u) const {
        const long L = (long)i * G + c; if (L >= nwg) return false;
        int wgid = (int)L; { const int q = nwg / NXCD, r = nwg % NXCD, xcd = wgid % NXCD, off = wgid / NXCD; wgid = (xcd < r ? xcd * (q + 1) : r * (q + 1) + (xcd - r) * q) + off; }
        const int nig = WGM * nN, gid = wgid / nig, fm = gid * WGM, gsz = (nM - fm) < WGM ? (nM - fm) : WGM;
        u.pm = fm + ((wgid % nig) % gsz); u.pn = (wgid % nig) / gsz; return true;
    }
    __device__ __forceinline__ void a_ready(const Unit&) const {}
    __device__ __forceinline__ void done(const Unit&) const {}
};
__device__ __forceinline__ unsigned cvt_pk_bf16(float lo, float hi) { unsigned r; asm volatile("v_cvt_pk_bf16_f32 %0, %1, %2" : "=v"(r) : "v"(lo), "v"(hi)); return r; }
typedef float f32x2 __attribute__((ext_vector_type(2)));
template <class Epi, class Sched, bool ALIGN_EPI = false, bool SP2 = false>
__device__ __forceinline__ void gemm_phase(PG8_LAS unsigned char* lds, const Gemm g, const Sched& S, const Epi& E) {
    const int tid = threadIdx.x, wid = __builtin_amdgcn_readfirstlane(tid >> 6), lane = tid & 63, wr = wid >> 2, wc = wid & 3, fr = lane & 15, fq = lane >> 4;
    const int K = g.K, nt = K / BK;
    unsigned voffA[2], voffB[2];
#pragma unroll
    for (int i = 0; i < 2; ++i) { int R, C; stage_rc(tid * 16 + i * 8192, R, C); const int Rb = Epi::PERM ? ((R & ~31) + perm32(R & 31)) : R;
        voffA[i] = (unsigned)(R * K + C) * 2u; voffB[i] = (unsigned)(Rb * K + C) * 2u; }
    const size_t kstep = (size_t)(BK * 2);
    const size_t hstep = (size_t)HALF * K * 2;
    const size_t tstep = 2 * hstep;
    const unsigned ldsw = (unsigned)wid * 1024u;
    const int aoff = lds_byte(wr * 64 + fr, fq * 8), boff = lds_byte(wc * 32 + fr, fq * 8);
#define PG8_SA(b, h) (((b) * 2 + (h)) * HTB)
#define PG8_SB(b, h) ((4 + (b) * 2 + (h)) * HTB)
#define PG8_STAGE(bufoff, gbase, voff) do { _Pragma("unroll") for (int _i = 0; _i < 2; ++_i) \
        __builtin_amdgcn_global_load_lds((const unsigned*)((const char*)(gbase) + (voff)[_i]), (PG8_LAS unsigned*)(lds + (bufoff) + ldsw + _i * 8192), 16, 0, 0); } while (0)
#define PG8_LDA(dst, b, h) do { _Pragma("unroll") for (int m = 0; m < 4; ++m) _Pragma("unroll") for (int k = 0; k < 2; ++k) dst[m][k] = *(const PG8_LAS bf16x8*)(lds + PG8_SA(b, h) + aoff + m * 2048 + k * 1024); } while (0)
#define PG8_LDB(dst, b, h) do { _Pragma("unroll") for (int n = 0; n < 2; ++n) _Pragma("unroll") for (int k = 0; k < 2; ++k) dst[n][k] = *(const PG8_LAS bf16x8*)(lds + PG8_SB(b, h) + boff + n * 2048 + k * 1024); } while (0)
#define PG8_MMA(ai, bj, At, Bt) do { __builtin_amdgcn_s_setprio(1); _Pragma("unroll") for (int m = 0; m < 4; ++m) _Pragma("unroll") for (int n = 0; n < 2; ++n) _Pragma("unroll") for (int k = 0; k < 2; ++k) \
        acc[ai][bj][m][n] = __builtin_amdgcn_mfma_f32_16x16x32_bf16(Bt[n][k], At[m][k], acc[ai][bj][m][n], 0, 0, 0); __builtin_amdgcn_s_setprio(0); } while (0)
#define PG8_WAIT_V(n) asm volatile("s_waitcnt vmcnt(" #n ")" ::: "memory")
#define PG8_WAIT_L(n) asm volatile("s_waitcnt lgkmcnt(" #n ")" ::: "memory")
#define PG8_BAR __builtin_amdgcn_s_barrier()
#define PG8_SCHED __builtin_amdgcn_sched_barrier(0)
    Unit cur, nxt; int ui = 0;
    if (!S.next(0, cur)) return;
    f32x4 acc[2][2][4][2];
#pragma unroll
    for (int a = 0; a < 2; ++a)
#pragma unroll
        for (int b = 0; b < 2; ++b)
#pragma unroll
            for (int m = 0; m < 4; ++m)
#pragma unroll
                for (int n = 0; n < 2; ++n) acc[a][b][m][n] = (f32x4){0.f, 0.f, 0.f, 0.f};
    bf16x8 At[4][2], B0[2][2], B1[2][2];
    const char* cA = (const char*)g.A + (size_t)cur.pm * tstep; const char* cB = (const char*)g.Bt + (size_t)cur.pn * tstep;
    S.a_ready(cur);
    if constexpr (SP2) {
        PG8_STAGE(PG8_SB(0, 0), cB, voffB); PG8_STAGE(PG8_SB(0, 1), cB + hstep, voffB); PG8_STAGE(PG8_SA(0, 0), cA, voffA); PG8_STAGE(PG8_SA(0, 1), cA + hstep, voffA);
        if (wr == 1) PG8_BAR;
        PG8_WAIT_V(2); PG8_BAR;
        PG8_STAGE(PG8_SB(1, 0), cB + kstep, voffB); PG8_STAGE(PG8_SA(1, 0), cA + kstep, voffA); PG8_STAGE(PG8_SB(1, 1), cB + hstep + kstep, voffB);
        PG8_WAIT_V(6); PG8_BAR;
    } else {
        PG8_STAGE(PG8_SB(0, 0), cB, voffB); PG8_STAGE(PG8_SA(0, 0), cA, voffA); PG8_STAGE(PG8_SB(0, 1), cB + hstep, voffB); PG8_STAGE(PG8_SA(0, 1), cA + hstep, voffA);
        if (wr == 1) PG8_BAR;
        PG8_WAIT_V(4); PG8_BAR;
        PG8_STAGE(PG8_SB(1, 0), cB + kstep, voffB); PG8_STAGE(PG8_SA(1, 0), cA + kstep, voffA); PG8_STAGE(PG8_SB(1, 1), cB + hstep + kstep, voffB);
        PG8_WAIT_V(6); PG8_BAR;
    }
    for (;;) {
        const bool has_next = S.next(ui + 1, nxt);
        const char* nA = has_next ? (const char*)g.A + (size_t)nxt.pm * tstep : cA; const char* nB = has_next ? (const char*)g.Bt + (size_t)nxt.pn * tstep : cB;
        for (int t = 0; t < nt; t += 2) {
            const bool last = (t == nt - 2);
            const char* a1 = cA + (size_t)(t + 1) * kstep;
            const char* a2 = last ? nA : cA + (size_t)(t + 2) * kstep; const char* b2 = last ? nB : cB + (size_t)(t + 2) * kstep;
            const char* a3 = a2 + kstep; const char* b3 = b2 + kstep;
            if (last && has_next) S.a_ready(nxt);
            if constexpr (SP2) {
            PG8_LDB(B0, 0, 0); PG8_LDB(B1, 0, 1); PG8_SCHED; PG8_LDA(At, 0, 0); PG8_STAGE(PG8_SA(1, 1), a1 + hstep, voffA);
            PG8_WAIT_V(8); PG8_WAIT_L(0); PG8_BAR; PG8_MMA(0, 0, At, B0); PG8_MMA(0, 1, At, B1); PG8_BAR; PG8_SCHED;
            PG8_LDA(At, 0, 1); PG8_STAGE(PG8_SB(0, 0), b2, voffB); PG8_STAGE(PG8_SB(0, 1), b2 + hstep, voffB); PG8_STAGE(PG8_SA(0, 0), a2, voffA);
            PG8_WAIT_V(8); PG8_WAIT_L(0); PG8_BAR; PG8_MMA(1, 0, At, B0); PG8_MMA(1, 1, At, B1); PG8_BAR; PG8_SCHED;
            PG8_LDB(B0, 1, 0); PG8_LDB(B1, 1, 1); PG8_SCHED; PG8_LDA(At, 1, 0); PG8_STAGE(PG8_SA(0, 1), a2 + hstep, voffA);
            PG8_WAIT_V(8); PG8_WAIT_L(0); PG8_BAR; PG8_MMA(0, 0, At, B0); PG8_MMA(0, 1, At, B1); PG8_BAR; PG8_SCHED;
            PG8_LDA(At, 1, 1); PG8_STAGE(PG8_SB(1, 0), b3, voffB); PG8_STAGE(PG8_SB(1, 1), b3 + hstep, voffB); PG8_STAGE(PG8_SA(1, 0), a3, voffA);
            PG8_WAIT_V(8); PG8_WAIT_L(0); PG8_BAR; PG8_MMA(1, 0, At, B0); PG8_MMA(1, 1, At, B1); PG8_BAR; PG8_SCHED;
            } else {
            PG8_LDB(B0, 0, 0); PG8_SCHED; PG8_LDA(At, 0, 0); PG8_STAGE(PG8_SA(1, 1), a1 + hstep, voffA);
            PG8_WAIT_L(8); PG8_BAR; PG8_WAIT_L(0); PG8_MMA(0, 0, At, B0); PG8_BAR; PG8_SCHED;
            PG8_LDB(B1, 0, 1); PG8_STAGE(PG8_SB(0, 0), b2, voffB);
            PG8_BAR; PG8_WAIT_L(0); PG8_MMA(0, 1, At, B1); PG8_BAR;
            PG8_LDA(At, 0, 1); PG8_STAGE(PG8_SA(0, 0), a2, voffA);
            PG8_BAR; PG8_WAIT_L(0); PG8_MMA(1, 0, At, B0); PG8_BAR; PG8_SCHED;
            PG8_STAGE(PG8_SB(0, 1), b2 + hstep, voffB);
            PG8_WAIT_V(6); PG8_BAR; PG8_MMA(1, 1, At, B1); PG8_BAR;
            PG8_LDB(B0, 1, 0); PG8_SCHED; PG8_LDA(At, 1, 0); PG8_STAGE(PG8_SA(0, 1), a2 + hstep, voffA);
            PG8_WAIT_L(8); PG8_BAR; PG8_WAIT_L(0); PG8_MMA(0, 0, At, B0); PG8_BAR; PG8_SCHED;
            PG8_LDB(B1, 1, 1); PG8_STAGE(PG8_SB(1, 0), b3, voffB);
            PG8_BAR; PG8_WAIT_L(0); PG8_MMA(0, 1, At, B1); PG8_BAR;
            PG8_LDA(At, 1, 1); PG8_STAGE(PG8_SA(1, 0), a3, voffA);
            PG8_BAR; PG8_WAIT_L(0); PG8_MMA(1, 0, At, B0); PG8_BAR; PG8_SCHED;
            PG8_STAGE(PG8_SB(1, 1), b3 + hstep, voffB);
            PG8_WAIT_V(6); PG8_BAR; PG8_MMA(1, 1, At, B1); PG8_BAR;
            }
        }
        if constexpr (ALIGN_EPI) { if (wr == 0) PG8_BAR; }
        if constexpr (!Epi::AFTER_DRAIN) { E(acc, cur, wr, wc, fr, fq); S.done(cur); }
        if (!has_next) break;
#pragma unroll
        for (int a = 0; a < 2; ++a)
#pragma unroll
            for (int b = 0; b < 2; ++b)
#pragma unroll
                for (int m = 0; m < 4; ++m)
#pragma unroll
                    for (int n = 0; n < 2; ++n) acc[a][b][m][n] = (f32x4){0.f, 0.f, 0.f, 0.f};
        cur = nxt; cA = nA; cB = nB; ++ui;
        if constexpr (ALIGN_EPI) { if (wr == 1) PG8_BAR; }
    }
    PG8_WAIT_V(0);
    if constexpr (!ALIGN_EPI) { if (wr == 0) PG8_BAR; }
    PG8_BAR;
    if constexpr (Epi::AFTER_DRAIN) { E.fused(acc, cur, wr, wc, fr, fq, lds, wid, lane); S.done(cur); }
#undef PG8_SA
#undef PG8_SB
#undef PG8_STAGE
#undef PG8_LDA
#undef PG8_LDB
#undef PG8_MMA
#undef PG8_WAIT_V
#undef PG8_WAIT_L
#undef PG8_BAR
#undef PG8_SCHED
}
}

constexpr int DM = 1024, NB = 2, SEQ = 8192, CTXL = 256, MLAT = NB * SEQ, MCTX = NB * CTXL, MROWS = MLAT + MCTX;
constexpr int NIN = 2560, NCHUNK = MROWS / 64  , NPJ = 132  ;
constexpr float EPSF = 1e-6f;
constexpr int NWAVES = 8, NTHR = 512;

constexpr size_t MiB = 1u << 20;
constexpr size_t WS_CTL = 0, CTL_ZERO_BYTES = 64 * 1024;
constexpr size_t WS_MOD = 1 * MiB;
constexpr size_t WS_GWF = 1 * MiB + 256 * 1024;
constexpr size_t WS_BT1 = 2 * MiB;
constexpr size_t WS_BT2 = 12 * MiB;
constexpr size_t WS_AGGA = 16 * MiB;
constexpr size_t WS_AGGB = 16 * MiB + 1536 * 1024;
constexpr size_t WS_SSQ = 19 * MiB;
constexpr size_t WS_XC1 = 21 * MiB;
constexpr size_t WS_A16 = 23 * MiB;
constexpr size_t WS_B16 = 28 * MiB;
constexpr size_t WS_H = 73 * MiB;
constexpr size_t WS_Y = 56 * MiB;
constexpr size_t WS_MIXIN = 73 * MiB;
constexpr size_t WS_U = 106 * MiB;
constexpr size_t WS_MIX = 189 * MiB;
constexpr size_t WS_END = 255 * MiB;

constexpr int LDS_BYTES = 158720;
constexpr int MISC_OFF = 157696;

#define LAS __attribute__((address_space(3)))
typedef unsigned short bf16;
typedef unsigned v4u __attribute__((ext_vector_type(4)));
typedef unsigned v2u __attribute__((ext_vector_type(2)));
typedef float f32x4 __attribute__((ext_vector_type(4)));
typedef short bf16x8 __attribute__((ext_vector_type(8)));
typedef float f32x2v __attribute__((ext_vector_type(2)));
#define LDS_WAIT() asm volatile("s_waitcnt lgkmcnt(0)" ::: "memory")

__device__ __forceinline__ unsigned f2bf(float f) { unsigned u = __builtin_bit_cast(unsigned, f); return (u + 0x7fffu + ((u >> 16) & 1u)) >> 16; }
__device__ __forceinline__ unsigned pk2(float lo, float hi) { return f2bf(lo) | (f2bf(hi) << 16); }
__device__ __forceinline__ unsigned cvtpk(float lo, float hi) { unsigned r; asm volatile("v_cvt_pk_bf16_f32 %0, %1, %2" : "=v"(r) : "v"(lo), "v"(hi)); return r; }
__device__ __forceinline__ float bflo(unsigned u) { return __builtin_bit_cast(float, u << 16); }
__device__ __forceinline__ float bfhi(unsigned u) { return __builtin_bit_cast(float, u & 0xffff0000u); }
__device__ __forceinline__ float sigmoidf_(float x) { return 1.0f / (1.0f + __expf(-x)); }
__device__ __forceinline__ float siluf_(float x) { return x / (1.0f + __expf(-x)); }
__device__ __forceinline__ float wave_sum(float v) {
#pragma unroll
    for (int o = 1; o < 64; o <<= 1) v += __shfl_xor(v, o);
    return v;
}

struct Args {
    const float* in[21]; float* out; unsigned char* ws; int ph_lo, ph_hi, coop, pad;
};
enum { I_X = 0, I_C, I_CTX, I_CCTX, I_WMOD, I_BMOD, I_GPRE, I_GPOST, I_WIN, I_CAW, I_CAB, I_WR, I_BR, I_WI, I_BI, I_LAM, I_DWW, I_DWB, I_LNG, I_LNB, I_WOUT };

namespace pg8 {
struct EpiU {
    static constexpr bool PERM = true, AFTER_DRAIN = false;
    bf16_t* O;
    __device__ __forceinline__ void operator()(const f32x4 (&acc)[2][2][4][2], const Unit& u, int wr, int wc, int fr, int fq) const {
        const int row0 = u.pm * BM + wr * 64 + fr, col0 = u.pn * BM + wc * 32 + 8 * fq;
        const bool act = (u.pn == 2 || u.pn == 3 || u.pn >= 8);
#pragma unroll
        for (int ai = 0; ai < 2; ++ai)
#pragma unroll
            for (int m = 0; m < 4; ++m) { bf16_t* rowp = O + (size_t)(row0 + ai * HALF + m * 16) * 2560 + col0;
#pragma unroll
                for (int bj = 0; bj < 2; ++bj) { f32x4 v0 = acc[ai][bj][m][0], v1 = acc[ai][bj][m][1];
                    if (act) {
#pragma unroll
                        for (int e = 0; e < 4; ++e) { v0[e] = v0[e] / (1.0f + __expf(-v0[e])); v1[e] = v1[e] / (1.0f + __expf(-v1[e])); }
                    }
                    u32x4 w; w.x = cvt_pk_bf16(v0[0], v0[1]); w.y = cvt_pk_bf16(v0[2], v0[3]); w.z = cvt_pk_bf16(v1[0], v1[1]); w.w = cvt_pk_bf16(v1[2], v1[3]);
                    *(u32x4*)(rowp + bj * HALF) = w; } }
    }
};
struct EpiMix {
    static constexpr bool PERM = true, AFTER_DRAIN = false;
    bf16_t* O; float* ssq;
    __device__ __forceinline__ void operator()(const f32x4 (&acc)[2][2][4][2], const Unit& u, int wr, int wc, int fr, int fq) const {
        const int col0 = u.pn * BM + wc * 32 + 8 * fq;
#pragma unroll
        for (int ai = 0; ai < 2; ++ai)
#pragma unroll
            for (int m = 0; m < 4; ++m) { const int r = u.pm * BM + ai * HALF + wr * 64 + m * 16 + fr; bf16_t* rowp = O + (size_t)r * 1024 + col0; float s = 0.f;
#pragma unroll
                for (int bj = 0; bj < 2; ++bj) { const f32x4 v0 = acc[ai][bj][m][0], v1 = acc[ai][bj][m][1];
                    s += ((v0[0] * v0[0] + v0[1] * v0[1]) + (v0[2] * v0[2] + v0[3] * v0[3])) + ((v1[0] * v1[0] + v1[1] * v1[1]) + (v1[2] * v1[2] + v1[3] * v1[3]));
                    u32x4 w; w.x = cvt_pk_bf16(v0[0], v0[1]); w.y = cvt_pk_bf16(v0[2], v0[3]); w.z = cvt_pk_bf16(v1[0], v1[1]); w.w = cvt_pk_bf16(v1[2], v1[3]);
                    *(u32x4*)(rowp + bj * HALF) = w; }
                s += __shfl_xor(s, 16); s += __shfl_xor(s, 32);
                if (fq == 0) ssq[(size_t)r * 16 + u.pn * 4 + wc] = s; }
    }
};
}

__device__ __forceinline__ void p0_transpose_item(const float* W, int K, int N, bf16* WT, LAS float* scr, int item, int lane) {
    const int nblk = N / 32, kb = item / nblk, nb = item % nblk, k0 = 64 * kb, n0 = 32 * nb;
#pragma unroll 8
    for (int i = 0; i < 32; ++i) { const int kk = 2 * i + (lane >> 5); scr[kk * 33 + (lane & 31)] = W[(size_t)(k0 + kk) * N + n0 + (lane & 31)]; }
    LDS_WAIT(); asm volatile("" ::: "memory");
    const int c = lane & 7;
#pragma unroll
    for (int j = 0; j < 4; ++j) { const int n = (lane >> 3) + 8 * j; const LAS float* s = scr + (8 * c) * 33 + n;
        v4u o; o.x = pk2(s[0 * 33], s[1 * 33]); o.y = pk2(s[2 * 33], s[3 * 33]); o.z = pk2(s[4 * 33], s[5 * 33]); o.w = pk2(s[6 * 33], s[7 * 33]);
        *(v4u*)(WT + (size_t)(n0 + n) * K + k0 + 8 * c) = o; }
    LDS_WAIT(); asm volatile("" ::: "memory");
}

__device__ __forceinline__ void p0_prologue(const Args& a, LAS unsigned char* lds, int tid, int lane, int wave) {
    const int G = gridDim.x, bx = blockIdx.x;
    unsigned char* ws = a.ws;
    {
        LAS float* part = (LAS float*)lds;
        float* MOD = (float*)(ws + WS_MOD);
        const float* c = a.in[I_C]; const float* cctx = a.in[I_CCTX];
        for (int un = bx; un < 192; un += G) {
            const int l = un / 96, n0 = (un % 96) * 32, cq = tid & 7, ks = tid >> 3;
            const float* wm = a.in[I_WMOD] + (size_t)l * 1024 * 3072 + n0 + cq * 4;
            f32x4 acc0 = {0.f, 0.f, 0.f, 0.f}, acc1 = acc0, acc2 = acc0;
#pragma unroll 4
            for (int kk = 0; kk < 16; ++kk) { const int k = ks * 16 + kk; const f32x4 w = *(const f32x4*)(wm + (size_t)k * 3072);
                const float a0 = siluf_(c[k]), a1 = siluf_(c[1024 + k]), a2 = siluf_(cctx[k]);
                acc0 += w * a0; acc1 += w * a1; acc2 += w * a2; }
            *(LAS f32x4*)(part + (0 * 64 + ks) * 32 + cq * 4) = acc0;
            *(LAS f32x4*)(part + (1 * 64 + ks) * 32 + cq * 4) = acc1;
            *(LAS f32x4*)(part + (2 * 64 + ks) * 32 + cq * 4) = acc2;
            __syncthreads();
            if (tid < 96) { const int v = tid >> 5, col = tid & 31; float s = a.in[I_BMOD][l * 3072 + n0 + col];
                for (int k2 = 0; k2 < 64; ++k2) s += part[(v * 64 + k2) * 32 + col];
                MOD[(l * 3 + v) * 3072 + n0 + col] = s; }
            __syncthreads();
        }
    }
    {
        v4u* GWF = (v4u*)(ws + WS_GWF);
        for (int idx = bx * NTHR + tid; idx < 32768; idx += G * NTHR) {
            const int ln = idx & 63, kk = (idx >> 6) & 1, ct = (idx >> 7) & 3, h = (idx >> 9) & 7, g = (idx >> 12) & 1, d = (idx >> 13) & 1, l = idx >> 14;
            const float* W = (g == 0 ? a.in[I_WR] : a.in[I_WI]) + (size_t)(((l * 2 + d) * 8 + h) * 64) * 64;
            const int k0 = 32 * kk + 8 * (ln >> 4), col = 16 * ct + (ln & 15);
            float e[8];
#pragma unroll
            for (int j = 0; j < 8; ++j) e[j] = W[(k0 + j) * 64 + col];
            v4u o; o.x = pk2(e[0], e[1]); o.y = pk2(e[2], e[3]); o.z = pk2(e[4], e[5]); o.w = pk2(e[6], e[7]);
            GWF[idx] = o;
        }
    }
    {
        LAS float* scr = (LAS float*)(lds + wave * 16384);
        const int gw = bx * NWAVES + wave, NGW = G * NWAVES;
        constexpr int I_1 = (1024 / 64) * (NIN / 32), I_2 = (1024 / 64) * (1024 / 32), NITEMS = 2 * (I_1 + I_2);
        bf16* BT1 = (bf16*)(ws + WS_BT1); bf16* BT2 = (bf16*)(ws + WS_BT2);
        for (int it = gw; it < NITEMS; it += NGW) {
            int r = it;
            if (r < I_1) { p0_transpose_item(a.in[I_WIN], 1024, NIN, BT1, scr, r, lane); continue; } r -= I_1;
            if (r < I_1) { p0_transpose_item(a.in[I_WIN] + (size_t)1024 * NIN, 1024, NIN, BT1 + (size_t)NIN * 1024, scr, r, lane); continue; } r -= I_1;
            if (r < I_2) { p0_transpose_item(a.in[I_WOUT], 1024, 1024, BT2, scr, r, lane); continue; } r -= I_2;
            p0_transpose_item(a.in[I_WOUT] + (size_t)1024 * 1024, 1024, 1024, BT2 + (size_t)1024 * 1024, scr, r, lane);
        }
    }
}

__device__ __forceinline__ void norm_phase(const Args& a, int mode, int lane, int wave) {
    unsigned char* ws = a.ws;
    const float* MOD = (const float*)(ws + WS_MOD); const bf16* MIX = (const bf16*)(ws + WS_MIX); const float* SSQ = (const float*)(ws + WS_SSQ);
    float* XC1 = (float*)(ws + WS_XC1); bf16* H = (bf16*)(ws + WS_H);
    const int gw = blockIdx.x * NWAVES + wave, NGW = gridDim.x * NWAVES;
    const int nrows = (mode == 2) ? MLAT : MROWS, lu = (mode == 1) ? 0 : 1, ln = (mode == 0) ? 0 : 1;
    for (int row = gw; row < nrows; row += NGW) {
        const int vsel = row < MLAT ? (row >> 13) : 2;
        const float* src;
        if (mode == 2) src = a.out + (size_t)row * 1024;
        else src = row < MLAT ? a.in[I_X] + (size_t)row * 1024 : a.in[I_CTX] + (size_t)(row - MLAT) * 1024;
        f32x4 v[4];
#pragma unroll
        for (int j = 0; j < 4; ++j) v[j] = *((const f32x4*)src + lane + 64 * j);
        if (mode >= 1) {
            const float sp = lane < 16 ? SSQ[(size_t)row * 16 + lane] : 0.f;
            const float rstd = rsqrtf(wave_sum(sp) * (1.0f / 1024.0f) + EPSF);
            const float* gate = MOD + (lu * 3 + vsel) * 3072 + 2048; const float* gp = a.in[I_GPOST] + lu * 1024;
#pragma unroll
            for (int j = 0; j < 4; ++j) { const v2u mq = *((const v2u*)(MIX + (size_t)row * 1024) + lane + 64 * j); const f32x4 mx = {bflo(mq.x), bfhi(mq.x), bflo(mq.y), bfhi(mq.y)};
                const f32x4 gt = *((const f32x4*)gate + lane + 64 * j), gv = *((const f32x4*)gp + lane + 64 * j);
                v[j] += gt * (mx * rstd * gv); }
            float* dst = row < MLAT ? a.out + (size_t)row * 1024 : XC1 + (size_t)(row - MLAT) * 1024;
#pragma unroll
            for (int j = 0; j < 4; ++j) *((f32x4*)dst + lane + 64 * j) = v[j];
        }
        if (mode <= 1) {
            float s = 0.f;
#pragma unroll
            for (int j = 0; j < 4; ++j) s += (v[j].x * v[j].x + v[j].y * v[j].y) + (v[j].z * v[j].z + v[j].w * v[j].w);
            const float r = rsqrtf(wave_sum(s) * (1.0f / 1024.0f) + EPSF);
            const float* shift = MOD + (ln * 3 + vsel) * 3072; const float* scale = shift + 1024; const float* gpre = a.in[I_GPRE] + ln * 1024;
            v2u* o8 = (v2u*)(H + (size_t)row * 1024);
#pragma unroll
            for (int j = 0; j < 4; ++j) { const f32x4 sh = *((const f32x4*)shift + lane + 64 * j), sc = *((const f32x4*)scale + lane + 64 * j), gv = *((const f32x4*)gpre + lane + 64 * j);
                const f32x4 hv = v[j] * r * gv * (sc + 1.0f) + sh;
                v2u w; w.x = pk2(hv.x, hv.y); w.y = pk2(hv.z, hv.w); o8[lane + 64 * j] = w; }
        }
    }
}

__device__ __forceinline__ void conv16(const LAS unsigned* vt, const float (&w0)[31], const float (&w1)[31], float b0, float b1, float (&o0)[16], float (&o1)[16]) {
#pragma unroll
    for (int t = 0; t < 16; ++t) { o0[t] = b0; o1[t] = b1; }
#pragma unroll
    for (int rr = 0; rr < 46; ++rr) { const unsigned u = vt[rr * 128]; const float lo = bflo(u), hi = bfhi(u);
#pragma unroll
        for (int t = 0; t < 16; ++t) { const int k = rr - t; if (k >= 0 && k < 31) { o0[t] += w0[k] * lo; o1[t] += w1[k] * hi; } }
        if ((rr & 3) == 3) asm volatile("" ::: "memory"); }
}
__device__ __forceinline__ v4u glu8(const v4u vq, const v4u gq) {
    v4u o;
    o.x = pk2(bflo(vq.x) * sigmoidf_(bflo(gq.x)), bfhi(vq.x) * sigmoidf_(bfhi(gq.x)));
    o.y = pk2(bflo(vq.y) * sigmoidf_(bflo(gq.y)), bfhi(vq.y) * sigmoidf_(bfhi(gq.y)));
    o.z = pk2(bflo(vq.z) * sigmoidf_(bflo(gq.z)), bfhi(vq.z) * sigmoidf_(bfhi(gq.z)));
    o.w = pk2(bflo(vq.w) * sigmoidf_(bflo(gq.w)), bfhi(vq.w) * sigmoidf_(bfhi(gq.w)));
    return o;
}
__device__ __forceinline__ void hconv_unit(const Args& a, LAS unsigned char* lds, int l, int r0, int g, int vlo, int vhi, int tid) {
    const bf16* U = (const bf16*)(a.ws + WS_U); bf16* Y = (bf16*)(a.ws + WS_Y);
    LAS unsigned* VT = (LAS unsigned*)lds;
    for (int i = tid; i < 94 * 32; i += NTHR) { const int rr = i >> 5, ch = i & 31, row = r0 - 15 + rr;
        v4u o = {0u, 0u, 0u, 0u};
        if (row >= vlo && row < vhi) { const bf16* up = U + (size_t)row * NIN + g * 256 + ch * 8; o = glu8(*(const v4u*)(up + 1024), *(const v4u*)(up + 1536)); }
        *(LAS v4u*)(VT + rr * 128 + ch * 4) = o; }
    __syncthreads();
    int p = tid & 127; asm volatile("" : "+v"(p));
    const int tg = tid >> 7, c0 = g * 256 + 2 * p;
    float w0[31], w1[31];
#pragma unroll
    for (int k = 0; k < 31; ++k) { const float2 w = *(const float2*)(a.in[I_DWW] + (size_t)(l * 31 + k) * 512 + c0); w0[k] = w.x; w1[k] = w.y; }
    const float2 bb = *(const float2*)(a.in[I_DWB] + l * 512 + c0);
    float o0[16], o1[16];
    conv16(VT + (tg * 16) * 128 + p, w0, w1, bb.x, bb.y, o0, o1);
#pragma unroll
    for (int t = 0; t < 16; ++t) *(unsigned*)(Y + (size_t)(r0 + tg * 16 + t) * 512 + c0) = pk2(o0[t], o1[t]);
    __syncthreads();
}
__device__ __forceinline__ void vconv_unit(const Args& a, LAS unsigned char* lds, int l, int b, int w, int tid) {
    const bf16* U = (const bf16*)(a.ws + WS_U); bf16* Y = (bf16*)(a.ws + WS_Y);
    LAS unsigned* VT = (LAS unsigned*)lds;
    for (int i = tid; i < 158 * 32; i += NTHR) { const int rr = i >> 5, ch = i & 31, gr = rr - 15;
        v4u o = {0u, 0u, 0u, 0u};
        if (gr >= 0 && gr < 128) { const bf16* up = U + (size_t)(b * SEQ + gr * 64 + w) * NIN + 256 + ch * 8; o = glu8(*(const v4u*)(up + 1024), *(const v4u*)(up + 1536)); }
        *(LAS v4u*)(VT + rr * 128 + ch * 4) = o; }
    __syncthreads();
    int p = tid & 127; asm volatile("" : "+v"(p));
    const int tg = tid >> 7, c0 = 256 + 2 * p;
    float w0[31], w1[31];
#pragma unroll
    for (int k = 0; k < 31; ++k) { const float2 wv = *(const float2*)(a.in[I_DWW] + (size_t)(l * 31 + k) * 512 + c0); w0[k] = wv.x; w1[k] = wv.y; }
    const float2 bb = *(const float2*)(a.in[I_DWB] + l * 512 + c0);
#pragma unroll 1
    for (int half = 0; half < 2; ++half) {
        const int tb = tg * 32 + half * 16;
        float o0[16], o1[16];
        conv16(VT + tb * 128 + p, w0, w1, bb.x, bb.y, o0, o1);
#pragma unroll
        for (int t = 0; t < 16; ++t) *(unsigned*)(Y + (size_t)(b * SEQ + (tb + t) * 64 + w) * 512 + c0) = pk2(o0[t], o1[t]);
    }
    __syncthreads();
}
__device__ __forceinline__ void ln_rows(const Args& a, int l, int nrows, int lane, int wave) {
    const bf16* U = (const bf16*)(a.ws + WS_U); const bf16* Y = (const bf16*)(a.ws + WS_Y); bf16* MIXIN = (bf16*)(a.ws + WS_MIXIN);
    const int gw = blockIdx.x * NWAVES + wave, NGW = gridDim.x * NWAVES, c0 = lane * 8;
    float lg[8], lb[8];
#pragma unroll
    for (int e = 0; e < 8; ++e) { lg[e] = a.in[I_LNG][l * 512 + c0 + e]; lb[e] = a.in[I_LNB][l * 512 + c0 + e]; }
    for (int row = gw; row < nrows; row += NGW) {
        const v4u yq = *(const v4u*)(Y + (size_t)row * 512 + c0); const v4u gq = *(const v4u*)(U + (size_t)row * NIN + 2048 + c0);
        float y[8] = {bflo(yq.x), bfhi(yq.x), bflo(yq.y), bfhi(yq.y), bflo(yq.z), bfhi(yq.z), bflo(yq.w), bfhi(yq.w)};
        const float gt[8] = {bflo(gq.x), bfhi(gq.x), bflo(gq.y), bfhi(gq.y), bflo(gq.z), bfhi(gq.z), bflo(gq.w), bfhi(gq.w)};
        float s = 0.f;
#pragma unroll
        for (int e = 0; e < 8; ++e) s += y[e];
        const float mean = wave_sum(s) * (1.0f / 512.0f); float q = 0.f;
#pragma unroll
        for (int e = 0; e < 8; ++e) { y[e] -= mean; q += y[e] * y[e]; }
        const float rstd = rsqrtf(wave_sum(q) * (1.0f / 512.0f) + EPSF);
        float o[8];
#pragma unroll
        for (int e = 0; e < 8; ++e) o[e] = siluf_(y[e] * rstd * lg[e] + lb[e]) * gt[e];
        v4u w; w.x = pk2(o[0], o[1]); w.y = pk2(o[2], o[3]); w.z = pk2(o[4], o[5]); w.w = pk2(o[6], o[7]);
        *(v4u*)(MIXIN + (size_t)row * 1024 + 512 + c0) = w;
    }
}

constexpr int RG_GW = 0, RG_FOLD = 32768, RG_F8 = 36864, RG_CAR = 40960, RG_WAVE = 57344, RG_WAVE_BYTES = 12544;
constexpr int NP16 = 4 * NPJ;
__device__ __forceinline__ float fsig(float x) { return __builtin_amdgcn_rcpf(1.0f + __expf(-x)); }

template <bool FINAL, int D>
__device__ __forceinline__ void rg_sweep(const Args& a, LAS unsigned char* lds, LAS unsigned char* wl, int l, int b, int h, int r0, int seg_lo, int seg_hi, int pj, bool is_ctx, int w, int lane) {
    const bf16* U = (const bf16*)(a.ws + WS_U); bf16* MIXIN = (bf16*)(a.ws + WS_MIXIN);
    float* AGGA = (float*)(a.ws + WS_AGGA); float* AGGB = (float*)(a.ws + WS_AGGB); float* A16 = (float*)(a.ws + WS_A16); float* B16 = (float*)(a.ws + WS_B16);
    LAS float* VCW = (LAS float*)wl; LAS unsigned* HBW = (LAS unsigned*)(wl + 4352);
    const LAS v4u* GWL = (const LAS v4u*)(lds + RG_GW) + (D * 2) * 8 * 64 + lane;
    const LAS float* CAR = (const LAS float*)(lds + RG_CAR);
    const int fr = lane & 15, fq = lane >> 4, cp = lane & 31, rh = lane >> 5;
    float2 cw[4];
#pragma unroll
    for (int k = 0; k < 4; ++k) cw[k] = *(const float2*)(a.in[I_CAW] + (size_t)((l * 2 + D) * 4 + k) * 512 + 64 * h + 2 * cp);
    const float2 cbv = *(const float2*)(a.in[I_CAB] + (l * 2 + D) * 512 + 64 * h + 2 * cp);
    float brv[4], biv[4], sp8[4], Hc[4], Ac[4];
    const int p16own = 4 * pj + (D ? 3 - fq : fq);
#pragma unroll
    for (int ct = 0; ct < 4; ++ct) { const int c = 16 * ct + fr, pidx = (l * 2 + D) * 512 + 64 * h + c;
        brv[ct] = a.in[I_BR][pidx]; biv[ct] = a.in[I_BI][pidx]; sp8[ct] = -8.0f * log1pf(__expf(-a.in[I_LAM][pidx]));
        Hc[ct] = 0.f; Ac[ct] = 1.f;
        if (FINAL) {
            if (is_ctx) { const size_t base = (size_t)((b * 2 + D) * NP16) * 512 + 64 * h + c; float S = 0.f;
                for (int i = 0; i < p16own; ++i) S = A16[base + (size_t)i * 512] * S + B16[base + (size_t)i * 512];
                Hc[ct] = S; }
            else Hc[ct] = CAR[(D * 32 + (D ? 31 - (4 * w + fq) : 4 * w + fq)) * 64 + c];
        } }
    const bf16* ub = U + 64 * h + 2 * cp;
    unsigned Wd[2][7], nx[2][4];
#pragma unroll
    for (int q = 0; q < 2; ++q) { const int g = 2 * rh + q;
#pragma unroll
        for (int j = 0; j < 3; ++j) { const int row = r0 + 16 * g + (D ? 16 + j : j - 3); const bool ok = row >= seg_lo && row < seg_hi; const int rc = ok ? row : r0;
            const unsigned v = *(const unsigned*)(ub + (size_t)rc * NIN); Wd[q][D ? j : 4 + j] = ok ? v : 0u; }
#pragma unroll
        for (int j = 0; j < 4; ++j) nx[q][j] = *(const unsigned*)(ub + (size_t)(r0 + 16 * g + 4 * (D ? 3 : 0) + j) * NIN); }
#pragma unroll 1
    for (int ti = 0; ti < 4; ++ti) {
        const int tile = D ? 3 - ti : ti;
        int zo = 0; asm volatile("" : "+v"(zo));
        const LAS v4u* GWLt = GWL + zo;
        v4u g0 = {0u, 0u, 0u, 0u}, g1 = g0; size_t orow = 0;
        if (FINAL && D == 0) { orow = (size_t)(r0 + 16 * (fr >> 2) + 4 * tile + (fr & 3)); const bf16* gp = U + orow * NIN + 512 + 64 * h + 16 * fq; g0 = *(const v4u*)gp; g1 = *(const v4u*)(gp + 8); }
#pragma unroll
        for (int q = 0; q < 2; ++q) {
            if (D == 0) { Wd[q][0] = Wd[q][4]; Wd[q][1] = Wd[q][5]; Wd[q][2] = Wd[q][6]; Wd[q][3] = nx[q][0]; Wd[q][4] = nx[q][1]; Wd[q][5] = nx[q][2]; Wd[q][6] = nx[q][3]; }
            else { Wd[q][4] = Wd[q][0]; Wd[q][5] = Wd[q][1]; Wd[q][6] = Wd[q][2]; Wd[q][0] = nx[q][0]; Wd[q][1] = nx[q][1]; Wd[q][2] = nx[q][2]; Wd[q][3] = nx[q][3]; } }
        if (ti < 3) { const int tn = D ? 2 - ti : ti + 1;
#pragma unroll
            for (int q = 0; q < 2; ++q)
#pragma unroll
                for (int j = 0; j < 4; ++j) nx[q][j] = *(const unsigned*)(ub + (size_t)(r0 + 16 * (2 * rh + q) + 4 * tn + j) * NIN); }
#pragma unroll
        for (int q = 0; q < 2; ++q)
#pragma unroll
            for (int jj = 0; jj < 4; ++jj) { float v0 = cbv.x, v1 = cbv.y;
#pragma unroll
                for (int k = 0; k < 4; ++k) { const unsigned u = Wd[q][jj + k]; v0 += cw[k].x * bflo(u); v1 += cw[k].y * bfhi(u); }
                *(LAS f32x2v*)(VCW + (4 * (2 * rh + q) + jj) * 68 + 2 * cp) = (f32x2v){v0, v1}; }
        bf16x8 af[2];
#pragma unroll
        for (int kk = 0; kk < 2; ++kk) { const LAS float* vp = VCW + fr * 68 + 32 * kk + 8 * fq; const f32x4 x0 = *(const LAS f32x4*)vp, x1 = *(const LAS f32x4*)(vp + 4);
            v4u pk; pk.x = cvtpk(x0.x, x0.y); pk.y = cvtpk(x0.z, x0.w); pk.z = cvtpk(x1.x, x1.y); pk.w = cvtpk(x1.z, x1.w); af[kk] = __builtin_bit_cast(bf16x8, pk); }
        float vcv[4][4];
#pragma unroll
        for (int ct = 0; ct < 4; ++ct)
#pragma unroll
            for (int jj = 0; jj < 4; ++jj) vcv[ct][jj] = VCW[(4 * fq + jj) * 68 + 16 * ct + fr];
        f32x4 accr[4], acci[4];
#pragma unroll
        for (int ct = 0; ct < 4; ++ct) { accr[ct] = (f32x4){0.f, 0.f, 0.f, 0.f}; acci[ct] = accr[ct];
#pragma unroll
            for (int kk = 0; kk < 2; ++kk) { const bf16x8 br = __builtin_bit_cast(bf16x8, GWLt[(ct * 2 + kk) * 64]), bi = __builtin_bit_cast(bf16x8, GWLt[(8 + ct * 2 + kk) * 64]);
                accr[ct] = __builtin_amdgcn_mfma_f32_16x16x32_bf16(af[kk], br, accr[ct], 0, 0, 0); acci[ct] = __builtin_amdgcn_mfma_f32_16x16x32_bf16(af[kk], bi, acci[ct], 0, 0, 0); } }
        float hsum[4][4];
#pragma unroll
        for (int ct = 0; ct < 4; ++ct) { float aa[4], bb[4];
#pragma unroll
            for (int jj = 0; jj < 4; ++jj) {
                const float r = fsig(accr[ct][jj] + brv[ct]), ig = fsig(acci[ct][jj] + biv[ct]), la = sp8[ct] * r, av = __expf(la), x2 = la + la;
                const float poly = -x2 * (1.0f + x2 * (0.5f + x2 * (0.16666667f + x2 * (0.041666668f + x2 * 0.0083333338f))));
                const float om = (x2 > -0.25f) ? poly : (1.0f - av * av);
                aa[jj] = av; bb[jj] = __builtin_amdgcn_sqrtf(fmaxf(om, 0.f)) * (ig * vcv[ct][jj]); }
            float hh = Hc[ct], A4 = 1.f;
#pragma unroll
            for (int ji = 0; ji < 4; ++ji) { const int jj = D ? 3 - ji : ji; hh = aa[jj] * hh + bb[jj]; A4 *= aa[jj]; hsum[ct][jj] = hh; }
            Hc[ct] = hh; if (!FINAL) Ac[ct] *= A4; }
        if (FINAL) {
            if (D == 1) {
#pragma unroll
                for (int ct = 0; ct < 4; ++ct)
#pragma unroll
                    for (int jp = 0; jp < 2; ++jp) HBW[(tile * 8 + ct * 2 + jp) * 64 + lane] = cvtpk(hsum[ct][2 * jp], hsum[ct][2 * jp + 1]);
            } else {
#pragma unroll
                for (int ct = 0; ct < 4; ++ct)
#pragma unroll
                    for (int jp = 0; jp < 2; ++jp) { const unsigned hb = HBW[(tile * 8 + ct * 2 + jp) * 64 + lane];
                        VCW[(4 * fq + 2 * jp) * 68 + 16 * ct + fr] = hsum[ct][2 * jp] + bflo(hb); VCW[(4 * fq + 2 * jp + 1) * 68 + 16 * ct + fr] = hsum[ct][2 * jp + 1] + bfhi(hb); }
                const size_t row = orow;
                const f32x4 s0 = *(const LAS f32x4*)(VCW + fr * 68 + 16 * fq), s1 = *(const LAS f32x4*)(VCW + fr * 68 + 16 * fq + 4), s2 = *(const LAS f32x4*)(VCW + fr * 68 + 16 * fq + 8), s3 = *(const LAS f32x4*)(VCW + fr * 68 + 16 * fq + 12);
                v4u o0, o1;
                o0.x = cvtpk(s0.x * bflo(g0.x), s0.y * bfhi(g0.x)); o0.y = cvtpk(s0.z * bflo(g0.y), s0.w * bfhi(g0.y)); o0.z = cvtpk(s1.x * bflo(g0.z), s1.y * bfhi(g0.z)); o0.w = cvtpk(s1.z * bflo(g0.w), s1.w * bfhi(g0.w));
                o1.x = cvtpk(s2.x * bflo(g1.x), s2.y * bfhi(g1.x)); o1.y = cvtpk(s2.z * bflo(g1.y), s2.w * bfhi(g1.y)); o1.z = cvtpk(s3.x * bflo(g1.z), s3.y * bfhi(g1.z)); o1.w = cvtpk(s3.z * bflo(g1.w), s3.w * bfhi(g1.w));
                bf16* op = MIXIN + row * 1024 + 64 * h + 16 * fq; *(v4u*)op = o0; *(v4u*)(op + 8) = o1;
            }
        }
    }
    if (!FINAL) {
#pragma unroll
        for (int ct = 0; ct < 4; ++ct) { const int c = 16 * ct + fr;
            const size_t i16 = (size_t)((b * 2 + D) * NP16 + p16own) * 512 + 64 * h + c; A16[i16] = Ac[ct]; B16[i16] = Hc[ct];
            float Ag[4], Bg[4];
#pragma unroll
            for (int g = 0; g < 4; ++g) { Ag[g] = __shfl(Ac[ct], fr + 16 * g); Bg[g] = __shfl(Hc[ct], fr + 16 * g); }
            float run = 0.f;
#pragma unroll
            for (int gi = 0; gi < 4; ++gi) { const int g = D ? 3 - gi : gi; run = Ag[g] * run + Bg[g]; }
            if (fq == 0) { const size_t idx = (size_t)((b * 2 + D) * NPJ + pj) * 512 + 64 * h + c; AGGA[idx] = (Ag[0] * Ag[1]) * (Ag[2] * Ag[3]); AGGB[idx] = run; } }
    }
}

template <bool FINAL>
__device__ __forceinline__ void rg_run(const Args& a, LAS unsigned char* lds, int l, int rn, int tid, int lane, int wave) {
    const bool is_ctx = rn >= 256; const int bh = is_ctx ? rn - 256 : rn >> 4, b = bh >> 3, h = bh & 7, cgp = is_ctx ? 0 : (rn & 15);
    { const v4u* GWF = (const v4u*)(a.ws + WS_GWF); LAS v4u* GWL = (LAS v4u*)(lds + RG_GW);
#pragma unroll
      for (int i = tid; i < 2048; i += NTHR) { const int d = i >> 10, g = (i >> 9) & 1, rest = i & 511; GWL[i] = GWF[(size_t)((((l * 2 + d) * 2 + g) * 8 + h) * 8) * 64 + rest]; } }
    const int P0f = 4 + 8 * cgp, P0b = 124 - 8 * cgp;
    if (FINAL && !is_ctx) {
        const float* AGGA = (const float*)(a.ws + WS_AGGA); const float* AGGB = (const float*)(a.ws + WS_AGGB); const float* A16 = (const float*)(a.ws + WS_A16); const float* B16 = (const float*)(a.ws + WS_B16);
        const int d = tid >> 8, s = (tid >> 6) & 3, c = tid & 63, P0 = d ? P0b : P0f, lo = (P0 * s) >> 2, hi = (P0 * (s + 1)) >> 2;
        const size_t b16 = (size_t)((b * 2 + d) * NP16 + 4 * P0 + 8 * s) * 512 + 64 * h + c; float ai8[8], bi8[8];
#pragma unroll
        for (int i = 0; i < 8; ++i) { ai8[i] = A16[b16 + (size_t)i * 512]; bi8[i] = B16[b16 + (size_t)i * 512]; }
        const size_t base = (size_t)((b * 2 + d) * NPJ) * 512 + 64 * h + c; float A = 1.f, Bv = 0.f;
#pragma unroll 8
        for (int i = lo; i < hi; ++i) { const float ai = AGGA[base + (size_t)i * 512], bi = AGGB[base + (size_t)i * 512]; Bv = ai * Bv + bi; A *= ai; }
        LAS float* FO = (LAS float*)(lds + RG_FOLD); LAS float* F8 = (LAS float*)(lds + RG_F8); LAS float* CAR = (LAS float*)(lds + RG_CAR);
        FO[((d * 4 + s) * 64 + c) * 2] = A; FO[((d * 4 + s) * 64 + c) * 2 + 1] = Bv;
        float A8 = 1.f, B8 = 0.f;
#pragma unroll
        for (int i = 0; i < 8; ++i) { B8 = ai8[i] * B8 + bi8[i]; A8 *= ai8[i]; }
        F8[((d * 4 + s) * 64 + c) * 2] = A8; F8[((d * 4 + s) * 64 + c) * 2 + 1] = B8;
        __syncthreads();
        float S = 0.f;
#pragma unroll
        for (int s2 = 0; s2 < 4; ++s2) S = FO[((d * 4 + s2) * 64 + c) * 2] * S + FO[((d * 4 + s2) * 64 + c) * 2 + 1];
#pragma unroll
        for (int s2 = 0; s2 < 3; ++s2) if (s2 < s) S = F8[((d * 4 + s2) * 64 + c) * 2] * S + F8[((d * 4 + s2) * 64 + c) * 2 + 1];
#pragma unroll
        for (int i = 0; i < 8; ++i) { CAR[(d * 32 + 8 * s + i) * 64 + c] = S; S = ai8[i] * S + bi8[i]; }
    }
    __syncthreads();
    if (wave < (is_ctx ? 4 : 8)) {
        const int j = is_ctx ? wave : 8 * cgp + wave;
        const int seg_lo = is_ctx ? MLAT + b * CTXL : b * SEQ, seg_hi = seg_lo + (is_ctx ? CTXL : SEQ), r0 = seg_lo + 64 * j;
        const int pjf = is_ctx ? j : 4 + j, pjb = is_ctx ? 3 - j : 131 - j;
        LAS unsigned char* wl = lds + RG_WAVE + wave * RG_WAVE_BYTES;
        rg_sweep<FINAL, 1>(a, lds, wl, l, b, h, r0, seg_lo, seg_hi, pjb, is_ctx, wave, lane);
        rg_sweep<FINAL, 0>(a, lds, wl, l, b, h, r0, seg_lo, seg_hi, pjf, is_ctx, wave, lane);
    }
    __syncthreads();
}

#define RLX_AGENT __ATOMIC_RELAXED, __HIP_MEMORY_SCOPE_AGENT


#define XB_TMO      128
#define XB_XCNT(j)  (256  + 64 * (j))
#define XB_XSUB(j)  (1280 + 64 * (j))
#define XB_XGEN(j)  (2304 + 64 * (j))
#define XB_TOP      3328
#define XB_TOPGEN   3392
#define XCD_BAR_WORDS 3456
#define XB_SPIN_CAP (1u << 18)

__device__ __forceinline__ unsigned xb_ld(unsigned* p)              { return __hip_atomic_load(p, __ATOMIC_RELAXED, __HIP_MEMORY_SCOPE_AGENT); }
__device__ __forceinline__ unsigned xb_add(unsigned* p, unsigned v) { return __hip_atomic_fetch_add(p, v, __ATOMIC_RELAXED, __HIP_MEMORY_SCOPE_AGENT); }
__device__ __forceinline__ unsigned xb_xcc_id() { return (unsigned)__builtin_amdgcn_s_getreg((3 << 11) | 20) & 0xFu; }
#define XB_SPIN(cond, bar) do { unsigned _sp = 0; while (cond) { __builtin_amdgcn_s_sleep(1); \
    if ((++_sp & 255u) == 0u) { if (xb_ld(&(bar)[XB_TMO])) break; if (_sp > XB_SPIN_CAP) { atomicAdd(&(bar)[XB_TMO], 1u); break; } } } } while (0)

struct XcdBarrier {
    unsigned* bar; unsigned x;
    volatile LAS unsigned* st;
};

__device__ __forceinline__ XcdBarrier xcd_barrier_post(unsigned* bar, volatile LAS unsigned* st) {
    XcdBarrier b; b.bar = bar; b.x = xb_xcc_id(); b.st = st;
    if (threadIdx.x == 0) (void)xb_add(&bar[XB_XCNT(b.x)], 1u);
    return b;
}
__device__ __forceinline__ void xcd_barrier_complete(unsigned* bar, unsigned x, unsigned& nloc, unsigned& nx) {
    const unsigned G = gridDim.x * gridDim.y * gridDim.z;
    unsigned sum, cnt, mine, sp = 0u;
    for (;;) {
        sum = 0u; cnt = 0u; mine = 0u;
#pragma unroll
        for (unsigned j = 0; j < 16; ++j) { const unsigned c = xb_ld(&bar[XB_XCNT(j)]); sum += c; cnt += (c > 0u) ? 1u : 0u; mine = (j == x) ? c : mine; }
        if (sum == G) break;
        __builtin_amdgcn_s_sleep(1);
        if ((++sp & 255u) == 0u) { if (xb_ld(&bar[XB_TMO])) break; if (sp > XB_SPIN_CAP) { atomicAdd(&bar[XB_TMO], 1u); break; } }
    }
    nloc = mine > 0u ? mine : 1u; nx = cnt > 0u ? cnt : 1u;
}

__device__ __forceinline__ void xcd_barrier(const XcdBarrier& b) {
    asm volatile("s_waitcnt vmcnt(0)" ::: "memory");
    __syncthreads();
    if (threadIdx.x == 0) {
        unsigned* bar = b.bar;
        __builtin_amdgcn_s_waitcnt(0);
        unsigned nloc = b.st[0], nx = b.st[1];
        if (nloc == 0u) { xcd_barrier_complete(bar, b.x, nloc, nx); b.st[0] = nloc; b.st[1] = nx; }
        const unsigned old = xb_add(&bar[XB_XSUB(b.x)], 1u);
        const unsigned gen = old / nloc;
        if (old + 1u == (gen + 1u) * nloc) {
            __builtin_amdgcn_fence(__ATOMIC_RELEASE, "agent");
            asm volatile("s_waitcnt vmcnt(0)" ::: "memory");
            const unsigned og = xb_add(&bar[XB_TOP], 1u);
            const unsigned tg = og / nx;
            if (og + 1u == (tg + 1u) * nx) xb_add(&bar[XB_TOPGEN], 1u);
            else XB_SPIN(xb_ld(&bar[XB_TOPGEN]) == tg, bar);
            __builtin_amdgcn_fence(__ATOMIC_ACQUIRE, "agent");
            xb_add(&bar[XB_XGEN(b.x)], 1u);
            asm volatile("s_waitcnt vmcnt(0)" ::: "memory");
        } else {
            XB_SPIN(xb_ld(&bar[XB_XGEN(b.x)]) == gen, bar);
            __builtin_amdgcn_fence(__ATOMIC_ACQUIRE, "agent");
            asm volatile("s_waitcnt vmcnt(0)" ::: "memory");
        }
    }
    __syncthreads();
}

template <int l>
__device__ __forceinline__ void layer_phases(const Args& args, LAS unsigned char* lds, const int tid, const int lane, const int wave, const int lo, const int hi, const XcdBarrier& xbar) {
    const int G = gridDim.x, bx = blockIdx.x; unsigned char* ws = args.ws;
    constexpr int pb = 1 + 5 * l;
#define IN(k) (lo <= (k) && (k) < hi)
#define SEAM(k) do { if (IN(k) && IN((k) + 1)) { xcd_barrier(xbar); } } while (0)
        if (IN(pb)) { norm_phase(args, l, lane, wave); }
        SEAM(pb);
        if (IN(pb + 1)) {
            pg8::Gemm g{(const pg8::bf16_t*)(ws + WS_H), (const pg8::bf16_t*)(ws + WS_BT1) + (size_t)l * NIN * 1024, MROWS, NIN, 1024};
            pg8::StaticOrder S; S.init(MROWS, NIN, G, bx);
            pg8::EpiU E{(pg8::bf16_t*)(ws + WS_U)};
            pg8::gemm_phase<pg8::EpiU, pg8::StaticOrder, true, true>(lds, g, S, E);
        }
        SEAM(pb + 1);
        if (IN(pb + 2)) {
            rg_run<false>(args, lds, l, bx, tid, lane, wave);
            const int n_h = 256 + (l == 0 ? 16 : 0), n_conv = 128 + n_h;
            for (int un = bx; un < n_conv; un += G) {
                if (un < 128) { vconv_unit(args, lds, l, un >> 6, un & 63, tid); }
                else { const int hu = un - 128;
                    if (hu < 256) hconv_unit(args, lds, l, hu * 64, 0, hu * 64, hu * 64 + 64, tid);
                    else { const int cu = hu - 256, cc = cu >> 1, g = cu & 1, bb = cc >> 2; hconv_unit(args, lds, l, MLAT + cc * 64, g, MLAT + bb * CTXL, MLAT + bb * CTXL + CTXL, tid); } }
            }
            if (bx >= G - 16) rg_run<false>(args, lds, l, 256 + (G - 1 - bx), tid, lane, wave);
        }
        SEAM(pb + 2);
        if (IN(pb + 3)) {
            rg_run<true>(args, lds, l, bx, tid, lane, wave);
            if (l == 0 && bx >= G - 16) rg_run<true>(args, lds, l, 256 + (G - 1 - bx), tid, lane, wave);
            ln_rows(args, l, (l == 0) ? MROWS : MLAT, lane, wave);
        }
        SEAM(pb + 3);
        if (IN(pb + 4)) {
            const int M2 = (l == 0) ? MROWS : MLAT;
            pg8::Gemm g{(const pg8::bf16_t*)(ws + WS_MIXIN), (const pg8::bf16_t*)(ws + WS_BT2) + (size_t)l * 1024 * 1024, M2, 1024, 1024};
            pg8::StaticOrder S; S.init(M2, 1024, G, bx);
            pg8::EpiMix E{(pg8::bf16_t*)(ws + WS_MIX), (float*)(ws + WS_SSQ)};
            pg8::gemm_phase<pg8::EpiMix, pg8::StaticOrder, true, true>(lds, g, S, E);
        }
        SEAM(pb + 4);
#undef IN
#undef SEAM
}

__global__ void __launch_bounds__(NTHR, 2) fwd_megakernel(Args args) {
    extern __shared__ __attribute__((aligned(16))) unsigned char lds_raw[];
    LAS unsigned char* lds = (LAS unsigned char*)lds_raw;
    const int tid = threadIdx.x, lane = tid & 63, wave = __builtin_amdgcn_readfirstlane(tid >> 6);
    const int G = gridDim.x, bx = blockIdx.x;
    unsigned char* ws = args.ws;
    const int lo = args.ph_lo, hi = args.ph_hi;
    if (args.coop == 2) cg::this_grid().sync();
    volatile LAS unsigned* MISC = (volatile LAS unsigned*)(lds + MISC_OFF);
    if (tid < 64) MISC[tid] = 0u;
    __syncthreads();
    XcdBarrier xbar; xbar.bar = (unsigned*)(ws + WS_CTL); xbar.x = 0; xbar.st = nullptr;
    if (args.coop == 1) xbar = xcd_barrier_post((unsigned*)(ws + WS_CTL), MISC + 8);
#define IN(k) (lo <= (k) && (k) < hi)
#define SEAM(k) do { if (IN(k) && IN((k) + 1)) { xcd_barrier(xbar); } } while (0)

    if (IN(0)) { p0_prologue(args, lds, tid, lane, wave); }
    SEAM(0);
    layer_phases<0>(args, lds, tid, lane, wave, lo, hi, xbar);
    layer_phases<1>(args, lds, tid, lane, wave, lo, hi, xbar);
    if (IN(11)) { norm_phase(args, 2, lane, wave); }
#undef IN
#undef SEAM
}

#ifndef MK_PER_PHASE
#define MK_PER_PHASE 0
#endif
extern "C" void kernel_launch(void* const* d_in, const int* in_sizes, int n_in, void* d_out, int out_size, void* d_ws, size_t ws_size, hipStream_t stream) {
    static int grid = 0;
    if (grid == 0) {
        if (n_in != 21 || out_size != MLAT * DM || ws_size < WS_END) { fprintf(stderr, "kernel_launch: unexpected shapes (n_in %d, out %d, ws %zu)\n", n_in, out_size, ws_size); grid = -1; return; }
        int dev = 0, cus = 0, per_cu = 0;
        if (hipGetDevice(&dev) != hipSuccess || hipDeviceGetAttribute(&cus, hipDeviceAttributeMultiprocessorCount, dev) != hipSuccess) { grid = -1; return; }
        if (hipFuncSetAttribute((const void*)fwd_megakernel, hipFuncAttributeMaxDynamicSharedMemorySize, LDS_BYTES) != hipSuccess) { fprintf(stderr, "kernel_launch: hipFuncSetAttribute failed\n"); grid = -1; return; }
        if (hipOccupancyMaxActiveBlocksPerMultiprocessor(&per_cu, (const void*)fwd_megakernel, NTHR, LDS_BYTES) != hipSuccess || per_cu < 1) { fprintf(stderr, "kernel_launch: occupancy query says %d\n", per_cu); per_cu = 1; }
        (void)hipGetLastError();
        grid = cus;
    }
    if (grid < 0) return;
    if (hipMemsetAsync((char*)d_ws + WS_CTL, 0, CTL_ZERO_BYTES, stream) != hipSuccess) { fprintf(stderr, "kernel_launch: memset failed\n"); return; }
    Args a{};
    for (int i = 0; i < 21; ++i) a.in[i] = (const float*)d_in[i];
    a.out = (float*)d_out; a.ws = (unsigned char*)d_ws;
#if MK_PER_PHASE
    for (int ph = 0; ph < 12; ++ph) { a.ph_lo = ph; a.ph_hi = ph + 1; a.coop = 0;
        hipLaunchKernelGGL(fwd_megakernel, dim3(grid), dim3(NTHR), LDS_BYTES, stream, a); }
#else
    a.ph_lo = 0; a.ph_hi = 12; a.coop = 1;
    void* kargs[] = {&a};
    hipError_t e = hipLaunchCooperativeKernel((const void*)fwd_megakernel, dim3(grid), dim3(NTHR), kargs, LDS_BYTES, stream);
    if (e != hipSuccess) fprintf(stderr, "cooperative launch failed: %s (grid %d)\n", hipGetErrorString(e), grid);
#endif
}
```

```cpp
#include <hip/hip_runtime.h>
#include <hip/hip_cooperative_groups.h>
#include <cstdio>
#include <cstdint>
namespace cg = cooperative_groups;
#define MK_PER_PHASE 0
namespace pg8 {
#define PG8_LAS __attribute__((address_space(3)))
typedef unsigned short bf16_t;
typedef short bf16x8 __attribute__((ext_vector_type(8)));
typedef float f32x4 __attribute__((ext_vector_type(4)));
typedef unsigned u32x4 __attribute__((ext_vector_type(4)));
constexpr int BM = 256, BK = 64, HALF = 128, HTB = HALF * BK * 2  , STAGE_BYTES = 8 * HTB, NXCD = 8, WGM = 8;

__host__ __device__ __forceinline__ int lds_byte(int r, int c) { const int st = (r >> 4) * 2 + (c >> 5), rr = r & 15, cc = c & 31, ob = rr * 64 + cc * 2; return st * 1024 + (ob ^ (((ob >> 9) & 1) << 5)); }
__host__ __device__ __forceinline__ void stage_rc(int b, int& R, int& C) { const int st = b / 1024, sb = b % 1024, swz = sb ^ (((sb >> 9) & 1) << 5); R = (st >> 1) * 16 + swz / 64; C = (st & 1) * 32 + (swz % 64) / 2; }
__host__ __device__ __forceinline__ int perm32(int rho) { const int n = rho >> 4, i = rho & 15; return 8 * (i >> 2) + 4 * n + (i & 3); }

struct Unit { int pm, pn; };
struct Gemm { const bf16_t* A; const bf16_t* Bt; int M, N, K; };

struct StaticOrder {
    int nM, nN, nwg, G, c;
    __host__ __device__ void init(int M, int N, int G_, int c_) { nM = M / BM; nN = N / BM; nwg = nM * nN; G = G_; c = c_; }
    __host__ __device__ bool next(int i, Unit& u) const {
        const long L = (long)i * G + c; if (L >= nwg) return false;
        int wgid = (int)L; { const int q = nwg / NXCD, r = nwg % NXCD, xcd = wgid % NXCD, off = wgid / NXCD; wgid = (xcd < r ? xcd * (q + 1) : r * (q + 1) + (xcd - r) * q) + off; }
        const int nig = WGM * nN, gid = wgid / nig, fm = gid * WGM, gsz = (nM - fm) < WGM ? (nM - fm) : WGM;
        u.pm = fm + ((wgid % nig) % gsz); u.pn = (wgid % nig) / gsz; return true;
    }
    __device__ __forceinline__ void a_ready(const Unit&) const {}
    __device__ __forceinline__ void done(const Unit&) const {}
};
__device__ __forceinline__ unsigned cvt_pk_bf16(float lo, float hi) { unsigned r; asm volatile("v_cvt_pk_bf16_f32 %0, %1, %2" : "=v"(r) : "v"(lo), "v"(hi)); return r; }
typedef float f32x2 __attribute__((ext_vector_type(2)));
template <class Epi, class Sched, bool ALIGN_EPI = false, bool SP2 = false>
__device__ __forceinline__ void gemm_phase(PG8_LAS unsigned char* lds, const Gemm g, const Sched& S, const Epi& E) {
    const int tid = threadIdx.x, wid = __builtin_amdgcn_readfirstlane(tid >> 6), lane = tid & 63, wr = wid >> 2, wc = wid & 3, fr = lane & 15, fq = lane >> 4;
    const int K = g.K, nt = K / BK;
    unsigned voffA[2], voffB[2];
#pragma unroll
    for (int i = 0; i < 2; ++i) { int R, C; stage_rc(tid * 16 + i * 8192, R, C); const int Rb = Epi::PERM ? ((R & ~31) + perm32(R & 31)) : R;
        voffA[i] = (unsigned)(R * K + C) * 2u; voffB[i] = (unsigned)(Rb * K + C) * 2u; }
    const size_t kstep = (size_t)(BK * 2);
    const size_t hstep = (size_t)HALF * K * 2;
    const size_t tstep = 2 * hstep;
    const unsigned ldsw = (unsigned)wid * 1024u;
    const int aoff = lds_byte(wr * 64 + fr, fq * 8), boff = lds_byte(wc * 32 + fr, fq * 8);
#define PG8_SA(b, h) (((b) * 2 + (h)) * HTB)
#define PG8_SB(b, h) ((4 + (b) * 2 + (h)) * HTB)
#define PG8_STAGE(bufoff, gbase, voff) do { _Pragma("unroll") for (int _i = 0; _i < 2; ++_i) \
        __builtin_amdgcn_global_load_lds((const unsigned*)((const char*)(gbase) + (voff)[_i]), (PG8_LAS unsigned*)(lds + (bufoff) + ldsw + _i * 8192), 16, 0, 0); } while (0)
#define PG8_LDA(dst, b, h) do { _Pragma("unroll") for (int m = 0; m < 4; ++m) _Pragma("unroll") for (int k = 0; k < 2; ++k) dst[m][k] = *(const PG8_LAS bf16x8*)(lds + PG8_SA(b, h) + aoff + m * 2048 + k * 1024); } while (0)
#define PG8_LDB(dst, b, h) do { _Pragma("unroll") for (int n = 0; n < 2; ++n) _Pragma("unroll") for (int k = 0; k < 2; ++k) dst[n][k] = *(const PG8_LAS bf16x8*)(lds + PG8_SB(b, h) + boff + n * 2048 + k * 1024); } while (0)
#define PG8_MMA(ai, bj, At, Bt) do { __builtin_amdgcn_s_setprio(1); _Pragma("unroll") for (int m = 0; m < 4; ++m) _Pragma("unroll") for (int n = 0; n < 2; ++n) _Pragma("unroll") for (int k = 0; k < 2; ++k) \
        acc[ai][bj][m][n] = __builtin_amdgcn_mfma_f32_16x16x32_bf16(Bt[n][k], At[m][k], acc[ai][bj][m][n], 0, 0, 0); __builtin_amdgcn_s_setprio(0); } while (0)
#define PG8_WAIT_V(n) asm volatile("s_waitcnt vmcnt(" #n ")" ::: "memory")
#define PG8_WAIT_L(n) asm volatile("s_waitcnt lgkmcnt(" #n ")" ::: "memory")
#define PG8_BAR __builtin_amdgcn_s_barrier()
#define PG8_SCHED __builtin_amdgcn_sched_barrier(0)
    Unit cur, nxt; int ui = 0;
    if (!S.next(0, cur)) return;
    f32x4 acc[2][2][4][2];
#pragma unroll
    for (int a = 0; a < 2; ++a)
#pragma unroll
        for (int b = 0; b < 2; ++b)
#pragma unroll
            for (int m = 0; m < 4; ++m)
#pragma unroll
                for (int n = 0; n < 2; ++n) acc[a][b][m][n] = (f32x4){0.f, 0.f, 0.f, 0.f};
    bf16x8 At[4][2], B0[2][2], B1[2][2];
    const char* cA = (const char*)g.A + (size_t)cur.pm * tstep; const char* cB = (const char*)g.Bt + (size_t)cur.pn * tstep;
    S.a_ready(cur);
    if constexpr (SP2) {
        PG8_STAGE(PG8_SB(0, 0), cB, voffB); PG8_STAGE(PG8_SB(0, 1), cB + hstep, voffB); PG8_STAGE(PG8_SA(0, 0), cA, voffA); PG8_STAGE(PG8_SA(0, 1), cA + hstep, voffA);
        if (wr == 1) PG8_BAR;
        PG8_WAIT_V(2); PG8_BAR;
        PG8_STAGE(PG8_SB(1, 0), cB + kstep, voffB); PG8_STAGE(PG8_SA(1, 0), cA + kstep, voffA); PG8_STAGE(PG8_SB(1, 1), cB + hstep + kstep, voffB);
        PG8_WAIT_V(6); PG8_BAR;
    } else {
        PG8_STAGE(PG8_SB(0, 0), cB, voffB); PG8_STAGE(PG8_SA(0, 0), cA, voffA); PG8_STAGE(PG8_SB(0, 1), cB + hstep, voffB); PG8_STAGE(PG8_SA(0, 1), cA + hstep, voffA);
        if (wr == 1) PG8_BAR;
        PG8_WAIT_V(4); PG8_BAR;
        PG8_STAGE(PG8_SB(1, 0), cB + kstep, voffB); PG8_STAGE(PG8_SA(1, 0), cA + kstep, voffA); PG8_STAGE(PG8_SB(1, 1), cB + hstep + kstep, voffB);
        PG8_WAIT_V(6); PG8_BAR;
    }
    for (;;) {
        const bool has_next = S.next(ui + 1, nxt);
        const char* nA = has_next ? (const char*)g.A + (size_t)nxt.pm * tstep : cA; const char* nB = has_next ? (const char*)g.Bt + (size_t)nxt.pn * tstep : cB;
        for (int t = 0; t < nt; t += 2) {
            const bool last = (t == nt - 2);
            const char* a1 = cA + (size_t)(t + 1) * kstep;
            const char* a2 = last ? nA : cA + (size_t)(t + 2) * kstep; const char* b2 = last ? nB : cB + (size_t)(t + 2) * kstep;
            const char* a3 = a2 + kstep; const char* b3 = b2 + kstep;
            if (last && has_next) S.a_ready(nxt);
            if constexpr (SP2) {
            PG8_LDB(B0, 0, 0); PG8_LDB(B1, 0, 1); PG8_SCHED; PG8_LDA(At, 0, 0); PG8_STAGE(PG8_SA(1, 1), a1 + hstep, voffA);
            PG8_WAIT_V(8); PG8_WAIT_L(0); PG8_BAR; PG8_MMA(0, 0, At, B0); PG8_MMA(0, 1, At, B1); PG8_BAR; PG8_SCHED;
            PG8_LDA(At, 0, 1); PG8_STAGE(PG8_SB(0, 0), b2, voffB); PG8_STAGE(PG8_SB(0, 1), b2 + hstep, voffB); PG8_STAGE(PG8_SA(0, 0), a2, voffA);
            PG8_WAIT_V(8); PG8_WAIT_L(0); PG8_BAR; PG8_MMA(1, 0, At, B0); PG8_MMA(1, 1, At, B1); PG8_BAR; PG8_SCHED;
            PG8_LDB(B0, 1, 0); PG8_LDB(B1, 1, 1); PG8_SCHED; PG8_LDA(At, 1, 0); PG8_STAGE(PG8_SA(0, 1), a2 + hstep, voffA);
            PG8_WAIT_V(8); PG8_WAIT_L(0); PG8_BAR; PG8_MMA(0, 0, At, B0); PG8_MMA(0, 1, At, B1); PG8_BAR; PG8_SCHED;
            PG8_LDA(At, 1, 1); PG8_STAGE(PG8_SB(1, 0), b3, voffB); PG8_STAGE(PG8_SB(1, 1), b3 + hstep, voffB); PG8_STAGE(PG8_SA(1, 0), a3, voffA);
            PG8_WAIT_V(8); PG8_WAIT_L(0); PG8_BAR; PG8_MMA(1, 0, At, B0); PG8_MMA(1, 1, At, B1); PG8_BAR; PG8_SCHED;
            } else {
            PG8_LDB(B0, 0, 0); PG8_SCHED; PG8_LDA(At, 0, 0); PG8_STAGE(PG8_SA(1, 1), a1 + hstep, voffA);
            PG8_WAIT_L(8); PG8_BAR; PG8_WAIT_L(0); PG8_MMA(0, 0, At, B0); PG8_BAR; PG8_SCHED;
            PG8_LDB(B1, 0, 1); PG8_STAGE(PG8_SB(0, 0), b2, voffB);
            PG8_BAR; PG8_WAIT_L(0); PG8_MMA(0, 1, At, B1); PG8_BAR;
            PG8_LDA(At, 0, 1); PG8_STAGE(PG8_SA(0, 0), a2, voffA);
            PG8_BAR; PG8_WAIT_L(0); PG8_MMA(1, 0, At, B0); PG8_BAR; PG8_SCHED;
            PG8_STAGE(PG8_SB(0, 1), b2 + hstep, voffB);
            PG8_WAIT_V(6); PG8_BAR; PG8_MMA(1, 1, At, B1); PG8_BAR;
            PG8_LDB(B0, 1, 0); PG8_SCHED; PG8_LDA(At, 1, 0); PG8_STAGE(PG8_SA(0, 1), a2 + hstep, voffA);
            PG8_WAIT_L(8); PG8_BAR; PG8_WAIT_L(0); PG8_MMA(0, 0, At, B0); PG8_BAR; PG8_SCHED;
            PG8_LDB(B1, 1, 1); PG8_STAGE(PG8_SB(1, 0), b3, voffB);
            PG8_BAR; PG8_WAIT_L(0); PG8_MMA(0, 1, At, B1); PG8_BAR;
            PG8_LDA(At, 1, 1); PG8_STAGE(PG8_SA(1, 0), a3, voffA);
            PG8_BAR; PG8_WAIT_L(0); PG8_MMA(1, 0, At, B0); PG8_BAR; PG8_SCHED;
            PG8_STAGE(PG8_SB(1, 1), b3 + hstep, voffB);
            PG8_WAIT_V(6); PG8_BAR; PG8_MMA(1, 1, At, B1); PG8_BAR;
            }
        }
        if constexpr (ALIGN_EPI) { if (wr == 0) PG8_BAR; }
        if constexpr (!Epi::AFTER_DRAIN) { E(acc, cur, wr, wc, fr, fq); S.done(cur); }
        if (!has_next) break;
#pragma unroll
        for (int a = 0; a < 2; ++a)
#pragma unroll
            for (int b = 0; b < 2; ++b)
#pragma unroll
                for (int m = 0; m < 4; ++m)
#pragma unroll
                    for (int n = 0; n < 2; ++n) acc[a][b][m][n] = (f32x4){0.f, 0.f, 0.f, 0.f};
        cur = nxt; cA = nA; cB = nB; ++ui;
        if constexpr (ALIGN_EPI) { if (wr == 1) PG8_BAR; }
    }
    PG8_WAIT_V(0);
    if constexpr (!ALIGN_EPI) { if (wr == 0) PG8_BAR; }
    PG8_BAR;
    if constexpr (Epi::AFTER_DRAIN) { E.fused(acc, cur, wr, wc, fr, fq, lds, wid, lane); S.done(cur); }
#undef PG8_SA
#undef PG8_SB
#undef PG8_STAGE
#undef PG8_LDA
#undef PG8_LDB
#undef PG8_MMA
#undef PG8_WAIT_V
#undef PG8_WAIT_L
#undef PG8_BAR
#undef PG8_SCHED
}
}

constexpr int DM = 1024, NB = 2, SEQ = 8192, CTXL = 256, MLAT = NB * SEQ, MCTX = NB * CTXL, MROWS = MLAT + MCTX;
constexpr int NIN = 2560, NCHUNK = MROWS / 64  , NPJ = 132  ;
constexpr float EPSF = 1e-6f;
constexpr int NWAVES = 8, NTHR = 512;

constexpr size_t MiB = 1u << 20;
constexpr size_t WS_CTL = 0, CTL_ZERO_BYTES = 64 * 1024;
constexpr size_t WS_MOD = 1 * MiB;
constexpr size_t WS_GWF = 1 * MiB + 256 * 1024;
constexpr size_t WS_BT1 = 2 * MiB;
constexpr size_t WS_BT2 = 12 * MiB;
constexpr size_t WS_AGGA = 16 * MiB;
constexpr size_t WS_AGGB = 16 * MiB + 1536 * 1024;
constexpr size_t WS_SSQ = 19 * MiB;
constexpr size_t WS_XC1 = 21 * MiB;
constexpr size_t WS_A16 = 23 * MiB;
constexpr size_t WS_B16 = 28 * MiB;
constexpr size_t WS_H = 73 * MiB;
constexpr size_t WS_Y = 56 * MiB;
constexpr size_t WS_MIXIN = 73 * MiB;
constexpr size_t WS_U = 106 * MiB;
constexpr size_t WS_MIX = 189 * MiB;
constexpr size_t WS_END = 255 * MiB;

constexpr int LDS_BYTES = 158720;
constexpr int MISC_OFF = 157696;

#define LAS __attribute__((address_space(3)))
typedef unsigned short bf16;
typedef unsigned v4u __attribute__((ext_vector_type(4)));
typedef unsigned v2u __attribute__((ext_vector_type(2)));
typedef float f32x4 __attribute__((ext_vector_type(4)));
typedef short bf16x8 __attribute__((ext_vector_type(8)));
typedef float f32x2v __attribute__((ext_vector_type(2)));
#define LDS_WAIT() asm volatile("s_waitcnt lgkmcnt(0)" ::: "memory")

__device__ __forceinline__ unsigned f2bf(float f) { unsigned u = __builtin_bit_cast(unsigned, f); return (u + 0x7fffu + ((u >> 16) & 1u)) >> 16; }
__device__ __forceinline__ unsigned pk2(float lo, float hi) { return f2bf(lo) | (f2bf(hi) << 16); }
__device__ __forceinline__ unsigned cvtpk(float lo, float hi) { unsigned r; asm volatile("v_cvt_pk_bf16_f32 %0, %1, %2" : "=v"(r) : "v"(lo), "v"(hi)); return r; }
__device__ __forceinline__ float bflo(unsigned u) { return __builtin_bit_cast(float, u << 16); }
__device__ __forceinline__ float bfhi(unsigned u) { return __builtin_bit_cast(float, u & 0xffff0000u); }
__device__ __forceinline__ float sigmoidf_(float x) { return 1.0f / (1.0f + __expf(-x)); }
__device__ __forceinline__ float siluf_(float x) { return x / (1.0f + __expf(-x)); }
__device__ __forceinline__ float wave_sum(float v) {
#pragma unroll
    for (int o = 1; o < 64; o <<= 1) v += __shfl_xor(v, o);
    return v;
}

struct Args {
    const float* in[21]; float* out; unsigned char* ws; int ph_lo, ph_hi, coop, pad;
};
enum { I_X = 0, I_C, I_CTX, I_CCTX, I_WMOD, I_BMOD, I_GPRE, I_GPOST, I_WIN, I_CAW, I_CAB, I_WR, I_BR, I_WI, I_BI, I_LAM, I_DWW, I_DWB, I_LNG, I_LNB, I_WOUT };

namespace pg8 {
struct EpiU {
    static constexpr bool PERM = true, AFTER_DRAIN = false;
    bf16_t* O;
    __device__ __forceinline__ void operator()(const f32x4 (&acc)[2][2][4][2], const Unit& u, int wr, int wc, int fr, int fq) const {
        const int row0 = u.pm * BM + wr * 64 + fr, col0 = u.pn * BM + wc * 32 + 8 * fq;
        const bool act = (u.pn == 2 || u.pn == 3 || u.pn >= 8);
#pragma unroll
        for (int ai = 0; ai < 2; ++ai)
#pragma unroll
            for (int m = 0; m < 4; ++m) { bf16_t* rowp = O + (size_t)(row0 + ai * HALF + m * 16) * 2560 + col0;
#pragma unroll
                for (int bj = 0; bj < 2; ++bj) { f32x4 v0 = acc[ai][bj][m][0], v1 = acc[ai][bj][m][1];
                    if (act) {
#pragma unroll
                        for (int e = 0; e < 4; ++e) { v0[e] = v0[e] / (1.0f + __expf(-v0[e])); v1[e] = v1[e] / (1.0f + __expf(-v1[e])); }
                    }
                    u32x4 w; w.x = cvt_pk_bf16(v0[0], v0[1]); w.y = cvt_pk_bf16(v0[2], v0[3]); w.z = cvt_pk_bf16(v1[0], v1[1]); w.w = cvt_pk_bf16(v1[2], v1[3]);
                    *(u32x4*)(rowp + bj * HALF) = w; } }
    }
};
struct EpiMix {
    static constexpr bool PERM = true, AFTER_DRAIN = false;
    bf16_t* O; float* ssq;
    __device__ __forceinline__ void operator()(const f32x4 (&acc)[2][2][4][2], const Unit& u, int wr, int wc, int fr, int fq) const {
        const int col0 = u.pn * BM + wc * 32 + 8 * fq;
#pragma unroll
        for (int ai = 0; ai < 2; ++ai)
#pragma unroll
            for (int m = 0; m < 4; ++m) { const int r = u.pm * BM + ai * HALF + wr * 64 + m * 16 + fr; bf16_t* rowp = O + (size_t)r * 1024 + col0; float s = 0.f;
#pragma unroll
                for (int bj = 0; bj < 2; ++bj) { const f32x4 v0 = acc[ai][bj][m][0], v1 = acc[ai][bj][m][1];
                    s += ((v0[0] * v0[0] + v0[1] * v0[1]) + (v0[2] * v0[2] + v0[3] * v0[3])) + ((v1[0] * v1[0] + v1[1] * v1[1]) + (v1[2] * v1[2] + v1[3] * v1[3]));
                    u32x4 w; w.x = cvt_pk_bf16(v0[0], v0[1]); w.y = cvt_pk_bf16(v0[2], v0[3]); w.z = cvt_pk_bf16(v1[0], v1[1]); w.w = cvt_pk_bf16(v1[2], v1[3]);
                    *(u32x4*)(rowp + bj * HALF) = w; }
                s += __shfl_xor(s, 16); s += __shfl_xor(s, 32);
                if (fq == 0) ssq[(size_t)r * 16 + u.pn * 4 + wc] = s; }
    }
};
}

__device__ __forceinline__ void p0_transpose_item(const float* W, int K, int N, bf16* WT, LAS float* scr, int item, int lane) {
    const int nblk = N / 32, kb = item / nblk, nb = item % nblk, k0 = 64 * kb, n0 = 32 * nb;
#pragma unroll 8
    for (int i = 0; i < 32; ++i) { const int kk = 2 * i + (lane >> 5); scr[kk * 33 + (lane & 31)] = W[(size_t)(k0 + kk) * N + n0 + (lane & 31)]; }
    LDS_WAIT(); asm volatile("" ::: "memory");
    const int c = lane & 7;
#pragma unroll
    for (int j = 0; j < 4; ++j) { const int n = (lane >> 3) + 8 * j; const LAS float* s = scr + (8 * c) * 33 + n;
        v4u o; o.x = pk2(s[0 * 33], s[1 * 33]); o.y = pk2(s[2 * 33], s[3 * 33]); o.z = pk2(s[4 * 33], s[5 * 33]); o.w = pk2(s[6 * 33], s[7 * 33]);
        *(v4u*)(WT + (size_t)(n0 + n) * K + k0 + 8 * c) = o; }
    LDS_WAIT(); asm volatile("" ::: "memory");
}

__device__ __forceinline__ void p0_prologue(const Args& a, LAS unsigned char* lds, int tid, int lane, int wave) {
    const int G = gridDim.x, bx = blockIdx.x;
    unsigned char* ws = a.ws;
    {
        LAS float* part = (LAS float*)lds;
        float* MOD = (float*)(ws + WS_MOD);
        const float* c = a.in[I_C]; const float* cctx = a.in[I_CCTX];
        for (int un = bx; un < 192; un += G) {
            const int l = un / 96, n0 = (un % 96) * 32, cq = tid & 7, ks = tid >> 3;
            const float* wm = a.in[I_WMOD] + (size_t)l * 1024 * 3072 + n0 + cq * 4;
            f32x4 acc0 = {0.f, 0.f, 0.f, 0.f}, acc1 = acc0, acc2 = acc0;
#pragma unroll 4
            for (int kk = 0; kk < 16; ++kk) { const int k = ks * 16 + kk; const f32x4 w = *(const f32x4*)(wm + (size_t)k * 3072);
                const float a0 = siluf_(c[k]), a1 = siluf_(c[1024 + k]), a2 = siluf_(cctx[k]);
                acc0 += w * a0; acc1 += w * a1; acc2 += w * a2; }
            *(LAS f32x4*)(part + (0 * 64 + ks) * 32 + cq * 4) = acc0;
            *(LAS f32x4*)(part + (1 * 64 + ks) * 32 + cq * 4) = acc1;
            *(LAS f32x4*)(part + (2 * 64 + ks) * 32 + cq * 4) = acc2;
            __syncthreads();
            if (tid < 96) { const int v = tid >> 5, col = tid & 31; float s = a.in[I_BMOD][l * 3072 + n0 + col];
                for (int k2 = 0; k2 < 64; ++k2) s += part[(v * 64 + k2) * 32 + col];
                MOD[(l * 3 + v) * 3072 + n0 + col] = s; }
            __syncthreads();
        }
    }
    {
        v4u* GWF = (v4u*)(ws + WS_GWF);
        for (int idx = bx * NTHR + tid; idx < 32768; idx += G * NTHR) {
            const int ln = idx & 63, kk = (idx >> 6) & 1, ct = (idx >> 7) & 3, h = (idx >> 9) & 7, g = (idx >> 12) & 1, d = (idx >> 13) & 1, l = idx >> 14;
            const float* W = (g == 0 ? a.in[I_WR] : a.in[I_WI]) + (size_t)(((l * 2 + d) * 8 + h) * 64) * 64;
            const int k0 = 32 * kk + 8 * (ln >> 4), col = 16 * ct + (ln & 15);
            float e[8];
#pragma unroll
            for (int j = 0; j < 8; ++j) e[j] = W[(k0 + j) * 64 + col];
            v4u o; o.x = pk2(e[0], e[1]); o.y = pk2(e[2], e[3]); o.z = pk2(e[4], e[5]); o.w = pk2(e[6], e[7]);
            GWF[idx] = o;
        }
    }
    {
        LAS float* scr = (LAS float*)(lds + wave * 16384);
        const int gw = bx * NWAVES + wave, NGW = G * NWAVES;
        constexpr int I_1 = (1024 / 64) * (NIN / 32), I_2 = (1024 / 64) * (1024 / 32), NITEMS = 2 * (I_1 + I_2);
        bf16* BT1 = (bf16*)(ws + WS_BT1); bf16* BT2 = (bf16*)(ws + WS_BT2);
        for (int it = gw; it < NITEMS; it += NGW) {
            int r = it;
            if (r < I_1) { p0_transpose_item(a.in[I_WIN], 1024, NIN, BT1, scr, r, lane); continue; } r -= I_1;
            if (r < I_1) { p0_transpose_item(a.in[I_WIN] + (size_t)1024 * NIN, 1024, NIN, BT1 + (size_t)NIN * 1024, scr, r, lane); continue; } r -= I_1;
            if (r < I_2) { p0_transpose_item(a.in[I_WOUT], 1024, 1024, BT2, scr, r, lane); continue; } r -= I_2;
            p0_transpose_item(a.in[I_WOUT] + (size_t)1024 * 1024, 1024, 1024, BT2 + (size_t)1024 * 1024, scr, r, lane);
        }
    }
}

__device__ __forceinline__ void norm_phase(const Args& a, int mode, int lane, int wave) {
    unsigned char* ws = a.ws;
    const float* MOD = (const float*)(ws + WS_MOD); const bf16* MIX = (const bf16*)(ws + WS_MIX); const float* SSQ = (const float*)(ws + WS_SSQ);
    float* XC1 = (float*)(ws + WS_XC1); bf16* H = (bf16*)(ws + WS_H);
    const int gw = blockIdx.x * NWAVES + wave, NGW = gridDim.x * NWAVES;
    const int nrows = (mode == 2) ? MLAT : MROWS, lu = (mode == 1) ? 0 : 1, ln = (mode == 0) ? 0 : 1;
    for (int row = gw; row < nrows; row += NGW) {
        const int vsel = row < MLAT ? (row >> 13) : 2;
        const float* src;
        if (mode == 2) src = a.out + (size_t)row * 1024;
        else src = row < MLAT ? a.in[I_X] + (size_t)row * 1024 : a.in[I_CTX] + (size_t)(row - MLAT) * 1024;
        f32x4 v[4];
#pragma unroll
        for (int j = 0; j < 4; ++j) v[j] = *((const f32x4*)src + lane + 64 * j);
        if (mode >= 1) {
            const float sp = lane < 16 ? SSQ[(size_t)row * 16 + lane] : 0.f;
            const float rstd = rsqrtf(wave_sum(sp) * (1.0f / 1024.0f) + EPSF);
            const float* gate = MOD + (lu * 3 + vsel) * 3072 + 2048; const float* gp = a.in[I_GPOST] + lu * 1024;
#pragma unroll
            for (int j = 0; j < 4; ++j) { const v2u mq = *((const v2u*)(MIX + (size_t)row * 1024) + lane + 64 * j); const f32x4 mx = {bflo(mq.x), bfhi(mq.x), bflo(mq.y), bfhi(mq.y)};
                const f32x4 gt = *((const f32x4*)gate + lane + 64 * j), gv = *((const f32x4*)gp + lane + 64 * j);
                v[j] += gt * (mx * rstd * gv); }
            float* dst = row < MLAT ? a.out + (size_t)row * 1024 : XC1 + (size_t)(row - MLAT) * 1024;
#pragma unroll
            for (int j = 0; j < 4; ++j) *((f32x4*)dst + lane + 64 * j) = v[j];
        }
        if (mode <= 1) {
            float s = 0.f;
#pragma unroll
            for (int j = 0; j < 4; ++j) s += (v[j].x * v[j].x + v[j].y * v[j].y) + (v[j].z * v[j].z + v[j].w * v[j].w);
            const float r = rsqrtf(wave_sum(s) * (1.0f / 1024.0f) + EPSF);
            const float* shift = MOD + (ln * 3 + vsel) * 3072; const float* scale = shift + 1024; const float* gpre = a.in[I_GPRE] + ln * 1024;
            v2u* o8 = (v2u*)(H + (size_t)row * 1024);
#pragma unroll
            for (int j = 0; j < 4; ++j) { const f32x4 sh = *((const f32x4*)shift + lane + 64 * j), sc = *((const f32x4*)scale + lane + 64 * j), gv = *((const f32x4*)gpre + lane + 64 * j);
                const f32x4 hv = v[j] * r * gv * (sc + 1.0f) + sh;
                v2u w; w.x = pk2(hv.x, hv.y); w.y = pk2(hv.z, hv.w); o8[lane + 64 * j] = w; }
        }
    }
}

__device__ __forceinline__ void conv16(const LAS unsigned* vt, const float (&w0)[31], const float (&w1)[31], float b0, float b1, float (&o0)[16], float (&o1)[16]) {
#pragma unroll
    for (int t = 0; t < 16; ++t) { o0[t] = b0; o1[t] = b1; }
#pragma unroll
    for (int rr = 0; rr < 46; ++rr) { const unsigned u = vt[rr * 128]; const float lo = bflo(u), hi = bfhi(u);
#pragma unroll
        for (int t = 0; t < 16; ++t) { const int k = rr - t; if (k >= 0 && k < 31) { o0[t] += w0[k] * lo; o1[t] += w1[k] * hi; } }
        if ((rr & 3) == 3) asm volatile("" ::: "memory"); }
}
__device__ __forceinline__ v4u glu8(const v4u vq, const v4u gq) {
    v4u o;
    o.x = pk2(bflo(vq.x) * sigmoidf_(bflo(gq.x)), bfhi(vq.x) * sigmoidf_(bfhi(gq.x)));
    o.y = pk2(bflo(vq.y) * sigmoidf_(bflo(gq.y)), bfhi(vq.y) * sigmoidf_(bfhi(gq.y)));
    o.z = pk2(bflo(vq.z) * sigmoidf_(bflo(gq.z)), bfhi(vq.z) * sigmoidf_(bfhi(gq.z)));
    o.w = pk2(bflo(vq.w) * sigmoidf_(bflo(gq.w)), bfhi(vq.w) * sigmoidf_(bfhi(gq.w)));
    return o;
}
__device__ __forceinline__ void hconv_unit(const Args& a, LAS unsigned char* lds, int l, int r0, int g, int vlo, int vhi, int tid) {
    const bf16* U = (const bf16*)(a.ws + WS_U); bf16* Y = (bf16*)(a.ws + WS_Y);
    LAS unsigned* VT = (LAS unsigned*)lds;
    {
        v4u vq[6], gq[6];
#pragma unroll
        for (int it = 0; it < 6; ++it) { const int i = tid + it * NTHR, rr = i >> 5, ch = i & 31, row = r0 - 15 + rr; const bool ok = i < 94 * 32 && row >= vlo && row < vhi;
            const bf16* up = U + (size_t)(ok ? row : r0) * NIN + g * 256 + ch * 8; vq[it] = *(const v4u*)(up + 1024); gq[it] = *(const v4u*)(up + 1536); }
#pragma unroll
        for (int it = 0; it < 6; ++it) { const int i = tid + it * NTHR, rr = i >> 5, ch = i & 31, row = r0 - 15 + rr; const bool ok = row >= vlo && row < vhi;
            if (i < 94 * 32) { const v4u z = {0u, 0u, 0u, 0u}; const v4u o = glu8(vq[it], gq[it]); *(LAS v4u*)(VT + rr * 128 + ch * 4) = ok ? o : z; } }
    }
    __syncthreads();
    int p = tid & 127; asm volatile("" : "+v"(p));
    const int tg = tid >> 7, c0 = g * 256 + 2 * p;
    float w0[31], w1[31];
#pragma unroll
    for (int k = 0; k < 31; ++k) { const float2 w = *(const float2*)(a.in[I_DWW] + (size_t)(l * 31 + k) * 512 + c0); w0[k] = w.x; w1[k] = w.y; }
    const float2 bb = *(const float2*)(a.in[I_DWB] + l * 512 + c0);
    float o0[16], o1[16];
    conv16(VT + (tg * 16) * 128 + p, w0, w1, bb.x, bb.y, o0, o1);
#pragma unroll
    for (int t = 0; t < 16; ++t) *(unsigned*)(Y + (size_t)(r0 + tg * 16 + t) * 512 + c0) = pk2(o0[t], o1[t]);
    __syncthreads();
}
__device__ __forceinline__ void vconv_unit(const Args& a, LAS unsigned char* lds, int l, int b, int w, int tid) {
    const bf16* U = (const bf16*)(a.ws + WS_U); bf16* Y = (bf16*)(a.ws + WS_Y);
    LAS unsigned* VT = (LAS unsigned*)lds;
#pragma unroll 1
    for (int hb = 0; hb < 2; ++hb) {
        v4u vq[5], gq[5];
#pragma unroll
        for (int it = 0; it < 5; ++it) { const int i = tid + (hb * 5 + it) * NTHR, rr = i >> 5, ch = i & 31, gr = rr - 15; const bool ok = i < 158 * 32 && gr >= 0 && gr < 128;
            const bf16* up = U + (size_t)(b * SEQ + (ok ? gr : 0) * 64 + w) * NIN + 256 + ch * 8; vq[it] = *(const v4u*)(up + 1024); gq[it] = *(const v4u*)(up + 1536); }
#pragma unroll
        for (int it = 0; it < 5; ++it) { const int i = tid + (hb * 5 + it) * NTHR, rr = i >> 5, ch = i & 31, gr = rr - 15; const bool ok = gr >= 0 && gr < 128;
            if (i < 158 * 32) { const v4u z = {0u, 0u, 0u, 0u}; const v4u o = glu8(vq[it], gq[it]); *(LAS v4u*)(VT + rr * 128 + ch * 4) = ok ? o : z; } }
    }
    __syncthreads();
    int p = tid & 127; asm volatile("" : "+v"(p));
    const int tg = tid >> 7, c0 = 256 + 2 * p;
    float w0[31], w1[31];
#pragma unroll
    for (int k = 0; k < 31; ++k) { const float2 wv = *(const float2*)(a.in[I_DWW] + (size_t)(l * 31 + k) * 512 + c0); w0[k] = wv.x; w1[k] = wv.y; }
    const float2 bb = *(const float2*)(a.in[I_DWB] + l * 512 + c0);
#pragma unroll 1
    for (int half = 0; half < 2; ++half) {
        const int tb = tg * 32 + half * 16;
        float o0[16], o1[16];
        conv16(VT + tb * 128 + p, w0, w1, bb.x, bb.y, o0, o1);
#pragma unroll
        for (int t = 0; t < 16; ++t) *(unsigned*)(Y + (size_t)(b * SEQ + (tb + t) * 64 + w) * 512 + c0) = pk2(o0[t], o1[t]);
    }
    __syncthreads();
}
__device__ __forceinline__ void ln_rows(const Args& a, int l, int nrows, int lane, int wave) {
    const bf16* U = (const bf16*)(a.ws + WS_U); const bf16* Y = (const bf16*)(a.ws + WS_Y); bf16* MIXIN = (bf16*)(a.ws + WS_MIXIN);
    const int gw = blockIdx.x * NWAVES + wave, NGW = gridDim.x * NWAVES, c0 = lane * 8;
    float lg[8], lb[8];
#pragma unroll
    for (int e = 0; e < 8; ++e) { lg[e] = a.in[I_LNG][l * 512 + c0 + e]; lb[e] = a.in[I_LNB][l * 512 + c0 + e]; }
    for (int row = gw; row < nrows; row += NGW) {
        const v4u yq = *(const v4u*)(Y + (size_t)row * 512 + c0); const v4u gq = *(const v4u*)(U + (size_t)row * NIN + 2048 + c0);
        float y[8] = {bflo(yq.x), bfhi(yq.x), bflo(yq.y), bfhi(yq.y), bflo(yq.z), bfhi(yq.z), bflo(yq.w), bfhi(yq.w)};
        const float gt[8] = {bflo(gq.x), bfhi(gq.x), bflo(gq.y), bfhi(gq.y), bflo(gq.z), bfhi(gq.z), bflo(gq.w), bfhi(gq.w)};
        float s = 0.f;
#pragma unroll
        for (int e = 0; e < 8; ++e) s += y[e];
        const float mean = wave_sum(s) * (1.0f / 512.0f); float q = 0.f;
#pragma unroll
        for (int e = 0; e < 8; ++e) { y[e] -= mean; q += y[e] * y[e]; }
        const float rstd = rsqrtf(wave_sum(q) * (1.0f / 512.0f) + EPSF);
        float o[8];
#pragma unroll
        for (int e = 0; e < 8; ++e) o[e] = siluf_(y[e] * rstd * lg[e] + lb[e]) * gt[e];
        v4u w; w.x = pk2(o[0], o[1]); w.y = pk2(o[2], o[3]); w.z = pk2(o[4], o[5]); w.w = pk2(o[6], o[7]);
        *(v4u*)(MIXIN + (size_t)row * 1024 + 512 + c0) = w;
    }
}

constexpr int RG_GW = 0, RG_FOLD = 32768, RG_F8 = 36864, RG_CAR = 40960, RG_WAVE = 57344, RG_WAVE_BYTES = 12544;
constexpr int NP16 = 4 * NPJ;
__device__ __forceinline__ float fsig(float x) { return __builtin_amdgcn_rcpf(1.0f + __expf(-x)); }

template <bool FINAL, int D>
__device__ __forceinline__ void rg_sweep(const Args& a, LAS unsigned char* lds, LAS unsigned char* wl, int l, int b, int h, int r0, int seg_lo, int seg_hi, int pj, bool is_ctx, int w, int lane) {
    const bf16* U = (const bf16*)(a.ws + WS_U); bf16* MIXIN = (bf16*)(a.ws + WS_MIXIN);
    float* AGGA = (float*)(a.ws + WS_AGGA); float* AGGB = (float*)(a.ws + WS_AGGB); float* A16 = (float*)(a.ws + WS_A16); float* B16 = (float*)(a.ws + WS_B16);
    LAS float* VCW = (LAS float*)wl; LAS unsigned* HBW = (LAS unsigned*)(wl + 4352);
    const LAS v4u* GWL = (const LAS v4u*)(lds + RG_GW) + (D * 2) * 8 * 64 + lane;
    const LAS float* CAR = (const LAS float*)(lds + RG_CAR);
    const int fr = lane & 15, fq = lane >> 4, cp = lane & 31, rh = lane >> 5;
    float2 cw[4];
#pragma unroll
    for (int k = 0; k < 4; ++k) cw[k] = *(const float2*)(a.in[I_CAW] + (size_t)((l * 2 + D) * 4 + k) * 512 + 64 * h + 2 * cp);
    const float2 cbv = *(const float2*)(a.in[I_CAB] + (l * 2 + D) * 512 + 64 * h + 2 * cp);
    float brv[4], biv[4], sp8[4], Hc[4], Ac[4];
    const int p16own = 4 * pj + (D ? 3 - fq : fq);
#pragma unroll
    for (int ct = 0; ct < 4; ++ct) { const int c = 16 * ct + fr, pidx = (l * 2 + D) * 512 + 64 * h + c;
        brv[ct] = a.in[I_BR][pidx]; biv[ct] = a.in[I_BI][pidx]; sp8[ct] = -8.0f * log1pf(__expf(-a.in[I_LAM][pidx]));
        Hc[ct] = 0.f; Ac[ct] = 1.f;
        if (FINAL) {
            if (is_ctx) { const size_t base = (size_t)((b * 2 + D) * NP16) * 512 + 64 * h + c; float S = 0.f;
                for (int i = 0; i < p16own; ++i) S = A16[base + (size_t)i * 512] * S + B16[base + (size_t)i * 512];
                Hc[ct] = S; }
            else Hc[ct] = CAR[(D * 32 + (D ? 31 - (4 * w + fq) : 4 * w + fq)) * 64 + c];
        } }
    const bf16* ub = U + 64 * h + 2 * cp;
    unsigned Wd[2][7], nx[2][4];
#pragma unroll
    for (int q = 0; q < 2; ++q) { const int g = 2 * rh + q;
#pragma unroll
        for (int j = 0; j < 3; ++j) { const int row = r0 + 16 * g + (D ? 16 + j : j - 3); const bool ok = row >= seg_lo && row < seg_hi; const int rc = ok ? row : r0;
            const unsigned v = *(const unsigned*)(ub + (size_t)rc * NIN); Wd[q][D ? j : 4 + j] = ok ? v : 0u; }
#pragma unroll
        for (int j = 0; j < 4; ++j) nx[q][j] = *(const unsigned*)(ub + (size_t)(r0 + 16 * g + 4 * (D ? 3 : 0) + j) * NIN); }
#pragma unroll 1
    for (int ti = 0; ti < 4; ++ti) {
        const int tile = D ? 3 - ti : ti;
        int zo = 0; asm volatile("" : "+v"(zo));
        const LAS v4u* GWLt = GWL + zo;
        v4u g0 = {0u, 0u, 0u, 0u}, g1 = g0; size_t orow = 0;
        if (FINAL && D == 0) { orow = (size_t)(r0 + 16 * (fr >> 2) + 4 * tile + (fr & 3)); const bf16* gp = U + orow * NIN + 512 + 64 * h + 16 * fq; g0 = *(const v4u*)gp; g1 = *(const v4u*)(gp + 8); }
#pragma unroll
        for (int q = 0; q < 2; ++q) {
            if (D == 0) { Wd[q][0] = Wd[q][4]; Wd[q][1] = Wd[q][5]; Wd[q][2] = Wd[q][6]; Wd[q][3] = nx[q][0]; Wd[q][4] = nx[q][1]; Wd[q][5] = nx[q][2]; Wd[q][6] = nx[q][3]; }
            else { Wd[q][4] = Wd[q][0]; Wd[q][5] = Wd[q][1]; Wd[q][6] = Wd[q][2]; Wd[q][0] = nx[q][0]; Wd[q][1] = nx[q][1]; Wd[q][2] = nx[q][2]; Wd[q][3] = nx[q][3]; } }
        if (ti < 3) { const int tn = D ? 2 - ti : ti + 1;
#pragma unroll
            for (int q = 0; q < 2; ++q)
#pragma unroll
                for (int j = 0; j < 4; ++j) nx[q][j] = *(const unsigned*)(ub + (size_t)(r0 + 16 * (2 * rh + q) + 4 * tn + j) * NIN); }
#pragma unroll
        for (int q = 0; q < 2; ++q)
#pragma unroll
            for (int jj = 0; jj < 4; ++jj) { float v0 = cbv.x, v1 = cbv.y;
#pragma unroll
                for (int k = 0; k < 4; ++k) { const unsigned u = Wd[q][jj + k]; v0 += cw[k].x * bflo(u); v1 += cw[k].y * bfhi(u); }
                *(LAS f32x2v*)(VCW + (4 * (2 * rh + q) + jj) * 68 + 2 * cp) = (f32x2v){v0, v1}; }
        bf16x8 af[2];
#pragma unroll
        for (int kk = 0; kk < 2; ++kk) { const LAS float* vp = VCW + fr * 68 + 32 * kk + 8 * fq; const f32x4 x0 = *(const LAS f32x4*)vp, x1 = *(const LAS f32x4*)(vp + 4);
            v4u pk; pk.x = cvtpk(x0.x, x0.y); pk.y = cvtpk(x0.z, x0.w); pk.z = cvtpk(x1.x, x1.y); pk.w = cvtpk(x1.z, x1.w); af[kk] = __builtin_bit_cast(bf16x8, pk); }
        float vcv[4][4];
#pragma unroll
        for (int ct = 0; ct < 4; ++ct)
#pragma unroll
            for (int jj = 0; jj < 4; ++jj) vcv[ct][jj] = VCW[(4 * fq + jj) * 68 + 16 * ct + fr];
        f32x4 accr[4], acci[4];
#pragma unroll
        for (int ct = 0; ct < 4; ++ct) { accr[ct] = (f32x4){0.f, 0.f, 0.f, 0.f}; acci[ct] = accr[ct];
#pragma unroll
            for (int kk = 0; kk < 2; ++kk) { const bf16x8 br = __builtin_bit_cast(bf16x8, GWLt[(ct * 2 + kk) * 64]), bi = __builtin_bit_cast(bf16x8, GWLt[(8 + ct * 2 + kk) * 64]);
                accr[ct] = __builtin_amdgcn_mfma_f32_16x16x32_bf16(af[kk], br, accr[ct], 0, 0, 0); acci[ct] = __builtin_amdgcn_mfma_f32_16x16x32_bf16(af[kk], bi, acci[ct], 0, 0, 0); } }
        float hsum[4][4];
#pragma unroll
        for (int ct = 0; ct < 4; ++ct) { float aa[4], bb[4];
            const float nbr = -1.44269504f * brv[ct], nbi = -1.44269504f * biv[ct];
#pragma unroll
            for (int p = 0; p < 2; ++p) {
                f32x2v xr = (f32x2v){accr[ct][2 * p], accr[ct][2 * p + 1]} * -1.44269504f + nbr, xi = (f32x2v){acci[ct][2 * p], acci[ct][2 * p + 1]} * -1.44269504f + nbi;
                xr = __builtin_elementwise_min(xr, (f32x2v){60.f, 60.f}); xi = __builtin_elementwise_min(xi, (f32x2v){60.f, 60.f});
                f32x2v d1, d2; d1.x = __builtin_amdgcn_exp2f(xr.x); d1.y = __builtin_amdgcn_exp2f(xr.y); d2.x = __builtin_amdgcn_exp2f(xi.x); d2.y = __builtin_amdgcn_exp2f(xi.y);
                d1 = d1 + 1.0f; d2 = d2 + 1.0f; const f32x2v m = d1 * d2; f32x2v inv; inv.x = __builtin_amdgcn_rcpf(m.x); inv.y = __builtin_amdgcn_rcpf(m.y);
                const f32x2v r = d2 * inv, ig = d1 * inv, la = r * sp8[ct], x2 = la + la, le = la * 1.44269504f;
                const f32x2v pom = -x2 * (x2 * (x2 * (x2 * (x2 * 0.0083333338f + 0.041666668f) + 0.16666667f) + 0.5f) + 1.0f);
                f32x2v av; av.x = __builtin_amdgcn_exp2f(le.x); av.y = __builtin_amdgcn_exp2f(le.y);
                const f32x2v o2 = 1.0f - av * av; f32x2v om; om.x = x2.x > -0.25f ? pom.x : o2.x; om.y = x2.y > -0.25f ? pom.y : o2.y;
                om = __builtin_elementwise_max(om, (f32x2v){0.f, 0.f});
                f32x2v sq; sq.x = __builtin_amdgcn_sqrtf(om.x); sq.y = __builtin_amdgcn_sqrtf(om.y);
                const f32x2v bv = sq * (ig * (f32x2v){vcv[ct][2 * p], vcv[ct][2 * p + 1]});
                aa[2 * p] = av.x; aa[2 * p + 1] = av.y; bb[2 * p] = bv.x; bb[2 * p + 1] = bv.y; }
            float hh = Hc[ct], A4 = 1.f;
#pragma unroll
            for (int ji = 0; ji < 4; ++ji) { const int jj = D ? 3 - ji : ji; hh = aa[jj] * hh + bb[jj]; A4 *= aa[jj]; hsum[ct][jj] = hh; }
            Hc[ct] = hh; if (!FINAL) Ac[ct] *= A4; }
        if (FINAL) {
            if (D == 1) {
#pragma unroll
                for (int ct = 0; ct < 4; ++ct)
#pragma unroll
                    for (int jp = 0; jp < 2; ++jp) HBW[(tile * 8 + ct * 2 + jp) * 64 + lane] = cvtpk(hsum[ct][2 * jp], hsum[ct][2 * jp + 1]);
            } else {
#pragma unroll
                for (int ct = 0; ct < 4; ++ct)
#pragma unroll
                    for (int jp = 0; jp < 2; ++jp) { const unsigned hb = HBW[(tile * 8 + ct * 2 + jp) * 64 + lane];
                        VCW[(4 * fq + 2 * jp) * 68 + 16 * ct + fr] = hsum[ct][2 * jp] + bflo(hb); VCW[(4 * fq + 2 * jp + 1) * 68 + 16 * ct + fr] = hsum[ct][2 * jp + 1] + bfhi(hb); }
                const size_t row = orow;
                const f32x4 s0 = *(const LAS f32x4*)(VCW + fr * 68 + 16 * fq), s1 = *(const LAS f32x4*)(VCW + fr * 68 + 16 * fq + 4), s2 = *(const LAS f32x4*)(VCW + fr * 68 + 16 * fq + 8), s3 = *(const LAS f32x4*)(VCW + fr * 68 + 16 * fq + 12);
                v4u o0, o1;
                o0.x = cvtpk(s0.x * bflo(g0.x), s0.y * bfhi(g0.x)); o0.y = cvtpk(s0.z * bflo(g0.y), s0.w * bfhi(g0.y)); o0.z = cvtpk(s1.x * bflo(g0.z), s1.y * bfhi(g0.z)); o0.w = cvtpk(s1.z * bflo(g0.w), s1.w * bfhi(g0.w));
                o1.x = cvtpk(s2.x * bflo(g1.x), s2.y * bfhi(g1.x)); o1.y = cvtpk(s2.z * bflo(g1.y), s2.w * bfhi(g1.y)); o1.z = cvtpk(s3.x * bflo(g1.z), s3.y * bfhi(g1.z)); o1.w = cvtpk(s3.z * bflo(g1.w), s3.w * bfhi(g1.w));
                bf16* op = MIXIN + row * 1024 + 64 * h + 16 * fq; *(v4u*)op = o0; *(v4u*)(op + 8) = o1;
            }
        }
    }
    if (!FINAL) {
#pragma unroll
        for (int ct = 0; ct < 4; ++ct) { const int c = 16 * ct + fr;
            const size_t i16 = (size_t)((b * 2 + D) * NP16 + p16own) * 512 + 64 * h + c; A16[i16] = Ac[ct]; B16[i16] = Hc[ct];
            float Ag[4], Bg[4];
#pragma unroll
            for (int g = 0; g < 4; ++g) { Ag[g] = __shfl(Ac[ct], fr + 16 * g); Bg[g] = __shfl(Hc[ct], fr + 16 * g); }
            float run = 0.f;
#pragma unroll
            for (int gi = 0; gi < 4; ++gi) { const int g = D ? 3 - gi : gi; run = Ag[g] * run + Bg[g]; }
            if (fq == 0) { const size_t idx = (size_t)((b * 2 + D) * NPJ + pj) * 512 + 64 * h + c; AGGA[idx] = (Ag[0] * Ag[1]) * (Ag[2] * Ag[3]); AGGB[idx] = run; } }
    }
}

template <bool FINAL>
__device__ __forceinline__ void rg_run(const Args& a, LAS unsigned char* lds, int l, int rn, int tid, int lane, int wave) {
    const bool is_ctx = rn >= 256; const int bh = is_ctx ? rn - 256 : rn >> 4, b = bh >> 3, h = bh & 7, cgp = is_ctx ? 0 : (rn & 15);
    { const v4u* GWF = (const v4u*)(a.ws + WS_GWF); LAS v4u* GWL = (LAS v4u*)(lds + RG_GW);
#pragma unroll
      for (int i = tid; i < 2048; i += NTHR) { const int d = i >> 10, g = (i >> 9) & 1, rest = i & 511; GWL[i] = GWF[(size_t)((((l * 2 + d) * 2 + g) * 8 + h) * 8) * 64 + rest]; } }
    const int P0f = 4 + 8 * cgp, P0b = 124 - 8 * cgp;
    if (FINAL && !is_ctx) {
        const float* AGGA = (const float*)(a.ws + WS_AGGA); const float* AGGB = (const float*)(a.ws + WS_AGGB); const float* A16 = (const float*)(a.ws + WS_A16); const float* B16 = (const float*)(a.ws + WS_B16);
        const int d = tid >> 8, s = (tid >> 6) & 3, c = tid & 63, P0 = d ? P0b : P0f, lo = (P0 * s) >> 2, hi = (P0 * (s + 1)) >> 2;
        const size_t b16 = (size_t)((b * 2 + d) * NP16 + 4 * P0 + 8 * s) * 512 + 64 * h + c; float ai8[8], bi8[8];
#pragma unroll
        for (int i = 0; i < 8; ++i) { ai8[i] = A16[b16 + (size_t)i * 512]; bi8[i] = B16[b16 + (size_t)i * 512]; }
        const size_t base = (size_t)((b * 2 + d) * NPJ) * 512 + 64 * h + c; float A = 1.f, Bv = 0.f;
#pragma unroll 8
        for (int i = lo; i < hi; ++i) { const float ai = AGGA[base + (size_t)i * 512], bi = AGGB[base + (size_t)i * 512]; Bv = ai * Bv + bi; A *= ai; }
        LAS float* FO = (LAS float*)(lds + RG_FOLD); LAS float* F8 = (LAS float*)(lds + RG_F8); LAS float* CAR = (LAS float*)(lds + RG_CAR);
        FO[((d * 4 + s) * 64 + c) * 2] = A; FO[((d * 4 + s) * 64 + c) * 2 + 1] = Bv;
        float A8 = 1.f, B8 = 0.f;
#pragma unroll
        for (int i = 0; i < 8; ++i) { B8 = ai8[i] * B8 + bi8[i]; A8 *= ai8[i]; }
        F8[((d * 4 + s) * 64 + c) * 2] = A8; F8[((d * 4 + s) * 64 + c) * 2 + 1] = B8;
        __syncthreads();
        float S = 0.f;
#pragma unroll
        for (int s2 = 0; s2 < 4; ++s2) S = FO[((d * 4 + s2) * 64 + c) * 2] * S + FO[((d * 4 + s2) * 64 + c) * 2 + 1];
#pragma unroll
        for (int s2 = 0; s2 < 3; ++s2) if (s2 < s) S = F8[((d * 4 + s2) * 64 + c) * 2] * S + F8[((d * 4 + s2) * 64 + c) * 2 + 1];
#pragma unroll
        for (int i = 0; i < 8; ++i) { CAR[(d * 32 + 8 * s + i) * 64 + c] = S; S = ai8[i] * S + bi8[i]; }
    }
    __syncthreads();
    if (wave < (is_ctx ? 4 : 8)) {
        const int j = is_ctx ? wave : 8 * cgp + wave;
        const int seg_lo = is_ctx ? MLAT + b * CTXL : b * SEQ, seg_hi = seg_lo + (is_ctx ? CTXL : SEQ), r0 = seg_lo + 64 * j;
        const int pjf = is_ctx ? j : 4 + j, pjb = is_ctx ? 3 - j : 131 - j;
        LAS unsigned char* wl = lds + RG_WAVE + wave * RG_WAVE_BYTES;
        rg_sweep<FINAL, 1>(a, lds, wl, l, b, h, r0, seg_lo, seg_hi, pjb, is_ctx, wave, lane);
        rg_sweep<FINAL, 0>(a, lds, wl, l, b, h, r0, seg_lo, seg_hi, pjf, is_ctx, wave, lane);
    }
    __syncthreads();
}

#define RLX_AGENT __ATOMIC_RELAXED, __HIP_MEMORY_SCOPE_AGENT


#define XB_TMO      128
#define XB_XCNT(j)  (256  + 64 * (j))
#define XB_XSUB(j)  (1280 + 64 * (j))
#define XB_XGEN(j)  (2304 + 64 * (j))
#define XB_TOP      3328
#define XB_TOPGEN   3392
#define XCD_BAR_WORDS 3456
#define XB_SPIN_CAP (1u << 18)

__device__ __forceinline__ unsigned xb_ld(unsigned* p)              { return __hip_atomic_load(p, __ATOMIC_RELAXED, __HIP_MEMORY_SCOPE_AGENT); }
__device__ __forceinline__ unsigned xb_add(unsigned* p, unsigned v) { return __hip_atomic_fetch_add(p, v, __ATOMIC_RELAXED, __HIP_MEMORY_SCOPE_AGENT); }
__device__ __forceinline__ unsigned xb_xcc_id() { return (unsigned)__builtin_amdgcn_s_getreg((3 << 11) | 20) & 0xFu; }
#define XB_SPIN(cond, bar) do { unsigned _sp = 0; while (cond) { __builtin_amdgcn_s_sleep(1); \
    if ((++_sp & 255u) == 0u) { if (xb_ld(&(bar)[XB_TMO])) break; if (_sp > XB_SPIN_CAP) { atomicAdd(&(bar)[XB_TMO], 1u); break; } } } } while (0)

struct XcdBarrier {
    unsigned* bar; unsigned x;
    volatile LAS unsigned* st;
};

__device__ __forceinline__ XcdBarrier xcd_barrier_post(unsigned* bar, volatile LAS unsigned* st) {
    XcdBarrier b; b.bar = bar; b.x = xb_xcc_id(); b.st = st;
    if (threadIdx.x == 0) (void)xb_add(&bar[XB_XCNT(b.x)], 1u);
    return b;
}
__device__ __forceinline__ void xcd_barrier_complete(unsigned* bar, unsigned x, unsigned& nloc, unsigned& nx) {
    const unsigned G = gridDim.x * gridDim.y * gridDim.z;
    unsigned sum, cnt, mine, sp = 0u;
    for (;;) {
        sum = 0u; cnt = 0u; mine = 0u;
#pragma unroll
        for (unsigned j = 0; j < 16; ++j) { const unsigned c = xb_ld(&bar[XB_XCNT(j)]); sum += c; cnt += (c > 0u) ? 1u : 0u; mine = (j == x) ? c : mine; }
        if (sum == G) break;
        __builtin_amdgcn_s_sleep(1);
        if ((++sp & 255u) == 0u) { if (xb_ld(&bar[XB_TMO])) break; if (sp > XB_SPIN_CAP) { atomicAdd(&bar[XB_TMO], 1u); break; } }
    }
    nloc = mine > 0u ? mine : 1u; nx = cnt > 0u ? cnt : 1u;
}

__device__ __forceinline__ void xcd_barrier(const XcdBarrier& b) {
    asm volatile("s_waitcnt vmcnt(0)" ::: "memory");
    __syncthreads();
    if (threadIdx.x == 0) {
        unsigned* bar = b.bar;
        __builtin_amdgcn_s_waitcnt(0);
        unsigned nloc = b.st[0], nx = b.st[1];
        if (nloc == 0u) { xcd_barrier_complete(bar, b.x, nloc, nx); b.st[0] = nloc; b.st[1] = nx; }
        const unsigned old = xb_add(&bar[XB_XSUB(b.x)], 1u);
        const unsigned gen = old / nloc;
        if (old + 1u == (gen + 1u) * nloc) {
            __builtin_amdgcn_fence(__ATOMIC_RELEASE, "agent");
            asm volatile("s_waitcnt vmcnt(0)" ::: "memory");
            const unsigned og = xb_add(&bar[XB_TOP], 1u);
            const unsigned tg = og / nx;
            if (og + 1u == (tg + 1u) * nx) xb_add(&bar[XB_TOPGEN], 1u);
            else XB_SPIN(xb_ld(&bar[XB_TOPGEN]) == tg, bar);
            __builtin_amdgcn_fence(__ATOMIC_ACQUIRE, "agent");
            xb_add(&bar[XB_XGEN(b.x)], 1u);
            asm volatile("s_waitcnt vmcnt(0)" ::: "memory");
        } else {
            XB_SPIN(xb_ld(&bar[XB_XGEN(b.x)]) == gen, bar);
            __builtin_amdgcn_fence(__ATOMIC_ACQUIRE, "agent");
            asm volatile("s_waitcnt vmcnt(0)" ::: "memory");
        }
    }
    __syncthreads();
}

template <int l>
__device__ __forceinline__ void layer_phases(const Args& args, LAS unsigned char* lds, const int tid, const int lane, const int wave, const int lo, const int hi, const XcdBarrier& xbar) {
    const int G = gridDim.x, bx = blockIdx.x; unsigned char* ws = args.ws;
    constexpr int pb = 1 + 5 * l;
#define IN(k) (lo <= (k) && (k) < hi)
#define SEAM(k) do { if (IN(k) && IN((k) + 1)) { xcd_barrier(xbar); } } while (0)
        if (IN(pb)) { norm_phase(args, l, lane, wave); }
        SEAM(pb);
        if (IN(pb + 1)) {
            pg8::Gemm g{(const pg8::bf16_t*)(ws + WS_H), (const pg8::bf16_t*)(ws + WS_BT1) + (size_t)l * NIN * 1024, MROWS, NIN, 1024};
            pg8::StaticOrder S; S.init(MROWS, NIN, G, bx);
            pg8::EpiU E{(pg8::bf16_t*)(ws + WS_U)};
            pg8::gemm_phase<pg8::EpiU, pg8::StaticOrder, true, true>(lds, g, S, E);
        }
        SEAM(pb + 1);
        if (IN(pb + 2)) {
            rg_run<false>(args, lds, l, bx, tid, lane, wave);
            const int n_h = 256 + (l == 0 ? 16 : 0), n_conv = 128 + n_h;
            const int GC = G - 16;
            for (int un = bx; un < n_conv && bx < GC; un += GC) {
                if (un < 128) { vconv_unit(args, lds, l, un >> 6, un & 63, tid); }
                else { const int hu = un - 128;
                    if (hu < 256) hconv_unit(args, lds, l, hu * 64, 0, hu * 64, hu * 64 + 64, tid);
                    else { const int cu = hu - 256, cc = cu >> 1, g = cu & 1, bb = cc >> 2; hconv_unit(args, lds, l, MLAT + cc * 64, g, MLAT + bb * CTXL, MLAT + bb * CTXL + CTXL, tid); } }
            }
            if (bx >= G - 16) rg_run<false>(args, lds, l, 256 + (G - 1 - bx), tid, lane, wave);
        }
        SEAM(pb + 2);
        if (IN(pb + 3)) {
            rg_run<true>(args, lds, l, bx, tid, lane, wave);
            if (l == 0 && bx >= G - 16) rg_run<true>(args, lds, l, 256 + (G - 1 - bx), tid, lane, wave);
            ln_rows(args, l, (l == 0) ? MROWS : MLAT, lane, wave);
        }
        SEAM(pb + 3);
        if (IN(pb + 4)) {
            const int M2 = (l == 0) ? MROWS : MLAT;
            pg8::Gemm g{(const pg8::bf16_t*)(ws + WS_MIXIN), (const pg8::bf16_t*)(ws + WS_BT2) + (size_t)l * 1024 * 1024, M2, 1024, 1024};
            pg8::StaticOrder S; S.init(M2, 1024, G, bx);
            pg8::EpiMix E{(pg8::bf16_t*)(ws + WS_MIX), (float*)(ws + WS_SSQ)};
            pg8::gemm_phase<pg8::EpiMix, pg8::StaticOrder, true, true>(lds, g, S, E);
        }
        SEAM(pb + 4);
#undef IN
#undef SEAM
}

__global__ void __launch_bounds__(NTHR, 2) fwd_megakernel(Args args) {
    extern __shared__ __attribute__((aligned(16))) unsigned char lds_raw[];
    LAS unsigned char* lds = (LAS unsigned char*)lds_raw;
    const int tid = threadIdx.x, lane = tid & 63, wave = __builtin_amdgcn_readfirstlane(tid >> 6);
    const int G = gridDim.x, bx = blockIdx.x;
    unsigned char* ws = args.ws;
    const int lo = args.ph_lo, hi = args.ph_hi;
    if (args.coop == 2) cg::this_grid().sync();
    volatile LAS unsigned* MISC = (volatile LAS unsigned*)(lds + MISC_OFF);
    if (tid < 64) MISC[tid] = 0u;
    __syncthreads();
    XcdBarrier xbar; xbar.bar = (unsigned*)(ws + WS_CTL); xbar.x = 0; xbar.st = nullptr;
    if (args.coop == 1) xbar = xcd_barrier_post((unsigned*)(ws + WS_CTL), MISC + 8);
#define IN(k) (lo <= (k) && (k) < hi)
#define SEAM(k) do { if (IN(k) && IN((k) + 1)) { xcd_barrier(xbar); } } while (0)

    if (IN(0)) { p0_prologue(args, lds, tid, lane, wave); }
    SEAM(0);
    layer_phases<0>(args, lds, tid, lane, wave, lo, hi, xbar);
    layer_phases<1>(args, lds, tid, lane, wave, lo, hi, xbar);
    if (IN(11)) { norm_phase(args, 2, lane, wave); }
#undef IN
#undef SEAM
}

#ifndef MK_PER_PHASE
#define MK_PER_PHASE 0
#endif
extern "C" void kernel_launch(void* const* d_in, const int* in_sizes, int n_in, void* d_out, int out_size, void* d_ws, size_t ws_size, hipStream_t stream) {
    static int grid = 0;
    if (grid == 0) {
        if (n_in != 21 || out_size != MLAT * DM || ws_size < WS_END) { fprintf(stderr, "kernel_launch: unexpected shapes (n_in %d, out %d, ws %zu)\n", n_in, out_size, ws_size); grid = -1; return; }
        int dev = 0, cus = 0, per_cu = 0;
        if (hipGetDevice(&dev) != hipSuccess || hipDeviceGetAttribute(&cus, hipDeviceAttributeMultiprocessorCount, dev) != hipSuccess) { grid = -1; return; }
        if (hipFuncSetAttribute((const void*)fwd_megakernel, hipFuncAttributeMaxDynamicSharedMemorySize, LDS_BYTES) != hipSuccess) { fprintf(stderr, "kernel_launch: hipFuncSetAttribute failed\n"); grid = -1; return; }
        if (hipOccupancyMaxActiveBlocksPerMultiprocessor(&per_cu, (const void*)fwd_megakernel, NTHR, LDS_BYTES) != hipSuccess || per_cu < 1) { fprintf(stderr, "kernel_launch: occupancy query says %d\n", per_cu); per_cu = 1; }
        (void)hipGetLastError();
        grid = cus;
    }
    if (grid < 0) return;
    if (hipMemsetAsync((char*)d_ws + WS_CTL, 0, CTL_ZERO_BYTES, stream) != hipSuccess) { fprintf(stderr, "kernel_launch: memset failed\n"); return; }
    Args a{};
    for (int i = 0; i < 21; ++i) a.in[i] = (const float*)d_in[i];
    a.out = (float*)d_out; a.ws = (unsigned char*)d_ws;
#if MK_PER_PHASE
    for (int ph = 0; ph < 12; ++ph) { a.ph_lo = ph; a.ph_hi = ph + 1; a.coop = 0;
        hipLaunchKernelGGL(fwd_megakernel, dim3(grid), dim3(NTHR), LDS_BYTES, stream, a); }
#else
    a.ph_lo = 0; a.ph_hi = 12; a.coop = 1;
    void* kargs[] = {&a};
    hipError_t e = hipLaunchCooperativeKernel((const void*)fwd_megakernel, dim3(grid), dim3(NTHR), kargs, LDS_BYTES, stream);
    if (e != hipSuccess) fprintf(stderr, "cooperative launch failed: %s (grid %d)\n", hipGetErrorString(e), grid);
#endif
}
```

```cpp
#include <hip/hip_runtime.h>
#include <hip/hip_cooperative_groups.h>
#include <cstdio>
#include <cstdint>
namespace cg = cooperative_groups;
#define MK_PER_PHASE 0
namespace pg8 {
#define PG8_LAS __attribute__((address_space(3)))
typedef unsigned short bf16_t;
typedef short bf16x8 __attribute__((ext_vector_type(8)));
typedef float f32x4 __attribute__((ext_vector_type(4)));
typedef unsigned u32x4 __attribute__((ext_vector_type(4)));
constexpr int BM = 256, BK = 64, HALF = 128, HTB = HALF * BK * 2  , STAGE_BYTES = 8 * HTB, NXCD = 8, WGM = 8;

__host__ __device__ __forceinline__ int lds_byte(int r, int c) { const int st = (r >> 4) * 2 + (c >> 5), rr = r & 15, cc = c & 31, ob = rr * 64 + cc * 2; return st * 1024 + (ob ^ (((ob >> 9) & 1) << 5)); }
__host__ __device__ __forceinline__ void stage_rc(int b, int& R, int& C) { const int st = b / 1024, sb = b % 1024, swz = sb ^ (((sb >> 9) & 1) << 5); R = (st >> 1) * 16 + swz / 64; C = (st & 1) * 32 + (swz % 64) / 2; }
__host__ __device__ __forceinline__ int perm32(int rho) { const int n = rho >> 4, i = rho & 15; return 8 * (i >> 2) + 4 * n + (i & 3); }

struct Unit { int pm, pn; };
struct Gemm { const bf16_t* A; const bf16_t* Bt; int M, N, K; };

struct StaticOrder {
    int nM, nN, nwg, G, c;
    __host__ __device__ void init(int M, int N, int G_, int c_) { nM = M / BM; nN = N / BM; nwg = nM * nN; G = G_; c = c_; }
    __host__ __device__ bool next(int i, Unit& u) const {
        const long L = (long)i * G + c; if (L >= nwg) return false;
        int wgid = (int)L; { const int q = nwg / NXCD, r = nwg % NXCD, xcd = wgid % NXCD, off = wgid / NXCD; wgid = (xcd < r ? xcd * (q + 1) : r * (q + 1) + (xcd - r) * q) + off; }
        const int nig = WGM * nN, gid = wgid / nig, fm = gid * WGM, gsz = (nM - fm) < WGM ? (nM - fm) : WGM;
        u.pm = fm + ((wgid % nig) % gsz); u.pn = (wgid % nig) / gsz; return true;
    }
    __device__ __forceinline__ void a_ready(const Unit&) const {}
    __device__ __forceinline__ void done(const Unit&) const {}
};
__device__ __forceinline__ unsigned cvt_pk_bf16(float lo, float hi) { unsigned r; asm volatile("v_cvt_pk_bf16_f32 %0, %1, %2" : "=v"(r) : "v"(lo), "v"(hi)); return r; }
typedef float f32x2 __attribute__((ext_vector_type(2)));
template <class Epi, class Sched, bool ALIGN_EPI = false, bool SP2 = false>
__device__ __forceinline__ void gemm_phase(PG8_LAS unsigned char* lds, const Gemm g, const Sched& S, const Epi& E) {
    const int tid = threadIdx.x, wid = __builtin_amdgcn_readfirstlane(tid >> 6), lane = tid & 63, wr = wid >> 2, wc = wid & 3, fr = lane & 15, fq = lane >> 4;
    const int K = g.K, nt = K / BK;
    unsigned voffA[2], voffB[2];
#pragma unroll
    for (int i = 0; i < 2; ++i) { int R, C; stage_rc(tid * 16 + i * 8192, R, C); const int Rb = Epi::PERM ? ((R & ~31) + perm32(R & 31)) : R;
        voffA[i] = (unsigned)(R * K + C) * 2u; voffB[i] = (unsigned)(Rb * K + C) * 2u; }
    const size_t kstep = (size_t)(BK * 2);
    const size_t hstep = (size_t)HALF * K * 2;
    const size_t tstep = 2 * hstep;
    const unsigned ldsw = (unsigned)wid * 1024u;
    const int aoff = lds_byte(wr * 64 + fr, fq * 8), boff = lds_byte(wc * 32 + fr, fq * 8);
#define PG8_SA(b, h) (((b) * 2 + (h)) * HTB)
#define PG8_SB(b, h) ((4 + (b) * 2 + (h)) * HTB)
#define PG8_STAGE(bufoff, gbase, voff) do { _Pragma("unroll") for (int _i = 0; _i < 2; ++_i) \
        __builtin_amdgcn_global_load_lds((const unsigned*)((const char*)(gbase) + (voff)[_i]), (PG8_LAS unsigned*)(lds + (bufoff) + ldsw + _i * 8192), 16, 0, 0); } while (0)
#define PG8_LDA(dst, b, h) do { _Pragma("unroll") for (int m = 0; m < 4; ++m) _Pragma("unroll") for (int k = 0; k < 2; ++k) dst[m][k] = *(const PG8_LAS bf16x8*)(lds + PG8_SA(b, h) + aoff + m * 2048 + k * 1024); } while (0)
#define PG8_LDB(dst, b, h) do { _Pragma("unroll") for (int n = 0; n < 2; ++n) _Pragma("unroll") for (int k = 0; k < 2; ++k) dst[n][k] = *(const PG8_LAS bf16x8*)(lds + PG8_SB(b, h) + boff + n * 2048 + k * 1024); } while (0)
#define PG8_MMA(ai, bj, At, Bt) do { __builtin_amdgcn_s_setprio(1); _Pragma("unroll") for (int m = 0; m < 4; ++m) _Pragma("unroll") for (int n = 0; n < 2; ++n) _Pragma("unroll") for (int k = 0; k < 2; ++k) \
        acc[ai][bj][m][n] = __builtin_amdgcn_mfma_f32_16x16x32_bf16(Bt[n][k], At[m][k], acc[ai][bj][m][n], 0, 0, 0); __builtin_amdgcn_s_setprio(0); } while (0)
#define PG8_WAIT_V(n) asm volatile("s_waitcnt vmcnt(" #n ")" ::: "memory")
#define PG8_WAIT_L(n) asm volatile("s_waitcnt lgkmcnt(" #n ")" ::: "memory")
#define PG8_BAR __builtin_amdgcn_s_barrier()
#define PG8_SCHED __builtin_amdgcn_sched_barrier(0)
    Unit cur, nxt; int ui = 0;
    if (!S.next(0, cur)) return;
    f32x4 acc[2][2][4][2];
#pragma unroll
    for (int a = 0; a < 2; ++a)
#pragma unroll
        for (int b = 0; b < 2; ++b)
#pragma unroll
            for (int m = 0; m < 4; ++m)
#pragma unroll
                for (int n = 0; n < 2; ++n) acc[a][b][m][n] = (f32x4){0.f, 0.f, 0.f, 0.f};
    bf16x8 At[4][2], B0[2][2], B1[2][2];
    const char* cA = (const char*)g.A + (size_t)cur.pm * tstep; const char* cB = (const char*)g.Bt + (size_t)cur.pn * tstep;
    S.a_ready(cur);
    if constexpr (SP2) {
        PG8_STAGE(PG8_SB(0, 0), cB, voffB); PG8_STAGE(PG8_SB(0, 1), cB + hstep, voffB); PG8_STAGE(PG8_SA(0, 0), cA, voffA); PG8_STAGE(PG8_SA(0, 1), cA + hstep, voffA);
        if (wr == 1) PG8_BAR;
        PG8_WAIT_V(2); PG8_BAR;
        PG8_STAGE(PG8_SB(1, 0), cB + kstep, voffB); PG8_STAGE(PG8_SA(1, 0), cA + kstep, voffA); PG8_STAGE(PG8_SB(1, 1), cB + hstep + kstep, voffB);
        PG8_WAIT_V(6); PG8_BAR;
    } else {
        PG8_STAGE(PG8_SB(0, 0), cB, voffB); PG8_STAGE(PG8_SA(0, 0), cA, voffA); PG8_STAGE(PG8_SB(0, 1), cB + hstep, voffB); PG8_STAGE(PG8_SA(0, 1), cA + hstep, voffA);
        if (wr == 1) PG8_BAR;
        PG8_WAIT_V(4); PG8_BAR;
        PG8_STAGE(PG8_SB(1, 0), cB + kstep, voffB); PG8_STAGE(PG8_SA(1, 0), cA + kstep, voffA); PG8_STAGE(PG8_SB(1, 1), cB + hstep + kstep, voffB);
        PG8_WAIT_V(6); PG8_BAR;
    }
    for (;;) {
        const bool has_next = S.next(ui + 1, nxt);
        const char* nA = has_next ? (const char*)g.A + (size_t)nxt.pm * tstep : cA; const char* nB = has_next ? (const char*)g.Bt + (size_t)nxt.pn * tstep : cB;
        for (int t = 0; t < nt; t += 2) {
            const bool last = (t == nt - 2);
            const char* a1 = cA + (size_t)(t + 1) * kstep;
            const char* a2 = last ? nA : cA + (size_t)(t + 2) * kstep; const char* b2 = last ? nB : cB + (size_t)(t + 2) * kstep;
            const char* a3 = a2 + kstep; const char* b3 = b2 + kstep;
            if (last && has_next) S.a_ready(nxt);
            if constexpr (SP2) {
            PG8_LDB(B0, 0, 0); PG8_LDB(B1, 0, 1); PG8_SCHED; PG8_LDA(At, 0, 0); PG8_STAGE(PG8_SA(1, 1), a1 + hstep, voffA);
            PG8_WAIT_V(8); PG8_WAIT_L(0); PG8_BAR; PG8_MMA(0, 0, At, B0); PG8_MMA(0, 1, At, B1); PG8_BAR; PG8_SCHED;
            PG8_LDA(At, 0, 1); PG8_STAGE(PG8_SB(0, 0), b2, voffB); PG8_STAGE(PG8_SB(0, 1), b2 + hstep, voffB); PG8_STAGE(PG8_SA(0, 0), a2, voffA);
            PG8_WAIT_V(8); PG8_WAIT_L(0); PG8_BAR; PG8_MMA(1, 0, At, B0); PG8_MMA(1, 1, At, B1); PG8_BAR; PG8_SCHED;
            PG8_LDB(B0, 1, 0); PG8_LDB(B1, 1, 1); PG8_SCHED; PG8_LDA(At, 1, 0); PG8_STAGE(PG8_SA(0, 1), a2 + hstep, voffA);
            PG8_WAIT_V(8); PG8_WAIT_L(0); PG8_BAR; PG8_MMA(0, 0, At, B0); PG8_MMA(0, 1, At, B1); PG8_BAR; PG8_SCHED;
            PG8_LDA(At, 1, 1); PG8_STAGE(PG8_SB(1, 0), b3, voffB); PG8_STAGE(PG8_SB(1, 1), b3 + hstep, voffB); PG8_STAGE(PG8_SA(1, 0), a3, voffA);
            PG8_WAIT_V(8); PG8_WAIT_L(0); PG8_BAR; PG8_MMA(1, 0, At, B0); PG8_MMA(1, 1, At, B1); PG8_BAR; PG8_SCHED;
            } else {
            PG8_LDB(B0, 0, 0); PG8_SCHED; PG8_LDA(At, 0, 0); PG8_STAGE(PG8_SA(1, 1), a1 + hstep, voffA);
            PG8_WAIT_L(8); PG8_BAR; PG8_WAIT_L(0); PG8_MMA(0, 0, At, B0); PG8_BAR; PG8_SCHED;
            PG8_LDB(B1, 0, 1); PG8_STAGE(PG8_SB(0, 0), b2, voffB);
            PG8_BAR; PG8_WAIT_L(0); PG8_MMA(0, 1, At, B1); PG8_BAR;
            PG8_LDA(At, 0, 1); PG8_STAGE(PG8_SA(0, 0), a2, voffA);
            PG8_BAR; PG8_WAIT_L(0); PG8_MMA(1, 0, At, B0); PG8_BAR; PG8_SCHED;
            PG8_STAGE(PG8_SB(0, 1), b2 + hstep, voffB);
            PG8_WAIT_V(6); PG8_BAR; PG8_MMA(1, 1, At, B1); PG8_BAR;
            PG8_LDB(B0, 1, 0); PG8_SCHED; PG8_LDA(At, 1, 0); PG8_STAGE(PG8_SA(0, 1), a2 + hstep, voffA);
            PG8_WAIT_L(8); PG8_BAR; PG8_WAIT_L(0); PG8_MMA(0, 0, At, B0); PG8_BAR; PG8_SCHED;
            PG8_LDB(B1, 1, 1); PG8_STAGE(PG8_SB(1, 0), b3, voffB);
            PG8_BAR; PG8_WAIT_L(0); PG8_MMA(0, 1, At, B1); PG8_BAR;
            PG8_LDA(At, 1, 1); PG8_STAGE(PG8_SA(1, 0), a3, voffA);
            PG8_BAR; PG8_WAIT_L(0); PG8_MMA(1, 0, At, B0); PG8_BAR; PG8_SCHED;
            PG8_STAGE(PG8_SB(1, 1), b3 + hstep, voffB);
            PG8_WAIT_V(6); PG8_BAR; PG8_MMA(1, 1, At, B1); PG8_BAR;
            }
        }
        if constexpr (ALIGN_EPI) { if (wr == 0) PG8_BAR; }
        if constexpr (!Epi::AFTER_DRAIN) { E(acc, cur, wr, wc, fr, fq); S.done(cur); }
        if (!has_next) break;
#pragma unroll
        for (int a = 0; a < 2; ++a)
#pragma unroll
            for (int b = 0; b < 2; ++b)
#pragma unroll
                for (int m = 0; m < 4; ++m)
#pragma unroll
                    for (int n = 0; n < 2; ++n) acc[a][b][m][n] = (f32x4){0.f, 0.f, 0.f, 0.f};
        cur = nxt; cA = nA; cB = nB; ++ui;
        if constexpr (ALIGN_EPI) { if (wr == 1) PG8_BAR; }
    }
    PG8_WAIT_V(0);
    if constexpr (!ALIGN_EPI) { if (wr == 0) PG8_BAR; }
    PG8_BAR;
    if constexpr (Epi::AFTER_DRAIN) { E.fused(acc, cur, wr, wc, fr, fq, lds, wid, lane); S.done(cur); }
#undef PG8_SA
#undef PG8_SB
#undef PG8_STAGE
#undef PG8_LDA
#undef PG8_LDB
#undef PG8_MMA
#undef PG8_WAIT_V
#undef PG8_WAIT_L
#undef PG8_BAR
#undef PG8_SCHED
}
}

constexpr int DM = 1024, NB = 2, SEQ = 8192, CTXL = 256, MLAT = NB * SEQ, MCTX = NB * CTXL, MROWS = MLAT + MCTX;
constexpr int NIN = 2560, NCHUNK = MROWS / 64  , NPJ = 132  ;
constexpr float EPSF = 1e-6f;
constexpr int NWAVES = 8, NTHR = 512;

constexpr size_t MiB = 1u << 20;
constexpr size_t WS_CTL = 0, CTL_ZERO_BYTES = 64 * 1024;
constexpr size_t WS_MOD = 1 * MiB;
constexpr size_t WS_GWF = 1 * MiB + 256 * 1024;
constexpr size_t WS_BT1 = 2 * MiB;
constexpr size_t WS_BT2 = 12 * MiB;
constexpr size_t WS_AGGA = 16 * MiB;
constexpr size_t WS_AGGB = 16 * MiB + 1536 * 1024;
constexpr size_t WS_SSQ = 19 * MiB;
constexpr size_t WS_XC1 = 21 * MiB;
constexpr size_t WS_A16 = 23 * MiB;
constexpr size_t WS_B16 = 28 * MiB;
constexpr size_t WS_H = 73 * MiB;
constexpr size_t WS_Y = 56 * MiB;
constexpr size_t WS_MIXIN = 73 * MiB;
constexpr size_t WS_U = 106 * MiB;
constexpr size_t WS_MIX = 189 * MiB;
constexpr size_t WS_END = 255 * MiB;

constexpr int LDS_BYTES = 158720;
constexpr int MISC_OFF = 157696;

#define LAS __attribute__((address_space(3)))
typedef unsigned short bf16;
typedef unsigned v4u __attribute__((ext_vector_type(4)));
typedef unsigned v2u __attribute__((ext_vector_type(2)));
typedef float f32x4 __attribute__((ext_vector_type(4)));
typedef short bf16x8 __attribute__((ext_vector_type(8)));
typedef float f32x2v __attribute__((ext_vector_type(2)));
#define LDS_WAIT() asm volatile("s_waitcnt lgkmcnt(0)" ::: "memory")

__device__ __forceinline__ unsigned f2bf(float f) { unsigned u = __builtin_bit_cast(unsigned, f); return (u + 0x7fffu + ((u >> 16) & 1u)) >> 16; }
__device__ __forceinline__ unsigned pk2(float lo, float hi) { return f2bf(lo) | (f2bf(hi) << 16); }
__device__ __forceinline__ unsigned cvtpk(float lo, float hi) { unsigned r; asm volatile("v_cvt_pk_bf16_f32 %0, %1, %2" : "=v"(r) : "v"(lo), "v"(hi)); return r; }
__device__ __forceinline__ float bflo(unsigned u) { return __builtin_bit_cast(float, u << 16); }
__device__ __forceinline__ float bfhi(unsigned u) { return __builtin_bit_cast(float, u & 0xffff0000u); }
__device__ __forceinline__ float sigmoidf_(float x) { return 1.0f / (1.0f + __expf(-x)); }
__device__ __forceinline__ float siluf_(float x) { return x / (1.0f + __expf(-x)); }
__device__ __forceinline__ float wave_sum(float v) {
#pragma unroll
    for (int o = 1; o < 64; o <<= 1) v += __shfl_xor(v, o);
    return v;
}

struct Args {
    const float* in[21]; float* out; unsigned char* ws; int ph_lo, ph_hi, coop, pad;
};
enum { I_X = 0, I_C, I_CTX, I_CCTX, I_WMOD, I_BMOD, I_GPRE, I_GPOST, I_WIN, I_CAW, I_CAB, I_WR, I_BR, I_WI, I_BI, I_LAM, I_DWW, I_DWB, I_LNG, I_LNB, I_WOUT };

namespace pg8 {
struct EpiU {
    static constexpr bool PERM = true, AFTER_DRAIN = false;
    bf16_t* O;
    __device__ __forceinline__ void operator()(const f32x4 (&acc)[2][2][4][2], const Unit& u, int wr, int wc, int fr, int fq) const {
        const int row0 = u.pm * BM + wr * 64 + fr;
        if (u.pn >= 4 && u.pn < 8) {
            const int col0 = 1024 + 128 * (u.pn - 4) + wc * 32 + 8 * fq;
#pragma unroll
            for (int ai = 0; ai < 2; ++ai)
#pragma unroll
                for (int m = 0; m < 4; ++m) { f32x4 v0 = acc[ai][0][m][0], v1 = acc[ai][0][m][1]; const f32x4 g0 = acc[ai][1][m][0], g1 = acc[ai][1][m][1];
#pragma unroll
                    for (int e = 0; e < 4; ++e) { v0[e] = v0[e] * __builtin_amdgcn_rcpf(1.0f + __expf(-g0[e])); v1[e] = v1[e] * __builtin_amdgcn_rcpf(1.0f + __expf(-g1[e])); }
                    u32x4 w; w.x = cvt_pk_bf16(v0[0], v0[1]); w.y = cvt_pk_bf16(v0[2], v0[3]); w.z = cvt_pk_bf16(v1[0], v1[1]); w.w = cvt_pk_bf16(v1[2], v1[3]);
                    *(u32x4*)(O + (size_t)(row0 + ai * HALF + m * 16) * 2560 + col0) = w; }
            return;
        }
        const int col0 = u.pn * BM + wc * 32 + 8 * fq;
        const bool act = (u.pn == 2 || u.pn == 3 || u.pn >= 8);
#pragma unroll
        for (int ai = 0; ai < 2; ++ai)
#pragma unroll
            for (int m = 0; m < 4; ++m) { bf16_t* rowp = O + (size_t)(row0 + ai * HALF + m * 16) * 2560 + col0;
#pragma unroll
                for (int bj = 0; bj < 2; ++bj) { f32x4 v0 = acc[ai][bj][m][0], v1 = acc[ai][bj][m][1];
                    if (act) {
#pragma unroll
                        for (int e = 0; e < 4; ++e) { v0[e] = v0[e] * __builtin_amdgcn_rcpf(1.0f + __expf(-v0[e])); v1[e] = v1[e] * __builtin_amdgcn_rcpf(1.0f + __expf(-v1[e])); }
                    }
                    u32x4 w; w.x = cvt_pk_bf16(v0[0], v0[1]); w.y = cvt_pk_bf16(v0[2], v0[3]); w.z = cvt_pk_bf16(v1[0], v1[1]); w.w = cvt_pk_bf16(v1[2], v1[3]);
                    *(u32x4*)(rowp + bj * HALF) = w; } }
    }
};
struct EpiMix {
    static constexpr bool PERM = true, AFTER_DRAIN = false;
    bf16_t* O; float* ssq;
    __device__ __forceinline__ void operator()(const f32x4 (&acc)[2][2][4][2], const Unit& u, int wr, int wc, int fr, int fq) const {
        const int col0 = u.pn * BM + wc * 32 + 8 * fq;
#pragma unroll
        for (int ai = 0; ai < 2; ++ai)
#pragma unroll
            for (int m = 0; m < 4; ++m) { const int r = u.pm * BM + ai * HALF + wr * 64 + m * 16 + fr; bf16_t* rowp = O + (size_t)r * 1024 + col0; float s = 0.f;
#pragma unroll
                for (int bj = 0; bj < 2; ++bj) { const f32x4 v0 = acc[ai][bj][m][0], v1 = acc[ai][bj][m][1];
                    s += ((v0[0] * v0[0] + v0[1] * v0[1]) + (v0[2] * v0[2] + v0[3] * v0[3])) + ((v1[0] * v1[0] + v1[1] * v1[1]) + (v1[2] * v1[2] + v1[3] * v1[3]));
                    u32x4 w; w.x = cvt_pk_bf16(v0[0], v0[1]); w.y = cvt_pk_bf16(v0[2], v0[3]); w.z = cvt_pk_bf16(v1[0], v1[1]); w.w = cvt_pk_bf16(v1[2], v1[3]);
                    *(u32x4*)(rowp + bj * HALF) = w; }
                s += __shfl_xor(s, 16); s += __shfl_xor(s, 32);
                if (fq == 0) ssq[(size_t)r * 16 + u.pn * 4 + wc] = s; }
    }
};
}

__device__ __forceinline__ void p0_transpose_item(const float* W, int K, int N, bf16* WT, LAS float* scr, int item, int lane, bool glu_remap) {
    const int nblk = N / 32, kb = item / nblk, nb = item % nblk, k0 = 64 * kb, n0 = 32 * nb;
    int nd = n0;
    if (glu_remap) { if (n0 >= 1024 && n0 < 1536) nd = 1024 + 256 * ((n0 - 1024) >> 7) + ((n0 - 1024) & 127); else if (n0 >= 1536 && n0 < 2048) nd = 1024 + 256 * ((n0 - 1536) >> 7) + 128 + ((n0 - 1536) & 127); }
#pragma unroll 8
    for (int i = 0; i < 32; ++i) { const int kk = 2 * i + (lane >> 5); scr[kk * 33 + (lane & 31)] = W[(size_t)(k0 + kk) * N + n0 + (lane & 31)]; }
    LDS_WAIT(); asm volatile("" ::: "memory");
    const int c = lane & 7;
#pragma unroll
    for (int j = 0; j < 4; ++j) { const int n = (lane >> 3) + 8 * j; const LAS float* s = scr + (8 * c) * 33 + n;
        v4u o; o.x = pk2(s[0 * 33], s[1 * 33]); o.y = pk2(s[2 * 33], s[3 * 33]); o.z = pk2(s[4 * 33], s[5 * 33]); o.w = pk2(s[6 * 33], s[7 * 33]);
        *(v4u*)(WT + (size_t)(nd + n) * K + k0 + 8 * c) = o; }
    LDS_WAIT(); asm volatile("" ::: "memory");
}

__device__ __forceinline__ void p0_prologue(const Args& a, LAS unsigned char* lds, int tid, int lane, int wave) {
    const int G = gridDim.x, bx = blockIdx.x;
    unsigned char* ws = a.ws;
    {
        LAS float* part = (LAS float*)lds;
        float* MOD = (float*)(ws + WS_MOD);
        const float* c = a.in[I_C]; const float* cctx = a.in[I_CCTX];
        for (int un = bx; un < 192; un += G) {
            const int l = un / 96, n0 = (un % 96) * 32, cq = tid & 7, ks = tid >> 3;
            const float* wm = a.in[I_WMOD] + (size_t)l * 1024 * 3072 + n0 + cq * 4;
            f32x4 acc0 = {0.f, 0.f, 0.f, 0.f}, acc1 = acc0, acc2 = acc0;
#pragma unroll 4
            for (int kk = 0; kk < 16; ++kk) { const int k = ks * 16 + kk; const f32x4 w = *(const f32x4*)(wm + (size_t)k * 3072);
                const float a0 = siluf_(c[k]), a1 = siluf_(c[1024 + k]), a2 = siluf_(cctx[k]);
                acc0 += w * a0; acc1 += w * a1; acc2 += w * a2; }
            *(LAS f32x4*)(part + (0 * 64 + ks) * 32 + cq * 4) = acc0;
            *(LAS f32x4*)(part + (1 * 64 + ks) * 32 + cq * 4) = acc1;
            *(LAS f32x4*)(part + (2 * 64 + ks) * 32 + cq * 4) = acc2;
            __syncthreads();
            if (tid < 96) { const int v = tid >> 5, col = tid & 31; float s = a.in[I_BMOD][l * 3072 + n0 + col];
                for (int k2 = 0; k2 < 64; ++k2) s += part[(v * 64 + k2) * 32 + col];
                MOD[(l * 3 + v) * 3072 + n0 + col] = s; }
            __syncthreads();
        }
    }
    {
        v4u* GWF = (v4u*)(ws + WS_GWF);
        for (int idx = bx * NTHR + tid; idx < 32768; idx += G * NTHR) {
            const int ln = idx & 63, kk = (idx >> 6) & 1, ct = (idx >> 7) & 3, h = (idx >> 9) & 7, g = (idx >> 12) & 1, d = (idx >> 13) & 1, l = idx >> 14;
            const float* W = (g == 0 ? a.in[I_WR] : a.in[I_WI]) + (size_t)(((l * 2 + d) * 8 + h) * 64) * 64;
            const int k0 = 32 * kk + 8 * (ln >> 4), col = 16 * ct + (ln & 15);
            float e[8];
#pragma unroll
            for (int j = 0; j < 8; ++j) e[j] = W[(k0 + j) * 64 + col];
            v4u o; o.x = pk2(e[0], e[1]); o.y = pk2(e[2], e[3]); o.z = pk2(e[4], e[5]); o.w = pk2(e[6], e[7]);
            GWF[idx] = o;
        }
    }
    {
        LAS float* scr = (LAS float*)(lds + wave * 16384);
        const int gw = bx * NWAVES + wave, NGW = G * NWAVES;
        constexpr int I_1 = (1024 / 64) * (NIN / 32), I_2 = (1024 / 64) * (1024 / 32), NITEMS = 2 * (I_1 + I_2);
        bf16* BT1 = (bf16*)(ws + WS_BT1); bf16* BT2 = (bf16*)(ws + WS_BT2);
        for (int it = gw; it < NITEMS; it += NGW) {
            int r = it;
            if (r < I_1) { p0_transpose_item(a.in[I_WIN], 1024, NIN, BT1, scr, r, lane, true); continue; } r -= I_1;
            if (r < I_1) { p0_transpose_item(a.in[I_WIN] + (size_t)1024 * NIN, 1024, NIN, BT1 + (size_t)NIN * 1024, scr, r, lane, true); continue; } r -= I_1;
            if (r < I_2) { p0_transpose_item(a.in[I_WOUT], 1024, 1024, BT2, scr, r, lane, false); continue; } r -= I_2;
            p0_transpose_item(a.in[I_WOUT] + (size_t)1024 * 1024, 1024, 1024, BT2 + (size_t)1024 * 1024, scr, r, lane, false);
        }
    }
}

__device__ __forceinline__ void norm_phase(const Args& a, int mode, int lane, int wave) {
    unsigned char* ws = a.ws;
    const float* MOD = (const float*)(ws + WS_MOD); const bf16* MIX = (const bf16*)(ws + WS_MIX); const float* SSQ = (const float*)(ws + WS_SSQ);
    float* XC1 = (float*)(ws + WS_XC1); bf16* H = (bf16*)(ws + WS_H);
    const int gw = blockIdx.x * NWAVES + wave, NGW = gridDim.x * NWAVES;
    const int nrows = (mode == 2) ? MLAT : MROWS, lu = (mode == 1) ? 0 : 1, ln = (mode == 0) ? 0 : 1;
    for (int row = gw; row < nrows; row += NGW) {
        const int vsel = row < MLAT ? (row >> 13) : 2;
        const float* src;
        if (mode == 2) src = a.out + (size_t)row * 1024;
        else src = row < MLAT ? a.in[I_X] + (size_t)row * 1024 : a.in[I_CTX] + (size_t)(row - MLAT) * 1024;
        f32x4 v[4];
#pragma unroll
        for (int j = 0; j < 4; ++j) v[j] = *((const f32x4*)src + lane + 64 * j);
        if (mode >= 1) {
            const float sp = lane < 16 ? SSQ[(size_t)row * 16 + lane] : 0.f;
            const float rstd = rsqrtf(wave_sum(sp) * (1.0f / 1024.0f) + EPSF);
            const float* gate = MOD + (lu * 3 + vsel) * 3072 + 2048; const float* gp = a.in[I_GPOST] + lu * 1024;
#pragma unroll
            for (int j = 0; j < 4; ++j) { const v2u mq = *((const v2u*)(MIX + (size_t)row * 1024) + lane + 64 * j); const f32x4 mx = {bflo(mq.x), bfhi(mq.x), bflo(mq.y), bfhi(mq.y)};
                const f32x4 gt = *((const f32x4*)gate + lane + 64 * j), gv = *((const f32x4*)gp + lane + 64 * j);
                v[j] += gt * (mx * rstd * gv); }
            float* dst = row < MLAT ? a.out + (size_t)row * 1024 : XC1 + (size_t)(row - MLAT) * 1024;
#pragma unroll
            for (int j = 0; j < 4; ++j) *((f32x4*)dst + lane + 64 * j) = v[j];
        }
        if (mode <= 1) {
            float s = 0.f;
#pragma unroll
            for (int j = 0; j < 4; ++j) s += (v[j].x * v[j].x + v[j].y * v[j].y) + (v[j].z * v[j].z + v[j].w * v[j].w);
            const float r = rsqrtf(wave_sum(s) * (1.0f / 1024.0f) + EPSF);
            const float* shift = MOD + (ln * 3 + vsel) * 3072; const float* scale = shift + 1024; const float* gpre = a.in[I_GPRE] + ln * 1024;
            v2u* o8 = (v2u*)(H + (size_t)row * 1024);
#pragma unroll
            for (int j = 0; j < 4; ++j) { const f32x4 sh = *((const f32x4*)shift + lane + 64 * j), sc = *((const f32x4*)scale + lane + 64 * j), gv = *((const f32x4*)gpre + lane + 64 * j);
                const f32x4 hv = v[j] * r * gv * (sc + 1.0f) + sh;
                v2u w; w.x = pk2(hv.x, hv.y); w.y = pk2(hv.z, hv.w); o8[lane + 64 * j] = w; }
        }
    }
}

__device__ __forceinline__ void conv16(const LAS unsigned* vt, const float (&w0)[31], const float (&w1)[31], float b0, float b1, float (&o0)[16], float (&o1)[16]) {
#pragma unroll
    for (int t = 0; t < 16; ++t) { o0[t] = b0; o1[t] = b1; }
#pragma unroll
    for (int rr = 0; rr < 46; ++rr) { const unsigned u = vt[rr * 128]; const float lo = bflo(u), hi = bfhi(u);
#pragma unroll
        for (int t = 0; t < 16; ++t) { const int k = rr - t; if (k >= 0 && k < 31) { o0[t] += w0[k] * lo; o1[t] += w1[k] * hi; } }
        if ((rr & 3) == 3) asm volatile("" ::: "memory"); }
}
__device__ __forceinline__ v4u glu8(const v4u vq, const v4u gq) {
    v4u o;
    o.x = pk2(bflo(vq.x) * sigmoidf_(bflo(gq.x)), bfhi(vq.x) * sigmoidf_(bfhi(gq.x)));
    o.y = pk2(bflo(vq.y) * sigmoidf_(bflo(gq.y)), bfhi(vq.y) * sigmoidf_(bfhi(gq.y)));
    o.z = pk2(bflo(vq.z) * sigmoidf_(bflo(gq.z)), bfhi(vq.z) * sigmoidf_(bfhi(gq.z)));
    o.w = pk2(bflo(vq.w) * sigmoidf_(bflo(gq.w)), bfhi(vq.w) * sigmoidf_(bfhi(gq.w)));
    return o;
}
__device__ __forceinline__ void hconv_unit(const Args& a, LAS unsigned char* lds, int l, int r0, int g, int vlo, int vhi, int tid) {
    const bf16* U = (const bf16*)(a.ws + WS_U); bf16* Y = (bf16*)(a.ws + WS_Y);
    LAS unsigned* VT = (LAS unsigned*)lds;
    {
        v4u vq[6];
#pragma unroll
        for (int it = 0; it < 6; ++it) { const int i = tid + it * NTHR, rr = i >> 5, ch = i & 31, row = r0 - 15 + rr; const bool ok = i < 94 * 32 && row >= vlo && row < vhi;
            vq[it] = *(const v4u*)(U + (size_t)(ok ? row : r0) * NIN + 1024 + g * 256 + ch * 8); }
#pragma unroll
        for (int it = 0; it < 6; ++it) { const int i = tid + it * NTHR, rr = i >> 5, ch = i & 31, row = r0 - 15 + rr; const bool ok = row >= vlo && row < vhi;
            if (i < 94 * 32) { const v4u z = {0u, 0u, 0u, 0u}; *(LAS v4u*)(VT + rr * 128 + ch * 4) = ok ? vq[it] : z; } }
    }
    __syncthreads();
    int p = tid & 127; asm volatile("" : "+v"(p));
    const int tg = tid >> 7, c0 = g * 256 + 2 * p;
    float w0[31], w1[31];
#pragma unroll
    for (int k = 0; k < 31; ++k) { const float2 w = *(const float2*)(a.in[I_DWW] + (size_t)(l * 31 + k) * 512 + c0); w0[k] = w.x; w1[k] = w.y; }
    const float2 bb = *(const float2*)(a.in[I_DWB] + l * 512 + c0);
    float o0[16], o1[16];
    conv16(VT + (tg * 16) * 128 + p, w0, w1, bb.x, bb.y, o0, o1);
#pragma unroll
    for (int t = 0; t < 16; ++t) *(unsigned*)(Y + (size_t)(r0 + tg * 16 + t) * 512 + c0) = pk2(o0[t], o1[t]);
    __syncthreads();
}
__device__ __forceinline__ void vconv_unit(const Args& a, LAS unsigned char* lds, int l, int b, int w, int tid) {
    const bf16* U = (const bf16*)(a.ws + WS_U); bf16* Y = (bf16*)(a.ws + WS_Y);
    LAS unsigned* VT = (LAS unsigned*)lds;
#pragma unroll 1
    for (int hb = 0; hb < 2; ++hb) {
        v4u vq[5];
#pragma unroll
        for (int it = 0; it < 5; ++it) { const int i = tid + (hb * 5 + it) * NTHR, rr = i >> 5, ch = i & 31, gr = rr - 15; const bool ok = i < 158 * 32 && gr >= 0 && gr < 128;
            vq[it] = *(const v4u*)(U + (size_t)(b * SEQ + (ok ? gr : 0) * 64 + w) * NIN + 1024 + 256 + ch * 8); }
#pragma unroll
        for (int it = 0; it < 5; ++it) { const int i = tid + (hb * 5 + it) * NTHR, rr = i >> 5, ch = i & 31, gr = rr - 15; const bool ok = gr >= 0 && gr < 128;
            if (i < 158 * 32) { const v4u z = {0u, 0u, 0u, 0u}; *(LAS v4u*)(VT + rr * 128 + ch * 4) = ok ? vq[it] : z; } }
    }
    __syncthreads();
    int p = tid & 127; asm volatile("" : "+v"(p));
    const int tg = tid >> 7, c0 = 256 + 2 * p;
    float w0[31], w1[31];
#pragma unroll
    for (int k = 0; k < 31; ++k) { const float2 wv = *(const float2*)(a.in[I_DWW] + (size_t)(l * 31 + k) * 512 + c0); w0[k] = wv.x; w1[k] = wv.y; }
    const float2 bb = *(const float2*)(a.in[I_DWB] + l * 512 + c0);
#pragma unroll 1
    for (int half = 0; half < 2; ++half) {
        const int tb = tg * 32 + half * 16;
        float o0[16], o1[16];
        conv16(VT + tb * 128 + p, w0, w1, bb.x, bb.y, o0, o1);
#pragma unroll
        for (int t = 0; t < 16; ++t) *(unsigned*)(Y + (size_t)(b * SEQ + (tb + t) * 64 + w) * 512 + c0) = pk2(o0[t], o1[t]);
    }
    __syncthreads();
}
__device__ __forceinline__ void ln_rows(const Args& a, int l, int nrows, int lane, int wave) {
    const bf16* U = (const bf16*)(a.ws + WS_U); const bf16* Y = (const bf16*)(a.ws + WS_Y); bf16* MIXIN = (bf16*)(a.ws + WS_MIXIN);
    const int gw = blockIdx.x * NWAVES + wave, NGW = gridDim.x * NWAVES, c0 = lane * 8;
    float lg[8], lb[8];
#pragma unroll
    for (int e = 0; e < 8; ++e) { lg[e] = a.in[I_LNG][l * 512 + c0 + e]; lb[e] = a.in[I_LNB][l * 512 + c0 + e]; }
    for (int row = gw; row < nrows; row += NGW) {
        const v4u yq = *(const v4u*)(Y + (size_t)row * 512 + c0); const v4u gq = *(const v4u*)(U + (size_t)row * NIN + 2048 + c0);
        float y[8] = {bflo(yq.x), bfhi(yq.x), bflo(yq.y), bfhi(yq.y), bflo(yq.z), bfhi(yq.z), bflo(yq.w), bfhi(yq.w)};
        const float gt[8] = {bflo(gq.x), bfhi(gq.x), bflo(gq.y), bfhi(gq.y), bflo(gq.z), bfhi(gq.z), bflo(gq.w), bfhi(gq.w)};
        float s = 0.f;
#pragma unroll
        for (int e = 0; e < 8; ++e) s += y[e];
        const float mean = wave_sum(s) * (1.0f / 512.0f); float q = 0.f;
#pragma unroll
        for (int e = 0; e < 8; ++e) { y[e] -= mean; q += y[e] * y[e]; }
        const float rstd = rsqrtf(wave_sum(q) * (1.0f / 512.0f) + EPSF);
        float o[8];
#pragma unroll
        for (int e = 0; e < 8; ++e) o[e] = siluf_(y[e] * rstd * lg[e] + lb[e]) * gt[e];
        v4u w; w.x = pk2(o[0], o[1]); w.y = pk2(o[2], o[3]); w.z = pk2(o[4], o[5]); w.w = pk2(o[6], o[7]);
        *(v4u*)(MIXIN + (size_t)row * 1024 + 512 + c0) = w;
    }
}

constexpr int RG_GW = 0, RG_FOLD = 32768, RG_F8 = 36864, RG_CAR = 40960, RG_WAVE = 57344, RG_WAVE_BYTES = 12544;
constexpr int NP16 = 4 * NPJ;
__device__ __forceinline__ float fsig(float x) { return __builtin_amdgcn_rcpf(1.0f + __expf(-x)); }

template <bool FINAL, int D>
__device__ __forceinline__ void rg_sweep(const Args& a, LAS unsigned char* lds, LAS unsigned char* wl, int l, int b, int h, int r0, int seg_lo, int seg_hi, int pj, bool is_ctx, int w, int lane) {
    const bf16* U = (const bf16*)(a.ws + WS_U); bf16* MIXIN = (bf16*)(a.ws + WS_MIXIN);
    float* AGGA = (float*)(a.ws + WS_AGGA); float* AGGB = (float*)(a.ws + WS_AGGB); float* A16 = (float*)(a.ws + WS_A16); float* B16 = (float*)(a.ws + WS_B16);
    LAS float* VCW = (LAS float*)wl; LAS unsigned* HBW = (LAS unsigned*)(wl + 4352);
    const LAS v4u* GWL = (const LAS v4u*)(lds + RG_GW) + (D * 2) * 8 * 64 + lane;
    const LAS float* CAR = (const LAS float*)(lds + RG_CAR);
    const int fr = lane & 15, fq = lane >> 4, cp = lane & 31, rh = lane >> 5;
    float2 cw[4];
#pragma unroll
    for (int k = 0; k < 4; ++k) cw[k] = *(const float2*)(a.in[I_CAW] + (size_t)((l * 2 + D) * 4 + k) * 512 + 64 * h + 2 * cp);
    const float2 cbv = *(const float2*)(a.in[I_CAB] + (l * 2 + D) * 512 + 64 * h + 2 * cp);
    float brv[4], biv[4], sp8[4], Hc[4], Ac[4];
    const int p16own = 4 * pj + (D ? 3 - fq : fq);
#pragma unroll
    for (int ct = 0; ct < 4; ++ct) { const int c = 16 * ct + fr, pidx = (l * 2 + D) * 512 + 64 * h + c;
        brv[ct] = a.in[I_BR][pidx]; biv[ct] = a.in[I_BI][pidx]; sp8[ct] = -8.0f * log1pf(__expf(-a.in[I_LAM][pidx]));
        Hc[ct] = 0.f; Ac[ct] = 1.f;
        if (FINAL) {
            if (is_ctx) { const size_t base = (size_t)((b * 2 + D) * NP16) * 512 + 64 * h + c; float S = 0.f;
                for (int i = 0; i < p16own; ++i) S = A16[base + (size_t)i * 512] * S + B16[base + (size_t)i * 512];
                Hc[ct] = S; }
            else Hc[ct] = CAR[(D * 32 + (D ? 31 - (4 * w + fq) : 4 * w + fq)) * 64 + c];
        } }
    const bf16* ub = U + 64 * h + 2 * cp;
    unsigned Wd[2][7], nx[2][4];
#pragma unroll
    for (int q = 0; q < 2; ++q) { const int g = 2 * rh + q;
#pragma unroll
        for (int j = 0; j < 3; ++j) { const int row = r0 + 16 * g + (D ? 16 + j : j - 3); const bool ok = row >= seg_lo && row < seg_hi; const int rc = ok ? row : r0;
            const unsigned v = *(const unsigned*)(ub + (size_t)rc * NIN); Wd[q][D ? j : 4 + j] = ok ? v : 0u; }
#pragma unroll
        for (int j = 0; j < 4; ++j) nx[q][j] = *(const unsigned*)(ub + (size_t)(r0 + 16 * g + 4 * (D ? 3 : 0) + j) * NIN); }
#pragma unroll 1
    for (int ti = 0; ti < 4; ++ti) {
        const int tile = D ? 3 - ti : ti;
        int zo = 0; asm volatile("" : "+v"(zo));
        const LAS v4u* GWLt = GWL + zo;
        v4u g0 = {0u, 0u, 0u, 0u}, g1 = g0; size_t orow = 0;
        if (FINAL && D == 0) { orow = (size_t)(r0 + 16 * (fr >> 2) + 4 * tile + (fr & 3)); const bf16* gp = U + orow * NIN + 512 + 64 * h + 16 * fq; g0 = *(const v4u*)gp; g1 = *(const v4u*)(gp + 8); }
#pragma unroll
        for (int q = 0; q < 2; ++q) {
            if (D == 0) { Wd[q][0] = Wd[q][4]; Wd[q][1] = Wd[q][5]; Wd[q][2] = Wd[q][6]; Wd[q][3] = nx[q][0]; Wd[q][4] = nx[q][1]; Wd[q][5] = nx[q][2]; Wd[q][6] = nx[q][3]; }
            else { Wd[q][4] = Wd[q][0]; Wd[q][5] = Wd[q][1]; Wd[q][6] = Wd[q][2]; Wd[q][0] = nx[q][0]; Wd[q][1] = nx[q][1]; Wd[q][2] = nx[q][2]; Wd[q][3] = nx[q][3]; } }
        if (ti < 3) { const int tn = D ? 2 - ti : ti + 1;
#pragma unroll
            for (int q = 0; q < 2; ++q)
#pragma unroll
                for (int j = 0; j < 4; ++j) nx[q][j] = *(const unsigned*)(ub + (size_t)(r0 + 16 * (2 * rh + q) + 4 * tn + j) * NIN); }
#pragma unroll
        for (int q = 0; q < 2; ++q)
#pragma unroll
            for (int jj = 0; jj < 4; ++jj) { float v0 = cbv.x, v1 = cbv.y;
#pragma unroll
                for (int k = 0; k < 4; ++k) { const unsigned u = Wd[q][jj + k]; v0 += cw[k].x * bflo(u); v1 += cw[k].y * bfhi(u); }
                *(LAS f32x2v*)(VCW + (4 * (2 * rh + q) + jj) * 68 + 2 * cp) = (f32x2v){v0, v1}; }
        bf16x8 af[2];
#pragma unroll
        for (int kk = 0; kk < 2; ++kk) { const LAS float* vp = VCW + fr * 68 + 32 * kk + 8 * fq; const f32x4 x0 = *(const LAS f32x4*)vp, x1 = *(const LAS f32x4*)(vp + 4);
            v4u pk; pk.x = cvtpk(x0.x, x0.y); pk.y = cvtpk(x0.z, x0.w); pk.z = cvtpk(x1.x, x1.y); pk.w = cvtpk(x1.z, x1.w); af[kk] = __builtin_bit_cast(bf16x8, pk); }
        float vcv[4][4];
#pragma unroll
        for (int ct = 0; ct < 4; ++ct)
#pragma unroll
            for (int jj = 0; jj < 4; ++jj) vcv[ct][jj] = VCW[(4 * fq + jj) * 68 + 16 * ct + fr];
        f32x4 accr[4], acci[4];
#pragma unroll
        for (int ct = 0; ct < 4; ++ct) { accr[ct] = (f32x4){0.f, 0.f, 0.f, 0.f}; acci[ct] = accr[ct];
#pragma unroll
            for (int kk = 0; kk < 2; ++kk) { const bf16x8 br = __builtin_bit_cast(bf16x8, GWLt[(ct * 2 + kk) * 64]), bi = __builtin_bit_cast(bf16x8, GWLt[(8 + ct * 2 + kk) * 64]);
                accr[ct] = __builtin_amdgcn_mfma_f32_16x16x32_bf16(af[kk], br, accr[ct], 0, 0, 0); acci[ct] = __builtin_amdgcn_mfma_f32_16x16x32_bf16(af[kk], bi, acci[ct], 0, 0, 0); } }
        float hsum[4][4];
#pragma unroll
        for (int ct = 0; ct < 4; ++ct) { float aa[4], bb[4];
            const float nbr = -1.44269504f * brv[ct], nbi = -1.44269504f * biv[ct];
#pragma unroll
            for (int p = 0; p < 2; ++p) {
                f32x2v xr = (f32x2v){accr[ct][2 * p], accr[ct][2 * p + 1]} * -1.44269504f + nbr, xi = (f32x2v){acci[ct][2 * p], acci[ct][2 * p + 1]} * -1.44269504f + nbi;
                xr = __builtin_elementwise_min(xr, (f32x2v){60.f, 60.f}); xi = __builtin_elementwise_min(xi, (f32x2v){60.f, 60.f});
                f32x2v d1, d2; d1.x = __builtin_amdgcn_exp2f(xr.x); d1.y = __builtin_amdgcn_exp2f(xr.y); d2.x = __builtin_amdgcn_exp2f(xi.x); d2.y = __builtin_amdgcn_exp2f(xi.y);
                d1 = d1 + 1.0f; d2 = d2 + 1.0f; const f32x2v m = d1 * d2; f32x2v inv; inv.x = __builtin_amdgcn_rcpf(m.x); inv.y = __builtin_amdgcn_rcpf(m.y);
                const f32x2v r = d2 * inv, ig = d1 * inv, la = r * sp8[ct], x2 = la + la, le = la * 1.44269504f;
                const f32x2v pom = -x2 * (x2 * (x2 * (x2 * (x2 * 0.0083333338f + 0.041666668f) + 0.16666667f) + 0.5f) + 1.0f);
                f32x2v av; av.x = __builtin_amdgcn_exp2f(le.x); av.y = __builtin_amdgcn_exp2f(le.y);
                const f32x2v o2 = 1.0f - av * av; f32x2v om; om.x = x2.x > -0.25f ? pom.x : o2.x; om.y = x2.y > -0.25f ? pom.y : o2.y;
                om = __builtin_elementwise_max(om, (f32x2v){0.f, 0.f});
                f32x2v sq; sq.x = __builtin_amdgcn_sqrtf(om.x); sq.y = __builtin_amdgcn_sqrtf(om.y);
                const f32x2v bv = sq * (ig * (f32x2v){vcv[ct][2 * p], vcv[ct][2 * p + 1]});
                aa[2 * p] = av.x; aa[2 * p + 1] = av.y; bb[2 * p] = bv.x; bb[2 * p + 1] = bv.y; }
            float hh = Hc[ct], A4 = 1.f;
#pragma unroll
            for (int ji = 0; ji < 4; ++ji) { const int jj = D ? 3 - ji : ji; hh = aa[jj] * hh + bb[jj]; A4 *= aa[jj]; hsum[ct][jj] = hh; }
            Hc[ct] = hh; if (!FINAL) Ac[ct] *= A4; }
        if (FINAL) {
            if (D == 1) {
#pragma unroll
                for (int ct = 0; ct < 4; ++ct)
#pragma unroll
                    for (int jp = 0; jp < 2; ++jp) HBW[(tile * 8 + ct * 2 + jp) * 64 + lane] = cvtpk(hsum[ct][2 * jp], hsum[ct][2 * jp + 1]);
            } else {
#pragma unroll
                for (int ct = 0; ct < 4; ++ct)
#pragma unroll
                    for (int jp = 0; jp < 2; ++jp) { const unsigned hb = HBW[(tile * 8 + ct * 2 + jp) * 64 + lane];
                        VCW[(4 * fq + 2 * jp) * 68 + 16 * ct + fr] = hsum[ct][2 * jp] + bflo(hb); VCW[(4 * fq + 2 * jp + 1) * 68 + 16 * ct + fr] = hsum[ct][2 * jp + 1] + bfhi(hb); }
                const size_t row = orow;
                const f32x4 s0 = *(const LAS f32x4*)(VCW + fr * 68 + 16 * fq), s1 = *(const LAS f32x4*)(VCW + fr * 68 + 16 * fq + 4), s2 = *(const LAS f32x4*)(VCW + fr * 68 + 16 * fq + 8), s3 = *(const LAS f32x4*)(VCW + fr * 68 + 16 * fq + 12);
                v4u o0, o1;
                o0.x = cvtpk(s0.x * bflo(g0.x), s0.y * bfhi(g0.x)); o0.y = cvtpk(s0.z * bflo(g0.y), s0.w * bfhi(g0.y)); o0.z = cvtpk(s1.x * bflo(g0.z), s1.y * bfhi(g0.z)); o0.w = cvtpk(s1.z * bflo(g0.w), s1.w * bfhi(g0.w));
                o1.x = cvtpk(s2.x * bflo(g1.x), s2.y * bfhi(g1.x)); o1.y = cvtpk(s2.z * bflo(g1.y), s2.w * bfhi(g1.y)); o1.z = cvtpk(s3.x * bflo(g1.z), s3.y * bfhi(g1.z)); o1.w = cvtpk(s3.z * bflo(g1.w), s3.w * bfhi(g1.w));
                bf16* op = MIXIN + row * 1024 + 64 * h + 16 * fq; *(v4u*)op = o0; *(v4u*)(op + 8) = o1;
            }
        }
    }
    if (!FINAL) {
#pragma unroll
        for (int ct = 0; ct < 4; ++ct) { const int c = 16 * ct + fr;
            const size_t i16 = (size_t)((b * 2 + D) * NP16 + p16own) * 512 + 64 * h + c; A16[i16] = Ac[ct]; B16[i16] = Hc[ct];
            float Ag[4], Bg[4];
#pragma unroll
            for (int g = 0; g < 4; ++g) { Ag[g] = __shfl(Ac[ct], fr + 16 * g); Bg[g] = __shfl(Hc[ct], fr + 16 * g); }
            float run = 0.f;
#pragma unroll
            for (int gi = 0; gi < 4; ++gi) { const int g = D ? 3 - gi : gi; run = Ag[g] * run + Bg[g]; }
            if (fq == 0) { const size_t idx = (size_t)((b * 2 + D) * NPJ + pj) * 512 + 64 * h + c; AGGA[idx] = (Ag[0] * Ag[1]) * (Ag[2] * Ag[3]); AGGB[idx] = run; } }
    }
}

template <bool FINAL>
__device__ __forceinline__ void rg_run(const Args& a, LAS unsigned char* lds, int l, int rn, int tid, int lane, int wave) {
    const bool is_ctx = rn >= 256; const int bh = is_ctx ? rn - 256 : rn >> 4, b = bh >> 3, h = bh & 7, cgp = is_ctx ? 0 : (rn & 15);
    { const v4u* GWF = (const v4u*)(a.ws + WS_GWF); LAS v4u* GWL = (LAS v4u*)(lds + RG_GW);
#pragma unroll
      for (int i = tid; i < 2048; i += NTHR) { const int d = i >> 10, g = (i >> 9) & 1, rest = i & 511; GWL[i] = GWF[(size_t)((((l * 2 + d) * 2 + g) * 8 + h) * 8) * 64 + rest]; } }
    const int P0f = 4 + 8 * cgp, P0b = 124 - 8 * cgp;
    if (FINAL && !is_ctx) {
        const float* AGGA = (const float*)(a.ws + WS_AGGA); const float* AGGB = (const float*)(a.ws + WS_AGGB); const float* A16 = (const float*)(a.ws + WS_A16); const float* B16 = (const float*)(a.ws + WS_B16);
        const int d = tid >> 8, s = (tid >> 6) & 3, c = tid & 63, P0 = d ? P0b : P0f, lo = (P0 * s) >> 2, hi = (P0 * (s + 1)) >> 2;
        const size_t b16 = (size_t)((b * 2 + d) * NP16 + 4 * P0 + 8 * s) * 512 + 64 * h + c; float ai8[8], bi8[8];
#pragma unroll
        for (int i = 0; i < 8; ++i) { ai8[i] = A16[b16 + (size_t)i * 512]; bi8[i] = B16[b16 + (size_t)i * 512]; }
        const size_t base = (size_t)((b * 2 + d) * NPJ) * 512 + 64 * h + c; float A = 1.f, Bv = 0.f;
#pragma unroll 8
        for (int i = lo; i < hi; ++i) { const float ai = AGGA[base + (size_t)i * 512], bi = AGGB[base + (size_t)i * 512]; Bv = ai * Bv + bi; A *= ai; }
        LAS float* FO = (LAS float*)(lds + RG_FOLD); LAS float* F8 = (LAS float*)(lds + RG_F8); LAS float* CAR = (LAS float*)(lds + RG_CAR);
        FO[((d * 4 + s) * 64 + c) * 2] = A; FO[((d * 4 + s) * 64 + c) * 2 + 1] = Bv;
        float A8 = 1.f, B8 = 0.f;
#pragma unroll
        for (int i = 0; i < 8; ++i) { B8 = ai8[i] * B8 + bi8[i]; A8 *= ai8[i]; }
        F8[((d * 4 + s) * 64 + c) * 2] = A8; F8[((d * 4 + s) * 64 + c) * 2 + 1] = B8;
        __syncthreads();
        float S = 0.f;
#pragma unroll
        for (int s2 = 0; s2 < 4; ++s2) S = FO[((d * 4 + s2) * 64 + c) * 2] * S + FO[((d * 4 + s2) * 64 + c) * 2 + 1];
#pragma unroll
        for (int s2 = 0; s2 < 3; ++s2) if (s2 < s) S = F8[((d * 4 + s2) * 64 + c) * 2] * S + F8[((d * 4 + s2) * 64 + c) * 2 + 1];
#pragma unroll
        for (int i = 0; i < 8; ++i) { CAR[(d * 32 + 8 * s + i) * 64 + c] = S; S = ai8[i] * S + bi8[i]; }
    }
    __syncthreads();
    if (wave < (is_ctx ? 4 : 8)) {
        const int j = is_ctx ? wave : 8 * cgp + wave;
        const int seg_lo = is_ctx ? MLAT + b * CTXL : b * SEQ, seg_hi = seg_lo + (is_ctx ? CTXL : SEQ), r0 = seg_lo + 64 * j;
        const int pjf = is_ctx ? j : 4 + j, pjb = is_ctx ? 3 - j : 131 - j;
        LAS unsigned char* wl = lds + RG_WAVE + wave * RG_WAVE_BYTES;
        rg_sweep<FINAL, 1>(a, lds, wl, l, b, h, r0, seg_lo, seg_hi, pjb, is_ctx, wave, lane);
        rg_sweep<FINAL, 0>(a, lds, wl, l, b, h, r0, seg_lo, seg_hi, pjf, is_ctx, wave, lane);
    }
    __syncthreads();
}

#define RLX_AGENT __ATOMIC_RELAXED, __HIP_MEMORY_SCOPE_AGENT


#define XB_TMO      128
#define XB_XCNT(j)  (256  + 64 * (j))
#define XB_XSUB(j)  (1280 + 64 * (j))
#define XB_XGEN(j)  (2304 + 64 * (j))
#define XB_TOP      3328
#define XB_TOPGEN   3392
#define XCD_BAR_WORDS 3456
#define XB_SPIN_CAP (1u << 18)

__device__ __forceinline__ unsigned xb_ld(unsigned* p)              { return __hip_atomic_load(p, __ATOMIC_RELAXED, __HIP_MEMORY_SCOPE_AGENT); }
__device__ __forceinline__ unsigned xb_add(unsigned* p, unsigned v) { return __hip_atomic_fetch_add(p, v, __ATOMIC_RELAXED, __HIP_MEMORY_SCOPE_AGENT); }
__device__ __forceinline__ unsigned xb_xcc_id() { return (unsigned)__builtin_amdgcn_s_getreg((3 << 11) | 20) & 0xFu; }
#define XB_SPIN(cond, bar) do { unsigned _sp = 0; while (cond) { __builtin_amdgcn_s_sleep(1); \
    if ((++_sp & 255u) == 0u) { if (xb_ld(&(bar)[XB_TMO])) break; if (_sp > XB_SPIN_CAP) { atomicAdd(&(bar)[XB_TMO], 1u); break; } } } } while (0)

struct XcdBarrier {
    unsigned* bar; unsigned x;
    volatile LAS unsigned* st;
};

__device__ __forceinline__ XcdBarrier xcd_barrier_post(unsigned* bar, volatile LAS unsigned* st) {
    XcdBarrier b; b.bar = bar; b.x = xb_xcc_id(); b.st = st;
    if (threadIdx.x == 0) (void)xb_add(&bar[XB_XCNT(b.x)], 1u);
    return b;
}
__device__ __forceinline__ void xcd_barrier_complete(unsigned* bar, unsigned x, unsigned& nloc, unsigned& nx) {
    const unsigned G = gridDim.x * gridDim.y * gridDim.z;
    unsigned sum, cnt, mine, sp = 0u;
    for (;;) {
        sum = 0u; cnt = 0u; mine = 0u;
#pragma unroll
        for (unsigned j = 0; j < 16; ++j) { const unsigned c = xb_ld(&bar[XB_XCNT(j)]); sum += c; cnt += (c > 0u) ? 1u : 0u; mine = (j == x) ? c : mine; }
        if (sum == G) break;
        __builtin_amdgcn_s_sleep(1);
        if ((++sp & 255u) == 0u) { if (xb_ld(&bar[XB_TMO])) break; if (sp > XB_SPIN_CAP) { atomicAdd(&bar[XB_TMO], 1u); break; } }
    }
    nloc = mine > 0u ? mine : 1u; nx = cnt > 0u ? cnt : 1u;
}

__device__ __forceinline__ void xcd_barrier(const XcdBarrier& b) {
    asm volatile("s_waitcnt vmcnt(0)" ::: "memory");
    __syncthreads();
    if (threadIdx.x == 0) {
        unsigned* bar = b.bar;
        __builtin_amdgcn_s_waitcnt(0);
        unsigned nloc = b.st[0], nx = b.st[1];
        if (nloc == 0u) { xcd_barrier_complete(bar, b.x, nloc, nx); b.st[0] = nloc; b.st[1] = nx; }
        const unsigned old = xb_add(&bar[XB_XSUB(b.x)], 1u);
        const unsigned gen = old / nloc;
        if (old + 1u == (gen + 1u) * nloc) {
            __builtin_amdgcn_fence(__ATOMIC_RELEASE, "agent");
            asm volatile("s_waitcnt vmcnt(0)" ::: "memory");
            const unsigned og = xb_add(&bar[XB_TOP], 1u);
            const unsigned tg = og / nx;
            if (og + 1u == (tg + 1u) * nx) xb_add(&bar[XB_TOPGEN], 1u);
            else XB_SPIN(xb_ld(&bar[XB_TOPGEN]) == tg, bar);
            __builtin_amdgcn_fence(__ATOMIC_ACQUIRE, "agent");
            xb_add(&bar[XB_XGEN(b.x)], 1u);
            asm volatile("s_waitcnt vmcnt(0)" ::: "memory");
        } else {
            XB_SPIN(xb_ld(&bar[XB_XGEN(b.x)]) == gen, bar);
            __builtin_amdgcn_fence(__ATOMIC_ACQUIRE, "agent");
            asm volatile("s_waitcnt vmcnt(0)" ::: "memory");
        }
    }
    __syncthreads();
}

template <int l>
__device__ __forceinline__ void layer_phases(const Args& args, LAS unsigned char* lds, const int tid, const int lane, const int wave, const int lo, const int hi, const XcdBarrier& xbar) {
    const int G = gridDim.x, bx = blockIdx.x; unsigned char* ws = args.ws;
    constexpr int pb = 1 + 5 * l;
#define IN(k) (lo <= (k) && (k) < hi)
#define SEAM(k) do { if (IN(k) && IN((k) + 1)) { xcd_barrier(xbar); } } while (0)
        if (IN(pb)) { norm_phase(args, l, lane, wave); }
        SEAM(pb);
        if (IN(pb + 1)) {
            pg8::Gemm g{(const pg8::bf16_t*)(ws + WS_H), (const pg8::bf16_t*)(ws + WS_BT1) + (size_t)l * NIN * 1024, MROWS, NIN, 1024};
            pg8::StaticOrder S; S.init(MROWS, NIN, G, bx);
            pg8::EpiU E{(pg8::bf16_t*)(ws + WS_U)};
            pg8::gemm_phase<pg8::EpiU, pg8::StaticOrder, true, true>(lds, g, S, E);
        }
        SEAM(pb + 1);
        if (IN(pb + 2)) {
            rg_run<false>(args, lds, l, bx, tid, lane, wave);
            const int n_h = 256 + (l == 0 ? 16 : 0), n_conv = 128 + n_h;
            const int GC = G - 16;
            for (int un = bx; un < n_conv && bx < GC; un += GC) {
                if (un < 128) { vconv_unit(args, lds, l, un >> 6, un & 63, tid); }
                else { const int hu = un - 128;
                    if (hu < 256) hconv_unit(args, lds, l, hu * 64, 0, hu * 64, hu * 64 + 64, tid);
                    else { const int cu = hu - 256, cc = cu >> 1, g = cu & 1, bb = cc >> 2; hconv_unit(args, lds, l, MLAT + cc * 64, g, MLAT + bb * CTXL, MLAT + bb * CTXL + CTXL, tid); } }
            }
            if (bx >= G - 16) rg_run<false>(args, lds, l, 256 + (G - 1 - bx), tid, lane, wave);
        }
        SEAM(pb + 2);
        if (IN(pb + 3)) {
            rg_run<true>(args, lds, l, bx, tid, lane, wave);
            if (l == 0 && bx >= G - 16) rg_run<true>(args, lds, l, 256 + (G - 1 - bx), tid, lane, wave);
            ln_rows(args, l, (l == 0) ? MROWS : MLAT, lane, wave);
        }
        SEAM(pb + 3);
        if (IN(pb + 4)) {
            const int M2 = (l == 0) ? MROWS : MLAT;
            pg8::Gemm g{(const pg8::bf16_t*)(ws + WS_MIXIN), (const pg8::bf16_t*)(ws + WS_BT2) + (size_t)l * 1024 * 1024, M2, 1024, 1024};
            pg8::StaticOrder S; S.init(M2, 1024, G, bx);
            pg8::EpiMix E{(pg8::bf16_t*)(ws + WS_MIX), (float*)(ws + WS_SSQ)};
            pg8::gemm_phase<pg8::EpiMix, pg8::StaticOrder, true, true>(lds, g, S, E);
        }
        SEAM(pb + 4);
#undef IN
#undef SEAM
}

__global__ void __launch_bounds__(NTHR, 2) fwd_megakernel(Args args) {
    extern __shared__ __attribute__((aligned(16))) unsigned char lds_raw[];
    LAS unsigned char* lds = (LAS unsigned char*)lds_raw;
    const int tid = threadIdx.x, lane = tid & 63, wave = __builtin_amdgcn_readfirstlane(tid >> 6);
    const int G = gridDim.x, bx = blockIdx.x;
    unsigned char* ws = args.ws;
    const int lo = args.ph_lo, hi = args.ph_hi;
    if (args.coop == 2) cg::this_grid().sync();
    volatile LAS unsigned* MISC = (volatile LAS unsigned*)(lds + MISC_OFF);
    if (tid < 64) MISC[tid] = 0u;
    __syncthreads();
    XcdBarrier xbar; xbar.bar = (unsigned*)(ws + WS_CTL); xbar.x = 0; xbar.st = nullptr;
    if (args.coop == 1) xbar = xcd_barrier_post((unsigned*)(ws + WS_CTL), MISC + 8);
#define IN(k) (lo <= (k) && (k) < hi)
#define SEAM(k) do { if (IN(k) && IN((k) + 1)) { xcd_barrier(xbar); } } while (0)

    if (IN(0)) { p0_prologue(args, lds, tid, lane, wave); }
    SEAM(0);
    layer_phases<0>(args, lds, tid, lane, wave, lo, hi, xbar);
    layer_phases<1>(args, lds, tid, lane, wave, lo, hi, xbar);
    if (IN(11)) { norm_phase(args, 2, lane, wave); }
#undef IN
#undef SEAM
}

#ifndef MK_PER_PHASE
#define MK_PER_PHASE 0
#endif
extern "C" void kernel_launch(void* const* d_in, const int* in_sizes, int n_in, void* d_out, int out_size, void* d_ws, size_t ws_size, hipStream_t stream) {
    static int grid = 0;
    if (grid == 0) {
        if (n_in != 21 || out_size != MLAT * DM || ws_size < WS_END) { fprintf(stderr, "kernel_launch: unexpected shapes (n_in %d, out %d, ws %zu)\n", n_in, out_size, ws_size); grid = -1; return; }
        int dev = 0, cus = 0, per_cu = 0;
        if (hipGetDevice(&dev) != hipSuccess || hipDeviceGetAttribute(&cus, hipDeviceAttributeMultiprocessorCount, dev) != hipSuccess) { grid = -1; return; }
        if (hipFuncSetAttribute((const void*)fwd_megakernel, hipFuncAttributeMaxDynamicSharedMemorySize, LDS_BYTES) != hipSuccess) { fprintf(stderr, "kernel_launch: hipFuncSetAttribute failed\n"); grid = -1; return; }
        if (hipOccupancyMaxActiveBlocksPerMultiprocessor(&per_cu, (const void*)fwd_megakernel, NTHR, LDS_BYTES) != hipSuccess || per_cu < 1) { fprintf(stderr, "kernel_launch: occupancy query says %d\n", per_cu); per_cu = 1; }
        (void)hipGetLastError();
        grid = cus;
    }
    if (grid < 0) return;
    if (hipMemsetAsync((char*)d_ws + WS_CTL, 0, CTL_ZERO_BYTES, stream) != hipSuccess) { fprintf(stderr, "kernel_launch: memset failed\n"); return; }
    Args a{};
    for (int i = 0; i < 21; ++i) a.in[i] = (const float*)d_in[i];
    a.out = (float*)d_out; a.ws = (unsigned char*)d_ws;
#if MK_PER_PHASE
    for (int ph = 0; ph < 12; ++ph) { a.ph_lo = ph; a.ph_hi = ph + 1; a.coop = 0;
        hipLaunchKernelGGL(fwd_megakernel, dim3(grid), dim3(NTHR), LDS_BYTES, stream, a); }
#else
    a.ph_lo = 0; a.ph_hi = 12; a.coop = 1;
    void* kargs[] = {&a};
    hipError_t e = hipLaunchCooperativeKernel((const void*)fwd_megakernel, dim3(grid), dim3(NTHR), kargs, LDS_BYTES, stream);
    if (e != hipSuccess) fprintf(stderr, "cooperative launch failed: %s (grid %d)\n", hipGetErrorString(e), grid);
#endif
}
```

```cpp
#include <hip/hip_runtime.h>
#include <hip/hip_cooperative_groups.h>
#include <cstdio>
#include <cstdint>
namespace cg = cooperative_groups;
#define MK_PER_PHASE 0
namespace pg8 {
#define PG8_LAS __attribute__((address_space(3)))
typedef unsigned short bf16_t;
typedef short bf16x8 __attribute__((ext_vector_type(8)));
typedef float f32x4 __attribute__((ext_vector_type(4)));
typedef unsigned u32x4 __attribute__((ext_vector_type(4)));
constexpr int BM = 256, BK = 64, HALF = 128, HTB = HALF * BK * 2  , STAGE_BYTES = 8 * HTB, NXCD = 8, WGM = 8;

__host__ __device__ __forceinline__ int lds_byte(int r, int c) { const int st = (r >> 4) * 2 + (c >> 5), rr = r & 15, cc = c & 31, ob = rr * 64 + cc * 2; return st * 1024 + (ob ^ (((ob >> 9) & 1) << 5)); }
__host__ __device__ __forceinline__ void stage_rc(int b, int& R, int& C) { const int st = b / 1024, sb = b % 1024, swz = sb ^ (((sb >> 9) & 1) << 5); R = (st >> 1) * 16 + swz / 64; C = (st & 1) * 32 + (swz % 64) / 2; }
__host__ __device__ __forceinline__ int perm32(int rho) { const int n = rho >> 4, i = rho & 15; return 8 * (i >> 2) + 4 * n + (i & 3); }

struct Unit { int pm, pn; };
struct Gemm { const bf16_t* A; const bf16_t* Bt; int M, N, K; };

struct StaticOrder {
    int nM, nN, nwg, G, c;
    __host__ __device__ void init(int M, int N, int G_, int c_) { nM = M / BM; nN = N / BM; nwg = nM * nN; G = G_; c = c_; }
    __host__ __device__ bool next(int i, Unit& u) const {
        const long L = (long)i * G + c; if (L >= nwg) return false;
        int wgid = (int)L; { const int q = nwg / NXCD, r = nwg % NXCD, xcd = wgid % NXCD, off = wgid / NXCD; wgid = (xcd < r ? xcd * (q + 1) : r * (q + 1) + (xcd - r) * q) + off; }
        const int nig = WGM * nN, gid = wgid / nig, fm = gid * WGM, gsz = (nM - fm) < WGM ? (nM - fm) : WGM;
        u.pm = fm + ((wgid % nig) % gsz); u.pn = (wgid % nig) / gsz; return true;
    }
    __device__ __forceinline__ void a_ready(const Unit&) const {}
    __device__ __forceinline__ void done(const Unit&) const {}
};
__device__ __forceinline__ unsigned cvt_pk_bf16(float lo, float hi) { unsigned r; asm volatile("v_cvt_pk_bf16_f32 %0, %1, %2" : "=v"(r) : "v"(lo), "v"(hi)); return r; }
typedef float f32x2 __attribute__((ext_vector_type(2)));
template <class Epi, class Sched, bool ALIGN_EPI = false, bool SP2 = false>
__device__ __forceinline__ void gemm_phase(PG8_LAS unsigned char* lds, const Gemm g, const Sched& S, const Epi& E) {
    const int tid = threadIdx.x, wid = __builtin_amdgcn_readfirstlane(tid >> 6), lane = tid & 63, wr = wid >> 2, wc = wid & 3, fr = lane & 15, fq = lane >> 4;
    const int K = g.K, nt = K / BK;
    unsigned voffA[2], voffB[2];
#pragma unroll
    for (int i = 0; i < 2; ++i) { int R, C; stage_rc(tid * 16 + i * 8192, R, C); const int Rb = Epi::PERM ? ((R & ~31) + perm32(R & 31)) : R;
        voffA[i] = (unsigned)(R * K + C) * 2u; voffB[i] = (unsigned)(Rb * K + C) * 2u; }
    const size_t kstep = (size_t)(BK * 2);
    const size_t hstep = (size_t)HALF * K * 2;
    const size_t tstep = 2 * hstep;
    const unsigned ldsw = (unsigned)wid * 1024u;
    const int aoff = lds_byte(wr * 64 + fr, fq * 8), boff = lds_byte(wc * 32 + fr, fq * 8);
#define PG8_SA(b, h) (((b) * 2 + (h)) * HTB)
#define PG8_SB(b, h) ((4 + (b) * 2 + (h)) * HTB)
#define PG8_STAGE(bufoff, gbase, voff) do { _Pragma("unroll") for (int _i = 0; _i < 2; ++_i) \
        __builtin_amdgcn_global_load_lds((const unsigned*)((const char*)(gbase) + (voff)[_i]), (PG8_LAS unsigned*)(lds + (bufoff) + ldsw + _i * 8192), 16, 0, 0); } while (0)
#define PG8_LDA(dst, b, h) do { _Pragma("unroll") for (int m = 0; m < 4; ++m) _Pragma("unroll") for (int k = 0; k < 2; ++k) dst[m][k] = *(const PG8_LAS bf16x8*)(lds + PG8_SA(b, h) + aoff + m * 2048 + k * 1024); } while (0)
#define PG8_LDB(dst, b, h) do { _Pragma("unroll") for (int n = 0; n < 2; ++n) _Pragma("unroll") for (int k = 0; k < 2; ++k) dst[n][k] = *(const PG8_LAS bf16x8*)(lds + PG8_SB(b, h) + boff + n * 2048 + k * 1024); } while (0)
#define PG8_MMA(ai, bj, At, Bt) do { __builtin_amdgcn_s_setprio(1); _Pragma("unroll") for (int m = 0; m < 4; ++m) _Pragma("unroll") for (int n = 0; n < 2; ++n) _Pragma("unroll") for (int k = 0; k < 2; ++k) \
        acc[ai][bj][m][n] = __builtin_amdgcn_mfma_f32_16x16x32_bf16(Bt[n][k], At[m][k], acc[ai][bj][m][n], 0, 0, 0); __builtin_amdgcn_s_setprio(0); } while (0)
#define PG8_WAIT_V(n) asm volatile("s_waitcnt vmcnt(" #n ")" ::: "memory")
#define PG8_WAIT_L(n) asm volatile("s_waitcnt lgkmcnt(" #n ")" ::: "memory")
#define PG8_BAR __builtin_amdgcn_s_barrier()
#define PG8_SCHED __builtin_amdgcn_sched_barrier(0)
    Unit cur, nxt; int ui = 0;
    if (!S.next(0, cur)) return;
    f32x4 acc[2][2][4][2];
#pragma unroll
    for (int a = 0; a < 2; ++a)
#pragma unroll
        for (int b = 0; b < 2; ++b)
#pragma unroll
            for (int m = 0; m < 4; ++m)
#pragma unroll
                for (int n = 0; n < 2; ++n) acc[a][b][m][n] = (f32x4){0.f, 0.f, 0.f, 0.f};
    bf16x8 At[4][2], B0[2][2], B1[2][2];
    const char* cA = (const char*)g.A + (size_t)cur.pm * tstep; const char* cB = (const char*)g.Bt + (size_t)cur.pn * tstep;
    S.a_ready(cur);
    if constexpr (SP2) {
        PG8_STAGE(PG8_SB(0, 0), cB, voffB); PG8_STAGE(PG8_SB(0, 1), cB + hstep, voffB); PG8_STAGE(PG8_SA(0, 0), cA, voffA); PG8_STAGE(PG8_SA(0, 1), cA + hstep, voffA);
        if (wr == 1) PG8_BAR;
        PG8_WAIT_V(2); PG8_BAR;
        PG8_STAGE(PG8_SB(1, 0), cB + kstep, voffB); PG8_STAGE(PG8_SA(1, 0), cA + kstep, voffA); PG8_STAGE(PG8_SB(1, 1), cB + hstep + kstep, voffB);
        PG8_WAIT_V(6); PG8_BAR;
    } else {
        PG8_STAGE(PG8_SB(0, 0), cB, voffB); PG8_STAGE(PG8_SA(0, 0), cA, voffA); PG8_STAGE(PG8_SB(0, 1), cB + hstep, voffB); PG8_STAGE(PG8_SA(0, 1), cA + hstep, voffA);
        if (wr == 1) PG8_BAR;
        PG8_WAIT_V(4); PG8_BAR;
        PG8_STAGE(PG8_SB(1, 0), cB + kstep, voffB); PG8_STAGE(PG8_SA(1, 0), cA + kstep, voffA); PG8_STAGE(PG8_SB(1, 1), cB + hstep + kstep, voffB);
        PG8_WAIT_V(6); PG8_BAR;
    }
    for (;;) {
        const bool has_next = S.next(ui + 1, nxt);
        const char* nA = has_next ? (const char*)g.A + (size_t)nxt.pm * tstep : cA; const char* nB = has_next ? (const char*)g.Bt + (size_t)nxt.pn * tstep : cB;
        for (int t = 0; t < nt; t += 2) {
            const bool last = (t == nt - 2);
            const char* a1 = cA + (size_t)(t + 1) * kstep;
            const char* a2 = last ? nA : cA + (size_t)(t + 2) * kstep; const char* b2 = last ? nB : cB + (size_t)(t + 2) * kstep;
            const char* a3 = a2 + kstep; const char* b3 = b2 + kstep;
            if (last && has_next) S.a_ready(nxt);
            if constexpr (SP2) {
            PG8_LDB(B0, 0, 0); PG8_LDB(B1, 0, 1); PG8_SCHED; PG8_LDA(At, 0, 0); PG8_STAGE(PG8_SA(1, 1), a1 + hstep, voffA);
            PG8_WAIT_V(8); PG8_WAIT_L(0); PG8_BAR; PG8_MMA(0, 0, At, B0); PG8_MMA(0, 1, At, B1); PG8_BAR; PG8_SCHED;
            PG8_LDA(At, 0, 1); PG8_STAGE(PG8_SB(0, 0), b2, voffB); PG8_STAGE(PG8_SB(0, 1), b2 + hstep, voffB); PG8_STAGE(PG8_SA(0, 0), a2, voffA);
            PG8_WAIT_V(8); PG8_WAIT_L(0); PG8_BAR; PG8_MMA(1, 0, At, B0); PG8_MMA(1, 1, At, B1); PG8_BAR; PG8_SCHED;
            PG8_LDB(B0, 1, 0); PG8_LDB(B1, 1, 1); PG8_SCHED; PG8_LDA(At, 1, 0); PG8_STAGE(PG8_SA(0, 1), a2 + hstep, voffA);
            PG8_WAIT_V(8); PG8_WAIT_L(0); PG8_BAR; PG8_MMA(0, 0, At, B0); PG8_MMA(0, 1, At, B1); PG8_BAR; PG8_SCHED;
            PG8_LDA(At, 1, 1); PG8_STAGE(PG8_SB(1, 0), b3, voffB); PG8_STAGE(PG8_SB(1, 1), b3 + hstep, voffB); PG8_STAGE(PG8_SA(1, 0), a3, voffA);
            PG8_WAIT_V(8); PG8_WAIT_L(0); PG8_BAR; PG8_MMA(1, 0, At, B0); PG8_MMA(1, 1, At, B1); PG8_BAR; PG8_SCHED;
            } else {
            PG8_LDB(B0, 0, 0); PG8_SCHED; PG8_LDA(At, 0, 0); PG8_STAGE(PG8_SA(1, 1), a1 + hstep, voffA);
            PG8_WAIT_L(8); PG8_BAR; PG8_WAIT_L(0); PG8_MMA(0, 0, At, B0); PG8_BAR; PG8_SCHED;
            PG8_LDB(B1, 0, 1); PG8_STAGE(PG8_SB(0, 0), b2, voffB);
            PG8_BAR; PG8_WAIT_L(0); PG8_MMA(0, 1, At, B1); PG8_BAR;
            PG8_LDA(At, 0, 1); PG8_STAGE(PG8_SA(0, 0), a2, voffA);
            PG8_BAR; PG8_WAIT_L(0); PG8_MMA(1, 0, At, B0); PG8_BAR; PG8_SCHED;
            PG8_STAGE(PG8_SB(0, 1), b2 + hstep, voffB);
            PG8_WAIT_V(6); PG8_BAR; PG8_MMA(1, 1, At, B1); PG8_BAR;
            PG8_LDB(B0, 1, 0); PG8_SCHED; PG8_LDA(At, 1, 0); PG8_STAGE(PG8_SA(0, 1), a2 + hstep, voffA);
            PG8_WAIT_L(8); PG8_BAR; PG8_WAIT_L(0); PG8_MMA(0, 0, At, B0); PG8_BAR; PG8_SCHED;
            PG8_LDB(B1, 1, 1); PG8_STAGE(PG8_SB(1, 0), b3, voffB);
            PG8_BAR; PG8_WAIT_L(0); PG8_MMA(0, 1, At, B1); PG8_BAR;
            PG8_LDA(At, 1, 1); PG8_STAGE(PG8_SA(1, 0), a3, voffA);
            PG8_BAR; PG8_WAIT_L(0); PG8_MMA(1, 0, At, B0); PG8_BAR; PG8_SCHED;
            PG8_STAGE(PG8_SB(1, 1), b3 + hstep, voffB);
            PG8_WAIT_V(6); PG8_BAR; PG8_MMA(1, 1, At, B1); PG8_BAR;
            }
        }
        if constexpr (ALIGN_EPI) { if (wr == 0) PG8_BAR; }
        if constexpr (!Epi::AFTER_DRAIN) { E(acc, cur, wr, wc, fr, fq); S.done(cur); }
        if (!has_next) break;
#pragma unroll
        for (int a = 0; a < 2; ++a)
#pragma unroll
            for (int b = 0; b < 2; ++b)
#pragma unroll
                for (int m = 0; m < 4; ++m)
#pragma unroll
                    for (int n = 0; n < 2; ++n) acc[a][b][m][n] = (f32x4){0.f, 0.f, 0.f, 0.f};
        cur = nxt; cA = nA; cB = nB; ++ui;
        if constexpr (ALIGN_EPI) { if (wr == 1) PG8_BAR; }
    }
    PG8_WAIT_V(0);
    if constexpr (!ALIGN_EPI) { if (wr == 0) PG8_BAR; }
    PG8_BAR;
    if constexpr (Epi::AFTER_DRAIN) { E.fused(acc, cur, wr, wc, fr, fq, lds, wid, lane); S.done(cur); }
#undef PG8_SA
#undef PG8_SB
#undef PG8_STAGE
#undef PG8_LDA
#undef PG8_LDB
#undef PG8_MMA
#undef PG8_WAIT_V
#undef PG8_WAIT_L
#undef PG8_BAR
#undef PG8_SCHED
}
}

constexpr int DM = 1024, NB = 2, SEQ = 8192, CTXL = 256, MLAT = NB * SEQ, MCTX = NB * CTXL, MROWS = MLAT + MCTX;
constexpr int NIN = 2560, NCHUNK = MROWS / 64  , NPJ = 132  ;
constexpr float EPSF = 1e-6f;
constexpr int NWAVES = 8, NTHR = 512;

constexpr size_t MiB = 1u << 20;
constexpr size_t WS_CTL = 0, CTL_ZERO_BYTES = 64 * 1024;
constexpr size_t WS_MOD = 1 * MiB;
constexpr size_t WS_GWF = 1 * MiB + 256 * 1024;
constexpr size_t WS_BT1 = 2 * MiB;
constexpr size_t WS_BT2 = 12 * MiB;
constexpr size_t WS_AGGA = 16 * MiB;
constexpr size_t WS_AGGB = 16 * MiB + 1536 * 1024;
constexpr size_t WS_SSQ = 19 * MiB;
constexpr size_t WS_XC1 = 21 * MiB;
constexpr size_t WS_A16 = 23 * MiB;
constexpr size_t WS_B16 = 28 * MiB;
constexpr size_t WS_H = 73 * MiB;
constexpr size_t WS_Y = 56 * MiB;
constexpr size_t WS_MIXIN = 73 * MiB;
constexpr size_t WS_U = 106 * MiB;
constexpr size_t WS_MIX = 189 * MiB;
constexpr size_t WS_END = 255 * MiB;

constexpr int LDS_BYTES = 158720;
constexpr int MISC_OFF = 157696;

#define LAS __attribute__((address_space(3)))
typedef unsigned short bf16;
typedef unsigned v4u __attribute__((ext_vector_type(4)));
typedef unsigned v2u __attribute__((ext_vector_type(2)));
typedef float f32x4 __attribute__((ext_vector_type(4)));
typedef short bf16x8 __attribute__((ext_vector_type(8)));
typedef float f32x2v __attribute__((ext_vector_type(2)));
#define LDS_WAIT() asm volatile("s_waitcnt lgkmcnt(0)" ::: "memory")

__device__ __forceinline__ unsigned f2bf(float f) { unsigned u = __builtin_bit_cast(unsigned, f); return (u + 0x7fffu + ((u >> 16) & 1u)) >> 16; }
__device__ __forceinline__ unsigned pk2(float lo, float hi) { return f2bf(lo) | (f2bf(hi) << 16); }
__device__ __forceinline__ unsigned cvtpk(float lo, float hi) { unsigned r; asm volatile("v_cvt_pk_bf16_f32 %0, %1, %2" : "=v"(r) : "v"(lo), "v"(hi)); return r; }
__device__ __forceinline__ float bflo(unsigned u) { return __builtin_bit_cast(float, u << 16); }
__device__ __forceinline__ float bfhi(unsigned u) { return __builtin_bit_cast(float, u & 0xffff0000u); }
__device__ __forceinline__ float sigmoidf_(float x) { return 1.0f / (1.0f + __expf(-x)); }
__device__ __forceinline__ float siluf_(float x) { return x / (1.0f + __expf(-x)); }
__device__ __forceinline__ float wave_sum(float v) {
#pragma unroll
    for (int o = 1; o < 64; o <<= 1) v += __shfl_xor(v, o);
    return v;
}

struct Args {
    const float* in[21]; float* out; unsigned char* ws; int ph_lo, ph_hi, coop, pad;
};
enum { I_X = 0, I_C, I_CTX, I_CCTX, I_WMOD, I_BMOD, I_GPRE, I_GPOST, I_WIN, I_CAW, I_CAB, I_WR, I_BR, I_WI, I_BI, I_LAM, I_DWW, I_DWB, I_LNG, I_LNB, I_WOUT };

namespace pg8 {
struct EpiU {
    static constexpr bool PERM = true, AFTER_DRAIN = false;
    bf16_t* O;
    __device__ __forceinline__ void operator()(const f32x4 (&acc)[2][2][4][2], const Unit& u, int wr, int wc, int fr, int fq) const {
        const int row0 = u.pm * BM + wr * 64 + fr;
        if (u.pn >= 4 && u.pn < 8) {
            const int col0 = 1024 + 128 * (u.pn - 4) + wc * 32 + 8 * fq;
#pragma unroll
            for (int ai = 0; ai < 2; ++ai)
#pragma unroll
                for (int m = 0; m < 4; ++m) { f32x4 v0 = acc[ai][0][m][0], v1 = acc[ai][0][m][1]; const f32x4 g0 = acc[ai][1][m][0], g1 = acc[ai][1][m][1];
#pragma unroll
                    for (int e = 0; e < 4; ++e) { v0[e] = v0[e] * __builtin_amdgcn_rcpf(1.0f + __expf(-g0[e])); v1[e] = v1[e] * __builtin_amdgcn_rcpf(1.0f + __expf(-g1[e])); }
                    u32x4 w; w.x = cvt_pk_bf16(v0[0], v0[1]); w.y = cvt_pk_bf16(v0[2], v0[3]); w.z = cvt_pk_bf16(v1[0], v1[1]); w.w = cvt_pk_bf16(v1[2], v1[3]);
                    *(u32x4*)(O + (size_t)(row0 + ai * HALF + m * 16) * 2560 + col0) = w; }
            return;
        }
        const int col0 = u.pn * BM + wc * 32 + 8 * fq;
        const bool act = (u.pn == 2 || u.pn == 3 || u.pn >= 8);
#pragma unroll
        for (int ai = 0; ai < 2; ++ai)
#pragma unroll
            for (int m = 0; m < 4; ++m) { bf16_t* rowp = O + (size_t)(row0 + ai * HALF + m * 16) * 2560 + col0;
#pragma unroll
                for (int bj = 0; bj < 2; ++bj) { f32x4 v0 = acc[ai][bj][m][0], v1 = acc[ai][bj][m][1];
                    if (act) {
#pragma unroll
                        for (int e = 0; e < 4; ++e) { v0[e] = v0[e] * __builtin_amdgcn_rcpf(1.0f + __expf(-v0[e])); v1[e] = v1[e] * __builtin_amdgcn_rcpf(1.0f + __expf(-v1[e])); }
                    }
                    u32x4 w; w.x = cvt_pk_bf16(v0[0], v0[1]); w.y = cvt_pk_bf16(v0[2], v0[3]); w.z = cvt_pk_bf16(v1[0], v1[1]); w.w = cvt_pk_bf16(v1[2], v1[3]);
                    *(u32x4*)(rowp + bj * HALF) = w; } }
    }
};
struct EpiMix {
    static constexpr bool PERM = true, AFTER_DRAIN = false;
    bf16_t* O; float* ssq;
    __device__ __forceinline__ void operator()(const f32x4 (&acc)[2][2][4][2], const Unit& u, int wr, int wc, int fr, int fq) const {
        const int col0 = u.pn * BM + wc * 32 + 8 * fq;
#pragma unroll
        for (int ai = 0; ai < 2; ++ai)
#pragma unroll
            for (int m = 0; m < 4; ++m) { const int r = u.pm * BM + ai * HALF + wr * 64 + m * 16 + fr; bf16_t* rowp = O + (size_t)r * 1024 + col0; float s = 0.f;
#pragma unroll
                for (int bj = 0; bj < 2; ++bj) { const f32x4 v0 = acc[ai][bj][m][0], v1 = acc[ai][bj][m][1];
                    s += ((v0[0] * v0[0] + v0[1] * v0[1]) + (v0[2] * v0[2] + v0[3] * v0[3])) + ((v1[0] * v1[0] + v1[1] * v1[1]) + (v1[2] * v1[2] + v1[3] * v1[3]));
                    u32x4 w; w.x = cvt_pk_bf16(v0[0], v0[1]); w.y = cvt_pk_bf16(v0[2], v0[3]); w.z = cvt_pk_bf16(v1[0], v1[1]); w.w = cvt_pk_bf16(v1[2], v1[3]);
                    *(u32x4*)(rowp + bj * HALF) = w; }
                s += __shfl_xor(s, 16); s += __shfl_xor(s, 32);
                if (fq == 0) ssq[(size_t)r * 16 + u.pn * 4 + wc] = s; }
    }
};
}

__device__ __forceinline__ void p0_transpose_item(const float* W, int K, int N, bf16* WT, LAS float* scr, int item, int lane, bool glu_remap) {
    const int nblk = N / 32, kb = item / nblk, nb = item % nblk, k0 = 64 * kb, n0 = 32 * nb;
    int nd = n0;
    if (glu_remap) { if (n0 >= 1024 && n0 < 1536) nd = 1024 + 256 * ((n0 - 1024) >> 7) + ((n0 - 1024) & 127); else if (n0 >= 1536 && n0 < 2048) nd = 1024 + 256 * ((n0 - 1536) >> 7) + 128 + ((n0 - 1536) & 127); }
#pragma unroll 8
    for (int i = 0; i < 32; ++i) { const int kk = 2 * i + (lane >> 5); scr[kk * 33 + (lane & 31)] = W[(size_t)(k0 + kk) * N + n0 + (lane & 31)]; }
    LDS_WAIT(); asm volatile("" ::: "memory");
    const int c = lane & 7;
#pragma unroll
    for (int j = 0; j < 4; ++j) { const int n = (lane >> 3) + 8 * j; const LAS float* s = scr + (8 * c) * 33 + n;
        v4u o; o.x = pk2(s[0 * 33], s[1 * 33]); o.y = pk2(s[2 * 33], s[3 * 33]); o.z = pk2(s[4 * 33], s[5 * 33]); o.w = pk2(s[6 * 33], s[7 * 33]);
        *(v4u*)(WT + (size_t)(nd + n) * K + k0 + 8 * c) = o; }
    LDS_WAIT(); asm volatile("" ::: "memory");
}

__device__ __forceinline__ void p0_prologue(const Args& a, LAS unsigned char* lds, int tid, int lane, int wave) {
    const int G = gridDim.x, bx = blockIdx.x;
    unsigned char* ws = a.ws;
    {
        LAS float* part = (LAS float*)lds;
        float* MOD = (float*)(ws + WS_MOD);
        const float* c = a.in[I_C]; const float* cctx = a.in[I_CCTX];
        for (int un = bx; un < 192; un += G) {
            const int l = un / 96, n0 = (un % 96) * 32, cq = tid & 7, ks = tid >> 3;
            const float* wm = a.in[I_WMOD] + (size_t)l * 1024 * 3072 + n0 + cq * 4;
            f32x4 acc0 = {0.f, 0.f, 0.f, 0.f}, acc1 = acc0, acc2 = acc0;
#pragma unroll 4
            for (int kk = 0; kk < 16; ++kk) { const int k = ks * 16 + kk; const f32x4 w = *(const f32x4*)(wm + (size_t)k * 3072);
                const float a0 = siluf_(c[k]), a1 = siluf_(c[1024 + k]), a2 = siluf_(cctx[k]);
                acc0 += w * a0; acc1 += w * a1; acc2 += w * a2; }
            *(LAS f32x4*)(part + (0 * 64 + ks) * 32 + cq * 4) = acc0;
            *(LAS f32x4*)(part + (1 * 64 + ks) * 32 + cq * 4) = acc1;
            *(LAS f32x4*)(part + (2 * 64 + ks) * 32 + cq * 4) = acc2;
            __syncthreads();
            if (tid < 96) { const int v = tid >> 5, col = tid & 31; float s = a.in[I_BMOD][l * 3072 + n0 + col];
                for (int k2 = 0; k2 < 64; ++k2) s += part[(v * 64 + k2) * 32 + col];
                MOD[(l * 3 + v) * 3072 + n0 + col] = s; }
            __syncthreads();
        }
    }
    {
        v4u* GWF = (v4u*)(ws + WS_GWF);
        for (int idx = bx * NTHR + tid; idx < 32768; idx += G * NTHR) {
            const int ln = idx & 63, kk = (idx >> 6) & 1, ct = (idx >> 7) & 3, h = (idx >> 9) & 7, g = (idx >> 12) & 1, d = (idx >> 13) & 1, l = idx >> 14;
            const float* W = (g == 0 ? a.in[I_WR] : a.in[I_WI]) + (size_t)(((l * 2 + d) * 8 + h) * 64) * 64;
            const int k0 = 32 * kk + 8 * (ln >> 4), col = 16 * ct + (ln & 15);
            float e[8];
#pragma unroll
            for (int j = 0; j < 8; ++j) e[j] = W[(k0 + j) * 64 + col];
            v4u o; o.x = pk2(e[0], e[1]); o.y = pk2(e[2], e[3]); o.z = pk2(e[4], e[5]); o.w = pk2(e[6], e[7]);
            GWF[idx] = o;
        }
    }
    {
        LAS float* scr = (LAS float*)(lds + wave * 16384);
        const int gw = bx * NWAVES + wave, NGW = G * NWAVES;
        constexpr int I_1 = (1024 / 64) * (NIN / 32), I_2 = (1024 / 64) * (1024 / 32), NITEMS = 2 * (I_1 + I_2);
        bf16* BT1 = (bf16*)(ws + WS_BT1); bf16* BT2 = (bf16*)(ws + WS_BT2);
        for (int it = gw; it < NITEMS; it += NGW) {
            int r = it;
            if (r < I_1) { p0_transpose_item(a.in[I_WIN], 1024, NIN, BT1, scr, r, lane, true); continue; } r -= I_1;
            if (r < I_1) { p0_transpose_item(a.in[I_WIN] + (size_t)1024 * NIN, 1024, NIN, BT1 + (size_t)NIN * 1024, scr, r, lane, true); continue; } r -= I_1;
            if (r < I_2) { p0_transpose_item(a.in[I_WOUT], 1024, 1024, BT2, scr, r, lane, false); continue; } r -= I_2;
            p0_transpose_item(a.in[I_WOUT] + (size_t)1024 * 1024, 1024, 1024, BT2 + (size_t)1024 * 1024, scr, r, lane, false);
        }
    }
}

__device__ __forceinline__ void norm_phase(const Args& a, int mode, int lane, int wave) {
    unsigned char* ws = a.ws;
    const float* MOD = (const float*)(ws + WS_MOD); const bf16* MIX = (const bf16*)(ws + WS_MIX); const float* SSQ = (const float*)(ws + WS_SSQ);
    float* XC1 = (float*)(ws + WS_XC1); bf16* H = (bf16*)(ws + WS_H);
    const int gw = blockIdx.x * NWAVES + wave, NGW = gridDim.x * NWAVES;
    const int nrows = (mode == 2) ? MLAT : MROWS, lu = (mode == 1) ? 0 : 1, ln = (mode == 0) ? 0 : 1;
    for (int row = gw; row < nrows; row += NGW) {
        const int vsel = row < MLAT ? (row >> 13) : 2;
        const float* src;
        if (mode == 2) src = a.out + (size_t)row * 1024;
        else src = row < MLAT ? a.in[I_X] + (size_t)row * 1024 : a.in[I_CTX] + (size_t)(row - MLAT) * 1024;
        f32x4 v[4];
#pragma unroll
        for (int j = 0; j < 4; ++j) v[j] = *((const f32x4*)src + lane + 64 * j);
        if (mode >= 1) {
            const float sp = lane < 16 ? SSQ[(size_t)row * 16 + lane] : 0.f;
            const float rstd = rsqrtf(wave_sum(sp) * (1.0f / 1024.0f) + EPSF);
            const float* gate = MOD + (lu * 3 + vsel) * 3072 + 2048; const float* gp = a.in[I_GPOST] + lu * 1024;
#pragma unroll
            for (int j = 0; j < 4; ++j) { const v2u mq = *((const v2u*)(MIX + (size_t)row * 1024) + lane + 64 * j); const f32x4 mx = {bflo(mq.x), bfhi(mq.x), bflo(mq.y), bfhi(mq.y)};
                const f32x4 gt = *((const f32x4*)gate + lane + 64 * j), gv = *((const f32x4*)gp + lane + 64 * j);
                v[j] += gt * (mx * rstd * gv); }
            float* dst = row < MLAT ? a.out + (size_t)row * 1024 : XC1 + (size_t)(row - MLAT) * 1024;
#pragma unroll
            for (int j = 0; j < 4; ++j) *((f32x4*)dst + lane + 64 * j) = v[j];
        }
        if (mode <= 1) {
            float s = 0.f;
#pragma unroll
            for (int j = 0; j < 4; ++j) s += (v[j].x * v[j].x + v[j].y * v[j].y) + (v[j].z * v[j].z + v[j].w * v[j].w);
            const float r = rsqrtf(wave_sum(s) * (1.0f / 1024.0f) + EPSF);
            const float* shift = MOD + (ln * 3 + vsel) * 3072; const float* scale = shift + 1024; const float* gpre = a.in[I_GPRE] + ln * 1024;
            v2u* o8 = (v2u*)(H + (size_t)row * 1024);
#pragma unroll
            for (int j = 0; j < 4; ++j) { const f32x4 sh = *((const f32x4*)shift + lane + 64 * j), sc = *((const f32x4*)scale + lane + 64 * j), gv = *((const f32x4*)gpre + lane + 64 * j);
                const f32x4 hv = v[j] * r * gv * (sc + 1.0f) + sh;
                v2u w; w.x = pk2(hv.x, hv.y); w.y = pk2(hv.z, hv.w); o8[lane + 64 * j] = w; }
        }
    }
}

__device__ __forceinline__ void conv16(const LAS unsigned* vt, const float (&w0)[31], const float (&w1)[31], float b0, float b1, float (&o0)[16], float (&o1)[16]) {
#pragma unroll
    for (int t = 0; t < 16; ++t) { o0[t] = b0; o1[t] = b1; }
#pragma unroll
    for (int rr = 0; rr < 46; ++rr) { const unsigned u = vt[rr * 128]; const float lo = bflo(u), hi = bfhi(u);
#pragma unroll
        for (int t = 0; t < 16; ++t) { const int k = rr - t; if (k >= 0 && k < 31) { o0[t] += w0[k] * lo; o1[t] += w1[k] * hi; } }
        if ((rr & 3) == 3) asm volatile("" ::: "memory"); }
}
__device__ __forceinline__ v4u glu8(const v4u vq, const v4u gq) {
    v4u o;
    o.x = pk2(bflo(vq.x) * sigmoidf_(bflo(gq.x)), bfhi(vq.x) * sigmoidf_(bfhi(gq.x)));
    o.y = pk2(bflo(vq.y) * sigmoidf_(bflo(gq.y)), bfhi(vq.y) * sigmoidf_(bfhi(gq.y)));
    o.z = pk2(bflo(vq.z) * sigmoidf_(bflo(gq.z)), bfhi(vq.z) * sigmoidf_(bfhi(gq.z)));
    o.w = pk2(bflo(vq.w) * sigmoidf_(bflo(gq.w)), bfhi(vq.w) * sigmoidf_(bfhi(gq.w)));
    return o;
}
__device__ __forceinline__ void hconv_unit(const Args& a, LAS unsigned char* lds, int l, int r0, int g, int vlo, int vhi, int tid) {
    const bf16* U = (const bf16*)(a.ws + WS_U); bf16* Y = (bf16*)(a.ws + WS_Y);
    LAS unsigned* VT = (LAS unsigned*)lds;
    {
        v4u vq[6];
#pragma unroll
        for (int it = 0; it < 6; ++it) { const int i = tid + it * NTHR, rr = i >> 5, ch = i & 31, row = r0 - 15 + rr; const bool ok = i < 94 * 32 && row >= vlo && row < vhi;
            vq[it] = *(const v4u*)(U + (size_t)(ok ? row : r0) * NIN + 1024 + g * 256 + ch * 8); }
#pragma unroll
        for (int it = 0; it < 6; ++it) { const int i = tid + it * NTHR, rr = i >> 5, ch = i & 31, row = r0 - 15 + rr; const bool ok = row >= vlo && row < vhi;
            if (i < 94 * 32) { const v4u z = {0u, 0u, 0u, 0u}; *(LAS v4u*)(VT + rr * 128 + ch * 4) = ok ? vq[it] : z; } }
    }
    __syncthreads();
    int p = tid & 127; asm volatile("" : "+v"(p));
    const int tg = tid >> 7, c0 = g * 256 + 2 * p;
    float w0[31], w1[31];
#pragma unroll
    for (int k = 0; k < 31; ++k) { const float2 w = *(const float2*)(a.in[I_DWW] + (size_t)(l * 31 + k) * 512 + c0); w0[k] = w.x; w1[k] = w.y; }
    const float2 bb = *(const float2*)(a.in[I_DWB] + l * 512 + c0);
    float o0[16], o1[16];
    conv16(VT + (tg * 16) * 128 + p, w0, w1, bb.x, bb.y, o0, o1);
#pragma unroll
    for (int t = 0; t < 16; ++t) *(unsigned*)(Y + (size_t)(r0 + tg * 16 + t) * 512 + c0) = pk2(o0[t], o1[t]);
    __syncthreads();
}
__device__ __forceinline__ void vconv_unit(const Args& a, LAS unsigned char* lds, int l, int b, int w, int tid) {
    const bf16* U = (const bf16*)(a.ws + WS_U); bf16* Y = (bf16*)(a.ws + WS_Y);
    LAS unsigned* VT = (LAS unsigned*)lds;
#pragma unroll 1
    for (int hb = 0; hb < 2; ++hb) {
        v4u vq[5];
#pragma unroll
        for (int it = 0; it < 5; ++it) { const int i = tid + (hb * 5 + it) * NTHR, rr = i >> 5, ch = i & 31, gr = rr - 15; const bool ok = i < 158 * 32 && gr >= 0 && gr < 128;
            vq[it] = *(const v4u*)(U + (size_t)(b * SEQ + (ok ? gr : 0) * 64 + w) * NIN + 1024 + 256 + ch * 8); }
#pragma unroll
        for (int it = 0; it < 5; ++it) { const int i = tid + (hb * 5 + it) * NTHR, rr = i >> 5, ch = i & 31, gr = rr - 15; const bool ok = gr >= 0 && gr < 128;
            if (i < 158 * 32) { const v4u z = {0u, 0u, 0u, 0u}; *(LAS v4u*)(VT + rr * 128 + ch * 4) = ok ? vq[it] : z; } }
    }
    __syncthreads();
    int p = tid & 127; asm volatile("" : "+v"(p));
    const int tg = tid >> 7, c0 = 256 + 2 * p;
    float w0[31], w1[31];
#pragma unroll
    for (int k = 0; k < 31; ++k) { const float2 wv = *(const float2*)(a.in[I_DWW] + (size_t)(l * 31 + k) * 512 + c0); w0[k] = wv.x; w1[k] = wv.y; }
    const float2 bb = *(const float2*)(a.in[I_DWB] + l * 512 + c0);
#pragma unroll 1
    for (int half = 0; half < 2; ++half) {
        const int tb = tg * 32 + half * 16;
        float o0[16], o1[16];
        conv16(VT + tb * 128 + p, w0, w1, bb.x, bb.y, o0, o1);
#pragma unroll
        for (int t = 0; t < 16; ++t) *(unsigned*)(Y + (size_t)(b * SEQ + (tb + t) * 64 + w) * 512 + c0) = pk2(o0[t], o1[t]);
    }
    __syncthreads();
}
__device__ __forceinline__ void ln_rows(const Args& a, int l, int nrows, int lane, int wave) {
    const bf16* U = (const bf16*)(a.ws + WS_U); const bf16* Y = (const bf16*)(a.ws + WS_Y); bf16* MIXIN = (bf16*)(a.ws + WS_MIXIN);
    const int gw = blockIdx.x * NWAVES + wave, NGW = gridDim.x * NWAVES, c0 = lane * 8;
    float lg[8], lb[8];
#pragma unroll
    for (int e = 0; e < 8; ++e) { lg[e] = a.in[I_LNG][l * 512 + c0 + e]; lb[e] = a.in[I_LNB][l * 512 + c0 + e]; }
    for (int row = gw; row < nrows; row += NGW) {
        const v4u yq = *(const v4u*)(Y + (size_t)row * 512 + c0); const v4u gq = *(const v4u*)(U + (size_t)row * NIN + 2048 + c0);
        float y[8] = {bflo(yq.x), bfhi(yq.x), bflo(yq.y), bfhi(yq.y), bflo(yq.z), bfhi(yq.z), bflo(yq.w), bfhi(yq.w)};
        const float gt[8] = {bflo(gq.x), bfhi(gq.x), bflo(gq.y), bfhi(gq.y), bflo(gq.z), bfhi(gq.z), bflo(gq.w), bfhi(gq.w)};
        float s = 0.f;
#pragma unroll
        for (int e = 0; e < 8; ++e) s += y[e];
        const float mean = wave_sum(s) * (1.0f / 512.0f); float q = 0.f;
#pragma unroll
        for (int e = 0; e < 8; ++e) { y[e] -= mean; q += y[e] * y[e]; }
        const float rstd = rsqrtf(wave_sum(q) * (1.0f / 512.0f) + EPSF);
        float o[8];
#pragma unroll
        for (int e = 0; e < 8; ++e) o[e] = siluf_(y[e] * rstd * lg[e] + lb[e]) * gt[e];
        v4u w; w.x = pk2(o[0], o[1]); w.y = pk2(o[2], o[3]); w.z = pk2(o[4], o[5]); w.w = pk2(o[6], o[7]);
        *(v4u*)(MIXIN + (size_t)row * 1024 + 512 + c0) = w;
    }
}

constexpr int RG_GW = 0, RG_FOLD = 32768, RG_F8 = 36864, RG_CAR = 40960, RG_WAVE = 57344, RG_WAVE_BYTES = 12544;
constexpr int NP16 = 4 * NPJ;
__device__ __forceinline__ float fsig(float x) { return __builtin_amdgcn_rcpf(1.0f + __expf(-x)); }

template <bool FINAL, int D>
__device__ __forceinline__ void rg_sweep(const Args& a, LAS unsigned char* lds, LAS unsigned char* wl, int l, int b, int h, int r0, int seg_lo, int seg_hi, int pj, bool is_ctx, int w, int lane) {
    const bf16* U = (const bf16*)(a.ws + WS_U); bf16* MIXIN = (bf16*)(a.ws + WS_MIXIN);
    float* AGGA = (float*)(a.ws + WS_AGGA); float* AGGB = (float*)(a.ws + WS_AGGB); float* A16 = (float*)(a.ws + WS_A16); float* B16 = (float*)(a.ws + WS_B16);
    LAS float* VCW = (LAS float*)wl; LAS unsigned* HBW = (LAS unsigned*)(wl + 4352);
    const LAS v4u* GWL = (const LAS v4u*)(lds + RG_GW) + (D * 2) * 8 * 64 + lane;
    const LAS float* CAR = (const LAS float*)(lds + RG_CAR);
    const int fr = lane & 15, fq = lane >> 4, cp = lane & 31, rh = lane >> 5;
    float2 cw[4];
#pragma unroll
    for (int k = 0; k < 4; ++k) cw[k] = *(const float2*)(a.in[I_CAW] + (size_t)((l * 2 + D) * 4 + k) * 512 + 64 * h + 2 * cp);
    const float2 cbv = *(const float2*)(a.in[I_CAB] + (l * 2 + D) * 512 + 64 * h + 2 * cp);
    float brv[4], biv[4], sp8[4], Hc[4], Ac[4];
    const int p16own = 4 * pj + (D ? 3 - fq : fq);
#pragma unroll
    for (int ct = 0; ct < 4; ++ct) { const int c = 16 * ct + fr, pidx = (l * 2 + D) * 512 + 64 * h + c;
        brv[ct] = a.in[I_BR][pidx]; biv[ct] = a.in[I_BI][pidx]; sp8[ct] = -8.0f * log1pf(__expf(-a.in[I_LAM][pidx]));
        Hc[ct] = 0.f; Ac[ct] = 1.f;
        if (FINAL) {
            if (is_ctx) { const size_t base = (size_t)((b * 2 + D) * NP16) * 512 + 64 * h + c; float S = 0.f;
                for (int i = 0; i < p16own; ++i) S = A16[base + (size_t)i * 512] * S + B16[base + (size_t)i * 512];
                Hc[ct] = S; }
            else Hc[ct] = CAR[(D * 32 + (D ? 31 - (4 * w + fq) : 4 * w + fq)) * 64 + c];
        } }
    const bf16* ub = U + 64 * h + 2 * cp;
    unsigned Wd[2][7], nx[2][4];
#pragma unroll
    for (int q = 0; q < 2; ++q) { const int g = 2 * rh + q;
#pragma unroll
        for (int j = 0; j < 3; ++j) { const int row = r0 + 16 * g + (D ? 16 + j : j - 3); const bool ok = row >= seg_lo && row < seg_hi; const int rc = ok ? row : r0;
            const unsigned v = *(const unsigned*)(ub + (size_t)rc * NIN); Wd[q][D ? j : 4 + j] = ok ? v : 0u; }
#pragma unroll
        for (int j = 0; j < 4; ++j) nx[q][j] = *(const unsigned*)(ub + (size_t)(r0 + 16 * g + 4 * (D ? 3 : 0) + j) * NIN); }
#pragma unroll 1
    for (int ti = 0; ti < 4; ++ti) {
        const int tile = D ? 3 - ti : ti;
        int zo = 0; asm volatile("" : "+v"(zo));
        const LAS v4u* GWLt = GWL + zo;
        v4u g0 = {0u, 0u, 0u, 0u}, g1 = g0; size_t orow = 0;
        if (FINAL && D == 0) { orow = (size_t)(r0 + 16 * (fr >> 2) + 4 * tile + (fr & 3)); const bf16* gp = U + orow * NIN + 512 + 64 * h + 16 * fq; g0 = *(const v4u*)gp; g1 = *(const v4u*)(gp + 8); }
#pragma unroll
        for (int q = 0; q < 2; ++q) {
            if (D == 0) { Wd[q][0] = Wd[q][4]; Wd[q][1] = Wd[q][5]; Wd[q][2] = Wd[q][6]; Wd[q][3] = nx[q][0]; Wd[q][4] = nx[q][1]; Wd[q][5] = nx[q][2]; Wd[q][6] = nx[q][3]; }
            else { Wd[q][4] = Wd[q][0]; Wd[q][5] = Wd[q][1]; Wd[q][6] = Wd[q][2]; Wd[q][0] = nx[q][0]; Wd[q][1] = nx[q][1]; Wd[q][2] = nx[q][2]; Wd[q][3] = nx[q][3]; } }
        if (ti < 3) { const int tn = D ? 2 - ti : ti + 1;
#pragma unroll
            for (int q = 0; q < 2; ++q)
#pragma unroll
                for (int j = 0; j < 4; ++j) nx[q][j] = *(const unsigned*)(ub + (size_t)(r0 + 16 * (2 * rh + q) + 4 * tn + j) * NIN); }
#pragma unroll
        for (int q = 0; q < 2; ++q)
#pragma unroll
            for (int jj = 0; jj < 4; ++jj) { float v0 = cbv.x, v1 = cbv.y;
#pragma unroll
                for (int k = 0; k < 4; ++k) { const unsigned u = Wd[q][jj + k]; v0 += cw[k].x * bflo(u); v1 += cw[k].y * bfhi(u); }
                *(LAS f32x2v*)(VCW + (4 * (2 * rh + q) + jj) * 68 + 2 * cp) = (f32x2v){v0, v1}; }
        bf16x8 af[2];
#pragma unroll
        for (int kk = 0; kk < 2; ++kk) { const LAS float* vp = VCW + fr * 68 + 32 * kk + 8 * fq; const f32x4 x0 = *(const LAS f32x4*)vp, x1 = *(const LAS f32x4*)(vp + 4);
            v4u pk; pk.x = cvtpk(x0.x, x0.y); pk.y = cvtpk(x0.z, x0.w); pk.z = cvtpk(x1.x, x1.y); pk.w = cvtpk(x1.z, x1.w); af[kk] = __builtin_bit_cast(bf16x8, pk); }
        float vcv[4][4];
#pragma unroll
        for (int ct = 0; ct < 4; ++ct)
#pragma unroll
            for (int jj = 0; jj < 4; ++jj) vcv[ct][jj] = VCW[(4 * fq + jj) * 68 + 16 * ct + fr];
        f32x4 accr[4], acci[4];
#pragma unroll
        for (int ct = 0; ct < 4; ++ct) { accr[ct] = (f32x4){0.f, 0.f, 0.f, 0.f}; acci[ct] = accr[ct];
#pragma unroll
            for (int kk = 0; kk < 2; ++kk) { const bf16x8 br = __builtin_bit_cast(bf16x8, GWLt[(ct * 2 + kk) * 64]), bi = __builtin_bit_cast(bf16x8, GWLt[(8 + ct * 2 + kk) * 64]);
                accr[ct] = __builtin_amdgcn_mfma_f32_16x16x32_bf16(af[kk], br, accr[ct], 0, 0, 0); acci[ct] = __builtin_amdgcn_mfma_f32_16x16x32_bf16(af[kk], bi, acci[ct], 0, 0, 0); } }
        float hsum[4][4];
#pragma unroll
        for (int ct = 0; ct < 4; ++ct) { float aa[4], bb[4];
            const float nbr = -1.44269504f * brv[ct], nbi = -1.44269504f * biv[ct];
#pragma unroll
            for (int p = 0; p < 2; ++p) {
                f32x2v xr = (f32x2v){accr[ct][2 * p], accr[ct][2 * p + 1]} * -1.44269504f + nbr, xi = (f32x2v){acci[ct][2 * p], acci[ct][2 * p + 1]} * -1.44269504f + nbi;
                xr = __builtin_elementwise_min(xr, (f32x2v){60.f, 60.f}); xi = __builtin_elementwise_min(xi, (f32x2v){60.f, 60.f});
                f32x2v d1, d2; d1.x = __builtin_amdgcn_exp2f(xr.x); d1.y = __builtin_amdgcn_exp2f(xr.y); d2.x = __builtin_amdgcn_exp2f(xi.x); d2.y = __builtin_amdgcn_exp2f(xi.y);
                d1 = d1 + 1.0f; d2 = d2 + 1.0f; const f32x2v m = d1 * d2; f32x2v inv; inv.x = __builtin_amdgcn_rcpf(m.x); inv.y = __builtin_amdgcn_rcpf(m.y);
                const f32x2v r = d2 * inv, ig = d1 * inv, la = r * sp8[ct], x2 = la + la, le = la * 1.44269504f;
                const f32x2v pom = -x2 * (x2 * (x2 * (x2 * (x2 * 0.0083333338f + 0.041666668f) + 0.16666667f) + 0.5f) + 1.0f);
                f32x2v av; av.x = __builtin_amdgcn_exp2f(le.x); av.y = __builtin_amdgcn_exp2f(le.y);
                const f32x2v o2 = 1.0f - av * av; f32x2v om; om.x = x2.x > -0.25f ? pom.x : o2.x; om.y = x2.y > -0.25f ? pom.y : o2.y;
                om = __builtin_elementwise_max(om, (f32x2v){0.f, 0.f});
                f32x2v sq; sq.x = __builtin_amdgcn_sqrtf(om.x); sq.y = __builtin_amdgcn_sqrtf(om.y);
                const f32x2v bv = sq * (ig * (f32x2v){vcv[ct][2 * p], vcv[ct][2 * p + 1]});
                aa[2 * p] = av.x; aa[2 * p + 1] = av.y; bb[2 * p] = bv.x; bb[2 * p + 1] = bv.y; }
            float hh = Hc[ct], A4 = 1.f;
#pragma unroll
            for (int ji = 0; ji < 4; ++ji) { const int jj = D ? 3 - ji : ji; hh = aa[jj] * hh + bb[jj]; A4 *= aa[jj]; hsum[ct][jj] = hh; }
            Hc[ct] = hh; if (!FINAL) Ac[ct] *= A4; }
        if (FINAL) {
            if (D == 1) {
#pragma unroll
                for (int ct = 0; ct < 4; ++ct)
#pragma unroll
                    for (int jp = 0; jp < 2; ++jp) HBW[(tile * 8 + ct * 2 + jp) * 64 + lane] = cvtpk(hsum[ct][2 * jp], hsum[ct][2 * jp + 1]);
            } else {
#pragma unroll
                for (int ct = 0; ct < 4; ++ct)
#pragma unroll
                    for (int jp = 0; jp < 2; ++jp) { const unsigned hb = HBW[(tile * 8 + ct * 2 + jp) * 64 + lane];
                        VCW[(4 * fq + 2 * jp) * 68 + 16 * ct + fr] = hsum[ct][2 * jp] + bflo(hb); VCW[(4 * fq + 2 * jp + 1) * 68 + 16 * ct + fr] = hsum[ct][2 * jp + 1] + bfhi(hb); }
                const size_t row = orow;
                const f32x4 s0 = *(const LAS f32x4*)(VCW + fr * 68 + 16 * fq), s1 = *(const LAS f32x4*)(VCW + fr * 68 + 16 * fq + 4), s2 = *(const LAS f32x4*)(VCW + fr * 68 + 16 * fq + 8), s3 = *(const LAS f32x4*)(VCW + fr * 68 + 16 * fq + 12);
                v4u o0, o1;
                o0.x = cvtpk(s0.x * bflo(g0.x), s0.y * bfhi(g0.x)); o0.y = cvtpk(s0.z * bflo(g0.y), s0.w * bfhi(g0.y)); o0.z = cvtpk(s1.x * bflo(g0.z), s1.y * bfhi(g0.z)); o0.w = cvtpk(s1.z * bflo(g0.w), s1.w * bfhi(g0.w));
                o1.x = cvtpk(s2.x * bflo(g1.x), s2.y * bfhi(g1.x)); o1.y = cvtpk(s2.z * bflo(g1.y), s2.w * bfhi(g1.y)); o1.z = cvtpk(s3.x * bflo(g1.z), s3.y * bfhi(g1.z)); o1.w = cvtpk(s3.z * bflo(g1.w), s3.w * bfhi(g1.w));
                bf16* op = MIXIN + row * 1024 + 64 * h + 16 * fq; *(v4u*)op = o0; *(v4u*)(op + 8) = o1;
            }
        }
    }
    if (!FINAL) {
#pragma unroll
        for (int ct = 0; ct < 4; ++ct) { const int c = 16 * ct + fr;
            const size_t i16 = (size_t)((b * 2 + D) * NP16 + p16own) * 512 + 64 * h + c; A16[i16] = Ac[ct]; B16[i16] = Hc[ct];
            float Ag[4], Bg[4];
#pragma unroll
            for (int g = 0; g < 4; ++g) { Ag[g] = __shfl(Ac[ct], fr + 16 * g); Bg[g] = __shfl(Hc[ct], fr + 16 * g); }
            float run = 0.f;
#pragma unroll
            for (int gi = 0; gi < 4; ++gi) { const int g = D ? 3 - gi : gi; run = Ag[g] * run + Bg[g]; }
            if (fq == 0) { const size_t idx = (size_t)((b * 2 + D) * NPJ + pj) * 512 + 64 * h + c; AGGA[idx] = (Ag[0] * Ag[1]) * (Ag[2] * Ag[3]); AGGB[idx] = run; } }
    }
}

template <bool FINAL>
__device__ __forceinline__ void rg_run(const Args& a, LAS unsigned char* lds, int l, int rn, int tid, int lane, int wave) {
    const bool is_ctx = rn >= 256; const int bh = is_ctx ? rn - 256 : rn >> 4, b = bh >> 3, h = bh & 7, cgp = is_ctx ? 0 : (rn & 15);
    { const v4u* GWF = (const v4u*)(a.ws + WS_GWF); LAS v4u* GWL = (LAS v4u*)(lds + RG_GW);
#pragma unroll
      for (int i = tid; i < 2048; i += NTHR) { const int d = i >> 10, g = (i >> 9) & 1, rest = i & 511; GWL[i] = GWF[(size_t)((((l * 2 + d) * 2 + g) * 8 + h) * 8) * 64 + rest]; } }
    const int P0f = 4 + 8 * cgp, P0b = 124 - 8 * cgp;
    if (FINAL && !is_ctx) {
        const float* AGGA = (const float*)(a.ws + WS_AGGA); const float* AGGB = (const float*)(a.ws + WS_AGGB); const float* A16 = (const float*)(a.ws + WS_A16); const float* B16 = (const float*)(a.ws + WS_B16);
        const int d = tid >> 8, s = (tid >> 6) & 3, c = tid & 63, P0 = d ? P0b : P0f, lo = (P0 * s) >> 2, hi = (P0 * (s + 1)) >> 2;
        const size_t b16 = (size_t)((b * 2 + d) * NP16 + 4 * P0 + 8 * s) * 512 + 64 * h + c; float ai8[8], bi8[8];
#pragma unroll
        for (int i = 0; i < 8; ++i) { ai8[i] = A16[b16 + (size_t)i * 512]; bi8[i] = B16[b16 + (size_t)i * 512]; }
        const size_t base = (size_t)((b * 2 + d) * NPJ) * 512 + 64 * h + c; float A = 1.f, Bv = 0.f;
#pragma unroll 8
        for (int i = lo; i < hi; ++i) { const float ai = AGGA[base + (size_t)i * 512], bi = AGGB[base + (size_t)i * 512]; Bv = ai * Bv + bi; A *= ai; }
        LAS float* FO = (LAS float*)(lds + RG_FOLD); LAS float* F8 = (LAS float*)(lds + RG_F8); LAS float* CAR = (LAS float*)(lds + RG_CAR);
        FO[((d * 4 + s) * 64 + c) * 2] = A; FO[((d * 4 + s) * 64 + c) * 2 + 1] = Bv;
        float A8 = 1.f, B8 = 0.f;
#pragma unroll
        for (int i = 0; i < 8; ++i) { B8 = ai8[i] * B8 + bi8[i]; A8 *= ai8[i]; }
        F8[((d * 4 + s) * 64 + c) * 2] = A8; F8[((d * 4 + s) * 64 + c) * 2 + 1] = B8;
        __syncthreads();
        float S = 0.f;
#pragma unroll
        for (int s2 = 0; s2 < 4; ++s2) S = FO[((d * 4 + s2) * 64 + c) * 2] * S + FO[((d * 4 + s2) * 64 + c) * 2 + 1];
#pragma unroll
        for (int s2 = 0; s2 < 3; ++s2) if (s2 < s) S = F8[((d * 4 + s2) * 64 + c) * 2] * S + F8[((d * 4 + s2) * 64 + c) * 2 + 1];
#pragma unroll
        for (int i = 0; i < 8; ++i) { CAR[(d * 32 + 8 * s + i) * 64 + c] = S; S = ai8[i] * S + bi8[i]; }
    }
    __syncthreads();
    if (wave < (is_ctx ? 4 : 8)) {
        const int j = is_ctx ? wave : 8 * cgp + wave;
        const int seg_lo = is_ctx ? MLAT + b * CTXL : b * SEQ, seg_hi = seg_lo + (is_ctx ? CTXL : SEQ), r0 = seg_lo + 64 * j;
        const int pjf = is_ctx ? j : 4 + j, pjb = is_ctx ? 3 - j : 131 - j;
        LAS unsigned char* wl = lds + RG_WAVE + wave * RG_WAVE_BYTES;
        rg_sweep<FINAL, 1>(a, lds, wl, l, b, h, r0, seg_lo, seg_hi, pjb, is_ctx, wave, lane);
        rg_sweep<FINAL, 0>(a, lds, wl, l, b, h, r0, seg_lo, seg_hi, pjf, is_ctx, wave, lane);
    }
    __syncthreads();
}

#define RLX_AGENT __ATOMIC_RELAXED, __HIP_MEMORY_SCOPE_AGENT


#define XB_TMO      128
#define XB_XCNT(j)  (256  + 64 * (j))
#define XB_XSUB(j)  (1280 + 64 * (j))
#define XB_XGEN(j)  (2304 + 64 * (j))
#define XB_TOP      3328
#define XB_TOPGEN   3392
#define XCD_BAR_WORDS 3456
#define XB_SPIN_CAP (1u << 18)

__device__ __forceinline__ unsigned xb_ld(unsigned* p)              { return __hip_atomic_load(p, __ATOMIC_RELAXED, __HIP_MEMORY_SCOPE_AGENT); }
__device__ __forceinline__ unsigned xb_add(unsigned* p, unsigned v) { return __hip_atomic_fetch_add(p, v, __ATOMIC_RELAXED, __HIP_MEMORY_SCOPE_AGENT); }
__device__ __forceinline__ unsigned xb_xcc_id() { return (unsigned)__builtin_amdgcn_s_getreg((3 << 11) | 20) & 0xFu; }
#define XB_SPIN(cond, bar) do { unsigned _sp = 0; while (cond) { __builtin_amdgcn_s_sleep(1); \
    if ((++_sp & 255u) == 0u) { if (xb_ld(&(bar)[XB_TMO])) break; if (_sp > XB_SPIN_CAP) { atomicAdd(&(bar)[XB_TMO], 1u); break; } } } } while (0)

struct XcdBarrier {
    unsigned* bar; unsigned x;
    volatile LAS unsigned* st;
};

__device__ __forceinline__ XcdBarrier xcd_barrier_post(unsigned* bar, volatile LAS unsigned* st) {
    XcdBarrier b; b.bar = bar; b.x = xb_xcc_id(); b.st = st;
    if (threadIdx.x == 0) (void)xb_add(&bar[XB_XCNT(b.x)], 1u);
    return b;
}
__device__ __forceinline__ void xcd_barrier_complete(unsigned* bar, unsigned x, unsigned& nloc, unsigned& nx) {
    const unsigned G = gridDim.x * gridDim.y * gridDim.z;
    unsigned sum, cnt, mine, sp = 0u;
    for (;;) {
        sum = 0u; cnt = 0u; mine = 0u;
#pragma unroll
        for (unsigned j = 0; j < 16; ++j) { const unsigned c = xb_ld(&bar[XB_XCNT(j)]); sum += c; cnt += (c > 0u) ? 1u : 0u; mine = (j == x) ? c : mine; }
        if (sum == G) break;
        __builtin_amdgcn_s_sleep(1);
        if ((++sp & 255u) == 0u) { if (xb_ld(&bar[XB_TMO])) break; if (sp > XB_SPIN_CAP) { atomicAdd(&bar[XB_TMO], 1u); break; } }
    }
    nloc = mine > 0u ? mine : 1u; nx = cnt > 0u ? cnt : 1u;
}

__device__ __forceinline__ void xcd_barrier(const XcdBarrier& b) {
    asm volatile("s_waitcnt vmcnt(0)" ::: "memory");
    __syncthreads();
    if (threadIdx.x == 0) {
        unsigned* bar = b.bar;
        __builtin_amdgcn_s_waitcnt(0);
        unsigned nloc = b.st[0], nx = b.st[1];
        if (nloc == 0u) { xcd_barrier_complete(bar, b.x, nloc, nx); b.st[0] = nloc; b.st[1] = nx; }
        const unsigned old = xb_add(&bar[XB_XSUB(b.x)], 1u);
        const unsigned gen = old / nloc;
        if (old + 1u == (gen + 1u) * nloc) {
            __builtin_amdgcn_fence(__ATOMIC_RELEASE, "agent");
            asm volatile("s_waitcnt vmcnt(0)" ::: "memory");
            const unsigned og = xb_add(&bar[XB_TOP], 1u);
            const unsigned tg = og / nx;
            if (og + 1u == (tg + 1u) * nx) xb_add(&bar[XB_TOPGEN], 1u);
            else XB_SPIN(xb_ld(&bar[XB_TOPGEN]) == tg, bar);
            __builtin_amdgcn_fence(__ATOMIC_ACQUIRE, "agent");
            xb_add(&bar[XB_XGEN(b.x)], 1u);
            asm volatile("s_waitcnt vmcnt(0)" ::: "memory");
        } else {
            XB_SPIN(xb_ld(&bar[XB_XGEN(b.x)]) == gen, bar);
            __builtin_amdgcn_fence(__ATOMIC_ACQUIRE, "agent");
            asm volatile("s_waitcnt vmcnt(0)" ::: "memory");
        }
    }
    __syncthreads();
}

__device__ __forceinline__ void layer_phases(int l, const Args& args, LAS unsigned char* lds, const int tid0, const int lo, const int hi, const XcdBarrier& xbar) {
    const int G = gridDim.x; unsigned char* ws = args.ws;
    const int pb = 1 + 5 * l;
#define LAUNDER() int tid = tid0; asm volatile("" : "+v"(tid)); const int lane = tid & 63, wave = __builtin_amdgcn_readfirstlane(tid >> 6); int bx = blockIdx.x; asm volatile("" : "+s"(bx)); (void)lane; (void)wave; (void)bx
#define IN(k) (lo <= (k) && (k) < hi)
#define SEAM(k) do { if (IN(k) && IN((k) + 1)) { xcd_barrier(xbar); } } while (0)
        if (IN(pb)) { LAUNDER(); norm_phase(args, l, lane, wave); }
        SEAM(pb);
        if (IN(pb + 1)) { LAUNDER();
            pg8::Gemm g{(const pg8::bf16_t*)(ws + WS_H), (const pg8::bf16_t*)(ws + WS_BT1) + (size_t)l * NIN * 1024, MROWS, NIN, 1024};
            pg8::StaticOrder S; S.init(MROWS, NIN, G, bx);
            pg8::EpiU E{(pg8::bf16_t*)(ws + WS_U)};
            pg8::gemm_phase<pg8::EpiU, pg8::StaticOrder, true, true>(lds, g, S, E);
        }
        SEAM(pb + 1);
        if (IN(pb + 2)) { LAUNDER();
            const int nrun = (bx >= G - 16) ? 2 : 1;
#pragma unroll 1
            for (int k = 0; k < nrun; ++k) rg_run<false>(args, lds, l, k == 0 ? bx : 256 + (G - 1 - bx), tid, lane, wave);
            const int n_h = 256 + (l == 0 ? 16 : 0), n_conv = 128 + n_h;
            const int GC = G - 16;
            for (int un = bx; un < n_conv && bx < GC; un += GC) {
                if (un < 128) { vconv_unit(args, lds, l, un >> 6, un & 63, tid); }
                else { const int hu = un - 128;
                    if (hu < 256) hconv_unit(args, lds, l, hu * 64, 0, hu * 64, hu * 64 + 64, tid);
                    else { const int cu = hu - 256, cc = cu >> 1, g = cu & 1, bb = cc >> 2; hconv_unit(args, lds, l, MLAT + cc * 64, g, MLAT + bb * CTXL, MLAT + bb * CTXL + CTXL, tid); } }
            }
        }
        SEAM(pb + 2);
        if (IN(pb + 3)) { LAUNDER();
            const int nrun = (l == 0 && bx >= G - 16) ? 2 : 1;
#pragma unroll 1
            for (int k = 0; k < nrun; ++k) rg_run<true>(args, lds, l, k == 0 ? bx : 256 + (G - 1 - bx), tid, lane, wave);
            ln_rows(args, l, (l == 0) ? MROWS : MLAT, lane, wave);
        }
        SEAM(pb + 3);
        if (IN(pb + 4)) { LAUNDER();
            const int M2 = (l == 0) ? MROWS : MLAT;
            pg8::Gemm g{(const pg8::bf16_t*)(ws + WS_MIXIN), (const pg8::bf16_t*)(ws + WS_BT2) + (size_t)l * 1024 * 1024, M2, 1024, 1024};
            pg8::StaticOrder S; S.init(M2, 1024, G, bx);
            pg8::EpiMix E{(pg8::bf16_t*)(ws + WS_MIX), (float*)(ws + WS_SSQ)};
            pg8::gemm_phase<pg8::EpiMix, pg8::StaticOrder, true, true>(lds, g, S, E);
        }
        SEAM(pb + 4);
#undef IN
#undef SEAM
#undef LAUNDER
}

__global__ void __launch_bounds__(NTHR, 2) fwd_megakernel(Args args) {
    extern __shared__ __attribute__((aligned(16))) unsigned char lds_raw[];
    LAS unsigned char* lds = (LAS unsigned char*)lds_raw;
    const int tid = threadIdx.x, lane = tid & 63, wave = __builtin_amdgcn_readfirstlane(tid >> 6);
    const int G = gridDim.x, bx = blockIdx.x;
    unsigned char* ws = args.ws;
    const int lo = args.ph_lo, hi = args.ph_hi;
    if (args.coop == 2) cg::this_grid().sync();
    volatile LAS unsigned* MISC = (volatile LAS unsigned*)(lds + MISC_OFF);
    if (tid < 64) MISC[tid] = 0u;
    __syncthreads();
    XcdBarrier xbar; xbar.bar = (unsigned*)(ws + WS_CTL); xbar.x = 0; xbar.st = nullptr;
    if (args.coop == 1) xbar = xcd_barrier_post((unsigned*)(ws + WS_CTL), MISC + 8);
#define IN(k) (lo <= (k) && (k) < hi)
#define SEAM(k) do { if (IN(k) && IN((k) + 1)) { xcd_barrier(xbar); } } while (0)

    if (IN(0)) { p0_prologue(args, lds, tid, lane, wave); }
    SEAM(0);
#pragma unroll 1
    for (int l = 0; l < 2; ++l) { int lo_ = l; asm volatile("" : "+s"(lo_)); layer_phases(lo_, args, lds, tid, lo, hi, xbar); }
    if (IN(11)) { norm_phase(args, 2, lane, wave); }
#undef IN
#undef SEAM
}

#ifndef MK_PER_PHASE
#define MK_PER_PHASE 0
#endif
extern "C" void kernel_launch(void* const* d_in, const int* in_sizes, int n_in, void* d_out, int out_size, void* d_ws, size_t ws_size, hipStream_t stream) {
    static int grid = 0;
    if (grid == 0) {
        if (n_in != 21 || out_size != MLAT * DM || ws_size < WS_END) { fprintf(stderr, "kernel_launch: unexpected shapes (n_in %d, out %d, ws %zu)\n", n_in, out_size, ws_size); grid = -1; return; }
        int dev = 0, cus = 0, per_cu = 0;
        if (hipGetDevice(&dev) != hipSuccess || hipDeviceGetAttribute(&cus, hipDeviceAttributeMultiprocessorCount, dev) != hipSuccess) { grid = -1; return; }
        if (hipFuncSetAttribute((const void*)fwd_megakernel, hipFuncAttributeMaxDynamicSharedMemorySize, LDS_BYTES) != hipSuccess) { fprintf(stderr, "kernel_launch: hipFuncSetAttribute failed\n"); grid = -1; return; }
        if (hipOccupancyMaxActiveBlocksPerMultiprocessor(&per_cu, (const void*)fwd_megakernel, NTHR, LDS_BYTES) != hipSuccess || per_cu < 1) { fprintf(stderr, "kernel_launch: occupancy query says %d\n", per_cu); per_cu = 1; }
        (void)hipGetLastError();
        grid = cus;
    }
    if (grid < 0) return;
    if (hipMemsetAsync((char*)d_ws + WS_CTL, 0, CTL_ZERO_BYTES, stream) != hipSuccess) { fprintf(stderr, "kernel_launch: memset failed\n"); return; }
    Args a{};
    for (int i = 0; i < 21; ++i) a.in[i] = (const float*)d_in[i];
    a.out = (float*)d_out; a.ws = (unsigned char*)d_ws;
#if MK_PER_PHASE
    for (int ph = 0; ph < 12; ++ph) { a.ph_lo = ph; a.ph_hi = ph + 1; a.coop = 0;
        hipLaunchKernelGGL(fwd_megakernel, dim3(grid), dim3(NTHR), LDS_BYTES, stream, a); }
#else
    a.ph_lo = 0; a.ph_hi = 12; a.coop = 1;
    void* kargs[] = {&a};
    hipError_t e = hipLaunchCooperativeKernel((const void*)fwd_megakernel, dim3(grid), dim3(NTHR), kargs, LDS_BYTES, stream);
    if (e != hipSuccess) fprintf(stderr, "cooperative launch failed: %s (grid %d)\n", hipGetErrorString(e), grid);
#endif
}
```

```cpp
#include <hip/hip_runtime.h>
#include <hip/hip_cooperative_groups.h>
#include <cstdio>
#include <cstdint>
namespace cg = cooperative_groups;
#define MK_PER_PHASE 0
namespace pg8 {
#define PG8_LAS __attribute__((address_space(3)))
typedef unsigned short bf16_t;
typedef short bf16x8 __attribute__((ext_vector_type(8)));
typedef float f32x4 __attribute__((ext_vector_type(4)));
typedef unsigned u32x4 __attribute__((ext_vector_type(4)));
constexpr int BM = 256, BK = 64, HALF = 128, HTB = HALF * BK * 2  , STAGE_BYTES = 8 * HTB, NXCD = 8, WGM = 8;

__host__ __device__ __forceinline__ int lds_byte(int r, int c) { const int st = (r >> 4) * 2 + (c >> 5), rr = r & 15, cc = c & 31, ob = rr * 64 + cc * 2; return st * 1024 + (ob ^ (((ob >> 9) & 1) << 5)); }
__host__ __device__ __forceinline__ void stage_rc(int b, int& R, int& C) { const int st = b / 1024, sb = b % 1024, swz = sb ^ (((sb >> 9) & 1) << 5); R = (st >> 1) * 16 + swz / 64; C = (st & 1) * 32 + (swz % 64) / 2; }
__host__ __device__ __forceinline__ int perm32(int rho) { const int n = rho >> 4, i = rho & 15; return 8 * (i >> 2) + 4 * n + (i & 3); }

struct Unit { int pm, pn; };
struct Gemm { const bf16_t* A; const bf16_t* Bt; int M, N, K; };

struct StaticOrder {
    int nM, nN, nwg, G, c;
    __host__ __device__ void init(int M, int N, int G_, int c_) { nM = M / BM; nN = N / BM; nwg = nM * nN; G = G_; c = c_; }
    __host__ __device__ bool next(int i, Unit& u) const {
        const long L = (long)i * G + c; if (L >= nwg) return false;
        int wgid = (int)L; { const int q = nwg / NXCD, r = nwg % NXCD, xcd = wgid % NXCD, off = wgid / NXCD; wgid = (xcd < r ? xcd * (q + 1) : r * (q + 1) + (xcd - r) * q) + off; }
        const int nig = WGM * nN, gid = wgid / nig, fm = gid * WGM, gsz = (nM - fm) < WGM ? (nM - fm) : WGM;
        u.pm = fm + ((wgid % nig) % gsz); u.pn = (wgid % nig) / gsz; return true;
    }
    __device__ __forceinline__ void a_ready(const Unit&) const {}
    __device__ __forceinline__ void done(const Unit&) const {}
};
__device__ __forceinline__ unsigned cvt_pk_bf16(float lo, float hi) { unsigned r; asm volatile("v_cvt_pk_bf16_f32 %0, %1, %2" : "=v"(r) : "v"(lo), "v"(hi)); return r; }
typedef float f32x2 __attribute__((ext_vector_type(2)));
template <class Epi, class Sched, bool ALIGN_EPI = false, bool SP2 = false>
__device__ __forceinline__ void gemm_phase(PG8_LAS unsigned char* lds, const Gemm g, const Sched& S, const Epi& E) {
    const int tid = threadIdx.x, wid = __builtin_amdgcn_readfirstlane(tid >> 6), lane = tid & 63, wr = wid >> 2, wc = wid & 3, fr = lane & 15, fq = lane >> 4;
    const int K = g.K, nt = K / BK;
    unsigned voffA[2], voffB[2];
#pragma unroll
    for (int i = 0; i < 2; ++i) { int R, C; stage_rc(tid * 16 + i * 8192, R, C); const int Rb = Epi::PERM ? ((R & ~31) + perm32(R & 31)) : R;
        voffA[i] = (unsigned)(R * K + C) * 2u; voffB[i] = (unsigned)(Rb * K + C) * 2u; }
    const size_t kstep = (size_t)(BK * 2);
    const size_t hstep = (size_t)HALF * K * 2;
    const size_t tstep = 2 * hstep;
    const unsigned ldsw = (unsigned)wid * 1024u;
    const int aoff = lds_byte(wr * 64 + fr, fq * 8), boff = lds_byte(wc * 32 + fr, fq * 8);
#define PG8_SA(b, h) (((b) * 2 + (h)) * HTB)
#define PG8_SB(b, h) ((4 + (b) * 2 + (h)) * HTB)
#define PG8_STAGE(bufoff, gbase, voff) do { _Pragma("unroll") for (int _i = 0; _i < 2; ++_i) \
        __builtin_amdgcn_global_load_lds((const unsigned*)((const char*)(gbase) + (voff)[_i]), (PG8_LAS unsigned*)(lds + (bufoff) + ldsw + _i * 8192), 16, 0, 0); } while (0)
#define PG8_LDA(dst, b, h) do { _Pragma("unroll") for (int m = 0; m < 4; ++m) _Pragma("unroll") for (int k = 0; k < 2; ++k) dst[m][k] = *(const PG8_LAS bf16x8*)(lds + PG8_SA(b, h) + aoff + m * 2048 + k * 1024); } while (0)
#define PG8_LDB(dst, b, h) do { _Pragma("unroll") for (int n = 0; n < 2; ++n) _Pragma("unroll") for (int k = 0; k < 2; ++k) dst[n][k] = *(const PG8_LAS bf16x8*)(lds + PG8_SB(b, h) + boff + n * 2048 + k * 1024); } while (0)
#define PG8_MMA(ai, bj, At, Bt) do { __builtin_amdgcn_s_setprio(1); _Pragma("unroll") for (int m = 0; m < 4; ++m) _Pragma("unroll") for (int n = 0; n < 2; ++n) _Pragma("unroll") for (int k = 0; k < 2; ++k) \
        acc[ai][bj][m][n] = __builtin_amdgcn_mfma_f32_16x16x32_bf16(Bt[n][k], At[m][k], acc[ai][bj][m][n], 0, 0, 0); __builtin_amdgcn_s_setprio(0); } while (0)
#define PG8_WAIT_V(n) asm volatile("s_waitcnt vmcnt(" #n ")" ::: "memory")
#define PG8_WAIT_L(n) asm volatile("s_waitcnt lgkmcnt(" #n ")" ::: "memory")
#define PG8_BAR __builtin_amdgcn_s_barrier()
#define PG8_SCHED __builtin_amdgcn_sched_barrier(0)
    Unit cur, nxt; int ui = 0;
    if (!S.next(0, cur)) return;
    f32x4 acc[2][2][4][2];
#pragma unroll
    for (int a = 0; a < 2; ++a)
#pragma unroll
        for (int b = 0; b < 2; ++b)
#pragma unroll
            for (int m = 0; m < 4; ++m)
#pragma unroll
                for (int n = 0; n < 2; ++n) acc[a][b][m][n] = (f32x4){0.f, 0.f, 0.f, 0.f};
    bf16x8 At[4][2], B0[2][2], B1[2][2];
    const char* cA = (const char*)g.A + (size_t)cur.pm * tstep; const char* cB = (const char*)g.Bt + (size_t)cur.pn * tstep;
    S.a_ready(cur);
    if constexpr (SP2) {
        PG8_STAGE(PG8_SB(0, 0), cB, voffB); PG8_STAGE(PG8_SB(0, 1), cB + hstep, voffB); PG8_STAGE(PG8_SA(0, 0), cA, voffA); PG8_STAGE(PG8_SA(0, 1), cA + hstep, voffA);
        if (wr == 1) PG8_BAR;
        PG8_WAIT_V(2); PG8_BAR;
        PG8_STAGE(PG8_SB(1, 0), cB + kstep, voffB); PG8_STAGE(PG8_SA(1, 0), cA + kstep, voffA); PG8_STAGE(PG8_SB(1, 1), cB + hstep + kstep, voffB);
        PG8_WAIT_V(6); PG8_BAR;
    } else {
        PG8_STAGE(PG8_SB(0, 0), cB, voffB); PG8_STAGE(PG8_SA(0, 0), cA, voffA); PG8_STAGE(PG8_SB(0, 1), cB + hstep, voffB); PG8_STAGE(PG8_SA(0, 1), cA + hstep, voffA);
        if (wr == 1) PG8_BAR;
        PG8_WAIT_V(4); PG8_BAR;
        PG8_STAGE(PG8_SB(1, 0), cB + kstep, voffB); PG8_STAGE(PG8_SA(1, 0), cA + kstep, voffA); PG8_STAGE(PG8_SB(1, 1), cB + hstep + kstep, voffB);
        PG8_WAIT_V(6); PG8_BAR;
    }
    for (;;) {
        const bool has_next = S.next(ui + 1, nxt);
        const char* nA = has_next ? (const char*)g.A + (size_t)nxt.pm * tstep : cA; const char* nB = has_next ? (const char*)g.Bt + (size_t)nxt.pn * tstep : cB;
        for (int t = 0; t < nt; t += 2) {
            const bool last = (t == nt - 2);
            const char* a1 = cA + (size_t)(t + 1) * kstep;
            const char* a2 = last ? nA : cA + (size_t)(t + 2) * kstep; const char* b2 = last ? nB : cB + (size_t)(t + 2) * kstep;
            const char* a3 = a2 + kstep; const char* b3 = b2 + kstep;
            if (last && has_next) S.a_ready(nxt);
            if constexpr (SP2) {
            PG8_LDB(B0, 0, 0); PG8_LDB(B1, 0, 1); PG8_SCHED; PG8_LDA(At, 0, 0); PG8_STAGE(PG8_SA(1, 1), a1 + hstep, voffA);
            PG8_WAIT_V(8); PG8_WAIT_L(0); PG8_BAR; PG8_MMA(0, 0, At, B0); PG8_MMA(0, 1, At, B1); PG8_BAR; PG8_SCHED;
            PG8_LDA(At, 0, 1); PG8_STAGE(PG8_SB(0, 0), b2, voffB); PG8_STAGE(PG8_SB(0, 1), b2 + hstep, voffB); PG8_STAGE(PG8_SA(0, 0), a2, voffA);
            PG8_WAIT_V(8); PG8_WAIT_L(0); PG8_BAR; PG8_MMA(1, 0, At, B0); PG8_MMA(1, 1, At, B1); PG8_BAR; PG8_SCHED;
            PG8_LDB(B0, 1, 0); PG8_LDB(B1, 1, 1); PG8_SCHED; PG8_LDA(At, 1, 0); PG8_STAGE(PG8_SA(0, 1), a2 + hstep, voffA);
            PG8_WAIT_V(8); PG8_WAIT_L(0); PG8_BAR; PG8_MMA(0, 0, At, B0); PG8_MMA(0, 1, At, B1); PG8_BAR; PG8_SCHED;
            PG8_LDA(At, 1, 1); PG8_STAGE(PG8_SB(1, 0), b3, voffB); PG8_STAGE(PG8_SB(1, 1), b3 + hstep, voffB); PG8_STAGE(PG8_SA(1, 0), a3, voffA);
            PG8_WAIT_V(8); PG8_WAIT_L(0); PG8_BAR; PG8_MMA(1, 0, At, B0); PG8_MMA(1, 1, At, B1); PG8_BAR; PG8_SCHED;
            } else {
            PG8_LDB(B0, 0, 0); PG8_SCHED; PG8_LDA(At, 0, 0); PG8_STAGE(PG8_SA(1, 1), a1 + hstep, voffA);
            PG8_WAIT_L(8); PG8_BAR; PG8_WAIT_L(0); PG8_MMA(0, 0, At, B0); PG8_BAR; PG8_SCHED;
            PG8_LDB(B1, 0, 1); PG8_STAGE(PG8_SB(0, 0), b2, voffB);
            PG8_BAR; PG8_WAIT_L(0); PG8_MMA(0, 1, At, B1); PG8_BAR;
            PG8_LDA(At, 0, 1); PG8_STAGE(PG8_SA(0, 0), a2, voffA);
            PG8_BAR; PG8_WAIT_L(0); PG8_MMA(1, 0, At, B0); PG8_BAR; PG8_SCHED;
            PG8_STAGE(PG8_SB(0, 1), b2 + hstep, voffB);
            PG8_WAIT_V(6); PG8_BAR; PG8_MMA(1, 1, At, B1); PG8_BAR;
            PG8_LDB(B0, 1, 0); PG8_SCHED; PG8_LDA(At, 1, 0); PG8_STAGE(PG8_SA(0, 1), a2 + hstep, voffA);
            PG8_WAIT_L(8); PG8_BAR; PG8_WAIT_L(0); PG8_MMA(0, 0, At, B0); PG8_BAR; PG8_SCHED;
            PG8_LDB(B1, 1, 1); PG8_STAGE(PG8_SB(1, 0), b3, voffB);
            PG8_BAR; PG8_WAIT_L(0); PG8_MMA(0, 1, At, B1); PG8_BAR;
            PG8_LDA(At, 1, 1); PG8_STAGE(PG8_SA(1, 0), a3, voffA);
            PG8_BAR; PG8_WAIT_L(0); PG8_MMA(1, 0, At, B0); PG8_BAR; PG8_SCHED;
            PG8_STAGE(PG8_SB(1, 1), b3 + hstep, voffB);
            PG8_WAIT_V(6); PG8_BAR; PG8_MMA(1, 1, At, B1); PG8_BAR;
            }
        }
        if constexpr (ALIGN_EPI) { if (wr == 0) PG8_BAR; }
        if constexpr (!Epi::AFTER_DRAIN) { E(acc, cur, wr, wc, fr, fq); S.done(cur); }
        if (!has_next) break;
#pragma unroll
        for (int a = 0; a < 2; ++a)
#pragma unroll
            for (int b = 0; b < 2; ++b)
#pragma unroll
                for (int m = 0; m < 4; ++m)
#pragma unroll
                    for (int n = 0; n < 2; ++n) acc[a][b][m][n] = (f32x4){0.f, 0.f, 0.f, 0.f};
        cur = nxt; cA = nA; cB = nB; ++ui;
        if constexpr (ALIGN_EPI) { if (wr == 1) PG8_BAR; }
    }
    PG8_WAIT_V(0);
    if constexpr (!ALIGN_EPI) { if (wr == 0) PG8_BAR; }
    PG8_BAR;
    if constexpr (Epi::AFTER_DRAIN) { E.fused(acc, cur, wr, wc, fr, fq, lds, wid, lane); S.done(cur); }
#undef PG8_SA
#undef PG8_SB
#undef PG8_STAGE
#undef PG8_LDA
#undef PG8_LDB
#undef PG8_MMA
#undef PG8_WAIT_V
#undef PG8_WAIT_L
#undef PG8_BAR
#undef PG8_SCHED
}
}

constexpr int DM = 1024, NB = 2, SEQ = 8192, CTXL = 256, MLAT = NB * SEQ, MCTX = NB * CTXL, MROWS = MLAT + MCTX;
constexpr int NIN = 2560, NCHUNK = MROWS / 64  , NPJ = 132  ;
constexpr float EPSF = 1e-6f;
constexpr int NWAVES = 8, NTHR = 512;

constexpr size_t MiB = 1u << 20;
constexpr size_t WS_CTL = 0, CTL_ZERO_BYTES = 64 * 1024;
constexpr size_t WS_MOD = 1 * MiB;
constexpr size_t WS_SP8 = 1 * MiB + 128 * 1024;
constexpr size_t WS_GWF = 1 * MiB + 256 * 1024;
constexpr size_t WS_BT1 = 2 * MiB;
constexpr size_t WS_BT2 = 12 * MiB;
constexpr size_t WS_AGGA = 16 * MiB;
constexpr size_t WS_AGGB = 16 * MiB + 1536 * 1024;
constexpr size_t WS_SSQ = 19 * MiB;
constexpr size_t WS_XC1 = 21 * MiB;
constexpr size_t WS_A16 = 23 * MiB;
constexpr size_t WS_B16 = 28 * MiB;
constexpr size_t WS_H = 73 * MiB;
constexpr size_t WS_Y = 56 * MiB;
constexpr size_t WS_MIXIN = 73 * MiB;
constexpr size_t WS_U = 106 * MiB;
constexpr size_t WS_MIX = 189 * MiB;
constexpr size_t WS_END = 255 * MiB;

constexpr int LDS_BYTES = 158720;
constexpr int MISC_OFF = 157696;

#define LAS __attribute__((address_space(3)))
typedef unsigned short bf16;
typedef unsigned v4u __attribute__((ext_vector_type(4)));
typedef unsigned v2u __attribute__((ext_vector_type(2)));
typedef float f32x4 __attribute__((ext_vector_type(4)));
typedef short bf16x8 __attribute__((ext_vector_type(8)));
typedef float f32x2v __attribute__((ext_vector_type(2)));
#define LDS_WAIT() asm volatile("s_waitcnt lgkmcnt(0)" ::: "memory")

__device__ __forceinline__ unsigned f2bf(float f) { unsigned u = __builtin_bit_cast(unsigned, f); return (u + 0x7fffu + ((u >> 16) & 1u)) >> 16; }
__device__ __forceinline__ unsigned pk2(float lo, float hi) { return f2bf(lo) | (f2bf(hi) << 16); }
__device__ __forceinline__ unsigned cvtpk(float lo, float hi) { unsigned r; asm volatile("v_cvt_pk_bf16_f32 %0, %1, %2" : "=v"(r) : "v"(lo), "v"(hi)); return r; }
__device__ __forceinline__ float bflo(unsigned u) { return __builtin_bit_cast(float, u << 16); }
__device__ __forceinline__ float bfhi(unsigned u) { return __builtin_bit_cast(float, u & 0xffff0000u); }
__device__ __forceinline__ float sigmoidf_(float x) { return 1.0f / (1.0f + __expf(-x)); }
__device__ __forceinline__ float siluf_(float x) { return x / (1.0f + __expf(-x)); }
__device__ __forceinline__ float wave_sum(float v) {
#pragma unroll
    for (int o = 1; o < 64; o <<= 1) v += __shfl_xor(v, o);
    return v;
}

struct Args {
    const float* in[21]; float* out; unsigned char* ws; int ph_lo, ph_hi, coop, pad;
};
enum { I_X = 0, I_C, I_CTX, I_CCTX, I_WMOD, I_BMOD, I_GPRE, I_GPOST, I_WIN, I_CAW, I_CAB, I_WR, I_BR, I_WI, I_BI, I_LAM, I_DWW, I_DWB, I_LNG, I_LNB, I_WOUT };

namespace pg8 {
struct EpiU {
    static constexpr bool PERM = true, AFTER_DRAIN = false;
    bf16_t* O;
    __device__ __forceinline__ void operator()(const f32x4 (&acc)[2][2][4][2], const Unit& u, int wr, int wc, int fr, int fq) const {
        const int row0 = u.pm * BM + wr * 64 + fr;
        if (u.pn >= 4 && u.pn < 8) {
            const int col0 = 1024 + 128 * (u.pn - 4) + wc * 32 + 8 * fq;
#pragma unroll
            for (int ai = 0; ai < 2; ++ai)
#pragma unroll
                for (int m = 0; m < 4; ++m) { f32x4 v0 = acc[ai][0][m][0], v1 = acc[ai][0][m][1]; const f32x4 g0 = acc[ai][1][m][0], g1 = acc[ai][1][m][1];
#pragma unroll
                    for (int e = 0; e < 4; ++e) { v0[e] = v0[e] * __builtin_amdgcn_rcpf(1.0f + __expf(-g0[e])); v1[e] = v1[e] * __builtin_amdgcn_rcpf(1.0f + __expf(-g1[e])); }
                    u32x4 w; w.x = cvt_pk_bf16(v0[0], v0[1]); w.y = cvt_pk_bf16(v0[2], v0[3]); w.z = cvt_pk_bf16(v1[0], v1[1]); w.w = cvt_pk_bf16(v1[2], v1[3]);
                    *(u32x4*)(O + (size_t)(row0 + ai * HALF + m * 16) * 2560 + col0) = w; }
            return;
        }
        const int col0 = u.pn * BM + wc * 32 + 8 * fq;
        const bool act = (u.pn == 2 || u.pn == 3 || u.pn >= 8);
#pragma unroll
        for (int ai = 0; ai < 2; ++ai)
#pragma unroll
            for (int m = 0; m < 4; ++m) { bf16_t* rowp = O + (size_t)(row0 + ai * HALF + m * 16) * 2560 + col0;
#pragma unroll
                for (int bj = 0; bj < 2; ++bj) { f32x4 v0 = acc[ai][bj][m][0], v1 = acc[ai][bj][m][1];
                    if (act) {
#pragma unroll
                        for (int e = 0; e < 4; ++e) { v0[e] = v0[e] * __builtin_amdgcn_rcpf(1.0f + __expf(-v0[e])); v1[e] = v1[e] * __builtin_amdgcn_rcpf(1.0f + __expf(-v1[e])); }
                    }
                    u32x4 w; w.x = cvt_pk_bf16(v0[0], v0[1]); w.y = cvt_pk_bf16(v0[2], v0[3]); w.z = cvt_pk_bf16(v1[0], v1[1]); w.w = cvt_pk_bf16(v1[2], v1[3]);
                    *(u32x4*)(rowp + bj * HALF) = w; } }
    }
};
struct EpiMix {
    static constexpr bool PERM = true, AFTER_DRAIN = false;
    bf16_t* O; float* ssq;
    __device__ __forceinline__ void operator()(const f32x4 (&acc)[2][2][4][2], const Unit& u, int wr, int wc, int fr, int fq) const {
        const int col0 = u.pn * BM + wc * 32 + 8 * fq;
#pragma unroll
        for (int ai = 0; ai < 2; ++ai)
#pragma unroll
            for (int m = 0; m < 4; ++m) { const int r = u.pm * BM + ai * HALF + wr * 64 + m * 16 + fr; bf16_t* rowp = O + (size_t)r * 1024 + col0; float s = 0.f;
#pragma unroll
                for (int bj = 0; bj < 2; ++bj) { const f32x4 v0 = acc[ai][bj][m][0], v1 = acc[ai][bj][m][1];
                    s += ((v0[0] * v0[0] + v0[1] * v0[1]) + (v0[2] * v0[2] + v0[3] * v0[3])) + ((v1[0] * v1[0] + v1[1] * v1[1]) + (v1[2] * v1[2] + v1[3] * v1[3]));
                    u32x4 w; w.x = cvt_pk_bf16(v0[0], v0[1]); w.y = cvt_pk_bf16(v0[2], v0[3]); w.z = cvt_pk_bf16(v1[0], v1[1]); w.w = cvt_pk_bf16(v1[2], v1[3]);
                    *(u32x4*)(rowp + bj * HALF) = w; }
                s += __shfl_xor(s, 16); s += __shfl_xor(s, 32);
                if (fq == 0) ssq[(size_t)r * 16 + u.pn * 4 + wc] = s; }
    }
};
}

__device__ __forceinline__ void p0_transpose_item(const float* W, int K, int N, bf16* WT, LAS float* scr, int item, int lane, bool glu_remap) {
    const int nblk = N / 32, kb = item / nblk, nb = item % nblk, k0 = 64 * kb, n0 = 32 * nb;
    int nd = n0;
    if (glu_remap) { if (n0 >= 1024 && n0 < 1536) nd = 1024 + 256 * ((n0 - 1024) >> 7) + ((n0 - 1024) & 127); else if (n0 >= 1536 && n0 < 2048) nd = 1024 + 256 * ((n0 - 1536) >> 7) + 128 + ((n0 - 1536) & 127); }
#pragma unroll 8
    for (int i = 0; i < 32; ++i) { const int kk = 2 * i + (lane >> 5); scr[kk * 33 + (lane & 31)] = W[(size_t)(k0 + kk) * N + n0 + (lane & 31)]; }
    LDS_WAIT(); asm volatile("" ::: "memory");
    const int c = lane & 7;
#pragma unroll
    for (int j = 0; j < 4; ++j) { const int n = (lane >> 3) + 8 * j; const LAS float* s = scr + (8 * c) * 33 + n;
        v4u o; o.x = pk2(s[0 * 33], s[1 * 33]); o.y = pk2(s[2 * 33], s[3 * 33]); o.z = pk2(s[4 * 33], s[5 * 33]); o.w = pk2(s[6 * 33], s[7 * 33]);
        *(v4u*)(WT + (size_t)(nd + n) * K + k0 + 8 * c) = o; }
    LDS_WAIT(); asm volatile("" ::: "memory");
}

__device__ __forceinline__ void p0_prologue(const Args& a, LAS unsigned char* lds, int tid, int lane, int wave) {
    const int G = gridDim.x, bx = blockIdx.x;
    unsigned char* ws = a.ws;
    {
        LAS float* part = (LAS float*)lds;
        float* MOD = (float*)(ws + WS_MOD);
        const float* c = a.in[I_C]; const float* cctx = a.in[I_CCTX];
        for (int un = bx; un < 192; un += G) {
            const int l = un / 96, n0 = (un % 96) * 32, cq = tid & 7, ks = tid >> 3;
            const float* wm = a.in[I_WMOD] + (size_t)l * 1024 * 3072 + n0 + cq * 4;
            f32x4 acc0 = {0.f, 0.f, 0.f, 0.f}, acc1 = acc0, acc2 = acc0;
#pragma unroll 4
            for (int kk = 0; kk < 16; ++kk) { const int k = ks * 16 + kk; const f32x4 w = *(const f32x4*)(wm + (size_t)k * 3072);
                const float a0 = siluf_(c[k]), a1 = siluf_(c[1024 + k]), a2 = siluf_(cctx[k]);
                acc0 += w * a0; acc1 += w * a1; acc2 += w * a2; }
            *(LAS f32x4*)(part + (0 * 64 + ks) * 32 + cq * 4) = acc0;
            *(LAS f32x4*)(part + (1 * 64 + ks) * 32 + cq * 4) = acc1;
            *(LAS f32x4*)(part + (2 * 64 + ks) * 32 + cq * 4) = acc2;
            __syncthreads();
            if (tid < 96) { const int v = tid >> 5, col = tid & 31; float s = a.in[I_BMOD][l * 3072 + n0 + col];
                for (int k2 = 0; k2 < 64; ++k2) s += part[(v * 64 + k2) * 32 + col];
                MOD[(l * 3 + v) * 3072 + n0 + col] = s; }
            __syncthreads();
        }
    }
    { float* SP8 = (float*)(ws + WS_SP8); for (int idx = bx * NTHR + tid; idx < 2048; idx += G * NTHR) SP8[idx] = -8.0f * log1pf(__expf(-a.in[I_LAM][idx])); }
    {
        v4u* GWF = (v4u*)(ws + WS_GWF);
        for (int idx = bx * NTHR + tid; idx < 32768; idx += G * NTHR) {
            const int ln = idx & 63, kk = (idx >> 6) & 1, ct = (idx >> 7) & 3, h = (idx >> 9) & 7, g = (idx >> 12) & 1, d = (idx >> 13) & 1, l = idx >> 14;
            const float* W = (g == 0 ? a.in[I_WR] : a.in[I_WI]) + (size_t)(((l * 2 + d) * 8 + h) * 64) * 64;
            const int k0 = 32 * kk + 8 * (ln >> 4), col = 16 * ct + (ln & 15);
            float e[8];
#pragma unroll
            for (int j = 0; j < 8; ++j) e[j] = W[(k0 + j) * 64 + col];
            v4u o; o.x = pk2(e[0], e[1]); o.y = pk2(e[2], e[3]); o.z = pk2(e[4], e[5]); o.w = pk2(e[6], e[7]);
            GWF[idx] = o;
        }
    }
    {
        LAS float* scr = (LAS float*)(lds + wave * 16384);
        const int gw = bx * NWAVES + wave, NGW = G * NWAVES;
        constexpr int I_1 = (1024 / 64) * (NIN / 32), I_2 = (1024 / 64) * (1024 / 32), NITEMS = 2 * (I_1 + I_2);
        bf16* BT1 = (bf16*)(ws + WS_BT1); bf16* BT2 = (bf16*)(ws + WS_BT2);
        for (int it = gw; it < NITEMS; it += NGW) {
            int r = it;
            if (r < I_1) { p0_transpose_item(a.in[I_WIN], 1024, NIN, BT1, scr, r, lane, true); continue; } r -= I_1;
            if (r < I_1) { p0_transpose_item(a.in[I_WIN] + (size_t)1024 * NIN, 1024, NIN, BT1 + (size_t)NIN * 1024, scr, r, lane, true); continue; } r -= I_1;
            if (r < I_2) { p0_transpose_item(a.in[I_WOUT], 1024, 1024, BT2, scr, r, lane, false); continue; } r -= I_2;
            p0_transpose_item(a.in[I_WOUT] + (size_t)1024 * 1024, 1024, 1024, BT2 + (size_t)1024 * 1024, scr, r, lane, false);
        }
    }
}

__device__ __forceinline__ void norm_phase(const Args& a, int mode, int lane, int wave) {
    unsigned char* ws = a.ws;
    const float* MOD = (const float*)(ws + WS_MOD); const bf16* MIX = (const bf16*)(ws + WS_MIX); const float* SSQ = (const float*)(ws + WS_SSQ);
    float* XC1 = (float*)(ws + WS_XC1); bf16* H = (bf16*)(ws + WS_H);
    const int gw = blockIdx.x * NWAVES + wave, NGW = gridDim.x * NWAVES;
    const int nrows = (mode == 2) ? MLAT : MROWS, lu = (mode == 1) ? 0 : 1, ln = (mode == 0) ? 0 : 1;
    for (int row = gw; row < nrows; row += NGW) {
        const int vsel = row < MLAT ? (row >> 13) : 2;
        const float* src;
        if (mode == 2) src = a.out + (size_t)row * 1024;
        else src = row < MLAT ? a.in[I_X] + (size_t)row * 1024 : a.in[I_CTX] + (size_t)(row - MLAT) * 1024;
        f32x4 v[4];
#pragma unroll
        for (int j = 0; j < 4; ++j) v[j] = *((const f32x4*)src + lane + 64 * j);
        if (mode >= 1) {
            const float sp = lane < 16 ? SSQ[(size_t)row * 16 + lane] : 0.f;
            const float rstd = rsqrtf(wave_sum(sp) * (1.0f / 1024.0f) + EPSF);
            const float* gate = MOD + (lu * 3 + vsel) * 3072 + 2048; const float* gp = a.in[I_GPOST] + lu * 1024;
#pragma unroll
            for (int j = 0; j < 4; ++j) { const v2u mq = *((const v2u*)(MIX + (size_t)row * 1024) + lane + 64 * j); const f32x4 mx = {bflo(mq.x), bfhi(mq.x), bflo(mq.y), bfhi(mq.y)};
                const f32x4 gt = *((const f32x4*)gate + lane + 64 * j), gv = *((const f32x4*)gp + lane + 64 * j);
                v[j] += gt * (mx * rstd * gv); }
            float* dst = row < MLAT ? a.out + (size_t)row * 1024 : XC1 + (size_t)(row - MLAT) * 1024;
#pragma unroll
            for (int j = 0; j < 4; ++j) *((f32x4*)dst + lane + 64 * j) = v[j];
        }
        if (mode <= 1) {
            float s = 0.f;
#pragma unroll
            for (int j = 0; j < 4; ++j) s += (v[j].x * v[j].x + v[j].y * v[j].y) + (v[j].z * v[j].z + v[j].w * v[j].w);
            const float r = rsqrtf(wave_sum(s) * (1.0f / 1024.0f) + EPSF);
            const float* shift = MOD + (ln * 3 + vsel) * 3072; const float* scale = shift + 1024; const float* gpre = a.in[I_GPRE] + ln * 1024;
            v2u* o8 = (v2u*)(H + (size_t)row * 1024);
#pragma unroll
            for (int j = 0; j < 4; ++j) { const f32x4 sh = *((const f32x4*)shift + lane + 64 * j), sc = *((const f32x4*)scale + lane + 64 * j), gv = *((const f32x4*)gpre + lane + 64 * j);
                const f32x4 hv = v[j] * r * gv * (sc + 1.0f) + sh;
                v2u w; w.x = pk2(hv.x, hv.y); w.y = pk2(hv.z, hv.w); o8[lane + 64 * j] = w; }
        }
    }
}

__device__ __forceinline__ void conv16(const LAS unsigned* vt, const float (&w0)[31], const float (&w1)[31], float b0, float b1, float (&o0)[16], float (&o1)[16]) {
#pragma unroll
    for (int t = 0; t < 16; ++t) { o0[t] = b0; o1[t] = b1; }
#pragma unroll
    for (int rr = 0; rr < 46; ++rr) { const unsigned u = vt[rr * 128]; const float lo = bflo(u), hi = bfhi(u);
#pragma unroll
        for (int t = 0; t < 16; ++t) { const int k = rr - t; if (k >= 0 && k < 31) { o0[t] += w0[k] * lo; o1[t] += w1[k] * hi; } }
        if ((rr & 3) == 3) asm volatile("" ::: "memory"); }
}
__device__ __forceinline__ v4u glu8(const v4u vq, const v4u gq) {
    v4u o;
    o.x = pk2(bflo(vq.x) * sigmoidf_(bflo(gq.x)), bfhi(vq.x) * sigmoidf_(bfhi(gq.x)));
    o.y = pk2(bflo(vq.y) * sigmoidf_(bflo(gq.y)), bfhi(vq.y) * sigmoidf_(bfhi(gq.y)));
    o.z = pk2(bflo(vq.z) * sigmoidf_(bflo(gq.z)), bfhi(vq.z) * sigmoidf_(bfhi(gq.z)));
    o.w = pk2(bflo(vq.w) * sigmoidf_(bflo(gq.w)), bfhi(vq.w) * sigmoidf_(bfhi(gq.w)));
    return o;
}
__device__ __forceinline__ void hconv_unit(const Args& a, LAS unsigned char* lds, int l, int r0, int g, int vlo, int vhi, int tid) {
    const bf16* U = (const bf16*)(a.ws + WS_U); bf16* Y = (bf16*)(a.ws + WS_Y);
    LAS unsigned* VT = (LAS unsigned*)lds;
    {
        v4u vq[6];
#pragma unroll
        for (int it = 0; it < 6; ++it) { const int i = tid + it * NTHR, rr = i >> 5, ch = i & 31, row = r0 - 15 + rr; const bool ok = i < 94 * 32 && row >= vlo && row < vhi;
            vq[it] = *(const v4u*)(U + (size_t)(ok ? row : r0) * NIN + 1024 + g * 256 + ch * 8); }
#pragma unroll
        for (int it = 0; it < 6; ++it) { const int i = tid + it * NTHR, rr = i >> 5, ch = i & 31, row = r0 - 15 + rr; const bool ok = row >= vlo && row < vhi;
            if (i < 94 * 32) { const v4u z = {0u, 0u, 0u, 0u}; *(LAS v4u*)(VT + rr * 128 + ch * 4) = ok ? vq[it] : z; } }
    }
    __syncthreads();
    int p = tid & 127; asm volatile("" : "+v"(p));
    const int tg = tid >> 7, c0 = g * 256 + 2 * p;
    float w0[31], w1[31];
#pragma unroll
    for (int k = 0; k < 31; ++k) { const float2 w = *(const float2*)(a.in[I_DWW] + (size_t)(l * 31 + k) * 512 + c0); w0[k] = w.x; w1[k] = w.y; }
    const float2 bb = *(const float2*)(a.in[I_DWB] + l * 512 + c0);
    float o0[16], o1[16];
    conv16(VT + (tg * 16) * 128 + p, w0, w1, bb.x, bb.y, o0, o1);
#pragma unroll
    for (int t = 0; t < 16; ++t) *(unsigned*)(Y + (size_t)(r0 + tg * 16 + t) * 512 + c0) = pk2(o0[t], o1[t]);
    __syncthreads();
}
__device__ __forceinline__ void vconv_unit(const Args& a, LAS unsigned char* lds, int l, int b, int w, int tid) {
    const bf16* U = (const bf16*)(a.ws + WS_U); bf16* Y = (bf16*)(a.ws + WS_Y);
    LAS unsigned* VT = (LAS unsigned*)lds;
#pragma unroll 1
    for (int hb = 0; hb < 2; ++hb) {
        v4u vq[5];
#pragma unroll
        for (int it = 0; it < 5; ++it) { const int i = tid + (hb * 5 + it) * NTHR, rr = i >> 5, ch = i & 31, gr = rr - 15; const bool ok = i < 158 * 32 && gr >= 0 && gr < 128;
            vq[it] = *(const v4u*)(U + (size_t)(b * SEQ + (ok ? gr : 0) * 64 + w) * NIN + 1024 + 256 + ch * 8); }
#pragma unroll
        for (int it = 0; it < 5; ++it) { const int i = tid + (hb * 5 + it) * NTHR, rr = i >> 5, ch = i & 31, gr = rr - 15; const bool ok = gr >= 0 && gr < 128;
            if (i < 158 * 32) { const v4u z = {0u, 0u, 0u, 0u}; *(LAS v4u*)(VT + rr * 128 + ch * 4) = ok ? vq[it] : z; } }
    }
    __syncthreads();
    int p = tid & 127; asm volatile("" : "+v"(p));
    const int tg = tid >> 7, c0 = 256 + 2 * p;
    float w0[31], w1[31];
#pragma unroll
    for (int k = 0; k < 31; ++k) { const float2 wv = *(const float2*)(a.in[I_DWW] + (size_t)(l * 31 + k) * 512 + c0); w0[k] = wv.x; w1[k] = wv.y; }
    const float2 bb = *(const float2*)(a.in[I_DWB] + l * 512 + c0);
#pragma unroll 1
    for (int half = 0; half < 2; ++half) {
        const int tb = tg * 32 + half * 16;
        float o0[16], o1[16];
        conv16(VT + tb * 128 + p, w0, w1, bb.x, bb.y, o0, o1);
#pragma unroll
        for (int t = 0; t < 16; ++t) *(unsigned*)(Y + (size_t)(b * SEQ + (tb + t) * 64 + w) * 512 + c0) = pk2(o0[t], o1[t]);
    }
    __syncthreads();
}
__device__ __forceinline__ void ln_rows(const Args& a, int l, int nrows, int lane, int wave) {
    const bf16* U = (const bf16*)(a.ws + WS_U); const bf16* Y = (const bf16*)(a.ws + WS_Y); bf16* MIXIN = (bf16*)(a.ws + WS_MIXIN);
    const int gw = blockIdx.x * NWAVES + wave, NGW = gridDim.x * NWAVES, c0 = lane * 8;
    float lg[8], lb[8];
#pragma unroll
    for (int e = 0; e < 8; ++e) { lg[e] = a.in[I_LNG][l * 512 + c0 + e]; lb[e] = a.in[I_LNB][l * 512 + c0 + e]; }
    for (int row = gw; row < nrows; row += NGW) {
        const v4u yq = *(const v4u*)(Y + (size_t)row * 512 + c0); const v4u gq = *(const v4u*)(U + (size_t)row * NIN + 2048 + c0);
        float y[8] = {bflo(yq.x), bfhi(yq.x), bflo(yq.y), bfhi(yq.y), bflo(yq.z), bfhi(yq.z), bflo(yq.w), bfhi(yq.w)};
        const float gt[8] = {bflo(gq.x), bfhi(gq.x), bflo(gq.y), bfhi(gq.y), bflo(gq.z), bfhi(gq.z), bflo(gq.w), bfhi(gq.w)};
        float s = 0.f;
#pragma unroll
        for (int e = 0; e < 8; ++e) s += y[e];
        const float mean = wave_sum(s) * (1.0f / 512.0f); float q = 0.f;
#pragma unroll
        for (int e = 0; e < 8; ++e) { y[e] -= mean; q += y[e] * y[e]; }
        const float rstd = rsqrtf(wave_sum(q) * (1.0f / 512.0f) + EPSF);
        float o[8];
#pragma unroll
        for (int e = 0; e < 8; ++e) o[e] = siluf_(y[e] * rstd * lg[e] + lb[e]) * gt[e];
        v4u w; w.x = pk2(o[0], o[1]); w.y = pk2(o[2], o[3]); w.z = pk2(o[4], o[5]); w.w = pk2(o[6], o[7]);
        *(v4u*)(MIXIN + (size_t)row * 1024 + 512 + c0) = w;
    }
}

constexpr int RG_GW = 0, RG_FOLD = 32768, RG_F8 = 36864, RG_CAR = 40960, RG_WAVE = 57344, RG_WAVE_BYTES = 12544;
constexpr int NP16 = 4 * NPJ;
__device__ __forceinline__ float fsig(float x) { return __builtin_amdgcn_rcpf(1.0f + __expf(-x)); }

template <bool FINAL, int D>
__device__ __forceinline__ void rg_sweep(const Args& a, LAS unsigned char* lds, LAS unsigned char* wl, int l, int b, int h, int r0, int seg_lo, int seg_hi, int pj, bool is_ctx, int w, int lane) {
    const bf16* U = (const bf16*)(a.ws + WS_U); bf16* MIXIN = (bf16*)(a.ws + WS_MIXIN);
    float* AGGA = (float*)(a.ws + WS_AGGA); float* AGGB = (float*)(a.ws + WS_AGGB); float* A16 = (float*)(a.ws + WS_A16); float* B16 = (float*)(a.ws + WS_B16);
    LAS float* VCW = (LAS float*)wl; LAS unsigned* HBW = (LAS unsigned*)(wl + 4352);
    const LAS v4u* GWL = (const LAS v4u*)(lds + RG_GW) + (D * 2) * 8 * 64 + lane;
    const LAS float* CAR = (const LAS float*)(lds + RG_CAR);
    const int fr = lane & 15, fq = lane >> 4, cp = lane & 31, rh = lane >> 5;
    float2 cw[4];
#pragma unroll
    for (int k = 0; k < 4; ++k) cw[k] = *(const float2*)(a.in[I_CAW] + (size_t)((l * 2 + D) * 4 + k) * 512 + 64 * h + 2 * cp);
    const float2 cbv = *(const float2*)(a.in[I_CAB] + (l * 2 + D) * 512 + 64 * h + 2 * cp);
    float brv[4], biv[4], sp8[4], Hc[4], Ac[4];
    const int p16own = 4 * pj + (D ? 3 - fq : fq);
#pragma unroll
    for (int ct = 0; ct < 4; ++ct) { const int c = 16 * ct + fr, pidx = (l * 2 + D) * 512 + 64 * h + c;
        brv[ct] = a.in[I_BR][pidx]; biv[ct] = a.in[I_BI][pidx]; sp8[ct] = ((const float*)(a.ws + WS_SP8))[pidx];
        Hc[ct] = 0.f; Ac[ct] = 1.f;
        if (FINAL) {
            if (is_ctx) { const size_t base = (size_t)((b * 2 + D) * NP16) * 512 + 64 * h + c; float S = 0.f;
                for (int i = 0; i < p16own; ++i) S = A16[base + (size_t)i * 512] * S + B16[base + (size_t)i * 512];
                Hc[ct] = S; }
            else Hc[ct] = CAR[(D * 32 + (D ? 31 - (4 * w + fq) : 4 * w + fq)) * 64 + c];
        } }
    const bf16* ub = U + 64 * h + 2 * cp;
    unsigned Wd[2][7], nx[2][4];
#pragma unroll
    for (int q = 0; q < 2; ++q) { const int g = 2 * rh + q;
#pragma unroll
        for (int j = 0; j < 3; ++j) { const int row = r0 + 16 * g + (D ? 16 + j : j - 3); const bool ok = row >= seg_lo && row < seg_hi; const int rc = ok ? row : r0;
            const unsigned v = *(const unsigned*)(ub + (size_t)rc * NIN); Wd[q][D ? j : 4 + j] = ok ? v : 0u; }
#pragma unroll
        for (int j = 0; j < 4; ++j) nx[q][j] = *(const unsigned*)(ub + (size_t)(r0 + 16 * g + 4 * (D ? 3 : 0) + j) * NIN); }
#pragma unroll 1
    for (int ti = 0; ti < 4; ++ti) {
        const int tile = D ? 3 - ti : ti;
        int zo = 0; asm volatile("" : "+v"(zo));
        const LAS v4u* GWLt = GWL + zo;
        v4u g0 = {0u, 0u, 0u, 0u}, g1 = g0; size_t orow = 0;
        if (FINAL && D == 0) { orow = (size_t)(r0 + 16 * (fr >> 2) + 4 * tile + (fr & 3)); const bf16* gp = U + orow * NIN + 512 + 64 * h + 16 * fq; g0 = *(const v4u*)gp; g1 = *(const v4u*)(gp + 8); }
#pragma unroll
        for (int q = 0; q < 2; ++q) {
            if (D == 0) { Wd[q][0] = Wd[q][4]; Wd[q][1] = Wd[q][5]; Wd[q][2] = Wd[q][6]; Wd[q][3] = nx[q][0]; Wd[q][4] = nx[q][1]; Wd[q][5] = nx[q][2]; Wd[q][6] = nx[q][3]; }
            else { Wd[q][4] = Wd[q][0]; Wd[q][5] = Wd[q][1]; Wd[q][6] = Wd[q][2]; Wd[q][0] = nx[q][0]; Wd[q][1] = nx[q][1]; Wd[q][2] = nx[q][2]; Wd[q][3] = nx[q][3]; } }
        if (ti < 3) { const int tn = D ? 2 - ti : ti + 1;
#pragma unroll
            for (int q = 0; q < 2; ++q)
#pragma unroll
                for (int j = 0; j < 4; ++j) nx[q][j] = *(const unsigned*)(ub + (size_t)(r0 + 16 * (2 * rh + q) + 4 * tn + j) * NIN); }
#pragma unroll
        for (int q = 0; q < 2; ++q)
#pragma unroll
            for (int jj = 0; jj < 4; ++jj) { float v0 = cbv.x, v1 = cbv.y;
#pragma unroll
                for (int k = 0; k < 4; ++k) { const unsigned u = Wd[q][jj + k]; v0 += cw[k].x * bflo(u); v1 += cw[k].y * bfhi(u); }
                *(LAS f32x2v*)(VCW + (4 * (2 * rh + q) + jj) * 68 + 2 * cp) = (f32x2v){v0, v1}; }
        bf16x8 af[2];
#pragma unroll
        for (int kk = 0; kk < 2; ++kk) { const LAS float* vp = VCW + fr * 68 + 32 * kk + 8 * fq; const f32x4 x0 = *(const LAS f32x4*)vp, x1 = *(const LAS f32x4*)(vp + 4);
            v4u pk; pk.x = cvtpk(x0.x, x0.y); pk.y = cvtpk(x0.z, x0.w); pk.z = cvtpk(x1.x, x1.y); pk.w = cvtpk(x1.z, x1.w); af[kk] = __builtin_bit_cast(bf16x8, pk); }
        float vcv[4][4];
#pragma unroll
        for (int ct = 0; ct < 4; ++ct)
#pragma unroll
            for (int jj = 0; jj < 4; ++jj) vcv[ct][jj] = VCW[(4 * fq + jj) * 68 + 16 * ct + fr];
        f32x4 accr[4], acci[4];
#pragma unroll
        for (int ct = 0; ct < 4; ++ct) { accr[ct] = (f32x4){0.f, 0.f, 0.f, 0.f}; acci[ct] = accr[ct];
#pragma unroll
            for (int kk = 0; kk < 2; ++kk) { const bf16x8 br = __builtin_bit_cast(bf16x8, GWLt[(ct * 2 + kk) * 64]), bi = __builtin_bit_cast(bf16x8, GWLt[(8 + ct * 2 + kk) * 64]);
                accr[ct] = __builtin_amdgcn_mfma_f32_16x16x32_bf16(af[kk], br, accr[ct], 0, 0, 0); acci[ct] = __builtin_amdgcn_mfma_f32_16x16x32_bf16(af[kk], bi, acci[ct], 0, 0, 0); } }
        float hsum[4][4];
#pragma unroll
        for (int ct = 0; ct < 4; ++ct) { float aa[4], bb[4];
            const float nbr = -1.44269504f * brv[ct], nbi = -1.44269504f * biv[ct];
#pragma unroll
            for (int p = 0; p < 2; ++p) {
                f32x2v xr = (f32x2v){accr[ct][2 * p], accr[ct][2 * p + 1]} * -1.44269504f + nbr, xi = (f32x2v){acci[ct][2 * p], acci[ct][2 * p + 1]} * -1.44269504f + nbi;
                xr = __builtin_elementwise_min(xr, (f32x2v){60.f, 60.f}); xi = __builtin_elementwise_min(xi, (f32x2v){60.f, 60.f});
                f32x2v d1, d2; d1.x = __builtin_amdgcn_exp2f(xr.x); d1.y = __builtin_amdgcn_exp2f(xr.y); d2.x = __builtin_amdgcn_exp2f(xi.x); d2.y = __builtin_amdgcn_exp2f(xi.y);
                d1 = d1 + 1.0f; d2 = d2 + 1.0f; const f32x2v m = d1 * d2; f32x2v inv; inv.x = __builtin_amdgcn_rcpf(m.x); inv.y = __builtin_amdgcn_rcpf(m.y);
                const f32x2v r = d2 * inv, ig = d1 * inv, la = r * sp8[ct], x2 = la + la, le = la * 1.44269504f;
                const f32x2v pom = -x2 * (x2 * (x2 * (x2 * (x2 * 0.0083333338f + 0.041666668f) + 0.16666667f) + 0.5f) + 1.0f);
                f32x2v av; av.x = __builtin_amdgcn_exp2f(le.x); av.y = __builtin_amdgcn_exp2f(le.y);
                const f32x2v o2 = 1.0f - av * av; f32x2v om; om.x = x2.x > -0.25f ? pom.x : o2.x; om.y = x2.y > -0.25f ? pom.y : o2.y;
                om = __builtin_elementwise_max(om, (f32x2v){0.f, 0.f});
                f32x2v sq; sq.x = __builtin_amdgcn_sqrtf(om.x); sq.y = __builtin_amdgcn_sqrtf(om.y);
                const f32x2v bv = sq * (ig * (f32x2v){vcv[ct][2 * p], vcv[ct][2 * p + 1]});
                aa[2 * p] = av.x; aa[2 * p + 1] = av.y; bb[2 * p] = bv.x; bb[2 * p + 1] = bv.y; }
            float hh = Hc[ct], A4 = 1.f;
#pragma unroll
            for (int ji = 0; ji < 4; ++ji) { const int jj = D ? 3 - ji : ji; hh = aa[jj] * hh + bb[jj]; A4 *= aa[jj]; hsum[ct][jj] = hh; }
            Hc[ct] = hh; if (!FINAL) Ac[ct] *= A4; }
        if (FINAL) {
            if (D == 1) {
#pragma unroll
                for (int ct = 0; ct < 4; ++ct)
#pragma unroll
                    for (int jp = 0; jp < 2; ++jp) HBW[(tile * 8 + ct * 2 + jp) * 64 + lane] = cvtpk(hsum[ct][2 * jp], hsum[ct][2 * jp + 1]);
            } else {
#pragma unroll
                for (int ct = 0; ct < 4; ++ct)
#pragma unroll
                    for (int jp = 0; jp < 2; ++jp) { const unsigned hb = HBW[(tile * 8 + ct * 2 + jp) * 64 + lane];
                        VCW[(4 * fq + 2 * jp) * 68 + 16 * ct + fr] = hsum[ct][2 * jp] + bflo(hb); VCW[(4 * fq + 2 * jp + 1) * 68 + 16 * ct + fr] = hsum[ct][2 * jp + 1] + bfhi(hb); }
                const size_t row = orow;
                const f32x4 s0 = *(const LAS f32x4*)(VCW + fr * 68 + 16 * fq), s1 = *(const LAS f32x4*)(VCW + fr * 68 + 16 * fq + 4), s2 = *(const LAS f32x4*)(VCW + fr * 68 + 16 * fq + 8), s3 = *(const LAS f32x4*)(VCW + fr * 68 + 16 * fq + 12);
                v4u o0, o1;
                o0.x = cvtpk(s0.x * bflo(g0.x), s0.y * bfhi(g0.x)); o0.y = cvtpk(s0.z * bflo(g0.y), s0.w * bfhi(g0.y)); o0.z = cvtpk(s1.x * bflo(g0.z), s1.y * bfhi(g0.z)); o0.w = cvtpk(s1.z * bflo(g0.w), s1.w * bfhi(g0.w));
                o1.x = cvtpk(s2.x * bflo(g1.x), s2.y * bfhi(g1.x)); o1.y = cvtpk(s2.z * bflo(g1.y), s2.w * bfhi(g1.y)); o1.z = cvtpk(s3.x * bflo(g1.z), s3.y * bfhi(g1.z)); o1.w = cvtpk(s3.z * bflo(g1.w), s3.w * bfhi(g1.w));
                bf16* op = MIXIN + row * 1024 + 64 * h + 16 * fq; *(v4u*)op = o0; *(v4u*)(op + 8) = o1;
            }
        }
    }
    if (!FINAL) {
#pragma unroll
        for (int ct = 0; ct < 4; ++ct) { const int c = 16 * ct + fr;
            const size_t i16 = (size_t)((b * 2 + D) * NP16 + p16own) * 512 + 64 * h + c; A16[i16] = Ac[ct]; B16[i16] = Hc[ct];
            float Ag[4], Bg[4];
#pragma unroll
            for (int g = 0; g < 4; ++g) { Ag[g] = __shfl(Ac[ct], fr + 16 * g); Bg[g] = __shfl(Hc[ct], fr + 16 * g); }
            float run = 0.f;
#pragma unroll
            for (int gi = 0; gi < 4; ++gi) { const int g = D ? 3 - gi : gi; run = Ag[g] * run + Bg[g]; }
            if (fq == 0) { const size_t idx = (size_t)((b * 2 + D) * NPJ + pj) * 512 + 64 * h + c; AGGA[idx] = (Ag[0] * Ag[1]) * (Ag[2] * Ag[3]); AGGB[idx] = run; } }
    }
}

template <bool FINAL>
__device__ __forceinline__ void rg_run(const Args& a, LAS unsigned char* lds, int l, int rn, int tid, int lane, int wave) {
    const bool is_ctx = rn >= 256; const int bh = is_ctx ? rn - 256 : rn >> 4, b = bh >> 3, h = bh & 7, cgp = is_ctx ? 0 : (rn & 15);
    { const v4u* GWF = (const v4u*)(a.ws + WS_GWF); LAS v4u* GWL = (LAS v4u*)(lds + RG_GW);
#pragma unroll
      for (int i = tid; i < 2048; i += NTHR) { const int d = i >> 10, g = (i >> 9) & 1, rest = i & 511; GWL[i] = GWF[(size_t)((((l * 2 + d) * 2 + g) * 8 + h) * 8) * 64 + rest]; } }
    const int P0f = 4 + 8 * cgp, P0b = 124 - 8 * cgp;
    if (FINAL && !is_ctx) {
        const float* AGGA = (const float*)(a.ws + WS_AGGA); const float* AGGB = (const float*)(a.ws + WS_AGGB); const float* A16 = (const float*)(a.ws + WS_A16); const float* B16 = (const float*)(a.ws + WS_B16);
        const int d = tid >> 8, s = (tid >> 6) & 3, c = tid & 63, P0 = d ? P0b : P0f, lo = (P0 * s) >> 2, hi = (P0 * (s + 1)) >> 2;
        const size_t b16 = (size_t)((b * 2 + d) * NP16 + 4 * P0 + 8 * s) * 512 + 64 * h + c; float ai8[8], bi8[8];
#pragma unroll
        for (int i = 0; i < 8; ++i) { ai8[i] = A16[b16 + (size_t)i * 512]; bi8[i] = B16[b16 + (size_t)i * 512]; }
        const size_t base = (size_t)((b * 2 + d) * NPJ) * 512 + 64 * h + c; float A = 1.f, Bv = 0.f;
#pragma unroll 8
        for (int i = lo; i < hi; ++i) { const float ai = AGGA[base + (size_t)i * 512], bi = AGGB[base + (size_t)i * 512]; Bv = ai * Bv + bi; A *= ai; }
        LAS float* FO = (LAS float*)(lds + RG_FOLD); LAS float* F8 = (LAS float*)(lds + RG_F8); LAS float* CAR = (LAS float*)(lds + RG_CAR);
        FO[((d * 4 + s) * 64 + c) * 2] = A; FO[((d * 4 + s) * 64 + c) * 2 + 1] = Bv;
        float A8 = 1.f, B8 = 0.f;
#pragma unroll
        for (int i = 0; i < 8; ++i) { B8 = ai8[i] * B8 + bi8[i]; A8 *= ai8[i]; }
        F8[((d * 4 + s) * 64 + c) * 2] = A8; F8[((d * 4 + s) * 64 + c) * 2 + 1] = B8;
        __syncthreads();
        float S = 0.f;
#pragma unroll
        for (int s2 = 0; s2 < 4; ++s2) S = FO[((d * 4 + s2) * 64 + c) * 2] * S + FO[((d * 4 + s2) * 64 + c) * 2 + 1];
#pragma unroll
        for (int s2 = 0; s2 < 3; ++s2) if (s2 < s) S = F8[((d * 4 + s2) * 64 + c) * 2] * S + F8[((d * 4 + s2) * 64 + c) * 2 + 1];
#pragma unroll
        for (int i = 0; i < 8; ++i) { CAR[(d * 32 + 8 * s + i) * 64 + c] = S; S = ai8[i] * S + bi8[i]; }
    }
    __syncthreads();
    if (wave < (is_ctx ? 4 : 8)) {
        const int j = is_ctx ? wave : 8 * cgp + wave;
        const int seg_lo = is_ctx ? MLAT + b * CTXL : b * SEQ, seg_hi = seg_lo + (is_ctx ? CTXL : SEQ), r0 = seg_lo + 64 * j;
        const int pjf = is_ctx ? j : 4 + j, pjb = is_ctx ? 3 - j : 131 - j;
        LAS unsigned char* wl = lds + RG_WAVE + wave * RG_WAVE_BYTES;
        rg_sweep<FINAL, 1>(a, lds, wl, l, b, h, r0, seg_lo, seg_hi, pjb, is_ctx, wave, lane);
        rg_sweep<FINAL, 0>(a, lds, wl, l, b, h, r0, seg_lo, seg_hi, pjf, is_ctx, wave, lane);
    }
    __syncthreads();
}

#define RLX_AGENT __ATOMIC_RELAXED, __HIP_MEMORY_SCOPE_AGENT


#define XB_TMO      128
#define XB_XCNT(j)  (256  + 64 * (j))
#define XB_XSUB(j)  (1280 + 64 * (j))
#define XB_XGEN(j)  (2304 + 64 * (j))
#define XB_TOP      3328
#define XB_TOPGEN   3392
#define XCD_BAR_WORDS 3456
#define XB_SPIN_CAP (1u << 18)

__device__ __forceinline__ unsigned xb_ld(unsigned* p)              { return __hip_atomic_load(p, __ATOMIC_RELAXED, __HIP_MEMORY_SCOPE_AGENT); }
__device__ __forceinline__ unsigned xb_add(unsigned* p, unsigned v) { return __hip_atomic_fetch_add(p, v, __ATOMIC_RELAXED, __HIP_MEMORY_SCOPE_AGENT); }
__device__ __forceinline__ unsigned xb_xcc_id() { return (unsigned)__builtin_amdgcn_s_getreg((3 << 11) | 20) & 0xFu; }
#define XB_SPIN(cond, bar) do { unsigned _sp = 0; while (cond) { __builtin_amdgcn_s_sleep(1); \
    if ((++_sp & 255u) == 0u) { if (xb_ld(&(bar)[XB_TMO])) break; if (_sp > XB_SPIN_CAP) { atomicAdd(&(bar)[XB_TMO], 1u); break; } } } } while (0)

struct XcdBarrier {
    unsigned* bar; unsigned x;
    volatile LAS unsigned* st;
};

__device__ __forceinline__ XcdBarrier xcd_barrier_post(unsigned* bar, volatile LAS unsigned* st) {
    XcdBarrier b; b.bar = bar; b.x = xb_xcc_id(); b.st = st;
    if (threadIdx.x == 0) (void)xb_add(&bar[XB_XCNT(b.x)], 1u);
    return b;
}
__device__ __forceinline__ void xcd_barrier_complete(unsigned* bar, unsigned x, unsigned& nloc, unsigned& nx) {
    const unsigned G = gridDim.x * gridDim.y * gridDim.z;
    unsigned sum, cnt, mine, sp = 0u;
    for (;;) {
        sum = 0u; cnt = 0u; mine = 0u;
#pragma unroll
        for (unsigned j = 0; j < 16; ++j) { const unsigned c = xb_ld(&bar[XB_XCNT(j)]); sum += c; cnt += (c > 0u) ? 1u : 0u; mine = (j == x) ? c : mine; }
        if (sum == G) break;
        __builtin_amdgcn_s_sleep(1);
        if ((++sp & 255u) == 0u) { if (xb_ld(&bar[XB_TMO])) break; if (sp > XB_SPIN_CAP) { atomicAdd(&bar[XB_TMO], 1u); break; } }
    }
    nloc = mine > 0u ? mine : 1u; nx = cnt > 0u ? cnt : 1u;
}

__device__ __forceinline__ void xcd_barrier(const XcdBarrier& b) {
    asm volatile("s_waitcnt vmcnt(0)" ::: "memory");
    __syncthreads();
    if (threadIdx.x == 0) {
        unsigned* bar = b.bar;
        __builtin_amdgcn_s_waitcnt(0);
        unsigned nloc = b.st[0], nx = b.st[1];
        if (nloc == 0u) { xcd_barrier_complete(bar, b.x, nloc, nx); b.st[0] = nloc; b.st[1] = nx; }
        const unsigned old = xb_add(&bar[XB_XSUB(b.x)], 1u);
        const unsigned gen = old / nloc;
        if (old + 1u == (gen + 1u) * nloc) {
            __builtin_amdgcn_fence(__ATOMIC_RELEASE, "agent");
            asm volatile("s_waitcnt vmcnt(0)" ::: "memory");
            const unsigned og = xb_add(&bar[XB_TOP], 1u);
            const unsigned tg = og / nx;
            if (og + 1u == (tg + 1u) * nx) xb_add(&bar[XB_TOPGEN], 1u);
            else XB_SPIN(xb_ld(&bar[XB_TOPGEN]) == tg, bar);
            __builtin_amdgcn_fence(__ATOMIC_ACQUIRE, "agent");
            xb_add(&bar[XB_XGEN(b.x)], 1u);
            asm volatile("s_waitcnt vmcnt(0)" ::: "memory");
        } else {
            XB_SPIN(xb_ld(&bar[XB_XGEN(b.x)]) == gen, bar);
            __builtin_amdgcn_fence(__ATOMIC_ACQUIRE, "agent");
            asm volatile("s_waitcnt vmcnt(0)" ::: "memory");
        }
    }
    __syncthreads();
}

__device__ __forceinline__ void layer_phases(int l, const Args& args, LAS unsigned char* lds, const int tid0, const int lo, const int hi, const XcdBarrier& xbar) {
    const int G = gridDim.x; unsigned char* ws = args.ws;
    const int pb = 1 + 5 * l;
#define LAUNDER() int tid = tid0; asm volatile("" : "+v"(tid)); const int lane = tid & 63, wave = __builtin_amdgcn_readfirstlane(tid >> 6); int bx = blockIdx.x; asm volatile("" : "+s"(bx)); (void)lane; (void)wave; (void)bx
#define IN(k) (lo <= (k) && (k) < hi)
#define SEAM(k) do { if (IN(k) && IN((k) + 1)) { xcd_barrier(xbar); } } while (0)
        if (IN(pb)) { LAUNDER(); norm_phase(args, l, lane, wave); }
        SEAM(pb);
        if (IN(pb + 1)) { LAUNDER();
            pg8::Gemm g{(const pg8::bf16_t*)(ws + WS_H), (const pg8::bf16_t*)(ws + WS_BT1) + (size_t)l * NIN * 1024, MROWS, NIN, 1024};
            pg8::StaticOrder S; S.init(MROWS, NIN, G, bx);
            pg8::EpiU E{(pg8::bf16_t*)(ws + WS_U)};
            pg8::gemm_phase<pg8::EpiU, pg8::StaticOrder, true, true>(lds, g, S, E);
        }
        SEAM(pb + 1);
        if (IN(pb + 2)) { LAUNDER();
            const int nrun = (bx >= G - 16) ? 2 : 1;
#pragma unroll 1
            for (int k = 0; k < nrun; ++k) rg_run<false>(args, lds, l, k == 0 ? bx : 256 + (G - 1 - bx), tid, lane, wave);
            const int n_h = 256 + (l == 0 ? 16 : 0), n_conv = 128 + n_h;
            const int GC = G - 16;
            for (int un = bx; un < n_conv && bx < GC; un += GC) {
                if (un < 128) { vconv_unit(args, lds, l, un >> 6, un & 63, tid); }
                else { const int hu = un - 128;
                    if (hu < 256) hconv_unit(args, lds, l, hu * 64, 0, hu * 64, hu * 64 + 64, tid);
                    else { const int cu = hu - 256, cc = cu >> 1, g = cu & 1, bb = cc >> 2; hconv_unit(args, lds, l, MLAT + cc * 64, g, MLAT + bb * CTXL, MLAT + bb * CTXL + CTXL, tid); } }
            }
        }
        SEAM(pb + 2);
        if (IN(pb + 3)) { LAUNDER();
            const int nrun = (l == 0 && bx >= G - 16) ? 2 : 1;
#pragma unroll 1
            for (int k = 0; k < nrun; ++k) rg_run<true>(args, lds, l, k == 0 ? bx : 256 + (G - 1 - bx), tid, lane, wave);
            ln_rows(args, l, (l == 0) ? MROWS : MLAT, lane, wave);
        }
        SEAM(pb + 3);
        if (IN(pb + 4)) { LAUNDER();
            const int M2 = (l == 0) ? MROWS : MLAT;
            pg8::Gemm g{(const pg8::bf16_t*)(ws + WS_MIXIN), (const pg8::bf16_t*)(ws + WS_BT2) + (size_t)l * 1024 * 1024, M2, 1024, 1024};
            pg8::StaticOrder S; S.init(M2, 1024, G, bx);
            pg8::EpiMix E{(pg8::bf16_t*)(ws + WS_MIX), (float*)(ws + WS_SSQ)};
            pg8::gemm_phase<pg8::EpiMix, pg8::StaticOrder, true, true>(lds, g, S, E);
        }
        SEAM(pb + 4);
#undef IN
#undef SEAM
#undef LAUNDER
}

__global__ void __launch_bounds__(NTHR, 2) fwd_megakernel(Args args) {
    extern __shared__ __attribute__((aligned(16))) unsigned char lds_raw[];
    LAS unsigned char* lds = (LAS unsigned char*)lds_raw;
    const int tid = threadIdx.x, lane = tid & 63, wave = __builtin_amdgcn_readfirstlane(tid >> 6);
    const int G = gridDim.x, bx = blockIdx.x;
    unsigned char* ws = args.ws;
    const int lo = args.ph_lo, hi = args.ph_hi;
    if (args.coop == 2) cg::this_grid().sync();
    volatile LAS unsigned* MISC = (volatile LAS unsigned*)(lds + MISC_OFF);
    if (tid < 64) MISC[tid] = 0u;
    __syncthreads();
    XcdBarrier xbar; xbar.bar = (unsigned*)(ws + WS_CTL); xbar.x = 0; xbar.st = nullptr;
    if (args.coop == 1) xbar = xcd_barrier_post((unsigned*)(ws + WS_CTL), MISC + 8);
#define IN(k) (lo <= (k) && (k) < hi)
#define SEAM(k) do { if (IN(k) && IN((k) + 1)) { xcd_barrier(xbar); } } while (0)

    if (IN(0)) { p0_prologue(args, lds, tid, lane, wave); }
    SEAM(0);
#pragma unroll 1
    for (int l = 0; l < 2; ++l) { int lo_ = l; asm volatile("" : "+s"(lo_)); layer_phases(lo_, args, lds, tid, lo, hi, xbar); }
    if (IN(11)) { norm_phase(args, 2, lane, wave); }
#undef IN
#undef SEAM
}

#ifndef MK_PER_PHASE
#define MK_PER_PHASE 0
#endif
extern "C" void kernel_launch(void* const* d_in, const int* in_sizes, int n_in, void* d_out, int out_size, void* d_ws, size_t ws_size, hipStream_t stream) {
    static int grid = 0;
    if (grid == 0) {
        if (n_in != 21 || out_size != MLAT * DM || ws_size < WS_END) { fprintf(stderr, "kernel_launch: unexpected shapes (n_in %d, out %d, ws %zu)\n", n_in, out_size, ws_size); grid = -1; return; }
        int dev = 0, cus = 0, per_cu = 0;
        if (hipGetDevice(&dev) != hipSuccess || hipDeviceGetAttribute(&cus, hipDeviceAttributeMultiprocessorCount, dev) != hipSuccess) { grid = -1; return; }
        if (hipFuncSetAttribute((const void*)fwd_megakernel, hipFuncAttributeMaxDynamicSharedMemorySize, LDS_BYTES) != hipSuccess) { fprintf(stderr, "kernel_launch: hipFuncSetAttribute failed\n"); grid = -1; return; }
        if (hipOccupancyMaxActiveBlocksPerMultiprocessor(&per_cu, (const void*)fwd_megakernel, NTHR, LDS_BYTES) != hipSuccess || per_cu < 1) { fprintf(stderr, "kernel_launch: occupancy query says %d\n", per_cu); per_cu = 1; }
        (void)hipGetLastError();
        grid = cus;
    }
    if (grid < 0) return;
    if (hipMemsetAsync((char*)d_ws + WS_CTL, 0, CTL_ZERO_BYTES, stream) != hipSuccess) { fprintf(stderr, "kernel_launch: memset failed\n"); return; }
    Args a{};
    for (int i = 0; i < 21; ++i) a.in[i] = (const float*)d_in[i];
    a.out = (float*)d_out; a.ws = (unsigned char*)d_ws;
#if MK_PER_PHASE
    for (int ph = 0; ph < 12; ++ph) { a.ph_lo = ph; a.ph_hi = ph + 1; a.coop = 0;
        hipLaunchKernelGGL(fwd_megakernel, dim3(grid), dim3(NTHR), LDS_BYTES, stream, a); }
#else
    a.ph_lo = 0; a.ph_hi = 12; a.coop = 1;
    void* kargs[] = {&a};
    hipError_t e = hipLaunchCooperativeKernel((const void*)fwd_megakernel, dim3(grid), dim3(NTHR), kargs, LDS_BYTES, stream);
    if (e != hipSuccess) fprintf(stderr, "cooperative launch failed: %s (grid %d)\n", hipGetErrorString(e), grid);
#endif
}
```

```cpp
#include <hip/hip_runtime.h>
#include <hip/hip_cooperative_groups.h>
#include <cstdio>
#include <cstdint>
namespace cg = cooperative_groups;
#define MK_PER_PHASE 0
namespace pg8 {
#define PG8_LAS __attribute__((address_space(3)))
typedef unsigned short bf16_t;
typedef short bf16x8 __attribute__((ext_vector_type(8)));
typedef float f32x4 __attribute__((ext_vector_type(4)));
typedef unsigned u32x4 __attribute__((ext_vector_type(4)));
constexpr int BM = 256, BK = 64, HALF = 128, HTB = HALF * BK * 2  , STAGE_BYTES = 8 * HTB, NXCD = 8, WGM = 8;

__host__ __device__ __forceinline__ int lds_byte(int r, int c) { const int st = (r >> 4) * 2 + (c >> 5), rr = r & 15, cc = c & 31, ob = rr * 64 + cc * 2; return st * 1024 + (ob ^ (((ob >> 9) & 1) << 5)); }
__host__ __device__ __forceinline__ void stage_rc(int b, int& R, int& C) { const int st = b / 1024, sb = b % 1024, swz = sb ^ (((sb >> 9) & 1) << 5); R = (st >> 1) * 16 + swz / 64; C = (st & 1) * 32 + (swz % 64) / 2; }
__host__ __device__ __forceinline__ int perm32(int rho) { const int n = rho >> 4, i = rho & 15; return 8 * (i >> 2) + 4 * n + (i & 3); }

struct Unit { int pm, pn; };
struct Gemm { const bf16_t* A; const bf16_t* Bt; int M, N, K; };

struct StaticOrder {
    int nM, nN, nwg, G, c;
    __host__ __device__ void init(int M, int N, int G_, int c_) { nM = M / BM; nN = N / BM; nwg = nM * nN; G = G_; c = c_; }
    __host__ __device__ bool next(int i, Unit& u) const {
        const long L = (long)i * G + c; if (L >= nwg) return false;
        int wgid = (int)L; { const int q = nwg / NXCD, r = nwg % NXCD, xcd = wgid % NXCD, off = wgid / NXCD; wgid = (xcd < r ? xcd * (q + 1) : r * (q + 1) + (xcd - r) * q) + off; }
        const int nig = WGM * nN, gid = wgid / nig, fm = gid * WGM, gsz = (nM - fm) < WGM ? (nM - fm) : WGM;
        u.pm = fm + ((wgid % nig) % gsz); u.pn = (wgid % nig) / gsz; return true;
    }
    __device__ __forceinline__ void a_ready(const Unit&) const {}
    __device__ __forceinline__ void done(const Unit&) const {}
};
__device__ __forceinline__ unsigned cvt_pk_bf16(float lo, float hi) { unsigned r; asm volatile("v_cvt_pk_bf16_f32 %0, %1, %2" : "=v"(r) : "v"(lo), "v"(hi)); return r; }
typedef float f32x2 __attribute__((ext_vector_type(2)));
template <class Epi, class Sched, bool ALIGN_EPI = false, bool SP2 = false>
__device__ __forceinline__ void gemm_phase(PG8_LAS unsigned char* lds, const Gemm g, const Sched& S, const Epi& E) {
    const int tid = threadIdx.x, wid = __builtin_amdgcn_readfirstlane(tid >> 6), lane = tid & 63, wr = wid >> 2, wc = wid & 3, fr = lane & 15, fq = lane >> 4;
    const int K = g.K, nt = K / BK;
    unsigned voffA[2], voffB[2];
#pragma unroll
    for (int i = 0; i < 2; ++i) { int R, C; stage_rc(tid * 16 + i * 8192, R, C); const int Rb = Epi::PERM ? ((R & ~31) + perm32(R & 31)) : R;
        voffA[i] = (unsigned)(R * K + C) * 2u; voffB[i] = (unsigned)(Rb * K + C) * 2u; }
    const size_t kstep = (size_t)(BK * 2);
    const size_t hstep = (size_t)HALF * K * 2;
    const size_t tstep = 2 * hstep;
    const unsigned ldsw = (unsigned)wid * 1024u;
    const int aoff = lds_byte(wr * 64 + fr, fq * 8), boff = lds_byte(wc * 32 + fr, fq * 8);
#define PG8_SA(b, h) (((b) * 2 + (h)) * HTB)
#define PG8_SB(b, h) ((4 + (b) * 2 + (h)) * HTB)
#define PG8_STAGE(bufoff, gbase, voff) do { _Pragma("unroll") for (int _i = 0; _i < 2; ++_i) \
        __builtin_amdgcn_global_load_lds((const unsigned*)((const char*)(gbase) + (voff)[_i]), (PG8_LAS unsigned*)(lds + (bufoff) + ldsw + _i * 8192), 16, 0, 0); } while (0)
#define PG8_LDA(dst, b, h) do { _Pragma("unroll") for (int m = 0; m < 4; ++m) _Pragma("unroll") for (int k = 0; k < 2; ++k) dst[m][k] = *(const PG8_LAS bf16x8*)(lds + PG8_SA(b, h) + aoff + m * 2048 + k * 1024); } while (0)
#define PG8_LDB(dst, b, h) do { _Pragma("unroll") for (int n = 0; n < 2; ++n) _Pragma("unroll") for (int k = 0; k < 2; ++k) dst[n][k] = *(const PG8_LAS bf16x8*)(lds + PG8_SB(b, h) + boff + n * 2048 + k * 1024); } while (0)
#define PG8_MMA(ai, bj, At, Bt) do { __builtin_amdgcn_s_setprio(1); _Pragma("unroll") for (int m = 0; m < 4; ++m) _Pragma("unroll") for (int n = 0; n < 2; ++n) _Pragma("unroll") for (int k = 0; k < 2; ++k) \
        acc[ai][bj][m][n] = __builtin_amdgcn_mfma_f32_16x16x32_bf16(Bt[n][k], At[m][k], acc[ai][bj][m][n], 0, 0, 0); __builtin_amdgcn_s_setprio(0); } while (0)
#define PG8_WAIT_V(n) asm volatile("s_waitcnt vmcnt(" #n ")" ::: "memory")
#define PG8_WAIT_L(n) asm volatile("s_waitcnt lgkmcnt(" #n ")" ::: "memory")
#define PG8_BAR __builtin_amdgcn_s_barrier()
#define PG8_SCHED __builtin_amdgcn_sched_barrier(0)
    Unit cur, nxt; int ui = 0;
    if (!S.next(0, cur)) return;
    f32x4 acc[2][2][4][2];
#pragma unroll
    for (int a = 0; a < 2; ++a)
#pragma unroll
        for (int b = 0; b < 2; ++b)
#pragma unroll
            for (int m = 0; m < 4; ++m)
#pragma unroll
                for (int n = 0; n < 2; ++n) acc[a][b][m][n] = (f32x4){0.f, 0.f, 0.f, 0.f};
    bf16x8 At[4][2], B0[2][2], B1[2][2];
    const char* cA = (const char*)g.A + (size_t)cur.pm * tstep; const char* cB = (const char*)g.Bt + (size_t)cur.pn * tstep;
    S.a_ready(cur);
    if constexpr (SP2) {
        PG8_STAGE(PG8_SB(0, 0), cB, voffB); PG8_STAGE(PG8_SB(0, 1), cB + hstep, voffB); PG8_STAGE(PG8_SA(0, 0), cA, voffA); PG8_STAGE(PG8_SA(0, 1), cA + hstep, voffA);
        if (wr == 1) PG8_BAR;
        PG8_WAIT_V(2); PG8_BAR;
        PG8_STAGE(PG8_SB(1, 0), cB + kstep, voffB); PG8_STAGE(PG8_SA(1, 0), cA + kstep, voffA); PG8_STAGE(PG8_SB(1, 1), cB + hstep + kstep, voffB);
        PG8_WAIT_V(6); PG8_BAR;
    } else {
        PG8_STAGE(PG8_SB(0, 0), cB, voffB); PG8_STAGE(PG8_SA(0, 0), cA, voffA); PG8_STAGE(PG8_SB(0, 1), cB + hstep, voffB); PG8_STAGE(PG8_SA(0, 1), cA + hstep, voffA);
        if (wr == 1) PG8_BAR;
        PG8_WAIT_V(4); PG8_BAR;
        PG8_STAGE(PG8_SB(1, 0), cB + kstep, voffB); PG8_STAGE(PG8_SA(1, 0), cA + kstep, voffA); PG8_STAGE(PG8_SB(1, 1), cB + hstep + kstep, voffB);
        PG8_WAIT_V(6); PG8_BAR;
    }
    for (;;) {
        const bool has_next = S.next(ui + 1, nxt);
        const char* nA = has_next ? (const char*)g.A + (size_t)nxt.pm * tstep : cA; const char* nB = has_next ? (const char*)g.Bt + (size_t)nxt.pn * tstep : cB;
        for (int t = 0; t < nt; t += 2) {
            const bool last = (t == nt - 2);
            const char* a1 = cA + (size_t)(t + 1) * kstep;
            const char* a2 = last ? nA : cA + (size_t)(t + 2) * kstep; const char* b2 = last ? nB : cB + (size_t)(t + 2) * kstep;
            const char* a3 = a2 + kstep; const char* b3 = b2 + kstep;
            if (last && has_next) S.a_ready(nxt);
            if constexpr (SP2) {
            PG8_LDB(B0, 0, 0); PG8_LDB(B1, 0, 1); PG8_SCHED; PG8_LDA(At, 0, 0); PG8_STAGE(PG8_SA(1, 1), a1 + hstep, voffA);
            PG8_WAIT_V(8); PG8_WAIT_L(0); PG8_BAR; PG8_MMA(0, 0, At, B0); PG8_MMA(0, 1, At, B1); PG8_BAR; PG8_SCHED;
            PG8_LDA(At, 0, 1); PG8_STAGE(PG8_SB(0, 0), b2, voffB); PG8_STAGE(PG8_SB(0, 1), b2 + hstep, voffB); PG8_STAGE(PG8_SA(0, 0), a2, voffA);
            PG8_WAIT_V(8); PG8_WAIT_L(0); PG8_BAR; PG8_MMA(1, 0, At, B0); PG8_MMA(1, 1, At, B1); PG8_BAR; PG8_SCHED;
            PG8_LDB(B0, 1, 0); PG8_LDB(B1, 1, 1); PG8_SCHED; PG8_LDA(At, 1, 0); PG8_STAGE(PG8_SA(0, 1), a2 + hstep, voffA);
            PG8_WAIT_V(8); PG8_WAIT_L(0); PG8_BAR; PG8_MMA(0, 0, At, B0); PG8_MMA(0, 1, At, B1); PG8_BAR; PG8_SCHED;
            PG8_LDA(At, 1, 1); PG8_STAGE(PG8_SB(1, 0), b3, voffB); PG8_STAGE(PG8_SB(1, 1), b3 + hstep, voffB); PG8_STAGE(PG8_SA(1, 0), a3, voffA);
            PG8_WAIT_V(8); PG8_WAIT_L(0); PG8_BAR; PG8_MMA(1, 0, At, B0); PG8_MMA(1, 1, At, B1); PG8_BAR; PG8_SCHED;
            } else {
            PG8_LDB(B0, 0, 0); PG8_SCHED; PG8_LDA(At, 0, 0); PG8_STAGE(PG8_SA(1, 1), a1 + hstep, voffA);
            PG8_WAIT_L(8); PG8_BAR; PG8_WAIT_L(0); PG8_MMA(0, 0, At, B0); PG8_BAR; PG8_SCHED;
            PG8_LDB(B1, 0, 1); PG8_STAGE(PG8_SB(0, 0), b2, voffB);
            PG8_BAR; PG8_WAIT_L(0); PG8_MMA(0, 1, At, B1); PG8_BAR;
            PG8_LDA(At, 0, 1); PG8_STAGE(PG8_SA(0, 0), a2, voffA);
            PG8_BAR; PG8_WAIT_L(0); PG8_MMA(1, 0, At, B0); PG8_BAR; PG8_SCHED;
            PG8_STAGE(PG8_SB(0, 1), b2 + hstep, voffB);
            PG8_WAIT_V(6); PG8_BAR; PG8_MMA(1, 1, At, B1); PG8_BAR;
            PG8_LDB(B0, 1, 0); PG8_SCHED; PG8_LDA(At, 1, 0); PG8_STAGE(PG8_SA(0, 1), a2 + hstep, voffA);
            PG8_WAIT_L(8); PG8_BAR; PG8_WAIT_L(0); PG8_MMA(0, 0, At, B0); PG8_BAR; PG8_SCHED;
            PG8_LDB(B1, 1, 1); PG8_STAGE(PG8_SB(1, 0), b3, voffB);
            PG8_BAR; PG8_WAIT_L(0); PG8_MMA(0, 1, At, B1); PG8_BAR;
            PG8_LDA(At, 1, 1); PG8_STAGE(PG8_SA(1, 0), a3, voffA);
            PG8_BAR; PG8_WAIT_L(0); PG8_MMA(1, 0, At, B0); PG8_BAR; PG8_SCHED;
            PG8_STAGE(PG8_SB(1, 1), b3 + hstep, voffB);
            PG8_WAIT_V(6); PG8_BAR; PG8_MMA(1, 1, At, B1); PG8_BAR;
            }
        }
        if constexpr (ALIGN_EPI) { if (wr == 0) PG8_BAR; }
        if constexpr (!Epi::AFTER_DRAIN) { E(acc, cur, wr, wc, fr, fq); S.done(cur); }
        if (!has_next) break;
#pragma unroll
        for (int a = 0; a < 2; ++a)
#pragma unroll
            for (int b = 0; b < 2; ++b)
#pragma unroll
                for (int m = 0; m < 4; ++m)
#pragma unroll
                    for (int n = 0; n < 2; ++n) acc[a][b][m][n] = (f32x4){0.f, 0.f, 0.f, 0.f};
        cur = nxt; cA = nA; cB = nB; ++ui;
        if constexpr (ALIGN_EPI) { if (wr == 1) PG8_BAR; }
    }
    PG8_WAIT_V(0);
    if constexpr (!ALIGN_EPI) { if (wr == 0) PG8_BAR; }
    PG8_BAR;
    if constexpr (Epi::AFTER_DRAIN) { E.fused(acc, cur, wr, wc, fr, fq, lds, wid, lane); S.done(cur); }
#undef PG8_SA
#undef PG8_SB
#undef PG8_STAGE
#undef PG8_LDA
#undef PG8_LDB
#undef PG8_MMA
#undef PG8_WAIT_V
#undef PG8_WAIT_L
#undef PG8_BAR
#undef PG8_SCHED
}
}

constexpr int DM = 1024, NB = 2, SEQ = 8192, CTXL = 256, MLAT = NB * SEQ, MCTX = NB * CTXL, MROWS = MLAT + MCTX;
constexpr int NIN = 2560, NCHUNK = MROWS / 64  , NPJ = 132  ;
constexpr float EPSF = 1e-6f;
constexpr int NWAVES = 8, NTHR = 512;

constexpr size_t MiB = 1u << 20;
constexpr size_t WS_CTL = 0, CTL_ZERO_BYTES = 64 * 1024;
constexpr size_t WS_MOD = 1 * MiB;
constexpr size_t WS_SP8 = 1 * MiB + 128 * 1024;
constexpr size_t WS_GWF = 1 * MiB + 256 * 1024;
constexpr size_t WS_BT1 = 2 * MiB;
constexpr size_t WS_BT2 = 12 * MiB;
constexpr size_t WS_AGGA = 16 * MiB;
constexpr size_t WS_AGGB = 16 * MiB + 1536 * 1024;
constexpr size_t WS_SSQ = 19 * MiB;
constexpr size_t WS_XC1 = 21 * MiB;
constexpr size_t WS_A16 = 23 * MiB;
constexpr size_t WS_B16 = 28 * MiB;
constexpr size_t WS_H = 73 * MiB;
constexpr size_t WS_Y = 56 * MiB;
constexpr size_t WS_MIXIN = 73 * MiB;
constexpr size_t WS_U = 106 * MiB;
constexpr size_t WS_MIX = 189 * MiB;
constexpr size_t WS_END = 255 * MiB;

constexpr int LDS_BYTES = 158720;
constexpr int MISC_OFF = 157696;

#define LAS __attribute__((address_space(3)))
typedef unsigned short bf16;
typedef unsigned v4u __attribute__((ext_vector_type(4)));
typedef unsigned v2u __attribute__((ext_vector_type(2)));
typedef float f32x4 __attribute__((ext_vector_type(4)));
typedef short bf16x8 __attribute__((ext_vector_type(8)));
typedef float f32x2v __attribute__((ext_vector_type(2)));
#define LDS_WAIT() asm volatile("s_waitcnt lgkmcnt(0)" ::: "memory")

__device__ __forceinline__ unsigned f2bf(float f) { unsigned u = __builtin_bit_cast(unsigned, f); return (u + 0x7fffu + ((u >> 16) & 1u)) >> 16; }
__device__ __forceinline__ unsigned pk2(float lo, float hi) { return f2bf(lo) | (f2bf(hi) << 16); }
__device__ __forceinline__ unsigned cvtpk(float lo, float hi) { unsigned r; asm volatile("v_cvt_pk_bf16_f32 %0, %1, %2" : "=v"(r) : "v"(lo), "v"(hi)); return r; }
__device__ __forceinline__ float bflo(unsigned u) { return __builtin_bit_cast(float, u << 16); }
__device__ __forceinline__ float bfhi(unsigned u) { return __builtin_bit_cast(float, u & 0xffff0000u); }
__device__ __forceinline__ float sigmoidf_(float x) { return 1.0f / (1.0f + __expf(-x)); }
__device__ __forceinline__ float siluf_(float x) { return x / (1.0f + __expf(-x)); }
__device__ __forceinline__ float wave_sum(float v) {
#pragma unroll
    for (int o = 1; o < 64; o <<= 1) v += __shfl_xor(v, o);
    return v;
}

struct Args {
    const float* in[21]; float* out; unsigned char* ws; int ph_lo, ph_hi, coop, pad;
};
enum { I_X = 0, I_C, I_CTX, I_CCTX, I_WMOD, I_BMOD, I_GPRE, I_GPOST, I_WIN, I_CAW, I_CAB, I_WR, I_BR, I_WI, I_BI, I_LAM, I_DWW, I_DWB, I_LNG, I_LNB, I_WOUT };

namespace pg8 {
struct EpiU {
    static constexpr bool PERM = true, AFTER_DRAIN = false;
    bf16_t* O;
    __device__ __forceinline__ void operator()(const f32x4 (&acc)[2][2][4][2], const Unit& u, int wr, int wc, int fr, int fq) const {
        const int row0 = u.pm * BM + wr * 64 + fr;
        if (u.pn >= 4 && u.pn < 8) {
            const int col0 = 1024 + 128 * (u.pn - 4) + wc * 32 + 8 * fq;
#pragma unroll
            for (int ai = 0; ai < 2; ++ai)
#pragma unroll
                for (int m = 0; m < 4; ++m) { f32x4 v0 = acc[ai][0][m][0], v1 = acc[ai][0][m][1]; const f32x4 g0 = acc[ai][1][m][0], g1 = acc[ai][1][m][1];
#pragma unroll
                    for (int e = 0; e < 4; ++e) { v0[e] = v0[e] * __builtin_amdgcn_rcpf(1.0f + __expf(-g0[e])); v1[e] = v1[e] * __builtin_amdgcn_rcpf(1.0f + __expf(-g1[e])); }
                    u32x4 w; w.x = cvt_pk_bf16(v0[0], v0[1]); w.y = cvt_pk_bf16(v0[2], v0[3]); w.z = cvt_pk_bf16(v1[0], v1[1]); w.w = cvt_pk_bf16(v1[2], v1[3]);
                    *(u32x4*)(O + (size_t)(row0 + ai * HALF + m * 16) * 2560 + col0) = w; }
            return;
        }
        const int col0 = u.pn * BM + wc * 32 + 8 * fq;
        const bool act = (u.pn == 2 || u.pn == 3 || u.pn >= 8);
#pragma unroll
        for (int ai = 0; ai < 2; ++ai)
#pragma unroll
            for (int m = 0; m < 4; ++m) { bf16_t* rowp = O + (size_t)(row0 + ai * HALF + m * 16) * 2560 + col0;
#pragma unroll
                for (int bj = 0; bj < 2; ++bj) { f32x4 v0 = acc[ai][bj][m][0], v1 = acc[ai][bj][m][1];
                    if (act) {
#pragma unroll
                        for (int e = 0; e < 4; ++e) { v0[e] = v0[e] * __builtin_amdgcn_rcpf(1.0f + __expf(-v0[e])); v1[e] = v1[e] * __builtin_amdgcn_rcpf(1.0f + __expf(-v1[e])); }
                    }
                    u32x4 w; w.x = cvt_pk_bf16(v0[0], v0[1]); w.y = cvt_pk_bf16(v0[2], v0[3]); w.z = cvt_pk_bf16(v1[0], v1[1]); w.w = cvt_pk_bf16(v1[2], v1[3]);
                    *(u32x4*)(rowp + bj * HALF) = w; } }
    }
};
struct EpiMix {
    static constexpr bool PERM = true, AFTER_DRAIN = false;
    bf16_t* O; float* ssq;
    __device__ __forceinline__ void operator()(const f32x4 (&acc)[2][2][4][2], const Unit& u, int wr, int wc, int fr, int fq) const {
        const int col0 = u.pn * BM + wc * 32 + 8 * fq;
#pragma unroll
        for (int ai = 0; ai < 2; ++ai)
#pragma unroll
            for (int m = 0; m < 4; ++m) { const int r = u.pm * BM + ai * HALF + wr * 64 + m * 16 + fr; bf16_t* rowp = O + (size_t)r * 1024 + col0; float s = 0.f;
#pragma unroll
                for (int bj = 0; bj < 2; ++bj) { const f32x4 v0 = acc[ai][bj][m][0], v1 = acc[ai][bj][m][1];
                    s += ((v0[0] * v0[0] + v0[1] * v0[1]) + (v0[2] * v0[2] + v0[3] * v0[3])) + ((v1[0] * v1[0] + v1[1] * v1[1]) + (v1[2] * v1[2] + v1[3] * v1[3]));
                    u32x4 w; w.x = cvt_pk_bf16(v0[0], v0[1]); w.y = cvt_pk_bf16(v0[2], v0[3]); w.z = cvt_pk_bf16(v1[0], v1[1]); w.w = cvt_pk_bf16(v1[2], v1[3]);
                    *(u32x4*)(rowp + bj * HALF) = w; }
                s += __shfl_xor(s, 16); s += __shfl_xor(s, 32);
                if (fq == 0) ssq[(size_t)r * 16 + u.pn * 4 + wc] = s; }
    }
};
}

__device__ __forceinline__ void p0_transpose_item(const float* W, int K, int N, bf16* WT, LAS float* scr, int item, int lane, bool glu_remap) {
    const int nblk = N / 32, kb = item / nblk, nb = item % nblk, k0 = 64 * kb, n0 = 32 * nb;
    int nd = n0;
    if (glu_remap) { if (n0 >= 1024 && n0 < 1536) nd = 1024 + 256 * ((n0 - 1024) >> 7) + ((n0 - 1024) & 127); else if (n0 >= 1536 && n0 < 2048) nd = 1024 + 256 * ((n0 - 1536) >> 7) + 128 + ((n0 - 1536) & 127); }
#pragma unroll 8
    for (int i = 0; i < 32; ++i) { const int kk = 2 * i + (lane >> 5); scr[kk * 33 + (lane & 31)] = W[(size_t)(k0 + kk) * N + n0 + (lane & 31)]; }
    LDS_WAIT(); asm volatile("" ::: "memory");
    const int c = lane & 7;
#pragma unroll
    for (int j = 0; j < 4; ++j) { const int n = (lane >> 3) + 8 * j; const LAS float* s = scr + (8 * c) * 33 + n;
        v4u o; o.x = pk2(s[0 * 33], s[1 * 33]); o.y = pk2(s[2 * 33], s[3 * 33]); o.z = pk2(s[4 * 33], s[5 * 33]); o.w = pk2(s[6 * 33], s[7 * 33]);
        *(v4u*)(WT + (size_t)(nd + n) * K + k0 + 8 * c) = o; }
    LDS_WAIT(); asm volatile("" ::: "memory");
}

__device__ __forceinline__ void p0_prologue(const Args& a, LAS unsigned char* lds, int tid, int lane, int wave) {
    const int G = gridDim.x, bx = blockIdx.x;
    unsigned char* ws = a.ws;
    {
        LAS float* part = (LAS float*)lds;
        float* MOD = (float*)(ws + WS_MOD);
        const float* c = a.in[I_C]; const float* cctx = a.in[I_CCTX];
        for (int un = bx; un < 192; un += G) {
            const int l = un / 96, n0 = (un % 96) * 32, cq = tid & 7, ks = tid >> 3;
            const float* wm = a.in[I_WMOD] + (size_t)l * 1024 * 3072 + n0 + cq * 4;
            f32x4 acc0 = {0.f, 0.f, 0.f, 0.f}, acc1 = acc0, acc2 = acc0;
#pragma unroll 4
            for (int kk = 0; kk < 16; ++kk) { const int k = ks * 16 + kk; const f32x4 w = *(const f32x4*)(wm + (size_t)k * 3072);
                const float a0 = siluf_(c[k]), a1 = siluf_(c[1024 + k]), a2 = siluf_(cctx[k]);
                acc0 += w * a0; acc1 += w * a1; acc2 += w * a2; }
            *(LAS f32x4*)(part + (0 * 64 + ks) * 32 + cq * 4) = acc0;
            *(LAS f32x4*)(part + (1 * 64 + ks) * 32 + cq * 4) = acc1;
            *(LAS f32x4*)(part + (2 * 64 + ks) * 32 + cq * 4) = acc2;
            __syncthreads();
            if (tid < 96) { const int v = tid >> 5, col = tid & 31; float s = a.in[I_BMOD][l * 3072 + n0 + col];
                for (int k2 = 0; k2 < 64; ++k2) s += part[(v * 64 + k2) * 32 + col];
                MOD[(l * 3 + v) * 3072 + n0 + col] = s; }
            __syncthreads();
        }
    }
    { float* SP8 = (float*)(ws + WS_SP8); for (int idx = bx * NTHR + tid; idx < 2048; idx += G * NTHR) SP8[idx] = -8.0f * log1pf(__expf(-a.in[I_LAM][idx])); }
    {
        v4u* GWF = (v4u*)(ws + WS_GWF);
        for (int idx = bx * NTHR + tid; idx < 32768; idx += G * NTHR) {
            const int ln = idx & 63, kk = (idx >> 6) & 1, ct = (idx >> 7) & 3, h = (idx >> 9) & 7, g = (idx >> 12) & 1, d = (idx >> 13) & 1, l = idx >> 14;
            const float* W = (g == 0 ? a.in[I_WR] : a.in[I_WI]) + (size_t)(((l * 2 + d) * 8 + h) * 64) * 64;
            const int k0 = 32 * kk + 8 * (ln >> 4), col = 16 * ct + (ln & 15);
            float e[8];
#pragma unroll
            for (int j = 0; j < 8; ++j) e[j] = W[(k0 + j) * 64 + col];
            v4u o; o.x = pk2(e[0], e[1]); o.y = pk2(e[2], e[3]); o.z = pk2(e[4], e[5]); o.w = pk2(e[6], e[7]);
            GWF[idx] = o;
        }
    }
    {
        LAS float* scr = (LAS float*)(lds + wave * 16384);
        const int gw = bx * NWAVES + wave, NGW = G * NWAVES;
        constexpr int I_1 = (1024 / 64) * (NIN / 32), I_2 = (1024 / 64) * (1024 / 32), NITEMS = 2 * (I_1 + I_2);
        bf16* BT1 = (bf16*)(ws + WS_BT1); bf16* BT2 = (bf16*)(ws + WS_BT2);
        for (int it = gw; it < NITEMS; it += NGW) {
            int r = it;
            if (r < I_1) { p0_transpose_item(a.in[I_WIN], 1024, NIN, BT1, scr, r, lane, true); continue; } r -= I_1;
            if (r < I_1) { p0_transpose_item(a.in[I_WIN] + (size_t)1024 * NIN, 1024, NIN, BT1 + (size_t)NIN * 1024, scr, r, lane, true); continue; } r -= I_1;
            if (r < I_2) { p0_transpose_item(a.in[I_WOUT], 1024, 1024, BT2, scr, r, lane, false); continue; } r -= I_2;
            p0_transpose_item(a.in[I_WOUT] + (size_t)1024 * 1024, 1024, 1024, BT2 + (size_t)1024 * 1024, scr, r, lane, false);
        }
    }
}

__device__ __forceinline__ void norm_phase(const Args& a, int mode, int lane, int wave) {
    unsigned char* ws = a.ws;
    const float* MOD = (const float*)(ws + WS_MOD); const bf16* MIX = (const bf16*)(ws + WS_MIX); const float* SSQ = (const float*)(ws + WS_SSQ);
    float* XC1 = (float*)(ws + WS_XC1); bf16* H = (bf16*)(ws + WS_H);
    const int gw = blockIdx.x * NWAVES + wave, NGW = gridDim.x * NWAVES;
    const int nrows = (mode == 2) ? MLAT : MROWS, lu = (mode == 1) ? 0 : 1, ln = (mode == 0) ? 0 : 1;
    for (int row = gw; row < nrows; row += NGW) {
        const int vsel = row < MLAT ? (row >> 13) : 2;
        const float* src;
        if (mode == 2) src = a.out + (size_t)row * 1024;
        else src = row < MLAT ? a.in[I_X] + (size_t)row * 1024 : a.in[I_CTX] + (size_t)(row - MLAT) * 1024;
        f32x4 v[4];
#pragma unroll
        for (int j = 0; j < 4; ++j) v[j] = *((const f32x4*)src + lane + 64 * j);
        if (mode >= 1) {
            const float sp = lane < 16 ? SSQ[(size_t)row * 16 + lane] : 0.f;
            const float rstd = rsqrtf(wave_sum(sp) * (1.0f / 1024.0f) + EPSF);
            const float* gate = MOD + (lu * 3 + vsel) * 3072 + 2048; const float* gp = a.in[I_GPOST] + lu * 1024;
#pragma unroll
            for (int j = 0; j < 4; ++j) { const v2u mq = *((const v2u*)(MIX + (size_t)row * 1024) + lane + 64 * j); const f32x4 mx = {bflo(mq.x), bfhi(mq.x), bflo(mq.y), bfhi(mq.y)};
                const f32x4 gt = *((const f32x4*)gate + lane + 64 * j), gv = *((const f32x4*)gp + lane + 64 * j);
                v[j] += gt * (mx * rstd * gv); }
            float* dst = row < MLAT ? a.out + (size_t)row * 1024 : XC1 + (size_t)(row - MLAT) * 1024;
#pragma unroll
            for (int j = 0; j < 4; ++j) *((f32x4*)dst + lane + 64 * j) = v[j];
        }
        if (mode <= 1) {
            float s = 0.f;
#pragma unroll
            for (int j = 0; j < 4; ++j) s += (v[j].x * v[j].x + v[j].y * v[j].y) + (v[j].z * v[j].z + v[j].w * v[j].w);
            const float r = rsqrtf(wave_sum(s) * (1.0f / 1024.0f) + EPSF);
            const float* shift = MOD + (ln * 3 + vsel) * 3072; const float* scale = shift + 1024; const float* gpre = a.in[I_GPRE] + ln * 1024;
            v2u* o8 = (v2u*)(H + (size_t)row * 1024);
#pragma unroll
            for (int j = 0; j < 4; ++j) { const f32x4 sh = *((const f32x4*)shift + lane + 64 * j), sc = *((const f32x4*)scale + lane + 64 * j), gv = *((const f32x4*)gpre + lane + 64 * j);
                const f32x4 hv = v[j] * r * gv * (sc + 1.0f) + sh;
                v2u w; w.x = pk2(hv.x, hv.y); w.y = pk2(hv.z, hv.w); o8[lane + 64 * j] = w; }
        }
    }
}

__device__ __forceinline__ void conv16(const LAS unsigned* vt, const float (&w0)[31], const float (&w1)[31], float b0, float b1, bf16* ybase, size_t ystride) {
#pragma unroll 1
    for (int tq = 0; tq < 4; ++tq) {
        const LAS unsigned* vq = vt + tq * 4 * 128;
        float a0[4], a1[4];
#pragma unroll
        for (int t = 0; t < 4; ++t) { a0[t] = b0; a1[t] = b1; }
#pragma unroll
        for (int rr = 0; rr < 34; ++rr) { const unsigned u = vq[rr * 128]; const float lo = bflo(u), hi = bfhi(u);
#pragma unroll
            for (int t = 0; t < 4; ++t) { const int k = rr - t; if (k >= 0 && k < 31) { a0[t] += w0[k] * lo; a1[t] += w1[k] * hi; } }
            if ((rr & 7) == 7) asm volatile("" ::: "memory"); }
#pragma unroll
        for (int t = 0; t < 4; ++t) *(unsigned*)(ybase + (size_t)(tq * 4 + t) * ystride) = cvtpk(a0[t], a1[t]);
    }
}
__device__ __forceinline__ v4u glu8(const v4u vq, const v4u gq) {
    v4u o;
    o.x = pk2(bflo(vq.x) * sigmoidf_(bflo(gq.x)), bfhi(vq.x) * sigmoidf_(bfhi(gq.x)));
    o.y = pk2(bflo(vq.y) * sigmoidf_(bflo(gq.y)), bfhi(vq.y) * sigmoidf_(bfhi(gq.y)));
    o.z = pk2(bflo(vq.z) * sigmoidf_(bflo(gq.z)), bfhi(vq.z) * sigmoidf_(bfhi(gq.z)));
    o.w = pk2(bflo(vq.w) * sigmoidf_(bflo(gq.w)), bfhi(vq.w) * sigmoidf_(bfhi(gq.w)));
    return o;
}
__device__ __forceinline__ void hconv_unit(const Args& a, LAS unsigned char* lds, int l, int r0, int g, int vlo, int vhi, int tid) {
    const bf16* U = (const bf16*)(a.ws + WS_U); bf16* Y = (bf16*)(a.ws + WS_Y);
    LAS unsigned* VT = (LAS unsigned*)lds;
    {
        v4u vq[6];
#pragma unroll
        for (int it = 0; it < 6; ++it) { const int i = tid + it * NTHR, rr = i >> 5, ch = i & 31, row = r0 - 15 + rr; const bool ok = i < 94 * 32 && row >= vlo && row < vhi;
            vq[it] = *(const v4u*)(U + (size_t)(ok ? row : r0) * NIN + 1024 + g * 256 + ch * 8); }
#pragma unroll
        for (int it = 0; it < 6; ++it) { const int i = tid + it * NTHR, rr = i >> 5, ch = i & 31, row = r0 - 15 + rr; const bool ok = row >= vlo && row < vhi;
            if (i < 94 * 32) { const v4u z = {0u, 0u, 0u, 0u}; *(LAS v4u*)(VT + rr * 128 + ch * 4) = ok ? vq[it] : z; } }
    }
    __syncthreads();
    int p = tid & 127; asm volatile("" : "+v"(p));
    const int tg = tid >> 7, c0 = g * 256 + 2 * p;
    float w0[31], w1[31];
#pragma unroll
    for (int k = 0; k < 31; ++k) { const float2 w = *(const float2*)(a.in[I_DWW] + (size_t)(l * 31 + k) * 512 + c0); w0[k] = w.x; w1[k] = w.y; }
    const float2 bb = *(const float2*)(a.in[I_DWB] + l * 512 + c0);
    conv16(VT + (tg * 16) * 128 + p, w0, w1, bb.x, bb.y, Y + (size_t)(r0 + tg * 16) * 512 + c0, 512);
    __syncthreads();
}
__device__ __forceinline__ void vconv_unit(const Args& a, LAS unsigned char* lds, int l, int b, int w, int tid) {
    const bf16* U = (const bf16*)(a.ws + WS_U); bf16* Y = (bf16*)(a.ws + WS_Y);
    LAS unsigned* VT = (LAS unsigned*)lds;
#pragma unroll 1
    for (int hb = 0; hb < 2; ++hb) {
        v4u vq[5];
#pragma unroll
        for (int it = 0; it < 5; ++it) { const int i = tid + (hb * 5 + it) * NTHR, rr = i >> 5, ch = i & 31, gr = rr - 15; const bool ok = i < 158 * 32 && gr >= 0 && gr < 128;
            vq[it] = *(const v4u*)(U + (size_t)(b * SEQ + (ok ? gr : 0) * 64 + w) * NIN + 1024 + 256 + ch * 8); }
#pragma unroll
        for (int it = 0; it < 5; ++it) { const int i = tid + (hb * 5 + it) * NTHR, rr = i >> 5, ch = i & 31, gr = rr - 15; const bool ok = gr >= 0 && gr < 128;
            if (i < 158 * 32) { const v4u z = {0u, 0u, 0u, 0u}; *(LAS v4u*)(VT + rr * 128 + ch * 4) = ok ? vq[it] : z; } }
    }
    __syncthreads();
    int p = tid & 127; asm volatile("" : "+v"(p));
    const int tg = tid >> 7, c0 = 256 + 2 * p;
    float w0[31], w1[31];
#pragma unroll
    for (int k = 0; k < 31; ++k) { const float2 wv = *(const float2*)(a.in[I_DWW] + (size_t)(l * 31 + k) * 512 + c0); w0[k] = wv.x; w1[k] = wv.y; }
    const float2 bb = *(const float2*)(a.in[I_DWB] + l * 512 + c0);
#pragma unroll 1
    for (int half = 0; half < 2; ++half) {
        const int tb = tg * 32 + half * 16;
        conv16(VT + tb * 128 + p, w0, w1, bb.x, bb.y, Y + (size_t)(b * SEQ + tb * 64 + w) * 512 + c0, (size_t)64 * 512);
    }
    __syncthreads();
}
__device__ __forceinline__ void ln_rows(const Args& a, int l, int nrows, int lane, int wave) {
    const bf16* U = (const bf16*)(a.ws + WS_U); const bf16* Y = (const bf16*)(a.ws + WS_Y); bf16* MIXIN = (bf16*)(a.ws + WS_MIXIN);
    const int gw = blockIdx.x * NWAVES + wave, NGW = gridDim.x * NWAVES, c0 = lane * 8;
    float lg[8], lb[8];
#pragma unroll
    for (int e = 0; e < 8; ++e) { lg[e] = a.in[I_LNG][l * 512 + c0 + e]; lb[e] = a.in[I_LNB][l * 512 + c0 + e]; }
    for (int row = gw; row < nrows; row += NGW) {
        const v4u yq = *(const v4u*)(Y + (size_t)row * 512 + c0); const v4u gq = *(const v4u*)(U + (size_t)row * NIN + 2048 + c0);
        float y[8] = {bflo(yq.x), bfhi(yq.x), bflo(yq.y), bfhi(yq.y), bflo(yq.z), bfhi(yq.z), bflo(yq.w), bfhi(yq.w)};
        const float gt[8] = {bflo(gq.x), bfhi(gq.x), bflo(gq.y), bfhi(gq.y), bflo(gq.z), bfhi(gq.z), bflo(gq.w), bfhi(gq.w)};
        float s = 0.f;
#pragma unroll
        for (int e = 0; e < 8; ++e) s += y[e];
        const float mean = wave_sum(s) * (1.0f / 512.0f); float q = 0.f;
#pragma unroll
        for (int e = 0; e < 8; ++e) { y[e] -= mean; q += y[e] * y[e]; }
        const float rstd = rsqrtf(wave_sum(q) * (1.0f / 512.0f) + EPSF);
        float o[8];
#pragma unroll
        for (int e = 0; e < 8; ++e) o[e] = siluf_(y[e] * rstd * lg[e] + lb[e]) * gt[e];
        v4u w; w.x = pk2(o[0], o[1]); w.y = pk2(o[2], o[3]); w.z = pk2(o[4], o[5]); w.w = pk2(o[6], o[7]);
        *(v4u*)(MIXIN + (size_t)row * 1024 + 512 + c0) = w;
    }
}

constexpr int RG_GW = 0, RG_FOLD = 32768, RG_F8 = 36864, RG_CAR = 40960, RG_WAVE = 57344, RG_WAVE_BYTES = 12544;
constexpr int NP16 = 4 * NPJ;
__device__ __forceinline__ float fsig(float x) { return __builtin_amdgcn_rcpf(1.0f + __expf(-x)); }

template <bool FINAL, int D>
__device__ __forceinline__ void rg_sweep(const Args& a, LAS unsigned char* lds, LAS unsigned char* wl, int l, int b, int h, int r0, int seg_lo, int seg_hi, int pj, bool is_ctx, int w, int lane) {
    const bf16* U = (const bf16*)(a.ws + WS_U); bf16* MIXIN = (bf16*)(a.ws + WS_MIXIN);
    float* AGGA = (float*)(a.ws + WS_AGGA); float* AGGB = (float*)(a.ws + WS_AGGB); float* A16 = (float*)(a.ws + WS_A16); float* B16 = (float*)(a.ws + WS_B16);
    LAS float* VCW = (LAS float*)wl; LAS unsigned* HBW = (LAS unsigned*)(wl + 4352);
    const LAS v4u* GWL = (const LAS v4u*)(lds + RG_GW) + (D * 2) * 8 * 64 + lane;
    const LAS float* CAR = (const LAS float*)(lds + RG_CAR);
    const int fr = lane & 15, fq = lane >> 4, cp = lane & 31, rh = lane >> 5;
    float2 cw[4];
#pragma unroll
    for (int k = 0; k < 4; ++k) cw[k] = *(const float2*)(a.in[I_CAW] + (size_t)((l * 2 + D) * 4 + k) * 512 + 64 * h + 2 * cp);
    const float2 cbv = *(const float2*)(a.in[I_CAB] + (l * 2 + D) * 512 + 64 * h + 2 * cp);
    float brv[4], biv[4], sp8[4], Hc[4], Ac[4];
    const int p16own = 4 * pj + (D ? 3 - fq : fq);
#pragma unroll
    for (int ct = 0; ct < 4; ++ct) { const int c = 16 * ct + fr, pidx = (l * 2 + D) * 512 + 64 * h + c;
        brv[ct] = a.in[I_BR][pidx]; biv[ct] = a.in[I_BI][pidx]; sp8[ct] = ((const float*)(a.ws + WS_SP8))[pidx];
        Hc[ct] = 0.f; Ac[ct] = 1.f;
        if (FINAL) {
            if (is_ctx) { const size_t base = (size_t)((b * 2 + D) * NP16) * 512 + 64 * h + c; float S = 0.f;
                for (int i = 0; i < p16own; ++i) S = A16[base + (size_t)i * 512] * S + B16[base + (size_t)i * 512];
                Hc[ct] = S; }
            else Hc[ct] = CAR[(D * 32 + (D ? 31 - (4 * w + fq) : 4 * w + fq)) * 64 + c];
        } }
    const bf16* ub = U + 64 * h + 2 * cp;
    unsigned Wd[2][7], nx[2][4];
#pragma unroll
    for (int q = 0; q < 2; ++q) { const int g = 2 * rh + q;
#pragma unroll
        for (int j = 0; j < 3; ++j) { const int row = r0 + 16 * g + (D ? 16 + j : j - 3); const bool ok = row >= seg_lo && row < seg_hi; const int rc = ok ? row : r0;
            const unsigned v = *(const unsigned*)(ub + (size_t)rc * NIN); Wd[q][D ? j : 4 + j] = ok ? v : 0u; }
#pragma unroll
        for (int j = 0; j < 4; ++j) nx[q][j] = *(const unsigned*)(ub + (size_t)(r0 + 16 * g + 4 * (D ? 3 : 0) + j) * NIN); }
#pragma unroll 1
    for (int ti = 0; ti < 4; ++ti) {
        const int tile = D ? 3 - ti : ti;
        int zo = 0; asm volatile("" : "+v"(zo));
        const LAS v4u* GWLt = GWL + zo;
        v4u g0 = {0u, 0u, 0u, 0u}, g1 = g0; size_t orow = 0;
        if (FINAL && D == 0) { orow = (size_t)(r0 + 16 * (fr >> 2) + 4 * tile + (fr & 3)); const bf16* gp = U + orow * NIN + 512 + 64 * h + 16 * fq; g0 = *(const v4u*)gp; g1 = *(const v4u*)(gp + 8); }
#pragma unroll
        for (int q = 0; q < 2; ++q) {
            if (D == 0) { Wd[q][0] = Wd[q][4]; Wd[q][1] = Wd[q][5]; Wd[q][2] = Wd[q][6]; Wd[q][3] = nx[q][0]; Wd[q][4] = nx[q][1]; Wd[q][5] = nx[q][2]; Wd[q][6] = nx[q][3]; }
            else { Wd[q][4] = Wd[q][0]; Wd[q][5] = Wd[q][1]; Wd[q][6] = Wd[q][2]; Wd[q][0] = nx[q][0]; Wd[q][1] = nx[q][1]; Wd[q][2] = nx[q][2]; Wd[q][3] = nx[q][3]; } }
        if (ti < 3) { const int tn = D ? 2 - ti : ti + 1;
#pragma unroll
            for (int q = 0; q < 2; ++q)
#pragma unroll
                for (int j = 0; j < 4; ++j) nx[q][j] = *(const unsigned*)(ub + (size_t)(r0 + 16 * (2 * rh + q) + 4 * tn + j) * NIN); }
#pragma unroll
        for (int q = 0; q < 2; ++q)
#pragma unroll
            for (int jj = 0; jj < 4; ++jj) { float v0 = cbv.x, v1 = cbv.y;
#pragma unroll
                for (int k = 0; k < 4; ++k) { const unsigned u = Wd[q][jj + k]; v0 += cw[k].x * bflo(u); v1 += cw[k].y * bfhi(u); }
                *(LAS f32x2v*)(VCW + (4 * (2 * rh + q) + jj) * 68 + 2 * cp) = (f32x2v){v0, v1}; }
        bf16x8 af[2];
#pragma unroll
        for (int kk = 0; kk < 2; ++kk) { const LAS float* vp = VCW + fr * 68 + 32 * kk + 8 * fq; const f32x4 x0 = *(const LAS f32x4*)vp, x1 = *(const LAS f32x4*)(vp + 4);
            v4u pk; pk.x = cvtpk(x0.x, x0.y); pk.y = cvtpk(x0.z, x0.w); pk.z = cvtpk(x1.x, x1.y); pk.w = cvtpk(x1.z, x1.w); af[kk] = __builtin_bit_cast(bf16x8, pk); }
        float vcv[4][4];
#pragma unroll
        for (int ct = 0; ct < 4; ++ct)
#pragma unroll
            for (int jj = 0; jj < 4; ++jj) vcv[ct][jj] = VCW[(4 * fq + jj) * 68 + 16 * ct + fr];
        f32x4 accr[4], acci[4];
#pragma unroll
        for (int ct = 0; ct < 4; ++ct) { accr[ct] = (f32x4){0.f, 0.f, 0.f, 0.f}; acci[ct] = accr[ct];
#pragma unroll
            for (int kk = 0; kk < 2; ++kk) { const bf16x8 br = __builtin_bit_cast(bf16x8, GWLt[(ct * 2 + kk) * 64]), bi = __builtin_bit_cast(bf16x8, GWLt[(8 + ct * 2 + kk) * 64]);
                accr[ct] = __builtin_amdgcn_mfma_f32_16x16x32_bf16(af[kk], br, accr[ct], 0, 0, 0); acci[ct] = __builtin_amdgcn_mfma_f32_16x16x32_bf16(af[kk], bi, acci[ct], 0, 0, 0); } }
        float hsum[4][4];
#pragma unroll
        for (int ct = 0; ct < 4; ++ct) { float aa[4], bb[4];
            const float nbr = -1.44269504f * brv[ct], nbi = -1.44269504f * biv[ct];
#pragma unroll
            for (int p = 0; p < 2; ++p) {
                f32x2v xr = (f32x2v){accr[ct][2 * p], accr[ct][2 * p + 1]} * -1.44269504f + nbr, xi = (f32x2v){acci[ct][2 * p], acci[ct][2 * p + 1]} * -1.44269504f + nbi;
                xr = __builtin_elementwise_min(xr, (f32x2v){60.f, 60.f}); xi = __builtin_elementwise_min(xi, (f32x2v){60.f, 60.f});
                f32x2v d1, d2; d1.x = __builtin_amdgcn_exp2f(xr.x); d1.y = __builtin_amdgcn_exp2f(xr.y); d2.x = __builtin_amdgcn_exp2f(xi.x); d2.y = __builtin_amdgcn_exp2f(xi.y);
                d1 = d1 + 1.0f; d2 = d2 + 1.0f; const f32x2v m = d1 * d2; f32x2v inv; inv.x = __builtin_amdgcn_rcpf(m.x); inv.y = __builtin_amdgcn_rcpf(m.y);
                const f32x2v r = d2 * inv, ig = d1 * inv, la = r * sp8[ct], x2 = la + la, le = la * 1.44269504f;
                const f32x2v pom = -x2 * (x2 * (x2 * (x2 * (x2 * 0.0083333338f + 0.041666668f) + 0.16666667f) + 0.5f) + 1.0f);
                f32x2v av; av.x = __builtin_amdgcn_exp2f(le.x); av.y = __builtin_amdgcn_exp2f(le.y);
                const f32x2v o2 = 1.0f - av * av; f32x2v om; om.x = x2.x > -0.25f ? pom.x : o2.x; om.y = x2.y > -0.25f ? pom.y : o2.y;
                om = __builtin_elementwise_max(om, (f32x2v){0.f, 0.f});
                f32x2v sq; sq.x = __builtin_amdgcn_sqrtf(om.x); sq.y = __builtin_amdgcn_sqrtf(om.y);
                const f32x2v bv = sq * (ig * (f32x2v){vcv[ct][2 * p], vcv[ct][2 * p + 1]});
                aa[2 * p] = av.x; aa[2 * p + 1] = av.y; bb[2 * p] = bv.x; bb[2 * p + 1] = bv.y; }
            float hh = Hc[ct], A4 = 1.f;
#pragma unroll
            for (int ji = 0; ji < 4; ++ji) { const int jj = D ? 3 - ji : ji; hh = aa[jj] * hh + bb[jj]; A4 *= aa[jj]; hsum[ct][jj] = hh; }
            Hc[ct] = hh; if (!FINAL) Ac[ct] *= A4; }
        if (FINAL) {
            if (D == 1) {
#pragma unroll
                for (int ct = 0; ct < 4; ++ct)
#pragma unroll
                    for (int jp = 0; jp < 2; ++jp) HBW[(tile * 8 + ct * 2 + jp) * 64 + lane] = cvtpk(hsum[ct][2 * jp], hsum[ct][2 * jp + 1]);
            } else {
#pragma unroll
                for (int ct = 0; ct < 4; ++ct)
#pragma unroll
                    for (int jp = 0; jp < 2; ++jp) { const unsigned hb = HBW[(tile * 8 + ct * 2 + jp) * 64 + lane];
                        VCW[(4 * fq + 2 * jp) * 68 + 16 * ct + fr] = hsum[ct][2 * jp] + bflo(hb); VCW[(4 * fq + 2 * jp + 1) * 68 + 16 * ct + fr] = hsum[ct][2 * jp + 1] + bfhi(hb); }
                const size_t row = orow;
                const f32x4 s0 = *(const LAS f32x4*)(VCW + fr * 68 + 16 * fq), s1 = *(const LAS f32x4*)(VCW + fr * 68 + 16 * fq + 4), s2 = *(const LAS f32x4*)(VCW + fr * 68 + 16 * fq + 8), s3 = *(const LAS f32x4*)(VCW + fr * 68 + 16 * fq + 12);
                v4u o0, o1;
                o0.x = cvtpk(s0.x * bflo(g0.x), s0.y * bfhi(g0.x)); o0.y = cvtpk(s0.z * bflo(g0.y), s0.w * bfhi(g0.y)); o0.z = cvtpk(s1.x * bflo(g0.z), s1.y * bfhi(g0.z)); o0.w = cvtpk(s1.z * bflo(g0.w), s1.w * bfhi(g0.w));
                o1.x = cvtpk(s2.x * bflo(g1.x), s2.y * bfhi(g1.x)); o1.y = cvtpk(s2.z * bflo(g1.y), s2.w * bfhi(g1.y)); o1.z = cvtpk(s3.x * bflo(g1.z), s3.y * bfhi(g1.z)); o1.w = cvtpk(s3.z * bflo(g1.w), s3.w * bfhi(g1.w));
                bf16* op = MIXIN + row * 1024 + 64 * h + 16 * fq; *(v4u*)op = o0; *(v4u*)(op + 8) = o1;
            }
        }
    }
    if (!FINAL) {
#pragma unroll
        for (int ct = 0; ct < 4; ++ct) { const int c = 16 * ct + fr;
            const size_t i16 = (size_t)((b * 2 + D) * NP16 + p16own) * 512 + 64 * h + c; A16[i16] = Ac[ct]; B16[i16] = Hc[ct];
            float Ag[4], Bg[4];
#pragma unroll
            for (int g = 0; g < 4; ++g) { Ag[g] = __shfl(Ac[ct], fr + 16 * g); Bg[g] = __shfl(Hc[ct], fr + 16 * g); }
            float run = 0.f;
#pragma unroll
            for (int gi = 0; gi < 4; ++gi) { const int g = D ? 3 - gi : gi; run = Ag[g] * run + Bg[g]; }
            if (fq == 0) { const size_t idx = (size_t)((b * 2 + D) * NPJ + pj) * 512 + 64 * h + c; AGGA[idx] = (Ag[0] * Ag[1]) * (Ag[2] * Ag[3]); AGGB[idx] = run; } }
    }
}

template <bool FINAL>
__device__ __forceinline__ void rg_run(const Args& a, LAS unsigned char* lds, int l, int rn, int tid, int lane, int wave) {
    const bool is_ctx = rn >= 256; const int bh = is_ctx ? rn - 256 : rn >> 4, b = bh >> 3, h = bh & 7, cgp = is_ctx ? 0 : (rn & 15);
    { const v4u* GWF = (const v4u*)(a.ws + WS_GWF); LAS v4u* GWL = (LAS v4u*)(lds + RG_GW);
#pragma unroll
      for (int i = tid; i < 2048; i += NTHR) { const int d = i >> 10, g = (i >> 9) & 1, rest = i & 511; GWL[i] = GWF[(size_t)((((l * 2 + d) * 2 + g) * 8 + h) * 8) * 64 + rest]; } }
    const int P0f = 4 + 8 * cgp, P0b = 124 - 8 * cgp;
    if (FINAL && !is_ctx) {
        const float* AGGA = (const float*)(a.ws + WS_AGGA); const float* AGGB = (const float*)(a.ws + WS_AGGB); const float* A16 = (const float*)(a.ws + WS_A16); const float* B16 = (const float*)(a.ws + WS_B16);
        const int d = tid >> 8, s = (tid >> 6) & 3, c = tid & 63, P0 = d ? P0b : P0f, lo = (P0 * s) >> 2, hi = (P0 * (s + 1)) >> 2;
        const size_t b16 = (size_t)((b * 2 + d) * NP16 + 4 * P0 + 8 * s) * 512 + 64 * h + c; float ai8[8], bi8[8];
#pragma unroll
        for (int i = 0; i < 8; ++i) { ai8[i] = A16[b16 + (size_t)i * 512]; bi8[i] = B16[b16 + (size_t)i * 512]; }
        const size_t base = (size_t)((b * 2 + d) * NPJ) * 512 + 64 * h + c; float A = 1.f, Bv = 0.f;
#pragma unroll 8
        for (int i = lo; i < hi; ++i) { const float ai = AGGA[base + (size_t)i * 512], bi = AGGB[base + (size_t)i * 512]; Bv = ai * Bv + bi; A *= ai; }
        LAS float* FO = (LAS float*)(lds + RG_FOLD); LAS float* F8 = (LAS float*)(lds + RG_F8); LAS float* CAR = (LAS float*)(lds + RG_CAR);
        FO[((d * 4 + s) * 64 + c) * 2] = A; FO[((d * 4 + s) * 64 + c) * 2 + 1] = Bv;
        float A8 = 1.f, B8 = 0.f;
#pragma unroll
        for (int i = 0; i < 8; ++i) { B8 = ai8[i] * B8 + bi8[i]; A8 *= ai8[i]; }
        F8[((d * 4 + s) * 64 + c) * 2] = A8; F8[((d * 4 + s) * 64 + c) * 2 + 1] = B8;
        __syncthreads();
        float S = 0.f;
#pragma unroll
        for (int s2 = 0; s2 < 4; ++s2) S = FO[((d * 4 + s2) * 64 + c) * 2] * S + FO[((d * 4 + s2) * 64 + c) * 2 + 1];
#pragma unroll
        for (int s2 = 0; s2 < 3; ++s2) if (s2 < s) S = F8[((d * 4 + s2) * 64 + c) * 2] * S + F8[((d * 4 + s2) * 64 + c) * 2 + 1];
#pragma unroll
        for (int i = 0; i < 8; ++i) { CAR[(d * 32 + 8 * s + i) * 64 + c] = S; S = ai8[i] * S + bi8[i]; }
    }
    __syncthreads();
    if (wave < (is_ctx ? 4 : 8)) {
        const int j = is_ctx ? wave : 8 * cgp + wave;
        const int seg_lo = is_ctx ? MLAT + b * CTXL : b * SEQ, seg_hi = seg_lo + (is_ctx ? CTXL : SEQ), r0 = seg_lo + 64 * j;
        const int pjf = is_ctx ? j : 4 + j, pjb = is_ctx ? 3 - j : 131 - j;
        LAS unsigned char* wl = lds + RG_WAVE + wave * RG_WAVE_BYTES;
        rg_sweep<FINAL, 1>(a, lds, wl, l, b, h, r0, seg_lo, seg_hi, pjb, is_ctx, wave, lane);
        rg_sweep<FINAL, 0>(a, lds, wl, l, b, h, r0, seg_lo, seg_hi, pjf, is_ctx, wave, lane);
    }
    __syncthreads();
}

#define RLX_AGENT __ATOMIC_RELAXED, __HIP_MEMORY_SCOPE_AGENT


#define XB_TMO      128
#define XB_XCNT(j)  (256  + 64 * (j))
#define XB_XSUB(j)  (1280 + 64 * (j))
#define XB_XGEN(j)  (2304 + 64 * (j))
#define XB_TOP      3328
#define XB_TOPGEN   3392
#define XCD_BAR_WORDS 3456
#define XB_SPIN_CAP (1u << 18)

__device__ __forceinline__ unsigned xb_ld(unsigned* p)              { return __hip_atomic_load(p, __ATOMIC_RELAXED, __HIP_MEMORY_SCOPE_AGENT); }
__device__ __forceinline__ unsigned xb_add(unsigned* p, unsigned v) { return __hip_atomic_fetch_add(p, v, __ATOMIC_RELAXED, __HIP_MEMORY_SCOPE_AGENT); }
__device__ __forceinline__ unsigned xb_xcc_id() { return (unsigned)__builtin_amdgcn_s_getreg((3 << 11) | 20) & 0xFu; }
#define XB_SPIN(cond, bar) do { unsigned _sp = 0; while (cond) { __builtin_amdgcn_s_sleep(1); \
    if ((++_sp & 255u) == 0u) { if (xb_ld(&(bar)[XB_TMO])) break; if (_sp > XB_SPIN_CAP) { atomicAdd(&(bar)[XB_TMO], 1u); break; } } } } while (0)

struct XcdBarrier {
    unsigned* bar; unsigned x;
    volatile LAS unsigned* st;
};

__device__ __forceinline__ XcdBarrier xcd_barrier_post(unsigned* bar, volatile LAS unsigned* st) {
    XcdBarrier b; b.bar = bar; b.x = xb_xcc_id(); b.st = st;
    if (threadIdx.x == 0) (void)xb_add(&bar[XB_XCNT(b.x)], 1u);
    return b;
}
__device__ __forceinline__ void xcd_barrier_complete(unsigned* bar, unsigned x, unsigned& nloc, unsigned& nx) {
    const unsigned G = gridDim.x * gridDim.y * gridDim.z;
    unsigned sum, cnt, mine, sp = 0u;
    for (;;) {
        sum = 0u; cnt = 0u; mine = 0u;
#pragma unroll
        for (unsigned j = 0; j < 16; ++j) { const unsigned c = xb_ld(&bar[XB_XCNT(j)]); sum += c; cnt += (c > 0u) ? 1u : 0u; mine = (j == x) ? c : mine; }
        if (sum == G) break;
        __builtin_amdgcn_s_sleep(1);
        if ((++sp & 255u) == 0u) { if (xb_ld(&bar[XB_TMO])) break; if (sp > XB_SPIN_CAP) { atomicAdd(&bar[XB_TMO], 1u); break; } }
    }
    nloc = mine > 0u ? mine : 1u; nx = cnt > 0u ? cnt : 1u;
}

__device__ __forceinline__ void xcd_barrier(const XcdBarrier& b) {
    asm volatile("s_waitcnt vmcnt(0)" ::: "memory");
    __syncthreads();
    if (threadIdx.x == 0) {
        unsigned* bar = b.bar;
        __builtin_amdgcn_s_waitcnt(0);
        unsigned nloc = b.st[0], nx = b.st[1];
        if (nloc == 0u) { xcd_barrier_complete(bar, b.x, nloc, nx); b.st[0] = nloc; b.st[1] = nx; }
        const unsigned old = xb_add(&bar[XB_XSUB(b.x)], 1u);
        const unsigned gen = old / nloc;
        if (old + 1u == (gen + 1u) * nloc) {
            __builtin_amdgcn_fence(__ATOMIC_RELEASE, "agent");
            asm volatile("s_waitcnt vmcnt(0)" ::: "memory");
            const unsigned og = xb_add(&bar[XB_TOP], 1u);
            const unsigned tg = og / nx;
            if (og + 1u == (tg + 1u) * nx) xb_add(&bar[XB_TOPGEN], 1u);
            else XB_SPIN(xb_ld(&bar[XB_TOPGEN]) == tg, bar);
            __builtin_amdgcn_fence(__ATOMIC_ACQUIRE, "agent");
            xb_add(&bar[XB_XGEN(b.x)], 1u);
            asm volatile("s_waitcnt vmcnt(0)" ::: "memory");
        } else {
            XB_SPIN(xb_ld(&bar[XB_XGEN(b.x)]) == gen, bar);
            __builtin_amdgcn_fence(__ATOMIC_ACQUIRE, "agent");
            asm volatile("s_waitcnt vmcnt(0)" ::: "memory");
        }
    }
    __syncthreads();
}

__device__ __forceinline__ void layer_phases(int l, const Args& args, LAS unsigned char* lds, const int tid0, const int lo, const int hi, const XcdBarrier& xbar) {
    const int G = gridDim.x; unsigned char* ws = args.ws;
    const int pb = 1 + 5 * l;
#define LAUNDER() int tid = tid0; asm volatile("" : "+v"(tid)); const int lane = tid & 63, wave = __builtin_amdgcn_readfirstlane(tid >> 6); int bx = blockIdx.x; asm volatile("" : "+s"(bx)); (void)lane; (void)wave; (void)bx
#define IN(k) (lo <= (k) && (k) < hi)
#define SEAM(k) do { if (IN(k) && IN((k) + 1)) { xcd_barrier(xbar); } } while (0)
        if (IN(pb)) { LAUNDER(); norm_phase(args, l, lane, wave); }
        SEAM(pb);
        if (IN(pb + 1)) { LAUNDER();
            pg8::Gemm g{(const pg8::bf16_t*)(ws + WS_H), (const pg8::bf16_t*)(ws + WS_BT1) + (size_t)l * NIN * 1024, MROWS, NIN, 1024};
            pg8::StaticOrder S; S.init(MROWS, NIN, G, bx);
            pg8::EpiU E{(pg8::bf16_t*)(ws + WS_U)};
            pg8::gemm_phase<pg8::EpiU, pg8::StaticOrder, true, true>(lds, g, S, E);
        }
        SEAM(pb + 1);
        if (IN(pb + 2)) { LAUNDER();
            const int nrun = (bx >= G - 16) ? 2 : 1;
#pragma unroll 1
            for (int k = 0; k < nrun; ++k) rg_run<false>(args, lds, l, k == 0 ? bx : 256 + (G - 1 - bx), tid, lane, wave);
            const int n_h = 256 + (l == 0 ? 16 : 0), n_conv = 128 + n_h;
            const int GC = G - 16;
            for (int un = bx; un < n_conv && bx < GC; un += GC) {
                if (un < 128) { vconv_unit(args, lds, l, un >> 6, un & 63, tid); }
                else { const int hu = un - 128;
                    if (hu < 256) hconv_unit(args, lds, l, hu * 64, 0, hu * 64, hu * 64 + 64, tid);
                    else { const int cu = hu - 256, cc = cu >> 1, g = cu & 1, bb = cc >> 2; hconv_unit(args, lds, l, MLAT + cc * 64, g, MLAT + bb * CTXL, MLAT + bb * CTXL + CTXL, tid); } }
            }
        }
        SEAM(pb + 2);
        if (IN(pb + 3)) { LAUNDER();
            const int nrun = (l == 0 && bx >= G - 16) ? 2 : 1;
#pragma unroll 1
            for (int k = 0; k < nrun; ++k) rg_run<true>(args, lds, l, k == 0 ? bx : 256 + (G - 1 - bx), tid, lane, wave);
            ln_rows(args, l, (l == 0) ? MROWS : MLAT, lane, wave);
        }
        SEAM(pb + 3);
        if (IN(pb + 4)) { LAUNDER();
            const int M2 = (l == 0) ? MROWS : MLAT;
            pg8::Gemm g{(const pg8::bf16_t*)(ws + WS_MIXIN), (const pg8::bf16_t*)(ws + WS_BT2) + (size_t)l * 1024 * 1024, M2, 1024, 1024};
            pg8::StaticOrder S; S.init(M2, 1024, G, bx);
            pg8::EpiMix E{(pg8::bf16_t*)(ws + WS_MIX), (float*)(ws + WS_SSQ)};
            pg8::gemm_phase<pg8::EpiMix, pg8::StaticOrder, true, true>(lds, g, S, E);
        }
        SEAM(pb + 4);
#undef IN
#undef SEAM
#undef LAUNDER
}

__global__ void __launch_bounds__(NTHR, 2) fwd_megakernel(Args args) {
    extern __shared__ __attribute__((aligned(16))) unsigned char lds_raw[];
    LAS unsigned char* lds = (LAS unsigned char*)lds_raw;
    const int tid = threadIdx.x, lane = tid & 63, wave = __builtin_amdgcn_readfirstlane(tid >> 6);
    const int G = gridDim.x, bx = blockIdx.x;
    unsigned char* ws = args.ws;
    const int lo = args.ph_lo, hi = args.ph_hi;
    if (args.coop == 2) cg::this_grid().sync();
    volatile LAS unsigned* MISC = (volatile LAS unsigned*)(lds + MISC_OFF);
    if (tid < 64) MISC[tid] = 0u;
    __syncthreads();
    XcdBarrier xbar; xbar.bar = (unsigned*)(ws + WS_CTL); xbar.x = 0; xbar.st = nullptr;
    if (args.coop == 1) xbar = xcd_barrier_post((unsigned*)(ws + WS_CTL), MISC + 8);
#define IN(k) (lo <= (k) && (k) < hi)
#define SEAM(k) do { if (IN(k) && IN((k) + 1)) { xcd_barrier(xbar); } } while (0)

    if (IN(0)) { p0_prologue(args, lds, tid, lane, wave); }
    SEAM(0);
#pragma unroll 1
    for (int l = 0; l < 2; ++l) { int lo_ = l; asm volatile("" : "+s"(lo_)); layer_phases(lo_, args, lds, tid, lo, hi, xbar); }
    if (IN(11)) { norm_phase(args, 2, lane, wave); }
#undef IN
#undef SEAM
}

#ifndef MK_PER_PHASE
#define MK_PER_PHASE 0
#endif
extern "C" void kernel_launch(void* const* d_in, const int* in_sizes, int n_in, void* d_out, int out_size, void* d_ws, size_t ws_size, hipStream_t stream) {
    static int grid = 0;
    if (grid == 0) {
        if (n_in != 21 || out_size != MLAT * DM || ws_size < WS_END) { fprintf(stderr, "kernel_launch: unexpected shapes (n_in %d, out %d, ws %zu)\n", n_in, out_size, ws_size); grid = -1; return; }
        int dev = 0, cus = 0, per_cu = 0;
        if (hipGetDevice(&dev) != hipSuccess || hipDeviceGetAttribute(&cus, hipDeviceAttributeMultiprocessorCount, dev) != hipSuccess) { grid = -1; return; }
        if (hipFuncSetAttribute((const void*)fwd_megakernel, hipFuncAttributeMaxDynamicSharedMemorySize, LDS_BYTES) != hipSuccess) { fprintf(stderr, "kernel_launch: hipFuncSetAttribute failed\n"); grid = -1; return; }
        if (hipOccupancyMaxActiveBlocksPerMultiprocessor(&per_cu, (const void*)fwd_megakernel, NTHR, LDS_BYTES) != hipSuccess || per_cu < 1) { fprintf(stderr, "kernel_launch: occupancy query says %d\n", per_cu); per_cu = 1; }
        (void)hipGetLastError();
        grid = cus;
    }
    if (grid < 0) return;
    if (hipMemsetAsync((char*)d_ws + WS_CTL, 0, CTL_ZERO_BYTES, stream) != hipSuccess) { fprintf(stderr, "kernel_launch: memset failed\n"); return; }
    Args a{};
    for (int i = 0; i < 21; ++i) a.in[i] = (const float*)d_in[i];
    a.out = (float*)d_out; a.ws = (unsigned char*)d_ws;
#if MK_PER_PHASE
    for (int ph = 0; ph < 12; ++ph) { a.ph_lo = ph; a.ph_hi = ph + 1; a.coop = 0;
        hipLaunchKernelGGL(fwd_megakernel, dim3(grid), dim3(NTHR), LDS_BYTES, stream, a); }
#else
    a.ph_lo = 0; a.ph_hi = 12; a.coop = 1;
    void* kargs[] = {&a};
    hipError_t e = hipLaunchCooperativeKernel((const void*)fwd_megakernel, dim3(grid), dim3(NTHR), kargs, LDS_BYTES, stream);
    if (e != hipSuccess) fprintf(stderr, "cooperative launch failed: %s (grid %d)\n", hipGetErrorString(e), grid);
#endif
}
```

```cpp
#include <hip/hip_runtime.h>
#include <hip/hip_cooperative_groups.h>
#include <cstdio>
#include <cstdint>
namespace cg = cooperative_groups;
#define MK_PER_PHASE 0
namespace pg8 {
#define PG8_LAS __attribute__((address_space(3)))
typedef unsigned short bf16_t;
typedef short bf16x8 __attribute__((ext_vector_type(8)));
typedef float f32x4 __attribute__((ext_vector_type(4)));
typedef unsigned u32x4 __attribute__((ext_vector_type(4)));
constexpr int BM = 256, BK = 64, HALF = 128, HTB = HALF * BK * 2  , STAGE_BYTES = 8 * HTB, NXCD = 8, WGM = 8;

__host__ __device__ __forceinline__ int lds_byte(int r, int c) { const int st = (r >> 4) * 2 + (c >> 5), rr = r & 15, cc = c & 31, ob = rr * 64 + cc * 2; return st * 1024 + (ob ^ (((ob >> 9) & 1) << 5)); }
__host__ __device__ __forceinline__ void stage_rc(int b, int& R, int& C) { const int st = b / 1024, sb = b % 1024, swz = sb ^ (((sb >> 9) & 1) << 5); R = (st >> 1) * 16 + swz / 64; C = (st & 1) * 32 + (swz % 64) / 2; }
__host__ __device__ __forceinline__ int perm32(int rho) { const int n = rho >> 4, i = rho & 15; return 8 * (i >> 2) + 4 * n + (i & 3); }

struct Unit { int pm, pn; };
struct Gemm { const bf16_t* A; const bf16_t* Bt; int M, N, K; };

struct StaticOrder {
    int nM, nN, nwg, G, c;
    __host__ __device__ void init(int M, int N, int G_, int c_) { nM = M / BM; nN = N / BM; nwg = nM * nN; G = G_; c = c_; }
    __host__ __device__ bool next(int i, Unit& u) const {
        const long L = (long)i * G + c; if (L >= nwg) return false;
        int wgid = (int)L; { const int q = nwg / NXCD, r = nwg % NXCD, xcd = wgid % NXCD, off = wgid / NXCD; wgid = (xcd < r ? xcd * (q + 1) : r * (q + 1) + (xcd - r) * q) + off; }
        const int nig = WGM * nN, gid = wgid / nig, fm = gid * WGM, gsz = (nM - fm) < WGM ? (nM - fm) : WGM;
        u.pm = fm + ((wgid % nig) % gsz); u.pn = (wgid % nig) / gsz; return true;
    }
    __device__ __forceinline__ void a_ready(const Unit&) const {}
    __device__ __forceinline__ void done(const Unit&) const {}
};
__device__ __forceinline__ unsigned cvt_pk_bf16(float lo, float hi) { unsigned r; asm volatile("v_cvt_pk_bf16_f32 %0, %1, %2" : "=v"(r) : "v"(lo), "v"(hi)); return r; }
typedef float f32x2 __attribute__((ext_vector_type(2)));
template <class Epi, class Sched, bool ALIGN_EPI = false, bool SP2 = false>
__device__ __forceinline__ void gemm_phase(PG8_LAS unsigned char* lds, const Gemm g, const Sched& S, const Epi& E) {
    const int tid = threadIdx.x, wid = __builtin_amdgcn_readfirstlane(tid >> 6), lane = tid & 63, wr = wid >> 2, wc = wid & 3, fr = lane & 15, fq = lane >> 4;
    const int K = g.K, nt = K / BK;
    unsigned voffA[2], voffB[2];
#pragma unroll
    for (int i = 0; i < 2; ++i) { int R, C; stage_rc(tid * 16 + i * 8192, R, C); const int Rb = Epi::PERM ? ((R & ~31) + perm32(R & 31)) : R;
        voffA[i] = (unsigned)(R * K + C) * 2u; voffB[i] = (unsigned)(Rb * K + C) * 2u; }
    const size_t kstep = (size_t)(BK * 2);
    const size_t hstep = (size_t)HALF * K * 2;
    const size_t tstep = 2 * hstep;
    const unsigned ldsw = (unsigned)wid * 1024u;
    const int aoff = lds_byte(wr * 64 + fr, fq * 8), boff = lds_byte(wc * 32 + fr, fq * 8);
#define PG8_SA(b, h) (((b) * 2 + (h)) * HTB)
#define PG8_SB(b, h) ((4 + (b) * 2 + (h)) * HTB)
#define PG8_STAGE(bufoff, gbase, voff) do { _Pragma("unroll") for (int _i = 0; _i < 2; ++_i) \
        __builtin_amdgcn_global_load_lds((const unsigned*)((const char*)(gbase) + (voff)[_i]), (PG8_LAS unsigned*)(lds + (bufoff) + ldsw + _i * 8192), 16, 0, 0); } while (0)
#define PG8_LDA(dst, b, h) do { _Pragma("unroll") for (int m = 0; m < 4; ++m) _Pragma("unroll") for (int k = 0; k < 2; ++k) dst[m][k] = *(const PG8_LAS bf16x8*)(lds + PG8_SA(b, h) + aoff + m * 2048 + k * 1024); } while (0)
#define PG8_LDB(dst, b, h) do { _Pragma("unroll") for (int n = 0; n < 2; ++n) _Pragma("unroll") for (int k = 0; k < 2; ++k) dst[n][k] = *(const PG8_LAS bf16x8*)(lds + PG8_SB(b, h) + boff + n * 2048 + k * 1024); } while (0)
#define PG8_MMA(ai, bj, At, Bt) do { __builtin_amdgcn_s_setprio(1); _Pragma("unroll") for (int m = 0; m < 4; ++m) _Pragma("unroll") for (int n = 0; n < 2; ++n) _Pragma("unroll") for (int k = 0; k < 2; ++k) \
        acc[ai][bj][m][n] = __builtin_amdgcn_mfma_f32_16x16x32_bf16(Bt[n][k], At[m][k], acc[ai][bj][m][n], 0, 0, 0); __builtin_amdgcn_s_setprio(0); } while (0)
#define PG8_WAIT_V(n) asm volatile("s_waitcnt vmcnt(" #n ")" ::: "memory")
#define PG8_WAIT_L(n) asm volatile("s_waitcnt lgkmcnt(" #n ")" ::: "memory")
#define PG8_BAR __builtin_amdgcn_s_barrier()
#define PG8_SCHED __builtin_amdgcn_sched_barrier(0)
    Unit cur, nxt; int ui = 0;
    if (!S.next(0, cur)) return;
    f32x4 acc[2][2][4][2];
#pragma unroll
    for (int a = 0; a < 2; ++a)
#pragma unroll
        for (int b = 0; b < 2; ++b)
#pragma unroll
            for (int m = 0; m < 4; ++m)
#pragma unroll
                for (int n = 0; n < 2; ++n) acc[a][b][m][n] = (f32x4){0.f, 0.f, 0.f, 0.f};
    bf16x8 At[4][2], B0[2][2], B1[2][2];
    const char* cA = (const char*)g.A + (size_t)cur.pm * tstep; const char* cB = (const char*)g.Bt + (size_t)cur.pn * tstep;
    S.a_ready(cur);
    if constexpr (SP2) {
        PG8_STAGE(PG8_SB(0, 0), cB, voffB); PG8_STAGE(PG8_SB(0, 1), cB + hstep, voffB); PG8_STAGE(PG8_SA(0, 0), cA, voffA); PG8_STAGE(PG8_SA(0, 1), cA + hstep, voffA);
        if (wr == 1) PG8_BAR;
        PG8_WAIT_V(2); PG8_BAR;
        PG8_STAGE(PG8_SB(1, 0), cB + kstep, voffB); PG8_STAGE(PG8_SA(1, 0), cA + kstep, voffA); PG8_STAGE(PG8_SB(1, 1), cB + hstep + kstep, voffB);
        PG8_WAIT_V(6); PG8_BAR;
    } else {
        PG8_STAGE(PG8_SB(0, 0), cB, voffB); PG8_STAGE(PG8_SA(0, 0), cA, voffA); PG8_STAGE(PG8_SB(0, 1), cB + hstep, voffB); PG8_STAGE(PG8_SA(0, 1), cA + hstep, voffA);
        if (wr == 1) PG8_BAR;
        PG8_WAIT_V(4); PG8_BAR;
        PG8_STAGE(PG8_SB(1, 0), cB + kstep, voffB); PG8_STAGE(PG8_SA(1, 0), cA + kstep, voffA); PG8_STAGE(PG8_SB(1, 1), cB + hstep + kstep, voffB);
        PG8_WAIT_V(6); PG8_BAR;
    }
    for (;;) {
        const bool has_next = S.next(ui + 1, nxt);
        const char* nA = has_next ? (const char*)g.A + (size_t)nxt.pm * tstep : cA; const char* nB = has_next ? (const char*)g.Bt + (size_t)nxt.pn * tstep : cB;
        for (int t = 0; t < nt; t += 2) {
            const bool last = (t == nt - 2);
            const char* a1 = cA + (size_t)(t + 1) * kstep;
            const char* a2 = last ? nA : cA + (size_t)(t + 2) * kstep; const char* b2 = last ? nB : cB + (size_t)(t + 2) * kstep;
            const char* a3 = a2 + kstep; const char* b3 = b2 + kstep;
            if (last && has_next) S.a_ready(nxt);
            if constexpr (SP2) {
            PG8_LDB(B0, 0, 0); PG8_LDB(B1, 0, 1); PG8_SCHED; PG8_LDA(At, 0, 0); PG8_STAGE(PG8_SA(1, 1), a1 + hstep, voffA);
            PG8_WAIT_V(8); PG8_WAIT_L(0); PG8_BAR; PG8_MMA(0, 0, At, B0); PG8_MMA(0, 1, At, B1); PG8_BAR; PG8_SCHED;
            PG8_LDA(At, 0, 1); PG8_STAGE(PG8_SB(0, 0), b2, voffB); PG8_STAGE(PG8_SB(0, 1), b2 + hstep, voffB); PG8_STAGE(PG8_SA(0, 0), a2, voffA);
            PG8_WAIT_V(8); PG8_WAIT_L(0); PG8_BAR; PG8_MMA(1, 0, At, B0); PG8_MMA(1, 1, At, B1); PG8_BAR; PG8_SCHED;
            PG8_LDB(B0, 1, 0); PG8_LDB(B1, 1, 1); PG8_SCHED; PG8_LDA(At, 1, 0); PG8_STAGE(PG8_SA(0, 1), a2 + hstep, voffA);
            PG8_WAIT_V(8); PG8_WAIT_L(0); PG8_BAR; PG8_MMA(0, 0, At, B0); PG8_MMA(0, 1, At, B1); PG8_BAR; PG8_SCHED;
            PG8_LDA(At, 1, 1); PG8_STAGE(PG8_SB(1, 0), b3, voffB); PG8_STAGE(PG8_SB(1, 1), b3 + hstep, voffB); PG8_STAGE(PG8_SA(1, 0), a3, voffA);
            PG8_WAIT_V(8); PG8_WAIT_L(0); PG8_BAR; PG8_MMA(1, 0, At, B0); PG8_MMA(1, 1, At, B1); PG8_BAR; PG8_SCHED;
            } else {
            PG8_LDB(B0, 0, 0); PG8_SCHED; PG8_LDA(At, 0, 0); PG8_STAGE(PG8_SA(1, 1), a1 + hstep, voffA);
            PG8_WAIT_L(8); PG8_BAR; PG8_WAIT_L(0); PG8_MMA(0, 0, At, B0); PG8_BAR; PG8_SCHED;
            PG8_LDB(B1, 0, 1); PG8_STAGE(PG8_SB(0, 0), b2, voffB);
            PG8_BAR; PG8_WAIT_L(0); PG8_MMA(0, 1, At, B1); PG8_BAR;
            PG8_LDA(At, 0, 1); PG8_STAGE(PG8_SA(0, 0), a2, voffA);
            PG8_BAR; PG8_WAIT_L(0); PG8_MMA(1, 0, At, B0); PG8_BAR; PG8_SCHED;
            PG8_STAGE(PG8_SB(0, 1), b2 + hstep, voffB);
            PG8_WAIT_V(6); PG8_BAR; PG8_MMA(1, 1, At, B1); PG8_BAR;
            PG8_LDB(B0, 1, 0); PG8_SCHED; PG8_LDA(At, 1, 0); PG8_STAGE(PG8_SA(0, 1), a2 + hstep, voffA);
            PG8_WAIT_L(8); PG8_BAR; PG8_WAIT_L(0); PG8_MMA(0, 0, At, B0); PG8_BAR; PG8_SCHED;
            PG8_LDB(B1, 1, 1); PG8_STAGE(PG8_SB(1, 0), b3, voffB);
            PG8_BAR; PG8_WAIT_L(0); PG8_MMA(0, 1, At, B1); PG8_BAR;
            PG8_LDA(At, 1, 1); PG8_STAGE(PG8_SA(1, 0), a3, voffA);
            PG8_BAR; PG8_WAIT_L(0); PG8_MMA(1, 0, At, B0); PG8_BAR; PG8_SCHED;
            PG8_STAGE(PG8_SB(1, 1), b3 + hstep, voffB);
            PG8_WAIT_V(6); PG8_BAR; PG8_MMA(1, 1, At, B1); PG8_BAR;
            }
        }
        if constexpr (ALIGN_EPI) { if (wr == 0) PG8_BAR; }
        if constexpr (!Epi::AFTER_DRAIN) { E(acc, cur, wr, wc, fr, fq); S.done(cur); }
        if (!has_next) break;
#pragma unroll
        for (int a = 0; a < 2; ++a)
#pragma unroll
            for (int b = 0; b < 2; ++b)
#pragma unroll
                for (int m = 0; m < 4; ++m)
#pragma unroll
                    for (int n = 0; n < 2; ++n) acc[a][b][m][n] = (f32x4){0.f, 0.f, 0.f, 0.f};
        cur = nxt; cA = nA; cB = nB; ++ui;
        if constexpr (ALIGN_EPI) { if (wr == 1) PG8_BAR; }
    }
    PG8_WAIT_V(0);
    if constexpr (!ALIGN_EPI) { if (wr == 0) PG8_BAR; }
    PG8_BAR;
    if constexpr (Epi::AFTER_DRAIN) { E.fused(acc, cur, wr, wc, fr, fq, lds, wid, lane); S.done(cur); }
#undef PG8_SA
#undef PG8_SB
#undef PG8_STAGE
#undef PG8_LDA
#undef PG8_LDB
#undef PG8_MMA
#undef PG8_WAIT_V
#undef PG8_WAIT_L
#undef PG8_BAR
#undef PG8_SCHED
}
}

constexpr int DM = 1024, NB = 2, SEQ = 8192, CTXL = 256, MLAT = NB * SEQ, MCTX = NB * CTXL, MROWS = MLAT + MCTX;
constexpr int NIN = 2560, NCHUNK = MROWS / 64  , NPJ = 132  ;
constexpr float EPSF = 1e-6f;
constexpr int NWAVES = 8, NTHR = 512;

constexpr size_t MiB = 1u << 20;
constexpr size_t WS_CTL = 0, CTL_ZERO_BYTES = 64 * 1024;
constexpr size_t WS_MOD = 1 * MiB;
constexpr size_t WS_SP8 = 1 * MiB + 128 * 1024;
constexpr size_t WS_GWF = 1 * MiB + 256 * 1024;
constexpr size_t WS_BT1 = 2 * MiB;
constexpr size_t WS_BT2 = 12 * MiB;
constexpr size_t WS_AGGA = 16 * MiB;
constexpr size_t WS_AGGB = 16 * MiB + 1536 * 1024;
constexpr size_t WS_SSQ = 19 * MiB;
constexpr size_t WS_XC1 = 21 * MiB;
constexpr size_t WS_A16 = 23 * MiB;
constexpr size_t WS_B16 = 28 * MiB;
constexpr size_t WS_H = 73 * MiB;
constexpr size_t WS_Y = 56 * MiB;
constexpr size_t WS_MIXIN = 73 * MiB;
constexpr size_t WS_U = 106 * MiB;
constexpr size_t WS_MIX = 189 * MiB;
constexpr size_t WS_END = 255 * MiB;

constexpr int LDS_BYTES = 158720;
constexpr int MISC_OFF = 157696;

#define LAS __attribute__((address_space(3)))
typedef unsigned short bf16;
typedef unsigned v4u __attribute__((ext_vector_type(4)));
typedef unsigned v2u __attribute__((ext_vector_type(2)));
typedef float f32x4 __attribute__((ext_vector_type(4)));
typedef short bf16x8 __attribute__((ext_vector_type(8)));
typedef float f32x2v __attribute__((ext_vector_type(2)));
#define LDS_WAIT() asm volatile("s_waitcnt lgkmcnt(0)" ::: "memory")

__device__ __forceinline__ unsigned f2bf(float f) { unsigned u = __builtin_bit_cast(unsigned, f); return (u + 0x7fffu + ((u >> 16) & 1u)) >> 16; }
__device__ __forceinline__ unsigned pk2(float lo, float hi) { return f2bf(lo) | (f2bf(hi) << 16); }
__device__ __forceinline__ unsigned cvtpk(float lo, float hi) { unsigned r; asm volatile("v_cvt_pk_bf16_f32 %0, %1, %2" : "=v"(r) : "v"(lo), "v"(hi)); return r; }
__device__ __forceinline__ float bflo(unsigned u) { return __builtin_bit_cast(float, u << 16); }
__device__ __forceinline__ float bfhi(unsigned u) { return __builtin_bit_cast(float, u & 0xffff0000u); }
__device__ __forceinline__ float sigmoidf_(float x) { return 1.0f / (1.0f + __expf(-x)); }
__device__ __forceinline__ float siluf_(float x) { return x * __builtin_amdgcn_rcpf(1.0f + __builtin_amdgcn_exp2f(-1.44269504f * x)); }
__device__ __forceinline__ float wave_sum(float v) {
#pragma unroll
    for (int o = 1; o < 64; o <<= 1) v += __shfl_xor(v, o);
    return v;
}

struct Args {
    const float* in[21]; float* out; unsigned char* ws; int ph_lo, ph_hi, coop, pad;
};
enum { I_X = 0, I_C, I_CTX, I_CCTX, I_WMOD, I_BMOD, I_GPRE, I_GPOST, I_WIN, I_CAW, I_CAB, I_WR, I_BR, I_WI, I_BI, I_LAM, I_DWW, I_DWB, I_LNG, I_LNB, I_WOUT };

namespace pg8 {
struct EpiU {
    static constexpr bool PERM = true, AFTER_DRAIN = false;
    bf16_t* O;
    __device__ __forceinline__ void operator()(const f32x4 (&acc)[2][2][4][2], const Unit& u, int wr, int wc, int fr, int fq) const {
        const int row0 = u.pm * BM + wr * 64 + fr;
        if (u.pn >= 4 && u.pn < 8) {
            const int col0 = 1024 + 128 * (u.pn - 4) + wc * 32 + 8 * fq;
#pragma unroll
            for (int ai = 0; ai < 2; ++ai)
#pragma unroll
                for (int m = 0; m < 4; ++m) { f32x4 v0 = acc[ai][0][m][0], v1 = acc[ai][0][m][1]; const f32x4 g0 = acc[ai][1][m][0], g1 = acc[ai][1][m][1];
#pragma unroll
                    for (int e = 0; e < 4; ++e) { v0[e] = v0[e] * __builtin_amdgcn_rcpf(1.0f + __builtin_amdgcn_exp2f(-1.44269504f * g0[e])); v1[e] = v1[e] * __builtin_amdgcn_rcpf(1.0f + __builtin_amdgcn_exp2f(-1.44269504f * g1[e])); }
                    u32x4 w; w.x = cvt_pk_bf16(v0[0], v0[1]); w.y = cvt_pk_bf16(v0[2], v0[3]); w.z = cvt_pk_bf16(v1[0], v1[1]); w.w = cvt_pk_bf16(v1[2], v1[3]);
                    *(u32x4*)(O + (size_t)(row0 + ai * HALF + m * 16) * 2560 + col0) = w; }
            return;
        }
        const int col0 = u.pn * BM + wc * 32 + 8 * fq;
        const bool act = (u.pn == 2 || u.pn == 3 || u.pn >= 8);
#pragma unroll
        for (int ai = 0; ai < 2; ++ai)
#pragma unroll
            for (int m = 0; m < 4; ++m) { bf16_t* rowp = O + (size_t)(row0 + ai * HALF + m * 16) * 2560 + col0;
#pragma unroll
                for (int bj = 0; bj < 2; ++bj) { f32x4 v0 = acc[ai][bj][m][0], v1 = acc[ai][bj][m][1];
                    if (act) {
#pragma unroll
                        for (int e = 0; e < 4; ++e) { v0[e] = v0[e] * __builtin_amdgcn_rcpf(1.0f + __builtin_amdgcn_exp2f(-1.44269504f * v0[e])); v1[e] = v1[e] * __builtin_amdgcn_rcpf(1.0f + __builtin_amdgcn_exp2f(-1.44269504f * v1[e])); }
                    }
                    u32x4 w; w.x = cvt_pk_bf16(v0[0], v0[1]); w.y = cvt_pk_bf16(v0[2], v0[3]); w.z = cvt_pk_bf16(v1[0], v1[1]); w.w = cvt_pk_bf16(v1[2], v1[3]);
                    *(u32x4*)(rowp + bj * HALF) = w; } }
    }
};
struct EpiMix {
    static constexpr bool PERM = true, AFTER_DRAIN = false;
    bf16_t* O; float* ssq;
    __device__ __forceinline__ void operator()(const f32x4 (&acc)[2][2][4][2], const Unit& u, int wr, int wc, int fr, int fq) const {
        const int col0 = u.pn * BM + wc * 32 + 8 * fq;
#pragma unroll
        for (int ai = 0; ai < 2; ++ai)
#pragma unroll
            for (int m = 0; m < 4; ++m) { const int r = u.pm * BM + ai * HALF + wr * 64 + m * 16 + fr; bf16_t* rowp = O + (size_t)r * 1024 + col0; float s = 0.f;
#pragma unroll
                for (int bj = 0; bj < 2; ++bj) { const f32x4 v0 = acc[ai][bj][m][0], v1 = acc[ai][bj][m][1];
                    s += ((v0[0] * v0[0] + v0[1] * v0[1]) + (v0[2] * v0[2] + v0[3] * v0[3])) + ((v1[0] * v1[0] + v1[1] * v1[1]) + (v1[2] * v1[2] + v1[3] * v1[3]));
                    u32x4 w; w.x = cvt_pk_bf16(v0[0], v0[1]); w.y = cvt_pk_bf16(v0[2], v0[3]); w.z = cvt_pk_bf16(v1[0], v1[1]); w.w = cvt_pk_bf16(v1[2], v1[3]);
                    *(u32x4*)(rowp + bj * HALF) = w; }
                s += __shfl_xor(s, 16); s += __shfl_xor(s, 32);
                if (fq == 0) ssq[(size_t)r * 16 + u.pn * 4 + wc] = s; }
    }
};
}

__device__ __forceinline__ void p0_transpose_item(const float* W, int K, int N, bf16* WT, LAS float* scr, int item, int lane, bool glu_remap) {
    const int nblk = N / 32, kb = item / nblk, nb = item % nblk, k0 = 64 * kb, n0 = 32 * nb;
    int nd = n0;
    if (glu_remap) { if (n0 >= 1024 && n0 < 1536) nd = 1024 + 256 * ((n0 - 1024) >> 7) + ((n0 - 1024) & 127); else if (n0 >= 1536 && n0 < 2048) nd = 1024 + 256 * ((n0 - 1536) >> 7) + 128 + ((n0 - 1536) & 127); }
#pragma unroll 8
    for (int i = 0; i < 32; ++i) { const int kk = 2 * i + (lane >> 5); scr[kk * 33 + (lane & 31)] = W[(size_t)(k0 + kk) * N + n0 + (lane & 31)]; }
    LDS_WAIT(); asm volatile("" ::: "memory");
    const int c = lane & 7;
#pragma unroll
    for (int j = 0; j < 4; ++j) { const int n = (lane >> 3) + 8 * j; const LAS float* s = scr + (8 * c) * 33 + n;
        v4u o; o.x = pk2(s[0 * 33], s[1 * 33]); o.y = pk2(s[2 * 33], s[3 * 33]); o.z = pk2(s[4 * 33], s[5 * 33]); o.w = pk2(s[6 * 33], s[7 * 33]);
        *(v4u*)(WT + (size_t)(nd + n) * K + k0 + 8 * c) = o; }
    LDS_WAIT(); asm volatile("" ::: "memory");
}

__device__ __forceinline__ void p0_prologue(const Args& a, LAS unsigned char* lds, int tid, int lane, int wave) {
    const int G = gridDim.x, bx = blockIdx.x;
    unsigned char* ws = a.ws;
    {
        LAS float* part = (LAS float*)lds;
        float* MOD = (float*)(ws + WS_MOD);
        const float* c = a.in[I_C]; const float* cctx = a.in[I_CCTX];
        for (int un = bx; un < 192; un += G) {
            const int l = un / 96, n0 = (un % 96) * 32, cq = tid & 7, ks = tid >> 3;
            const float* wm = a.in[I_WMOD] + (size_t)l * 1024 * 3072 + n0 + cq * 4;
            f32x4 acc0 = {0.f, 0.f, 0.f, 0.f}, acc1 = acc0, acc2 = acc0;
#pragma unroll 4
            for (int kk = 0; kk < 16; ++kk) { const int k = ks * 16 + kk; const f32x4 w = *(const f32x4*)(wm + (size_t)k * 3072);
                const float a0 = siluf_(c[k]), a1 = siluf_(c[1024 + k]), a2 = siluf_(cctx[k]);
                acc0 += w * a0; acc1 += w * a1; acc2 += w * a2; }
            *(LAS f32x4*)(part + (0 * 64 + ks) * 32 + cq * 4) = acc0;
            *(LAS f32x4*)(part + (1 * 64 + ks) * 32 + cq * 4) = acc1;
            *(LAS f32x4*)(part + (2 * 64 + ks) * 32 + cq * 4) = acc2;
            __syncthreads();
            if (tid < 96) { const int v = tid >> 5, col = tid & 31; float s = a.in[I_BMOD][l * 3072 + n0 + col];
                for (int k2 = 0; k2 < 64; ++k2) s += part[(v * 64 + k2) * 32 + col];
                MOD[(l * 3 + v) * 3072 + n0 + col] = s; }
            __syncthreads();
        }
    }
    { float* SP8 = (float*)(ws + WS_SP8); for (int idx = bx * NTHR + tid; idx < 2048; idx += G * NTHR) SP8[idx] = -8.0f * log1pf(__expf(-a.in[I_LAM][idx])); }
    {
        v4u* GWF = (v4u*)(ws + WS_GWF);
        for (int idx = bx * NTHR + tid; idx < 32768; idx += G * NTHR) {
            const int ln = idx & 63, kk = (idx >> 6) & 1, ct = (idx >> 7) & 3, h = (idx >> 9) & 7, g = (idx >> 12) & 1, d = (idx >> 13) & 1, l = idx >> 14;
            const float* W = (g == 0 ? a.in[I_WR] : a.in[I_WI]) + (size_t)(((l * 2 + d) * 8 + h) * 64) * 64;
            const int k0 = 32 * kk + 8 * (ln >> 4), col = 16 * ct + (ln & 15);
            float e[8];
#pragma unroll
            for (int j = 0; j < 8; ++j) e[j] = W[(k0 + j) * 64 + col];
            v4u o; o.x = pk2(e[0], e[1]); o.y = pk2(e[2], e[3]); o.z = pk2(e[4], e[5]); o.w = pk2(e[6], e[7]);
            GWF[idx] = o;
        }
    }
    {
        LAS float* scr = (LAS float*)(lds + wave * 16384);
        const int gw = bx * NWAVES + wave, NGW = G * NWAVES;
        constexpr int I_1 = (1024 / 64) * (NIN / 32), I_2 = (1024 / 64) * (1024 / 32), NITEMS = 2 * (I_1 + I_2);
        bf16* BT1 = (bf16*)(ws + WS_BT1); bf16* BT2 = (bf16*)(ws + WS_BT2);
        for (int it = gw; it < NITEMS; it += NGW) {
            int r = it;
            if (r < I_1) { p0_transpose_item(a.in[I_WIN], 1024, NIN, BT1, scr, r, lane, true); continue; } r -= I_1;
            if (r < I_1) { p0_transpose_item(a.in[I_WIN] + (size_t)1024 * NIN, 1024, NIN, BT1 + (size_t)NIN * 1024, scr, r, lane, true); continue; } r -= I_1;
            if (r < I_2) { p0_transpose_item(a.in[I_WOUT], 1024, 1024, BT2, scr, r, lane, false); continue; } r -= I_2;
            p0_transpose_item(a.in[I_WOUT] + (size_t)1024 * 1024, 1024, 1024, BT2 + (size_t)1024 * 1024, scr, r, lane, false);
        }
    }
}

__device__ __forceinline__ void norm_phase(const Args& a, int mode, int lane, int wave) {
    unsigned char* ws = a.ws;
    const float* MOD = (const float*)(ws + WS_MOD); const bf16* MIX = (const bf16*)(ws + WS_MIX); const float* SSQ = (const float*)(ws + WS_SSQ);
    float* XC1 = (float*)(ws + WS_XC1); bf16* H = (bf16*)(ws + WS_H);
    const int gw = blockIdx.x * NWAVES + wave, NGW = gridDim.x * NWAVES;
    const int nrows = (mode == 2) ? MLAT : MROWS, lu = (mode == 1) ? 0 : 1, ln = (mode == 0) ? 0 : 1;
    for (int row = gw; row < nrows; row += NGW) {
        const int vsel = row < MLAT ? (row >> 13) : 2;
        const float* src;
        if (mode == 2) src = a.out + (size_t)row * 1024;
        else src = row < MLAT ? a.in[I_X] + (size_t)row * 1024 : a.in[I_CTX] + (size_t)(row - MLAT) * 1024;
        f32x4 v[4];
#pragma unroll
        for (int j = 0; j < 4; ++j) v[j] = *((const f32x4*)src + lane + 64 * j);
        if (mode >= 1) {
            const float sp = lane < 16 ? SSQ[(size_t)row * 16 + lane] : 0.f;
            const float rstd = rsqrtf(wave_sum(sp) * (1.0f / 1024.0f) + EPSF);
            const float* gate = MOD + (lu * 3 + vsel) * 3072 + 2048; const float* gp = a.in[I_GPOST] + lu * 1024;
#pragma unroll
            for (int j = 0; j < 4; ++j) { const v2u mq = *((const v2u*)(MIX + (size_t)row * 1024) + lane + 64 * j); const f32x4 mx = {bflo(mq.x), bfhi(mq.x), bflo(mq.y), bfhi(mq.y)};
                const f32x4 gt = *((const f32x4*)gate + lane + 64 * j), gv = *((const f32x4*)gp + lane + 64 * j);
                v[j] += gt * (mx * rstd * gv); }
            float* dst = row < MLAT ? a.out + (size_t)row * 1024 : XC1 + (size_t)(row - MLAT) * 1024;
#pragma unroll
            for (int j = 0; j < 4; ++j) *((f32x4*)dst + lane + 64 * j) = v[j];
        }
        if (mode <= 1) {
            float s = 0.f;
#pragma unroll
            for (int j = 0; j < 4; ++j) s += (v[j].x * v[j].x + v[j].y * v[j].y) + (v[j].z * v[j].z + v[j].w * v[j].w);
            const float r = rsqrtf(wave_sum(s) * (1.0f / 1024.0f) + EPSF);
            const float* shift = MOD + (ln * 3 + vsel) * 3072; const float* scale = shift + 1024; const float* gpre = a.in[I_GPRE] + ln * 1024;
            v2u* o8 = (v2u*)(H + (size_t)row * 1024);
#pragma unroll
            for (int j = 0; j < 4; ++j) { const f32x4 sh = *((const f32x4*)shift + lane + 64 * j), sc = *((const f32x4*)scale + lane + 64 * j), gv = *((const f32x4*)gpre + lane + 64 * j);
                const f32x4 hv = v[j] * r * gv * (sc + 1.0f) + sh;
                v2u w; w.x = pk2(hv.x, hv.y); w.y = pk2(hv.z, hv.w); o8[lane + 64 * j] = w; }
        }
    }
}

__device__ __forceinline__ void conv16(const LAS unsigned* vt, const float (&w0)[31], const float (&w1)[31], float b0, float b1, bf16* ybase, size_t ystride) {
#pragma unroll 1
    for (int tq = 0; tq < 4; ++tq) {
        const LAS unsigned* vq = vt + tq * 4 * 128;
        float a0[4], a1[4];
#pragma unroll
        for (int t = 0; t < 4; ++t) { a0[t] = b0; a1[t] = b1; }
#pragma unroll
        for (int rr = 0; rr < 34; ++rr) { const unsigned u = vq[rr * 128]; const float lo = bflo(u), hi = bfhi(u);
#pragma unroll
            for (int t = 0; t < 4; ++t) { const int k = rr - t; if (k >= 0 && k < 31) { a0[t] += w0[k] * lo; a1[t] += w1[k] * hi; } }
            if ((rr & 7) == 7) asm volatile("" ::: "memory"); }
#pragma unroll
        for (int t = 0; t < 4; ++t) *(unsigned*)(ybase + (size_t)(tq * 4 + t) * ystride) = cvtpk(a0[t], a1[t]);
    }
}
__device__ __forceinline__ v4u glu8(const v4u vq, const v4u gq) {
    v4u o;
    o.x = pk2(bflo(vq.x) * sigmoidf_(bflo(gq.x)), bfhi(vq.x) * sigmoidf_(bfhi(gq.x)));
    o.y = pk2(bflo(vq.y) * sigmoidf_(bflo(gq.y)), bfhi(vq.y) * sigmoidf_(bfhi(gq.y)));
    o.z = pk2(bflo(vq.z) * sigmoidf_(bflo(gq.z)), bfhi(vq.z) * sigmoidf_(bfhi(gq.z)));
    o.w = pk2(bflo(vq.w) * sigmoidf_(bflo(gq.w)), bfhi(vq.w) * sigmoidf_(bfhi(gq.w)));
    return o;
}
__device__ __forceinline__ void hconv_unit(const Args& a, LAS unsigned char* lds, int l, int r0, int g, int vlo, int vhi, int tid) {
    const bf16* U = (const bf16*)(a.ws + WS_U); bf16* Y = (bf16*)(a.ws + WS_Y);
    LAS unsigned* VT = (LAS unsigned*)lds;
    {
        v4u vq[6];
#pragma unroll
        for (int it = 0; it < 6; ++it) { const int i = tid + it * NTHR, rr = i >> 5, ch = i & 31, row = r0 - 15 + rr; const bool ok = i < 94 * 32 && row >= vlo && row < vhi;
            vq[it] = *(const v4u*)(U + (size_t)(ok ? row : r0) * NIN + 1024 + g * 256 + ch * 8); }
#pragma unroll
        for (int it = 0; it < 6; ++it) { const int i = tid + it * NTHR, rr = i >> 5, ch = i & 31, row = r0 - 15 + rr; const bool ok = row >= vlo && row < vhi;
            if (i < 94 * 32) { const v4u z = {0u, 0u, 0u, 0u}; *(LAS v4u*)(VT + rr * 128 + ch * 4) = ok ? vq[it] : z; } }
    }
    __syncthreads();
    int p = tid & 127; asm volatile("" : "+v"(p));
    const int tg = tid >> 7, c0 = g * 256 + 2 * p;
    float w0[31], w1[31];
#pragma unroll
    for (int k = 0; k < 31; ++k) { const float2 w = *(const float2*)(a.in[I_DWW] + (size_t)(l * 31 + k) * 512 + c0); w0[k] = w.x; w1[k] = w.y; }
    const float2 bb = *(const float2*)(a.in[I_DWB] + l * 512 + c0);
    conv16(VT + (tg * 16) * 128 + p, w0, w1, bb.x, bb.y, Y + (size_t)(r0 + tg * 16) * 512 + c0, 512);
    __syncthreads();
}
__device__ __forceinline__ void vconv_unit(const Args& a, LAS unsigned char* lds, int l, int b, int w, int tid) {
    const bf16* U = (const bf16*)(a.ws + WS_U); bf16* Y = (bf16*)(a.ws + WS_Y);
    LAS unsigned* VT = (LAS unsigned*)lds;
#pragma unroll 1
    for (int hb = 0; hb < 2; ++hb) {
        v4u vq[5];
#pragma unroll
        for (int it = 0; it < 5; ++it) { const int i = tid + (hb * 5 + it) * NTHR, rr = i >> 5, ch = i & 31, gr = rr - 15; const bool ok = i < 158 * 32 && gr >= 0 && gr < 128;
            vq[it] = *(const v4u*)(U + (size_t)(b * SEQ + (ok ? gr : 0) * 64 + w) * NIN + 1024 + 256 + ch * 8); }
#pragma unroll
        for (int it = 0; it < 5; ++it) { const int i = tid + (hb * 5 + it) * NTHR, rr = i >> 5, ch = i & 31, gr = rr - 15; const bool ok = gr >= 0 && gr < 128;
            if (i < 158 * 32) { const v4u z = {0u, 0u, 0u, 0u}; *(LAS v4u*)(VT + rr * 128 + ch * 4) = ok ? vq[it] : z; } }
    }
    __syncthreads();
    int p = tid & 127; asm volatile("" : "+v"(p));
    const int tg = tid >> 7, c0 = 256 + 2 * p;
    float w0[31], w1[31];
#pragma unroll
    for (int k = 0; k < 31; ++k) { const float2 wv = *(const float2*)(a.in[I_DWW] + (size_t)(l * 31 + k) * 512 + c0); w0[k] = wv.x; w1[k] = wv.y; }
    const float2 bb = *(const float2*)(a.in[I_DWB] + l * 512 + c0);
#pragma unroll 1
    for (int half = 0; half < 2; ++half) {
        const int tb = tg * 32 + half * 16;
        conv16(VT + tb * 128 + p, w0, w1, bb.x, bb.y, Y + (size_t)(b * SEQ + tb * 64 + w) * 512 + c0, (size_t)64 * 512);
    }
    __syncthreads();
}
__device__ __forceinline__ void ln_rows(const Args& a, int l, int nrows, int lane, int wave) {
    const bf16* U = (const bf16*)(a.ws + WS_U); const bf16* Y = (const bf16*)(a.ws + WS_Y); bf16* MIXIN = (bf16*)(a.ws + WS_MIXIN);
    const int gw = blockIdx.x * NWAVES + wave, NGW = gridDim.x * NWAVES, c0 = lane * 8;
    float lg[8], lb[8];
#pragma unroll
    for (int e = 0; e < 8; ++e) { lg[e] = a.in[I_LNG][l * 512 + c0 + e]; lb[e] = a.in[I_LNB][l * 512 + c0 + e]; }
    for (int row = gw; row < nrows; row += NGW) {
        const v4u yq = *(const v4u*)(Y + (size_t)row * 512 + c0); const v4u gq = *(const v4u*)(U + (size_t)row * NIN + 2048 + c0);
        float y[8] = {bflo(yq.x), bfhi(yq.x), bflo(yq.y), bfhi(yq.y), bflo(yq.z), bfhi(yq.z), bflo(yq.w), bfhi(yq.w)};
        const float gt[8] = {bflo(gq.x), bfhi(gq.x), bflo(gq.y), bfhi(gq.y), bflo(gq.z), bfhi(gq.z), bflo(gq.w), bfhi(gq.w)};
        float s = 0.f;
#pragma unroll
        for (int e = 0; e < 8; ++e) s += y[e];
        const float mean = wave_sum(s) * (1.0f / 512.0f); float q = 0.f;
#pragma unroll
        for (int e = 0; e < 8; ++e) { y[e] -= mean; q += y[e] * y[e]; }
        const float rstd = rsqrtf(wave_sum(q) * (1.0f / 512.0f) + EPSF);
        float o[8];
#pragma unroll
        for (int e = 0; e < 8; ++e) o[e] = siluf_(y[e] * rstd * lg[e] + lb[e]) * gt[e];
        v4u w; w.x = pk2(o[0], o[1]); w.y = pk2(o[2], o[3]); w.z = pk2(o[4], o[5]); w.w = pk2(o[6], o[7]);
        *(v4u*)(MIXIN + (size_t)row * 1024 + 512 + c0) = w;
    }
}

constexpr int RG_GW = 0, RG_FOLD = 32768, RG_F8 = 36864, RG_CAR = 40960, RG_WAVE = 57344, RG_WAVE_BYTES = 12544;
constexpr int NP16 = 4 * NPJ;
__device__ __forceinline__ float fsig(float x) { return __builtin_amdgcn_rcpf(1.0f + __expf(-x)); }

template <bool FINAL, int D>
__device__ __forceinline__ void rg_sweep(const Args& a, LAS unsigned char* lds, LAS unsigned char* wl, int l, int b, int h, int r0, int seg_lo, int seg_hi, int pj, bool is_ctx, int w, int lane) {
    const bf16* U = (const bf16*)(a.ws + WS_U); bf16* MIXIN = (bf16*)(a.ws + WS_MIXIN);
    float* AGGA = (float*)(a.ws + WS_AGGA); float* AGGB = (float*)(a.ws + WS_AGGB); float* A16 = (float*)(a.ws + WS_A16); float* B16 = (float*)(a.ws + WS_B16);
    LAS float* VCW = (LAS float*)wl; LAS unsigned* HBW = (LAS unsigned*)(wl + 4352);
    const LAS v4u* GWL = (const LAS v4u*)(lds + RG_GW) + (D * 2) * 8 * 64 + lane;
    const LAS float* CAR = (const LAS float*)(lds + RG_CAR);
    const int fr = lane & 15, fq = lane >> 4, cp = lane & 31, rh = lane >> 5;
    float2 cw[4];
#pragma unroll
    for (int k = 0; k < 4; ++k) cw[k] = *(const float2*)(a.in[I_CAW] + (size_t)((l * 2 + D) * 4 + k) * 512 + 64 * h + 2 * cp);
    const float2 cbv = *(const float2*)(a.in[I_CAB] + (l * 2 + D) * 512 + 64 * h + 2 * cp);
    float brv[4], biv[4], sp8[4], Hc[4], Ac[4];
    const int p16own = 4 * pj + (D ? 3 - fq : fq);
#pragma unroll
    for (int ct = 0; ct < 4; ++ct) { const int c = 16 * ct + fr, pidx = (l * 2 + D) * 512 + 64 * h + c;
        brv[ct] = a.in[I_BR][pidx]; biv[ct] = a.in[I_BI][pidx]; sp8[ct] = ((const float*)(a.ws + WS_SP8))[pidx];
        Hc[ct] = 0.f; Ac[ct] = 1.f;
        if (FINAL) {
            if (is_ctx) { const size_t base = (size_t)((b * 2 + D) * NP16) * 512 + 64 * h + c; float S = 0.f;
                for (int i = 0; i < p16own; ++i) S = A16[base + (size_t)i * 512] * S + B16[base + (size_t)i * 512];
                Hc[ct] = S; }
            else Hc[ct] = CAR[(D * 32 + (D ? 31 - (4 * w + fq) : 4 * w + fq)) * 64 + c];
        } }
    const bf16* ub = U + 64 * h + 2 * cp;
    unsigned Wd[2][7], nx[2][4];
#pragma unroll
    for (int q = 0; q < 2; ++q) { const int g = 2 * rh + q;
#pragma unroll
        for (int j = 0; j < 3; ++j) { const int row = r0 + 16 * g + (D ? 16 + j : j - 3); const bool ok = row >= seg_lo && row < seg_hi; const int rc = ok ? row : r0;
            const unsigned v = *(const unsigned*)(ub + (size_t)rc * NIN); Wd[q][D ? j : 4 + j] = ok ? v : 0u; }
#pragma unroll
        for (int j = 0; j < 4; ++j) nx[q][j] = *(const unsigned*)(ub + (size_t)(r0 + 16 * g + 4 * (D ? 3 : 0) + j) * NIN); }
#pragma unroll 1
    for (int ti = 0; ti < 4; ++ti) {
        const int tile = D ? 3 - ti : ti;
        int zo = 0; asm volatile("" : "+v"(zo));
        const LAS v4u* GWLt = GWL + zo;
        v4u g0 = {0u, 0u, 0u, 0u}, g1 = g0; size_t orow = 0;
        if (FINAL && D == 0) { orow = (size_t)(r0 + 16 * (fr >> 2) + 4 * tile + (fr & 3)); const bf16* gp = U + orow * NIN + 512 + 64 * h + 16 * fq; g0 = *(const v4u*)gp; g1 = *(const v4u*)(gp + 8); }
#pragma unroll
        for (int q = 0; q < 2; ++q) {
            if (D == 0) { Wd[q][0] = Wd[q][4]; Wd[q][1] = Wd[q][5]; Wd[q][2] = Wd[q][6]; Wd[q][3] = nx[q][0]; Wd[q][4] = nx[q][1]; Wd[q][5] = nx[q][2]; Wd[q][6] = nx[q][3]; }
            else { Wd[q][4] = Wd[q][0]; Wd[q][5] = Wd[q][1]; Wd[q][6] = Wd[q][2]; Wd[q][0] = nx[q][0]; Wd[q][1] = nx[q][1]; Wd[q][2] = nx[q][2]; Wd[q][3] = nx[q][3]; } }
        if (ti < 3) { const int tn = D ? 2 - ti : ti + 1;
#pragma unroll
            for (int q = 0; q < 2; ++q)
#pragma unroll
                for (int j = 0; j < 4; ++j) nx[q][j] = *(const unsigned*)(ub + (size_t)(r0 + 16 * (2 * rh + q) + 4 * tn + j) * NIN); }
#pragma unroll
        for (int q = 0; q < 2; ++q)
#pragma unroll
            for (int jj = 0; jj < 4; ++jj) { float v0 = cbv.x, v1 = cbv.y;
#pragma unroll
                for (int k = 0; k < 4; ++k) { const unsigned u = Wd[q][jj + k]; v0 += cw[k].x * bflo(u); v1 += cw[k].y * bfhi(u); }
                *(LAS f32x2v*)(VCW + (4 * (2 * rh + q) + jj) * 68 + 2 * cp) = (f32x2v){v0, v1}; }
        bf16x8 af[2];
#pragma unroll
        for (int kk = 0; kk < 2; ++kk) { const LAS float* vp = VCW + fr * 68 + 32 * kk + 8 * fq; const f32x4 x0 = *(const LAS f32x4*)vp, x1 = *(const LAS f32x4*)(vp + 4);
            v4u pk; pk.x = cvtpk(x0.x, x0.y); pk.y = cvtpk(x0.z, x0.w); pk.z = cvtpk(x1.x, x1.y); pk.w = cvtpk(x1.z, x1.w); af[kk] = __builtin_bit_cast(bf16x8, pk); }
        float vcv[4][4];
#pragma unroll
        for (int ct = 0; ct < 4; ++ct)
#pragma unroll
            for (int jj = 0; jj < 4; ++jj) vcv[ct][jj] = VCW[(4 * fq + jj) * 68 + 16 * ct + fr];
        f32x4 accr[4], acci[4];
#pragma unroll
        for (int ct = 0; ct < 4; ++ct) { accr[ct] = (f32x4){0.f, 0.f, 0.f, 0.f}; acci[ct] = accr[ct];
#pragma unroll
            for (int kk = 0; kk < 2; ++kk) { const bf16x8 br = __builtin_bit_cast(bf16x8, GWLt[(ct * 2 + kk) * 64]), bi = __builtin_bit_cast(bf16x8, GWLt[(8 + ct * 2 + kk) * 64]);
                accr[ct] = __builtin_amdgcn_mfma_f32_16x16x32_bf16(af[kk], br, accr[ct], 0, 0, 0); acci[ct] = __builtin_amdgcn_mfma_f32_16x16x32_bf16(af[kk], bi, acci[ct], 0, 0, 0); } }
        float hsum[4][4];
#pragma unroll
        for (int ct = 0; ct < 4; ++ct) { float aa[4], bb[4];
            const float nbr = -1.44269504f * brv[ct], nbi = -1.44269504f * biv[ct];
#pragma unroll
            for (int p = 0; p < 2; ++p) {
                f32x2v xr = (f32x2v){accr[ct][2 * p], accr[ct][2 * p + 1]} * -1.44269504f + nbr, xi = (f32x2v){acci[ct][2 * p], acci[ct][2 * p + 1]} * -1.44269504f + nbi;
                xr = __builtin_elementwise_min(xr, (f32x2v){60.f, 60.f}); xi = __builtin_elementwise_min(xi, (f32x2v){60.f, 60.f});
                f32x2v d1, d2; d1.x = __builtin_amdgcn_exp2f(xr.x); d1.y = __builtin_amdgcn_exp2f(xr.y); d2.x = __builtin_amdgcn_exp2f(xi.x); d2.y = __builtin_amdgcn_exp2f(xi.y);
                d1 = d1 + 1.0f; d2 = d2 + 1.0f; const f32x2v m = d1 * d2; f32x2v inv; inv.x = __builtin_amdgcn_rcpf(m.x); inv.y = __builtin_amdgcn_rcpf(m.y);
                const f32x2v r = d2 * inv, ig = d1 * inv, la = r * sp8[ct], x2 = la + la, le = la * 1.44269504f;
                const f32x2v pom = -x2 * (x2 * (x2 * (x2 * (x2 * 0.0083333338f + 0.041666668f) + 0.16666667f) + 0.5f) + 1.0f);
                f32x2v av; av.x = __builtin_amdgcn_exp2f(le.x); av.y = __builtin_amdgcn_exp2f(le.y);
                const f32x2v o2 = 1.0f - av * av; f32x2v om; om.x = x2.x > -0.25f ? pom.x : o2.x; om.y = x2.y > -0.25f ? pom.y : o2.y;
                om = __builtin_elementwise_max(om, (f32x2v){0.f, 0.f});
                f32x2v sq; sq.x = __builtin_amdgcn_sqrtf(om.x); sq.y = __builtin_amdgcn_sqrtf(om.y);
                const f32x2v bv = sq * (ig * (f32x2v){vcv[ct][2 * p], vcv[ct][2 * p + 1]});
                aa[2 * p] = av.x; aa[2 * p + 1] = av.y; bb[2 * p] = bv.x; bb[2 * p + 1] = bv.y; }
            float hh = Hc[ct], A4 = 1.f;
#pragma unroll
            for (int ji = 0; ji < 4; ++ji) { const int jj = D ? 3 - ji : ji; hh = aa[jj] * hh + bb[jj]; A4 *= aa[jj]; hsum[ct][jj] = hh; }
            Hc[ct] = hh; if (!FINAL) Ac[ct] *= A4; }
        if (FINAL) {
            if (D == 1) {
#pragma unroll
                for (int ct = 0; ct < 4; ++ct)
#pragma unroll
                    for (int jp = 0; jp < 2; ++jp) HBW[(tile * 8 + ct * 2 + jp) * 64 + lane] = cvtpk(hsum[ct][2 * jp], hsum[ct][2 * jp + 1]);
            } else {
#pragma unroll
                for (int ct = 0; ct < 4; ++ct)
#pragma unroll
                    for (int jp = 0; jp < 2; ++jp) { const unsigned hb = HBW[(tile * 8 + ct * 2 + jp) * 64 + lane];
                        VCW[(4 * fq + 2 * jp) * 68 + 16 * ct + fr] = hsum[ct][2 * jp] + bflo(hb); VCW[(4 * fq + 2 * jp + 1) * 68 + 16 * ct + fr] = hsum[ct][2 * jp + 1] + bfhi(hb); }
                const size_t row = orow;
                const f32x4 s0 = *(const LAS f32x4*)(VCW + fr * 68 + 16 * fq), s1 = *(const LAS f32x4*)(VCW + fr * 68 + 16 * fq + 4), s2 = *(const LAS f32x4*)(VCW + fr * 68 + 16 * fq + 8), s3 = *(const LAS f32x4*)(VCW + fr * 68 + 16 * fq + 12);
                v4u o0, o1;
                o0.x = cvtpk(s0.x * bflo(g0.x), s0.y * bfhi(g0.x)); o0.y = cvtpk(s0.z * bflo(g0.y), s0.w * bfhi(g0.y)); o0.z = cvtpk(s1.x * bflo(g0.z), s1.y * bfhi(g0.z)); o0.w = cvtpk(s1.z * bflo(g0.w), s1.w * bfhi(g0.w));
                o1.x = cvtpk(s2.x * bflo(g1.x), s2.y * bfhi(g1.x)); o1.y = cvtpk(s2.z * bflo(g1.y), s2.w * bfhi(g1.y)); o1.z = cvtpk(s3.x * bflo(g1.z), s3.y * bfhi(g1.z)); o1.w = cvtpk(s3.z * bflo(g1.w), s3.w * bfhi(g1.w));
                bf16* op = MIXIN + row * 1024 + 64 * h + 16 * fq; *(v4u*)op = o0; *(v4u*)(op + 8) = o1;
            }
        }
    }
    if (!FINAL) {
#pragma unroll
        for (int ct = 0; ct < 4; ++ct) { const int c = 16 * ct + fr;
            const size_t i16 = (size_t)((b * 2 + D) * NP16 + p16own) * 512 + 64 * h + c; A16[i16] = Ac[ct]; B16[i16] = Hc[ct];
            float Ag[4], Bg[4];
#pragma unroll
            for (int g = 0; g < 4; ++g) { Ag[g] = __shfl(Ac[ct], fr + 16 * g); Bg[g] = __shfl(Hc[ct], fr + 16 * g); }
            float run = 0.f;
#pragma unroll
            for (int gi = 0; gi < 4; ++gi) { const int g = D ? 3 - gi : gi; run = Ag[g] * run + Bg[g]; }
            if (fq == 0) { const size_t idx = (size_t)((b * 2 + D) * NPJ + pj) * 512 + 64 * h + c; AGGA[idx] = (Ag[0] * Ag[1]) * (Ag[2] * Ag[3]); AGGB[idx] = run; } }
    }
}

template <bool FINAL>
__device__ __forceinline__ void rg_run(const Args& a, LAS unsigned char* lds, int l, int rn, int tid, int lane, int wave) {
    const bool is_ctx = rn >= 256; const int bh = is_ctx ? rn - 256 : rn >> 4, b = bh >> 3, h = bh & 7, cgp = is_ctx ? 0 : (rn & 15);
    { const v4u* GWF = (const v4u*)(a.ws + WS_GWF); LAS v4u* GWL = (LAS v4u*)(lds + RG_GW);
#pragma unroll
      for (int i = tid; i < 2048; i += NTHR) { const int d = i >> 10, g = (i >> 9) & 1, rest = i & 511; GWL[i] = GWF[(size_t)((((l * 2 + d) * 2 + g) * 8 + h) * 8) * 64 + rest]; } }
    const int P0f = 4 + 8 * cgp, P0b = 124 - 8 * cgp;
    if (FINAL && !is_ctx) {
        const float* AGGA = (const float*)(a.ws + WS_AGGA); const float* AGGB = (const float*)(a.ws + WS_AGGB); const float* A16 = (const float*)(a.ws + WS_A16); const float* B16 = (const float*)(a.ws + WS_B16);
        const int d = tid >> 8, s = (tid >> 6) & 3, c = tid & 63, P0 = d ? P0b : P0f, lo = (P0 * s) >> 2, hi = (P0 * (s + 1)) >> 2;
        const size_t b16 = (size_t)((b * 2 + d) * NP16 + 4 * P0 + 8 * s) * 512 + 64 * h + c; float ai8[8], bi8[8];
#pragma unroll
        for (int i = 0; i < 8; ++i) { ai8[i] = A16[b16 + (size_t)i * 512]; bi8[i] = B16[b16 + (size_t)i * 512]; }
        const size_t base = (size_t)((b * 2 + d) * NPJ) * 512 + 64 * h + c; float A = 1.f, Bv = 0.f;
#pragma unroll 8
        for (int i = lo; i < hi; ++i) { const float ai = AGGA[base + (size_t)i * 512], bi = AGGB[base + (size_t)i * 512]; Bv = ai * Bv + bi; A *= ai; }
        LAS float* FO = (LAS float*)(lds + RG_FOLD); LAS float* F8 = (LAS float*)(lds + RG_F8); LAS float* CAR = (LAS float*)(lds + RG_CAR);
        FO[((d * 4 + s) * 64 + c) * 2] = A; FO[((d * 4 + s) * 64 + c) * 2 + 1] = Bv;
        float A8 = 1.f, B8 = 0.f;
#pragma unroll
        for (int i = 0; i < 8; ++i) { B8 = ai8[i] * B8 + bi8[i]; A8 *= ai8[i]; }
        F8[((d * 4 + s) * 64 + c) * 2] = A8; F8[((d * 4 + s) * 64 + c) * 2 + 1] = B8;
        __syncthreads();
        float S = 0.f;
#pragma unroll
        for (int s2 = 0; s2 < 4; ++s2) S = FO[((d * 4 + s2) * 64 + c) * 2] * S + FO[((d * 4 + s2) * 64 + c) * 2 + 1];
#pragma unroll
        for (int s2 = 0; s2 < 3; ++s2) if (s2 < s) S = F8[((d * 4 + s2) * 64 + c) * 2] * S + F8[((d * 4 + s2) * 64 + c) * 2 + 1];
#pragma unroll
        for (int i = 0; i < 8; ++i) { CAR[(d * 32 + 8 * s + i) * 64 + c] = S; S = ai8[i] * S + bi8[i]; }
    }
    __syncthreads();
    if (wave < (is_ctx ? 4 : 8)) {
        const int j = is_ctx ? wave : 8 * cgp + wave;
        const int seg_lo = is_ctx ? MLAT + b * CTXL : b * SEQ, seg_hi = seg_lo + (is_ctx ? CTXL : SEQ), r0 = seg_lo + 64 * j;
        const int pjf = is_ctx ? j : 4 + j, pjb = is_ctx ? 3 - j : 131 - j;
        LAS unsigned char* wl = lds + RG_WAVE + wave * RG_WAVE_BYTES;
        rg_sweep<FINAL, 1>(a, lds, wl, l, b, h, r0, seg_lo, seg_hi, pjb, is_ctx, wave, lane);
        rg_sweep<FINAL, 0>(a, lds, wl, l, b, h, r0, seg_lo, seg_hi, pjf, is_ctx, wave, lane);
    }
    __syncthreads();
}

#define RLX_AGENT __ATOMIC_RELAXED, __HIP_MEMORY_SCOPE_AGENT


#define XB_TMO      128
#define XB_XCNT(j)  (256  + 64 * (j))
#define XB_XSUB(j)  (1280 + 64 * (j))
#define XB_XGEN(j)  (2304 + 64 * (j))
#define XB_TOP      3328
#define XB_TOPGEN   3392
#define XCD_BAR_WORDS 3456
#define XB_SPIN_CAP (1u << 18)

__device__ __forceinline__ unsigned xb_ld(unsigned* p)              { return __hip_atomic_load(p, __ATOMIC_RELAXED, __HIP_MEMORY_SCOPE_AGENT); }
__device__ __forceinline__ unsigned xb_add(unsigned* p, unsigned v) { return __hip_atomic_fetch_add(p, v, __ATOMIC_RELAXED, __HIP_MEMORY_SCOPE_AGENT); }
__device__ __forceinline__ unsigned xb_xcc_id() { return (unsigned)__builtin_amdgcn_s_getreg((3 << 11) | 20) & 0xFu; }
#define XB_SPIN(cond, bar) do { unsigned _sp = 0; while (cond) { __builtin_amdgcn_s_sleep(1); \
    if ((++_sp & 255u) == 0u) { if (xb_ld(&(bar)[XB_TMO])) break; if (_sp > XB_SPIN_CAP) { atomicAdd(&(bar)[XB_TMO], 1u); break; } } } } while (0)

struct XcdBarrier {
    unsigned* bar; unsigned x;
    volatile LAS unsigned* st;
};

__device__ __forceinline__ XcdBarrier xcd_barrier_post(unsigned* bar, volatile LAS unsigned* st) {
    XcdBarrier b; b.bar = bar; b.x = xb_xcc_id(); b.st = st;
    if (threadIdx.x == 0) (void)xb_add(&bar[XB_XCNT(b.x)], 1u);
    return b;
}
__device__ __forceinline__ void xcd_barrier_complete(unsigned* bar, unsigned x, unsigned& nloc, unsigned& nx) {
    const unsigned G = gridDim.x * gridDim.y * gridDim.z;
    unsigned sum, cnt, mine, sp = 0u;
    for (;;) {
        sum = 0u; cnt = 0u; mine = 0u;
#pragma unroll
        for (unsigned j = 0; j < 16; ++j) { const unsigned c = xb_ld(&bar[XB_XCNT(j)]); sum += c; cnt += (c > 0u) ? 1u : 0u; mine = (j == x) ? c : mine; }
        if (sum == G) break;
        __builtin_amdgcn_s_sleep(1);
        if ((++sp & 255u) == 0u) { if (xb_ld(&bar[XB_TMO])) break; if (sp > XB_SPIN_CAP) { atomicAdd(&bar[XB_TMO], 1u); break; } }
    }
    nloc = mine > 0u ? mine : 1u; nx = cnt > 0u ? cnt : 1u;
}

__device__ __forceinline__ void xcd_barrier(const XcdBarrier& b) {
    asm volatile("s_waitcnt vmcnt(0)" ::: "memory");
    __syncthreads();
    if (threadIdx.x == 0) {
        unsigned* bar = b.bar;
        __builtin_amdgcn_s_waitcnt(0);
        unsigned nloc = b.st[0], nx = b.st[1];
        if (nloc == 0u) { xcd_barrier_complete(bar, b.x, nloc, nx); b.st[0] = nloc; b.st[1] = nx; }
        const unsigned old = xb_add(&bar[XB_XSUB(b.x)], 1u);
        const unsigned gen = old / nloc;
        if (old + 1u == (gen + 1u) * nloc) {
            __builtin_amdgcn_fence(__ATOMIC_RELEASE, "agent");
            asm volatile("s_waitcnt vmcnt(0)" ::: "memory");
            const unsigned og = xb_add(&bar[XB_TOP], 1u);
            const unsigned tg = og / nx;
            if (og + 1u == (tg + 1u) * nx) xb_add(&bar[XB_TOPGEN], 1u);
            else XB_SPIN(xb_ld(&bar[XB_TOPGEN]) == tg, bar);
            __builtin_amdgcn_fence(__ATOMIC_ACQUIRE, "agent");
            xb_add(&bar[XB_XGEN(b.x)], 1u);
            asm volatile("s_waitcnt vmcnt(0)" ::: "memory");
        } else {
            XB_SPIN(xb_ld(&bar[XB_XGEN(b.x)]) == gen, bar);
            __builtin_amdgcn_fence(__ATOMIC_ACQUIRE, "agent");
            asm volatile("s_waitcnt vmcnt(0)" ::: "memory");
        }
    }
    __syncthreads();
}

__device__ __forceinline__ void layer_phases(int l, const Args& args, LAS unsigned char* lds, const int tid0, const int lo, const int hi, const XcdBarrier& xbar) {
    const int G = gridDim.x; unsigned char* ws = args.ws;
    const int pb = 1 + 5 * l;
#define LAUNDER() int tid = tid0; asm volatile("" : "+v"(tid)); const int lane = tid & 63, wave = __builtin_amdgcn_readfirstlane(tid >> 6); int bx = blockIdx.x; asm volatile("" : "+s"(bx)); (void)lane; (void)wave; (void)bx
#define IN(k) (lo <= (k) && (k) < hi)
#define SEAM(k) do { if (IN(k) && IN((k) + 1)) { xcd_barrier(xbar); } } while (0)
        if (IN(pb)) { LAUNDER(); norm_phase(args, l, lane, wave); }
        SEAM(pb);
        if (IN(pb + 1)) { LAUNDER();
            pg8::Gemm g{(const pg8::bf16_t*)(ws + WS_H), (const pg8::bf16_t*)(ws + WS_BT1) + (size_t)l * NIN * 1024, MROWS, NIN, 1024};
            pg8::StaticOrder S; S.init(MROWS, NIN, G, bx);
            pg8::EpiU E{(pg8::bf16_t*)(ws + WS_U)};
            pg8::gemm_phase<pg8::EpiU, pg8::StaticOrder, true, true>(lds, g, S, E);
        }
        SEAM(pb + 1);
        if (IN(pb + 2)) { LAUNDER();
            const int nrun = (bx >= G - 16) ? 2 : 1;
#pragma unroll 1
            for (int k = 0; k < nrun; ++k) rg_run<false>(args, lds, l, k == 0 ? bx : 256 + (G - 1 - bx), tid, lane, wave);
            const int n_h = 256 + (l == 0 ? 16 : 0), n_conv = 128 + n_h;
            const int GC = G - 16;
            for (int un = bx; un < n_conv && bx < GC; un += GC) {
                if (un < 128) { vconv_unit(args, lds, l, un >> 6, un & 63, tid); }
                else { const int hu = un - 128;
                    if (hu < 256) hconv_unit(args, lds, l, hu * 64, 0, hu * 64, hu * 64 + 64, tid);
                    else { const int cu = hu - 256, cc = cu >> 1, g = cu & 1, bb = cc >> 2; hconv_unit(args, lds, l, MLAT + cc * 64, g, MLAT + bb * CTXL, MLAT + bb * CTXL + CTXL, tid); } }
            }
        }
        SEAM(pb + 2);
        if (IN(pb + 3)) { LAUNDER();
            const int nrun = (l == 0 && bx >= G - 16) ? 2 : 1;
#pragma unroll 1
            for (int k = 0; k < nrun; ++k) rg_run<true>(args, lds, l, k == 0 ? bx : 256 + (G - 1 - bx), tid, lane, wave);
            ln_rows(args, l, (l == 0) ? MROWS : MLAT, lane, wave);
        }
        SEAM(pb + 3);
        if (IN(pb + 4)) { LAUNDER();
            const int M2 = (l == 0) ? MROWS : MLAT;
            pg8::Gemm g{(const pg8::bf16_t*)(ws + WS_MIXIN), (const pg8::bf16_t*)(ws + WS_BT2) + (size_t)l * 1024 * 1024, M2, 1024, 1024};
            pg8::StaticOrder S; S.init(M2, 1024, G, bx);
            pg8::EpiMix E{(pg8::bf16_t*)(ws + WS_MIX), (float*)(ws + WS_SSQ)};
            pg8::gemm_phase<pg8::EpiMix, pg8::StaticOrder, true, true>(lds, g, S, E);
        }
        SEAM(pb + 4);
#undef IN
#undef SEAM
#undef LAUNDER
}

__global__ void __launch_bounds__(NTHR, 2) fwd_megakernel(Args args) {
    extern __shared__ __attribute__((aligned(16))) unsigned char lds_raw[];
    LAS unsigned char* lds = (LAS unsigned char*)lds_raw;
    const int tid = threadIdx.x, lane = tid & 63, wave = __builtin_amdgcn_readfirstlane(tid >> 6);
    const int G = gridDim.x, bx = blockIdx.x;
    unsigned char* ws = args.ws;
    const int lo = args.ph_lo, hi = args.ph_hi;
    if (args.coop == 2) cg::this_grid().sync();
    volatile LAS unsigned* MISC = (volatile LAS unsigned*)(lds + MISC_OFF);
    if (tid < 64) MISC[tid] = 0u;
    __syncthreads();
    XcdBarrier xbar; xbar.bar = (unsigned*)(ws + WS_CTL); xbar.x = 0; xbar.st = nullptr;
    if (args.coop == 1) xbar = xcd_barrier_post((unsigned*)(ws + WS_CTL), MISC + 8);
#define IN(k) (lo <= (k) && (k) < hi)
#define SEAM(k) do { if (IN(k) && IN((k) + 1)) { xcd_barrier(xbar); } } while (0)

    if (IN(0)) { p0_prologue(args, lds, tid, lane, wave); }
    SEAM(0);
#pragma unroll 1
    for (int l = 0; l < 2; ++l) { int lo_ = l; asm volatile("" : "+s"(lo_)); layer_phases(lo_, args, lds, tid, lo, hi, xbar); }
    if (IN(11)) { norm_phase(args, 2, lane, wave); }
#undef IN
#undef SEAM
}

#ifndef MK_PER_PHASE
#define MK_PER_PHASE 0
#endif
extern "C" void kernel_launch(void* const* d_in, const int* in_sizes, int n_in, void* d_out, int out_size, void* d_ws, size_t ws_size, hipStream_t stream) {
    static int grid = 0;
    if (grid == 0) {
        if (n_in != 21 || out_size != MLAT * DM || ws_size < WS_END) { fprintf(stderr, "kernel_launch: unexpected shapes (n_in %d, out %d, ws %zu)\n", n_in, out_size, ws_size); grid = -1; return; }
        int dev = 0, cus = 0, per_cu = 0;
        if (hipGetDevice(&dev) != hipSuccess || hipDeviceGetAttribute(&cus, hipDeviceAttributeMultiprocessorCount, dev) != hipSuccess) { grid = -1; return; }
        if (hipFuncSetAttribute((const void*)fwd_megakernel, hipFuncAttributeMaxDynamicSharedMemorySize, LDS_BYTES) != hipSuccess) { fprintf(stderr, "kernel_launch: hipFuncSetAttribute failed\n"); grid = -1; return; }
        if (hipOccupancyMaxActiveBlocksPerMultiprocessor(&per_cu, (const void*)fwd_megakernel, NTHR, LDS_BYTES) != hipSuccess || per_cu < 1) { fprintf(stderr, "kernel_launch: occupancy query says %d\n", per_cu); per_cu = 1; }
        (void)hipGetLastError();
        grid = cus;
    }
    if (grid < 0) return;
    if (hipMemsetAsync((char*)d_ws + WS_CTL, 0, CTL_ZERO_BYTES, stream) != hipSuccess) { fprintf(stderr, "kernel_launch: memset failed\n"); return; }
    Args a{};
    for (int i = 0; i < 21; ++i) a.in[i] = (const float*)d_in[i];
    a.out = (float*)d_out; a.ws = (unsigned char*)d_ws;
#if MK_PER_PHASE
    for (int ph = 0; ph < 12; ++ph) { a.ph_lo = ph; a.ph_hi = ph + 1; a.coop = 0;
        hipLaunchKernelGGL(fwd_megakernel, dim3(grid), dim3(NTHR), LDS_BYTES, stream, a); }
#else
    a.ph_lo = 0; a.ph_hi = 12; a.coop = 1;
    void* kargs[] = {&a};
    hipError_t e = hipLaunchCooperativeKernel((const void*)fwd_megakernel, dim3(grid), dim3(NTHR), kargs, LDS_BYTES, stream);
    if (e != hipSuccess) fprintf(stderr, "cooperative launch failed: %s (grid %d)\n", hipGetErrorString(e), grid);
#endif
}
```

```cpp
#include <hip/hip_runtime.h>
#include <hip/hip_cooperative_groups.h>
#include <cstdio>
#include <cstdint>
namespace cg = cooperative_groups;
#define MK_PER_PHASE 0
namespace pg8 {
#define PG8_LAS __attribute__((address_space(3)))
typedef unsigned short bf16_t;
typedef short bf16x8 __attribute__((ext_vector_type(8)));
typedef float f32x4 __attribute__((ext_vector_type(4)));
typedef unsigned u32x4 __attribute__((ext_vector_type(4)));
constexpr int BM = 256, BK = 64, HALF = 128, HTB = HALF * BK * 2  , STAGE_BYTES = 8 * HTB, NXCD = 8, WGM = 8;

__host__ __device__ __forceinline__ int lds_byte(int r, int c) { const int st = (r >> 4) * 2 + (c >> 5), rr = r & 15, cc = c & 31, ob = rr * 64 + cc * 2; return st * 1024 + (ob ^ (((ob >> 9) & 1) << 5)); }
__host__ __device__ __forceinline__ void stage_rc(int b, int& R, int& C) { const int st = b / 1024, sb = b % 1024, swz = sb ^ (((sb >> 9) & 1) << 5); R = (st >> 1) * 16 + swz / 64; C = (st & 1) * 32 + (swz % 64) / 2; }
__host__ __device__ __forceinline__ int perm32(int rho) { const int n = rho >> 4, i = rho & 15; return 8 * (i >> 2) + 4 * n + (i & 3); }

struct Unit { int pm, pn; };
struct Gemm { const bf16_t* A; const bf16_t* Bt; int M, N, K; };

struct StaticOrder {
    int nM, nN, nwg, G, c;
    __host__ __device__ void init(int M, int N, int G_, int c_) { nM = M / BM; nN = N / BM; nwg = nM * nN; G = G_; c = c_; }
    __host__ __device__ bool next(int i, Unit& u) const {
        const long L = (long)i * G + c; if (L >= nwg) return false;
        int wgid = (int)L; { const int q = nwg / NXCD, r = nwg % NXCD, xcd = wgid % NXCD, off = wgid / NXCD; wgid = (xcd < r ? xcd * (q + 1) : r * (q + 1) + (xcd - r) * q) + off; }
        const int nig = WGM * nN, gid = wgid / nig, fm = gid * WGM, gsz = (nM - fm) < WGM ? (nM - fm) : WGM;
        u.pm = fm + ((wgid % nig) % gsz); u.pn = (wgid % nig) / gsz; return true;
    }
    __device__ __forceinline__ void a_ready(const Unit&) const {}
    __device__ __forceinline__ void done(const Unit&) const {}
};
__device__ __forceinline__ unsigned cvt_pk_bf16(float lo, float hi) { unsigned r; asm volatile("v_cvt_pk_bf16_f32 %0, %1, %2" : "=v"(r) : "v"(lo), "v"(hi)); return r; }
typedef float f32x2 __attribute__((ext_vector_type(2)));
template <class Epi, class Sched, bool ALIGN_EPI = false, bool SP2 = false>
__device__ __forceinline__ void gemm_phase(PG8_LAS unsigned char* lds, const Gemm g, const Sched& S, const Epi& E) {
    const int tid = threadIdx.x, wid = __builtin_amdgcn_readfirstlane(tid >> 6), lane = tid & 63, wr = wid >> 2, wc = wid & 3, fr = lane & 15, fq = lane >> 4;
    const int K = g.K, nt = K / BK;
    unsigned voffA[2], voffB[2];
#pragma unroll
    for (int i = 0; i < 2; ++i) { int R, C; stage_rc(tid * 16 + i * 8192, R, C); const int Rb = Epi::PERM ? ((R & ~31) + perm32(R & 31)) : R;
        voffA[i] = (unsigned)(R * K + C) * 2u; voffB[i] = (unsigned)(Rb * K + C) * 2u; }
    const size_t kstep = (size_t)(BK * 2);
    const size_t hstep = (size_t)HALF * K * 2;
    const size_t tstep = 2 * hstep;
    const unsigned ldsw = (unsigned)wid * 1024u;
    const int aoff = lds_byte(wr * 64 + fr, fq * 8), boff = lds_byte(wc * 32 + fr, fq * 8);
#define PG8_SA(b, h) (((b) * 2 + (h)) * HTB)
#define PG8_SB(b, h) ((4 + (b) * 2 + (h)) * HTB)
#define PG8_STAGE(bufoff, gbase, voff) do { _Pragma("unroll") for (int _i = 0; _i < 2; ++_i) \
        __builtin_amdgcn_global_load_lds((const unsigned*)((const char*)(gbase) + (voff)[_i]), (PG8_LAS unsigned*)(lds + (bufoff) + ldsw + _i * 8192), 16, 0, 0); } while (0)
#define PG8_LDA(dst, b, h) do { _Pragma("unroll") for (int m = 0; m < 4; ++m) _Pragma("unroll") for (int k = 0; k < 2; ++k) dst[m][k] = *(const PG8_LAS bf16x8*)(lds + PG8_SA(b, h) + aoff + m * 2048 + k * 1024); } while (0)
#define PG8_LDB(dst, b, h) do { _Pragma("unroll") for (int n = 0; n < 2; ++n) _Pragma("unroll") for (int k = 0; k < 2; ++k) dst[n][k] = *(const PG8_LAS bf16x8*)(lds + PG8_SB(b, h) + boff + n * 2048 + k * 1024); } while (0)
#define PG8_MMA(ai, bj, At, Bt) do { __builtin_amdgcn_s_setprio(1); _Pragma("unroll") for (int m = 0; m < 4; ++m) _Pragma("unroll") for (int n = 0; n < 2; ++n) _Pragma("unroll") for (int k = 0; k < 2; ++k) \
        acc[ai][bj][m][n] = __builtin_amdgcn_mfma_f32_16x16x32_bf16(Bt[n][k], At[m][k], acc[ai][bj][m][n], 0, 0, 0); __builtin_amdgcn_s_setprio(0); } while (0)
#define PG8_WAIT_V(n) asm volatile("s_waitcnt vmcnt(" #n ")" ::: "memory")
#define PG8_WAIT_L(n) asm volatile("s_waitcnt lgkmcnt(" #n ")" ::: "memory")
#define PG8_BAR __builtin_amdgcn_s_barrier()
#define PG8_SCHED __builtin_amdgcn_sched_barrier(0)
    Unit cur, nxt; int ui = 0;
    if (!S.next(0, cur)) return;
    f32x4 acc[2][2][4][2];
#pragma unroll
    for (int a = 0; a < 2; ++a)
#pragma unroll
        for (int b = 0; b < 2; ++b)
#pragma unroll
            for (int m = 0; m < 4; ++m)
#pragma unroll
                for (int n = 0; n < 2; ++n) acc[a][b][m][n] = (f32x4){0.f, 0.f, 0.f, 0.f};
    bf16x8 At[4][2], B0[2][2], B1[2][2];
    const char* cA = (const char*)g.A + (size_t)cur.pm * tstep; const char* cB = (const char*)g.Bt + (size_t)cur.pn * tstep;
    S.a_ready(cur);
    if constexpr (SP2) {
        PG8_STAGE(PG8_SB(0, 0), cB, voffB); PG8_STAGE(PG8_SB(0, 1), cB + hstep, voffB); PG8_STAGE(PG8_SA(0, 0), cA, voffA); PG8_STAGE(PG8_SA(0, 1), cA + hstep, voffA);
        if (wr == 1) PG8_BAR;
        PG8_WAIT_V(2); PG8_BAR;
        PG8_STAGE(PG8_SB(1, 0), cB + kstep, voffB); PG8_STAGE(PG8_SA(1, 0), cA + kstep, voffA); PG8_STAGE(PG8_SB(1, 1), cB + hstep + kstep, voffB);
        PG8_WAIT_V(6); PG8_BAR;
    } else {
        PG8_STAGE(PG8_SB(0, 0), cB, voffB); PG8_STAGE(PG8_SA(0, 0), cA, voffA); PG8_STAGE(PG8_SB(0, 1), cB + hstep, voffB); PG8_STAGE(PG8_SA(0, 1), cA + hstep, voffA);
        if (wr == 1) PG8_BAR;
        PG8_WAIT_V(4); PG8_BAR;
        PG8_STAGE(PG8_SB(1, 0), cB + kstep, voffB); PG8_STAGE(PG8_SA(1, 0), cA + kstep, voffA); PG8_STAGE(PG8_SB(1, 1), cB + hstep + kstep, voffB);
        PG8_WAIT_V(6); PG8_BAR;
    }
    for (;;) {
        const bool has_next = S.next(ui + 1, nxt);
        const char* nA = has_next ? (const char*)g.A + (size_t)nxt.pm * tstep : cA; const char* nB = has_next ? (const char*)g.Bt + (size_t)nxt.pn * tstep : cB;
        for (int t = 0; t < nt; t += 2) {
            const bool last = (t == nt - 2);
            const char* a1 = cA + (size_t)(t + 1) * kstep;
            const char* a2 = last ? nA : cA + (size_t)(t + 2) * kstep; const char* b2 = last ? nB : cB + (size_t)(t + 2) * kstep;
            const char* a3 = a2 + kstep; const char* b3 = b2 + kstep;
            if (last && has_next) S.a_ready(nxt);
            if constexpr (SP2) {
            PG8_LDB(B0, 0, 0); PG8_LDB(B1, 0, 1); PG8_SCHED; PG8_LDA(At, 0, 0); PG8_STAGE(PG8_SA(1, 1), a1 + hstep, voffA);
            PG8_WAIT_V(8); PG8_WAIT_L(0); PG8_BAR; PG8_MMA(0, 0, At, B0); PG8_MMA(0, 1, At, B1); PG8_BAR; PG8_SCHED;
            PG8_LDA(At, 0, 1); PG8_STAGE(PG8_SB(0, 0), b2, voffB); PG8_STAGE(PG8_SB(0, 1), b2 + hstep, voffB); PG8_STAGE(PG8_SA(0, 0), a2, voffA);
            PG8_WAIT_V(8); PG8_WAIT_L(0); PG8_BAR; PG8_MMA(1, 0, At, B0); PG8_MMA(1, 1, At, B1); PG8_BAR; PG8_SCHED;
            PG8_LDB(B0, 1, 0); PG8_LDB(B1, 1, 1); PG8_SCHED; PG8_LDA(At, 1, 0); PG8_STAGE(PG8_SA(0, 1), a2 + hstep, voffA);
            PG8_WAIT_V(8); PG8_WAIT_L(0); PG8_BAR; PG8_MMA(0, 0, At, B0); PG8_MMA(0, 1, At, B1); PG8_BAR; PG8_SCHED;
            PG8_LDA(At, 1, 1); PG8_STAGE(PG8_SB(1, 0), b3, voffB); PG8_STAGE(PG8_SB(1, 1), b3 + hstep, voffB); PG8_STAGE(PG8_SA(1, 0), a3, voffA);
            PG8_WAIT_V(8); PG8_WAIT_L(0); PG8_BAR; PG8_MMA(1, 0, At, B0); PG8_MMA(1, 1, At, B1); PG8_BAR; PG8_SCHED;
            } else {
            PG8_LDB(B0, 0, 0); PG8_SCHED; PG8_LDA(At, 0, 0); PG8_STAGE(PG8_SA(1, 1), a1 + hstep, voffA);
            PG8_WAIT_L(8); PG8_BAR; PG8_WAIT_L(0); PG8_MMA(0, 0, At, B0); PG8_BAR; PG8_SCHED;
            PG8_LDB(B1, 0, 1); PG8_STAGE(PG8_SB(0, 0), b2, voffB);
            PG8_BAR; PG8_WAIT_L(0); PG8_MMA(0, 1, At, B1); PG8_BAR;
            PG8_LDA(At, 0, 1); PG8_STAGE(PG8_SA(0, 0), a2, voffA);
            PG8_BAR; PG8_WAIT_L(0); PG8_MMA(1, 0, At, B0); PG8_BAR; PG8_SCHED;
            PG8_STAGE(PG8_SB(0, 1), b2 + hstep, voffB);
            PG8_WAIT_V(6); PG8_BAR; PG8_MMA(1, 1, At, B1); PG8_BAR;
            PG8_LDB(B0, 1, 0); PG8_SCHED; PG8_LDA(At, 1, 0); PG8_STAGE(PG8_SA(0, 1), a2 + hstep, voffA);
            PG8_WAIT_L(8); PG8_BAR; PG8_WAIT_L(0); PG8_MMA(0, 0, At, B0); PG8_BAR; PG8_SCHED;
            PG8_LDB(B1, 1, 1); PG8_STAGE(PG8_SB(1, 0), b3, voffB);
            PG8_BAR; PG8_WAIT_L(0); PG8_MMA(0, 1, At, B1); PG8_BAR;
            PG8_LDA(At, 1, 1); PG8_STAGE(PG8_SA(1, 0), a3, voffA);
            PG8_BAR; PG8_WAIT_L(0); PG8_MMA(1, 0, At, B0); PG8_BAR; PG8_SCHED;
            PG8_STAGE(PG8_SB(1, 1), b3 + hstep, voffB);
            PG8_WAIT_V(6); PG8_BAR; PG8_MMA(1, 1, At, B1); PG8_BAR;
            }
        }
        if constexpr (ALIGN_EPI) { if (wr == 0) PG8_BAR; }
        if constexpr (!Epi::AFTER_DRAIN) { E(acc, cur, wr, wc, fr, fq); S.done(cur); }
        if (!has_next) break;
#pragma unroll
        for (int a = 0; a < 2; ++a)
#pragma unroll
            for (int b = 0; b < 2; ++b)
#pragma unroll
                for (int m = 0; m < 4; ++m)
#pragma unroll
                    for (int n = 0; n < 2; ++n) acc[a][b][m][n] = (f32x4){0.f, 0.f, 0.f, 0.f};
        cur = nxt; cA = nA; cB = nB; ++ui;
        if constexpr (ALIGN_EPI) { if (wr == 1) PG8_BAR; }
    }
    PG8_WAIT_V(0);
    if constexpr (!ALIGN_EPI) { if (wr == 0) PG8_BAR; }
    PG8_BAR;
    if constexpr (Epi::AFTER_DRAIN) { E.fused(acc, cur, wr, wc, fr, fq, lds, wid, lane); S.done(cur); }
#undef PG8_SA
#undef PG8_SB
#undef PG8_STAGE
#undef PG8_LDA
#undef PG8_LDB
#undef PG8_MMA
#undef PG8_WAIT_V
#undef PG8_WAIT_L
#undef PG8_BAR
#undef PG8_SCHED
}
}

constexpr int DM = 1024, NB = 2, SEQ = 8192, CTXL = 256, MLAT = NB * SEQ, MCTX = NB * CTXL, MROWS = MLAT + MCTX;
constexpr int NIN = 2560, NCHUNK = MROWS / 64  , NPJ = 132  ;
constexpr float EPSF = 1e-6f;
constexpr int NWAVES = 8, NTHR = 512;

constexpr size_t MiB = 1u << 20;
constexpr size_t WS_CTL = 0, CTL_ZERO_BYTES = 64 * 1024;
constexpr size_t WS_MOD = 1 * MiB;
constexpr size_t WS_SP8 = 1 * MiB + 128 * 1024;
constexpr size_t WS_GWF = 1 * MiB + 256 * 1024;
constexpr size_t WS_BT1 = 2 * MiB;
constexpr size_t WS_BT2 = 12 * MiB;
constexpr size_t WS_AGGA = 16 * MiB;
constexpr size_t WS_AGGB = 16 * MiB + 1536 * 1024;
constexpr size_t WS_SSQ = 19 * MiB;
constexpr size_t WS_XC1 = 21 * MiB;
constexpr size_t WS_A16 = 23 * MiB;
constexpr size_t WS_B16 = 28 * MiB;
constexpr size_t WS_H = 73 * MiB;
constexpr size_t WS_Y = 56 * MiB;
constexpr size_t WS_MIXIN = 73 * MiB;
constexpr size_t WS_U = 106 * MiB;
constexpr size_t WS_MIX = 189 * MiB;
constexpr size_t WS_END = 255 * MiB;

constexpr int LDS_BYTES = 158720;
constexpr int MISC_OFF = 157696;

#define LAS __attribute__((address_space(3)))
typedef unsigned short bf16;
typedef unsigned v4u __attribute__((ext_vector_type(4)));
typedef unsigned v2u __attribute__((ext_vector_type(2)));
typedef float f32x4 __attribute__((ext_vector_type(4)));
typedef short bf16x8 __attribute__((ext_vector_type(8)));
typedef float f32x2v __attribute__((ext_vector_type(2)));
#define LDS_WAIT() asm volatile("s_waitcnt lgkmcnt(0)" ::: "memory")

__device__ __forceinline__ unsigned f2bf(float f) { unsigned u = __builtin_bit_cast(unsigned, f); return (u + 0x7fffu + ((u >> 16) & 1u)) >> 16; }
__device__ __forceinline__ unsigned pk2(float lo, float hi) { return f2bf(lo) | (f2bf(hi) << 16); }
__device__ __forceinline__ unsigned cvtpk(float lo, float hi) { unsigned r; asm volatile("v_cvt_pk_bf16_f32 %0, %1, %2" : "=v"(r) : "v"(lo), "v"(hi)); return r; }
__device__ __forceinline__ float bflo(unsigned u) { return __builtin_bit_cast(float, u << 16); }
__device__ __forceinline__ float bfhi(unsigned u) { return __builtin_bit_cast(float, u & 0xffff0000u); }
__device__ __forceinline__ float sigmoidf_(float x) { return 1.0f / (1.0f + __expf(-x)); }
__device__ __forceinline__ float siluf_(float x) { return x * __builtin_amdgcn_rcpf(1.0f + __builtin_amdgcn_exp2f(-1.44269504f * x)); }
__device__ __forceinline__ float wave_sum(float v) {
#pragma unroll
    for (int o = 1; o < 64; o <<= 1) v += __shfl_xor(v, o);
    return v;
}

struct Args {
    const float* in[21]; float* out; unsigned char* ws; int ph_lo, ph_hi, coop, pad;
};
enum { I_X = 0, I_C, I_CTX, I_CCTX, I_WMOD, I_BMOD, I_GPRE, I_GPOST, I_WIN, I_CAW, I_CAB, I_WR, I_BR, I_WI, I_BI, I_LAM, I_DWW, I_DWB, I_LNG, I_LNB, I_WOUT };

namespace pg8 {
struct EpiU {
    static constexpr bool PERM = true, AFTER_DRAIN = false;
    bf16_t* O;
    __device__ __forceinline__ void operator()(const f32x4 (&acc)[2][2][4][2], const Unit& u, int wr, int wc, int fr, int fq) const {
        const int row0 = u.pm * BM + wr * 64 + fr;
        if (u.pn >= 4 && u.pn < 8) {
            const int col0 = 1024 + 128 * (u.pn - 4) + wc * 32 + 8 * fq;
#pragma unroll
            for (int ai = 0; ai < 2; ++ai)
#pragma unroll
                for (int m = 0; m < 4; ++m) { f32x4 v0 = acc[ai][0][m][0], v1 = acc[ai][0][m][1]; const f32x4 g0 = acc[ai][1][m][0], g1 = acc[ai][1][m][1];
#pragma unroll
                    for (int e = 0; e < 4; ++e) { v0[e] = v0[e] * __builtin_amdgcn_rcpf(1.0f + __builtin_amdgcn_exp2f(-1.44269504f * g0[e])); v1[e] = v1[e] * __builtin_amdgcn_rcpf(1.0f + __builtin_amdgcn_exp2f(-1.44269504f * g1[e])); }
                    u32x4 w; w.x = cvt_pk_bf16(v0[0], v0[1]); w.y = cvt_pk_bf16(v0[2], v0[3]); w.z = cvt_pk_bf16(v1[0], v1[1]); w.w = cvt_pk_bf16(v1[2], v1[3]);
                    *(u32x4*)(O + (size_t)(row0 + ai * HALF + m * 16) * 2560 + col0) = w; }
            return;
        }
        const int col0 = u.pn * BM + wc * 32 + 8 * fq;
        const bool act = (u.pn == 2 || u.pn == 3 || u.pn >= 8);
#pragma unroll
        for (int ai = 0; ai < 2; ++ai)
#pragma unroll
            for (int m = 0; m < 4; ++m) { bf16_t* rowp = O + (size_t)(row0 + ai * HALF + m * 16) * 2560 + col0;
#pragma unroll
                for (int bj = 0; bj < 2; ++bj) { f32x4 v0 = acc[ai][bj][m][0], v1 = acc[ai][bj][m][1];
                    if (act) {
#pragma unroll
                        for (int e = 0; e < 4; ++e) { v0[e] = v0[e] * __builtin_amdgcn_rcpf(1.0f + __builtin_amdgcn_exp2f(-1.44269504f * v0[e])); v1[e] = v1[e] * __builtin_amdgcn_rcpf(1.0f + __builtin_amdgcn_exp2f(-1.44269504f * v1[e])); }
                    }
                    u32x4 w; w.x = cvt_pk_bf16(v0[0], v0[1]); w.y = cvt_pk_bf16(v0[2], v0[3]); w.z = cvt_pk_bf16(v1[0], v1[1]); w.w = cvt_pk_bf16(v1[2], v1[3]);
                    *(u32x4*)(rowp + bj * HALF) = w; } }
    }
};
struct EpiMix {
    static constexpr bool PERM = true, AFTER_DRAIN = false;
    bf16_t* O; float* ssq;
    __device__ __forceinline__ void operator()(const f32x4 (&acc)[2][2][4][2], const Unit& u, int wr, int wc, int fr, int fq) const {
        const int col0 = u.pn * BM + wc * 32 + 8 * fq;
#pragma unroll
        for (int ai = 0; ai < 2; ++ai)
#pragma unroll
            for (int m = 0; m < 4; ++m) { const int r = u.pm * BM + ai * HALF + wr * 64 + m * 16 + fr; bf16_t* rowp = O + (size_t)r * 1024 + col0; float s = 0.f;
#pragma unroll
                for (int bj = 0; bj < 2; ++bj) { const f32x4 v0 = acc[ai][bj][m][0], v1 = acc[ai][bj][m][1];
                    s += ((v0[0] * v0[0] + v0[1] * v0[1]) + (v0[2] * v0[2] + v0[3] * v0[3])) + ((v1[0] * v1[0] + v1[1] * v1[1]) + (v1[2] * v1[2] + v1[3] * v1[3]));
                    u32x4 w; w.x = cvt_pk_bf16(v0[0], v0[1]); w.y = cvt_pk_bf16(v0[2], v0[3]); w.z = cvt_pk_bf16(v1[0], v1[1]); w.w = cvt_pk_bf16(v1[2], v1[3]);
                    *(u32x4*)(rowp + bj * HALF) = w; }
                s += __shfl_xor(s, 16); s += __shfl_xor(s, 32);
                if (fq == 0) ssq[(size_t)r * 16 + u.pn * 4 + wc] = s; }
    }
};
}

__device__ __forceinline__ void p0_transpose_item(const float* W, int K, int N, bf16* WT, LAS float* scr, int item, int lane, bool glu_remap) {
    const int nblk = N / 32, kb = item / nblk, nb = item % nblk, k0 = 64 * kb, n0 = 32 * nb;
    int nd = n0;
    if (glu_remap) { if (n0 >= 1024 && n0 < 1536) nd = 1024 + 256 * ((n0 - 1024) >> 7) + ((n0 - 1024) & 127); else if (n0 >= 1536 && n0 < 2048) nd = 1024 + 256 * ((n0 - 1536) >> 7) + 128 + ((n0 - 1536) & 127); }
#pragma unroll 8
    for (int i = 0; i < 32; ++i) { const int kk = 2 * i + (lane >> 5); scr[kk * 33 + (lane & 31)] = W[(size_t)(k0 + kk) * N + n0 + (lane & 31)]; }
    LDS_WAIT(); asm volatile("" ::: "memory");
    const int c = lane & 7;
#pragma unroll
    for (int j = 0; j < 4; ++j) { const int n = (lane >> 3) + 8 * j; const LAS float* s = scr + (8 * c) * 33 + n;
        v4u o; o.x = pk2(s[0 * 33], s[1 * 33]); o.y = pk2(s[2 * 33], s[3 * 33]); o.z = pk2(s[4 * 33], s[5 * 33]); o.w = pk2(s[6 * 33], s[7 * 33]);
        *(v4u*)(WT + (size_t)(nd + n) * K + k0 + 8 * c) = o; }
    LDS_WAIT(); asm volatile("" ::: "memory");
}

__device__ __forceinline__ void p0_prologue(const Args& a, LAS unsigned char* lds, int tid, int lane, int wave) {
    const int G = gridDim.x, bx = blockIdx.x;
    unsigned char* ws = a.ws;
    {
        LAS float* part = (LAS float*)lds;
        float* MOD = (float*)(ws + WS_MOD);
        const float* c = a.in[I_C]; const float* cctx = a.in[I_CCTX];
        for (int un = bx; un < 192; un += G) {
            const int l = un / 96, n0 = (un % 96) * 32, cq = tid & 7, ks = tid >> 3;
            const float* wm = a.in[I_WMOD] + (size_t)l * 1024 * 3072 + n0 + cq * 4;
            f32x4 acc0 = {0.f, 0.f, 0.f, 0.f}, acc1 = acc0, acc2 = acc0;
#pragma unroll 4
            for (int kk = 0; kk < 16; ++kk) { const int k = ks * 16 + kk; const f32x4 w = *(const f32x4*)(wm + (size_t)k * 3072);
                const float a0 = siluf_(c[k]), a1 = siluf_(c[1024 + k]), a2 = siluf_(cctx[k]);
                acc0 += w * a0; acc1 += w * a1; acc2 += w * a2; }
            *(LAS f32x4*)(part + (0 * 64 + ks) * 32 + cq * 4) = acc0;
            *(LAS f32x4*)(part + (1 * 64 + ks) * 32 + cq * 4) = acc1;
            *(LAS f32x4*)(part + (2 * 64 + ks) * 32 + cq * 4) = acc2;
            __syncthreads();
            if (tid < 96) { const int v = tid >> 5, col = tid & 31; float s = a.in[I_BMOD][l * 3072 + n0 + col];
                for (int k2 = 0; k2 < 64; ++k2) s += part[(v * 64 + k2) * 32 + col];
                MOD[(l * 3 + v) * 3072 + n0 + col] = s; }
            __syncthreads();
        }
    }
    { float* SP8 = (float*)(ws + WS_SP8); for (int idx = bx * NTHR + tid; idx < 2048; idx += G * NTHR) SP8[idx] = -8.0f * log1pf(__expf(-a.in[I_LAM][idx])); }
    {
        v4u* GWF = (v4u*)(ws + WS_GWF);
        for (int idx = bx * NTHR + tid; idx < 32768; idx += G * NTHR) {
            const int ln = idx & 63, kk = (idx >> 6) & 1, ct = (idx >> 7) & 3, h = (idx >> 9) & 7, g = (idx >> 12) & 1, d = (idx >> 13) & 1, l = idx >> 14;
            const float* W = (g == 0 ? a.in[I_WR] : a.in[I_WI]) + (size_t)(((l * 2 + d) * 8 + h) * 64) * 64;
            const int k0 = 32 * kk + 8 * (ln >> 4), col = 16 * ct + (ln & 15);
            float e[8];
#pragma unroll
            for (int j = 0; j < 8; ++j) e[j] = W[(k0 + j) * 64 + col];
            v4u o; o.x = pk2(e[0], e[1]); o.y = pk2(e[2], e[3]); o.z = pk2(e[4], e[5]); o.w = pk2(e[6], e[7]);
            GWF[idx] = o;
        }
    }
    {
        LAS float* scr = (LAS float*)(lds + wave * 16384);
        const int gw = bx * NWAVES + wave, NGW = G * NWAVES;
        constexpr int I_1 = (1024 / 64) * (NIN / 32), I_2 = (1024 / 64) * (1024 / 32), NITEMS = 2 * (I_1 + I_2);
        bf16* BT1 = (bf16*)(ws + WS_BT1); bf16* BT2 = (bf16*)(ws + WS_BT2);
        for (int it = gw; it < NITEMS; it += NGW) {
            int r = it;
            if (r < I_1) { p0_transpose_item(a.in[I_WIN], 1024, NIN, BT1, scr, r, lane, true); continue; } r -= I_1;
            if (r < I_1) { p0_transpose_item(a.in[I_WIN] + (size_t)1024 * NIN, 1024, NIN, BT1 + (size_t)NIN * 1024, scr, r, lane, true); continue; } r -= I_1;
            if (r < I_2) { p0_transpose_item(a.in[I_WOUT], 1024, 1024, BT2, scr, r, lane, false); continue; } r -= I_2;
            p0_transpose_item(a.in[I_WOUT] + (size_t)1024 * 1024, 1024, 1024, BT2 + (size_t)1024 * 1024, scr, r, lane, false);
        }
    }
}

__device__ __forceinline__ void norm_phase(const Args& a, int mode, int lane, int wave) {
    unsigned char* ws = a.ws;
    const float* MOD = (const float*)(ws + WS_MOD); const bf16* MIX = (const bf16*)(ws + WS_MIX); const float* SSQ = (const float*)(ws + WS_SSQ);
    float* XC1 = (float*)(ws + WS_XC1); bf16* H = (bf16*)(ws + WS_H);
    const int gw = blockIdx.x * NWAVES + wave, NGW = gridDim.x * NWAVES;
    const int nrows = (mode == 2) ? MLAT : MROWS, lu = (mode == 1) ? 0 : 1, ln = (mode == 0) ? 0 : 1;
    for (int row = gw; row < nrows; row += NGW) {
        const int vsel = row < MLAT ? (row >> 13) : 2;
        const float* src;
        if (mode == 2) src = a.out + (size_t)row * 1024;
        else src = row < MLAT ? a.in[I_X] + (size_t)row * 1024 : a.in[I_CTX] + (size_t)(row - MLAT) * 1024;
        f32x4 v[4];
#pragma unroll
        for (int j = 0; j < 4; ++j) v[j] = *((const f32x4*)src + lane + 64 * j);
        if (mode >= 1) {
            const float sp = lane < 16 ? SSQ[(size_t)row * 16 + lane] : 0.f;
            const float rstd = rsqrtf(wave_sum(sp) * (1.0f / 1024.0f) + EPSF);
            const float* gate = MOD + (lu * 3 + vsel) * 3072 + 2048; const float* gp = a.in[I_GPOST] + lu * 1024;
#pragma unroll
            for (int j = 0; j < 4; ++j) { const v2u mq = *((const v2u*)(MIX + (size_t)row * 1024) + lane + 64 * j); const f32x4 mx = {bflo(mq.x), bfhi(mq.x), bflo(mq.y), bfhi(mq.y)};
                const f32x4 gt = *((const f32x4*)gate + lane + 64 * j), gv = *((const f32x4*)gp + lane + 64 * j);
                v[j] += gt * (mx * rstd * gv); }
            float* dst = row < MLAT ? a.out + (size_t)row * 1024 : XC1 + (size_t)(row - MLAT) * 1024;
#pragma unroll
            for (int j = 0; j < 4; ++j) *((f32x4*)dst + lane + 64 * j) = v[j];
        }
        if (mode <= 1) {
            float s = 0.f;
#pragma unroll
            for (int j = 0; j < 4; ++j) s += (v[j].x * v[j].x + v[j].y * v[j].y) + (v[j].z * v[j].z + v[j].w * v[j].w);
            const float r = rsqrtf(wave_sum(s) * (1.0f / 1024.0f) + EPSF);
            const float* shift = MOD + (ln * 3 + vsel) * 3072; const float* scale = shift + 1024; const float* gpre = a.in[I_GPRE] + ln * 1024;
            v2u* o8 = (v2u*)(H + (size_t)row * 1024);
#pragma unroll
            for (int j = 0; j < 4; ++j) { const f32x4 sh = *((const f32x4*)shift + lane + 64 * j), sc = *((const f32x4*)scale + lane + 64 * j), gv = *((const f32x4*)gpre + lane + 64 * j);
                const f32x4 hv = v[j] * r * gv * (sc + 1.0f) + sh;
                v2u w; w.x = pk2(hv.x, hv.y); w.y = pk2(hv.z, hv.w); o8[lane + 64 * j] = w; }
        }
    }
}

__device__ __forceinline__ void conv16(const LAS unsigned* vt, const float (&w0)[31], const float (&w1)[31], float b0, float b1, bf16* ybase, size_t ystride) {
#pragma unroll 1
    for (int tq = 0; tq < 4; ++tq) {
        const LAS unsigned* vq = vt + tq * 4 * 128;
        float a0[4], a1[4];
#pragma unroll
        for (int t = 0; t < 4; ++t) { a0[t] = b0; a1[t] = b1; }
#pragma unroll
        for (int rr = 0; rr < 34; ++rr) { const unsigned u = vq[rr * 128]; const float lo = bflo(u), hi = bfhi(u);
#pragma unroll
            for (int t = 0; t < 4; ++t) { const int k = rr - t; if (k >= 0 && k < 31) { a0[t] += w0[k] * lo; a1[t] += w1[k] * hi; } }
            if ((rr & 7) == 7) asm volatile("" ::: "memory"); }
#pragma unroll
        for (int t = 0; t < 4; ++t) *(unsigned*)(ybase + (size_t)(tq * 4 + t) * ystride) = cvtpk(a0[t], a1[t]);
    }
}
__device__ __forceinline__ v4u glu8(const v4u vq, const v4u gq) {
    v4u o;
    o.x = pk2(bflo(vq.x) * sigmoidf_(bflo(gq.x)), bfhi(vq.x) * sigmoidf_(bfhi(gq.x)));
    o.y = pk2(bflo(vq.y) * sigmoidf_(bflo(gq.y)), bfhi(vq.y) * sigmoidf_(bfhi(gq.y)));
    o.z = pk2(bflo(vq.z) * sigmoidf_(bflo(gq.z)), bfhi(vq.z) * sigmoidf_(bfhi(gq.z)));
    o.w = pk2(bflo(vq.w) * sigmoidf_(bflo(gq.w)), bfhi(vq.w) * sigmoidf_(bfhi(gq.w)));
    return o;
}
__device__ __forceinline__ void hconv_unit(const Args& a, LAS unsigned char* lds, int l, int r0, int g, int vlo, int vhi, int tid) {
    const bf16* U = (const bf16*)(a.ws + WS_U); bf16* Y = (bf16*)(a.ws + WS_Y);
    LAS unsigned* VT = (LAS unsigned*)lds;
    {
        v4u vq[6];
#pragma unroll
        for (int it = 0; it < 6; ++it) { const int i = tid + it * NTHR, rr = i >> 5, ch = i & 31, row = r0 - 15 + rr; const bool ok = i < 94 * 32 && row >= vlo && row < vhi;
            vq[it] = *(const v4u*)(U + (size_t)(ok ? row : r0) * NIN + 1024 + g * 256 + ch * 8); }
#pragma unroll
        for (int it = 0; it < 6; ++it) { const int i = tid + it * NTHR, rr = i >> 5, ch = i & 31, row = r0 - 15 + rr; const bool ok = row >= vlo && row < vhi;
            if (i < 94 * 32) { const v4u z = {0u, 0u, 0u, 0u}; *(LAS v4u*)(VT + rr * 128 + ch * 4) = ok ? vq[it] : z; } }
    }
    __syncthreads();
    int p = tid & 127; asm volatile("" : "+v"(p));
    const int tg = tid >> 7, c0 = g * 256 + 2 * p;
    float w0[31], w1[31];
#pragma unroll
    for (int k = 0; k < 31; ++k) { const float2 w = *(const float2*)(a.in[I_DWW] + (size_t)(l * 31 + k) * 512 + c0); w0[k] = w.x; w1[k] = w.y; }
    const float2 bb = *(const float2*)(a.in[I_DWB] + l * 512 + c0);
    conv16(VT + (tg * 16) * 128 + p, w0, w1, bb.x, bb.y, Y + (size_t)(r0 + tg * 16) * 512 + c0, 512);
    __syncthreads();
}
__device__ __forceinline__ void vconv_unit(const Args& a, LAS unsigned char* lds, int l, int b, int w, int tid) {
    const bf16* U = (const bf16*)(a.ws + WS_U); bf16* Y = (bf16*)(a.ws + WS_Y);
    LAS unsigned* VT = (LAS unsigned*)lds;
#pragma unroll 1
    for (int hb = 0; hb < 2; ++hb) {
        v4u vq[5];
#pragma unroll
        for (int it = 0; it < 5; ++it) { const int i = tid + (hb * 5 + it) * NTHR, rr = i >> 5, ch = i & 31, gr = rr - 15; const bool ok = i < 158 * 32 && gr >= 0 && gr < 128;
            vq[it] = *(const v4u*)(U + (size_t)(b * SEQ + (ok ? gr : 0) * 64 + w) * NIN + 1024 + 256 + ch * 8); }
#pragma unroll
        for (int it = 0; it < 5; ++it) { const int i = tid + (hb * 5 + it) * NTHR, rr = i >> 5, ch = i & 31, gr = rr - 15; const bool ok = gr >= 0 && gr < 128;
            if (i < 158 * 32) { const v4u z = {0u, 0u, 0u, 0u}; *(LAS v4u*)(VT + rr * 128 + ch * 4) = ok ? vq[it] : z; } }
    }
    __syncthreads();
    int p = tid & 127; asm volatile("" : "+v"(p));
    const int tg = tid >> 7, c0 = 256 + 2 * p;
    float w0[31], w1[31];
#pragma unroll
    for (int k = 0; k < 31; ++k) { const float2 wv = *(const float2*)(a.in[I_DWW] + (size_t)(l * 31 + k) * 512 + c0); w0[k] = wv.x; w1[k] = wv.y; }
    const float2 bb = *(const float2*)(a.in[I_DWB] + l * 512 + c0);
#pragma unroll 1
    for (int half = 0; half < 2; ++half) {
        const int tb = tg * 32 + half * 16;
        conv16(VT + tb * 128 + p, w0, w1, bb.x, bb.y, Y + (size_t)(b * SEQ + tb * 64 + w) * 512 + c0, (size_t)64 * 512);
    }
    __syncthreads();
}
__device__ __forceinline__ void ln_rows(const Args& a, int l, int nrows, int lane, int wave, int nblk) {
    const bf16* U = (const bf16*)(a.ws + WS_U); const bf16* Y = (const bf16*)(a.ws + WS_Y); bf16* MIXIN = (bf16*)(a.ws + WS_MIXIN);
    if ((int)blockIdx.x >= nblk) return;
    const int gw = blockIdx.x * NWAVES + wave, NGW = nblk * NWAVES, c0 = lane * 8;
    float lg[8], lb[8];
#pragma unroll
    for (int e = 0; e < 8; ++e) { lg[e] = a.in[I_LNG][l * 512 + c0 + e]; lb[e] = a.in[I_LNB][l * 512 + c0 + e]; }
    for (int row = gw; row < nrows; row += NGW) {
        const v4u yq = *(const v4u*)(Y + (size_t)row * 512 + c0); const v4u gq = *(const v4u*)(U + (size_t)row * NIN + 2048 + c0);
        float y[8] = {bflo(yq.x), bfhi(yq.x), bflo(yq.y), bfhi(yq.y), bflo(yq.z), bfhi(yq.z), bflo(yq.w), bfhi(yq.w)};
        const float gt[8] = {bflo(gq.x), bfhi(gq.x), bflo(gq.y), bfhi(gq.y), bflo(gq.z), bfhi(gq.z), bflo(gq.w), bfhi(gq.w)};
        float s = 0.f;
#pragma unroll
        for (int e = 0; e < 8; ++e) s += y[e];
        const float mean = wave_sum(s) * (1.0f / 512.0f); float q = 0.f;
#pragma unroll
        for (int e = 0; e < 8; ++e) { y[e] -= mean; q += y[e] * y[e]; }
        const float rstd = rsqrtf(wave_sum(q) * (1.0f / 512.0f) + EPSF);
        float o[8];
#pragma unroll
        for (int e = 0; e < 8; ++e) o[e] = siluf_(y[e] * rstd * lg[e] + lb[e]) * gt[e];
        v4u w; w.x = pk2(o[0], o[1]); w.y = pk2(o[2], o[3]); w.z = pk2(o[4], o[5]); w.w = pk2(o[6], o[7]);
        *(v4u*)(MIXIN + (size_t)row * 1024 + 512 + c0) = w;
    }
}

constexpr int RG_GW = 0, RG_FOLD = 32768, RG_F8 = 36864, RG_CAR = 40960, RG_WAVE = 57344, RG_WAVE_BYTES = 12544;
constexpr int NP16 = 4 * NPJ;
__device__ __forceinline__ float fsig(float x) { return __builtin_amdgcn_rcpf(1.0f + __expf(-x)); }

template <bool FINAL, bool FASTP>
__device__ __forceinline__ void rg_sweep(const Args& a, LAS unsigned char* lds, LAS unsigned char* wl, int l, int b, int h, int r0, int seg_lo, int seg_hi, int pj, bool is_ctx, int w, int lane, const int D) {
    const bf16* U = (const bf16*)(a.ws + WS_U); bf16* MIXIN = (bf16*)(a.ws + WS_MIXIN);
    float* AGGA = (float*)(a.ws + WS_AGGA); float* AGGB = (float*)(a.ws + WS_AGGB); float* A16 = (float*)(a.ws + WS_A16); float* B16 = (float*)(a.ws + WS_B16);
    LAS float* VCW = (LAS float*)wl; LAS unsigned* HBW = (LAS unsigned*)(wl + 4352);
    const LAS v4u* GWL = (const LAS v4u*)(lds + RG_GW) + (D * 2) * 8 * 64 + lane;
    const LAS float* CAR = (const LAS float*)(lds + RG_CAR);
    const int fr = lane & 15, fq = lane >> 4, cp = lane & 31, rh = lane >> 5;
    const int rbase = D ? r0 + 63 : r0, rsign = D ? -1 : 1;
    float2 cw[4];
#pragma unroll
    for (int k = 0; k < 4; ++k) cw[k] = *(const float2*)(a.in[I_CAW] + (size_t)((l * 2 + D) * 4 + (D ? 3 - k : k)) * 512 + 64 * h + 2 * cp);
    const float2 cbv = *(const float2*)(a.in[I_CAB] + (l * 2 + D) * 512 + 64 * h + 2 * cp);
    float brv[4], biv[4], sp8[4], Hc[4], Ac[4];
    const int p16own = 4 * pj + fq;
#pragma unroll
    for (int ct = 0; ct < 4; ++ct) { const int c = 16 * ct + fr, pidx = (l * 2 + D) * 512 + 64 * h + c;
        brv[ct] = a.in[I_BR][pidx]; biv[ct] = a.in[I_BI][pidx]; sp8[ct] = ((const float*)(a.ws + WS_SP8))[pidx];
        Hc[ct] = 0.f; Ac[ct] = 1.f;
        if (FINAL) {
            if (is_ctx) { const size_t base = (size_t)((b * 2 + D) * NP16) * 512 + 64 * h + c; float S = 0.f;
                for (int i = 0; i < p16own; ++i) S = A16[base + (size_t)i * 512] * S + B16[base + (size_t)i * 512];
                Hc[ct] = S; }
            else Hc[ct] = CAR[(D * 32 + 4 * (D ? 7 - w : w) + fq) * 64 + c];
        } }
    const bf16* ub = U + 64 * h + 2 * cp;
    unsigned Wd[2][7], nx[2][4];
#pragma unroll
    for (int q = 0; q < 2; ++q) { const int g = 2 * rh + q;
#pragma unroll
        for (int j = 0; j < 3; ++j) { const int row = rbase + rsign * (16 * g - 3 + j); const bool ok = row >= seg_lo && row < seg_hi; const int rc = ok ? row : r0;
            const unsigned v = *(const unsigned*)(ub + (size_t)rc * NIN); Wd[q][4 + j] = ok ? v : 0u; }
#pragma unroll
        for (int j = 0; j < 4; ++j) nx[q][j] = *(const unsigned*)(ub + (size_t)(rbase + rsign * (16 * g + j)) * NIN); }
#pragma unroll 1
    for (int ti = 0; ti < 4; ++ti) {
        const int tile = ti;
        int zo = 0; asm volatile("" : "+v"(zo));
        const LAS v4u* GWLt = GWL + zo;
        v4u g0 = {0u, 0u, 0u, 0u}, g1 = g0; size_t orow = 0;
        if (FINAL && D == 0) { orow = (size_t)(r0 + 16 * (fr >> 2) + 4 * tile + (fr & 3)); const bf16* gp = U + orow * NIN + 512 + 64 * h + 16 * fq; g0 = *(const v4u*)gp; g1 = *(const v4u*)(gp + 8); }
#pragma unroll
        for (int q = 0; q < 2; ++q) {
            Wd[q][0] = Wd[q][4]; Wd[q][1] = Wd[q][5]; Wd[q][2] = Wd[q][6]; Wd[q][3] = nx[q][0]; Wd[q][4] = nx[q][1]; Wd[q][5] = nx[q][2]; Wd[q][6] = nx[q][3]; }
        if (ti < 3) { const int tn = ti + 1;
#pragma unroll
            for (int q = 0; q < 2; ++q)
#pragma unroll
                for (int j = 0; j < 4; ++j) nx[q][j] = *(const unsigned*)(ub + (size_t)(rbase + rsign * (16 * (2 * rh + q) + 4 * tn + j)) * NIN); }
#pragma unroll
        for (int q = 0; q < 2; ++q)
#pragma unroll
            for (int jj = 0; jj < 4; ++jj) { float v0 = cbv.x, v1 = cbv.y;
#pragma unroll
                for (int k = 0; k < 4; ++k) { const unsigned u = Wd[q][jj + k]; v0 += cw[k].x * bflo(u); v1 += cw[k].y * bfhi(u); }
                *(LAS f32x2v*)(VCW + (4 * (2 * rh + q) + jj) * 68 + 2 * cp) = (f32x2v){v0, v1}; }
        bf16x8 af[2];
#pragma unroll
        for (int kk = 0; kk < 2; ++kk) { const LAS float* vp = VCW + fr * 68 + 32 * kk + 8 * fq; const f32x4 x0 = *(const LAS f32x4*)vp, x1 = *(const LAS f32x4*)(vp + 4);
            v4u pk; pk.x = cvtpk(x0.x, x0.y); pk.y = cvtpk(x0.z, x0.w); pk.z = cvtpk(x1.x, x1.y); pk.w = cvtpk(x1.z, x1.w); af[kk] = __builtin_bit_cast(bf16x8, pk); }
        float vcv[4][4];
#pragma unroll
        for (int ct = 0; ct < 4; ++ct)
#pragma unroll
            for (int jj = 0; jj < 4; ++jj) vcv[ct][jj] = VCW[(4 * fq + jj) * 68 + 16 * ct + fr];
        f32x4 accr[4], acci[4];
#pragma unroll
        for (int ct = 0; ct < 4; ++ct) { accr[ct] = (f32x4){0.f, 0.f, 0.f, 0.f}; acci[ct] = accr[ct];
#pragma unroll
            for (int kk = 0; kk < 2; ++kk) { const bf16x8 br = __builtin_bit_cast(bf16x8, GWLt[(ct * 2 + kk) * 64]), bi = __builtin_bit_cast(bf16x8, GWLt[(8 + ct * 2 + kk) * 64]);
                accr[ct] = __builtin_amdgcn_mfma_f32_16x16x32_bf16(af[kk], br, accr[ct], 0, 0, 0); acci[ct] = __builtin_amdgcn_mfma_f32_16x16x32_bf16(af[kk], bi, acci[ct], 0, 0, 0); } }
        float hsum[4][4];
#pragma unroll
        for (int ct = 0; ct < 4; ++ct) { float aa[4], bb[4];
            const float nbr = -1.44269504f * brv[ct], nbi = -1.44269504f * biv[ct];
#pragma unroll
            for (int p = 0; p < 2; ++p) {
                f32x2v xr = (f32x2v){accr[ct][2 * p], accr[ct][2 * p + 1]} * -1.44269504f + nbr, xi = (f32x2v){acci[ct][2 * p], acci[ct][2 * p + 1]} * -1.44269504f + nbi;
                xr = __builtin_elementwise_min(xr, (f32x2v){60.f, 60.f}); xi = __builtin_elementwise_min(xi, (f32x2v){60.f, 60.f});
                f32x2v d1, d2; d1.x = __builtin_amdgcn_exp2f(xr.x); d1.y = __builtin_amdgcn_exp2f(xr.y); d2.x = __builtin_amdgcn_exp2f(xi.x); d2.y = __builtin_amdgcn_exp2f(xi.y);
                d1 = d1 + 1.0f; d2 = d2 + 1.0f; const f32x2v m = d1 * d2; f32x2v inv; inv.x = __builtin_amdgcn_rcpf(m.x); inv.y = __builtin_amdgcn_rcpf(m.y);
                const f32x2v r = d2 * inv, ig = d1 * inv, la = r * sp8[ct], x2 = la + la, le = la * 1.44269504f;
                const f32x2v pom = -x2 * (x2 * (x2 * (x2 * (x2 * 0.0083333338f + 0.041666668f) + 0.16666667f) + 0.5f) + 1.0f);
                f32x2v av, om;
                if (FASTP) { av = la * (la * (la * (la * (la * 0.0083333338f + 0.041666668f) + 0.16666667f) + 0.5f) + 1.0f) + 1.0f; om = pom; }
                else { av.x = __builtin_amdgcn_exp2f(le.x); av.y = __builtin_amdgcn_exp2f(le.y);
                    const f32x2v o2 = 1.0f - av * av; om.x = x2.x > -0.25f ? pom.x : o2.x; om.y = x2.y > -0.25f ? pom.y : o2.y;
                    om = __builtin_elementwise_max(om, (f32x2v){0.f, 0.f}); }
                f32x2v sq; sq.x = __builtin_amdgcn_sqrtf(om.x); sq.y = __builtin_amdgcn_sqrtf(om.y);
                const f32x2v bv = sq * (ig * (f32x2v){vcv[ct][2 * p], vcv[ct][2 * p + 1]});
                aa[2 * p] = av.x; aa[2 * p + 1] = av.y; bb[2 * p] = bv.x; bb[2 * p + 1] = bv.y; }
            float hh = Hc[ct], A4 = 1.f;
#pragma unroll
            for (int jj = 0; jj < 4; ++jj) { hh = aa[jj] * hh + bb[jj]; A4 *= aa[jj]; hsum[ct][jj] = hh; }
            Hc[ct] = hh; if (!FINAL) Ac[ct] *= A4; }
        if (FINAL) {
            if (D == 1) {
#pragma unroll
                for (int ct = 0; ct < 4; ++ct)
#pragma unroll
                    for (int jp = 0; jp < 2; ++jp) HBW[(tile * 8 + ct * 2 + jp) * 64 + lane] = cvtpk(hsum[ct][2 * jp], hsum[ct][2 * jp + 1]);
            } else {
#pragma unroll
                for (int ct = 0; ct < 4; ++ct)
#pragma unroll
                    for (int jp = 0; jp < 2; ++jp) {
                        const unsigned hb = HBW[((3 - tile) * 8 + ct * 2 + (1 - jp)) * 64 + fr + 16 * (3 - fq)];
                        VCW[(4 * fq + 2 * jp) * 68 + 16 * ct + fr] = hsum[ct][2 * jp] + bfhi(hb); VCW[(4 * fq + 2 * jp + 1) * 68 + 16 * ct + fr] = hsum[ct][2 * jp + 1] + bflo(hb); }
                const size_t row = orow;
                const f32x4 s0 = *(const LAS f32x4*)(VCW + fr * 68 + 16 * fq), s1 = *(const LAS f32x4*)(VCW + fr * 68 + 16 * fq + 4), s2 = *(const LAS f32x4*)(VCW + fr * 68 + 16 * fq + 8), s3 = *(const LAS f32x4*)(VCW + fr * 68 + 16 * fq + 12);
                v4u o0, o1;
                o0.x = cvtpk(s0.x * bflo(g0.x), s0.y * bfhi(g0.x)); o0.y = cvtpk(s0.z * bflo(g0.y), s0.w * bfhi(g0.y)); o0.z = cvtpk(s1.x * bflo(g0.z), s1.y * bfhi(g0.z)); o0.w = cvtpk(s1.z * bflo(g0.w), s1.w * bfhi(g0.w));
                o1.x = cvtpk(s2.x * bflo(g1.x), s2.y * bfhi(g1.x)); o1.y = cvtpk(s2.z * bflo(g1.y), s2.w * bfhi(g1.y)); o1.z = cvtpk(s3.x * bflo(g1.z), s3.y * bfhi(g1.z)); o1.w = cvtpk(s3.z * bflo(g1.w), s3.w * bfhi(g1.w));
                bf16* op = MIXIN + row * 1024 + 64 * h + 16 * fq; *(v4u*)op = o0; *(v4u*)(op + 8) = o1;
            }
        }
    }
    if (!FINAL) {
#pragma unroll
        for (int ct = 0; ct < 4; ++ct) { const int c = 16 * ct + fr;
            const size_t i16 = (size_t)((b * 2 + D) * NP16 + p16own) * 512 + 64 * h + c; A16[i16] = Ac[ct]; B16[i16] = Hc[ct];
            float Ag[4], Bg[4];
#pragma unroll
            for (int g = 0; g < 4; ++g) { Ag[g] = __shfl(Ac[ct], fr + 16 * g); Bg[g] = __shfl(Hc[ct], fr + 16 * g); }
            float run = 0.f;
#pragma unroll
            for (int g = 0; g < 4; ++g) run = Ag[g] * run + Bg[g];
            if (fq == 0) { const size_t idx = (size_t)((b * 2 + D) * NPJ + pj) * 512 + 64 * h + c; AGGA[idx] = (Ag[0] * Ag[1]) * (Ag[2] * Ag[3]); AGGB[idx] = run; } }
    }
}

template <bool FINAL>
__device__ __forceinline__ void rg_run(const Args& a, LAS unsigned char* lds, int l, int rn, int tid, int lane, int wave) {
    const bool is_ctx = rn >= 256; const int bh = is_ctx ? rn - 256 : rn >> 4, b = bh >> 3, h = bh & 7, cgp = is_ctx ? 0 : (rn & 15);
    { const v4u* GWF = (const v4u*)(a.ws + WS_GWF); LAS v4u* GWL = (LAS v4u*)(lds + RG_GW);
#pragma unroll
      for (int i = tid; i < 2048; i += NTHR) { const int d = i >> 10, g = (i >> 9) & 1, rest = i & 511; GWL[i] = GWF[(size_t)((((l * 2 + d) * 2 + g) * 8 + h) * 8) * 64 + rest]; } }
    const int P0f = 4 + 8 * cgp, P0b = 124 - 8 * cgp;
    if (FINAL && !is_ctx) {
        const float* AGGA = (const float*)(a.ws + WS_AGGA); const float* AGGB = (const float*)(a.ws + WS_AGGB); const float* A16 = (const float*)(a.ws + WS_A16); const float* B16 = (const float*)(a.ws + WS_B16);
        const int d = tid >> 8, s = (tid >> 6) & 3, c = tid & 63, P0 = d ? P0b : P0f, lo = (P0 * s) >> 2, hi = (P0 * (s + 1)) >> 2;
        const size_t b16 = (size_t)((b * 2 + d) * NP16 + 4 * P0 + 8 * s) * 512 + 64 * h + c; float ai8[8], bi8[8];
#pragma unroll
        for (int i = 0; i < 8; ++i) { ai8[i] = A16[b16 + (size_t)i * 512]; bi8[i] = B16[b16 + (size_t)i * 512]; }
        const size_t base = (size_t)((b * 2 + d) * NPJ) * 512 + 64 * h + c; float A = 1.f, Bv = 0.f;
#pragma unroll 8
        for (int i = lo; i < hi; ++i) { const float ai = AGGA[base + (size_t)i * 512], bi = AGGB[base + (size_t)i * 512]; Bv = ai * Bv + bi; A *= ai; }
        LAS float* FO = (LAS float*)(lds + RG_FOLD); LAS float* F8 = (LAS float*)(lds + RG_F8); LAS float* CAR = (LAS float*)(lds + RG_CAR);
        FO[((d * 4 + s) * 64 + c) * 2] = A; FO[((d * 4 + s) * 64 + c) * 2 + 1] = Bv;
        float A8 = 1.f, B8 = 0.f;
#pragma unroll
        for (int i = 0; i < 8; ++i) { B8 = ai8[i] * B8 + bi8[i]; A8 *= ai8[i]; }
        F8[((d * 4 + s) * 64 + c) * 2] = A8; F8[((d * 4 + s) * 64 + c) * 2 + 1] = B8;
        __syncthreads();
        float S = 0.f;
#pragma unroll
        for (int s2 = 0; s2 < 4; ++s2) S = FO[((d * 4 + s2) * 64 + c) * 2] * S + FO[((d * 4 + s2) * 64 + c) * 2 + 1];
#pragma unroll
        for (int s2 = 0; s2 < 3; ++s2) if (s2 < s) S = F8[((d * 4 + s2) * 64 + c) * 2] * S + F8[((d * 4 + s2) * 64 + c) * 2 + 1];
#pragma unroll
        for (int i = 0; i < 8; ++i) { CAR[(d * 32 + 8 * s + i) * 64 + c] = S; S = ai8[i] * S + bi8[i]; }
    }
    __syncthreads();
    if (wave < (is_ctx ? 4 : 8)) {
        const int j = is_ctx ? wave : 8 * cgp + wave;
        const int seg_lo = is_ctx ? MLAT + b * CTXL : b * SEQ, seg_hi = seg_lo + (is_ctx ? CTXL : SEQ), r0 = seg_lo + 64 * j;
        const int pjf = is_ctx ? j : 4 + j, pjb = is_ctx ? 3 - j : 131 - j;
        LAS unsigned char* wl = lds + RG_WAVE + wave * RG_WAVE_BYTES;
        const float* SP8 = (const float*)(a.ws + WS_SP8);
        const bool fast1 = !__any(SP8[(l * 2 + 1) * 512 + 64 * h + lane] < -0.25f), fast0 = !__any(SP8[(l * 2 + 0) * 512 + 64 * h + lane] < -0.25f);
#pragma unroll 1
        for (int it = 0; it < 2; ++it) { const int D = 1 - it, pj = D ? pjb : pjf; const bool fast = D ? fast1 : fast0;
            if (fast) rg_sweep<FINAL, true>(a, lds, wl, l, b, h, r0, seg_lo, seg_hi, pj, is_ctx, wave, lane, D); else rg_sweep<FINAL, false>(a, lds, wl, l, b, h, r0, seg_lo, seg_hi, pj, is_ctx, wave, lane, D); }
    }
    __syncthreads();
}

#define RLX_AGENT __ATOMIC_RELAXED, __HIP_MEMORY_SCOPE_AGENT


#define XB_TMO      128
#define XB_XCNT(j)  (256  + 64 * (j))
#define XB_XSUB(j)  (1280 + 64 * (j))
#define XB_XGEN(j)  (2304 + 64 * (j))
#define XB_TOP      3328
#define XB_TOPGEN   3392
#define XCD_BAR_WORDS 3456
#define XB_SPIN_CAP (1u << 18)

__device__ __forceinline__ unsigned xb_ld(unsigned* p)              { return __hip_atomic_load(p, __ATOMIC_RELAXED, __HIP_MEMORY_SCOPE_AGENT); }
__device__ __forceinline__ unsigned xb_add(unsigned* p, unsigned v) { return __hip_atomic_fetch_add(p, v, __ATOMIC_RELAXED, __HIP_MEMORY_SCOPE_AGENT); }
__device__ __forceinline__ unsigned xb_xcc_id() { return (unsigned)__builtin_amdgcn_s_getreg((3 << 11) | 20) & 0xFu; }
#define XB_SPIN(cond, bar) do { unsigned _sp = 0; while (cond) { __builtin_amdgcn_s_sleep(1); \
    if ((++_sp & 255u) == 0u) { if (xb_ld(&(bar)[XB_TMO])) break; if (_sp > XB_SPIN_CAP) { atomicAdd(&(bar)[XB_TMO], 1u); break; } } } } while (0)

struct XcdBarrier {
    unsigned* bar; unsigned x;
    volatile LAS unsigned* st;
};

__device__ __forceinline__ XcdBarrier xcd_barrier_post(unsigned* bar, volatile LAS unsigned* st) {
    XcdBarrier b; b.bar = bar; b.x = xb_xcc_id(); b.st = st;
    if (threadIdx.x == 0) (void)xb_add(&bar[XB_XCNT(b.x)], 1u);
    return b;
}
__device__ __forceinline__ void xcd_barrier_complete(unsigned* bar, unsigned x, unsigned& nloc, unsigned& nx) {
    const unsigned G = gridDim.x * gridDim.y * gridDim.z;
    unsigned sum, cnt, mine, sp = 0u;
    for (;;) {
        sum = 0u; cnt = 0u; mine = 0u;
#pragma unroll
        for (unsigned j = 0; j < 16; ++j) { const unsigned c = xb_ld(&bar[XB_XCNT(j)]); sum += c; cnt += (c > 0u) ? 1u : 0u; mine = (j == x) ? c : mine; }
        if (sum == G) break;
        __builtin_amdgcn_s_sleep(1);
        if ((++sp & 255u) == 0u) { if (xb_ld(&bar[XB_TMO])) break; if (sp > XB_SPIN_CAP) { atomicAdd(&bar[XB_TMO], 1u); break; } }
    }
    nloc = mine > 0u ? mine : 1u; nx = cnt > 0u ? cnt : 1u;
}

__device__ __forceinline__ void xcd_barrier(const XcdBarrier& b) {
    asm volatile("s_waitcnt vmcnt(0)" ::: "memory");
    __syncthreads();
    if (threadIdx.x == 0) {
        unsigned* bar = b.bar;
        __builtin_amdgcn_s_waitcnt(0);
        unsigned nloc = b.st[0], nx = b.st[1];
        if (nloc == 0u) { xcd_barrier_complete(bar, b.x, nloc, nx); b.st[0] = nloc; b.st[1] = nx; }
        const unsigned old = xb_add(&bar[XB_XSUB(b.x)], 1u);
        const unsigned gen = old / nloc;
        if (old + 1u == (gen + 1u) * nloc) {
            __builtin_amdgcn_fence(__ATOMIC_RELEASE, "agent");
            asm volatile("s_waitcnt vmcnt(0)" ::: "memory");
            const unsigned og = xb_add(&bar[XB_TOP], 1u);
            const unsigned tg = og / nx;
            if (og + 1u == (tg + 1u) * nx) xb_add(&bar[XB_TOPGEN], 1u);
            else XB_SPIN(xb_ld(&bar[XB_TOPGEN]) == tg, bar);
            __builtin_amdgcn_fence(__ATOMIC_ACQUIRE, "agent");
            xb_add(&bar[XB_XGEN(b.x)], 1u);
            asm volatile("s_waitcnt vmcnt(0)" ::: "memory");
        } else {
            XB_SPIN(xb_ld(&bar[XB_XGEN(b.x)]) == gen, bar);
            __builtin_amdgcn_fence(__ATOMIC_ACQUIRE, "agent");
            asm volatile("s_waitcnt vmcnt(0)" ::: "memory");
        }
    }
    __syncthreads();
}

__device__ __forceinline__ void layer_phases(int l, const Args& args, LAS unsigned char* lds, const int tid0, const int lo, const int hi, const XcdBarrier& xbar) {
    const int G = gridDim.x; unsigned char* ws = args.ws;
    const int pb = 1 + 5 * l;
#define LAUNDER() int tid = tid0; asm volatile("" : "+v"(tid)); const int lane = tid & 63, wave = __builtin_amdgcn_readfirstlane(tid >> 6); int bx = blockIdx.x; asm volatile("" : "+s"(bx)); (void)lane; (void)wave; (void)bx
#define IN(k) (lo <= (k) && (k) < hi)
#define SEAM(k) do { if (IN(k) && IN((k) + 1)) { xcd_barrier(xbar); } } while (0)
        if (IN(pb)) { LAUNDER(); norm_phase(args, l, lane, wave); }
        SEAM(pb);
        if (IN(pb + 1)) { LAUNDER();
            pg8::Gemm g{(const pg8::bf16_t*)(ws + WS_H), (const pg8::bf16_t*)(ws + WS_BT1) + (size_t)l * NIN * 1024, MROWS, NIN, 1024};
            pg8::StaticOrder S; S.init(MROWS, NIN, G, bx);
            pg8::EpiU E{(pg8::bf16_t*)(ws + WS_U)};
            pg8::gemm_phase<pg8::EpiU, pg8::StaticOrder, true, true>(lds, g, S, E);
        }
        SEAM(pb + 1);
        if (IN(pb + 2)) { LAUNDER();
            const int nrun = (bx >= G - 16) ? 2 : 1;
#pragma unroll 1
            for (int k = 0; k < nrun; ++k) rg_run<false>(args, lds, l, k == 0 ? bx : 256 + (G - 1 - bx), tid, lane, wave);
            const int n_h = 256 + (l == 0 ? 16 : 0), n_conv = 128 + n_h;
            const int GC = G - 16;
            for (int un = bx; un < n_conv && bx < GC; un += GC) {
                if (un < 128) { vconv_unit(args, lds, l, un >> 6, un & 63, tid); }
                else { const int hu = un - 128;
                    if (hu < 256) hconv_unit(args, lds, l, hu * 64, 0, hu * 64, hu * 64 + 64, tid);
                    else { const int cu = hu - 256, cc = cu >> 1, g = cu & 1, bb = cc >> 2; hconv_unit(args, lds, l, MLAT + cc * 64, g, MLAT + bb * CTXL, MLAT + bb * CTXL + CTXL, tid); } }
            }
        }
        SEAM(pb + 2);
        if (IN(pb + 3)) { LAUNDER();
            const int nrun = (l == 0 && bx >= G - 16) ? 2 : 1;
#pragma unroll 1
            for (int k = 0; k < nrun; ++k) rg_run<true>(args, lds, l, k == 0 ? bx : 256 + (G - 1 - bx), tid, lane, wave);
            ln_rows(args, l, (l == 0) ? MROWS : MLAT, lane, wave, (l == 0) ? G - 16 : G);
        }
        SEAM(pb + 3);
        if (IN(pb + 4)) { LAUNDER();
            const int M2 = (l == 0) ? MROWS : MLAT;
            pg8::Gemm g{(const pg8::bf16_t*)(ws + WS_MIXIN), (const pg8::bf16_t*)(ws + WS_BT2) + (size_t)l * 1024 * 1024, M2, 1024, 1024};
            pg8::StaticOrder S; S.init(M2, 1024, G, bx);
            pg8::EpiMix E{(pg8::bf16_t*)(ws + WS_MIX), (float*)(ws + WS_SSQ)};
            pg8::gemm_phase<pg8::EpiMix, pg8::StaticOrder, true, true>(lds, g, S, E);
        }
        SEAM(pb + 4);
#undef IN
#undef SEAM
#undef LAUNDER
}

__global__ void __launch_bounds__(NTHR, 2) fwd_megakernel(Args args) {
    extern __shared__ __attribute__((aligned(16))) unsigned char lds_raw[];
    LAS unsigned char* lds = (LAS unsigned char*)lds_raw;
    const int tid = threadIdx.x, lane = tid & 63, wave = __builtin_amdgcn_readfirstlane(tid >> 6);
    const int G = gridDim.x, bx = blockIdx.x;
    unsigned char* ws = args.ws;
    const int lo = args.ph_lo, hi = args.ph_hi;
    if (args.coop == 2) cg::this_grid().sync();
    volatile LAS unsigned* MISC = (volatile LAS unsigned*)(lds + MISC_OFF);
    if (tid < 64) MISC[tid] = 0u;
    __syncthreads();
    XcdBarrier xbar; xbar.bar = (unsigned*)(ws + WS_CTL); xbar.x = 0; xbar.st = nullptr;
    if (args.coop == 1) xbar = xcd_barrier_post((unsigned*)(ws + WS_CTL), MISC + 8);
#define IN(k) (lo <= (k) && (k) < hi)
#define SEAM(k) do { if (IN(k) && IN((k) + 1)) { xcd_barrier(xbar); } } while (0)

    if (IN(0)) { p0_prologue(args, lds, tid, lane, wave); }
    SEAM(0);
#pragma unroll 1
    for (int l = 0; l < 2; ++l) { int lo_ = l; asm volatile("" : "+s"(lo_)); layer_phases(lo_, args, lds, tid, lo, hi, xbar); }
    if (IN(11)) { norm_phase(args, 2, lane, wave); }
#undef IN
#undef SEAM
}

#ifndef MK_PER_PHASE
#define MK_PER_PHASE 0
#endif
extern "C" void kernel_launch(void* const* d_in, const int* in_sizes, int n_in, void* d_out, int out_size, void* d_ws, size_t ws_size, hipStream_t stream) {
    static int grid = 0;
    if (grid == 0) {
        if (n_in != 21 || out_size != MLAT * DM || ws_size < WS_END) { fprintf(stderr, "kernel_launch: unexpected shapes (n_in %d, out %d, ws %zu)\n", n_in, out_size, ws_size); grid = -1; return; }
        int dev = 0, cus = 0, per_cu = 0;
        if (hipGetDevice(&dev) != hipSuccess || hipDeviceGetAttribute(&cus, hipDeviceAttributeMultiprocessorCount, dev) != hipSuccess) { grid = -1; return; }
        if (hipFuncSetAttribute((const void*)fwd_megakernel, hipFuncAttributeMaxDynamicSharedMemorySize, LDS_BYTES) != hipSuccess) { fprintf(stderr, "kernel_launch: hipFuncSetAttribute failed\n"); grid = -1; return; }
        if (hipOccupancyMaxActiveBlocksPerMultiprocessor(&per_cu, (const void*)fwd_megakernel, NTHR, LDS_BYTES) != hipSuccess || per_cu < 1) { fprintf(stderr, "kernel_launch: occupancy query says %d\n", per_cu); per_cu = 1; }
        (void)hipGetLastError();
        grid = cus;
    }
    if (grid < 0) return;
    if (hipMemsetAsync((char*)d_ws + WS_CTL, 0, CTL_ZERO_BYTES, stream) != hipSuccess) { fprintf(stderr, "kernel_launch: memset failed\n"); return; }
    Args a{};
    for (int i = 0; i < 21; ++i) a.in[i] = (const float*)d_in[i];
    a.out = (float*)d_out; a.ws = (unsigned char*)d_ws;
#if MK_PER_PHASE
    for (int ph = 0; ph < 12; ++ph) { a.ph_lo = ph; a.ph_hi = ph + 1; a.coop = 0;
        hipLaunchKernelGGL(fwd_megakernel, dim3(grid), dim3(NTHR), LDS_BYTES, stream, a); }
#else
    a.ph_lo = 0; a.ph_hi = 12; a.coop = 1;
    void* kargs[] = {&a};
    hipError_t e = hipLaunchCooperativeKernel((const void*)fwd_megakernel, dim3(grid), dim3(NTHR), kargs, LDS_BYTES, stream);
    if (e != hipSuccess) fprintf(stderr, "cooperative launch failed: %s (grid %d)\n", hipGetErrorString(e), grid);
#endif
}
```

```cpp
#include <hip/hip_runtime.h>
#include <hip/hip_cooperative_groups.h>
#include <cstdio>
#include <cstdint>
namespace cg = cooperative_groups;
#define MK_PER_PHASE 0
namespace pg8 {
#define PG8_LAS __attribute__((address_space(3)))
typedef unsigned short bf16_t;
typedef short bf16x8 __attribute__((ext_vector_type(8)));
typedef float f32x4 __attribute__((ext_vector_type(4)));
typedef unsigned u32x4 __attribute__((ext_vector_type(4)));
constexpr int BM = 256, BK = 64, HALF = 128, HTB = HALF * BK * 2  , STAGE_BYTES = 8 * HTB, NXCD = 8, WGM = 8;

__host__ __device__ __forceinline__ int lds_byte(int r, int c) { const int st = (r >> 4) * 2 + (c >> 5), rr = r & 15, cc = c & 31, ob = rr * 64 + cc * 2; return st * 1024 + (ob ^ (((ob >> 9) & 1) << 5)); }
__host__ __device__ __forceinline__ void stage_rc(int b, int& R, int& C) { const int st = b / 1024, sb = b % 1024, swz = sb ^ (((sb >> 9) & 1) << 5); R = (st >> 1) * 16 + swz / 64; C = (st & 1) * 32 + (swz % 64) / 2; }
__host__ __device__ __forceinline__ int perm32(int rho) { const int n = rho >> 4, i = rho & 15; return 8 * (i >> 2) + 4 * n + (i & 3); }

struct Unit { int pm, pn; };
struct Gemm { const bf16_t* A; const bf16_t* Bt; int M, N, K; };

struct StaticOrder {
    int nM, nN, nwg, G, c;
    __host__ __device__ void init(int M, int N, int G_, int c_) { nM = M / BM; nN = N / BM; nwg = nM * nN; G = G_; c = c_; }
    __host__ __device__ bool next(int i, Unit& u) const {
        const long L = (long)i * G + c; if (L >= nwg) return false;
        int wgid = (int)L; { const int q = nwg / NXCD, r = nwg % NXCD, xcd = wgid % NXCD, off = wgid / NXCD; wgid = (xcd < r ? xcd * (q + 1) : r * (q + 1) + (xcd - r) * q) + off; }
        const int nig = WGM * nN, gid = wgid / nig, fm = gid * WGM, gsz = (nM - fm) < WGM ? (nM - fm) : WGM;
        u.pm = fm + ((wgid % nig) % gsz); u.pn = (wgid % nig) / gsz; return true;
    }
    __device__ __forceinline__ void a_ready(const Unit&) const {}
    __device__ __forceinline__ void done(const Unit&) const {}
};
__device__ __forceinline__ unsigned cvt_pk_bf16(float lo, float hi) { unsigned r; asm volatile("v_cvt_pk_bf16_f32 %0, %1, %2" : "=v"(r) : "v"(lo), "v"(hi)); return r; }
typedef float f32x2 __attribute__((ext_vector_type(2)));
template <class Epi, class Sched, bool ALIGN_EPI = false, bool SP2 = false>
__device__ __forceinline__ void gemm_phase(PG8_LAS unsigned char* lds, const Gemm g, const Sched& S, const Epi& E) {
    const int tid = threadIdx.x, wid = __builtin_amdgcn_readfirstlane(tid >> 6), lane = tid & 63, wr = wid >> 2, wc = wid & 3, fr = lane & 15, fq = lane >> 4;
    const int K = g.K, nt = K / BK;
    unsigned voffA[2], voffB[2];
#pragma unroll
    for (int i = 0; i < 2; ++i) { int R, C; stage_rc(tid * 16 + i * 8192, R, C); const int Rb = Epi::PERM ? ((R & ~31) + perm32(R & 31)) : R;
        voffA[i] = (unsigned)(R * K + C) * 2u; voffB[i] = (unsigned)(Rb * K + C) * 2u; }
    const size_t kstep = (size_t)(BK * 2);
    const size_t hstep = (size_t)HALF * K * 2;
    const size_t tstep = 2 * hstep;
    const unsigned ldsw = (unsigned)wid * 1024u;
    const int aoff = lds_byte(wr * 64 + fr, fq * 8), boff = lds_byte(wc * 32 + fr, fq * 8);
#define PG8_SA(b, h) (((b) * 2 + (h)) * HTB)
#define PG8_SB(b, h) ((4 + (b) * 2 + (h)) * HTB)
#define PG8_STAGE(bufoff, gbase, voff) do { _Pragma("unroll") for (int _i = 0; _i < 2; ++_i) \
        __builtin_amdgcn_global_load_lds((const unsigned*)((const char*)(gbase) + (voff)[_i]), (PG8_LAS unsigned*)(lds + (bufoff) + ldsw + _i * 8192), 16, 0, 0); } while (0)
#define PG8_LDA(dst, b, h) do { _Pragma("unroll") for (int m = 0; m < 4; ++m) _Pragma("unroll") for (int k = 0; k < 2; ++k) dst[m][k] = *(const PG8_LAS bf16x8*)(lds + PG8_SA(b, h) + aoff + m * 2048 + k * 1024); } while (0)
#define PG8_LDB(dst, b, h) do { _Pragma("unroll") for (int n = 0; n < 2; ++n) _Pragma("unroll") for (int k = 0; k < 2; ++k) dst[n][k] = *(const PG8_LAS bf16x8*)(lds + PG8_SB(b, h) + boff + n * 2048 + k * 1024); } while (0)
#define PG8_MMA(ai, bj, At, Bt) do { __builtin_amdgcn_s_setprio(1); _Pragma("unroll") for (int m = 0; m < 4; ++m) _Pragma("unroll") for (int n = 0; n < 2; ++n) _Pragma("unroll") for (int k = 0; k < 2; ++k) \
        acc[ai][bj][m][n] = __builtin_amdgcn_mfma_f32_16x16x32_bf16(Bt[n][k], At[m][k], acc[ai][bj][m][n], 0, 0, 0); __builtin_amdgcn_s_setprio(0); } while (0)
#define PG8_WAIT_V(n) asm volatile("s_waitcnt vmcnt(" #n ")" ::: "memory")
#define PG8_WAIT_L(n) asm volatile("s_waitcnt lgkmcnt(" #n ")" ::: "memory")
#define PG8_BAR __builtin_amdgcn_s_barrier()
#define PG8_SCHED __builtin_amdgcn_sched_barrier(0)
    Unit cur, nxt; int ui = 0;
    if (!S.next(0, cur)) return;
    f32x4 acc[2][2][4][2];
#pragma unroll
    for (int a = 0; a < 2; ++a)
#pragma unroll
        for (int b = 0; b < 2; ++b)
#pragma unroll
            for (int m = 0; m < 4; ++m)
#pragma unroll
                for (int n = 0; n < 2; ++n) acc[a][b][m][n] = (f32x4){0.f, 0.f, 0.f, 0.f};
    bf16x8 At[4][2], B0[2][2], B1[2][2];
    const char* cA = (const char*)g.A + (size_t)cur.pm * tstep; const char* cB = (const char*)g.Bt + (size_t)cur.pn * tstep;
    S.a_ready(cur);
    if constexpr (SP2) {
        PG8_STAGE(PG8_SB(0, 0), cB, voffB); PG8_STAGE(PG8_SB(0, 1), cB + hstep, voffB); PG8_STAGE(PG8_SA(0, 0), cA, voffA); PG8_STAGE(PG8_SA(0, 1), cA + hstep, voffA);
        if (wr == 1) PG8_BAR;
        PG8_WAIT_V(2); PG8_BAR;
        PG8_STAGE(PG8_SB(1, 0), cB + kstep, voffB); PG8_STAGE(PG8_SA(1, 0), cA + kstep, voffA); PG8_STAGE(PG8_SB(1, 1), cB + hstep + kstep, voffB);
        PG8_WAIT_V(6); PG8_BAR;
    } else {
        PG8_STAGE(PG8_SB(0, 0), cB, voffB); PG8_STAGE(PG8_SA(0, 0), cA, voffA); PG8_STAGE(PG8_SB(0, 1), cB + hstep, voffB); PG8_STAGE(PG8_SA(0, 1), cA + hstep, voffA);
        if (wr == 1) PG8_BAR;
        PG8_WAIT_V(4); PG8_BAR;
        PG8_STAGE(PG8_SB(1, 0), cB + kstep, voffB); PG8_STAGE(PG8_SA(1, 0), cA + kstep, voffA); PG8_STAGE(PG8_SB(1, 1), cB + hstep + kstep, voffB);
        PG8_WAIT_V(6); PG8_BAR;
    }
    for (;;) {
        const bool has_next = S.next(ui + 1, nxt);
        const char* nA = has_next ? (const char*)g.A + (size_t)nxt.pm * tstep : cA; const char* nB = has_next ? (const char*)g.Bt + (size_t)nxt.pn * tstep : cB;
        for (int t = 0; t < nt; t += 2) {
            const bool last = (t == nt - 2);
            const char* a1 = cA + (size_t)(t + 1) * kstep;
            const char* a2 = last ? nA : cA + (size_t)(t + 2) * kstep; const char* b2 = last ? nB : cB + (size_t)(t + 2) * kstep;
            const char* a3 = a2 + kstep; const char* b3 = b2 + kstep;
            if (last && has_next) S.a_ready(nxt);
            if constexpr (SP2) {
            PG8_LDB(B0, 0, 0); PG8_LDB(B1, 0, 1); PG8_SCHED; PG8_LDA(At, 0, 0); PG8_STAGE(PG8_SA(1, 1), a1 + hstep, voffA);
            PG8_WAIT_V(8); PG8_WAIT_L(0); PG8_BAR; PG8_MMA(0, 0, At, B0); PG8_MMA(0, 1, At, B1); PG8_BAR; PG8_SCHED;
            PG8_LDA(At, 0, 1); PG8_STAGE(PG8_SB(0, 0), b2, voffB); PG8_STAGE(PG8_SB(0, 1), b2 + hstep, voffB); PG8_STAGE(PG8_SA(0, 0), a2, voffA);
            PG8_WAIT_V(8); PG8_WAIT_L(0); PG8_BAR; PG8_MMA(1, 0, At, B0); PG8_MMA(1, 1, At, B1); PG8_BAR; PG8_SCHED;
            PG8_LDB(B0, 1, 0); PG8_LDB(B1, 1, 1); PG8_SCHED; PG8_LDA(At, 1, 0); PG8_STAGE(PG8_SA(0, 1), a2 + hstep, voffA);
            PG8_WAIT_V(8); PG8_WAIT_L(0); PG8_BAR; PG8_MMA(0, 0, At, B0); PG8_MMA(0, 1, At, B1); PG8_BAR; PG8_SCHED;
            PG8_LDA(At, 1, 1); PG8_STAGE(PG8_SB(1, 0), b3, voffB); PG8_STAGE(PG8_SB(1, 1), b3 + hstep, voffB); PG8_STAGE(PG8_SA(1, 0), a3, voffA);
            PG8_WAIT_V(8); PG8_WAIT_L(0); PG8_BAR; PG8_MMA(1, 0, At, B0); PG8_MMA(1, 1, At, B1); PG8_BAR; PG8_SCHED;
            } else {
            PG8_LDB(B0, 0, 0); PG8_SCHED; PG8_LDA(At, 0, 0); PG8_STAGE(PG8_SA(1, 1), a1 + hstep, voffA);
            PG8_WAIT_L(8); PG8_BAR; PG8_WAIT_L(0); PG8_MMA(0, 0, At, B0); PG8_BAR; PG8_SCHED;
            PG8_LDB(B1, 0, 1); PG8_STAGE(PG8_SB(0, 0), b2, voffB);
            PG8_BAR; PG8_WAIT_L(0); PG8_MMA(0, 1, At, B1); PG8_BAR;
            PG8_LDA(At, 0, 1); PG8_STAGE(PG8_SA(0, 0), a2, voffA);
            PG8_BAR; PG8_WAIT_L(0); PG8_MMA(1, 0, At, B0); PG8_BAR; PG8_SCHED;
            PG8_STAGE(PG8_SB(0, 1), b2 + hstep, voffB);
            PG8_WAIT_V(6); PG8_BAR; PG8_MMA(1, 1, At, B1); PG8_BAR;
            PG8_LDB(B0, 1, 0); PG8_SCHED; PG8_LDA(At, 1, 0); PG8_STAGE(PG8_SA(0, 1), a2 + hstep, voffA);
            PG8_WAIT_L(8); PG8_BAR; PG8_WAIT_L(0); PG8_MMA(0, 0, At, B0); PG8_BAR; PG8_SCHED;
            PG8_LDB(B1, 1, 1); PG8_STAGE(PG8_SB(1, 0), b3, voffB);
            PG8_BAR; PG8_WAIT_L(0); PG8_MMA(0, 1, At, B1); PG8_BAR;
            PG8_LDA(At, 1, 1); PG8_STAGE(PG8_SA(1, 0), a3, voffA);
            PG8_BAR; PG8_WAIT_L(0); PG8_MMA(1, 0, At, B0); PG8_BAR; PG8_SCHED;
            PG8_STAGE(PG8_SB(1, 1), b3 + hstep, voffB);
            PG8_WAIT_V(6); PG8_BAR; PG8_MMA(1, 1, At, B1); PG8_BAR;
            }
        }
        if constexpr (ALIGN_EPI) { if (wr == 0) PG8_BAR; }
        if constexpr (!Epi::AFTER_DRAIN) { E(acc, cur, wr, wc, fr, fq); S.done(cur); }
        if (!has_next) break;
#pragma unroll
        for (int a = 0; a < 2; ++a)
#pragma unroll
            for (int b = 0; b < 2; ++b)
#pragma unroll
                for (int m = 0; m < 4; ++m)
#pragma unroll
                    for (int n = 0; n < 2; ++n) acc[a][b][m][n] = (f32x4){0.f, 0.f, 0.f, 0.f};
        cur = nxt; cA = nA; cB = nB; ++ui;
        if constexpr (ALIGN_EPI) { if (wr == 1) PG8_BAR; }
    }
    PG8_WAIT_V(0);
    if constexpr (!ALIGN_EPI) { if (wr == 0) PG8_BAR; }
    PG8_BAR;
    if constexpr (Epi::AFTER_DRAIN) { E.fused(acc, cur, wr, wc, fr, fq, lds, wid, lane); S.done(cur); }
#undef PG8_SA
#undef PG8_SB
#undef PG8_STAGE
#undef PG8_LDA
#undef PG8_LDB
#undef PG8_MMA
#undef PG8_WAIT_V
#undef PG8_WAIT_L
#undef PG8_BAR
#undef PG8_SCHED
}
}

constexpr int DM = 1024, NB = 2, SEQ = 8192, CTXL = 256, MLAT = NB * SEQ, MCTX = NB * CTXL, MROWS = MLAT + MCTX;
constexpr int NIN = 2560, NCHUNK = MROWS / 64  , NPJ = 132  ;
constexpr float EPSF = 1e-6f;
constexpr int NWAVES = 8, NTHR = 512;

constexpr size_t MiB = 1u << 20;
constexpr size_t WS_CTL = 0, CTL_ZERO_BYTES = 64 * 1024;
constexpr size_t WS_MOD = 1 * MiB;
constexpr size_t WS_SP8 = 1 * MiB + 128 * 1024;
constexpr size_t WS_GWF = 1 * MiB + 256 * 1024;
constexpr size_t WS_BT1 = 2 * MiB;
constexpr size_t WS_BT2 = 12 * MiB;
constexpr size_t WS_AGGA = 16 * MiB;
constexpr size_t WS_AGGB = 16 * MiB + 1536 * 1024;
constexpr size_t WS_SSQ = 19 * MiB;
constexpr size_t WS_XC1 = 21 * MiB;
constexpr size_t WS_A16 = 23 * MiB;
constexpr size_t WS_B16 = 28 * MiB;
constexpr size_t WS_H = 73 * MiB;
constexpr size_t WS_Y = 56 * MiB;
constexpr size_t WS_MIXIN = 73 * MiB;
constexpr size_t WS_U = 106 * MiB;
constexpr size_t WS_MIX = 189 * MiB;
constexpr size_t WS_END = 255 * MiB;

constexpr int LDS_BYTES = 158720;
constexpr int MISC_OFF = 157696;

#define LAS __attribute__((address_space(3)))
typedef unsigned short bf16;
typedef unsigned v4u __attribute__((ext_vector_type(4)));
typedef unsigned v2u __attribute__((ext_vector_type(2)));
typedef float f32x4 __attribute__((ext_vector_type(4)));
typedef short bf16x8 __attribute__((ext_vector_type(8)));
typedef float f32x2v __attribute__((ext_vector_type(2)));
#define LDS_WAIT() asm volatile("s_waitcnt lgkmcnt(0)" ::: "memory")

__device__ __forceinline__ unsigned f2bf(float f) { unsigned u = __builtin_bit_cast(unsigned, f); return (u + 0x7fffu + ((u >> 16) & 1u)) >> 16; }
__device__ __forceinline__ unsigned pk2(float lo, float hi) { return f2bf(lo) | (f2bf(hi) << 16); }
__device__ __forceinline__ unsigned cvtpk(float lo, float hi) { unsigned r; asm volatile("v_cvt_pk_bf16_f32 %0, %1, %2" : "=v"(r) : "v"(lo), "v"(hi)); return r; }
__device__ __forceinline__ float bflo(unsigned u) { return __builtin_bit_cast(float, u << 16); }
__device__ __forceinline__ float bfhi(unsigned u) { return __builtin_bit_cast(float, u & 0xffff0000u); }
__device__ __forceinline__ float sigmoidf_(float x) { return 1.0f / (1.0f + __expf(-x)); }
__device__ __forceinline__ float siluf_(float x) { return x * __builtin_amdgcn_rcpf(1.0f + __builtin_amdgcn_exp2f(-1.44269504f * x)); }
__device__ __forceinline__ float wave_sum(float v) {
#pragma unroll
    for (int o = 1; o < 64; o <<= 1) v += __shfl_xor(v, o);
    return v;
}

struct Args {
    const float* in[21]; float* out; unsigned char* ws; int ph_lo, ph_hi, coop, pad;
};
enum { I_X = 0, I_C, I_CTX, I_CCTX, I_WMOD, I_BMOD, I_GPRE, I_GPOST, I_WIN, I_CAW, I_CAB, I_WR, I_BR, I_WI, I_BI, I_LAM, I_DWW, I_DWB, I_LNG, I_LNB, I_WOUT };

namespace pg8 {
struct EpiU {
    static constexpr bool PERM = true, AFTER_DRAIN = false;
    bf16_t* O;
    __device__ __forceinline__ void operator()(const f32x4 (&acc)[2][2][4][2], const Unit& u, int wr, int wc, int fr, int fq) const {
        const int row0 = u.pm * BM + wr * 64 + fr;
        if (u.pn >= 4 && u.pn < 8) {
            const int col0 = 1024 + 128 * (u.pn - 4) + wc * 32 + 8 * fq;
#pragma unroll
            for (int ai = 0; ai < 2; ++ai)
#pragma unroll
                for (int m = 0; m < 4; ++m) { f32x4 v0 = acc[ai][0][m][0], v1 = acc[ai][0][m][1]; const f32x4 g0 = acc[ai][1][m][0], g1 = acc[ai][1][m][1];
#pragma unroll
                    for (int e = 0; e < 4; ++e) { v0[e] = v0[e] * __builtin_amdgcn_rcpf(1.0f + __builtin_amdgcn_exp2f(-1.44269504f * g0[e])); v1[e] = v1[e] * __builtin_amdgcn_rcpf(1.0f + __builtin_amdgcn_exp2f(-1.44269504f * g1[e])); }
                    u32x4 w; w.x = cvt_pk_bf16(v0[0], v0[1]); w.y = cvt_pk_bf16(v0[2], v0[3]); w.z = cvt_pk_bf16(v1[0], v1[1]); w.w = cvt_pk_bf16(v1[2], v1[3]);
                    *(u32x4*)(O + (size_t)(row0 + ai * HALF + m * 16) * 2560 + col0) = w; }
            return;
        }
        const int col0 = u.pn * BM + wc * 32 + 8 * fq;
        const bool act = (u.pn == 2 || u.pn == 3 || u.pn >= 8);
#pragma unroll
        for (int ai = 0; ai < 2; ++ai)
#pragma unroll
            for (int m = 0; m < 4; ++m) { bf16_t* rowp = O + (size_t)(row0 + ai * HALF + m * 16) * 2560 + col0;
#pragma unroll
                for (int bj = 0; bj < 2; ++bj) { f32x4 v0 = acc[ai][bj][m][0], v1 = acc[ai][bj][m][1];
                    if (act) {
#pragma unroll
                        for (int e = 0; e < 4; ++e) { v0[e] = v0[e] * __builtin_amdgcn_rcpf(1.0f + __builtin_amdgcn_exp2f(-1.44269504f * v0[e])); v1[e] = v1[e] * __builtin_amdgcn_rcpf(1.0f + __builtin_amdgcn_exp2f(-1.44269504f * v1[e])); }
                    }
                    u32x4 w; w.x = cvt_pk_bf16(v0[0], v0[1]); w.y = cvt_pk_bf16(v0[2], v0[3]); w.z = cvt_pk_bf16(v1[0], v1[1]); w.w = cvt_pk_bf16(v1[2], v1[3]);
                    *(u32x4*)(rowp + bj * HALF) = w; } }
    }
};
struct EpiMix {
    static constexpr bool PERM = true, AFTER_DRAIN = false;
    bf16_t* O; float* ssq;
    __device__ __forceinline__ void operator()(const f32x4 (&acc)[2][2][4][2], const Unit& u, int wr, int wc, int fr, int fq) const {
        const int col0 = u.pn * BM + wc * 32 + 8 * fq;
#pragma unroll
        for (int ai = 0; ai < 2; ++ai)
#pragma unroll
            for (int m = 0; m < 4; ++m) { const int r = u.pm * BM + ai * HALF + wr * 64 + m * 16 + fr; bf16_t* rowp = O + (size_t)r * 1024 + col0; float s = 0.f;
#pragma unroll
                for (int bj = 0; bj < 2; ++bj) { const f32x4 v0 = acc[ai][bj][m][0], v1 = acc[ai][bj][m][1];
                    s += ((v0[0] * v0[0] + v0[1] * v0[1]) + (v0[2] * v0[2] + v0[3] * v0[3])) + ((v1[0] * v1[0] + v1[1] * v1[1]) + (v1[2] * v1[2] + v1[3] * v1[3]));
                    u32x4 w; w.x = cvt_pk_bf16(v0[0], v0[1]); w.y = cvt_pk_bf16(v0[2], v0[3]); w.z = cvt_pk_bf16(v1[0], v1[1]); w.w = cvt_pk_bf16(v1[2], v1[3]);
                    *(u32x4*)(rowp + bj * HALF) = w; }
                s += __shfl_xor(s, 16); s += __shfl_xor(s, 32);
                if (fq == 0) ssq[(size_t)r * 16 + u.pn * 4 + wc] = s; }
    }
};
}

__device__ __forceinline__ void p0_transpose_item(const float* W, int K, int N, bf16* WT, LAS float* scr, int item, int lane, bool glu_remap) {
    const int nblk = N / 32, kb = item / nblk, nb = item % nblk, k0 = 64 * kb, n0 = 32 * nb;
    int nd = n0;
    if (glu_remap) { if (n0 >= 1024 && n0 < 1536) nd = 1024 + 256 * ((n0 - 1024) >> 7) + ((n0 - 1024) & 127); else if (n0 >= 1536 && n0 < 2048) nd = 1024 + 256 * ((n0 - 1536) >> 7) + 128 + ((n0 - 1536) & 127); }
#pragma unroll 8
    for (int i = 0; i < 32; ++i) { const int kk = 2 * i + (lane >> 5); scr[kk * 33 + (lane & 31)] = W[(size_t)(k0 + kk) * N + n0 + (lane & 31)]; }
    LDS_WAIT(); asm volatile("" ::: "memory");
    const int c = lane & 7;
#pragma unroll
    for (int j = 0; j < 4; ++j) { const int n = (lane >> 3) + 8 * j; const LAS float* s = scr + (8 * c) * 33 + n;
        v4u o; o.x = pk2(s[0 * 33], s[1 * 33]); o.y = pk2(s[2 * 33], s[3 * 33]); o.z = pk2(s[4 * 33], s[5 * 33]); o.w = pk2(s[6 * 33], s[7 * 33]);
        *(v4u*)(WT + (size_t)(nd + n) * K + k0 + 8 * c) = o; }
    LDS_WAIT(); asm volatile("" ::: "memory");
}

__device__ __forceinline__ void p0_prologue(const Args& a, LAS unsigned char* lds, int tid, int lane, int wave) {
    const int G = gridDim.x, bx = blockIdx.x;
    unsigned char* ws = a.ws;
    {
        LAS float* part = (LAS float*)lds;
        float* MOD = (float*)(ws + WS_MOD);
        const float* c = a.in[I_C]; const float* cctx = a.in[I_CCTX];
        for (int un = bx; un < 192; un += G) {
            const int l = un / 96, n0 = (un % 96) * 32, cq = tid & 7, ks = tid >> 3;
            const float* wm = a.in[I_WMOD] + (size_t)l * 1024 * 3072 + n0 + cq * 4;
            f32x4 acc0 = {0.f, 0.f, 0.f, 0.f}, acc1 = acc0, acc2 = acc0;
#pragma unroll 4
            for (int kk = 0; kk < 16; ++kk) { const int k = ks * 16 + kk; const f32x4 w = *(const f32x4*)(wm + (size_t)k * 3072);
                const float a0 = siluf_(c[k]), a1 = siluf_(c[1024 + k]), a2 = siluf_(cctx[k]);
                acc0 += w * a0; acc1 += w * a1; acc2 += w * a2; }
            *(LAS f32x4*)(part + (0 * 64 + ks) * 32 + cq * 4) = acc0;
            *(LAS f32x4*)(part + (1 * 64 + ks) * 32 + cq * 4) = acc1;
            *(LAS f32x4*)(part + (2 * 64 + ks) * 32 + cq * 4) = acc2;
            __syncthreads();
            if (tid < 96) { const int v = tid >> 5, col = tid & 31; float s = a.in[I_BMOD][l * 3072 + n0 + col];
                for (int k2 = 0; k2 < 64; ++k2) s += part[(v * 64 + k2) * 32 + col];
                MOD[(l * 3 + v) * 3072 + n0 + col] = s; }
            __syncthreads();
        }
    }
    { float* SP8 = (float*)(ws + WS_SP8); for (int idx = bx * NTHR + tid; idx < 2048; idx += G * NTHR) SP8[idx] = -8.0f * log1pf(__expf(-a.in[I_LAM][idx])); }
    {
        v4u* GWF = (v4u*)(ws + WS_GWF);
        for (int idx = bx * NTHR + tid; idx < 32768; idx += G * NTHR) {
            const int ln = idx & 63, kk = (idx >> 6) & 1, ct = (idx >> 7) & 3, h = (idx >> 9) & 7, g = (idx >> 12) & 1, d = (idx >> 13) & 1, l = idx >> 14;
            const float* W = (g == 0 ? a.in[I_WR] : a.in[I_WI]) + (size_t)(((l * 2 + d) * 8 + h) * 64) * 64;
            const int k0 = 32 * kk + 8 * (ln >> 4), col = 16 * ct + (ln & 15);
            float e[8];
#pragma unroll
            for (int j = 0; j < 8; ++j) e[j] = W[(k0 + j) * 64 + col];
            v4u o; o.x = pk2(e[0], e[1]); o.y = pk2(e[2], e[3]); o.z = pk2(e[4], e[5]); o.w = pk2(e[6], e[7]);
            GWF[idx] = o;
        }
    }
    {
        LAS float* scr = (LAS float*)(lds + wave * 16384);
        const int gw = bx * NWAVES + wave, NGW = G * NWAVES;
        constexpr int I_1 = (1024 / 64) * (NIN / 32), I_2 = (1024 / 64) * (1024 / 32), NITEMS = 2 * (I_1 + I_2);
        bf16* BT1 = (bf16*)(ws + WS_BT1); bf16* BT2 = (bf16*)(ws + WS_BT2);
        for (int it = gw; it < NITEMS; it += NGW) {
            int r = it;
            if (r < I_1) { p0_transpose_item(a.in[I_WIN], 1024, NIN, BT1, scr, r, lane, true); continue; } r -= I_1;
            if (r < I_1) { p0_transpose_item(a.in[I_WIN] + (size_t)1024 * NIN, 1024, NIN, BT1 + (size_t)NIN * 1024, scr, r, lane, true); continue; } r -= I_1;
            if (r < I_2) { p0_transpose_item(a.in[I_WOUT], 1024, 1024, BT2, scr, r, lane, false); continue; } r -= I_2;
            p0_transpose_item(a.in[I_WOUT] + (size_t)1024 * 1024, 1024, 1024, BT2 + (size_t)1024 * 1024, scr, r, lane, false);
        }
    }
}

__device__ __forceinline__ void norm_phase(const Args& a, int mode, int lane, int wave) {
    unsigned char* ws = a.ws;
    const float* MOD = (const float*)(ws + WS_MOD); const bf16* MIX = (const bf16*)(ws + WS_MIX); const float* SSQ = (const float*)(ws + WS_SSQ);
    float* XC1 = (float*)(ws + WS_XC1); bf16* H = (bf16*)(ws + WS_H);
    const int gw = blockIdx.x * NWAVES + wave, NGW = gridDim.x * NWAVES;
    const int nrows = (mode == 2) ? MLAT : MROWS, lu = (mode == 1) ? 0 : 1, ln = (mode == 0) ? 0 : 1;
    for (int row = gw; row < nrows; row += NGW) {
        const int vsel = row < MLAT ? (row >> 13) : 2;
        const float* src;
        if (mode == 2) src = a.out + (size_t)row * 1024;
        else src = row < MLAT ? a.in[I_X] + (size_t)row * 1024 : a.in[I_CTX] + (size_t)(row - MLAT) * 1024;
        f32x4 v[4];
#pragma unroll
        for (int j = 0; j < 4; ++j) v[j] = *((const f32x4*)src + lane + 64 * j);
        if (mode >= 1) {
            const float sp = lane < 16 ? SSQ[(size_t)row * 16 + lane] : 0.f;
            const float rstd = rsqrtf(wave_sum(sp) * (1.0f / 1024.0f) + EPSF);
            const float* gate = MOD + (lu * 3 + vsel) * 3072 + 2048; const float* gp = a.in[I_GPOST] + lu * 1024;
#pragma unroll
            for (int j = 0; j < 4; ++j) { const v2u mq = *((const v2u*)(MIX + (size_t)row * 1024) + lane + 64 * j); const f32x4 mx = {bflo(mq.x), bfhi(mq.x), bflo(mq.y), bfhi(mq.y)};
                const f32x4 gt = *((const f32x4*)gate + lane + 64 * j), gv = *((const f32x4*)gp + lane + 64 * j);
                v[j] += gt * (mx * rstd * gv); }
            float* dst = row < MLAT ? a.out + (size_t)row * 1024 : XC1 + (size_t)(row - MLAT) * 1024;
#pragma unroll
            for (int j = 0; j < 4; ++j) *((f32x4*)dst + lane + 64 * j) = v[j];
        }
        if (mode <= 1) {
            float s = 0.f;
#pragma unroll
            for (int j = 0; j < 4; ++j) s += (v[j].x * v[j].x + v[j].y * v[j].y) + (v[j].z * v[j].z + v[j].w * v[j].w);
            const float r = rsqrtf(wave_sum(s) * (1.0f / 1024.0f) + EPSF);
            const float* shift = MOD + (ln * 3 + vsel) * 3072; const float* scale = shift + 1024; const float* gpre = a.in[I_GPRE] + ln * 1024;
            v2u* o8 = (v2u*)(H + (size_t)row * 1024);
#pragma unroll
            for (int j = 0; j < 4; ++j) { const f32x4 sh = *((const f32x4*)shift + lane + 64 * j), sc = *((const f32x4*)scale + lane + 64 * j), gv = *((const f32x4*)gpre + lane + 64 * j);
                const f32x4 hv = v[j] * r * gv * (sc + 1.0f) + sh;
                v2u w; w.x = pk2(hv.x, hv.y); w.y = pk2(hv.z, hv.w); o8[lane + 64 * j] = w; }
        }
    }
}

__device__ __forceinline__ void conv16(const LAS unsigned* vt, const float (&w0)[31], const float (&w1)[31], float b0, float b1, bf16* ybase, size_t ystride) {
#pragma unroll 1
    for (int tq = 0; tq < 4; ++tq) {
        const LAS unsigned* vq = vt + tq * 4 * 128;
        float a0[4], a1[4];
#pragma unroll
        for (int t = 0; t < 4; ++t) { a0[t] = b0; a1[t] = b1; }
#pragma unroll
        for (int rr = 0; rr < 34; ++rr) { const unsigned u = vq[rr * 128]; const float lo = bflo(u), hi = bfhi(u);
#pragma unroll
            for (int t = 0; t < 4; ++t) { const int k = rr - t; if (k >= 0 && k < 31) { a0[t] += w0[k] * lo; a1[t] += w1[k] * hi; } }
            if ((rr & 7) == 7) asm volatile("" ::: "memory"); }
#pragma unroll
        for (int t = 0; t < 4; ++t) *(unsigned*)(ybase + (size_t)(tq * 4 + t) * ystride) = cvtpk(a0[t], a1[t]);
    }
}
__device__ __forceinline__ v4u glu8(const v4u vq, const v4u gq) {
    v4u o;
    o.x = pk2(bflo(vq.x) * sigmoidf_(bflo(gq.x)), bfhi(vq.x) * sigmoidf_(bfhi(gq.x)));
    o.y = pk2(bflo(vq.y) * sigmoidf_(bflo(gq.y)), bfhi(vq.y) * sigmoidf_(bfhi(gq.y)));
    o.z = pk2(bflo(vq.z) * sigmoidf_(bflo(gq.z)), bfhi(vq.z) * sigmoidf_(bfhi(gq.z)));
    o.w = pk2(bflo(vq.w) * sigmoidf_(bflo(gq.w)), bfhi(vq.w) * sigmoidf_(bfhi(gq.w)));
    return o;
}
__device__ __forceinline__ void conv_unit(const Args& a, LAS unsigned char* lds, int l, int grow0, int gstride, int vlo, int vhi, int coff, int cbase, int nrows, int ncall, int orow0, int ostride, int tid) {
    const bf16* U = (const bf16*)(a.ws + WS_U); bf16* Y = (bf16*)(a.ws + WS_Y);
    LAS unsigned* VT = (LAS unsigned*)lds;
    const int nchunk = nrows * 32;
#pragma unroll 1
    for (int i0 = tid; i0 < nchunk; i0 += 3 * NTHR) {
        v4u vq[3];
#pragma unroll
        for (int it = 0; it < 3; ++it) { const int i = i0 + it * NTHR, rr = i >> 5, ch = i & 31, row = grow0 + rr * gstride; const bool ok = i < nchunk && row >= vlo && row < vhi;
            vq[it] = *(const v4u*)(U + (size_t)(ok ? row : vlo) * NIN + coff + ch * 8); }
#pragma unroll
        for (int it = 0; it < 3; ++it) { const int i = i0 + it * NTHR, rr = i >> 5, ch = i & 31, row = grow0 + rr * gstride; const bool ok = row >= vlo && row < vhi;
            if (i < nchunk) { const v4u z = {0u, 0u, 0u, 0u}; *(LAS v4u*)(VT + rr * 128 + ch * 4) = ok ? vq[it] : z; } }
    }
    __syncthreads();
    int p = tid & 127; asm volatile("" : "+v"(p));
    const int tg = tid >> 7, c0 = cbase + 2 * p;
    float w0[31], w1[31];
#pragma unroll
    for (int k = 0; k < 31; ++k) { const float2 w = *(const float2*)(a.in[I_DWW] + (size_t)(l * 31 + k) * 512 + c0); w0[k] = w.x; w1[k] = w.y; }
    const float2 bb = *(const float2*)(a.in[I_DWB] + l * 512 + c0);
#pragma unroll 1
    for (int hc = 0; hc < ncall; ++hc) { const int tb = (tg * ncall + hc) * 16;
        conv16(VT + tb * 128 + p, w0, w1, bb.x, bb.y, Y + (size_t)(orow0 + tb * ostride) * 512 + c0, (size_t)ostride * 512); }
    __syncthreads();
}
__device__ __forceinline__ void ln_rows(const Args& a, int l, int nrows, int lane, int wave, int nblk) {
    const bf16* U = (const bf16*)(a.ws + WS_U); const bf16* Y = (const bf16*)(a.ws + WS_Y); bf16* MIXIN = (bf16*)(a.ws + WS_MIXIN);
    if ((int)blockIdx.x >= nblk) return;
    const int gw = blockIdx.x * NWAVES + wave, NGW = nblk * NWAVES, c0 = lane * 8;
    float lg[8], lb[8];
#pragma unroll
    for (int e = 0; e < 8; ++e) { lg[e] = a.in[I_LNG][l * 512 + c0 + e]; lb[e] = a.in[I_LNB][l * 512 + c0 + e]; }
    for (int row = gw; row < nrows; row += NGW) {
        const v4u yq = *(const v4u*)(Y + (size_t)row * 512 + c0); const v4u gq = *(const v4u*)(U + (size_t)row * NIN + 2048 + c0);
        float y[8] = {bflo(yq.x), bfhi(yq.x), bflo(yq.y), bfhi(yq.y), bflo(yq.z), bfhi(yq.z), bflo(yq.w), bfhi(yq.w)};
        const float gt[8] = {bflo(gq.x), bfhi(gq.x), bflo(gq.y), bfhi(gq.y), bflo(gq.z), bfhi(gq.z), bflo(gq.w), bfhi(gq.w)};
        float s = 0.f;
#pragma unroll
        for (int e = 0; e < 8; ++e) s += y[e];
        const float mean = wave_sum(s) * (1.0f / 512.0f); float q = 0.f;
#pragma unroll
        for (int e = 0; e < 8; ++e) { y[e] -= mean; q += y[e] * y[e]; }
        const float rstd = rsqrtf(wave_sum(q) * (1.0f / 512.0f) + EPSF);
        float o[8];
#pragma unroll
        for (int e = 0; e < 8; ++e) o[e] = siluf_(y[e] * rstd * lg[e] + lb[e]) * gt[e];
        v4u w; w.x = pk2(o[0], o[1]); w.y = pk2(o[2], o[3]); w.z = pk2(o[4], o[5]); w.w = pk2(o[6], o[7]);
        *(v4u*)(MIXIN + (size_t)row * 1024 + 512 + c0) = w;
    }
}

constexpr int RG_GW = 0, RG_FOLD = 32768, RG_F8 = 36864, RG_CAR = 40960, RG_WAVE = 57344, RG_WAVE_BYTES = 12544;
constexpr int NP16 = 4 * NPJ;
__device__ __forceinline__ float fsig(float x) { return __builtin_amdgcn_rcpf(1.0f + __expf(-x)); }

template <bool FINAL, bool FASTP>
__device__ __forceinline__ void rg_sweep(const Args& a, LAS unsigned char* lds, LAS unsigned char* wl, int l, int b, int h, int r0, int seg_lo, int seg_hi, int pj, bool is_ctx, int w, int lane, const int D) {
    const bf16* U = (const bf16*)(a.ws + WS_U); bf16* MIXIN = (bf16*)(a.ws + WS_MIXIN);
    float* AGGA = (float*)(a.ws + WS_AGGA); float* AGGB = (float*)(a.ws + WS_AGGB); float* A16 = (float*)(a.ws + WS_A16); float* B16 = (float*)(a.ws + WS_B16);
    LAS float* VCW = (LAS float*)wl; LAS unsigned* HBW = (LAS unsigned*)(wl + 4352);
    const LAS v4u* GWL = (const LAS v4u*)(lds + RG_GW) + (D * 2) * 8 * 64 + lane;
    const LAS float* CAR = (const LAS float*)(lds + RG_CAR);
    const int fr = lane & 15, fq = lane >> 4, cp = lane & 31, rh = lane >> 5;
    const int rbase = D ? r0 + 63 : r0, rsign = D ? -1 : 1;
    float2 cw[4];
#pragma unroll
    for (int k = 0; k < 4; ++k) cw[k] = *(const float2*)(a.in[I_CAW] + (size_t)((l * 2 + D) * 4 + (D ? 3 - k : k)) * 512 + 64 * h + 2 * cp);
    const float2 cbv = *(const float2*)(a.in[I_CAB] + (l * 2 + D) * 512 + 64 * h + 2 * cp);
    float brv[4], biv[4], sp8[4], Hc[4], Ac[4];
    const int p16own = 4 * pj + fq;
#pragma unroll
    for (int ct = 0; ct < 4; ++ct) { const int c = 16 * ct + fr, pidx = (l * 2 + D) * 512 + 64 * h + c;
        brv[ct] = a.in[I_BR][pidx]; biv[ct] = a.in[I_BI][pidx]; sp8[ct] = ((const float*)(a.ws + WS_SP8))[pidx];
        Hc[ct] = 0.f; Ac[ct] = 1.f;
        if (FINAL) {
            if (is_ctx) { const size_t base = (size_t)((b * 2 + D) * NP16) * 512 + 64 * h + c; float S = 0.f;
                for (int i = 0; i < p16own; ++i) S = A16[base + (size_t)i * 512] * S + B16[base + (size_t)i * 512];
                Hc[ct] = S; }
            else Hc[ct] = CAR[(D * 32 + 4 * (D ? 7 - w : w) + fq) * 64 + c];
        } }
    const bf16* ub = U + 64 * h + 2 * cp;
    unsigned Wd[2][7], nx[2][4];
#pragma unroll
    for (int q = 0; q < 2; ++q) { const int g = 2 * rh + q;
#pragma unroll
        for (int j = 0; j < 3; ++j) { const int row = rbase + rsign * (16 * g - 3 + j); const bool ok = row >= seg_lo && row < seg_hi; const int rc = ok ? row : r0;
            const unsigned v = *(const unsigned*)(ub + (size_t)rc * NIN); Wd[q][4 + j] = ok ? v : 0u; }
#pragma unroll
        for (int j = 0; j < 4; ++j) nx[q][j] = *(const unsigned*)(ub + (size_t)(rbase + rsign * (16 * g + j)) * NIN); }
#pragma unroll 1
    for (int ti = 0; ti < 4; ++ti) {
        const int tile = ti;
        int zo = 0; asm volatile("" : "+v"(zo));
        const LAS v4u* GWLt = GWL + zo;
        v4u g0 = {0u, 0u, 0u, 0u}, g1 = g0; size_t orow = 0;
        if (FINAL && D == 0) { orow = (size_t)(r0 + 16 * (fr >> 2) + 4 * tile + (fr & 3)); const bf16* gp = U + orow * NIN + 512 + 64 * h + 16 * fq; g0 = *(const v4u*)gp; g1 = *(const v4u*)(gp + 8); }
#pragma unroll
        for (int q = 0; q < 2; ++q) {
            Wd[q][0] = Wd[q][4]; Wd[q][1] = Wd[q][5]; Wd[q][2] = Wd[q][6]; Wd[q][3] = nx[q][0]; Wd[q][4] = nx[q][1]; Wd[q][5] = nx[q][2]; Wd[q][6] = nx[q][3]; }
        if (ti < 3) { const int tn = ti + 1;
#pragma unroll
            for (int q = 0; q < 2; ++q)
#pragma unroll
                for (int j = 0; j < 4; ++j) nx[q][j] = *(const unsigned*)(ub + (size_t)(rbase + rsign * (16 * (2 * rh + q) + 4 * tn + j)) * NIN); }
#pragma unroll
        for (int q = 0; q < 2; ++q)
#pragma unroll
            for (int jj = 0; jj < 4; ++jj) { float v0 = cbv.x, v1 = cbv.y;
#pragma unroll
                for (int k = 0; k < 4; ++k) { const unsigned u = Wd[q][jj + k]; v0 += cw[k].x * bflo(u); v1 += cw[k].y * bfhi(u); }
                *(LAS f32x2v*)(VCW + (4 * (2 * rh + q) + jj) * 68 + 2 * cp) = (f32x2v){v0, v1}; }
        bf16x8 af[2];
#pragma unroll
        for (int kk = 0; kk < 2; ++kk) { const LAS float* vp = VCW + fr * 68 + 32 * kk + 8 * fq; const f32x4 x0 = *(const LAS f32x4*)vp, x1 = *(const LAS f32x4*)(vp + 4);
            v4u pk; pk.x = cvtpk(x0.x, x0.y); pk.y = cvtpk(x0.z, x0.w); pk.z = cvtpk(x1.x, x1.y); pk.w = cvtpk(x1.z, x1.w); af[kk] = __builtin_bit_cast(bf16x8, pk); }
        float vcv[4][4];
#pragma unroll
        for (int ct = 0; ct < 4; ++ct)
#pragma unroll
            for (int jj = 0; jj < 4; ++jj) vcv[ct][jj] = VCW[(4 * fq + jj) * 68 + 16 * ct + fr];
        f32x4 accr[4], acci[4];
#pragma unroll
        for (int ct = 0; ct < 4; ++ct) { accr[ct] = (f32x4){0.f, 0.f, 0.f, 0.f}; acci[ct] = accr[ct];
#pragma unroll
            for (int kk = 0; kk < 2; ++kk) { const bf16x8 br = __builtin_bit_cast(bf16x8, GWLt[(ct * 2 + kk) * 64]), bi = __builtin_bit_cast(bf16x8, GWLt[(8 + ct * 2 + kk) * 64]);
                accr[ct] = __builtin_amdgcn_mfma_f32_16x16x32_bf16(af[kk], br, accr[ct], 0, 0, 0); acci[ct] = __builtin_amdgcn_mfma_f32_16x16x32_bf16(af[kk], bi, acci[ct], 0, 0, 0); } }
        float hsum[4][4];
#pragma unroll
        for (int ct = 0; ct < 4; ++ct) { float aa[4], bb[4];
            const float nbr = -1.44269504f * brv[ct], nbi = -1.44269504f * biv[ct];
#pragma unroll
            for (int p = 0; p < 2; ++p) {
                f32x2v xr = (f32x2v){accr[ct][2 * p], accr[ct][2 * p + 1]} * -1.44269504f + nbr, xi = (f32x2v){acci[ct][2 * p], acci[ct][2 * p + 1]} * -1.44269504f + nbi;
                xr = __builtin_elementwise_min(xr, (f32x2v){60.f, 60.f}); xi = __builtin_elementwise_min(xi, (f32x2v){60.f, 60.f});
                f32x2v d1, d2; d1.x = __builtin_amdgcn_exp2f(xr.x); d1.y = __builtin_amdgcn_exp2f(xr.y); d2.x = __builtin_amdgcn_exp2f(xi.x); d2.y = __builtin_amdgcn_exp2f(xi.y);
                d1 = d1 + 1.0f; d2 = d2 + 1.0f; const f32x2v m = d1 * d2; f32x2v inv; inv.x = __builtin_amdgcn_rcpf(m.x); inv.y = __builtin_amdgcn_rcpf(m.y);
                const f32x2v r = d2 * inv, ig = d1 * inv, la = r * sp8[ct], x2 = la + la, le = la * 1.44269504f;
                const f32x2v pom = -x2 * (x2 * (x2 * (x2 * (x2 * 0.0083333338f + 0.041666668f) + 0.16666667f) + 0.5f) + 1.0f);
                f32x2v av, om;
                if (FASTP) { av = la * (la * (la * (la * (la * 0.0083333338f + 0.041666668f) + 0.16666667f) + 0.5f) + 1.0f) + 1.0f; om = pom; }
                else { av.x = __builtin_amdgcn_exp2f(le.x); av.y = __builtin_amdgcn_exp2f(le.y);
                    const f32x2v o2 = 1.0f - av * av; om.x = x2.x > -0.25f ? pom.x : o2.x; om.y = x2.y > -0.25f ? pom.y : o2.y;
                    om = __builtin_elementwise_max(om, (f32x2v){0.f, 0.f}); }
                f32x2v sq; sq.x = __builtin_amdgcn_sqrtf(om.x); sq.y = __builtin_amdgcn_sqrtf(om.y);
                const f32x2v bv = sq * (ig * (f32x2v){vcv[ct][2 * p], vcv[ct][2 * p + 1]});
                aa[2 * p] = av.x; aa[2 * p + 1] = av.y; bb[2 * p] = bv.x; bb[2 * p + 1] = bv.y; }
            float hh = Hc[ct], A4 = 1.f;
#pragma unroll
            for (int jj = 0; jj < 4; ++jj) { hh = aa[jj] * hh + bb[jj]; A4 *= aa[jj]; hsum[ct][jj] = hh; }
            Hc[ct] = hh; if (!FINAL) Ac[ct] *= A4; }
        if (FINAL) {
            if (D == 1) {
#pragma unroll
                for (int ct = 0; ct < 4; ++ct)
#pragma unroll
                    for (int jp = 0; jp < 2; ++jp) HBW[(tile * 8 + ct * 2 + jp) * 64 + lane] = cvtpk(hsum[ct][2 * jp], hsum[ct][2 * jp + 1]);
            } else {
#pragma unroll
                for (int ct = 0; ct < 4; ++ct)
#pragma unroll
                    for (int jp = 0; jp < 2; ++jp) {
                        const unsigned hb = HBW[((3 - tile) * 8 + ct * 2 + (1 - jp)) * 64 + fr + 16 * (3 - fq)];
                        VCW[(4 * fq + 2 * jp) * 68 + 16 * ct + fr] = hsum[ct][2 * jp] + bfhi(hb); VCW[(4 * fq + 2 * jp + 1) * 68 + 16 * ct + fr] = hsum[ct][2 * jp + 1] + bflo(hb); }
                const size_t row = orow;
                const f32x4 s0 = *(const LAS f32x4*)(VCW + fr * 68 + 16 * fq), s1 = *(const LAS f32x4*)(VCW + fr * 68 + 16 * fq + 4), s2 = *(const LAS f32x4*)(VCW + fr * 68 + 16 * fq + 8), s3 = *(const LAS f32x4*)(VCW + fr * 68 + 16 * fq + 12);
                v4u o0, o1;
                o0.x = cvtpk(s0.x * bflo(g0.x), s0.y * bfhi(g0.x)); o0.y = cvtpk(s0.z * bflo(g0.y), s0.w * bfhi(g0.y)); o0.z = cvtpk(s1.x * bflo(g0.z), s1.y * bfhi(g0.z)); o0.w = cvtpk(s1.z * bflo(g0.w), s1.w * bfhi(g0.w));
                o1.x = cvtpk(s2.x * bflo(g1.x), s2.y * bfhi(g1.x)); o1.y = cvtpk(s2.z * bflo(g1.y), s2.w * bfhi(g1.y)); o1.z = cvtpk(s3.x * bflo(g1.z), s3.y * bfhi(g1.z)); o1.w = cvtpk(s3.z * bflo(g1.w), s3.w * bfhi(g1.w));
                bf16* op = MIXIN + row * 1024 + 64 * h + 16 * fq; *(v4u*)op = o0; *(v4u*)(op + 8) = o1;
            }
        }
    }
    if (!FINAL) {
#pragma unroll
        for (int ct = 0; ct < 4; ++ct) { const int c = 16 * ct + fr;
            const size_t i16 = (size_t)((b * 2 + D) * NP16 + p16own) * 512 + 64 * h + c; A16[i16] = Ac[ct]; B16[i16] = Hc[ct];
            float Ag[4], Bg[4];
#pragma unroll
            for (int g = 0; g < 4; ++g) { Ag[g] = __shfl(Ac[ct], fr + 16 * g); Bg[g] = __shfl(Hc[ct], fr + 16 * g); }
            float run = 0.f;
#pragma unroll
            for (int g = 0; g < 4; ++g) run = Ag[g] * run + Bg[g];
            if (fq == 0) { const size_t idx = (size_t)((b * 2 + D) * NPJ + pj) * 512 + 64 * h + c; AGGA[idx] = (Ag[0] * Ag[1]) * (Ag[2] * Ag[3]); AGGB[idx] = run; } }
    }
}

template <bool FINAL>
__device__ __forceinline__ void rg_run(const Args& a, LAS unsigned char* lds, int l, int rn, int tid, int lane, int wave) {
    const bool is_ctx = rn >= 256; const int bh = is_ctx ? rn - 256 : rn >> 4, b = bh >> 3, h = bh & 7, cgp = is_ctx ? 0 : (rn & 15);
    { const v4u* GWF = (const v4u*)(a.ws + WS_GWF); LAS v4u* GWL = (LAS v4u*)(lds + RG_GW);
#pragma unroll
      for (int i = tid; i < 2048; i += NTHR) { const int d = i >> 10, g = (i >> 9) & 1, rest = i & 511; GWL[i] = GWF[(size_t)((((l * 2 + d) * 2 + g) * 8 + h) * 8) * 64 + rest]; } }
    const int P0f = 4 + 8 * cgp, P0b = 124 - 8 * cgp;
    if (FINAL && !is_ctx) {
        const float* AGGA = (const float*)(a.ws + WS_AGGA); const float* AGGB = (const float*)(a.ws + WS_AGGB); const float* A16 = (const float*)(a.ws + WS_A16); const float* B16 = (const float*)(a.ws + WS_B16);
        const int d = tid >> 8, s = (tid >> 6) & 3, c = tid & 63, P0 = d ? P0b : P0f, lo = (P0 * s) >> 2, hi = (P0 * (s + 1)) >> 2;
        const size_t b16 = (size_t)((b * 2 + d) * NP16 + 4 * P0 + 8 * s) * 512 + 64 * h + c; float ai8[8], bi8[8];
#pragma unroll
        for (int i = 0; i < 8; ++i) { ai8[i] = A16[b16 + (size_t)i * 512]; bi8[i] = B16[b16 + (size_t)i * 512]; }
        const size_t base = (size_t)((b * 2 + d) * NPJ) * 512 + 64 * h + c; float A = 1.f, Bv = 0.f;
#pragma unroll 8
        for (int i = lo; i < hi; ++i) { const float ai = AGGA[base + (size_t)i * 512], bi = AGGB[base + (size_t)i * 512]; Bv = ai * Bv + bi; A *= ai; }
        LAS float* FO = (LAS float*)(lds + RG_FOLD); LAS float* F8 = (LAS float*)(lds + RG_F8); LAS float* CAR = (LAS float*)(lds + RG_CAR);
        FO[((d * 4 + s) * 64 + c) * 2] = A; FO[((d * 4 + s) * 64 + c) * 2 + 1] = Bv;
        float A8 = 1.f, B8 = 0.f;
#pragma unroll
        for (int i = 0; i < 8; ++i) { B8 = ai8[i] * B8 + bi8[i]; A8 *= ai8[i]; }
        F8[((d * 4 + s) * 64 + c) * 2] = A8; F8[((d * 4 + s) * 64 + c) * 2 + 1] = B8;
        __syncthreads();
        float S = 0.f;
#pragma unroll
        for (int s2 = 0; s2 < 4; ++s2) S = FO[((d * 4 + s2) * 64 + c) * 2] * S + FO[((d * 4 + s2) * 64 + c) * 2 + 1];
#pragma unroll
        for (int s2 = 0; s2 < 3; ++s2) if (s2 < s) S = F8[((d * 4 + s2) * 64 + c) * 2] * S + F8[((d * 4 + s2) * 64 + c) * 2 + 1];
#pragma unroll
        for (int i = 0; i < 8; ++i) { CAR[(d * 32 + 8 * s + i) * 64 + c] = S; S = ai8[i] * S + bi8[i]; }
    }
    __syncthreads();
    if (wave < (is_ctx ? 4 : 8)) {
        const int j = is_ctx ? wave : 8 * cgp + wave;
        const int seg_lo = is_ctx ? MLAT + b * CTXL : b * SEQ, seg_hi = seg_lo + (is_ctx ? CTXL : SEQ), r0 = seg_lo + 64 * j;
        const int pjf = is_ctx ? j : 4 + j, pjb = is_ctx ? 3 - j : 131 - j;
        LAS unsigned char* wl = lds + RG_WAVE + wave * RG_WAVE_BYTES;
        const float* SP8 = (const float*)(a.ws + WS_SP8);
        const bool fast1 = !__any(SP8[(l * 2 + 1) * 512 + 64 * h + lane] < -0.25f), fast0 = !__any(SP8[(l * 2 + 0) * 512 + 64 * h + lane] < -0.25f);
#pragma unroll 1
        for (int it = 0; it < 2; ++it) { const int D = 1 - it, pj = D ? pjb : pjf; const bool fast = D ? fast1 : fast0;
            if (fast) rg_sweep<FINAL, true>(a, lds, wl, l, b, h, r0, seg_lo, seg_hi, pj, is_ctx, wave, lane, D); else rg_sweep<FINAL, false>(a, lds, wl, l, b, h, r0, seg_lo, seg_hi, pj, is_ctx, wave, lane, D); }
    }
    __syncthreads();
}

#define RLX_AGENT __ATOMIC_RELAXED, __HIP_MEMORY_SCOPE_AGENT


#define XB_TMO      128
#define XB_XCNT(j)  (256  + 64 * (j))
#define XB_XSUB(j)  (1280 + 64 * (j))
#define XB_XGEN(j)  (2304 + 64 * (j))
#define XB_TOP      3328
#define XB_TOPGEN   3392
#define XCD_BAR_WORDS 3456
#define XB_SPIN_CAP (1u << 18)

__device__ __forceinline__ unsigned xb_ld(unsigned* p)              { return __hip_atomic_load(p, __ATOMIC_RELAXED, __HIP_MEMORY_SCOPE_AGENT); }
__device__ __forceinline__ unsigned xb_add(unsigned* p, unsigned v) { return __hip_atomic_fetch_add(p, v, __ATOMIC_RELAXED, __HIP_MEMORY_SCOPE_AGENT); }
__device__ __forceinline__ unsigned xb_xcc_id() { return (unsigned)__builtin_amdgcn_s_getreg((3 << 11) | 20) & 0xFu; }
#define XB_SPIN(cond, bar) do { unsigned _sp = 0; while (cond) { __builtin_amdgcn_s_sleep(1); \
    if ((++_sp & 255u) == 0u) { if (xb_ld(&(bar)[XB_TMO])) break; if (_sp > XB_SPIN_CAP) { atomicAdd(&(bar)[XB_TMO], 1u); break; } } } } while (0)

struct XcdBarrier {
    unsigned* bar; unsigned x;
    volatile LAS unsigned* st;
};

__device__ __forceinline__ XcdBarrier xcd_barrier_post(unsigned* bar, volatile LAS unsigned* st) {
    XcdBarrier b; b.bar = bar; b.x = xb_xcc_id(); b.st = st;
    if (threadIdx.x == 0) (void)xb_add(&bar[XB_XCNT(b.x)], 1u);
    return b;
}
__device__ __forceinline__ void xcd_barrier_complete(unsigned* bar, unsigned x, unsigned& nloc, unsigned& nx) {
    const unsigned G = gridDim.x * gridDim.y * gridDim.z;
    unsigned sum, cnt, mine, sp = 0u;
    for (;;) {
        sum = 0u; cnt = 0u; mine = 0u;
#pragma unroll
        for (unsigned j = 0; j < 16; ++j) { const unsigned c = xb_ld(&bar[XB_XCNT(j)]); sum += c; cnt += (c > 0u) ? 1u : 0u; mine = (j == x) ? c : mine; }
        if (sum == G) break;
        __builtin_amdgcn_s_sleep(1);
        if ((++sp & 255u) == 0u) { if (xb_ld(&bar[XB_TMO])) break; if (sp > XB_SPIN_CAP) { atomicAdd(&bar[XB_TMO], 1u); break; } }
    }
    nloc = mine > 0u ? mine : 1u; nx = cnt > 0u ? cnt : 1u;
}

__device__ __forceinline__ void xcd_barrier(const XcdBarrier& b) {
    asm volatile("s_waitcnt vmcnt(0)" ::: "memory");
    __syncthreads();
    if (threadIdx.x == 0) {
        unsigned* bar = b.bar;
        __builtin_amdgcn_s_waitcnt(0);
        unsigned nloc = b.st[0], nx = b.st[1];
        if (nloc == 0u) { xcd_barrier_complete(bar, b.x, nloc, nx); b.st[0] = nloc; b.st[1] = nx; }
        const unsigned old = xb_add(&bar[XB_XSUB(b.x)], 1u);
        const unsigned gen = old / nloc;
        if (old + 1u == (gen + 1u) * nloc) {
            __builtin_amdgcn_fence(__ATOMIC_RELEASE, "agent");
            asm volatile("s_waitcnt vmcnt(0)" ::: "memory");
            const unsigned og = xb_add(&bar[XB_TOP], 1u);
            const unsigned tg = og / nx;
            if (og + 1u == (tg + 1u) * nx) xb_add(&bar[XB_TOPGEN], 1u);
            else XB_SPIN(xb_ld(&bar[XB_TOPGEN]) == tg, bar);
            __builtin_amdgcn_fence(__ATOMIC_ACQUIRE, "agent");
            xb_add(&bar[XB_XGEN(b.x)], 1u);
            asm volatile("s_waitcnt vmcnt(0)" ::: "memory");
        } else {
            XB_SPIN(xb_ld(&bar[XB_XGEN(b.x)]) == gen, bar);
            __builtin_amdgcn_fence(__ATOMIC_ACQUIRE, "agent");
            asm volatile("s_waitcnt vmcnt(0)" ::: "memory");
        }
    }
    __syncthreads();
}

__device__ __forceinline__ void layer_phases(int l, const Args& args, LAS unsigned char* lds, const int tid0, const int lo, const int hi, const XcdBarrier& xbar) {
    const int G = gridDim.x; unsigned char* ws = args.ws;
    const int pb = 1 + 5 * l;
#define LAUNDER() int tid = tid0; asm volatile("" : "+v"(tid)); const int lane = tid & 63, wave = __builtin_amdgcn_readfirstlane(tid >> 6); int bx = blockIdx.x; asm volatile("" : "+s"(bx)); (void)lane; (void)wave; (void)bx
#define IN(k) (lo <= (k) && (k) < hi)
#define SEAM(k) do { if (IN(k) && IN((k) + 1)) { xcd_barrier(xbar); } } while (0)
        if (IN(pb)) { LAUNDER(); norm_phase(args, l, lane, wave); }
        SEAM(pb);
        if (IN(pb + 1)) { LAUNDER();
            pg8::Gemm g{(const pg8::bf16_t*)(ws + WS_H), (const pg8::bf16_t*)(ws + WS_BT1) + (size_t)l * NIN * 1024, MROWS, NIN, 1024};
            pg8::StaticOrder S; S.init(MROWS, NIN, G, bx);
            pg8::EpiU E{(pg8::bf16_t*)(ws + WS_U)};
            pg8::gemm_phase<pg8::EpiU, pg8::StaticOrder, true, true>(lds, g, S, E);
        }
        SEAM(pb + 1);
        if (IN(pb + 2)) { LAUNDER();
            const int nrun = (bx >= G - 16) ? 2 : 1;
#pragma unroll 1
            for (int k = 0; k < nrun; ++k) rg_run<false>(args, lds, l, k == 0 ? bx : 256 + (G - 1 - bx), tid, lane, wave);
            const int n_h = 256 + (l == 0 ? 16 : 0), n_conv = 128 + n_h;
            const int GC = G - 16;
            for (int un = bx; un < n_conv && bx < GC; un += GC) {
                int grow0, gstride, vlo, vhi, coff, cbase, nrows, ncall, orow0, ostride;
                if (un < 128) { const int bb = un >> 6, w = un & 63; vlo = bb * SEQ + w; vhi = vlo + SEQ; grow0 = vlo - 15 * 64; gstride = 64; coff = 1024 + 256; cbase = 256; nrows = 158; ncall = 2; orow0 = vlo; ostride = 64; }
                else { const int hu = un - 128; int r0, g;
                    if (hu < 256) { r0 = hu * 64; g = 0; vlo = r0; vhi = r0 + 64; }
                    else { const int cu = hu - 256, cc = cu >> 1, bb = cc >> 2; g = cu & 1; r0 = MLAT + cc * 64; vlo = MLAT + bb * CTXL; vhi = vlo + CTXL; }
                    grow0 = r0 - 15; gstride = 1; coff = 1024 + g * 256; cbase = g * 256; nrows = 94; ncall = 1; orow0 = r0; ostride = 1; }
                conv_unit(args, lds, l, grow0, gstride, vlo, vhi, coff, cbase, nrows, ncall, orow0, ostride, tid);
            }
        }
        SEAM(pb + 2);
        if (IN(pb + 3)) { LAUNDER();
            const int nrun = (l == 0 && bx >= G - 16) ? 2 : 1;
#pragma unroll 1
            for (int k = 0; k < nrun; ++k) rg_run<true>(args, lds, l, k == 0 ? bx : 256 + (G - 1 - bx), tid, lane, wave);
            ln_rows(args, l, (l == 0) ? MROWS : MLAT, lane, wave, (l == 0) ? G - 16 : G);
        }
        SEAM(pb + 3);
        if (IN(pb + 4)) { LAUNDER();
            const int M2 = (l == 0) ? MROWS : MLAT;
            pg8::Gemm g{(const pg8::bf16_t*)(ws + WS_MIXIN), (const pg8::bf16_t*)(ws + WS_BT2) + (size_t)l * 1024 * 1024, M2, 1024, 1024};
            pg8::StaticOrder S; S.init(M2, 1024, G, bx);
            pg8::EpiMix E{(pg8::bf16_t*)(ws + WS_MIX), (float*)(ws + WS_SSQ)};
            pg8::gemm_phase<pg8::EpiMix, pg8::StaticOrder, true, true>(lds, g, S, E);
        }
        SEAM(pb + 4);
#undef IN
#undef SEAM
#undef LAUNDER
}

__global__ void __launch_bounds__(NTHR, 2) fwd_megakernel(Args args) {
    extern __shared__ __attribute__((aligned(16))) unsigned char lds_raw[];
    LAS unsigned char* lds = (LAS unsigned char*)lds_raw;
    const int tid = threadIdx.x, lane = tid & 63, wave = __builtin_amdgcn_readfirstlane(tid >> 6);
    const int G = gridDim.x, bx = blockIdx.x;
    unsigned char* ws = args.ws;
    const int lo = args.ph_lo, hi = args.ph_hi;
    if (args.coop == 2) cg::this_grid().sync();
    volatile LAS unsigned* MISC = (volatile LAS unsigned*)(lds + MISC_OFF);
    if (tid < 64) MISC[tid] = 0u;
    __syncthreads();
    XcdBarrier xbar; xbar.bar = (unsigned*)(ws + WS_CTL); xbar.x = 0; xbar.st = nullptr;
    if (args.coop == 1) xbar = xcd_barrier_post((unsigned*)(ws + WS_CTL), MISC + 8);
#define IN(k) (lo <= (k) && (k) < hi)
#define SEAM(k) do { if (IN(k) && IN((k) + 1)) { xcd_barrier(xbar); } } while (0)

    if (IN(0)) { p0_prologue(args, lds, tid, lane, wave); }
    SEAM(0);
#pragma unroll 1
    for (int l = 0; l < 2; ++l) { int lo_ = l; asm volatile("" : "+s"(lo_)); layer_phases(lo_, args, lds, tid, lo, hi, xbar); }
    if (IN(11)) { norm_phase(args, 2, lane, wave); }
#undef IN
#undef SEAM
}

#ifndef MK_PER_PHASE
#define MK_PER_PHASE 0
#endif
extern "C" void kernel_launch(void* const* d_in, const int* in_sizes, int n_in, void* d_out, int out_size, void* d_ws, size_t ws_size, hipStream_t stream) {
    static int grid = 0;
    if (grid == 0) {
        if (n_in != 21 || out_size != MLAT * DM || ws_size < WS_END) { fprintf(stderr, "kernel_launch: unexpected shapes (n_in %d, out %d, ws %zu)\n", n_in, out_size, ws_size); grid = -1; return; }
        int dev = 0, cus = 0, per_cu = 0;
        if (hipGetDevice(&dev) != hipSuccess || hipDeviceGetAttribute(&cus, hipDeviceAttributeMultiprocessorCount, dev) != hipSuccess) { grid = -1; return; }
        if (hipFuncSetAttribute((const void*)fwd_megakernel, hipFuncAttributeMaxDynamicSharedMemorySize, LDS_BYTES) != hipSuccess) { fprintf(stderr, "kernel_launch: hipFuncSetAttribute failed\n"); grid = -1; return; }
        if (hipOccupancyMaxActiveBlocksPerMultiprocessor(&per_cu, (const void*)fwd_megakernel, NTHR, LDS_BYTES) != hipSuccess || per_cu < 1) { fprintf(stderr, "kernel_launch: occupancy query says %d\n", per_cu); per_cu = 1; }
        (void)hipGetLastError();
        grid = cus;
    }
    if (grid < 0) return;
    if (hipMemsetAsync((char*)d_ws + WS_CTL, 0, CTL_ZERO_BYTES, stream) != hipSuccess) { fprintf(stderr, "kernel_launch: memset failed\n"); return; }
    Args a{};
    for (int i = 0; i < 21; ++i) a.in[i] = (const float*)d_in[i];
    a.out = (float*)d_out; a.ws = (unsigned char*)d_ws;
#if MK_PER_PHASE
    for (int ph = 0; ph < 12; ++ph) { a.ph_lo = ph; a.ph_hi = ph + 1; a.coop = 0;
        hipLaunchKernelGGL(fwd_megakernel, dim3(grid), dim3(NTHR), LDS_BYTES, stream, a); }
#else
    a.ph_lo = 0; a.ph_hi = 12; a.coop = 1;
    void* kargs[] = {&a};
    hipError_t e = hipLaunchCooperativeKernel((const void*)fwd_megakernel, dim3(grid), dim3(NTHR), kargs, LDS_BYTES, stream);
    if (e != hipSuccess) fprintf(stderr, "cooperative launch failed: %s (grid %d)\n", hipGetErrorString(e), grid);
#endif
}
```

```cpp
#include <hip/hip_runtime.h>
#include <hip/hip_cooperative_groups.h>
#include <cstdio>
#include <cstdint>
namespace cg = cooperative_groups;
#define MK_PER_PHASE 0
namespace pg8 {
#define PG8_LAS __attribute__((address_space(3)))
typedef unsigned short bf16_t;
typedef short bf16x8 __attribute__((ext_vector_type(8)));
typedef float f32x4 __attribute__((ext_vector_type(4)));
typedef unsigned u32x4 __attribute__((ext_vector_type(4)));
constexpr int BM = 256, BK = 64, HALF = 128, HTB = HALF * BK * 2  , STAGE_BYTES = 8 * HTB, NXCD = 8, WGM = 8;

__host__ __device__ __forceinline__ int lds_byte(int r, int c) { const int st = (r >> 4) * 2 + (c >> 5), rr = r & 15, cc = c & 31, ob = rr * 64 + cc * 2; return st * 1024 + (ob ^ (((ob >> 9) & 1) << 5)); }
__host__ __device__ __forceinline__ void stage_rc(int b, int& R, int& C) { const int st = b / 1024, sb = b % 1024, swz = sb ^ (((sb >> 9) & 1) << 5); R = (st >> 1) * 16 + swz / 64; C = (st & 1) * 32 + (swz % 64) / 2; }
__host__ __device__ __forceinline__ int perm32(int rho) { const int n = rho >> 4, i = rho & 15; return 8 * (i >> 2) + 4 * n + (i & 3); }

struct Unit { int pm, pn; };
struct Gemm { const bf16_t* A; const bf16_t* Bt; int M, N, K; };

struct StaticOrder {
    int nM, nN, nwg, G, c;
    __host__ __device__ void init(int M, int N, int G_, int c_) { nM = M / BM; nN = N / BM; nwg = nM * nN; G = G_; c = c_; }
    __host__ __device__ bool next(int i, Unit& u) const {
        const long L = (long)i * G + c; if (L >= nwg) return false;
        int wgid = (int)L; { const int q = nwg / NXCD, r = nwg % NXCD, xcd = wgid % NXCD, off = wgid / NXCD; wgid = (xcd < r ? xcd * (q + 1) : r * (q + 1) + (xcd - r) * q) + off; }
        const int nig = WGM * nN, gid = wgid / nig, fm = gid * WGM, gsz = (nM - fm) < WGM ? (nM - fm) : WGM;
        u.pm = fm + ((wgid % nig) % gsz); u.pn = (wgid % nig) / gsz; return true;
    }
    __device__ __forceinline__ void a_ready(const Unit&) const {}
    __device__ __forceinline__ void done(const Unit&) const {}
};
__device__ __forceinline__ unsigned cvt_pk_bf16(float lo, float hi) { unsigned r; asm volatile("v_cvt_pk_bf16_f32 %0, %1, %2" : "=v"(r) : "v"(lo), "v"(hi)); return r; }
typedef float f32x2 __attribute__((ext_vector_type(2)));
template <class Epi, class Sched, bool ALIGN_EPI = false, bool SP2 = false>
__device__ __forceinline__ void gemm_phase(PG8_LAS unsigned char* lds, const Gemm g, const Sched& S, const Epi& E) {
    const int tid = threadIdx.x, wid = __builtin_amdgcn_readfirstlane(tid >> 6), lane = tid & 63, wr = wid >> 2, wc = wid & 3, fr = lane & 15, fq = lane >> 4;
    const int K = g.K, nt = K / BK;
    unsigned voffA[2], voffB[2];
#pragma unroll
    for (int i = 0; i < 2; ++i) { int R, C; stage_rc(tid * 16 + i * 8192, R, C); const int Rb = Epi::PERM ? ((R & ~31) + perm32(R & 31)) : R;
        voffA[i] = (unsigned)(R * K + C) * 2u; voffB[i] = (unsigned)(Rb * K + C) * 2u; }
    const size_t kstep = (size_t)(BK * 2);
    const size_t hstep = (size_t)HALF * K * 2;
    const size_t tstep = 2 * hstep;
    const unsigned ldsw = (unsigned)wid * 1024u;
    const int aoff = lds_byte(wr * 64 + fr, fq * 8), boff = lds_byte(wc * 32 + fr, fq * 8);
#define PG8_SA(b, h) (((b) * 2 + (h)) * HTB)
#define PG8_SB(b, h) ((4 + (b) * 2 + (h)) * HTB)
#define PG8_STAGE(bufoff, gbase, voff) do { _Pragma("unroll") for (int _i = 0; _i < 2; ++_i) \
        __builtin_amdgcn_global_load_lds((const unsigned*)((const char*)(gbase) + (voff)[_i]), (PG8_LAS unsigned*)(lds + (bufoff) + ldsw + _i * 8192), 16, 0, 0); } while (0)
#define PG8_LDA(dst, b, h) do { _Pragma("unroll") for (int m = 0; m < 4; ++m) _Pragma("unroll") for (int k = 0; k < 2; ++k) dst[m][k] = *(const PG8_LAS bf16x8*)(lds + PG8_SA(b, h) + aoff + m * 2048 + k * 1024); } while (0)
#define PG8_LDB(dst, b, h) do { _Pragma("unroll") for (int n = 0; n < 2; ++n) _Pragma("unroll") for (int k = 0; k < 2; ++k) dst[n][k] = *(const PG8_LAS bf16x8*)(lds + PG8_SB(b, h) + boff + n * 2048 + k * 1024); } while (0)
#define PG8_MMA(ai, bj, At, Bt) do { __builtin_amdgcn_s_setprio(1); _Pragma("unroll") for (int m = 0; m < 4; ++m) _Pragma("unroll") for (int n = 0; n < 2; ++n) _Pragma("unroll") for (int k = 0; k < 2; ++k) \
        acc[ai][bj][m][n] = __builtin_amdgcn_mfma_f32_16x16x32_bf16(Bt[n][k], At[m][k], acc[ai][bj][m][n], 0, 0, 0); __builtin_amdgcn_s_setprio(0); } while (0)
#define PG8_WAIT_V(n) asm volatile("s_waitcnt vmcnt(" #n ")" ::: "memory")
#define PG8_WAIT_L(n) asm volatile("s_waitcnt lgkmcnt(" #n ")" ::: "memory")
#define PG8_BAR __builtin_amdgcn_s_barrier()
#define PG8_SCHED __builtin_amdgcn_sched_barrier(0)
    Unit cur, nxt; int ui = 0;
    if (!S.next(0, cur)) return;
    f32x4 acc[2][2][4][2];
#pragma unroll
    for (int a = 0; a < 2; ++a)
#pragma unroll
        for (int b = 0; b < 2; ++b)
#pragma unroll
            for (int m = 0; m < 4; ++m)
#pragma unroll
                for (int n = 0; n < 2; ++n) acc[a][b][m][n] = (f32x4){0.f, 0.f, 0.f, 0.f};
    bf16x8 At[4][2], B0[2][2], B1[2][2];
    const char* cA = (const char*)g.A + (size_t)cur.pm * tstep; const char* cB = (const char*)g.Bt + (size_t)cur.pn * tstep;
    S.a_ready(cur);
    if constexpr (SP2) {
        PG8_STAGE(PG8_SB(0, 0), cB, voffB); PG8_STAGE(PG8_SB(0, 1), cB + hstep, voffB); PG8_STAGE(PG8_SA(0, 0), cA, voffA); PG8_STAGE(PG8_SA(0, 1), cA + hstep, voffA);
        if (wr == 1) PG8_BAR;
        PG8_WAIT_V(2); PG8_BAR;
        PG8_STAGE(PG8_SB(1, 0), cB + kstep, voffB); PG8_STAGE(PG8_SA(1, 0), cA + kstep, voffA); PG8_STAGE(PG8_SB(1, 1), cB + hstep + kstep, voffB);
        PG8_WAIT_V(6); PG8_BAR;
    } else {
        PG8_STAGE(PG8_SB(0, 0), cB, voffB); PG8_STAGE(PG8_SA(0, 0), cA, voffA); PG8_STAGE(PG8_SB(0, 1), cB + hstep, voffB); PG8_STAGE(PG8_SA(0, 1), cA + hstep, voffA);
        if (wr == 1) PG8_BAR;
        PG8_WAIT_V(4); PG8_BAR;
        PG8_STAGE(PG8_SB(1, 0), cB + kstep, voffB); PG8_STAGE(PG8_SA(1, 0), cA + kstep, voffA); PG8_STAGE(PG8_SB(1, 1), cB + hstep + kstep, voffB);
        PG8_WAIT_V(6); PG8_BAR;
    }
    for (;;) {
        const bool has_next = S.next(ui + 1, nxt);
        const char* nA = has_next ? (const char*)g.A + (size_t)nxt.pm * tstep : cA; const char* nB = has_next ? (const char*)g.Bt + (size_t)nxt.pn * tstep : cB;
        for (int t = 0; t < nt; t += 2) {
            const bool last = (t == nt - 2);
            const char* a1 = cA + (size_t)(t + 1) * kstep;
            const char* a2 = last ? nA : cA + (size_t)(t + 2) * kstep; const char* b2 = last ? nB : cB + (size_t)(t + 2) * kstep;
            const char* a3 = a2 + kstep; const char* b3 = b2 + kstep;
            if (last && has_next) S.a_ready(nxt);
            if constexpr (SP2) {
            PG8_LDB(B0, 0, 0); PG8_LDB(B1, 0, 1); PG8_SCHED; PG8_LDA(At, 0, 0); PG8_STAGE(PG8_SA(1, 1), a1 + hstep, voffA);
            PG8_WAIT_V(8); PG8_WAIT_L(0); PG8_BAR; PG8_MMA(0, 0, At, B0); PG8_MMA(0, 1, At, B1); PG8_BAR; PG8_SCHED;
            PG8_LDA(At, 0, 1); PG8_STAGE(PG8_SB(0, 0), b2, voffB); PG8_STAGE(PG8_SB(0, 1), b2 + hstep, voffB); PG8_STAGE(PG8_SA(0, 0), a2, voffA);
            PG8_WAIT_V(8); PG8_WAIT_L(0); PG8_BAR; PG8_MMA(1, 0, At, B0); PG8_MMA(1, 1, At, B1); PG8_BAR; PG8_SCHED;
            PG8_LDB(B0, 1, 0); PG8_LDB(B1, 1, 1); PG8_SCHED; PG8_LDA(At, 1, 0); PG8_STAGE(PG8_SA(0, 1), a2 + hstep, voffA);
            PG8_WAIT_V(8); PG8_WAIT_L(0); PG8_BAR; PG8_MMA(0, 0, At, B0); PG8_MMA(0, 1, At, B1); PG8_BAR; PG8_SCHED;
            PG8_LDA(At, 1, 1); PG8_STAGE(PG8_SB(1, 0), b3, voffB); PG8_STAGE(PG8_SB(1, 1), b3 + hstep, voffB); PG8_STAGE(PG8_SA(1, 0), a3, voffA);
            PG8_WAIT_V(8); PG8_WAIT_L(0); PG8_BAR; PG8_MMA(1, 0, At, B0); PG8_MMA(1, 1, At, B1); PG8_BAR; PG8_SCHED;
            } else {
            PG8_LDB(B0, 0, 0); PG8_SCHED; PG8_LDA(At, 0, 0); PG8_STAGE(PG8_SA(1, 1), a1 + hstep, voffA);
            PG8_WAIT_L(8); PG8_BAR; PG8_WAIT_L(0); PG8_MMA(0, 0, At, B0); PG8_BAR; PG8_SCHED;
            PG8_LDB(B1, 0, 1); PG8_STAGE(PG8_SB(0, 0), b2, voffB);
            PG8_BAR; PG8_WAIT_L(0); PG8_MMA(0, 1, At, B1); PG8_BAR;
            PG8_LDA(At, 0, 1); PG8_STAGE(PG8_SA(0, 0), a2, voffA);
            PG8_BAR; PG8_WAIT_L(0); PG8_MMA(1, 0, At, B0); PG8_BAR; PG8_SCHED;
            PG8_STAGE(PG8_SB(0, 1), b2 + hstep, voffB);
            PG8_WAIT_V(6); PG8_BAR; PG8_MMA(1, 1, At, B1); PG8_BAR;
            PG8_LDB(B0, 1, 0); PG8_SCHED; PG8_LDA(At, 1, 0); PG8_STAGE(PG8_SA(0, 1), a2 + hstep, voffA);
            PG8_WAIT_L(8); PG8_BAR; PG8_WAIT_L(0); PG8_MMA(0, 0, At, B0); PG8_BAR; PG8_SCHED;
            PG8_LDB(B1, 1, 1); PG8_STAGE(PG8_SB(1, 0), b3, voffB);
            PG8_BAR; PG8_WAIT_L(0); PG8_MMA(0, 1, At, B1); PG8_BAR;
            PG8_LDA(At, 1, 1); PG8_STAGE(PG8_SA(1, 0), a3, voffA);
            PG8_BAR; PG8_WAIT_L(0); PG8_MMA(1, 0, At, B0); PG8_BAR; PG8_SCHED;
            PG8_STAGE(PG8_SB(1, 1), b3 + hstep, voffB);
            PG8_WAIT_V(6); PG8_BAR; PG8_MMA(1, 1, At, B1); PG8_BAR;
            }
        }
        if constexpr (ALIGN_EPI) { if (wr == 0) PG8_BAR; }
        if constexpr (!Epi::AFTER_DRAIN) { E(acc, cur, wr, wc, fr, fq); S.done(cur); }
        if (!has_next) break;
#pragma unroll
        for (int a = 0; a < 2; ++a)
#pragma unroll
            for (int b = 0; b < 2; ++b)
#pragma unroll
                for (int m = 0; m < 4; ++m)
#pragma unroll
                    for (int n = 0; n < 2; ++n) acc[a][b][m][n] = (f32x4){0.f, 0.f, 0.f, 0.f};
        cur = nxt; cA = nA; cB = nB; ++ui;
        if constexpr (ALIGN_EPI) { if (wr == 1) PG8_BAR; }
    }
    PG8_WAIT_V(0);
    if constexpr (!ALIGN_EPI) { if (wr == 0) PG8_BAR; }
    PG8_BAR;
    if constexpr (Epi::AFTER_DRAIN) { E.fused(acc, cur, wr, wc, fr, fq, lds, wid, lane); S.done(cur); }
#undef PG8_SA
#undef PG8_SB
#undef PG8_STAGE
#undef PG8_LDA
#undef PG8_LDB
#undef PG8_MMA
#undef PG8_WAIT_V
#undef PG8_WAIT_L
#undef PG8_BAR
#undef PG8_SCHED
}
}

constexpr int DM = 1024, NB = 2, SEQ = 8192, CTXL = 256, MLAT = NB * SEQ, MCTX = NB * CTXL, MROWS = MLAT + MCTX;
constexpr int NIN = 2560, NCHUNK = MROWS / 64  , NPJ = 132  ;
constexpr float EPSF = 1e-6f;
constexpr int NWAVES = 8, NTHR = 512;

constexpr size_t MiB = 1u << 20;
constexpr size_t WS_CTL = 0, CTL_ZERO_BYTES = 64 * 1024;
constexpr size_t WS_MOD = 1 * MiB;
constexpr size_t WS_SP8 = 1 * MiB + 128 * 1024;
constexpr size_t WS_GWF = 1 * MiB + 256 * 1024;
constexpr size_t WS_BT1 = 2 * MiB;
constexpr size_t WS_BT2 = 12 * MiB;
constexpr size_t WS_AGGA = 16 * MiB;
constexpr size_t WS_AGGB = 16 * MiB + 1536 * 1024;
constexpr size_t WS_SSQ = 19 * MiB;
constexpr size_t WS_SSQ1 = 21 * MiB;
constexpr size_t WS_A16 = 23 * MiB;
constexpr size_t WS_B16 = 28 * MiB;
constexpr size_t WS_H = 73 * MiB;
constexpr size_t WS_Y = 56 * MiB;
constexpr size_t WS_MIXIN = 73 * MiB;
constexpr size_t WS_U = 106 * MiB;
constexpr size_t WS_MIX = 189 * MiB;
constexpr size_t WS_END = 255 * MiB;

constexpr int LDS_BYTES = 158720;
constexpr int MISC_OFF = 157696;

#define LAS __attribute__((address_space(3)))
typedef unsigned short bf16;
typedef unsigned v4u __attribute__((ext_vector_type(4)));
typedef unsigned v2u __attribute__((ext_vector_type(2)));
typedef float f32x4 __attribute__((ext_vector_type(4)));
typedef short bf16x8 __attribute__((ext_vector_type(8)));
typedef float f32x2v __attribute__((ext_vector_type(2)));
#define LDS_WAIT() asm volatile("s_waitcnt lgkmcnt(0)" ::: "memory")

__device__ __forceinline__ unsigned f2bf(float f) { unsigned u = __builtin_bit_cast(unsigned, f); return (u + 0x7fffu + ((u >> 16) & 1u)) >> 16; }
__device__ __forceinline__ unsigned pk2(float lo, float hi) { return f2bf(lo) | (f2bf(hi) << 16); }
__device__ __forceinline__ unsigned cvtpk(float lo, float hi) { unsigned r; asm volatile("v_cvt_pk_bf16_f32 %0, %1, %2" : "=v"(r) : "v"(lo), "v"(hi)); return r; }
__device__ __forceinline__ float bflo(unsigned u) { return __builtin_bit_cast(float, u << 16); }
__device__ __forceinline__ float bfhi(unsigned u) { return __builtin_bit_cast(float, u & 0xffff0000u); }
__device__ __forceinline__ float sigmoidf_(float x) { return 1.0f / (1.0f + __expf(-x)); }
__device__ __forceinline__ float siluf_(float x) { return x * __builtin_amdgcn_rcpf(1.0f + __builtin_amdgcn_exp2f(-1.44269504f * x)); }
__device__ __forceinline__ float wave_sum(float v) {
#pragma unroll
    for (int o = 1; o < 64; o <<= 1) v += __shfl_xor(v, o);
    return v;
}

struct Args {
    const float* in[21]; float* out; unsigned char* ws; int ph_lo, ph_hi, coop, pad;
};
enum { I_X = 0, I_C, I_CTX, I_CCTX, I_WMOD, I_BMOD, I_GPRE, I_GPOST, I_WIN, I_CAW, I_CAB, I_WR, I_BR, I_WI, I_BI, I_LAM, I_DWW, I_DWB, I_LNG, I_LNB, I_WOUT };

namespace pg8 {
struct EpiU {
    static constexpr bool PERM = true, AFTER_DRAIN = false;
    bf16_t* O;
    __device__ __forceinline__ void operator()(const f32x4 (&acc)[2][2][4][2], const Unit& u, int wr, int wc, int fr, int fq) const {
        const int row0 = u.pm * BM + wr * 64 + fr;
        if (u.pn >= 4 && u.pn < 8) {
            const int col0 = 1024 + 128 * (u.pn - 4) + wc * 32 + 8 * fq;
#pragma unroll
            for (int ai = 0; ai < 2; ++ai)
#pragma unroll
                for (int m = 0; m < 4; ++m) { f32x4 v0 = acc[ai][0][m][0], v1 = acc[ai][0][m][1]; const f32x4 g0 = acc[ai][1][m][0], g1 = acc[ai][1][m][1];
#pragma unroll
                    for (int e = 0; e < 4; ++e) { v0[e] = v0[e] * __builtin_amdgcn_rcpf(1.0f + __builtin_amdgcn_exp2f(-1.44269504f * g0[e])); v1[e] = v1[e] * __builtin_amdgcn_rcpf(1.0f + __builtin_amdgcn_exp2f(-1.44269504f * g1[e])); }
                    u32x4 w; w.x = cvt_pk_bf16(v0[0], v0[1]); w.y = cvt_pk_bf16(v0[2], v0[3]); w.z = cvt_pk_bf16(v1[0], v1[1]); w.w = cvt_pk_bf16(v1[2], v1[3]);
                    *(u32x4*)(O + (size_t)(row0 + ai * HALF + m * 16) * 2560 + col0) = w; }
            return;
        }
        const int col0 = u.pn * BM + wc * 32 + 8 * fq;
        const bool act = (u.pn == 2 || u.pn == 3 || u.pn >= 8);
#pragma unroll
        for (int ai = 0; ai < 2; ++ai)
#pragma unroll
            for (int m = 0; m < 4; ++m) { bf16_t* rowp = O + (size_t)(row0 + ai * HALF + m * 16) * 2560 + col0;
#pragma unroll
                for (int bj = 0; bj < 2; ++bj) { f32x4 v0 = acc[ai][bj][m][0], v1 = acc[ai][bj][m][1];
                    if (act) {
#pragma unroll
                        for (int e = 0; e < 4; ++e) { v0[e] = v0[e] * __builtin_amdgcn_rcpf(1.0f + __builtin_amdgcn_exp2f(-1.44269504f * v0[e])); v1[e] = v1[e] * __builtin_amdgcn_rcpf(1.0f + __builtin_amdgcn_exp2f(-1.44269504f * v1[e])); }
                    }
                    u32x4 w; w.x = cvt_pk_bf16(v0[0], v0[1]); w.y = cvt_pk_bf16(v0[2], v0[3]); w.z = cvt_pk_bf16(v1[0], v1[1]); w.w = cvt_pk_bf16(v1[2], v1[3]);
                    *(u32x4*)(rowp + bj * HALF) = w; } }
    }
};
struct EpiMix {
    static constexpr bool PERM = true, AFTER_DRAIN = false;
    bf16_t* O; float* ssq;
    __device__ __forceinline__ void operator()(const f32x4 (&acc)[2][2][4][2], const Unit& u, int wr, int wc, int fr, int fq) const {
        const int col0 = u.pn * BM + wc * 32 + 8 * fq;
#pragma unroll
        for (int ai = 0; ai < 2; ++ai)
#pragma unroll
            for (int m = 0; m < 4; ++m) { const int r = u.pm * BM + ai * HALF + wr * 64 + m * 16 + fr; bf16_t* rowp = O + (size_t)r * 1024 + col0; float s = 0.f;
#pragma unroll
                for (int bj = 0; bj < 2; ++bj) { const f32x4 v0 = acc[ai][bj][m][0], v1 = acc[ai][bj][m][1];
                    s += ((v0[0] * v0[0] + v0[1] * v0[1]) + (v0[2] * v0[2] + v0[3] * v0[3])) + ((v1[0] * v1[0] + v1[1] * v1[1]) + (v1[2] * v1[2] + v1[3] * v1[3]));
                    u32x4 w; w.x = cvt_pk_bf16(v0[0], v0[1]); w.y = cvt_pk_bf16(v0[2], v0[3]); w.z = cvt_pk_bf16(v1[0], v1[1]); w.w = cvt_pk_bf16(v1[2], v1[3]);
                    *(u32x4*)(rowp + bj * HALF) = w; }
                s += __shfl_xor(s, 16); s += __shfl_xor(s, 32);
                if (fq == 0) ssq[(size_t)r * 16 + u.pn * 4 + wc] = s; }
    }
};
}

__device__ __forceinline__ void p0_transpose_item(const float* W, int K, int N, bf16* WT, LAS float* scr, int item, int lane, bool glu_remap) {
    const int nblk = N / 32, kb = item / nblk, nb = item % nblk, k0 = 64 * kb, n0 = 32 * nb;
    int nd = n0;
    if (glu_remap) { if (n0 >= 1024 && n0 < 1536) nd = 1024 + 256 * ((n0 - 1024) >> 7) + ((n0 - 1024) & 127); else if (n0 >= 1536 && n0 < 2048) nd = 1024 + 256 * ((n0 - 1536) >> 7) + 128 + ((n0 - 1536) & 127); }
#pragma unroll 8
    for (int i = 0; i < 32; ++i) { const int kk = 2 * i + (lane >> 5); scr[kk * 33 + (lane & 31)] = W[(size_t)(k0 + kk) * N + n0 + (lane & 31)]; }
    LDS_WAIT(); asm volatile("" ::: "memory");
    const int c = lane & 7;
#pragma unroll
    for (int j = 0; j < 4; ++j) { const int n = (lane >> 3) + 8 * j; const LAS float* s = scr + (8 * c) * 33 + n;
        v4u o; o.x = pk2(s[0 * 33], s[1 * 33]); o.y = pk2(s[2 * 33], s[3 * 33]); o.z = pk2(s[4 * 33], s[5 * 33]); o.w = pk2(s[6 * 33], s[7 * 33]);
        *(v4u*)(WT + (size_t)(nd + n) * K + k0 + 8 * c) = o; }
    LDS_WAIT(); asm volatile("" ::: "memory");
}

__device__ __forceinline__ void p0_prologue(const Args& a, LAS unsigned char* lds, int tid, int lane, int wave) {
    const int G = gridDim.x, bx = blockIdx.x;
    unsigned char* ws = a.ws;
    {
        LAS float* part = (LAS float*)lds;
        float* MOD = (float*)(ws + WS_MOD);
        const float* c = a.in[I_C]; const float* cctx = a.in[I_CCTX];
        for (int un = bx; un < 192; un += G) {
            const int l = un / 96, n0 = (un % 96) * 32, cq = tid & 7, ks = tid >> 3;
            const float* wm = a.in[I_WMOD] + (size_t)l * 1024 * 3072 + n0 + cq * 4;
            f32x4 acc0 = {0.f, 0.f, 0.f, 0.f}, acc1 = acc0, acc2 = acc0;
#pragma unroll 4
            for (int kk = 0; kk < 16; ++kk) { const int k = ks * 16 + kk; const f32x4 w = *(const f32x4*)(wm + (size_t)k * 3072);
                const float a0 = siluf_(c[k]), a1 = siluf_(c[1024 + k]), a2 = siluf_(cctx[k]);
                acc0 += w * a0; acc1 += w * a1; acc2 += w * a2; }
            *(LAS f32x4*)(part + (0 * 64 + ks) * 32 + cq * 4) = acc0;
            *(LAS f32x4*)(part + (1 * 64 + ks) * 32 + cq * 4) = acc1;
            *(LAS f32x4*)(part + (2 * 64 + ks) * 32 + cq * 4) = acc2;
            __syncthreads();
            if (tid < 96) { const int v = tid >> 5, col = tid & 31; float s = a.in[I_BMOD][l * 3072 + n0 + col];
                for (int k2 = 0; k2 < 64; ++k2) s += part[(v * 64 + k2) * 32 + col];
                MOD[(l * 3 + v) * 3072 + n0 + col] = s; }
            __syncthreads();
        }
    }
    { float* SP8 = (float*)(ws + WS_SP8); for (int idx = bx * NTHR + tid; idx < 2048; idx += G * NTHR) SP8[idx] = -8.0f * log1pf(__expf(-a.in[I_LAM][idx])); }
    {
        v4u* GWF = (v4u*)(ws + WS_GWF);
        for (int idx = bx * NTHR + tid; idx < 32768; idx += G * NTHR) {
            const int ln = idx & 63, kk = (idx >> 6) & 1, ct = (idx >> 7) & 3, h = (idx >> 9) & 7, g = (idx >> 12) & 1, d = (idx >> 13) & 1, l = idx >> 14;
            const float* W = (g == 0 ? a.in[I_WR] : a.in[I_WI]) + (size_t)(((l * 2 + d) * 8 + h) * 64) * 64;
            const int k0 = 32 * kk + 8 * (ln >> 4), col = 16 * ct + (ln & 15);
            float e[8];
#pragma unroll
            for (int j = 0; j < 8; ++j) e[j] = W[(k0 + j) * 64 + col];
            v4u o; o.x = pk2(e[0], e[1]); o.y = pk2(e[2], e[3]); o.z = pk2(e[4], e[5]); o.w = pk2(e[6], e[7]);
            GWF[idx] = o;
        }
    }
    {
        LAS float* scr = (LAS float*)(lds + wave * 16384);
        const int gw = bx * NWAVES + wave, NGW = G * NWAVES;
        constexpr int I_1 = (1024 / 64) * (NIN / 32), I_2 = (1024 / 64) * (1024 / 32), NITEMS = 2 * (I_1 + I_2);
        bf16* BT1 = (bf16*)(ws + WS_BT1); bf16* BT2 = (bf16*)(ws + WS_BT2);
        for (int it = gw; it < NITEMS; it += NGW) {
            int r = it;
            if (r < I_1) { p0_transpose_item(a.in[I_WIN], 1024, NIN, BT1, scr, r, lane, true); continue; } r -= I_1;
            if (r < I_1) { p0_transpose_item(a.in[I_WIN] + (size_t)1024 * NIN, 1024, NIN, BT1 + (size_t)NIN * 1024, scr, r, lane, true); continue; } r -= I_1;
            if (r < I_2) { p0_transpose_item(a.in[I_WOUT], 1024, 1024, BT2, scr, r, lane, false); continue; } r -= I_2;
            p0_transpose_item(a.in[I_WOUT] + (size_t)1024 * 1024, 1024, 1024, BT2 + (size_t)1024 * 1024, scr, r, lane, false);
        }
    }
}

__device__ __forceinline__ void norm_phase(const Args& a, int mode, int lane, int wave) {
    unsigned char* ws = a.ws;
    const float* MOD = (const float*)(ws + WS_MOD); bf16* H = (bf16*)(ws + WS_H);
    const int gw = blockIdx.x * NWAVES + wave, NGW = gridDim.x * NWAVES;
    const int nrows = (mode == 2) ? MLAT : MROWS, ln = (mode == 0) ? 0 : 1;
    for (int row = gw; row < nrows; row += NGW) {
        const int vsel = row < MLAT ? (row >> 13) : 2;
        const float* src = row < MLAT ? a.in[I_X] + (size_t)row * 1024 : a.in[I_CTX] + (size_t)(row - MLAT) * 1024;
        f32x4 v[4];
#pragma unroll
        for (int j = 0; j < 4; ++j) v[j] = *((const f32x4*)src + lane + 64 * j);
#pragma unroll 1
        for (int lu = 0; lu < mode; ++lu) {
            const bf16* MIX = (const bf16*)(ws + WS_MIX) + (size_t)lu * MROWS * 1024; const float* SSQ = (const float*)(ws + (lu ? WS_SSQ1 : WS_SSQ));
            const float sp = lane < 16 ? SSQ[(size_t)row * 16 + lane] : 0.f;
            const float rstd = rsqrtf(wave_sum(sp) * (1.0f / 1024.0f) + EPSF);
            const float* gate = MOD + (lu * 3 + vsel) * 3072 + 2048; const float* gp = a.in[I_GPOST] + lu * 1024;
#pragma unroll
            for (int j = 0; j < 4; ++j) { const v2u mq = *((const v2u*)(MIX + (size_t)row * 1024) + lane + 64 * j); const f32x4 mx = {bflo(mq.x), bfhi(mq.x), bflo(mq.y), bfhi(mq.y)};
                const f32x4 gt = *((const f32x4*)gate + lane + 64 * j), gv = *((const f32x4*)gp + lane + 64 * j);
                v[j] += gt * (mx * rstd * gv); }
        }
        if (mode == 2) {
            float* dst = a.out + (size_t)row * 1024;
#pragma unroll
            for (int j = 0; j < 4; ++j) *((f32x4*)dst + lane + 64 * j) = v[j];
        } else {
            float s = 0.f;
#pragma unroll
            for (int j = 0; j < 4; ++j) s += (v[j].x * v[j].x + v[j].y * v[j].y) + (v[j].z * v[j].z + v[j].w * v[j].w);
            const float r = rsqrtf(wave_sum(s) * (1.0f / 1024.0f) + EPSF);
            const float* shift = MOD + (ln * 3 + vsel) * 3072; const float* scale = shift + 1024; const float* gpre = a.in[I_GPRE] + ln * 1024;
            v2u* o8 = (v2u*)(H + (size_t)row * 1024);
#pragma unroll
            for (int j = 0; j < 4; ++j) { const f32x4 sh = *((const f32x4*)shift + lane + 64 * j), sc = *((const f32x4*)scale + lane + 64 * j), gv = *((const f32x4*)gpre + lane + 64 * j);
                const f32x4 hv = v[j] * r * gv * (sc + 1.0f) + sh;
                v2u w; w.x = cvtpk(hv.x, hv.y); w.y = cvtpk(hv.z, hv.w); o8[lane + 64 * j] = w; }
        }
    }
}

__device__ __forceinline__ void conv16(const LAS unsigned* vt, const float (&w0)[31], const float (&w1)[31], float b0, float b1, bf16* ybase, size_t ystride) {
#pragma unroll 1
    for (int tq = 0; tq < 4; ++tq) {
        const LAS unsigned* vq = vt + tq * 4 * 128;
        float a0[4], a1[4];
#pragma unroll
        for (int t = 0; t < 4; ++t) { a0[t] = b0; a1[t] = b1; }
#pragma unroll
        for (int rr = 0; rr < 34; ++rr) { const unsigned u = vq[rr * 128]; const float lo = bflo(u), hi = bfhi(u);
#pragma unroll
            for (int t = 0; t < 4; ++t) { const int k = rr - t; if (k >= 0 && k < 31) { a0[t] += w0[k] * lo; a1[t] += w1[k] * hi; } }
            if ((rr & 7) == 7) asm volatile("" ::: "memory"); }
#pragma unroll
        for (int t = 0; t < 4; ++t) *(unsigned*)(ybase + (size_t)(tq * 4 + t) * ystride) = cvtpk(a0[t], a1[t]);
    }
}
__device__ __forceinline__ v4u glu8(const v4u vq, const v4u gq) {
    v4u o;
    o.x = pk2(bflo(vq.x) * sigmoidf_(bflo(gq.x)), bfhi(vq.x) * sigmoidf_(bfhi(gq.x)));
    o.y = pk2(bflo(vq.y) * sigmoidf_(bflo(gq.y)), bfhi(vq.y) * sigmoidf_(bfhi(gq.y)));
    o.z = pk2(bflo(vq.z) * sigmoidf_(bflo(gq.z)), bfhi(vq.z) * sigmoidf_(bfhi(gq.z)));
    o.w = pk2(bflo(vq.w) * sigmoidf_(bflo(gq.w)), bfhi(vq.w) * sigmoidf_(bfhi(gq.w)));
    return o;
}
__device__ __forceinline__ void conv_unit(const Args& a, LAS unsigned char* lds, int l, int grow0, int gstride, int vlo, int vhi, int coff, int cbase, int nrows, int ncall, int orow0, int ostride, int tid) {
    const bf16* U = (const bf16*)(a.ws + WS_U); bf16* Y = (bf16*)(a.ws + WS_Y);
    LAS unsigned* VT = (LAS unsigned*)lds;
    const int nchunk = nrows * 32;
#pragma unroll 1
    for (int i0 = tid; i0 < nchunk; i0 += 3 * NTHR) {
        v4u vq[3];
#pragma unroll
        for (int it = 0; it < 3; ++it) { const int i = i0 + it * NTHR, rr = i >> 5, ch = i & 31, row = grow0 + rr * gstride; const bool ok = i < nchunk && row >= vlo && row < vhi;
            vq[it] = *(const v4u*)(U + (size_t)(ok ? row : vlo) * NIN + coff + ch * 8); }
#pragma unroll
        for (int it = 0; it < 3; ++it) { const int i = i0 + it * NTHR, rr = i >> 5, ch = i & 31, row = grow0 + rr * gstride; const bool ok = row >= vlo && row < vhi;
            if (i < nchunk) { const v4u z = {0u, 0u, 0u, 0u}; *(LAS v4u*)(VT + rr * 128 + ch * 4) = ok ? vq[it] : z; } }
    }
    __syncthreads();
    int p = tid & 127; asm volatile("" : "+v"(p));
    const int tg = tid >> 7, c0 = cbase + 2 * p;
    float w0[31], w1[31];
#pragma unroll
    for (int k = 0; k < 31; ++k) { const float2 w = *(const float2*)(a.in[I_DWW] + (size_t)(l * 31 + k) * 512 + c0); w0[k] = w.x; w1[k] = w.y; }
    const float2 bb = *(const float2*)(a.in[I_DWB] + l * 512 + c0);
#pragma unroll 1
    for (int hc = 0; hc < ncall; ++hc) { const int tb = (tg * ncall + hc) * 16;
        conv16(VT + tb * 128 + p, w0, w1, bb.x, bb.y, Y + (size_t)(orow0 + tb * ostride) * 512 + c0, (size_t)ostride * 512); }
    __syncthreads();
}
__device__ __forceinline__ void ln_rows(const Args& a, int l, int nrows, int lane, int wave, int nblk) {
    const bf16* U = (const bf16*)(a.ws + WS_U); const bf16* Y = (const bf16*)(a.ws + WS_Y); bf16* MIXIN = (bf16*)(a.ws + WS_MIXIN);
    if ((int)blockIdx.x >= nblk) return;
    const int gw = blockIdx.x * NWAVES + wave, NGW = nblk * NWAVES, c0 = lane * 8;
    float lg[8], lb[8];
#pragma unroll
    for (int e = 0; e < 8; ++e) { lg[e] = a.in[I_LNG][l * 512 + c0 + e]; lb[e] = a.in[I_LNB][l * 512 + c0 + e]; }
    for (int row = gw; row < nrows; row += NGW) {
        const v4u yq = *(const v4u*)(Y + (size_t)row * 512 + c0); const v4u gq = *(const v4u*)(U + (size_t)row * NIN + 2048 + c0);
        float y[8] = {bflo(yq.x), bfhi(yq.x), bflo(yq.y), bfhi(yq.y), bflo(yq.z), bfhi(yq.z), bflo(yq.w), bfhi(yq.w)};
        const float gt[8] = {bflo(gq.x), bfhi(gq.x), bflo(gq.y), bfhi(gq.y), bflo(gq.z), bfhi(gq.z), bflo(gq.w), bfhi(gq.w)};
        float s = 0.f;
#pragma unroll
        for (int e = 0; e < 8; ++e) s += y[e];
        const float mean = wave_sum(s) * (1.0f / 512.0f); float q = 0.f;
#pragma unroll
        for (int e = 0; e < 8; ++e) { y[e] -= mean; q += y[e] * y[e]; }
        const float rstd = rsqrtf(wave_sum(q) * (1.0f / 512.0f) + EPSF);
        float o[8];
#pragma unroll
        for (int e = 0; e < 8; ++e) o[e] = siluf_(y[e] * rstd * lg[e] + lb[e]) * gt[e];
        v4u w; w.x = pk2(o[0], o[1]); w.y = pk2(o[2], o[3]); w.z = pk2(o[4], o[5]); w.w = pk2(o[6], o[7]);
        *(v4u*)(MIXIN + (size_t)row * 1024 + 512 + c0) = w;
    }
}

constexpr int RG_GW = 0, RG_FOLD = 32768, RG_F8 = 36864, RG_CAR = 40960, RG_WAVE = 57344, RG_WAVE_BYTES = 12544;
constexpr int NP16 = 4 * NPJ;
__device__ __forceinline__ float fsig(float x) { return __builtin_amdgcn_rcpf(1.0f + __expf(-x)); }

template <bool FINAL, bool FASTP>
__device__ __forceinline__ void rg_sweep(const Args& a, LAS unsigned char* lds, LAS unsigned char* wl, int l, int b, int h, int r0, int seg_lo, int seg_hi, int pj, bool is_ctx, int w, int lane, const int D) {
    const bf16* U = (const bf16*)(a.ws + WS_U); bf16* MIXIN = (bf16*)(a.ws + WS_MIXIN);
    float* AGGA = (float*)(a.ws + WS_AGGA); float* AGGB = (float*)(a.ws + WS_AGGB); float* A16 = (float*)(a.ws + WS_A16); float* B16 = (float*)(a.ws + WS_B16);
    LAS float* VCW = (LAS float*)wl; LAS unsigned* HBW = (LAS unsigned*)(wl + 4352);
    const LAS v4u* GWL = (const LAS v4u*)(lds + RG_GW) + (D * 2) * 8 * 64 + lane;
    const LAS float* CAR = (const LAS float*)(lds + RG_CAR);
    const int fr = lane & 15, fq = lane >> 4, cp = lane & 31, rh = lane >> 5;
    const int rbase = D ? r0 + 63 : r0, rsign = D ? -1 : 1;
    float2 cw[4];
#pragma unroll
    for (int k = 0; k < 4; ++k) cw[k] = *(const float2*)(a.in[I_CAW] + (size_t)((l * 2 + D) * 4 + (D ? 3 - k : k)) * 512 + 64 * h + 2 * cp);
    const float2 cbv = *(const float2*)(a.in[I_CAB] + (l * 2 + D) * 512 + 64 * h + 2 * cp);
    float brv[4], biv[4], sp8[4], Hc[4], Ac[4];
    const int p16own = 4 * pj + fq;
#pragma unroll
    for (int ct = 0; ct < 4; ++ct) { const int c = 16 * ct + fr, pidx = (l * 2 + D) * 512 + 64 * h + c;
        brv[ct] = a.in[I_BR][pidx]; biv[ct] = a.in[I_BI][pidx]; sp8[ct] = ((const float*)(a.ws + WS_SP8))[pidx];
        Hc[ct] = 0.f; Ac[ct] = 1.f;
        if (FINAL) {
            if (is_ctx) { const size_t base = (size_t)((b * 2 + D) * NP16) * 512 + 64 * h + c; float S = 0.f;
                for (int i = 0; i < p16own; ++i) S = A16[base + (size_t)i * 512] * S + B16[base + (size_t)i * 512];
                Hc[ct] = S; }
            else Hc[ct] = CAR[(D * 32 + 4 * (D ? 7 - w : w) + fq) * 64 + c];
        } }
    const bf16* ub = U + 64 * h + 2 * cp;
    unsigned Wd[2][7], nx[2][4];
#pragma unroll
    for (int q = 0; q < 2; ++q) { const int g = 2 * rh + q;
#pragma unroll
        for (int j = 0; j < 3; ++j) { const int row = rbase + rsign * (16 * g - 3 + j); const bool ok = row >= seg_lo && row < seg_hi; const int rc = ok ? row : r0;
            const unsigned v = *(const unsigned*)(ub + (size_t)rc * NIN); Wd[q][4 + j] = ok ? v : 0u; }
#pragma unroll
        for (int j = 0; j < 4; ++j) nx[q][j] = *(const unsigned*)(ub + (size_t)(rbase + rsign * (16 * g + j)) * NIN); }
#pragma unroll 1
    for (int ti = 0; ti < 4; ++ti) {
        const int tile = ti;
        int zo = 0; asm volatile("" : "+v"(zo));
        const LAS v4u* GWLt = GWL + zo;
        v4u g0 = {0u, 0u, 0u, 0u}, g1 = g0; size_t orow = 0;
        if (FINAL && D == 0) { orow = (size_t)(r0 + 16 * (fr >> 2) + 4 * tile + (fr & 3)); const bf16* gp = U + orow * NIN + 512 + 64 * h + 16 * fq; g0 = *(const v4u*)gp; g1 = *(const v4u*)(gp + 8); }
#pragma unroll
        for (int q = 0; q < 2; ++q) {
            Wd[q][0] = Wd[q][4]; Wd[q][1] = Wd[q][5]; Wd[q][2] = Wd[q][6]; Wd[q][3] = nx[q][0]; Wd[q][4] = nx[q][1]; Wd[q][5] = nx[q][2]; Wd[q][6] = nx[q][3]; }
        if (ti < 3) { const int tn = ti + 1;
#pragma unroll
            for (int q = 0; q < 2; ++q)
#pragma unroll
                for (int j = 0; j < 4; ++j) nx[q][j] = *(const unsigned*)(ub + (size_t)(rbase + rsign * (16 * (2 * rh + q) + 4 * tn + j)) * NIN); }
#pragma unroll
        for (int q = 0; q < 2; ++q)
#pragma unroll
            for (int jj = 0; jj < 4; ++jj) { float v0 = cbv.x, v1 = cbv.y;
#pragma unroll
                for (int k = 0; k < 4; ++k) { const unsigned u = Wd[q][jj + k]; v0 += cw[k].x * bflo(u); v1 += cw[k].y * bfhi(u); }
                *(LAS f32x2v*)(VCW + (4 * (2 * rh + q) + jj) * 68 + 2 * cp) = (f32x2v){v0, v1}; }
        bf16x8 af[2];
#pragma unroll
        for (int kk = 0; kk < 2; ++kk) { const LAS float* vp = VCW + fr * 68 + 32 * kk + 8 * fq; const f32x4 x0 = *(const LAS f32x4*)vp, x1 = *(const LAS f32x4*)(vp + 4);
            v4u pk; pk.x = cvtpk(x0.x, x0.y); pk.y = cvtpk(x0.z, x0.w); pk.z = cvtpk(x1.x, x1.y); pk.w = cvtpk(x1.z, x1.w); af[kk] = __builtin_bit_cast(bf16x8, pk); }
        float vcv[4][4];
#pragma unroll
        for (int ct = 0; ct < 4; ++ct)
#pragma unroll
            for (int jj = 0; jj < 4; ++jj) vcv[ct][jj] = VCW[(4 * fq + jj) * 68 + 16 * ct + fr];
        f32x4 accr[4], acci[4];
#pragma unroll
        for (int ct = 0; ct < 4; ++ct) { accr[ct] = (f32x4){0.f, 0.f, 0.f, 0.f}; acci[ct] = accr[ct];
#pragma unroll
            for (int kk = 0; kk < 2; ++kk) { const bf16x8 br = __builtin_bit_cast(bf16x8, GWLt[(ct * 2 + kk) * 64]), bi = __builtin_bit_cast(bf16x8, GWLt[(8 + ct * 2 + kk) * 64]);
                accr[ct] = __builtin_amdgcn_mfma_f32_16x16x32_bf16(af[kk], br, accr[ct], 0, 0, 0); acci[ct] = __builtin_amdgcn_mfma_f32_16x16x32_bf16(af[kk], bi, acci[ct], 0, 0, 0); } }
        float hsum[4][4];
#pragma unroll
        for (int ct = 0; ct < 4; ++ct) { float aa[4], bb[4];
            const float nbr = -1.44269504f * brv[ct], nbi = -1.44269504f * biv[ct];
#pragma unroll
            for (int p = 0; p < 2; ++p) {
                f32x2v xr = (f32x2v){accr[ct][2 * p], accr[ct][2 * p + 1]} * -1.44269504f + nbr, xi = (f32x2v){acci[ct][2 * p], acci[ct][2 * p + 1]} * -1.44269504f + nbi;
                xr = __builtin_elementwise_min(xr, (f32x2v){60.f, 60.f}); xi = __builtin_elementwise_min(xi, (f32x2v){60.f, 60.f});
                f32x2v d1, d2; d1.x = __builtin_amdgcn_exp2f(xr.x); d1.y = __builtin_amdgcn_exp2f(xr.y); d2.x = __builtin_amdgcn_exp2f(xi.x); d2.y = __builtin_amdgcn_exp2f(xi.y);
                d1 = d1 + 1.0f; d2 = d2 + 1.0f; const f32x2v m = d1 * d2; f32x2v inv; inv.x = __builtin_amdgcn_rcpf(m.x); inv.y = __builtin_amdgcn_rcpf(m.y);
                const f32x2v r = d2 * inv, ig = d1 * inv, la = r * sp8[ct], x2 = la + la, le = la * 1.44269504f;
                const f32x2v pom = -x2 * (x2 * (x2 * (x2 * (x2 * 0.0083333338f + 0.041666668f) + 0.16666667f) + 0.5f) + 1.0f);
                f32x2v av, om;
                if (FASTP) { av = la * (la * (la * (la * (la * 0.0083333338f + 0.041666668f) + 0.16666667f) + 0.5f) + 1.0f) + 1.0f; om = pom; }
                else { av.x = __builtin_amdgcn_exp2f(le.x); av.y = __builtin_amdgcn_exp2f(le.y);
                    const f32x2v o2 = 1.0f - av * av; om.x = x2.x > -0.25f ? pom.x : o2.x; om.y = x2.y > -0.25f ? pom.y : o2.y;
                    om = __builtin_elementwise_max(om, (f32x2v){0.f, 0.f}); }
                f32x2v sq; sq.x = __builtin_amdgcn_sqrtf(om.x); sq.y = __builtin_amdgcn_sqrtf(om.y);
                const f32x2v bv = sq * (ig * (f32x2v){vcv[ct][2 * p], vcv[ct][2 * p + 1]});
                aa[2 * p] = av.x; aa[2 * p + 1] = av.y; bb[2 * p] = bv.x; bb[2 * p + 1] = bv.y; }
            float hh = Hc[ct], A4 = 1.f;
#pragma unroll
            for (int jj = 0; jj < 4; ++jj) { hh = aa[jj] * hh + bb[jj]; A4 *= aa[jj]; hsum[ct][jj] = hh; }
            Hc[ct] = hh; if (!FINAL) Ac[ct] *= A4; }
        if (FINAL) {
            if (D == 1) {
#pragma unroll
                for (int ct = 0; ct < 4; ++ct)
#pragma unroll
                    for (int jp = 0; jp < 2; ++jp) HBW[(tile * 8 + ct * 2 + jp) * 64 + lane] = cvtpk(hsum[ct][2 * jp], hsum[ct][2 * jp + 1]);
            } else {
#pragma unroll
                for (int ct = 0; ct < 4; ++ct)
#pragma unroll
                    for (int jp = 0; jp < 2; ++jp) {
                        const unsigned hb = HBW[((3 - tile) * 8 + ct * 2 + (1 - jp)) * 64 + fr + 16 * (3 - fq)];
                        VCW[(4 * fq + 2 * jp) * 68 + 16 * ct + fr] = hsum[ct][2 * jp] + bfhi(hb); VCW[(4 * fq + 2 * jp + 1) * 68 + 16 * ct + fr] = hsum[ct][2 * jp + 1] + bflo(hb); }
                const size_t row = orow;
                const f32x4 s0 = *(const LAS f32x4*)(VCW + fr * 68 + 16 * fq), s1 = *(const LAS f32x4*)(VCW + fr * 68 + 16 * fq + 4), s2 = *(const LAS f32x4*)(VCW + fr * 68 + 16 * fq + 8), s3 = *(const LAS f32x4*)(VCW + fr * 68 + 16 * fq + 12);
                v4u o0, o1;
                o0.x = cvtpk(s0.x * bflo(g0.x), s0.y * bfhi(g0.x)); o0.y = cvtpk(s0.z * bflo(g0.y), s0.w * bfhi(g0.y)); o0.z = cvtpk(s1.x * bflo(g0.z), s1.y * bfhi(g0.z)); o0.w = cvtpk(s1.z * bflo(g0.w), s1.w * bfhi(g0.w));
                o1.x = cvtpk(s2.x * bflo(g1.x), s2.y * bfhi(g1.x)); o1.y = cvtpk(s2.z * bflo(g1.y), s2.w * bfhi(g1.y)); o1.z = cvtpk(s3.x * bflo(g1.z), s3.y * bfhi(g1.z)); o1.w = cvtpk(s3.z * bflo(g1.w), s3.w * bfhi(g1.w));
                bf16* op = MIXIN + row * 1024 + 64 * h + 16 * fq; *(v4u*)op = o0; *(v4u*)(op + 8) = o1;
            }
        }
    }
    if (!FINAL) {
#pragma unroll
        for (int ct = 0; ct < 4; ++ct) { const int c = 16 * ct + fr;
            const size_t i16 = (size_t)((b * 2 + D) * NP16 + p16own) * 512 + 64 * h + c; A16[i16] = Ac[ct]; B16[i16] = Hc[ct];
            float Ag[4], Bg[4];
#pragma unroll
            for (int g = 0; g < 4; ++g) { Ag[g] = __shfl(Ac[ct], fr + 16 * g); Bg[g] = __shfl(Hc[ct], fr + 16 * g); }
            float run = 0.f;
#pragma unroll
            for (int g = 0; g < 4; ++g) run = Ag[g] * run + Bg[g];
            if (fq == 0) { const size_t idx = (size_t)((b * 2 + D) * NPJ + pj) * 512 + 64 * h + c; AGGA[idx] = (Ag[0] * Ag[1]) * (Ag[2] * Ag[3]); AGGB[idx] = run; } }
    }
}

template <bool FINAL>
__device__ __forceinline__ void rg_run(const Args& a, LAS unsigned char* lds, int l, int rn, int tid, int lane, int wave) {
    const bool is_ctx = rn >= 256; const int bh = is_ctx ? rn - 256 : rn >> 4, b = bh >> 3, h = bh & 7, cgp = is_ctx ? 0 : (rn & 15);
    { const v4u* GWF = (const v4u*)(a.ws + WS_GWF); LAS v4u* GWL = (LAS v4u*)(lds + RG_GW);
#pragma unroll
      for (int i = tid; i < 2048; i += NTHR) { const int d = i >> 10, g = (i >> 9) & 1, rest = i & 511; GWL[i] = GWF[(size_t)((((l * 2 + d) * 2 + g) * 8 + h) * 8) * 64 + rest]; } }
    const int P0f = 4 + 8 * cgp, P0b = 124 - 8 * cgp;
    if (FINAL && !is_ctx) {
        const float* AGGA = (const float*)(a.ws + WS_AGGA); const float* AGGB = (const float*)(a.ws + WS_AGGB); const float* A16 = (const float*)(a.ws + WS_A16); const float* B16 = (const float*)(a.ws + WS_B16);
        const int d = tid >> 8, s = (tid >> 6) & 3, c = tid & 63, P0 = d ? P0b : P0f, lo = (P0 * s) >> 2, hi = (P0 * (s + 1)) >> 2;
        const size_t b16 = (size_t)((b * 2 + d) * NP16 + 4 * P0 + 8 * s) * 512 + 64 * h + c; float ai8[8], bi8[8];
#pragma unroll
        for (int i = 0; i < 8; ++i) { ai8[i] = A16[b16 + (size_t)i * 512]; bi8[i] = B16[b16 + (size_t)i * 512]; }
        const size_t base = (size_t)((b * 2 + d) * NPJ) * 512 + 64 * h + c; float A = 1.f, Bv = 0.f;
#pragma unroll 8
        for (int i = lo; i < hi; ++i) { const float ai = AGGA[base + (size_t)i * 512], bi = AGGB[base + (size_t)i * 512]; Bv = ai * Bv + bi; A *= ai; }
        LAS float* FO = (LAS float*)(lds + RG_FOLD); LAS float* F8 = (LAS float*)(lds + RG_F8); LAS float* CAR = (LAS float*)(lds + RG_CAR);
        FO[((d * 4 + s) * 64 + c) * 2] = A; FO[((d * 4 + s) * 64 + c) * 2 + 1] = Bv;
        float A8 = 1.f, B8 = 0.f;
#pragma unroll
        for (int i = 0; i < 8; ++i) { B8 = ai8[i] * B8 + bi8[i]; A8 *= ai8[i]; }
        F8[((d * 4 + s) * 64 + c) * 2] = A8; F8[((d * 4 + s) * 64 + c) * 2 + 1] = B8;
        __syncthreads();
        float S = 0.f;
#pragma unroll
        for (int s2 = 0; s2 < 4; ++s2) S = FO[((d * 4 + s2) * 64 + c) * 2] * S + FO[((d * 4 + s2) * 64 + c) * 2 + 1];
#pragma unroll
        for (int s2 = 0; s2 < 3; ++s2) if (s2 < s) S = F8[((d * 4 + s2) * 64 + c) * 2] * S + F8[((d * 4 + s2) * 64 + c) * 2 + 1];
#pragma unroll
        for (int i = 0; i < 8; ++i) { CAR[(d * 32 + 8 * s + i) * 64 + c] = S; S = ai8[i] * S + bi8[i]; }
    }
    __syncthreads();
    if (wave < (is_ctx ? 4 : 8)) {
        const int j = is_ctx ? wave : 8 * cgp + wave;
        const int seg_lo = is_ctx ? MLAT + b * CTXL : b * SEQ, seg_hi = seg_lo + (is_ctx ? CTXL : SEQ), r0 = seg_lo + 64 * j;
        const int pjf = is_ctx ? j : 4 + j, pjb = is_ctx ? 3 - j : 131 - j;
        LAS unsigned char* wl = lds + RG_WAVE + wave * RG_WAVE_BYTES;
        const float* SP8 = (const float*)(a.ws + WS_SP8);
        const bool fast1 = !__any(SP8[(l * 2 + 1) * 512 + 64 * h + lane] < -0.25f), fast0 = !__any(SP8[(l * 2 + 0) * 512 + 64 * h + lane] < -0.25f);
#pragma unroll 1
        for (int it = 0; it < 2; ++it) { const int D = 1 - it, pj = D ? pjb : pjf; const bool fast = D ? fast1 : fast0;
            if (fast) rg_sweep<FINAL, true>(a, lds, wl, l, b, h, r0, seg_lo, seg_hi, pj, is_ctx, wave, lane, D); else rg_sweep<FINAL, false>(a, lds, wl, l, b, h, r0, seg_lo, seg_hi, pj, is_ctx, wave, lane, D); }
    }
    __syncthreads();
}

#define RLX_AGENT __ATOMIC_RELAXED, __HIP_MEMORY_SCOPE_AGENT


#define XB_TMO      128
#define XB_XCNT(j)  (256  + 64 * (j))
#define XB_XSUB(j)  (1280 + 64 * (j))
#define XB_XGEN(j)  (2304 + 64 * (j))
#define XB_TOP      3328
#define XB_TOPGEN   3392
#define XCD_BAR_WORDS 3456
#define XB_SPIN_CAP (1u << 18)

__device__ __forceinline__ unsigned xb_ld(unsigned* p)              { return __hip_atomic_load(p, __ATOMIC_RELAXED, __HIP_MEMORY_SCOPE_AGENT); }
__device__ __forceinline__ unsigned xb_add(unsigned* p, unsigned v) { return __hip_atomic_fetch_add(p, v, __ATOMIC_RELAXED, __HIP_MEMORY_SCOPE_AGENT); }
__device__ __forceinline__ unsigned xb_xcc_id() { return (unsigned)__builtin_amdgcn_s_getreg((3 << 11) | 20) & 0xFu; }
#define XB_SPIN(cond, bar) do { unsigned _sp = 0; while (cond) { __builtin_amdgcn_s_sleep(1); \
    if ((++_sp & 255u) == 0u) { if (xb_ld(&(bar)[XB_TMO])) break; if (_sp > XB_SPIN_CAP) { atomicAdd(&(bar)[XB_TMO], 1u); break; } } } } while (0)

struct XcdBarrier {
    unsigned* bar; unsigned x;
    volatile LAS unsigned* st;
};

__device__ __forceinline__ XcdBarrier xcd_barrier_post(unsigned* bar, volatile LAS unsigned* st) {
    XcdBarrier b; b.bar = bar; b.x = xb_xcc_id(); b.st = st;
    if (threadIdx.x == 0) (void)xb_add(&bar[XB_XCNT(b.x)], 1u);
    return b;
}
__device__ __forceinline__ void xcd_barrier_complete(unsigned* bar, unsigned x, unsigned& nloc, unsigned& nx) {
    const unsigned G = gridDim.x * gridDim.y * gridDim.z;
    unsigned sum, cnt, mine, sp = 0u;
    for (;;) {
        sum = 0u; cnt = 0u; mine = 0u;
#pragma unroll
        for (unsigned j = 0; j < 16; ++j) { const unsigned c = xb_ld(&bar[XB_XCNT(j)]); sum += c; cnt += (c > 0u) ? 1u : 0u; mine = (j == x) ? c : mine; }
        if (sum == G) break;
        __builtin_amdgcn_s_sleep(1);
        if ((++sp & 255u) == 0u) { if (xb_ld(&bar[XB_TMO])) break; if (sp > XB_SPIN_CAP) { atomicAdd(&bar[XB_TMO], 1u); break; } }
    }
    nloc = mine > 0u ? mine : 1u; nx = cnt > 0u ? cnt : 1u;
}

__device__ __forceinline__ void xcd_barrier(const XcdBarrier& b) {
    asm volatile("s_waitcnt vmcnt(0)" ::: "memory");
    __syncthreads();
    if (threadIdx.x == 0) {
        unsigned* bar = b.bar;
        __builtin_amdgcn_s_waitcnt(0);
        unsigned nloc = b.st[0], nx = b.st[1];
        if (nloc == 0u) { xcd_barrier_complete(bar, b.x, nloc, nx); b.st[0] = nloc; b.st[1] = nx; }
        const unsigned old = xb_add(&bar[XB_XSUB(b.x)], 1u);
        const unsigned gen = old / nloc;
        if (old + 1u == (gen + 1u) * nloc) {
            __builtin_amdgcn_fence(__ATOMIC_RELEASE, "agent");
            asm volatile("s_waitcnt vmcnt(0)" ::: "memory");
            const unsigned og = xb_add(&bar[XB_TOP], 1u);
            const unsigned tg = og / nx;
            if (og + 1u == (tg + 1u) * nx) xb_add(&bar[XB_TOPGEN], 1u);
            else XB_SPIN(xb_ld(&bar[XB_TOPGEN]) == tg, bar);
            __builtin_amdgcn_fence(__ATOMIC_ACQUIRE, "agent");
            xb_add(&bar[XB_XGEN(b.x)], 1u);
            asm volatile("s_waitcnt vmcnt(0)" ::: "memory");
        } else {
            XB_SPIN(xb_ld(&bar[XB_XGEN(b.x)]) == gen, bar);
            __builtin_amdgcn_fence(__ATOMIC_ACQUIRE, "agent");
            asm volatile("s_waitcnt vmcnt(0)" ::: "memory");
        }
    }
    __syncthreads();
}

__device__ __forceinline__ void layer_phases(int l, const Args& args, LAS unsigned char* lds, const int tid0, const int lo, const int hi, const XcdBarrier& xbar) {
    const int G = gridDim.x; unsigned char* ws = args.ws;
    const int pb = 1 + 5 * l;
#define LAUNDER() int tid = tid0; asm volatile("" : "+v"(tid)); const int lane = tid & 63, wave = __builtin_amdgcn_readfirstlane(tid >> 6); int bx = blockIdx.x; asm volatile("" : "+s"(bx)); (void)lane; (void)wave; (void)bx
#define IN(k) (lo <= (k) && (k) < hi)
#define SEAM(k) do { if (IN(k) && IN((k) + 1)) { xcd_barrier(xbar); } } while (0)
        if (IN(pb)) { LAUNDER(); norm_phase(args, l, lane, wave); }
        SEAM(pb);
        if (IN(pb + 1)) { LAUNDER();
            pg8::Gemm g{(const pg8::bf16_t*)(ws + WS_H), (const pg8::bf16_t*)(ws + WS_BT1) + (size_t)l * NIN * 1024, MROWS, NIN, 1024};
            pg8::StaticOrder S; S.init(MROWS, NIN, G, bx);
            pg8::EpiU E{(pg8::bf16_t*)(ws + WS_U)};
            pg8::gemm_phase<pg8::EpiU, pg8::StaticOrder, true, true>(lds, g, S, E);
        }
        SEAM(pb + 1);
        if (IN(pb + 2)) { LAUNDER();
            const int nrun = (bx >= G - 16) ? 2 : 1;
#pragma unroll 1
            for (int k = 0; k < nrun; ++k) rg_run<false>(args, lds, l, k == 0 ? bx : 256 + (G - 1 - bx), tid, lane, wave);
            const int n_h = 256 + (l == 0 ? 16 : 0), n_conv = 128 + n_h;
            const int GC = G - 16;
            for (int un = bx; un < n_conv && bx < GC; un += GC) {
                int grow0, gstride, vlo, vhi, coff, cbase, nrows, ncall, orow0, ostride;
                if (un < 128) { const int bb = un >> 6, w = un & 63; vlo = bb * SEQ + w; vhi = vlo + SEQ; grow0 = vlo - 15 * 64; gstride = 64; coff = 1024 + 256; cbase = 256; nrows = 158; ncall = 2; orow0 = vlo; ostride = 64; }
                else { const int hu = un - 128; int r0, g;
                    if (hu < 256) { r0 = hu * 64; g = 0; vlo = r0; vhi = r0 + 64; }
                    else { const int cu = hu - 256, cc = cu >> 1, bb = cc >> 2; g = cu & 1; r0 = MLAT + cc * 64; vlo = MLAT + bb * CTXL; vhi = vlo + CTXL; }
                    grow0 = r0 - 15; gstride = 1; coff = 1024 + g * 256; cbase = g * 256; nrows = 94; ncall = 1; orow0 = r0; ostride = 1; }
                conv_unit(args, lds, l, grow0, gstride, vlo, vhi, coff, cbase, nrows, ncall, orow0, ostride, tid);
            }
        }
        SEAM(pb + 2);
        if (IN(pb + 3)) { LAUNDER();
            const int nrun = (l == 0 && bx >= G - 16) ? 2 : 1;
#pragma unroll 1
            for (int k = 0; k < nrun; ++k) rg_run<true>(args, lds, l, k == 0 ? bx : 256 + (G - 1 - bx), tid, lane, wave);
            ln_rows(args, l, (l == 0) ? MROWS : MLAT, lane, wave, (l == 0) ? G - 16 : G);
        }
        SEAM(pb + 3);
        if (IN(pb + 4)) { LAUNDER();
            const int M2 = (l == 0) ? MROWS : MLAT;
            pg8::Gemm g{(const pg8::bf16_t*)(ws + WS_MIXIN), (const pg8::bf16_t*)(ws + WS_BT2) + (size_t)l * 1024 * 1024, M2, 1024, 1024};
            pg8::StaticOrder S; S.init(M2, 1024, G, bx);
            pg8::EpiMix E{(pg8::bf16_t*)(ws + WS_MIX) + (size_t)l * MROWS * 1024, (float*)(ws + (l ? WS_SSQ1 : WS_SSQ))};
            pg8::gemm_phase<pg8::EpiMix, pg8::StaticOrder, true, true>(lds, g, S, E);
        }
        SEAM(pb + 4);
#undef IN
#undef SEAM
#undef LAUNDER
}

__global__ void __launch_bounds__(NTHR, 2) fwd_megakernel(Args args) {
    extern __shared__ __attribute__((aligned(16))) unsigned char lds_raw[];
    LAS unsigned char* lds = (LAS unsigned char*)lds_raw;
    const int tid = threadIdx.x, lane = tid & 63, wave = __builtin_amdgcn_readfirstlane(tid >> 6);
    const int G = gridDim.x, bx = blockIdx.x;
    unsigned char* ws = args.ws;
    const int lo = args.ph_lo, hi = args.ph_hi;
    if (args.coop == 2) cg::this_grid().sync();
    volatile LAS unsigned* MISC = (volatile LAS unsigned*)(lds + MISC_OFF);
    if (tid < 64) MISC[tid] = 0u;
    __syncthreads();
    XcdBarrier xbar; xbar.bar = (unsigned*)(ws + WS_CTL); xbar.x = 0; xbar.st = nullptr;
    if (args.coop == 1) xbar = xcd_barrier_post((unsigned*)(ws + WS_CTL), MISC + 8);
#define IN(k) (lo <= (k) && (k) < hi)
#define SEAM(k) do { if (IN(k) && IN((k) + 1)) { xcd_barrier(xbar); } } while (0)

    if (IN(0)) { p0_prologue(args, lds, tid, lane, wave); }
    SEAM(0);
#pragma unroll 1
    for (int l = 0; l < 2; ++l) { int lo_ = l; asm volatile("" : "+s"(lo_)); layer_phases(lo_, args, lds, tid, lo, hi, xbar); }
    if (IN(11)) { norm_phase(args, 2, lane, wave); }
#undef IN
#undef SEAM
}

#ifndef MK_PER_PHASE
#define MK_PER_PHASE 0
#endif
extern "C" void kernel_launch(void* const* d_in, const int* in_sizes, int n_in, void* d_out, int out_size, void* d_ws, size_t ws_size, hipStream_t stream) {
    static int grid = 0;
    if (grid == 0) {
        if (n_in != 21 || out_size != MLAT * DM || ws_size < WS_END) { fprintf(stderr, "kernel_launch: unexpected shapes (n_in %d, out %d, ws %zu)\n", n_in, out_size, ws_size); grid = -1; return; }
        int dev = 0, cus = 0, per_cu = 0;
        if (hipGetDevice(&dev) != hipSuccess || hipDeviceGetAttribute(&cus, hipDeviceAttributeMultiprocessorCount, dev) != hipSuccess) { grid = -1; return; }
        if (hipFuncSetAttribute((const void*)fwd_megakernel, hipFuncAttributeMaxDynamicSharedMemorySize, LDS_BYTES) != hipSuccess) { fprintf(stderr, "kernel_launch: hipFuncSetAttribute failed\n"); grid = -1; return; }
        if (hipOccupancyMaxActiveBlocksPerMultiprocessor(&per_cu, (const void*)fwd_megakernel, NTHR, LDS_BYTES) != hipSuccess || per_cu < 1) { fprintf(stderr, "kernel_launch: occupancy query says %d\n", per_cu); per_cu = 1; }
        (void)hipGetLastError();
        grid = cus;
    }
    if (grid < 0) return;
    if (hipMemsetAsync((char*)d_ws + WS_CTL, 0, CTL_ZERO_BYTES, stream) != hipSuccess) { fprintf(stderr, "kernel_launch: memset failed\n"); return; }
    Args a{};
    for (int i = 0; i < 21; ++i) a.in[i] = (const float*)d_in[i];
    a.out = (float*)d_out; a.ws = (unsigned char*)d_ws;
#if MK_PER_PHASE
    for (int ph = 0; ph < 12; ++ph) { a.ph_lo = ph; a.ph_hi = ph + 1; a.coop = 0;
        hipLaunchKernelGGL(fwd_megakernel, dim3(grid), dim3(NTHR), LDS_BYTES, stream, a); }
#else
    a.ph_lo = 0; a.ph_hi = 12; a.coop = 1;
    void* kargs[] = {&a};
    hipError_t e = hipLaunchCooperativeKernel((const void*)fwd_megakernel, dim3(grid), dim3(NTHR), kargs, LDS_BYTES, stream);
    if (e != hipSuccess) fprintf(stderr, "cooperative launch failed: %s (grid %d)\n", hipGetErrorString(e), grid);
#endif
}
```

```cpp
#include <hip/hip_runtime.h>
#include <hip/hip_cooperative_groups.h>
#include <cstdio>
#include <cstdint>
namespace cg = cooperative_groups;
#define MK_PER_PHASE 0
namespace pg8 {
#define PG8_LAS __attribute__((address_space(3)))
typedef unsigned short bf16_t;
typedef short bf16x8 __attribute__((ext_vector_type(8)));
typedef float f32x4 __attribute__((ext_vector_type(4)));
typedef unsigned u32x4 __attribute__((ext_vector_type(4)));
constexpr int BM = 256, BK = 64, HALF = 128, HTB = HALF * BK * 2  , STAGE_BYTES = 8 * HTB, NXCD = 8, WGM = 8;

__host__ __device__ __forceinline__ int lds_byte(int r, int c) { const int st = (r >> 4) * 2 + (c >> 5), rr = r & 15, cc = c & 31, ob = rr * 64 + cc * 2; return st * 1024 + (ob ^ (((ob >> 9) & 1) << 5)); }
__host__ __device__ __forceinline__ void stage_rc(int b, int& R, int& C) { const int st = b / 1024, sb = b % 1024, swz = sb ^ (((sb >> 9) & 1) << 5); R = (st >> 1) * 16 + swz / 64; C = (st & 1) * 32 + (swz % 64) / 2; }
__host__ __device__ __forceinline__ int perm32(int rho) { const int n = rho >> 4, i = rho & 15; return 8 * (i >> 2) + 4 * n + (i & 3); }

struct Unit { int pm, pn; };
struct Gemm { const bf16_t* A; const bf16_t* Bt; int M, N, K; };

struct StaticOrder {
    int nM, nN, nwg, G, c;
    __host__ __device__ void init(int M, int N, int G_, int c_) { nM = M / BM; nN = N / BM; nwg = nM * nN; G = G_; c = c_; }
    __host__ __device__ bool next(int i, Unit& u) const {
        const long L = (long)i * G + c; if (L >= nwg) return false;
        int wgid = (int)L; { const int q = nwg / NXCD, r = nwg % NXCD, xcd = wgid % NXCD, off = wgid / NXCD; wgid = (xcd < r ? xcd * (q + 1) : r * (q + 1) + (xcd - r) * q) + off; }
        const int nig = WGM * nN, gid = wgid / nig, fm = gid * WGM, gsz = (nM - fm) < WGM ? (nM - fm) : WGM;
        u.pm = fm + ((wgid % nig) % gsz); u.pn = (wgid % nig) / gsz; return true;
    }
    __device__ __forceinline__ void a_ready(const Unit&) const {}
    __device__ __forceinline__ void done(const Unit&) const {}
};
__device__ __forceinline__ unsigned cvt_pk_bf16(float lo, float hi) { unsigned r; asm volatile("v_cvt_pk_bf16_f32 %0, %1, %2" : "=v"(r) : "v"(lo), "v"(hi)); return r; }
typedef float f32x2 __attribute__((ext_vector_type(2)));
template <class Epi, class Sched, bool ALIGN_EPI = false, bool SP2 = false>
__device__ __forceinline__ void gemm_phase(PG8_LAS unsigned char* lds, const Gemm g, const Sched& S, const Epi& E) {
    const int tid = threadIdx.x, wid = __builtin_amdgcn_readfirstlane(tid >> 6), lane = tid & 63, wr = wid >> 2, wc = wid & 3, fr = lane & 15, fq = lane >> 4;
    const int K = g.K, nt = K / BK;
    unsigned voffA[2], voffB[2];
#pragma unroll
    for (int i = 0; i < 2; ++i) { int R, C; stage_rc(tid * 16 + i * 8192, R, C); const int Rb = Epi::PERM ? ((R & ~31) + perm32(R & 31)) : R;
        voffA[i] = (unsigned)(R * K + C) * 2u; voffB[i] = (unsigned)(Rb * K + C) * 2u; }
    const size_t kstep = (size_t)(BK * 2);
    const size_t hstep = (size_t)HALF * K * 2;
    const size_t tstep = 2 * hstep;
    const unsigned ldsw = (unsigned)wid * 1024u;
    const int aoff = lds_byte(wr * 64 + fr, fq * 8), boff = lds_byte(wc * 32 + fr, fq * 8);
#define PG8_SA(b, h) (((b) * 2 + (h)) * HTB)
#define PG8_SB(b, h) ((4 + (b) * 2 + (h)) * HTB)
#define PG8_STAGE(bufoff, gbase, voff) do { _Pragma("unroll") for (int _i = 0; _i < 2; ++_i) \
        __builtin_amdgcn_global_load_lds((const unsigned*)((const char*)(gbase) + (voff)[_i]), (PG8_LAS unsigned*)(lds + (bufoff) + ldsw + _i * 8192), 16, 0, 0); } while (0)
#define PG8_LDA(dst, b, h) do { _Pragma("unroll") for (int m = 0; m < 4; ++m) _Pragma("unroll") for (int k = 0; k < 2; ++k) dst[m][k] = *(const PG8_LAS bf16x8*)(lds + PG8_SA(b, h) + aoff + m * 2048 + k * 1024); } while (0)
#define PG8_LDB(dst, b, h) do { _Pragma("unroll") for (int n = 0; n < 2; ++n) _Pragma("unroll") for (int k = 0; k < 2; ++k) dst[n][k] = *(const PG8_LAS bf16x8*)(lds + PG8_SB(b, h) + boff + n * 2048 + k * 1024); } while (0)
#define PG8_MMA(ai, bj, At, Bt) do { __builtin_amdgcn_s_setprio(1); _Pragma("unroll") for (int m = 0; m < 4; ++m) _Pragma("unroll") for (int n = 0; n < 2; ++n) _Pragma("unroll") for (int k = 0; k < 2; ++k) \
        acc[ai][bj][m][n] = __builtin_amdgcn_mfma_f32_16x16x32_bf16(Bt[n][k], At[m][k], acc[ai][bj][m][n], 0, 0, 0); __builtin_amdgcn_s_setprio(0); } while (0)
#define PG8_WAIT_V(n) asm volatile("s_waitcnt vmcnt(" #n ")" ::: "memory")
#define PG8_WAIT_L(n) asm volatile("s_waitcnt lgkmcnt(" #n ")" ::: "memory")
#define PG8_BAR __builtin_amdgcn_s_barrier()
#define PG8_SCHED __builtin_amdgcn_sched_barrier(0)
    Unit cur, nxt; int ui = 0;
    if (!S.next(0, cur)) return;
    f32x4 acc[2][2][4][2];
#pragma unroll
    for (int a = 0; a < 2; ++a)
#pragma unroll
        for (int b = 0; b < 2; ++b)
#pragma unroll
            for (int m = 0; m < 4; ++m)
#pragma unroll
                for (int n = 0; n < 2; ++n) acc[a][b][m][n] = (f32x4){0.f, 0.f, 0.f, 0.f};
    bf16x8 At[4][2], B0[2][2], B1[2][2];
    const char* cA = (const char*)g.A + (size_t)cur.pm * tstep; const char* cB = (const char*)g.Bt + (size_t)cur.pn * tstep;
    S.a_ready(cur);
    if constexpr (SP2) {
        PG8_STAGE(PG8_SB(0, 0), cB, voffB); PG8_STAGE(PG8_SB(0, 1), cB + hstep, voffB); PG8_STAGE(PG8_SA(0, 0), cA, voffA); PG8_STAGE(PG8_SA(0, 1), cA + hstep, voffA);
        if (wr == 1) PG8_BAR;
        PG8_WAIT_V(2); PG8_BAR;
        PG8_STAGE(PG8_SB(1, 0), cB + kstep, voffB); PG8_STAGE(PG8_SA(1, 0), cA + kstep, voffA); PG8_STAGE(PG8_SB(1, 1), cB + hstep + kstep, voffB);
        PG8_WAIT_V(6); PG8_BAR;
    } else {
        PG8_STAGE(PG8_SB(0, 0), cB, voffB); PG8_STAGE(PG8_SA(0, 0), cA, voffA); PG8_STAGE(PG8_SB(0, 1), cB + hstep, voffB); PG8_STAGE(PG8_SA(0, 1), cA + hstep, voffA);
        if (wr == 1) PG8_BAR;
        PG8_WAIT_V(4); PG8_BAR;
        PG8_STAGE(PG8_SB(1, 0), cB + kstep, voffB); PG8_STAGE(PG8_SA(1, 0), cA + kstep, voffA); PG8_STAGE(PG8_SB(1, 1), cB + hstep + kstep, voffB);
        PG8_WAIT_V(6); PG8_BAR;
    }
    for (;;) {
        const bool has_next = S.next(ui + 1, nxt);
        const char* nA = has_next ? (const char*)g.A + (size_t)nxt.pm * tstep : cA; const char* nB = has_next ? (const char*)g.Bt + (size_t)nxt.pn * tstep : cB;
        for (int t = 0; t < nt; t += 2) {
            const bool last = (t == nt - 2);
            const char* a1 = cA + (size_t)(t + 1) * kstep;
            const char* a2 = last ? nA : cA + (size_t)(t + 2) * kstep; const char* b2 = last ? nB : cB + (size_t)(t + 2) * kstep;
            const char* a3 = a2 + kstep; const char* b3 = b2 + kstep;
            if (last && has_next) S.a_ready(nxt);
            if constexpr (SP2) {
            PG8_LDB(B0, 0, 0); PG8_LDB(B1, 0, 1); PG8_SCHED; PG8_LDA(At, 0, 0); PG8_STAGE(PG8_SA(1, 1), a1 + hstep, voffA);
            PG8_WAIT_V(8); PG8_WAIT_L(0); PG8_BAR; PG8_MMA(0, 0, At, B0); PG8_MMA(0, 1, At, B1); PG8_BAR; PG8_SCHED;
            PG8_LDA(At, 0, 1); PG8_STAGE(PG8_SB(0, 0), b2, voffB); PG8_STAGE(PG8_SB(0, 1), b2 + hstep, voffB); PG8_STAGE(PG8_SA(0, 0), a2, voffA);
            PG8_WAIT_V(8); PG8_WAIT_L(0); PG8_BAR; PG8_MMA(1, 0, At, B0); PG8_MMA(1, 1, At, B1); PG8_BAR; PG8_SCHED;
            PG8_LDB(B0, 1, 0); PG8_LDB(B1, 1, 1); PG8_SCHED; PG8_LDA(At, 1, 0); PG8_STAGE(PG8_SA(0, 1), a2 + hstep, voffA);
            PG8_WAIT_V(8); PG8_WAIT_L(0); PG8_BAR; PG8_MMA(0, 0, At, B0); PG8_MMA(0, 1, At, B1); PG8_BAR; PG8_SCHED;
            PG8_LDA(At, 1, 1); PG8_STAGE(PG8_SB(1, 0), b3, voffB); PG8_STAGE(PG8_SB(1, 1), b3 + hstep, voffB); PG8_STAGE(PG8_SA(1, 0), a3, voffA);
            PG8_WAIT_V(8); PG8_WAIT_L(0); PG8_BAR; PG8_MMA(1, 0, At, B0); PG8_MMA(1, 1, At, B1); PG8_BAR; PG8_SCHED;
            } else {
            PG8_LDB(B0, 0, 0); PG8_SCHED; PG8_LDA(At, 0, 0); PG8_STAGE(PG8_SA(1, 1), a1 + hstep, voffA);
            PG8_WAIT_L(8); PG8_BAR; PG8_WAIT_L(0); PG8_MMA(0, 0, At, B0); PG8_BAR; PG8_SCHED;
            PG8_LDB(B1, 0, 1); PG8_STAGE(PG8_SB(0, 0), b2, voffB);
            PG8_BAR; PG8_WAIT_L(0); PG8_MMA(0, 1, At, B1); PG8_BAR;
            PG8_LDA(At, 0, 1); PG8_STAGE(PG8_SA(0, 0), a2, voffA);
            PG8_BAR; PG8_WAIT_L(0); PG8_MMA(1, 0, At, B0); PG8_BAR; PG8_SCHED;
            PG8_STAGE(PG8_SB(0, 1), b2 + hstep, voffB);
            PG8_WAIT_V(6); PG8_BAR; PG8_MMA(1, 1, At, B1); PG8_BAR;
            PG8_LDB(B0, 1, 0); PG8_SCHED; PG8_LDA(At, 1, 0); PG8_STAGE(PG8_SA(0, 1), a2 + hstep, voffA);
            PG8_WAIT_L(8); PG8_BAR; PG8_WAIT_L(0); PG8_MMA(0, 0, At, B0); PG8_BAR; PG8_SCHED;
            PG8_LDB(B1, 1, 1); PG8_STAGE(PG8_SB(1, 0), b3, voffB);
            PG8_BAR; PG8_WAIT_L(0); PG8_MMA(0, 1, At, B1); PG8_BAR;
            PG8_LDA(At, 1, 1); PG8_STAGE(PG8_SA(1, 0), a3, voffA);
            PG8_BAR; PG8_WAIT_L(0); PG8_MMA(1, 0, At, B0); PG8_BAR; PG8_SCHED;
            PG8_STAGE(PG8_SB(1, 1), b3 + hstep, voffB);
            PG8_WAIT_V(6); PG8_BAR; PG8_MMA(1, 1, At, B1); PG8_BAR;
            }
        }
        if constexpr (ALIGN_EPI) { if (wr == 0) PG8_BAR; }
        if constexpr (!Epi::AFTER_DRAIN) { E(acc, cur, wr, wc, fr, fq); S.done(cur); }
        if (!has_next) break;
#pragma unroll
        for (int a = 0; a < 2; ++a)
#pragma unroll
            for (int b = 0; b < 2; ++b)
#pragma unroll
                for (int m = 0; m < 4; ++m)
#pragma unroll
                    for (int n = 0; n < 2; ++n) acc[a][b][m][n] = (f32x4){0.f, 0.f, 0.f, 0.f};
        cur = nxt; cA = nA; cB = nB; ++ui;
        if constexpr (ALIGN_EPI) { if (wr == 1) PG8_BAR; }
    }
    PG8_WAIT_V(0);
    if constexpr (!ALIGN_EPI) { if (wr == 0) PG8_BAR; }
    PG8_BAR;
    if constexpr (Epi::AFTER_DRAIN) { E.fused(acc, cur, wr, wc, fr, fq, lds, wid, lane); S.done(cur); }
#undef PG8_SA
#undef PG8_SB
#undef PG8_STAGE
#undef PG8_LDA
#undef PG8_LDB
#undef PG8_MMA
#undef PG8_WAIT_V
#undef PG8_WAIT_L
#undef PG8_BAR
#undef PG8_SCHED
}
}

constexpr int DM = 1024, NB = 2, SEQ = 8192, CTXL = 256, MLAT = NB * SEQ, MCTX = NB * CTXL, MROWS = MLAT + MCTX;
constexpr int NIN = 2560, NCHUNK = MROWS / 64  , NPJ = 132  ;
constexpr float EPSF = 1e-6f;
constexpr int NWAVES = 8, NTHR = 512;

constexpr size_t MiB = 1u << 20;
constexpr size_t WS_CTL = 0, CTL_ZERO_BYTES = 64 * 1024;
constexpr size_t WS_MOD = 1 * MiB;
constexpr size_t WS_SP8 = 1 * MiB + 128 * 1024;
constexpr size_t WS_GWF = 1 * MiB + 256 * 1024;
constexpr size_t WS_BT1 = 2 * MiB;
constexpr size_t WS_BT2 = 12 * MiB;
constexpr size_t WS_AGGA = 16 * MiB;
constexpr size_t WS_AGGB = 16 * MiB + 1536 * 1024;
constexpr size_t WS_SSQ = 19 * MiB;
constexpr size_t WS_SSQ1 = 21 * MiB;
constexpr size_t WS_A16 = 23 * MiB;
constexpr size_t WS_B16 = 28 * MiB;
constexpr size_t WS_H = 73 * MiB;
constexpr size_t WS_Y = 56 * MiB;
constexpr size_t WS_MIXIN = 73 * MiB;
constexpr size_t WS_U = 106 * MiB;
constexpr size_t WS_MIX = 189 * MiB;
constexpr size_t WS_END = 255 * MiB;

constexpr int LDS_BYTES = 158720;
constexpr int MISC_OFF = 157696;

#define LAS __attribute__((address_space(3)))
typedef unsigned short bf16;
typedef unsigned v4u __attribute__((ext_vector_type(4)));
typedef unsigned v2u __attribute__((ext_vector_type(2)));
typedef float f32x4 __attribute__((ext_vector_type(4)));
typedef short bf16x8 __attribute__((ext_vector_type(8)));
typedef float f32x2v __attribute__((ext_vector_type(2)));
#define LDS_WAIT() asm volatile("s_waitcnt lgkmcnt(0)" ::: "memory")

__device__ __forceinline__ unsigned f2bf(float f) { unsigned u = __builtin_bit_cast(unsigned, f); return (u + 0x7fffu + ((u >> 16) & 1u)) >> 16; }
__device__ __forceinline__ unsigned pk2(float lo, float hi) { return f2bf(lo) | (f2bf(hi) << 16); }
__device__ __forceinline__ unsigned cvtpk(float lo, float hi) { unsigned r; asm volatile("v_cvt_pk_bf16_f32 %0, %1, %2" : "=v"(r) : "v"(lo), "v"(hi)); return r; }
__device__ __forceinline__ float bflo(unsigned u) { return __builtin_bit_cast(float, u << 16); }
__device__ __forceinline__ float bfhi(unsigned u) { return __builtin_bit_cast(float, u & 0xffff0000u); }
__device__ __forceinline__ float sigmoidf_(float x) { return 1.0f / (1.0f + __expf(-x)); }
__device__ __forceinline__ float siluf_(float x) { return x * __builtin_amdgcn_rcpf(1.0f + __builtin_amdgcn_exp2f(-1.44269504f * x)); }
__device__ __forceinline__ float wave_sum(float v) {
#pragma unroll
    for (int o = 1; o < 64; o <<= 1) v += __shfl_xor(v, o);
    return v;
}

struct Args {
    const float* in[21]; float* out; unsigned char* ws; int ph_lo, ph_hi, coop, pad;
};
enum { I_X = 0, I_C, I_CTX, I_CCTX, I_WMOD, I_BMOD, I_GPRE, I_GPOST, I_WIN, I_CAW, I_CAB, I_WR, I_BR, I_WI, I_BI, I_LAM, I_DWW, I_DWB, I_LNG, I_LNB, I_WOUT };

namespace pg8 {
struct EpiU {
    static constexpr bool PERM = true, AFTER_DRAIN = false;
    bf16_t* O;
    __device__ __forceinline__ void operator()(const f32x4 (&acc)[2][2][4][2], const Unit& u, int wr, int wc, int fr, int fq) const {
        const int row0 = u.pm * BM + wr * 64 + fr;
        if (u.pn >= 4 && u.pn < 8) {
            const int col0 = 1024 + 128 * (u.pn - 4) + wc * 32 + 8 * fq;
#pragma unroll
            for (int ai = 0; ai < 2; ++ai)
#pragma unroll
                for (int m = 0; m < 4; ++m) { f32x4 v0 = acc[ai][0][m][0], v1 = acc[ai][0][m][1]; const f32x4 g0 = acc[ai][1][m][0], g1 = acc[ai][1][m][1];
#pragma unroll
                    for (int e = 0; e < 4; ++e) { v0[e] = v0[e] * __builtin_amdgcn_rcpf(1.0f + __builtin_amdgcn_exp2f(-1.44269504f * g0[e])); v1[e] = v1[e] * __builtin_amdgcn_rcpf(1.0f + __builtin_amdgcn_exp2f(-1.44269504f * g1[e])); }
                    u32x4 w; w.x = cvt_pk_bf16(v0[0], v0[1]); w.y = cvt_pk_bf16(v0[2], v0[3]); w.z = cvt_pk_bf16(v1[0], v1[1]); w.w = cvt_pk_bf16(v1[2], v1[3]);
                    *(u32x4*)(O + (size_t)(row0 + ai * HALF + m * 16) * 2560 + col0) = w; }
            return;
        }
        const int col0 = u.pn * BM + wc * 32 + 8 * fq;
        const bool act = (u.pn == 2 || u.pn == 3 || u.pn >= 8);
#pragma unroll
        for (int ai = 0; ai < 2; ++ai)
#pragma unroll
            for (int m = 0; m < 4; ++m) { bf16_t* rowp = O + (size_t)(row0 + ai * HALF + m * 16) * 2560 + col0;
#pragma unroll
                for (int bj = 0; bj < 2; ++bj) { f32x4 v0 = acc[ai][bj][m][0], v1 = acc[ai][bj][m][1];
                    if (act) {
#pragma unroll
                        for (int e = 0; e < 4; ++e) { v0[e] = v0[e] * __builtin_amdgcn_rcpf(1.0f + __builtin_amdgcn_exp2f(-1.44269504f * v0[e])); v1[e] = v1[e] * __builtin_amdgcn_rcpf(1.0f + __builtin_amdgcn_exp2f(-1.44269504f * v1[e])); }
                    }
                    u32x4 w; w.x = cvt_pk_bf16(v0[0], v0[1]); w.y = cvt_pk_bf16(v0[2], v0[3]); w.z = cvt_pk_bf16(v1[0], v1[1]); w.w = cvt_pk_bf16(v1[2], v1[3]);
                    *(u32x4*)(rowp + bj * HALF) = w; } }
    }
};
struct EpiMix {
    static constexpr bool PERM = true, AFTER_DRAIN = false;
    bf16_t* O; float* ssq;
    __device__ __forceinline__ void operator()(const f32x4 (&acc)[2][2][4][2], const Unit& u, int wr, int wc, int fr, int fq) const {
        const int col0 = u.pn * BM + wc * 32 + 8 * fq;
#pragma unroll
        for (int ai = 0; ai < 2; ++ai)
#pragma unroll
            for (int m = 0; m < 4; ++m) { const int r = u.pm * BM + ai * HALF + wr * 64 + m * 16 + fr; bf16_t* rowp = O + (size_t)r * 1024 + col0; float s = 0.f;
#pragma unroll
                for (int bj = 0; bj < 2; ++bj) { const f32x4 v0 = acc[ai][bj][m][0], v1 = acc[ai][bj][m][1];
                    s += ((v0[0] * v0[0] + v0[1] * v0[1]) + (v0[2] * v0[2] + v0[3] * v0[3])) + ((v1[0] * v1[0] + v1[1] * v1[1]) + (v1[2] * v1[2] + v1[3] * v1[3]));
                    u32x4 w; w.x = cvt_pk_bf16(v0[0], v0[1]); w.y = cvt_pk_bf16(v0[2], v0[3]); w.z = cvt_pk_bf16(v1[0], v1[1]); w.w = cvt_pk_bf16(v1[2], v1[3]);
                    *(u32x4*)(rowp + bj * HALF) = w; }
                s += __shfl_xor(s, 16); s += __shfl_xor(s, 32);
                if (fq == 0) ssq[(size_t)r * 16 + u.pn * 4 + wc] = s; }
    }
};
}

__device__ __forceinline__ void p0_transpose_item(const float* W, int K, int N, bf16* WT, LAS float* scr, int item, int lane, bool glu_remap) {
    const int nblk = N / 32, kb = item / nblk, nb = item % nblk, k0 = 64 * kb, n0 = 32 * nb;
    int nd = n0;
    if (glu_remap) { if (n0 >= 1024 && n0 < 1536) nd = 1024 + 256 * ((n0 - 1024) >> 7) + ((n0 - 1024) & 127); else if (n0 >= 1536 && n0 < 2048) nd = 1024 + 256 * ((n0 - 1536) >> 7) + 128 + ((n0 - 1536) & 127); }
#pragma unroll 8
    for (int i = 0; i < 32; ++i) { const int kk = 2 * i + (lane >> 5); scr[kk * 33 + (lane & 31)] = W[(size_t)(k0 + kk) * N + n0 + (lane & 31)]; }
    LDS_WAIT(); asm volatile("" ::: "memory");
    const int c = lane & 7;
#pragma unroll
    for (int j = 0; j < 4; ++j) { const int n = (lane >> 3) + 8 * j; const LAS float* s = scr + (8 * c) * 33 + n;
        v4u o; o.x = pk2(s[0 * 33], s[1 * 33]); o.y = pk2(s[2 * 33], s[3 * 33]); o.z = pk2(s[4 * 33], s[5 * 33]); o.w = pk2(s[6 * 33], s[7 * 33]);
        *(v4u*)(WT + (size_t)(nd + n) * K + k0 + 8 * c) = o; }
    LDS_WAIT(); asm volatile("" ::: "memory");
}

__device__ __forceinline__ void p0_prologue(const Args& a, LAS unsigned char* lds, int tid, int lane, int wave) {
    const int G = gridDim.x, bx = blockIdx.x;
    unsigned char* ws = a.ws;
    {
        LAS float* part = (LAS float*)lds;
        float* MOD = (float*)(ws + WS_MOD);
        const float* c = a.in[I_C]; const float* cctx = a.in[I_CCTX];
        for (int un = bx; un < 192; un += G) {
            const int l = un / 96, n0 = (un % 96) * 32, cq = tid & 7, ks = tid >> 3;
            const float* wm = a.in[I_WMOD] + (size_t)l * 1024 * 3072 + n0 + cq * 4;
            f32x4 acc0 = {0.f, 0.f, 0.f, 0.f}, acc1 = acc0, acc2 = acc0;
#pragma unroll 4
            for (int kk = 0; kk < 16; ++kk) { const int k = ks * 16 + kk; const f32x4 w = *(const f32x4*)(wm + (size_t)k * 3072);
                const float a0 = siluf_(c[k]), a1 = siluf_(c[1024 + k]), a2 = siluf_(cctx[k]);
                acc0 += w * a0; acc1 += w * a1; acc2 += w * a2; }
            *(LAS f32x4*)(part + (0 * 64 + ks) * 32 + cq * 4) = acc0;
            *(LAS f32x4*)(part + (1 * 64 + ks) * 32 + cq * 4) = acc1;
            *(LAS f32x4*)(part + (2 * 64 + ks) * 32 + cq * 4) = acc2;
            __syncthreads();
            if (tid < 96) { const int v = tid >> 5, col = tid & 31; float s = a.in[I_BMOD][l * 3072 + n0 + col];
                for (int k2 = 0; k2 < 64; ++k2) s += part[(v * 64 + k2) * 32 + col];
                MOD[(l * 3 + v) * 3072 + n0 + col] = s; }
            __syncthreads();
        }
    }
    { float* SP8 = (float*)(ws + WS_SP8); for (int idx = bx * NTHR + tid; idx < 2048; idx += G * NTHR) SP8[idx] = -8.0f * log1pf(__expf(-a.in[I_LAM][idx])); }
    {
        v4u* GWF = (v4u*)(ws + WS_GWF);
        for (int idx = bx * NTHR + tid; idx < 32768; idx += G * NTHR) {
            const int ln = idx & 63, kk = (idx >> 6) & 1, ct = (idx >> 7) & 3, h = (idx >> 9) & 7, g = (idx >> 12) & 1, d = (idx >> 13) & 1, l = idx >> 14;
            const float* W = (g == 0 ? a.in[I_WR] : a.in[I_WI]) + (size_t)(((l * 2 + d) * 8 + h) * 64) * 64;
            const int k0 = 32 * kk + 8 * (ln >> 4), col = 16 * ct + (ln & 15);
            float e[8];
#pragma unroll
            for (int j = 0; j < 8; ++j) e[j] = W[(k0 + j) * 64 + col];
            v4u o; o.x = pk2(e[0], e[1]); o.y = pk2(e[2], e[3]); o.z = pk2(e[4], e[5]); o.w = pk2(e[6], e[7]);
            GWF[idx] = o;
        }
    }
    {
        LAS float* scr = (LAS float*)(lds + wave * 16384);
        const int gw = bx * NWAVES + wave, NGW = G * NWAVES;
        constexpr int I_1 = (1024 / 64) * (NIN / 32), I_2 = (1024 / 64) * (1024 / 32), NITEMS = 2 * (I_1 + I_2);
        bf16* BT1 = (bf16*)(ws + WS_BT1); bf16* BT2 = (bf16*)(ws + WS_BT2);
        for (int it = gw; it < NITEMS; it += NGW) {
            int r = it;
            if (r < I_1) { p0_transpose_item(a.in[I_WIN], 1024, NIN, BT1, scr, r, lane, true); continue; } r -= I_1;
            if (r < I_1) { p0_transpose_item(a.in[I_WIN] + (size_t)1024 * NIN, 1024, NIN, BT1 + (size_t)NIN * 1024, scr, r, lane, true); continue; } r -= I_1;
            if (r < I_2) { p0_transpose_item(a.in[I_WOUT], 1024, 1024, BT2, scr, r, lane, false); continue; } r -= I_2;
            p0_transpose_item(a.in[I_WOUT] + (size_t)1024 * 1024, 1024, 1024, BT2 + (size_t)1024 * 1024, scr, r, lane, false);
        }
    }
}

__device__ __forceinline__ void norm_phase(const Args& a, int mode, int lane, int wave) {
    unsigned char* ws = a.ws;
    const float* MOD = (const float*)(ws + WS_MOD); bf16* H = (bf16*)(ws + WS_H);
    const int gw = blockIdx.x * NWAVES + wave, NGW = gridDim.x * NWAVES;
    const int nrows = (mode == 2) ? MLAT : MROWS, ln = (mode == 0) ? 0 : 1;
    for (int row = gw; row < nrows; row += NGW) {
        const int vsel = row < MLAT ? (row >> 13) : 2;
        const float* src = row < MLAT ? a.in[I_X] + (size_t)row * 1024 : a.in[I_CTX] + (size_t)(row - MLAT) * 1024;
        f32x4 v[4];
#pragma unroll
        for (int j = 0; j < 4; ++j) v[j] = *((const f32x4*)src + lane + 64 * j);
#pragma unroll 1
        for (int lu = 0; lu < mode; ++lu) {
            const bf16* MIX = (const bf16*)(ws + WS_MIX) + (size_t)lu * MROWS * 1024; const float* SSQ = (const float*)(ws + (lu ? WS_SSQ1 : WS_SSQ));
            const float sp = lane < 16 ? SSQ[(size_t)row * 16 + lane] : 0.f;
            const float rstd = rsqrtf(wave_sum(sp) * (1.0f / 1024.0f) + EPSF);
            const float* gate = MOD + (lu * 3 + vsel) * 3072 + 2048; const float* gp = a.in[I_GPOST] + lu * 1024;
#pragma unroll
            for (int j = 0; j < 4; ++j) { const v2u mq = *((const v2u*)(MIX + (size_t)row * 1024) + lane + 64 * j); const f32x4 mx = {bflo(mq.x), bfhi(mq.x), bflo(mq.y), bfhi(mq.y)};
                const f32x4 gt = *((const f32x4*)gate + lane + 64 * j), gv = *((const f32x4*)gp + lane + 64 * j);
                v[j] += gt * (mx * rstd * gv); }
        }
        if (mode == 2) {
            float* dst = a.out + (size_t)row * 1024;
#pragma unroll
            for (int j = 0; j < 4; ++j) *((f32x4*)dst + lane + 64 * j) = v[j];
        } else {
            float s = 0.f;
#pragma unroll
            for (int j = 0; j < 4; ++j) s += (v[j].x * v[j].x + v[j].y * v[j].y) + (v[j].z * v[j].z + v[j].w * v[j].w);
            const float r = rsqrtf(wave_sum(s) * (1.0f / 1024.0f) + EPSF);
            const float* shift = MOD + (ln * 3 + vsel) * 3072; const float* scale = shift + 1024; const float* gpre = a.in[I_GPRE] + ln * 1024;
            v2u* o8 = (v2u*)(H + (size_t)row * 1024);
#pragma unroll
            for (int j = 0; j < 4; ++j) { const f32x4 sh = *((const f32x4*)shift + lane + 64 * j), sc = *((const f32x4*)scale + lane + 64 * j), gv = *((const f32x4*)gpre + lane + 64 * j);
                const f32x4 hv = v[j] * r * gv * (sc + 1.0f) + sh;
                v2u w; w.x = cvtpk(hv.x, hv.y); w.y = cvtpk(hv.z, hv.w); o8[lane + 64 * j] = w; }
        }
    }
}

__device__ __forceinline__ void conv16(const LAS unsigned* vt, const f32x2v (&w2)[31], const f32x2v b2, bf16* ybase, size_t ystride) {
#pragma unroll 1
    for (int tq = 0; tq < 4; ++tq) {
        const LAS unsigned* vq = vt + tq * 4 * 128;
        f32x2v acc[4];
#pragma unroll
        for (int t = 0; t < 4; ++t) acc[t] = b2;
#pragma unroll
        for (int rr = 0; rr < 34; ++rr) { const unsigned u = vq[rr * 128]; const f32x2v x = {bflo(u), bfhi(u)};
#pragma unroll
            for (int t = 0; t < 4; ++t) { const int k = rr - t; if (k >= 0 && k < 31) acc[t] += w2[k] * x; }
            if ((rr & 7) == 7) asm volatile("" ::: "memory"); }
#pragma unroll
        for (int t = 0; t < 4; ++t) *(unsigned*)(ybase + (size_t)(tq * 4 + t) * ystride) = cvtpk(acc[t].x, acc[t].y);
    }
}
__device__ __forceinline__ v4u glu8(const v4u vq, const v4u gq) {
    v4u o;
    o.x = pk2(bflo(vq.x) * sigmoidf_(bflo(gq.x)), bfhi(vq.x) * sigmoidf_(bfhi(gq.x)));
    o.y = pk2(bflo(vq.y) * sigmoidf_(bflo(gq.y)), bfhi(vq.y) * sigmoidf_(bfhi(gq.y)));
    o.z = pk2(bflo(vq.z) * sigmoidf_(bflo(gq.z)), bfhi(vq.z) * sigmoidf_(bfhi(gq.z)));
    o.w = pk2(bflo(vq.w) * sigmoidf_(bflo(gq.w)), bfhi(vq.w) * sigmoidf_(bfhi(gq.w)));
    return o;
}
__device__ __forceinline__ void conv_unit(const Args& a, LAS unsigned char* lds, int l, int grow0, int gstride, int vlo, int vhi, int coff, int cbase, int nrows, int ncall, int orow0, int ostride, int tid) {
    const bf16* U = (const bf16*)(a.ws + WS_U); bf16* Y = (bf16*)(a.ws + WS_Y);
    LAS unsigned* VT = (LAS unsigned*)lds;
    const int nchunk = nrows * 32;
#pragma unroll 1
    for (int i0 = tid; i0 < nchunk; i0 += 3 * NTHR) {
        v4u vq[3];
#pragma unroll
        for (int it = 0; it < 3; ++it) { const int i = i0 + it * NTHR, rr = i >> 5, ch = i & 31, row = grow0 + rr * gstride; const bool ok = i < nchunk && row >= vlo && row < vhi;
            vq[it] = *(const v4u*)(U + (size_t)(ok ? row : vlo) * NIN + coff + ch * 8); }
#pragma unroll
        for (int it = 0; it < 3; ++it) { const int i = i0 + it * NTHR, rr = i >> 5, ch = i & 31, row = grow0 + rr * gstride; const bool ok = row >= vlo && row < vhi;
            if (i < nchunk) { const v4u z = {0u, 0u, 0u, 0u}; *(LAS v4u*)(VT + rr * 128 + ch * 4) = ok ? vq[it] : z; } }
    }
    __syncthreads();
    int p = tid & 127; asm volatile("" : "+v"(p));
    const int tg = tid >> 7, c0 = cbase + 2 * p;
    f32x2v w2[31];
#pragma unroll
    for (int k = 0; k < 31; ++k) w2[k] = *(const f32x2v*)(a.in[I_DWW] + (size_t)(l * 31 + k) * 512 + c0);
    const f32x2v b2 = *(const f32x2v*)(a.in[I_DWB] + l * 512 + c0);
#pragma unroll 1
    for (int hc = 0; hc < ncall; ++hc) { const int tb = (tg * ncall + hc) * 16;
        conv16(VT + tb * 128 + p, w2, b2, Y + (size_t)(orow0 + tb * ostride) * 512 + c0, (size_t)ostride * 512); }
    __syncthreads();
}
__device__ __forceinline__ void ln_rows(const Args& a, int l, int nrows, int lane, int wave, int nblk) {
    const bf16* U = (const bf16*)(a.ws + WS_U); const bf16* Y = (const bf16*)(a.ws + WS_Y); bf16* MIXIN = (bf16*)(a.ws + WS_MIXIN);
    if ((int)blockIdx.x >= nblk) return;
    const int gw = blockIdx.x * NWAVES + wave, NGW = nblk * NWAVES, c0 = lane * 8;
    float lg[8], lb[8];
#pragma unroll
    for (int e = 0; e < 8; ++e) { lg[e] = a.in[I_LNG][l * 512 + c0 + e]; lb[e] = a.in[I_LNB][l * 512 + c0 + e]; }
    for (int row = gw; row < nrows; row += NGW) {
        const v4u yq = *(const v4u*)(Y + (size_t)row * 512 + c0); const v4u gq = *(const v4u*)(U + (size_t)row * NIN + 2048 + c0);
        float y[8] = {bflo(yq.x), bfhi(yq.x), bflo(yq.y), bfhi(yq.y), bflo(yq.z), bfhi(yq.z), bflo(yq.w), bfhi(yq.w)};
        const float gt[8] = {bflo(gq.x), bfhi(gq.x), bflo(gq.y), bfhi(gq.y), bflo(gq.z), bfhi(gq.z), bflo(gq.w), bfhi(gq.w)};
        float s = 0.f;
#pragma unroll
        for (int e = 0; e < 8; ++e) s += y[e];
        const float mean = wave_sum(s) * (1.0f / 512.0f); float q = 0.f;
#pragma unroll
        for (int e = 0; e < 8; ++e) { y[e] -= mean; q += y[e] * y[e]; }
        const float rstd = rsqrtf(wave_sum(q) * (1.0f / 512.0f) + EPSF);
        float o[8];
#pragma unroll
        for (int e = 0; e < 8; ++e) o[e] = siluf_(y[e] * rstd * lg[e] + lb[e]) * gt[e];
        v4u w; w.x = pk2(o[0], o[1]); w.y = pk2(o[2], o[3]); w.z = pk2(o[4], o[5]); w.w = pk2(o[6], o[7]);
        *(v4u*)(MIXIN + (size_t)row * 1024 + 512 + c0) = w;
    }
}

constexpr int RG_GW = 0, RG_FOLD = 32768, RG_F8 = 36864, RG_CAR = 40960, RG_WAVE = 57344, RG_WAVE_BYTES = 12544;
constexpr int NP16 = 4 * NPJ;
__device__ __forceinline__ float fsig(float x) { return __builtin_amdgcn_rcpf(1.0f + __expf(-x)); }

template <bool FINAL, bool FASTP>
__device__ __forceinline__ void rg_sweep(const Args& a, LAS unsigned char* lds, LAS unsigned char* wl, int l, int b, int h, int r0, int seg_lo, int seg_hi, int pj, bool is_ctx, int w, int lane, const int D) {
    const bf16* U = (const bf16*)(a.ws + WS_U); bf16* MIXIN = (bf16*)(a.ws + WS_MIXIN);
    float* AGGA = (float*)(a.ws + WS_AGGA); float* AGGB = (float*)(a.ws + WS_AGGB); float* A16 = (float*)(a.ws + WS_A16); float* B16 = (float*)(a.ws + WS_B16);
    LAS float* VCW = (LAS float*)wl; LAS unsigned* HBW = (LAS unsigned*)(wl + 4352);
    const LAS v4u* GWL = (const LAS v4u*)(lds + RG_GW) + (D * 2) * 8 * 64 + lane;
    const LAS float* CAR = (const LAS float*)(lds + RG_CAR);
    const int fr = lane & 15, fq = lane >> 4, cp = lane & 31, rh = lane >> 5;
    const int rbase = D ? r0 + 63 : r0, rsign = D ? -1 : 1;
    float2 cw[4];
#pragma unroll
    for (int k = 0; k < 4; ++k) cw[k] = *(const float2*)(a.in[I_CAW] + (size_t)((l * 2 + D) * 4 + (D ? 3 - k : k)) * 512 + 64 * h + 2 * cp);
    const float2 cbv = *(const float2*)(a.in[I_CAB] + (l * 2 + D) * 512 + 64 * h + 2 * cp);
    float brv[4], biv[4], sp8[4], Hc[4], Ac[4];
    const int p16own = 4 * pj + fq;
#pragma unroll
    for (int ct = 0; ct < 4; ++ct) { const int c = 16 * ct + fr, pidx = (l * 2 + D) * 512 + 64 * h + c;
        brv[ct] = a.in[I_BR][pidx]; biv[ct] = a.in[I_BI][pidx]; sp8[ct] = ((const float*)(a.ws + WS_SP8))[pidx];
        Hc[ct] = 0.f; Ac[ct] = 1.f;
        if (FINAL) {
            if (is_ctx) { const size_t base = (size_t)((b * 2 + D) * NP16) * 512 + 64 * h + c; float S = 0.f;
                for (int i = 0; i < p16own; ++i) S = A16[base + (size_t)i * 512] * S + B16[base + (size_t)i * 512];
                Hc[ct] = S; }
            else Hc[ct] = CAR[(D * 32 + 4 * (D ? 7 - w : w) + fq) * 64 + c];
        } }
    const bf16* ub = U + 64 * h + 2 * cp;
    unsigned Wd[2][7], nx[2][4];
#pragma unroll
    for (int q = 0; q < 2; ++q) { const int g = 2 * rh + q;
#pragma unroll
        for (int j = 0; j < 3; ++j) { const int row = rbase + rsign * (16 * g - 3 + j); const bool ok = row >= seg_lo && row < seg_hi; const int rc = ok ? row : r0;
            const unsigned v = *(const unsigned*)(ub + (size_t)rc * NIN); Wd[q][4 + j] = ok ? v : 0u; }
#pragma unroll
        for (int j = 0; j < 4; ++j) nx[q][j] = *(const unsigned*)(ub + (size_t)(rbase + rsign * (16 * g + j)) * NIN); }
#pragma unroll 1
    for (int ti = 0; ti < 4; ++ti) {
        const int tile = ti;
        int zo = 0; asm volatile("" : "+v"(zo));
        const LAS v4u* GWLt = GWL + zo;
        v4u g0 = {0u, 0u, 0u, 0u}, g1 = g0; size_t orow = 0;
        if (FINAL && D == 0) { orow = (size_t)(r0 + 16 * (fr >> 2) + 4 * tile + (fr & 3)); const bf16* gp = U + orow * NIN + 512 + 64 * h + 16 * fq; g0 = *(const v4u*)gp; g1 = *(const v4u*)(gp + 8); }
#pragma unroll
        for (int q = 0; q < 2; ++q) {
            Wd[q][0] = Wd[q][4]; Wd[q][1] = Wd[q][5]; Wd[q][2] = Wd[q][6]; Wd[q][3] = nx[q][0]; Wd[q][4] = nx[q][1]; Wd[q][5] = nx[q][2]; Wd[q][6] = nx[q][3]; }
        if (ti < 3) { const int tn = ti + 1;
#pragma unroll
            for (int q = 0; q < 2; ++q)
#pragma unroll
                for (int j = 0; j < 4; ++j) nx[q][j] = *(const unsigned*)(ub + (size_t)(rbase + rsign * (16 * (2 * rh + q) + 4 * tn + j)) * NIN); }
#pragma unroll
        for (int q = 0; q < 2; ++q)
#pragma unroll
            for (int jj = 0; jj < 4; ++jj) { float v0 = cbv.x, v1 = cbv.y;
#pragma unroll
                for (int k = 0; k < 4; ++k) { const unsigned u = Wd[q][jj + k]; v0 += cw[k].x * bflo(u); v1 += cw[k].y * bfhi(u); }
                *(LAS f32x2v*)(VCW + (4 * (2 * rh + q) + jj) * 68 + 2 * cp) = (f32x2v){v0, v1}; }
        bf16x8 af[2];
#pragma unroll
        for (int kk = 0; kk < 2; ++kk) { const LAS float* vp = VCW + fr * 68 + 32 * kk + 8 * fq; const f32x4 x0 = *(const LAS f32x4*)vp, x1 = *(const LAS f32x4*)(vp + 4);
            v4u pk; pk.x = cvtpk(x0.x, x0.y); pk.y = cvtpk(x0.z, x0.w); pk.z = cvtpk(x1.x, x1.y); pk.w = cvtpk(x1.z, x1.w); af[kk] = __builtin_bit_cast(bf16x8, pk); }
        float vcv[4][4];
#pragma unroll
        for (int ct = 0; ct < 4; ++ct)
#pragma unroll
            for (int jj = 0; jj < 4; ++jj) vcv[ct][jj] = VCW[(4 * fq + jj) * 68 + 16 * ct + fr];
        f32x4 accr[4], acci[4];
#pragma unroll
        for (int ct = 0; ct < 4; ++ct) { accr[ct] = (f32x4){0.f, 0.f, 0.f, 0.f}; acci[ct] = accr[ct];
#pragma unroll
            for (int kk = 0; kk < 2; ++kk) { const bf16x8 br = __builtin_bit_cast(bf16x8, GWLt[(ct * 2 + kk) * 64]), bi = __builtin_bit_cast(bf16x8, GWLt[(8 + ct * 2 + kk) * 64]);
                accr[ct] = __builtin_amdgcn_mfma_f32_16x16x32_bf16(af[kk], br, accr[ct], 0, 0, 0); acci[ct] = __builtin_amdgcn_mfma_f32_16x16x32_bf16(af[kk], bi, acci[ct], 0, 0, 0); } }
        float hsum[4][4];
#pragma unroll
        for (int ct = 0; ct < 4; ++ct) { float aa[4], bb[4];
            const float nbr = -1.44269504f * brv[ct], nbi = -1.44269504f * biv[ct];
#pragma unroll
            for (int p = 0; p < 2; ++p) {
                f32x2v xr = (f32x2v){accr[ct][2 * p], accr[ct][2 * p + 1]} * -1.44269504f + nbr, xi = (f32x2v){acci[ct][2 * p], acci[ct][2 * p + 1]} * -1.44269504f + nbi;
                xr = __builtin_elementwise_min(xr, (f32x2v){60.f, 60.f}); xi = __builtin_elementwise_min(xi, (f32x2v){60.f, 60.f});
                f32x2v d1, d2; d1.x = __builtin_amdgcn_exp2f(xr.x); d1.y = __builtin_amdgcn_exp2f(xr.y); d2.x = __builtin_amdgcn_exp2f(xi.x); d2.y = __builtin_amdgcn_exp2f(xi.y);
                d1 = d1 + 1.0f; d2 = d2 + 1.0f; const f32x2v m = d1 * d2; f32x2v inv; inv.x = __builtin_amdgcn_rcpf(m.x); inv.y = __builtin_amdgcn_rcpf(m.y);
                const f32x2v r = d2 * inv, ig = d1 * inv, la = r * sp8[ct], x2 = la + la, le = la * 1.44269504f;
                const f32x2v pom = -x2 * (x2 * (x2 * (x2 * (x2 * 0.0083333338f + 0.041666668f) + 0.16666667f) + 0.5f) + 1.0f);
                f32x2v av, om;
                if (FASTP) { av = la * (la * (la * (la * (la * 0.0083333338f + 0.041666668f) + 0.16666667f) + 0.5f) + 1.0f) + 1.0f; om = pom; }
                else { av.x = __builtin_amdgcn_exp2f(le.x); av.y = __builtin_amdgcn_exp2f(le.y);
                    const f32x2v o2 = 1.0f - av * av; om.x = x2.x > -0.25f ? pom.x : o2.x; om.y = x2.y > -0.25f ? pom.y : o2.y;
                    om = __builtin_elementwise_max(om, (f32x2v){0.f, 0.f}); }
                f32x2v sq; sq.x = __builtin_amdgcn_sqrtf(om.x); sq.y = __builtin_amdgcn_sqrtf(om.y);
                const f32x2v bv = sq * (ig * (f32x2v){vcv[ct][2 * p], vcv[ct][2 * p + 1]});
                aa[2 * p] = av.x; aa[2 * p + 1] = av.y; bb[2 * p] = bv.x; bb[2 * p + 1] = bv.y; }
            float hh = Hc[ct], A4 = 1.f;
#pragma unroll
            for (int jj = 0; jj < 4; ++jj) { hh = aa[jj] * hh + bb[jj]; A4 *= aa[jj]; hsum[ct][jj] = hh; }
            Hc[ct] = hh; if (!FINAL) Ac[ct] *= A4; }
        if (FINAL) {
            if (D == 1) {
#pragma unroll
                for (int ct = 0; ct < 4; ++ct)
#pragma unroll
                    for (int jp = 0; jp < 2; ++jp) HBW[(tile * 8 + ct * 2 + jp) * 64 + lane] = cvtpk(hsum[ct][2 * jp], hsum[ct][2 * jp + 1]);
            } else {
#pragma unroll
                for (int ct = 0; ct < 4; ++ct)
#pragma unroll
                    for (int jp = 0; jp < 2; ++jp) {
                        const unsigned hb = HBW[((3 - tile) * 8 + ct * 2 + (1 - jp)) * 64 + fr + 16 * (3 - fq)];
                        VCW[(4 * fq + 2 * jp) * 68 + 16 * ct + fr] = hsum[ct][2 * jp] + bfhi(hb); VCW[(4 * fq + 2 * jp + 1) * 68 + 16 * ct + fr] = hsum[ct][2 * jp + 1] + bflo(hb); }
                const size_t row = orow;
                const f32x4 s0 = *(const LAS f32x4*)(VCW + fr * 68 + 16 * fq), s1 = *(const LAS f32x4*)(VCW + fr * 68 + 16 * fq + 4), s2 = *(const LAS f32x4*)(VCW + fr * 68 + 16 * fq + 8), s3 = *(const LAS f32x4*)(VCW + fr * 68 + 16 * fq + 12);
                v4u o0, o1;
                o0.x = cvtpk(s0.x * bflo(g0.x), s0.y * bfhi(g0.x)); o0.y = cvtpk(s0.z * bflo(g0.y), s0.w * bfhi(g0.y)); o0.z = cvtpk(s1.x * bflo(g0.z), s1.y * bfhi(g0.z)); o0.w = cvtpk(s1.z * bflo(g0.w), s1.w * bfhi(g0.w));
                o1.x = cvtpk(s2.x * bflo(g1.x), s2.y * bfhi(g1.x)); o1.y = cvtpk(s2.z * bflo(g1.y), s2.w * bfhi(g1.y)); o1.z = cvtpk(s3.x * bflo(g1.z), s3.y * bfhi(g1.z)); o1.w = cvtpk(s3.z * bflo(g1.w), s3.w * bfhi(g1.w));
                bf16* op = MIXIN + row * 1024 + 64 * h + 16 * fq; *(v4u*)op = o0; *(v4u*)(op + 8) = o1;
            }
        }
    }
    if (!FINAL) {
#pragma unroll
        for (int ct = 0; ct < 4; ++ct) { const int c = 16 * ct + fr;
            const size_t i16 = (size_t)((b * 2 + D) * NP16 + p16own) * 512 + 64 * h + c; A16[i16] = Ac[ct]; B16[i16] = Hc[ct];
            float Ag[4], Bg[4];
#pragma unroll
            for (int g = 0; g < 4; ++g) { Ag[g] = __shfl(Ac[ct], fr + 16 * g); Bg[g] = __shfl(Hc[ct], fr + 16 * g); }
            float run = 0.f;
#pragma unroll
            for (int g = 0; g < 4; ++g) run = Ag[g] * run + Bg[g];
            if (fq == 0) { const size_t idx = (size_t)((b * 2 + D) * NPJ + pj) * 512 + 64 * h + c; AGGA[idx] = (Ag[0] * Ag[1]) * (Ag[2] * Ag[3]); AGGB[idx] = run; } }
    }
}

template <bool FINAL>
__device__ __forceinline__ void rg_run(const Args& a, LAS unsigned char* lds, int l, int rn, int tid, int lane, int wave) {
    const bool is_ctx = rn >= 256; const int bh = is_ctx ? rn - 256 : rn >> 4, b = bh >> 3, h = bh & 7, cgp = is_ctx ? 0 : (rn & 15);
    { const v4u* GWF = (const v4u*)(a.ws + WS_GWF); LAS v4u* GWL = (LAS v4u*)(lds + RG_GW);
#pragma unroll
      for (int i = tid; i < 2048; i += NTHR) { const int d = i >> 10, g = (i >> 9) & 1, rest = i & 511; GWL[i] = GWF[(size_t)((((l * 2 + d) * 2 + g) * 8 + h) * 8) * 64 + rest]; } }
    const int P0f = 4 + 8 * cgp, P0b = 124 - 8 * cgp;
    if (FINAL && !is_ctx) {
        const float* AGGA = (const float*)(a.ws + WS_AGGA); const float* AGGB = (const float*)(a.ws + WS_AGGB); const float* A16 = (const float*)(a.ws + WS_A16); const float* B16 = (const float*)(a.ws + WS_B16);
        const int d = tid >> 8, s = (tid >> 6) & 3, c = tid & 63, P0 = d ? P0b : P0f, lo = (P0 * s) >> 2, hi = (P0 * (s + 1)) >> 2;
        const size_t b16 = (size_t)((b * 2 + d) * NP16 + 4 * P0 + 8 * s) * 512 + 64 * h + c; float ai8[8], bi8[8];
#pragma unroll
        for (int i = 0; i < 8; ++i) { ai8[i] = A16[b16 + (size_t)i * 512]; bi8[i] = B16[b16 + (size_t)i * 512]; }
        const size_t base = (size_t)((b * 2 + d) * NPJ) * 512 + 64 * h + c; float A = 1.f, Bv = 0.f;
#pragma unroll 8
        for (int i = lo; i < hi; ++i) { const float ai = AGGA[base + (size_t)i * 512], bi = AGGB[base + (size_t)i * 512]; Bv = ai * Bv + bi; A *= ai; }
        LAS float* FO = (LAS float*)(lds + RG_FOLD); LAS float* F8 = (LAS float*)(lds + RG_F8); LAS float* CAR = (LAS float*)(lds + RG_CAR);
        FO[((d * 4 + s) * 64 + c) * 2] = A; FO[((d * 4 + s) * 64 + c) * 2 + 1] = Bv;
        float A8 = 1.f, B8 = 0.f;
#pragma unroll
        for (int i = 0; i < 8; ++i) { B8 = ai8[i] * B8 + bi8[i]; A8 *= ai8[i]; }
        F8[((d * 4 + s) * 64 + c) * 2] = A8; F8[((d * 4 + s) * 64 + c) * 2 + 1] = B8;
        __syncthreads();
        float S = 0.f;
#pragma unroll
        for (int s2 = 0; s2 < 4; ++s2) S = FO[((d * 4 + s2) * 64 + c) * 2] * S + FO[((d * 4 + s2) * 64 + c) * 2 + 1];
#pragma unroll
        for (int s2 = 0; s2 < 3; ++s2) if (s2 < s) S = F8[((d * 4 + s2) * 64 + c) * 2] * S + F8[((d * 4 + s2) * 64 + c) * 2 + 1];
#pragma unroll
        for (int i = 0; i < 8; ++i) { CAR[(d * 32 + 8 * s + i) * 64 + c] = S; S = ai8[i] * S + bi8[i]; }
    }
    __syncthreads();
    if (wave < (is_ctx ? 4 : 8)) {
        const int j = is_ctx ? wave : 8 * cgp + wave;
        const int seg_lo = is_ctx ? MLAT + b * CTXL : b * SEQ, seg_hi = seg_lo + (is_ctx ? CTXL : SEQ), r0 = seg_lo + 64 * j;
        const int pjf = is_ctx ? j : 4 + j, pjb = is_ctx ? 3 - j : 131 - j;
        LAS unsigned char* wl = lds + RG_WAVE + wave * RG_WAVE_BYTES;
        const float* SP8 = (const float*)(a.ws + WS_SP8);
        const bool fast1 = !__any(SP8[(l * 2 + 1) * 512 + 64 * h + lane] < -0.25f), fast0 = !__any(SP8[(l * 2 + 0) * 512 + 64 * h + lane] < -0.25f);
#pragma unroll 1
        for (int it = 0; it < 2; ++it) { const int D = 1 - it, pj = D ? pjb : pjf; const bool fast = D ? fast1 : fast0;
            if (fast) rg_sweep<FINAL, true>(a, lds, wl, l, b, h, r0, seg_lo, seg_hi, pj, is_ctx, wave, lane, D); else rg_sweep<FINAL, false>(a, lds, wl, l, b, h, r0, seg_lo, seg_hi, pj, is_ctx, wave, lane, D); }
    }
    __syncthreads();
}

#define RLX_AGENT __ATOMIC_RELAXED, __HIP_MEMORY_SCOPE_AGENT


#define XB_TMO      128
#define XB_XCNT(j)  (256  + 64 * (j))
#define XB_XSUB(j)  (1280 + 64 * (j))
#define XB_XGEN(j)  (2304 + 64 * (j))
#define XB_TOP      3328
#define XB_TOPGEN   3392
#define XCD_BAR_WORDS 3456
#define XB_SPIN_CAP (1u << 18)

__device__ __forceinline__ unsigned xb_ld(unsigned* p)              { return __hip_atomic_load(p, __ATOMIC_RELAXED, __HIP_MEMORY_SCOPE_AGENT); }
__device__ __forceinline__ unsigned xb_add(unsigned* p, unsigned v) { return __hip_atomic_fetch_add(p, v, __ATOMIC_RELAXED, __HIP_MEMORY_SCOPE_AGENT); }
__device__ __forceinline__ unsigned xb_xcc_id() { return (unsigned)__builtin_amdgcn_s_getreg((3 << 11) | 20) & 0xFu; }
#define XB_SPIN(cond, bar) do { unsigned _sp = 0; while (cond) { __builtin_amdgcn_s_sleep(1); \
    if ((++_sp & 255u) == 0u) { if (xb_ld(&(bar)[XB_TMO])) break; if (_sp > XB_SPIN_CAP) { atomicAdd(&(bar)[XB_TMO], 1u); break; } } } } while (0)

struct XcdBarrier {
    unsigned* bar; unsigned x;
    volatile LAS unsigned* st;
};

__device__ __forceinline__ XcdBarrier xcd_barrier_post(unsigned* bar, volatile LAS unsigned* st) {
    XcdBarrier b; b.bar = bar; b.x = xb_xcc_id(); b.st = st;
    if (threadIdx.x == 0) (void)xb_add(&bar[XB_XCNT(b.x)], 1u);
    return b;
}
__device__ __forceinline__ void xcd_barrier_complete(unsigned* bar, unsigned x, unsigned& nloc, unsigned& nx) {
    const unsigned G = gridDim.x * gridDim.y * gridDim.z;
    unsigned sum, cnt, mine, sp = 0u;
    for (;;) {
        sum = 0u; cnt = 0u; mine = 0u;
#pragma unroll
        for (unsigned j = 0; j < 16; ++j) { const unsigned c = xb_ld(&bar[XB_XCNT(j)]); sum += c; cnt += (c > 0u) ? 1u : 0u; mine = (j == x) ? c : mine; }
        if (sum == G) break;
        __builtin_amdgcn_s_sleep(1);
        if ((++sp & 255u) == 0u) { if (xb_ld(&bar[XB_TMO])) break; if (sp > XB_SPIN_CAP) { atomicAdd(&bar[XB_TMO], 1u); break; } }
    }
    nloc = mine > 0u ? mine : 1u; nx = cnt > 0u ? cnt : 1u;
}

__device__ __forceinline__ void xcd_barrier(const XcdBarrier& b) {
    asm volatile("s_waitcnt vmcnt(0)" ::: "memory");
    __syncthreads();
    if (threadIdx.x == 0) {
        unsigned* bar = b.bar;
        __builtin_amdgcn_s_waitcnt(0);
        unsigned nloc = b.st[0], nx = b.st[1];
        if (nloc == 0u) { xcd_barrier_complete(bar, b.x, nloc, nx); b.st[0] = nloc; b.st[1] = nx; }
        const unsigned old = xb_add(&bar[XB_XSUB(b.x)], 1u);
        const unsigned gen = old / nloc;
        if (old + 1u == (gen + 1u) * nloc) {
            __builtin_amdgcn_fence(__ATOMIC_RELEASE, "agent");
            asm volatile("s_waitcnt vmcnt(0)" ::: "memory");
            const unsigned og = xb_add(&bar[XB_TOP], 1u);
            const unsigned tg = og / nx;
            if (og + 1u == (tg + 1u) * nx) xb_add(&bar[XB_TOPGEN], 1u);
            else XB_SPIN(xb_ld(&bar[XB_TOPGEN]) == tg, bar);
            __builtin_amdgcn_fence(__ATOMIC_ACQUIRE, "agent");
            xb_add(&bar[XB_XGEN(b.x)], 1u);
            asm volatile("s_waitcnt vmcnt(0)" ::: "memory");
        } else {
            XB_SPIN(xb_ld(&bar[XB_XGEN(b.x)]) == gen, bar);
            __builtin_amdgcn_fence(__ATOMIC_ACQUIRE, "agent");
            asm volatile("s_waitcnt vmcnt(0)" ::: "memory");
        }
    }
    __syncthreads();
}

__device__ __forceinline__ void layer_phases(int l, const Args& args, LAS unsigned char* lds, const int tid0, const int lo, const int hi, const XcdBarrier& xbar) {
    const int G = gridDim.x; unsigned char* ws = args.ws;
    const int pb = 1 + 5 * l;
#define LAUNDER() int tid = tid0; asm volatile("" : "+v"(tid)); const int lane = tid & 63, wave = __builtin_amdgcn_readfirstlane(tid >> 6); int bx = blockIdx.x; asm volatile("" : "+s"(bx)); (void)lane; (void)wave; (void)bx
#define IN(k) (lo <= (k) && (k) < hi)
#define SEAM(k) do { if (IN(k) && IN((k) + 1)) { xcd_barrier(xbar); } } while (0)
        if (IN(pb)) { LAUNDER(); norm_phase(args, l, lane, wave); }
        SEAM(pb);
        if (IN(pb + 1)) { LAUNDER();
            pg8::Gemm g{(const pg8::bf16_t*)(ws + WS_H), (const pg8::bf16_t*)(ws + WS_BT1) + (size_t)l * NIN * 1024, MROWS, NIN, 1024};
            pg8::StaticOrder S; S.init(MROWS, NIN, G, bx);
            pg8::EpiU E{(pg8::bf16_t*)(ws + WS_U)};
            pg8::gemm_phase<pg8::EpiU, pg8::StaticOrder, true, true>(lds, g, S, E);
        }
        SEAM(pb + 1);
        if (IN(pb + 2)) { LAUNDER();
            const int nrun = (bx >= G - 16) ? 2 : 1;
#pragma unroll 1
            for (int k = 0; k < nrun; ++k) rg_run<false>(args, lds, l, k == 0 ? bx : 256 + (G - 1 - bx), tid, lane, wave);
            const int n_h = 256 + (l == 0 ? 16 : 0), n_conv = 128 + n_h;
            const int GC = G - 16;
            for (int un = bx; un < n_conv && bx < GC; un += GC) {
                int grow0, gstride, vlo, vhi, coff, cbase, nrows, ncall, orow0, ostride;
                if (un < 128) { const int bb = un >> 6, w = un & 63; vlo = bb * SEQ + w; vhi = vlo + SEQ; grow0 = vlo - 15 * 64; gstride = 64; coff = 1024 + 256; cbase = 256; nrows = 158; ncall = 2; orow0 = vlo; ostride = 64; }
                else { const int hu = un - 128; int r0, g;
                    if (hu < 256) { r0 = hu * 64; g = 0; vlo = r0; vhi = r0 + 64; }
                    else { const int cu = hu - 256, cc = cu >> 1, bb = cc >> 2; g = cu & 1; r0 = MLAT + cc * 64; vlo = MLAT + bb * CTXL; vhi = vlo + CTXL; }
                    grow0 = r0 - 15; gstride = 1; coff = 1024 + g * 256; cbase = g * 256; nrows = 94; ncall = 1; orow0 = r0; ostride = 1; }
                conv_unit(args, lds, l, grow0, gstride, vlo, vhi, coff, cbase, nrows, ncall, orow0, ostride, tid);
            }
        }
        SEAM(pb + 2);
        if (IN(pb + 3)) { LAUNDER();
            const int nrun = (l == 0 && bx >= G - 16) ? 2 : 1;
#pragma unroll 1
            for (int k = 0; k < nrun; ++k) rg_run<true>(args, lds, l, k == 0 ? bx : 256 + (G - 1 - bx), tid, lane, wave);
            ln_rows(args, l, (l == 0) ? MROWS : MLAT, lane, wave, (l == 0) ? G - 16 : G);
        }
        SEAM(pb + 3);
        if (IN(pb + 4)) { LAUNDER();
            const int M2 = (l == 0) ? MROWS : MLAT;
            pg8::Gemm g{(const pg8::bf16_t*)(ws + WS_MIXIN), (const pg8::bf16_t*)(ws + WS_BT2) + (size_t)l * 1024 * 1024, M2, 1024, 1024};
            pg8::StaticOrder S; S.init(M2, 1024, G, bx);
            pg8::EpiMix E{(pg8::bf16_t*)(ws + WS_MIX) + (size_t)l * MROWS * 1024, (float*)(ws + (l ? WS_SSQ1 : WS_SSQ))};
            pg8::gemm_phase<pg8::EpiMix, pg8::StaticOrder, true, true>(lds, g, S, E);
        }
        SEAM(pb + 4);
#undef IN
#undef SEAM
#undef LAUNDER
}

__global__ void __launch_bounds__(NTHR, 2) fwd_megakernel(Args args) {
    extern __shared__ __attribute__((aligned(16))) unsigned char lds_raw[];
    LAS unsigned char* lds = (LAS unsigned char*)lds_raw;
    const int tid = threadIdx.x, lane = tid & 63, wave = __builtin_amdgcn_readfirstlane(tid >> 6);
    const int G = gridDim.x, bx = blockIdx.x;
    unsigned char* ws = args.ws;
    const int lo = args.ph_lo, hi = args.ph_hi;
    if (args.coop == 2) cg::this_grid().sync();
    volatile LAS unsigned* MISC = (volatile LAS unsigned*)(lds + MISC_OFF);
    if (tid < 64) MISC[tid] = 0u;
    __syncthreads();
    XcdBarrier xbar; xbar.bar = (unsigned*)(ws + WS_CTL); xbar.x = 0; xbar.st = nullptr;
    if (args.coop == 1) xbar = xcd_barrier_post((unsigned*)(ws + WS_CTL), MISC + 8);
#define IN(k) (lo <= (k) && (k) < hi)
#define SEAM(k) do { if (IN(k) && IN((k) + 1)) { xcd_barrier(xbar); } } while (0)

    if (IN(0)) { p0_prologue(args, lds, tid, lane, wave); }
    SEAM(0);
#pragma unroll 1
    for (int l = 0; l < 2; ++l) { int lo_ = l; asm volatile("" : "+s"(lo_)); layer_phases(lo_, args, lds, tid, lo, hi, xbar); }
    if (IN(11)) { norm_phase(args, 2, lane, wave); }
#undef IN
#undef SEAM
}

#ifndef MK_PER_PHASE
#define MK_PER_PHASE 0
#endif
extern "C" void kernel_launch(void* const* d_in, const int* in_sizes, int n_in, void* d_out, int out_size, void* d_ws, size_t ws_size, hipStream_t stream) {
    static int grid = 0;
    if (grid == 0) {
        if (n_in != 21 || out_size != MLAT * DM || ws_size < WS_END) { fprintf(stderr, "kernel_launch: unexpected shapes (n_in %d, out %d, ws %zu)\n", n_in, out_size, ws_size); grid = -1; return; }
        int dev = 0, cus = 0, per_cu = 0;
        if (hipGetDevice(&dev) != hipSuccess || hipDeviceGetAttribute(&cus, hipDeviceAttributeMultiprocessorCount, dev) != hipSuccess) { grid = -1; return; }
        if (hipFuncSetAttribute((const void*)fwd_megakernel, hipFuncAttributeMaxDynamicSharedMemorySize, LDS_BYTES) != hipSuccess) { fprintf(stderr, "kernel_launch: hipFuncSetAttribute failed\n"); grid = -1; return; }
        if (hipOccupancyMaxActiveBlocksPerMultiprocessor(&per_cu, (const void*)fwd_megakernel, NTHR, LDS_BYTES) != hipSuccess || per_cu < 1) { fprintf(stderr, "kernel_launch: occupancy query says %d\n", per_cu); per_cu = 1; }
        (void)hipGetLastError();
        grid = cus;
    }
    if (grid < 0) return;
    if (hipMemsetAsync((char*)d_ws + WS_CTL, 0, CTL_ZERO_BYTES, stream) != hipSuccess) { fprintf(stderr, "kernel_launch: memset failed\n"); return; }
    Args a{};
    for (int i = 0; i < 21; ++i) a.in[i] = (const float*)d_in[i];
    a.out = (float*)d_out; a.ws = (unsigned char*)d_ws;
#if MK_PER_PHASE
    for (int ph = 0; ph < 12; ++ph) { a.ph_lo = ph; a.ph_hi = ph + 1; a.coop = 0;
        hipLaunchKernelGGL(fwd_megakernel, dim3(grid), dim3(NTHR), LDS_BYTES, stream, a); }
#else
    a.ph_lo = 0; a.ph_hi = 12; a.coop = 1;
    void* kargs[] = {&a};
    hipError_t e = hipLaunchCooperativeKernel((const void*)fwd_megakernel, dim3(grid), dim3(NTHR), kargs, LDS_BYTES, stream);
    if (e != hipSuccess) fprintf(stderr, "cooperative launch failed: %s (grid %d)\n", hipGetErrorString(e), grid);
#endif
}
```

```cpp
#include <hip/hip_runtime.h>
#include <hip/hip_cooperative_groups.h>
#include <cstdio>
#include <cstdint>
namespace cg = cooperative_groups;
#define MK_PER_PHASE 0
namespace pg8 {
#define PG8_LAS __attribute__((address_space(3)))
typedef unsigned short bf16_t;
typedef short bf16x8 __attribute__((ext_vector_type(8)));
typedef float f32x4 __attribute__((ext_vector_type(4)));
typedef unsigned u32x4 __attribute__((ext_vector_type(4)));
constexpr int BM = 256, BK = 64, HALF = 128, HTB = HALF * BK * 2  , STAGE_BYTES = 8 * HTB, NXCD = 8, WGM = 8;

__host__ __device__ __forceinline__ int lds_byte(int r, int c) { const int st = (r >> 4) * 2 + (c >> 5), rr = r & 15, cc = c & 31, ob = rr * 64 + cc * 2; return st * 1024 + (ob ^ (((ob >> 9) & 1) << 5)); }
__host__ __device__ __forceinline__ void stage_rc(int b, int& R, int& C) { const int st = b / 1024, sb = b % 1024, swz = sb ^ (((sb >> 9) & 1) << 5); R = (st >> 1) * 16 + swz / 64; C = (st & 1) * 32 + (swz % 64) / 2; }
__host__ __device__ __forceinline__ int perm32(int rho) { const int n = rho >> 4, i = rho & 15; return 8 * (i >> 2) + 4 * n + (i & 3); }

struct Unit { int pm, pn; };
struct Gemm { const bf16_t* A; const bf16_t* Bt; int M, N, K; };

struct StaticOrder {
    int nM, nN, nwg, G, c;
    __host__ __device__ void init(int M, int N, int G_, int c_) { nM = M / BM; nN = N / BM; nwg = nM * nN; G = G_; c = c_; }
    __host__ __device__ bool next(int i, Unit& u) const {
        const long L = (long)i * G + c; if (L >= nwg) return false;
        int wgid = (int)L; { const int q = nwg / NXCD, r = nwg % NXCD, xcd = wgid % NXCD, off = wgid / NXCD; wgid = (xcd < r ? xcd * (q + 1) : r * (q + 1) + (xcd - r) * q) + off; }
        const int nig = WGM * nN, gid = wgid / nig, fm = gid * WGM, gsz = (nM - fm) < WGM ? (nM - fm) : WGM;
        u.pm = fm + ((wgid % nig) % gsz); u.pn = (wgid % nig) / gsz; return true;
    }
    __device__ __forceinline__ void a_ready(const Unit&) const {}
    __device__ __forceinline__ void done(const Unit&) const {}
};
__device__ __forceinline__ unsigned cvt_pk_bf16(float lo, float hi) { unsigned r; asm volatile("v_cvt_pk_bf16_f32 %0, %1, %2" : "=v"(r) : "v"(lo), "v"(hi)); return r; }
typedef float f32x2 __attribute__((ext_vector_type(2)));
template <class Epi, class Sched, bool ALIGN_EPI = false, bool SP2 = false>
__device__ __forceinline__ void gemm_phase(PG8_LAS unsigned char* lds, const Gemm g, const Sched& S, const Epi& E) {
    const int tid = threadIdx.x, wid = __builtin_amdgcn_readfirstlane(tid >> 6), lane = tid & 63, wr = wid >> 2, wc = wid & 3, fr = lane & 15, fq = lane >> 4;
    const int K = g.K, nt = K / BK;
    unsigned voffA[2], voffB[2];
#pragma unroll
    for (int i = 0; i < 2; ++i) { int R, C; stage_rc(tid * 16 + i * 8192, R, C); const int Rb = Epi::PERM ? ((R & ~31) + perm32(R & 31)) : R;
        voffA[i] = (unsigned)(R * K + C) * 2u; voffB[i] = (unsigned)(Rb * K + C) * 2u; }
    const size_t kstep = (size_t)(BK * 2);
    const size_t hstep = (size_t)HALF * K * 2;
    const size_t tstep = 2 * hstep;
    const unsigned ldsw = (unsigned)wid * 1024u;
    const int aoff = lds_byte(wr * 64 + fr, fq * 8), boff = lds_byte(wc * 32 + fr, fq * 8);
#define PG8_SA(b, h) (((b) * 2 + (h)) * HTB)
#define PG8_SB(b, h) ((4 + (b) * 2 + (h)) * HTB)
#define PG8_STAGE(bufoff, gbase, voff) do { _Pragma("unroll") for (int _i = 0; _i < 2; ++_i) \
        __builtin_amdgcn_global_load_lds((const unsigned*)((const char*)(gbase) + (voff)[_i]), (PG8_LAS unsigned*)(lds + (bufoff) + ldsw + _i * 8192), 16, 0, 0); } while (0)
#define PG8_LDA(dst, b, h) do { _Pragma("unroll") for (int m = 0; m < 4; ++m) _Pragma("unroll") for (int k = 0; k < 2; ++k) dst[m][k] = *(const PG8_LAS bf16x8*)(lds + PG8_SA(b, h) + aoff + m * 2048 + k * 1024); } while (0)
#define PG8_LDB(dst, b, h) do { _Pragma("unroll") for (int n = 0; n < 2; ++n) _Pragma("unroll") for (int k = 0; k < 2; ++k) dst[n][k] = *(const PG8_LAS bf16x8*)(lds + PG8_SB(b, h) + boff + n * 2048 + k * 1024); } while (0)
#define PG8_MMA(ai, bj, At, Bt) do { __builtin_amdgcn_s_setprio(1); _Pragma("unroll") for (int m = 0; m < 4; ++m) _Pragma("unroll") for (int n = 0; n < 2; ++n) _Pragma("unroll") for (int k = 0; k < 2; ++k) \
        acc[ai][bj][m][n] = __builtin_amdgcn_mfma_f32_16x16x32_bf16(Bt[n][k], At[m][k], acc[ai][bj][m][n], 0, 0, 0); __builtin_amdgcn_s_setprio(0); } while (0)
#define PG8_WAIT_V(n) asm volatile("s_waitcnt vmcnt(" #n ")" ::: "memory")
#define PG8_WAIT_L(n) asm volatile("s_waitcnt lgkmcnt(" #n ")" ::: "memory")
#define PG8_BAR __builtin_amdgcn_s_barrier()
#define PG8_SCHED __builtin_amdgcn_sched_barrier(0)
    Unit cur, nxt; int ui = 0;
    if (!S.next(0, cur)) return;
    f32x4 acc[2][2][4][2];
#pragma unroll
    for (int a = 0; a < 2; ++a)
#pragma unroll
        for (int b = 0; b < 2; ++b)
#pragma unroll
            for (int m = 0; m < 4; ++m)
#pragma unroll
                for (int n = 0; n < 2; ++n) acc[a][b][m][n] = (f32x4){0.f, 0.f, 0.f, 0.f};
    bf16x8 At[4][2], B0[2][2], B1[2][2];
    const char* cA = (const char*)g.A + (size_t)cur.pm * tstep; const char* cB = (const char*)g.Bt + (size_t)cur.pn * tstep;
    S.a_ready(cur);
    if constexpr (SP2) {
        PG8_STAGE(PG8_SB(0, 0), cB, voffB); PG8_STAGE(PG8_SB(0, 1), cB + hstep, voffB); PG8_STAGE(PG8_SA(0, 0), cA, voffA); PG8_STAGE(PG8_SA(0, 1), cA + hstep, voffA);
        if (wr == 1) PG8_BAR;
        PG8_WAIT_V(2); PG8_BAR;
        PG8_STAGE(PG8_SB(1, 0), cB + kstep, voffB); PG8_STAGE(PG8_SA(1, 0), cA + kstep, voffA); PG8_STAGE(PG8_SB(1, 1), cB + hstep + kstep, voffB);
        PG8_WAIT_V(6); PG8_BAR;
    } else {
        PG8_STAGE(PG8_SB(0, 0), cB, voffB); PG8_STAGE(PG8_SA(0, 0), cA, voffA); PG8_STAGE(PG8_SB(0, 1), cB + hstep, voffB); PG8_STAGE(PG8_SA(0, 1), cA + hstep, voffA);
        if (wr == 1) PG8_BAR;
        PG8_WAIT_V(4); PG8_BAR;
        PG8_STAGE(PG8_SB(1, 0), cB + kstep, voffB); PG8_STAGE(PG8_SA(1, 0), cA + kstep, voffA); PG8_STAGE(PG8_SB(1, 1), cB + hstep + kstep, voffB);
        PG8_WAIT_V(6); PG8_BAR;
    }
    for (;;) {
        const bool has_next = S.next(ui + 1, nxt);
        const char* nA = has_next ? (const char*)g.A + (size_t)nxt.pm * tstep : cA; const char* nB = has_next ? (const char*)g.Bt + (size_t)nxt.pn * tstep : cB;
        for (int t = 0; t < nt; t += 2) {
            const bool last = (t == nt - 2);
            const char* a1 = cA + (size_t)(t + 1) * kstep;
            const char* a2 = last ? nA : cA + (size_t)(t + 2) * kstep; const char* b2 = last ? nB : cB + (size_t)(t + 2) * kstep;
            const char* a3 = a2 + kstep; const char* b3 = b2 + kstep;
            if (last && has_next) S.a_ready(nxt);
            if constexpr (SP2) {
            PG8_LDB(B0, 0, 0); PG8_LDB(B1, 0, 1); PG8_SCHED; PG8_LDA(At, 0, 0); PG8_STAGE(PG8_SA(1, 1), a1 + hstep, voffA);
            PG8_WAIT_V(8); PG8_WAIT_L(0); PG8_BAR; PG8_MMA(0, 0, At, B0); PG8_MMA(0, 1, At, B1); PG8_BAR; PG8_SCHED;
            PG8_LDA(At, 0, 1); PG8_STAGE(PG8_SB(0, 0), b2, voffB); PG8_STAGE(PG8_SB(0, 1), b2 + hstep, voffB); PG8_STAGE(PG8_SA(0, 0), a2, voffA);
            PG8_WAIT_V(8); PG8_WAIT_L(0); PG8_BAR; PG8_MMA(1, 0, At, B0); PG8_MMA(1, 1, At, B1); PG8_BAR; PG8_SCHED;
            PG8_LDB(B0, 1, 0); PG8_LDB(B1, 1, 1); PG8_SCHED; PG8_LDA(At, 1, 0); PG8_STAGE(PG8_SA(0, 1), a2 + hstep, voffA);
            PG8_WAIT_V(8); PG8_WAIT_L(0); PG8_BAR; PG8_MMA(0, 0, At, B0); PG8_MMA(0, 1, At, B1); PG8_BAR; PG8_SCHED;
            PG8_LDA(At, 1, 1); PG8_STAGE(PG8_SB(1, 0), b3, voffB); PG8_STAGE(PG8_SB(1, 1), b3 + hstep, voffB); PG8_STAGE(PG8_SA(1, 0), a3, voffA);
            PG8_WAIT_V(8); PG8_WAIT_L(0); PG8_BAR; PG8_MMA(1, 0, At, B0); PG8_MMA(1, 1, At, B1); PG8_BAR; PG8_SCHED;
            } else {
            PG8_LDB(B0, 0, 0); PG8_SCHED; PG8_LDA(At, 0, 0); PG8_STAGE(PG8_SA(1, 1), a1 + hstep, voffA);
            PG8_WAIT_L(8); PG8_BAR; PG8_WAIT_L(0); PG8_MMA(0, 0, At, B0); PG8_BAR; PG8_SCHED;
            PG8_LDB(B1, 0, 1); PG8_STAGE(PG8_SB(0, 0), b2, voffB);
            PG8_BAR; PG8_WAIT_L(0); PG8_MMA(0, 1, At, B1); PG8_BAR;
            PG8_LDA(At, 0, 1); PG8_STAGE(PG8_SA(0, 0), a2, voffA);
            PG8_BAR; PG8_WAIT_L(0); PG8_MMA(1, 0, At, B0); PG8_BAR; PG8_SCHED;
            PG8_STAGE(PG8_SB(0, 1), b2 + hstep, voffB);
            PG8_WAIT_V(6); PG8_BAR; PG8_MMA(1, 1, At, B1); PG8_BAR;
            PG8_LDB(B0, 1, 0); PG8_SCHED; PG8_LDA(At, 1, 0); PG8_STAGE(PG8_SA(0, 1), a2 + hstep, voffA);
            PG8_WAIT_L(8); PG8_BAR; PG8_WAIT_L(0); PG8_MMA(0, 0, At, B0); PG8_BAR; PG8_SCHED;
            PG8_LDB(B1, 1, 1); PG8_STAGE(PG8_SB(1, 0), b3, voffB);
            PG8_BAR; PG8_WAIT_L(0); PG8_MMA(0, 1, At, B1); PG8_BAR;
            PG8_LDA(At, 1, 1); PG8_STAGE(PG8_SA(1, 0), a3, voffA);
            PG8_BAR; PG8_WAIT_L(0); PG8_MMA(1, 0, At, B0); PG8_BAR; PG8_SCHED;
            PG8_STAGE(PG8_SB(1, 1), b3 + hstep, voffB);
            PG8_WAIT_V(6); PG8_BAR; PG8_MMA(1, 1, At, B1); PG8_BAR;
            }
        }
        if constexpr (ALIGN_EPI) { if (wr == 0) PG8_BAR; }
        if constexpr (!Epi::AFTER_DRAIN) { E(acc, cur, wr, wc, fr, fq); S.done(cur); }
        if (!has_next) break;
#pragma unroll
        for (int a = 0; a < 2; ++a)
#pragma unroll
            for (int b = 0; b < 2; ++b)
#pragma unroll
                for (int m = 0; m < 4; ++m)
#pragma unroll
                    for (int n = 0; n < 2; ++n) acc[a][b][m][n] = (f32x4){0.f, 0.f, 0.f, 0.f};
        cur = nxt; cA = nA; cB = nB; ++ui;
        if constexpr (ALIGN_EPI) { if (wr == 1) PG8_BAR; }
    }
    PG8_WAIT_V(0);
    if constexpr (!ALIGN_EPI) { if (wr == 0) PG8_BAR; }
    PG8_BAR;
    if constexpr (Epi::AFTER_DRAIN) { E.fused(acc, cur, wr, wc, fr, fq, lds, wid, lane); S.done(cur); }
#undef PG8_SA
#undef PG8_SB
#undef PG8_STAGE
#undef PG8_LDA
#undef PG8_LDB
#undef PG8_MMA
#undef PG8_WAIT_V
#undef PG8_WAIT_L
#undef PG8_BAR
#undef PG8_SCHED
}
}

constexpr int DM = 1024, NB = 2, SEQ = 8192, CTXL = 256, MLAT = NB * SEQ, MCTX = NB * CTXL, MROWS = MLAT + MCTX;
constexpr int NIN = 2560, NCHUNK = MROWS / 64  , NPJ = 132  ;
constexpr float EPSF = 1e-6f;
constexpr int NWAVES = 8, NTHR = 512;

constexpr size_t MiB = 1u << 20;
constexpr size_t WS_CTL = 0, CTL_ZERO_BYTES = 64 * 1024;
constexpr size_t WS_MOD = 1 * MiB;
constexpr size_t WS_SP8 = 1 * MiB + 128 * 1024;
constexpr size_t WS_GWF = 1 * MiB + 256 * 1024;
constexpr size_t WS_BT1 = 2 * MiB;
constexpr size_t WS_BT2 = 12 * MiB;
constexpr size_t WS_AGGA = 16 * MiB;
constexpr size_t WS_AGGB = 16 * MiB + 1536 * 1024;
constexpr size_t WS_SSQ = 19 * MiB;
constexpr size_t WS_SSQ1 = 21 * MiB;
constexpr size_t WS_A16 = 23 * MiB;
constexpr size_t WS_B16 = 28 * MiB;
constexpr size_t WS_H = 73 * MiB;
constexpr size_t WS_Y = 56 * MiB;
constexpr size_t WS_MIXIN = 73 * MiB;
constexpr size_t WS_U = 106 * MiB;
constexpr size_t WS_MIX = 189 * MiB;
constexpr size_t WS_END = 255 * MiB;

constexpr int LDS_BYTES = 158720;
constexpr int MISC_OFF = 157696;

#define LAS __attribute__((address_space(3)))
typedef unsigned short bf16;
typedef unsigned v4u __attribute__((ext_vector_type(4)));
typedef unsigned v2u __attribute__((ext_vector_type(2)));
typedef float f32x4 __attribute__((ext_vector_type(4)));
typedef short bf16x8 __attribute__((ext_vector_type(8)));
typedef float f32x2v __attribute__((ext_vector_type(2)));
#define LDS_WAIT() asm volatile("s_waitcnt lgkmcnt(0)" ::: "memory")

__device__ __forceinline__ unsigned f2bf(float f) { unsigned u = __builtin_bit_cast(unsigned, f); return (u + 0x7fffu + ((u >> 16) & 1u)) >> 16; }
__device__ __forceinline__ unsigned pk2(float lo, float hi) { return f2bf(lo) | (f2bf(hi) << 16); }
__device__ __forceinline__ unsigned cvtpk(float lo, float hi) { unsigned r; asm volatile("v_cvt_pk_bf16_f32 %0, %1, %2" : "=v"(r) : "v"(lo), "v"(hi)); return r; }
__device__ __forceinline__ float bflo(unsigned u) { return __builtin_bit_cast(float, u << 16); }
__device__ __forceinline__ float bfhi(unsigned u) { return __builtin_bit_cast(float, u & 0xffff0000u); }
__device__ __forceinline__ float sigmoidf_(float x) { return 1.0f / (1.0f + __expf(-x)); }
__device__ __forceinline__ float siluf_(float x) { return x * __builtin_amdgcn_rcpf(1.0f + __builtin_amdgcn_exp2f(-1.44269504f * x)); }
__device__ __forceinline__ float wave_sum(float v) {
#pragma unroll
    for (int o = 1; o < 64; o <<= 1) v += __shfl_xor(v, o);
    return v;
}

struct Args {
    const float* in[21]; float* out; unsigned char* ws; int ph_lo, ph_hi, coop, pad;
};
enum { I_X = 0, I_C, I_CTX, I_CCTX, I_WMOD, I_BMOD, I_GPRE, I_GPOST, I_WIN, I_CAW, I_CAB, I_WR, I_BR, I_WI, I_BI, I_LAM, I_DWW, I_DWB, I_LNG, I_LNB, I_WOUT };

namespace pg8 {
__device__ __forceinline__ void st16_wt(void* p, u32x4 w) { asm volatile("global_store_dwordx4 %0, %1, off sc1\n\ts_nop 1" :: "v"(p), "v"(w) : "memory"); }
struct EpiU {
    static constexpr bool PERM = true, AFTER_DRAIN = false;
    bf16_t* O;
    __device__ __forceinline__ void operator()(const f32x4 (&acc)[2][2][4][2], const Unit& u, int wr, int wc, int fr, int fq) const {
        const int row0 = u.pm * BM + wr * 64 + fr;
        if (u.pn >= 4 && u.pn < 8) {
            const int col0 = 1024 + 128 * (u.pn - 4) + wc * 32 + 8 * fq;
#pragma unroll
            for (int ai = 0; ai < 2; ++ai)
#pragma unroll
                for (int m = 0; m < 4; ++m) { f32x4 v0 = acc[ai][0][m][0], v1 = acc[ai][0][m][1]; const f32x4 g0 = acc[ai][1][m][0], g1 = acc[ai][1][m][1];
#pragma unroll
                    for (int e = 0; e < 4; ++e) { v0[e] = v0[e] * __builtin_amdgcn_rcpf(1.0f + __builtin_amdgcn_exp2f(-1.44269504f * g0[e])); v1[e] = v1[e] * __builtin_amdgcn_rcpf(1.0f + __builtin_amdgcn_exp2f(-1.44269504f * g1[e])); }
                    u32x4 w; w.x = cvt_pk_bf16(v0[0], v0[1]); w.y = cvt_pk_bf16(v0[2], v0[3]); w.z = cvt_pk_bf16(v1[0], v1[1]); w.w = cvt_pk_bf16(v1[2], v1[3]);
                    *(u32x4*)(O + (size_t)(row0 + ai * HALF + m * 16) * 2560 + col0) = w; }
            return;
        }
        const int col0 = u.pn * BM + wc * 32 + 8 * fq;
        const bool act = (u.pn == 2 || u.pn == 3 || u.pn >= 8);
#pragma unroll
        for (int ai = 0; ai < 2; ++ai)
#pragma unroll
            for (int m = 0; m < 4; ++m) { bf16_t* rowp = O + (size_t)(row0 + ai * HALF + m * 16) * 2560 + col0;
#pragma unroll
                for (int bj = 0; bj < 2; ++bj) { f32x4 v0 = acc[ai][bj][m][0], v1 = acc[ai][bj][m][1];
                    if (act) {
#pragma unroll
                        for (int e = 0; e < 4; ++e) { v0[e] = v0[e] * __builtin_amdgcn_rcpf(1.0f + __builtin_amdgcn_exp2f(-1.44269504f * v0[e])); v1[e] = v1[e] * __builtin_amdgcn_rcpf(1.0f + __builtin_amdgcn_exp2f(-1.44269504f * v1[e])); }
                    }
                    u32x4 w; w.x = cvt_pk_bf16(v0[0], v0[1]); w.y = cvt_pk_bf16(v0[2], v0[3]); w.z = cvt_pk_bf16(v1[0], v1[1]); w.w = cvt_pk_bf16(v1[2], v1[3]);
                    *(u32x4*)(rowp + bj * HALF) = w; } }
    }
};
struct EpiMix {
    static constexpr bool PERM = true, AFTER_DRAIN = false;
    bf16_t* O; unsigned* cnt;
    __device__ __forceinline__ void operator()(const f32x4 (&acc)[2][2][4][2], const Unit& u, int wr, int wc, int fr, int fq) const {
        const int col0 = u.pn * BM + wc * 32 + 8 * fq;
#pragma unroll
        for (int ai = 0; ai < 2; ++ai)
#pragma unroll
            for (int m = 0; m < 4; ++m) { const int r = u.pm * BM + ai * HALF + wr * 64 + m * 16 + fr; bf16_t* rowp = O + (size_t)r * 1024 + col0;
#pragma unroll
                for (int bj = 0; bj < 2; ++bj) { const f32x4 v0 = acc[ai][bj][m][0], v1 = acc[ai][bj][m][1];
                    u32x4 w; w.x = cvt_pk_bf16(v0[0], v0[1]); w.y = cvt_pk_bf16(v0[2], v0[3]); w.z = cvt_pk_bf16(v1[0], v1[1]); w.w = cvt_pk_bf16(v1[2], v1[3]);
                    if (cnt) st16_wt(rowp + bj * HALF, w); else *(u32x4*)(rowp + bj * HALF) = w; } }
        if (cnt) { asm volatile("s_waitcnt vmcnt(0)" ::: "memory");
            if (fr == 0 && fq == 0) __hip_atomic_fetch_add(cnt + 64 * u.pm, 1u, __ATOMIC_RELAXED, __HIP_MEMORY_SCOPE_AGENT); }
    }
};
}

__device__ __forceinline__ void p0_transpose_item(const float* W, int K, int N, bf16* WT, LAS float* scr, int item, int lane, bool glu_remap) {
    const int nblk = N / 32, kb = item / nblk, nb = item % nblk, k0 = 64 * kb, n0 = 32 * nb;
    int nd = n0;
    if (glu_remap) { if (n0 >= 1024 && n0 < 1536) nd = 1024 + 256 * ((n0 - 1024) >> 7) + ((n0 - 1024) & 127); else if (n0 >= 1536 && n0 < 2048) nd = 1024 + 256 * ((n0 - 1536) >> 7) + 128 + ((n0 - 1536) & 127); }
#pragma unroll 8
    for (int i = 0; i < 32; ++i) { const int kk = 2 * i + (lane >> 5); scr[kk * 33 + (lane & 31)] = W[(size_t)(k0 + kk) * N + n0 + (lane & 31)]; }
    LDS_WAIT(); asm volatile("" ::: "memory");
    const int c = lane & 7;
#pragma unroll
    for (int j = 0; j < 4; ++j) { const int n = (lane >> 3) + 8 * j; const LAS float* s = scr + (8 * c) * 33 + n;
        v4u o; o.x = pk2(s[0 * 33], s[1 * 33]); o.y = pk2(s[2 * 33], s[3 * 33]); o.z = pk2(s[4 * 33], s[5 * 33]); o.w = pk2(s[6 * 33], s[7 * 33]);
        *(v4u*)(WT + (size_t)(nd + n) * K + k0 + 8 * c) = o; }
    LDS_WAIT(); asm volatile("" ::: "memory");
}

__device__ __forceinline__ void p0_prologue(const Args& a, LAS unsigned char* lds, int tid, int lane, int wave) {
    const int G = gridDim.x, bx = blockIdx.x;
    unsigned char* ws = a.ws;
    {
        LAS float* part = (LAS float*)lds;
        float* MOD = (float*)(ws + WS_MOD);
        const float* c = a.in[I_C]; const float* cctx = a.in[I_CCTX];
        for (int un = bx; un < 192; un += G) {
            const int l = un / 96, n0 = (un % 96) * 32, cq = tid & 7, ks = tid >> 3;
            const float* wm = a.in[I_WMOD] + (size_t)l * 1024 * 3072 + n0 + cq * 4;
            f32x4 acc0 = {0.f, 0.f, 0.f, 0.f}, acc1 = acc0, acc2 = acc0;
#pragma unroll 4
            for (int kk = 0; kk < 16; ++kk) { const int k = ks * 16 + kk; const f32x4 w = *(const f32x4*)(wm + (size_t)k * 3072);
                const float a0 = siluf_(c[k]), a1 = siluf_(c[1024 + k]), a2 = siluf_(cctx[k]);
                acc0 += w * a0; acc1 += w * a1; acc2 += w * a2; }
            *(LAS f32x4*)(part + (0 * 64 + ks) * 32 + cq * 4) = acc0;
            *(LAS f32x4*)(part + (1 * 64 + ks) * 32 + cq * 4) = acc1;
            *(LAS f32x4*)(part + (2 * 64 + ks) * 32 + cq * 4) = acc2;
            __syncthreads();
            if (tid < 96) { const int v = tid >> 5, col = tid & 31; float s = a.in[I_BMOD][l * 3072 + n0 + col];
                for (int k2 = 0; k2 < 64; ++k2) s += part[(v * 64 + k2) * 32 + col];
                MOD[(l * 3 + v) * 3072 + n0 + col] = s; }
            __syncthreads();
        }
    }
    { float* SP8 = (float*)(ws + WS_SP8); for (int idx = bx * NTHR + tid; idx < 2048; idx += G * NTHR) SP8[idx] = -8.0f * log1pf(__expf(-a.in[I_LAM][idx])); }
    {
        v4u* GWF = (v4u*)(ws + WS_GWF);
        for (int idx = bx * NTHR + tid; idx < 32768; idx += G * NTHR) {
            const int ln = idx & 63, kk = (idx >> 6) & 1, ct = (idx >> 7) & 3, h = (idx >> 9) & 7, g = (idx >> 12) & 1, d = (idx >> 13) & 1, l = idx >> 14;
            const float* W = (g == 0 ? a.in[I_WR] : a.in[I_WI]) + (size_t)(((l * 2 + d) * 8 + h) * 64) * 64;
            const int k0 = 32 * kk + 8 * (ln >> 4), col = 16 * ct + (ln & 15);
            float e[8];
#pragma unroll
            for (int j = 0; j < 8; ++j) e[j] = W[(k0 + j) * 64 + col];
            v4u o; o.x = pk2(e[0], e[1]); o.y = pk2(e[2], e[3]); o.z = pk2(e[4], e[5]); o.w = pk2(e[6], e[7]);
            GWF[idx] = o;
        }
    }
    {
        LAS float* scr = (LAS float*)(lds + wave * 16384);
        const int gw = bx * NWAVES + wave, NGW = G * NWAVES;
        constexpr int I_1 = (1024 / 64) * (NIN / 32), I_2 = (1024 / 64) * (1024 / 32), NITEMS = 2 * (I_1 + I_2);
        bf16* BT1 = (bf16*)(ws + WS_BT1); bf16* BT2 = (bf16*)(ws + WS_BT2);
        for (int it = gw; it < NITEMS; it += NGW) {
            int r = it;
            if (r < I_1) { p0_transpose_item(a.in[I_WIN], 1024, NIN, BT1, scr, r, lane, true); continue; } r -= I_1;
            if (r < I_1) { p0_transpose_item(a.in[I_WIN] + (size_t)1024 * NIN, 1024, NIN, BT1 + (size_t)NIN * 1024, scr, r, lane, true); continue; } r -= I_1;
            if (r < I_2) { p0_transpose_item(a.in[I_WOUT], 1024, 1024, BT2, scr, r, lane, false); continue; } r -= I_2;
            p0_transpose_item(a.in[I_WOUT] + (size_t)1024 * 1024, 1024, 1024, BT2 + (size_t)1024 * 1024, scr, r, lane, false);
        }
    }
}

__device__ __forceinline__ void norm_phase(const Args& a, int mode, int lane, int wave) {
    unsigned char* ws = a.ws;
    const float* MOD = (const float*)(ws + WS_MOD); bf16* H = (bf16*)(ws + WS_H);
    const int gw = blockIdx.x * NWAVES + wave, NGW = gridDim.x * NWAVES;
    const int nrows = (mode == 2) ? MLAT : MROWS, ln = (mode == 0) ? 0 : 1;
    for (int row = gw; row < nrows; row += NGW) {
        const int vsel = row < MLAT ? (row >> 13) : 2;
        const float* src = row < MLAT ? a.in[I_X] + (size_t)row * 1024 : a.in[I_CTX] + (size_t)(row - MLAT) * 1024;
        f32x4 v[4];
#pragma unroll
        for (int j = 0; j < 4; ++j) v[j] = *((const f32x4*)src + lane + 64 * j);
#pragma unroll 1
        for (int lu = 0; lu < mode; ++lu) {
            const bf16* MIX = (const bf16*)(ws + WS_MIX) + (size_t)lu * MROWS * 1024;
            const float* gate = MOD + (lu * 3 + vsel) * 3072 + 2048; const float* gp = a.in[I_GPOST] + lu * 1024;
            f32x4 mx[4]; float sp = 0.f;
#pragma unroll
            for (int j = 0; j < 4; ++j) { const v2u mq = *((const v2u*)(MIX + (size_t)row * 1024) + lane + 64 * j); mx[j] = (f32x4){bflo(mq.x), bfhi(mq.x), bflo(mq.y), bfhi(mq.y)};
                sp += (mx[j].x * mx[j].x + mx[j].y * mx[j].y) + (mx[j].z * mx[j].z + mx[j].w * mx[j].w); }
            const float rstd = rsqrtf(wave_sum(sp) * (1.0f / 1024.0f) + EPSF);
#pragma unroll
            for (int j = 0; j < 4; ++j) { const f32x4 gt = *((const f32x4*)gate + lane + 64 * j), gv = *((const f32x4*)gp + lane + 64 * j);
                v[j] += gt * (mx[j] * rstd * gv); }
        }
        if (mode == 2) {
            float* dst = a.out + (size_t)row * 1024;
#pragma unroll
            for (int j = 0; j < 4; ++j) *((f32x4*)dst + lane + 64 * j) = v[j];
        } else {
            float s = 0.f;
#pragma unroll
            for (int j = 0; j < 4; ++j) s += (v[j].x * v[j].x + v[j].y * v[j].y) + (v[j].z * v[j].z + v[j].w * v[j].w);
            const float r = rsqrtf(wave_sum(s) * (1.0f / 1024.0f) + EPSF);
            const float* shift = MOD + (ln * 3 + vsel) * 3072; const float* scale = shift + 1024; const float* gpre = a.in[I_GPRE] + ln * 1024;
            v2u* o8 = (v2u*)(H + (size_t)row * 1024);
#pragma unroll
            for (int j = 0; j < 4; ++j) { const f32x4 sh = *((const f32x4*)shift + lane + 64 * j), sc = *((const f32x4*)scale + lane + 64 * j), gv = *((const f32x4*)gpre + lane + 64 * j);
                const f32x4 hv = v[j] * r * gv * (sc + 1.0f) + sh;
                v2u w; w.x = cvtpk(hv.x, hv.y); w.y = cvtpk(hv.z, hv.w); o8[lane + 64 * j] = w; }
        }
    }
}

__device__ __forceinline__ void conv16(const LAS unsigned* vt, const f32x2v (&w2)[31], const f32x2v b2, bf16* ybase, size_t ystride) {
#pragma unroll 1
    for (int tq = 0; tq < 4; ++tq) {
        const LAS unsigned* vq = vt + tq * 4 * 128;
        f32x2v acc[4];
#pragma unroll
        for (int t = 0; t < 4; ++t) acc[t] = b2;
#pragma unroll
        for (int rr = 0; rr < 34; ++rr) { const unsigned u = vq[rr * 128]; const f32x2v x = {bflo(u), bfhi(u)};
#pragma unroll
            for (int t = 0; t < 4; ++t) { const int k = rr - t; if (k >= 0 && k < 31) acc[t] += w2[k] * x; }
            if ((rr & 7) == 7) asm volatile("" ::: "memory"); }
#pragma unroll
        for (int t = 0; t < 4; ++t) *(unsigned*)(ybase + (size_t)(tq * 4 + t) * ystride) = cvtpk(acc[t].x, acc[t].y);
    }
}
__device__ __forceinline__ v4u glu8(const v4u vq, const v4u gq) {
    v4u o;
    o.x = pk2(bflo(vq.x) * sigmoidf_(bflo(gq.x)), bfhi(vq.x) * sigmoidf_(bfhi(gq.x)));
    o.y = pk2(bflo(vq.y) * sigmoidf_(bflo(gq.y)), bfhi(vq.y) * sigmoidf_(bfhi(gq.y)));
    o.z = pk2(bflo(vq.z) * sigmoidf_(bflo(gq.z)), bfhi(vq.z) * sigmoidf_(bfhi(gq.z)));
    o.w = pk2(bflo(vq.w) * sigmoidf_(bflo(gq.w)), bfhi(vq.w) * sigmoidf_(bfhi(gq.w)));
    return o;
}
__device__ __forceinline__ void conv_unit(const Args& a, LAS unsigned char* lds, int l, int grow0, int gstride, int vlo, int vhi, int coff, int cbase, int nrows, int ncall, int orow0, int ostride, int tid) {
    const bf16* U = (const bf16*)(a.ws + WS_U); bf16* Y = (bf16*)(a.ws + WS_Y);
    LAS unsigned* VT = (LAS unsigned*)lds;
    int p = tid & 127; asm volatile("" : "+v"(p));
    const int tg = tid >> 7, c0 = cbase + 2 * p;
    f32x2v w2[31];
#pragma unroll
    for (int k = 0; k < 31; ++k) w2[k] = *(const f32x2v*)(a.in[I_DWW] + (size_t)(l * 31 + k) * 512 + c0);
    const f32x2v b2 = *(const f32x2v*)(a.in[I_DWB] + l * 512 + c0);
    const int nchunk = nrows * 32;
#pragma unroll 1
    for (int i0 = tid; i0 < nchunk; i0 += 3 * NTHR) {
        v4u vq[3];
#pragma unroll
        for (int it = 0; it < 3; ++it) { const int i = i0 + it * NTHR, rr = i >> 5, ch = i & 31, row = grow0 + rr * gstride; const bool ok = i < nchunk && row >= vlo && row < vhi;
            vq[it] = *(const v4u*)(U + (size_t)(ok ? row : vlo) * NIN + coff + ch * 8); }
#pragma unroll
        for (int it = 0; it < 3; ++it) { const int i = i0 + it * NTHR, rr = i >> 5, ch = i & 31, row = grow0 + rr * gstride; const bool ok = row >= vlo && row < vhi;
            if (i < nchunk) { const v4u z = {0u, 0u, 0u, 0u}; *(LAS v4u*)(VT + rr * 128 + ch * 4) = ok ? vq[it] : z; } }
    }
    __syncthreads();
#pragma unroll 1
    for (int hc = 0; hc < ncall; ++hc) { const int tb = (tg * ncall + hc) * 16;
        conv16(VT + tb * 128 + p, w2, b2, Y + (size_t)(orow0 + tb * ostride) * 512 + c0, (size_t)ostride * 512); }
    __syncthreads();
}
__device__ __forceinline__ void ln_rows(const Args& a, int l, int nrows, int lane, int wave, int nblk) {
    const bf16* U = (const bf16*)(a.ws + WS_U); const bf16* Y = (const bf16*)(a.ws + WS_Y); bf16* MIXIN = (bf16*)(a.ws + WS_MIXIN);
    if ((int)blockIdx.x >= nblk) return;
    const int gw = blockIdx.x * NWAVES + wave, NGW = nblk * NWAVES, c0 = lane * 8;
    float lg[8], lb[8];
#pragma unroll
    for (int e = 0; e < 8; ++e) { lg[e] = a.in[I_LNG][l * 512 + c0 + e]; lb[e] = a.in[I_LNB][l * 512 + c0 + e]; }
    for (int row = gw; row < nrows; row += NGW) {
        const v4u yq = *(const v4u*)(Y + (size_t)row * 512 + c0); const v4u gq = *(const v4u*)(U + (size_t)row * NIN + 2048 + c0);
        float y[8] = {bflo(yq.x), bfhi(yq.x), bflo(yq.y), bfhi(yq.y), bflo(yq.z), bfhi(yq.z), bflo(yq.w), bfhi(yq.w)};
        const float gt[8] = {bflo(gq.x), bfhi(gq.x), bflo(gq.y), bfhi(gq.y), bflo(gq.z), bfhi(gq.z), bflo(gq.w), bfhi(gq.w)};
        float s = 0.f;
#pragma unroll
        for (int e = 0; e < 8; ++e) s += y[e];
        const float mean = wave_sum(s) * (1.0f / 512.0f); float q = 0.f;
#pragma unroll
        for (int e = 0; e < 8; ++e) { y[e] -= mean; q += y[e] * y[e]; }
        const float rstd = rsqrtf(wave_sum(q) * (1.0f / 512.0f) + EPSF);
        float o[8];
#pragma unroll
        for (int e = 0; e < 8; ++e) o[e] = siluf_(y[e] * rstd * lg[e] + lb[e]) * gt[e];
        v4u w; w.x = pk2(o[0], o[1]); w.y = pk2(o[2], o[3]); w.z = pk2(o[4], o[5]); w.w = pk2(o[6], o[7]);
        *(v4u*)(MIXIN + (size_t)row * 1024 + 512 + c0) = w;
    }
}

constexpr int RG_GW = 0, RG_FOLD = 32768, RG_F8 = 36864, RG_CAR = 40960, RG_WAVE = 57344, RG_WAVE_BYTES = 12544;
constexpr int NP16 = 4 * NPJ;
__device__ __forceinline__ float fsig(float x) { return __builtin_amdgcn_rcpf(1.0f + __expf(-x)); }

template <bool FINAL, bool FASTP>
__device__ __forceinline__ void rg_sweep(const Args& a, LAS unsigned char* lds, LAS unsigned char* wl, int l, int b, int h, int r0, int seg_lo, int seg_hi, int pj, bool is_ctx, int w, int lane, const int D) {
    const bf16* U = (const bf16*)(a.ws + WS_U); bf16* MIXIN = (bf16*)(a.ws + WS_MIXIN);
    float* AGGA = (float*)(a.ws + WS_AGGA); float* AGGB = (float*)(a.ws + WS_AGGB); float* A16 = (float*)(a.ws + WS_A16); float* B16 = (float*)(a.ws + WS_B16);
    LAS float* VCW = (LAS float*)wl; LAS unsigned* HBW = (LAS unsigned*)(wl + 4352);
    const LAS v4u* GWL = (const LAS v4u*)(lds + RG_GW) + (D * 2) * 8 * 64 + lane;
    const LAS float* CAR = (const LAS float*)(lds + RG_CAR);
    const int fr = lane & 15, fq = lane >> 4, cp = lane & 31, rh = lane >> 5;
    const int rbase = D ? r0 + 63 : r0, rsign = D ? -1 : 1;
    float2 cw[4];
#pragma unroll
    for (int k = 0; k < 4; ++k) cw[k] = *(const float2*)(a.in[I_CAW] + (size_t)((l * 2 + D) * 4 + (D ? 3 - k : k)) * 512 + 64 * h + 2 * cp);
    const float2 cbv = *(const float2*)(a.in[I_CAB] + (l * 2 + D) * 512 + 64 * h + 2 * cp);
    float brv[4], biv[4], sp8[4], Hc[4], Ac[4];
    const int p16own = 4 * pj + fq;
#pragma unroll
    for (int ct = 0; ct < 4; ++ct) { const int c = 16 * ct + fr, pidx = (l * 2 + D) * 512 + 64 * h + c;
        brv[ct] = a.in[I_BR][pidx]; biv[ct] = a.in[I_BI][pidx]; sp8[ct] = ((const float*)(a.ws + WS_SP8))[pidx];
        Hc[ct] = 0.f; Ac[ct] = 1.f;
        if (FINAL) {
            if (is_ctx) { const size_t base = (size_t)((b * 2 + D) * NP16) * 512 + 64 * h + c; float S = 0.f;
                for (int i = 0; i < p16own; ++i) S = A16[base + (size_t)i * 512] * S + B16[base + (size_t)i * 512];
                Hc[ct] = S; }
            else Hc[ct] = CAR[(D * 32 + 4 * (D ? 7 - w : w) + fq) * 64 + c];
        } }
    const bf16* ub = U + 64 * h + 2 * cp;
    unsigned Wd[2][7], nx[2][4];
#pragma unroll
    for (int q = 0; q < 2; ++q) { const int g = 2 * rh + q;
#pragma unroll
        for (int j = 0; j < 3; ++j) { const int row = rbase + rsign * (16 * g - 3 + j); const bool ok = row >= seg_lo && row < seg_hi; const int rc = ok ? row : r0;
            const unsigned v = *(const unsigned*)(ub + (size_t)rc * NIN); Wd[q][4 + j] = ok ? v : 0u; }
#pragma unroll
        for (int j = 0; j < 4; ++j) nx[q][j] = *(const unsigned*)(ub + (size_t)(rbase + rsign * (16 * g + j)) * NIN); }
#pragma unroll 1
    for (int ti = 0; ti < 4; ++ti) {
        const int tile = ti;
        int zo = 0; asm volatile("" : "+v"(zo));
        const LAS v4u* GWLt = GWL + zo;
        v4u g0 = {0u, 0u, 0u, 0u}, g1 = g0; size_t orow = 0;
        if (FINAL && D == 0) { orow = (size_t)(r0 + 16 * (fr >> 2) + 4 * tile + (fr & 3)); const bf16* gp = U + orow * NIN + 512 + 64 * h + 16 * fq; g0 = *(const v4u*)gp; g1 = *(const v4u*)(gp + 8); }
#pragma unroll
        for (int q = 0; q < 2; ++q) {
            Wd[q][0] = Wd[q][4]; Wd[q][1] = Wd[q][5]; Wd[q][2] = Wd[q][6]; Wd[q][3] = nx[q][0]; Wd[q][4] = nx[q][1]; Wd[q][5] = nx[q][2]; Wd[q][6] = nx[q][3]; }
        if (ti < 3) { const int tn = ti + 1;
#pragma unroll
            for (int q = 0; q < 2; ++q)
#pragma unroll
                for (int j = 0; j < 4; ++j) nx[q][j] = *(const unsigned*)(ub + (size_t)(rbase + rsign * (16 * (2 * rh + q) + 4 * tn + j)) * NIN); }
#pragma unroll
        for (int q = 0; q < 2; ++q)
#pragma unroll
            for (int jj = 0; jj < 4; ++jj) { float v0 = cbv.x, v1 = cbv.y;
#pragma unroll
                for (int k = 0; k < 4; ++k) { const unsigned u = Wd[q][jj + k]; v0 += cw[k].x * bflo(u); v1 += cw[k].y * bfhi(u); }
                *(LAS f32x2v*)(VCW + (4 * (2 * rh + q) + jj) * 68 + 2 * cp) = (f32x2v){v0, v1}; }
        bf16x8 af[2];
#pragma unroll
        for (int kk = 0; kk < 2; ++kk) { const LAS float* vp = VCW + fr * 68 + 32 * kk + 8 * fq; const f32x4 x0 = *(const LAS f32x4*)vp, x1 = *(const LAS f32x4*)(vp + 4);
            v4u pk; pk.x = cvtpk(x0.x, x0.y); pk.y = cvtpk(x0.z, x0.w); pk.z = cvtpk(x1.x, x1.y); pk.w = cvtpk(x1.z, x1.w); af[kk] = __builtin_bit_cast(bf16x8, pk); }
        float vcv[4][4];
#pragma unroll
        for (int ct = 0; ct < 4; ++ct)
#pragma unroll
            for (int jj = 0; jj < 4; ++jj) vcv[ct][jj] = VCW[(4 * fq + jj) * 68 + 16 * ct + fr];
        f32x4 accr[4], acci[4];
#pragma unroll
        for (int ct = 0; ct < 4; ++ct) { accr[ct] = (f32x4){0.f, 0.f, 0.f, 0.f}; acci[ct] = accr[ct];
#pragma unroll
            for (int kk = 0; kk < 2; ++kk) { const bf16x8 br = __builtin_bit_cast(bf16x8, GWLt[(ct * 2 + kk) * 64]), bi = __builtin_bit_cast(bf16x8, GWLt[(8 + ct * 2 + kk) * 64]);
                accr[ct] = __builtin_amdgcn_mfma_f32_16x16x32_bf16(af[kk], br, accr[ct], 0, 0, 0); acci[ct] = __builtin_amdgcn_mfma_f32_16x16x32_bf16(af[kk], bi, acci[ct], 0, 0, 0); } }
        float hsum[4][4];
#pragma unroll
        for (int ct = 0; ct < 4; ++ct) { float aa[4], bb[4];
            const float nbr = -1.44269504f * brv[ct], nbi = -1.44269504f * biv[ct];
#pragma unroll
            for (int p = 0; p < 2; ++p) {
                f32x2v xr = (f32x2v){accr[ct][2 * p], accr[ct][2 * p + 1]} * -1.44269504f + nbr, xi = (f32x2v){acci[ct][2 * p], acci[ct][2 * p + 1]} * -1.44269504f + nbi;
                xr = __builtin_elementwise_min(xr, (f32x2v){60.f, 60.f}); xi = __builtin_elementwise_min(xi, (f32x2v){60.f, 60.f});
                f32x2v d1, d2; d1.x = __builtin_amdgcn_exp2f(xr.x); d1.y = __builtin_amdgcn_exp2f(xr.y); d2.x = __builtin_amdgcn_exp2f(xi.x); d2.y = __builtin_amdgcn_exp2f(xi.y);
                d1 = d1 + 1.0f; d2 = d2 + 1.0f; const f32x2v m = d1 * d2; f32x2v inv; inv.x = __builtin_amdgcn_rcpf(m.x); inv.y = __builtin_amdgcn_rcpf(m.y);
                const f32x2v r = d2 * inv, ig = d1 * inv, la = r * sp8[ct], x2 = la + la, le = la * 1.44269504f;
                f32x2v av, om;
                if (FASTP) { const f32x2v q = la * (la * (la * (la * (la * 0.0083333338f + 0.041666668f) + 0.16666667f) + 0.5f) + 1.0f);
                    av = q + 1.0f; om = -q * (q + 2.0f); }
                else { const f32x2v pom = -x2 * (x2 * (x2 * (x2 * (x2 * 0.0083333338f + 0.041666668f) + 0.16666667f) + 0.5f) + 1.0f);
                    av.x = __builtin_amdgcn_exp2f(le.x); av.y = __builtin_amdgcn_exp2f(le.y);
                    const f32x2v o2 = 1.0f - av * av; om.x = x2.x > -0.25f ? pom.x : o2.x; om.y = x2.y > -0.25f ? pom.y : o2.y;
                    om = __builtin_elementwise_max(om, (f32x2v){0.f, 0.f}); }
                f32x2v sq; sq.x = __builtin_amdgcn_sqrtf(om.x); sq.y = __builtin_amdgcn_sqrtf(om.y);
                const f32x2v bv = sq * (ig * (f32x2v){vcv[ct][2 * p], vcv[ct][2 * p + 1]});
                aa[2 * p] = av.x; aa[2 * p + 1] = av.y; bb[2 * p] = bv.x; bb[2 * p + 1] = bv.y; }
            float hh = Hc[ct], A4 = 1.f;
#pragma unroll
            for (int jj = 0; jj < 4; ++jj) { hh = aa[jj] * hh + bb[jj]; A4 *= aa[jj]; hsum[ct][jj] = hh; }
            Hc[ct] = hh; if (!FINAL) Ac[ct] *= A4; }
        if (FINAL) {
            if (D == 1) {
#pragma unroll
                for (int ct = 0; ct < 4; ++ct)
#pragma unroll
                    for (int jp = 0; jp < 2; ++jp) HBW[(tile * 8 + ct * 2 + jp) * 64 + lane] = cvtpk(hsum[ct][2 * jp], hsum[ct][2 * jp + 1]);
            } else {
#pragma unroll
                for (int ct = 0; ct < 4; ++ct)
#pragma unroll
                    for (int jp = 0; jp < 2; ++jp) {
                        const unsigned hb = HBW[((3 - tile) * 8 + ct * 2 + (1 - jp)) * 64 + fr + 16 * (3 - fq)];
                        VCW[(4 * fq + 2 * jp) * 68 + 16 * ct + fr] = hsum[ct][2 * jp] + bfhi(hb); VCW[(4 * fq + 2 * jp + 1) * 68 + 16 * ct + fr] = hsum[ct][2 * jp + 1] + bflo(hb); }
                const size_t row = orow;
                const f32x4 s0 = *(const LAS f32x4*)(VCW + fr * 68 + 16 * fq), s1 = *(const LAS f32x4*)(VCW + fr * 68 + 16 * fq + 4), s2 = *(const LAS f32x4*)(VCW + fr * 68 + 16 * fq + 8), s3 = *(const LAS f32x4*)(VCW + fr * 68 + 16 * fq + 12);
                v4u o0, o1;
                o0.x = cvtpk(s0.x * bflo(g0.x), s0.y * bfhi(g0.x)); o0.y = cvtpk(s0.z * bflo(g0.y), s0.w * bfhi(g0.y)); o0.z = cvtpk(s1.x * bflo(g0.z), s1.y * bfhi(g0.z)); o0.w = cvtpk(s1.z * bflo(g0.w), s1.w * bfhi(g0.w));
                o1.x = cvtpk(s2.x * bflo(g1.x), s2.y * bfhi(g1.x)); o1.y = cvtpk(s2.z * bflo(g1.y), s2.w * bfhi(g1.y)); o1.z = cvtpk(s3.x * bflo(g1.z), s3.y * bfhi(g1.z)); o1.w = cvtpk(s3.z * bflo(g1.w), s3.w * bfhi(g1.w));
                bf16* op = MIXIN + row * 1024 + 64 * h + 16 * fq; *(v4u*)op = o0; *(v4u*)(op + 8) = o1;
            }
        }
    }
    if (!FINAL) {
#pragma unroll
        for (int ct = 0; ct < 4; ++ct) { const int c = 16 * ct + fr;
            const size_t i16 = (size_t)((b * 2 + D) * NP16 + p16own) * 512 + 64 * h + c; A16[i16] = Ac[ct]; B16[i16] = Hc[ct];
            float Ag[4], Bg[4];
#pragma unroll
            for (int g = 0; g < 4; ++g) { Ag[g] = __shfl(Ac[ct], fr + 16 * g); Bg[g] = __shfl(Hc[ct], fr + 16 * g); }
            float run = 0.f;
#pragma unroll
            for (int g = 0; g < 4; ++g) run = Ag[g] * run + Bg[g];
            if (fq == 0) { const size_t idx = (size_t)((b * 2 + D) * NPJ + pj) * 512 + 64 * h + c; AGGA[idx] = (Ag[0] * Ag[1]) * (Ag[2] * Ag[3]); AGGB[idx] = run; } }
    }
}

template <bool FINAL>
__device__ __forceinline__ void rg_run(const Args& a, LAS unsigned char* lds, int l, int rn, int tid, int lane, int wave) {
    const bool is_ctx = rn >= 256; const int bh = is_ctx ? rn - 256 : rn >> 4, b = bh >> 3, h = bh & 7, cgp = is_ctx ? 0 : (rn & 15);
    { const v4u* GWF = (const v4u*)(a.ws + WS_GWF); LAS v4u* GWL = (LAS v4u*)(lds + RG_GW);
#pragma unroll
      for (int i = tid; i < 2048; i += NTHR) { const int d = i >> 10, g = (i >> 9) & 1, rest = i & 511; GWL[i] = GWF[(size_t)((((l * 2 + d) * 2 + g) * 8 + h) * 8) * 64 + rest]; } }
    const int P0f = 4 + 8 * cgp, P0b = 124 - 8 * cgp;
    if (FINAL && !is_ctx) {
        const float* AGGA = (const float*)(a.ws + WS_AGGA); const float* AGGB = (const float*)(a.ws + WS_AGGB); const float* A16 = (const float*)(a.ws + WS_A16); const float* B16 = (const float*)(a.ws + WS_B16);
        const int d = tid >> 8, s = (tid >> 6) & 3, c = tid & 63, P0 = d ? P0b : P0f, lo = (P0 * s) >> 2, hi = (P0 * (s + 1)) >> 2;
        const size_t b16 = (size_t)((b * 2 + d) * NP16 + 4 * P0 + 8 * s) * 512 + 64 * h + c; float ai8[8], bi8[8];
#pragma unroll
        for (int i = 0; i < 8; ++i) { ai8[i] = A16[b16 + (size_t)i * 512]; bi8[i] = B16[b16 + (size_t)i * 512]; }
        const size_t base = (size_t)((b * 2 + d) * NPJ) * 512 + 64 * h + c; float A = 1.f, Bv = 0.f;
#pragma unroll 8
        for (int i = lo; i < hi; ++i) { const float ai = AGGA[base + (size_t)i * 512], bi = AGGB[base + (size_t)i * 512]; Bv = ai * Bv + bi; A *= ai; }
        LAS float* FO = (LAS float*)(lds + RG_FOLD); LAS float* F8 = (LAS float*)(lds + RG_F8); LAS float* CAR = (LAS float*)(lds + RG_CAR);
        FO[((d * 4 + s) * 64 + c) * 2] = A; FO[((d * 4 + s) * 64 + c) * 2 + 1] = Bv;
        float A8 = 1.f, B8 = 0.f;
#pragma unroll
        for (int i = 0; i < 8; ++i) { B8 = ai8[i] * B8 + bi8[i]; A8 *= ai8[i]; }
        F8[((d * 4 + s) * 64 + c) * 2] = A8; F8[((d * 4 + s) * 64 + c) * 2 + 1] = B8;
        __syncthreads();
        float S = 0.f;
#pragma unroll
        for (int s2 = 0; s2 < 4; ++s2) S = FO[((d * 4 + s2) * 64 + c) * 2] * S + FO[((d * 4 + s2) * 64 + c) * 2 + 1];
#pragma unroll
        for (int s2 = 0; s2 < 3; ++s2) if (s2 < s) S = F8[((d * 4 + s2) * 64 + c) * 2] * S + F8[((d * 4 + s2) * 64 + c) * 2 + 1];
#pragma unroll
        for (int i = 0; i < 8; ++i) { CAR[(d * 32 + 8 * s + i) * 64 + c] = S; S = ai8[i] * S + bi8[i]; }
    }
    __syncthreads();
    if (wave < (is_ctx ? 4 : 8)) {
        const int j = is_ctx ? wave : 8 * cgp + wave;
        const int seg_lo = is_ctx ? MLAT + b * CTXL : b * SEQ, seg_hi = seg_lo + (is_ctx ? CTXL : SEQ), r0 = seg_lo + 64 * j;
        const int pjf = is_ctx ? j : 4 + j, pjb = is_ctx ? 3 - j : 131 - j;
        LAS unsigned char* wl = lds + RG_WAVE + wave * RG_WAVE_BYTES;
        const float* SP8 = (const float*)(a.ws + WS_SP8);
        const bool fast1 = !__any(SP8[(l * 2 + 1) * 512 + 64 * h + lane] < -0.25f), fast0 = !__any(SP8[(l * 2 + 0) * 512 + 64 * h + lane] < -0.25f);
#pragma unroll 1
        for (int it = 0; it < 2; ++it) { const int D = 1 - it, pj = D ? pjb : pjf; const bool fast = D ? fast1 : fast0;
            if (fast) rg_sweep<FINAL, true>(a, lds, wl, l, b, h, r0, seg_lo, seg_hi, pj, is_ctx, wave, lane, D); else rg_sweep<FINAL, false>(a, lds, wl, l, b, h, r0, seg_lo, seg_hi, pj, is_ctx, wave, lane, D); }
    }
    __syncthreads();
}

#define RLX_AGENT __ATOMIC_RELAXED, __HIP_MEMORY_SCOPE_AGENT


#define XB_TMO      128
#define XB_XCNT(j)  (256  + 64 * (j))
#define XB_XSUB(j)  (1280 + 64 * (j))
#define XB_XGEN(j)  (2304 + 64 * (j))
#define XB_TOP      3328
#define XB_TOPGEN   3392
#define XCD_BAR_WORDS 3456
#define XB_SPIN_CAP (1u << 18)

__device__ __forceinline__ unsigned xb_ld(unsigned* p)              { return __hip_atomic_load(p, __ATOMIC_RELAXED, __HIP_MEMORY_SCOPE_AGENT); }
__device__ __forceinline__ unsigned xb_add(unsigned* p, unsigned v) { return __hip_atomic_fetch_add(p, v, __ATOMIC_RELAXED, __HIP_MEMORY_SCOPE_AGENT); }
__device__ __forceinline__ unsigned xb_xcc_id() { return (unsigned)__builtin_amdgcn_s_getreg((3 << 11) | 20) & 0xFu; }
#define XB_SPIN(cond, bar) do { unsigned _sp = 0; while (cond) { __builtin_amdgcn_s_sleep(1); \
    if ((++_sp & 255u) == 0u) { if (xb_ld(&(bar)[XB_TMO])) break; if (_sp > XB_SPIN_CAP) { atomicAdd(&(bar)[XB_TMO], 1u); break; } } } } while (0)

struct XcdBarrier {
    unsigned* bar; unsigned x;
    volatile LAS unsigned* st;
};

__device__ __forceinline__ XcdBarrier xcd_barrier_post(unsigned* bar, volatile LAS unsigned* st) {
    XcdBarrier b; b.bar = bar; b.x = xb_xcc_id(); b.st = st;
    if (threadIdx.x == 0) (void)xb_add(&bar[XB_XCNT(b.x)], 1u);
    return b;
}
__device__ __forceinline__ void xcd_barrier_complete(unsigned* bar, unsigned x, unsigned& nloc, unsigned& nx) {
    const unsigned G = gridDim.x * gridDim.y * gridDim.z;
    unsigned sum, cnt, mine, sp = 0u;
    for (;;) {
        sum = 0u; cnt = 0u; mine = 0u;
#pragma unroll
        for (unsigned j = 0; j < 16; ++j) { const unsigned c = xb_ld(&bar[XB_XCNT(j)]); sum += c; cnt += (c > 0u) ? 1u : 0u; mine = (j == x) ? c : mine; }
        if (sum == G) break;
        __builtin_amdgcn_s_sleep(1);
        if ((++sp & 255u) == 0u) { if (xb_ld(&bar[XB_TMO])) break; if (sp > XB_SPIN_CAP) { atomicAdd(&bar[XB_TMO], 1u); break; } }
    }
    nloc = mine > 0u ? mine : 1u; nx = cnt > 0u ? cnt : 1u;
}

__device__ __forceinline__ void xcd_barrier(const XcdBarrier& b) {
    asm volatile("s_waitcnt vmcnt(0)" ::: "memory");
    __syncthreads();
    if (threadIdx.x == 0) {
        unsigned* bar = b.bar;
        __builtin_amdgcn_s_waitcnt(0);
        unsigned nloc = b.st[0], nx = b.st[1];
        if (nloc == 0u) { xcd_barrier_complete(bar, b.x, nloc, nx); b.st[0] = nloc; b.st[1] = nx; }
        const unsigned old = xb_add(&bar[XB_XSUB(b.x)], 1u);
        const unsigned gen = old / nloc;
        if (old + 1u == (gen + 1u) * nloc) {
            __builtin_amdgcn_fence(__ATOMIC_RELEASE, "agent");
            asm volatile("s_waitcnt vmcnt(0)" ::: "memory");
            const unsigned og = xb_add(&bar[XB_TOP], 1u);
            const unsigned tg = og / nx;
            if (og + 1u == (tg + 1u) * nx) xb_add(&bar[XB_TOPGEN], 1u);
            else XB_SPIN(xb_ld(&bar[XB_TOPGEN]) == tg, bar);
            __builtin_amdgcn_fence(__ATOMIC_ACQUIRE, "agent");
            xb_add(&bar[XB_XGEN(b.x)], 1u);
            asm volatile("s_waitcnt vmcnt(0)" ::: "memory");
        } else {
            XB_SPIN(xb_ld(&bar[XB_XGEN(b.x)]) == gen, bar);
            __builtin_amdgcn_fence(__ATOMIC_ACQUIRE, "agent");
            asm volatile("s_waitcnt vmcnt(0)" ::: "memory");
        }
    }
    __syncthreads();
}

__device__ __forceinline__ void ctx_mix_tiles(const Args& a, int lane, int wave) {
    const bf16* MIXIN = (const bf16*)(a.ws + WS_MIXIN); const bf16* BT2 = (const bf16*)(a.ws + WS_BT2); bf16* MIX = (bf16*)(a.ws + WS_MIX);
    const int NGW = gridDim.x * NWAVES, fr = lane & 15, fq = lane >> 4;
    for (int t = blockIdx.x * NWAVES + wave; t < 32 * 64; t += NGW) {
        const int rg = t >> 6, cg = t & 63;
        const bf16* ap = MIXIN + (size_t)(MLAT + 16 * rg + fr) * 1024 + 8 * fq;
        const bf16* bp = BT2 + (size_t)(16 * cg + fr) * 1024 + 8 * fq;
        f32x4 acc = {0.f, 0.f, 0.f, 0.f};
#pragma unroll 1
        for (int k0 = 0; k0 < 32; k0 += 8) { v4u av[8], bv[8];
#pragma unroll
            for (int i = 0; i < 8; ++i) { av[i] = *(const v4u*)(ap + 32 * (k0 + i)); bv[i] = *(const v4u*)(bp + 32 * (k0 + i)); }
#pragma unroll
            for (int i = 0; i < 8; ++i) acc = __builtin_amdgcn_mfma_f32_16x16x32_bf16(__builtin_bit_cast(bf16x8, av[i]), __builtin_bit_cast(bf16x8, bv[i]), acc, 0, 0, 0); }
        bf16* op = MIX + (size_t)(MLAT + 16 * rg + 4 * fq) * 1024 + 16 * cg + fr;
#pragma unroll
        for (int j = 0; j < 4; ++j) op[(size_t)j * 1024] = (bf16)(cvtpk(acc[j], acc[j]) & 0xffffu);
    }
}

__device__ __forceinline__ void layer_phases(int l, const Args& args, LAS unsigned char* lds, const int tid0, const int lo, const int hi, const XcdBarrier& xbar) {
    const int G = gridDim.x; unsigned char* ws = args.ws;
    const int pb = 1 + 5 * l;
#define LAUNDER() int tid = tid0; asm volatile("" : "+v"(tid)); const int lane = tid & 63, wave = __builtin_amdgcn_readfirstlane(tid >> 6); int bx = blockIdx.x; asm volatile("" : "+s"(bx)); (void)lane; (void)wave; (void)bx
#define IN(k) (lo <= (k) && (k) < hi)
#define SEAM(k) do { if (IN(k) && IN((k) + 1)) { xcd_barrier(xbar); } } while (0)
        if (IN(pb)) { LAUNDER(); norm_phase(args, l, lane, wave); }
        SEAM(pb);
        if (IN(pb + 1)) { LAUNDER();
            pg8::Gemm g{(const pg8::bf16_t*)(ws + WS_H), (const pg8::bf16_t*)(ws + WS_BT1) + (size_t)l * NIN * 1024, MROWS, NIN, 1024};
            pg8::StaticOrder S; S.init(MROWS, NIN, G, bx);
            pg8::EpiU E{(pg8::bf16_t*)(ws + WS_U)};
            pg8::gemm_phase<pg8::EpiU, pg8::StaticOrder, true, true>(lds, g, S, E);
        }
        SEAM(pb + 1);
        if (IN(pb + 2)) { LAUNDER();
            const int nrun = (bx >= G - 16) ? 2 : 1;
#pragma unroll 1
            for (int k = 0; k < nrun; ++k) rg_run<false>(args, lds, l, k == 0 ? bx : 256 + (G - 1 - bx), tid, lane, wave);
            const int n_h = 256 + (l == 0 ? 16 : 0), n_conv = 128 + n_h;
            const int GC = G - 16;
            for (int un = bx; un < n_conv && bx < GC; un += GC) {
                int grow0, gstride, vlo, vhi, coff, cbase, nrows, ncall, orow0, ostride;
                if (un < 128) { const int bb = un >> 6, w = un & 63; vlo = bb * SEQ + w; vhi = vlo + SEQ; grow0 = vlo - 15 * 64; gstride = 64; coff = 1024 + 256; cbase = 256; nrows = 158; ncall = 2; orow0 = vlo; ostride = 64; }
                else { const int hu = un - 128; int r0, g;
                    if (hu < 256) { r0 = hu * 64; g = 0; vlo = r0; vhi = r0 + 64; }
                    else { const int cu = hu - 256, cc = cu >> 1, bb = cc >> 2; g = cu & 1; r0 = MLAT + cc * 64; vlo = MLAT + bb * CTXL; vhi = vlo + CTXL; }
                    grow0 = r0 - 15; gstride = 1; coff = 1024 + g * 256; cbase = g * 256; nrows = 94; ncall = 1; orow0 = r0; ostride = 1; }
                conv_unit(args, lds, l, grow0, gstride, vlo, vhi, coff, cbase, nrows, ncall, orow0, ostride, tid);
            }
        }
        SEAM(pb + 2);
        if (IN(pb + 3)) { LAUNDER();
            const int nrun = (l == 0 && bx >= G - 16) ? 2 : 1;
#pragma unroll 1
            for (int k = 0; k < nrun; ++k) rg_run<true>(args, lds, l, k == 0 ? bx : 256 + (G - 1 - bx), tid, lane, wave);
            ln_rows(args, l, (l == 0) ? MROWS : MLAT, lane, wave, (l == 0) ? G - 16 : G);
        }
        SEAM(pb + 3);
        if (IN(pb + 4)) { LAUNDER();
            const int M2 = MLAT;
            if (l == 0) ctx_mix_tiles(args, lane, wave);
            pg8::Gemm g{(const pg8::bf16_t*)(ws + WS_MIXIN), (const pg8::bf16_t*)(ws + WS_BT2) + (size_t)l * 1024 * 1024, M2, 1024, 1024};
            pg8::StaticOrder S; S.init(M2, 1024, G, bx);
            pg8::EpiMix E{(pg8::bf16_t*)(ws + WS_MIX) + (size_t)l * MROWS * 1024, nullptr};
            pg8::gemm_phase<pg8::EpiMix, pg8::StaticOrder, true, true>(lds, g, S, E);
        }
        SEAM(pb + 4);
#undef IN
#undef SEAM
#undef LAUNDER
}

__global__ void __launch_bounds__(NTHR, 2) fwd_megakernel(Args args) {
    extern __shared__ __attribute__((aligned(16))) unsigned char lds_raw[];
    LAS unsigned char* lds = (LAS unsigned char*)lds_raw;
    const int tid = threadIdx.x, lane = tid & 63, wave = __builtin_amdgcn_readfirstlane(tid >> 6);
    const int G = gridDim.x, bx = blockIdx.x;
    unsigned char* ws = args.ws;
    const int lo = args.ph_lo, hi = args.ph_hi;
    if (args.coop == 2) cg::this_grid().sync();
    volatile LAS unsigned* MISC = (volatile LAS unsigned*)(lds + MISC_OFF);
    if (tid < 64) MISC[tid] = 0u;
    __syncthreads();
    XcdBarrier xbar; xbar.bar = (unsigned*)(ws + WS_CTL); xbar.x = 0; xbar.st = nullptr;
    if (args.coop == 1) xbar = xcd_barrier_post((unsigned*)(ws + WS_CTL), MISC + 8);
#define IN(k) (lo <= (k) && (k) < hi)
#define SEAM(k) do { if (IN(k) && IN((k) + 1)) { xcd_barrier(xbar); } } while (0)

    if (IN(0)) { p0_prologue(args, lds, tid, lane, wave); }
    SEAM(0);
#pragma unroll 1
    for (int l = 0; l < 2; ++l) { int lo_ = l; asm volatile("" : "+s"(lo_)); layer_phases(lo_, args, lds, tid, lo, hi, xbar); }
    if (IN(11)) { norm_phase(args, 2, lane, wave); }
#undef IN
#undef SEAM
}

#ifndef MK_PER_PHASE
#define MK_PER_PHASE 0
#endif
extern "C" void kernel_launch(void* const* d_in, const int* in_sizes, int n_in, void* d_out, int out_size, void* d_ws, size_t ws_size, hipStream_t stream) {
    static int grid = 0;
    if (grid == 0) {
        if (n_in != 21 || out_size != MLAT * DM || ws_size < WS_END) { fprintf(stderr, "kernel_launch: unexpected shapes (n_in %d, out %d, ws %zu)\n", n_in, out_size, ws_size); grid = -1; return; }
        int dev = 0, cus = 0, per_cu = 0;
        if (hipGetDevice(&dev) != hipSuccess || hipDeviceGetAttribute(&cus, hipDeviceAttributeMultiprocessorCount, dev) != hipSuccess) { grid = -1; return; }
        if (hipFuncSetAttribute((const void*)fwd_megakernel, hipFuncAttributeMaxDynamicSharedMemorySize, LDS_BYTES) != hipSuccess) { fprintf(stderr, "kernel_launch: hipFuncSetAttribute failed\n"); grid = -1; return; }
        if (hipOccupancyMaxActiveBlocksPerMultiprocessor(&per_cu, (const void*)fwd_megakernel, NTHR, LDS_BYTES) != hipSuccess || per_cu < 1) { fprintf(stderr, "kernel_launch: occupancy query says %d\n", per_cu); per_cu = 1; }
        (void)hipGetLastError();
        grid = cus;
    }
    if (grid < 0) return;
    if (hipMemsetAsync((char*)d_ws + WS_CTL, 0, CTL_ZERO_BYTES, stream) != hipSuccess) { fprintf(stderr, "kernel_launch: memset failed\n"); return; }
    Args a{};
    for (int i = 0; i < 21; ++i) a.in[i] = (const float*)d_in[i];
    a.out = (float*)d_out; a.ws = (unsigned char*)d_ws;
#if MK_PER_PHASE
    for (int ph = 0; ph < 12; ++ph) { a.ph_lo = ph; a.ph_hi = ph + 1; a.coop = 0;
        hipLaunchKernelGGL(fwd_megakernel, dim3(grid), dim3(NTHR), LDS_BYTES, stream, a); }
#else
    a.ph_lo = 0; a.ph_hi = 12; a.coop = 1;
    void* kargs[] = {&a};
    hipError_t e = hipLaunchCooperativeKernel((const void*)fwd_megakernel, dim3(grid), dim3(NTHR), kargs, LDS_BYTES, stream);
    if (e != hipSuccess) fprintf(stderr, "cooperative launch failed: %s (grid %d)\n", hipGetErrorString(e), grid);
#endif
}
```

```cpp
#include <hip/hip_runtime.h>
#include <hip/hip_cooperative_groups.h>
#include <cstdio>
#include <cstdint>
namespace cg = cooperative_groups;
#define MK_PER_PHASE 0
namespace pg8 {
#define PG8_LAS __attribute__((address_space(3)))
typedef unsigned short bf16_t;
typedef short bf16x8 __attribute__((ext_vector_type(8)));
typedef float f32x4 __attribute__((ext_vector_type(4)));
typedef unsigned u32x4 __attribute__((ext_vector_type(4)));
constexpr int BM = 256, BK = 64, HALF = 128, HTB = HALF * BK * 2  , STAGE_BYTES = 8 * HTB, NXCD = 8, WGM = 8;

__host__ __device__ __forceinline__ int lds_byte(int r, int c) { const int st = (r >> 4) * 2 + (c >> 5), rr = r & 15, cc = c & 31, ob = rr * 64 + cc * 2; return st * 1024 + (ob ^ (((ob >> 9) & 1) << 5)); }
__host__ __device__ __forceinline__ void stage_rc(int b, int& R, int& C) { const int st = b / 1024, sb = b % 1024, swz = sb ^ (((sb >> 9) & 1) << 5); R = (st >> 1) * 16 + swz / 64; C = (st & 1) * 32 + (swz % 64) / 2; }
__host__ __device__ __forceinline__ int perm32(int rho) { const int n = rho >> 4, i = rho & 15; return 8 * (i >> 2) + 4 * n + (i & 3); }

struct Unit { int pm, pn; };
struct Gemm { const bf16_t* A; const bf16_t* Bt; int M, N, K; };

struct StaticOrder {
    int nM, nN, nwg, G, c;
    __host__ __device__ void init(int M, int N, int G_, int c_) { nM = M / BM; nN = N / BM; nwg = nM * nN; G = G_; c = c_; }
    __host__ __device__ bool next(int i, Unit& u) const {
        const long L = (long)i * G + c; if (L >= nwg) return false;
        int wgid = (int)L; { const int q = nwg / NXCD, r = nwg % NXCD, xcd = wgid % NXCD, off = wgid / NXCD; wgid = (xcd < r ? xcd * (q + 1) : r * (q + 1) + (xcd - r) * q) + off; }
        const int nig = WGM * nN, gid = wgid / nig, fm = gid * WGM, gsz = (nM - fm) < WGM ? (nM - fm) : WGM;
        u.pm = fm + ((wgid % nig) % gsz); u.pn = (wgid % nig) / gsz; return true;
    }
    __device__ __forceinline__ void a_ready(const Unit&) const {}
    __device__ __forceinline__ void done(const Unit&) const {}
};
__device__ __forceinline__ unsigned cvt_pk_bf16(float lo, float hi) { unsigned r; asm volatile("v_cvt_pk_bf16_f32 %0, %1, %2" : "=v"(r) : "v"(lo), "v"(hi)); return r; }
typedef float f32x2 __attribute__((ext_vector_type(2)));
template <class Epi, class Sched, bool ALIGN_EPI = false, bool SP2 = false>
__device__ __forceinline__ void gemm_phase(PG8_LAS unsigned char* lds, const Gemm g, const Sched& S, const Epi& E) {
    const int tid = threadIdx.x, wid = __builtin_amdgcn_readfirstlane(tid >> 6), lane = tid & 63, wr = wid >> 2, wc = wid & 3, fr = lane & 15, fq = lane >> 4;
    const int K = g.K, nt = K / BK;
    unsigned voffA[2], voffB[2];
#pragma unroll
    for (int i = 0; i < 2; ++i) { int R, C; stage_rc(tid * 16 + i * 8192, R, C); const int Rb = Epi::PERM ? ((R & ~31) + perm32(R & 31)) : R;
        voffA[i] = (unsigned)(R * K + C) * 2u; voffB[i] = (unsigned)(Rb * K + C) * 2u; }
    const size_t kstep = (size_t)(BK * 2);
    const size_t hstep = (size_t)HALF * K * 2;
    const size_t tstep = 2 * hstep;
    const unsigned ldsw = (unsigned)wid * 1024u;
    const int aoff = lds_byte(wr * 64 + fr, fq * 8), boff = lds_byte(wc * 32 + fr, fq * 8);
#define PG8_SA(b, h) (((b) * 2 + (h)) * HTB)
#define PG8_SB(b, h) ((4 + (b) * 2 + (h)) * HTB)
#define PG8_STAGE(bufoff, gbase, voff) do { _Pragma("unroll") for (int _i = 0; _i < 2; ++_i) \
        __builtin_amdgcn_global_load_lds((const unsigned*)((const char*)(gbase) + (voff)[_i]), (PG8_LAS unsigned*)(lds + (bufoff) + ldsw + _i * 8192), 16, 0, 0); } while (0)
#define PG8_LDA(dst, b, h) do { _Pragma("unroll") for (int m = 0; m < 4; ++m) _Pragma("unroll") for (int k = 0; k < 2; ++k) dst[m][k] = *(const PG8_LAS bf16x8*)(lds + PG8_SA(b, h) + aoff + m * 2048 + k * 1024); } while (0)
#define PG8_LDB(dst, b, h) do { _Pragma("unroll") for (int n = 0; n < 2; ++n) _Pragma("unroll") for (int k = 0; k < 2; ++k) dst[n][k] = *(const PG8_LAS bf16x8*)(lds + PG8_SB(b, h) + boff + n * 2048 + k * 1024); } while (0)
#define PG8_MMA(ai, bj, At, Bt) do { __builtin_amdgcn_s_setprio(1); _Pragma("unroll") for (int m = 0; m < 4; ++m) _Pragma("unroll") for (int n = 0; n < 2; ++n) _Pragma("unroll") for (int k = 0; k < 2; ++k) \
        acc[ai][bj][m][n] = __builtin_amdgcn_mfma_f32_16x16x32_bf16(Bt[n][k], At[m][k], acc[ai][bj][m][n], 0, 0, 0); __builtin_amdgcn_s_setprio(0); } while (0)
#define PG8_WAIT_V(n) asm volatile("s_waitcnt vmcnt(" #n ")" ::: "memory")
#define PG8_WAIT_L(n) asm volatile("s_waitcnt lgkmcnt(" #n ")" ::: "memory")
#define PG8_BAR __builtin_amdgcn_s_barrier()
#define PG8_SCHED __builtin_amdgcn_sched_barrier(0)
    Unit cur, nxt; int ui = 0;
    if (!S.next(0, cur)) return;
    f32x4 acc[2][2][4][2];
#pragma unroll
    for (int a = 0; a < 2; ++a)
#pragma unroll
        for (int b = 0; b < 2; ++b)
#pragma unroll
            for (int m = 0; m < 4; ++m)
#pragma unroll
                for (int n = 0; n < 2; ++n) acc[a][b][m][n] = (f32x4){0.f, 0.f, 0.f, 0.f};
    bf16x8 At[4][2], B0[2][2], B1[2][2];
    const char* cA = (const char*)g.A + (size_t)cur.pm * tstep; const char* cB = (const char*)g.Bt + (size_t)cur.pn * tstep;
    S.a_ready(cur);
    if constexpr (SP2) {
        PG8_STAGE(PG8_SB(0, 0), cB, voffB); PG8_STAGE(PG8_SB(0, 1), cB + hstep, voffB); PG8_STAGE(PG8_SA(0, 0), cA, voffA); PG8_STAGE(PG8_SA(0, 1), cA + hstep, voffA);
        if (wr == 1) PG8_BAR;
        PG8_WAIT_V(2); PG8_BAR;
        PG8_STAGE(PG8_SB(1, 0), cB + kstep, voffB); PG8_STAGE(PG8_SA(1, 0), cA + kstep, voffA); PG8_STAGE(PG8_SB(1, 1), cB + hstep + kstep, voffB);
        PG8_WAIT_V(6); PG8_BAR;
    } else {
        PG8_STAGE(PG8_SB(0, 0), cB, voffB); PG8_STAGE(PG8_SA(0, 0), cA, voffA); PG8_STAGE(PG8_SB(0, 1), cB + hstep, voffB); PG8_STAGE(PG8_SA(0, 1), cA + hstep, voffA);
        if (wr == 1) PG8_BAR;
        PG8_WAIT_V(4); PG8_BAR;
        PG8_STAGE(PG8_SB(1, 0), cB + kstep, voffB); PG8_STAGE(PG8_SA(1, 0), cA + kstep, voffA); PG8_STAGE(PG8_SB(1, 1), cB + hstep + kstep, voffB);
        PG8_WAIT_V(6); PG8_BAR;
    }
    for (;;) {
        const bool has_next = S.next(ui + 1, nxt);
        const char* nA = has_next ? (const char*)g.A + (size_t)nxt.pm * tstep : cA; const char* nB = has_next ? (const char*)g.Bt + (size_t)nxt.pn * tstep : cB;
        for (int t = 0; t < nt; t += 2) {
            const bool last = (t == nt - 2);
            const char* a1 = cA + (size_t)(t + 1) * kstep;
            const char* a2 = last ? nA : cA + (size_t)(t + 2) * kstep; const char* b2 = last ? nB : cB + (size_t)(t + 2) * kstep;
            const char* a3 = a2 + kstep; const char* b3 = b2 + kstep;
            if (last && has_next) S.a_ready(nxt);
            if constexpr (SP2) {
            PG8_LDB(B0, 0, 0); PG8_LDB(B1, 0, 1); PG8_SCHED; PG8_LDA(At, 0, 0); PG8_STAGE(PG8_SA(1, 1), a1 + hstep, voffA);
            PG8_WAIT_V(8); PG8_WAIT_L(0); PG8_BAR; PG8_MMA(0, 0, At, B0); PG8_MMA(0, 1, At, B1); PG8_BAR; PG8_SCHED;
            PG8_LDA(At, 0, 1); PG8_STAGE(PG8_SB(0, 0), b2, voffB); PG8_STAGE(PG8_SB(0, 1), b2 + hstep, voffB); PG8_STAGE(PG8_SA(0, 0), a2, voffA);
            PG8_WAIT_V(8); PG8_WAIT_L(0); PG8_BAR; PG8_MMA(1, 0, At, B0); PG8_MMA(1, 1, At, B1); PG8_BAR; PG8_SCHED;
            PG8_LDB(B0, 1, 0); PG8_LDB(B1, 1, 1); PG8_SCHED; PG8_LDA(At, 1, 0); PG8_STAGE(PG8_SA(0, 1), a2 + hstep, voffA);
            PG8_WAIT_V(8); PG8_WAIT_L(0); PG8_BAR; PG8_MMA(0, 0, At, B0); PG8_MMA(0, 1, At, B1); PG8_BAR; PG8_SCHED;
            PG8_LDA(At, 1, 1); PG8_STAGE(PG8_SB(1, 0), b3, voffB); PG8_STAGE(PG8_SB(1, 1), b3 + hstep, voffB); PG8_STAGE(PG8_SA(1, 0), a3, voffA);
            PG8_WAIT_V(8); PG8_WAIT_L(0); PG8_BAR; PG8_MMA(1, 0, At, B0); PG8_MMA(1, 1, At, B1); PG8_BAR; PG8_SCHED;
            } else {
            PG8_LDB(B0, 0, 0); PG8_SCHED; PG8_LDA(At, 0, 0); PG8_STAGE(PG8_SA(1, 1), a1 + hstep, voffA);
            PG8_WAIT_L(8); PG8_BAR; PG8_WAIT_L(0); PG8_MMA(0, 0, At, B0); PG8_BAR; PG8_SCHED;
            PG8_LDB(B1, 0, 1); PG8_STAGE(PG8_SB(0, 0), b2, voffB);
            PG8_BAR; PG8_WAIT_L(0); PG8_MMA(0, 1, At, B1); PG8_BAR;
            PG8_LDA(At, 0, 1); PG8_STAGE(PG8_SA(0, 0), a2, voffA);
            PG8_BAR; PG8_WAIT_L(0); PG8_MMA(1, 0, At, B0); PG8_BAR; PG8_SCHED;
            PG8_STAGE(PG8_SB(0, 1), b2 + hstep, voffB);
            PG8_WAIT_V(6); PG8_BAR; PG8_MMA(1, 1, At, B1); PG8_BAR;
            PG8_LDB(B0, 1, 0); PG8_SCHED; PG8_LDA(At, 1, 0); PG8_STAGE(PG8_SA(0, 1), a2 + hstep, voffA);
            PG8_WAIT_L(8); PG8_BAR; PG8_WAIT_L(0); PG8_MMA(0, 0, At, B0); PG8_BAR; PG8_SCHED;
            PG8_LDB(B1, 1, 1); PG8_STAGE(PG8_SB(1, 0), b3, voffB);
            PG8_BAR; PG8_WAIT_L(0); PG8_MMA(0, 1, At, B1); PG8_BAR;
            PG8_LDA(At, 1, 1); PG8_STAGE(PG8_SA(1, 0), a3, voffA);
            PG8_BAR; PG8_WAIT_L(0); PG8_MMA(1, 0, At, B0); PG8_BAR; PG8_SCHED;
            PG8_STAGE(PG8_SB(1, 1), b3 + hstep, voffB);
            PG8_WAIT_V(6); PG8_BAR; PG8_MMA(1, 1, At, B1); PG8_BAR;
            }
        }
        if constexpr (ALIGN_EPI) { if (wr == 0) PG8_BAR; }
        if constexpr (!Epi::AFTER_DRAIN) { E(acc, cur, wr, wc, fr, fq); S.done(cur); }
        if (!has_next) break;
#pragma unroll
        for (int a = 0; a < 2; ++a)
#pragma unroll
            for (int b = 0; b < 2; ++b)
#pragma unroll
                for (int m = 0; m < 4; ++m)
#pragma unroll
                    for (int n = 0; n < 2; ++n) acc[a][b][m][n] = (f32x4){0.f, 0.f, 0.f, 0.f};
        cur = nxt; cA = nA; cB = nB; ++ui;
        if constexpr (ALIGN_EPI) { if (wr == 1) PG8_BAR; }
    }
    PG8_WAIT_V(0);
    if constexpr (!ALIGN_EPI) { if (wr == 0) PG8_BAR; }
    PG8_BAR;
    if constexpr (Epi::AFTER_DRAIN) { E.fused(acc, cur, wr, wc, fr, fq, lds, wid, lane); S.done(cur); }
#undef PG8_SA
#undef PG8_SB
#undef PG8_STAGE
#undef PG8_LDA
#undef PG8_LDB
#undef PG8_MMA
#undef PG8_WAIT_V
#undef PG8_WAIT_L
#undef PG8_BAR
#undef PG8_SCHED
}
}

constexpr int DM = 1024, NB = 2, SEQ = 8192, CTXL = 256, MLAT = NB * SEQ, MCTX = NB * CTXL, MROWS = MLAT + MCTX;
constexpr int NIN = 2560, NCHUNK = MROWS / 64  , NPJ = 132  ;
constexpr float EPSF = 1e-6f;
constexpr int NWAVES = 8, NTHR = 512;

constexpr size_t MiB = 1u << 20;
constexpr size_t WS_CTL = 0, CTL_ZERO_BYTES = 64 * 1024;
constexpr size_t WS_MOD = 1 * MiB;
constexpr size_t WS_SP8 = 1 * MiB + 128 * 1024;
constexpr size_t WS_GWF = 1 * MiB + 256 * 1024;
constexpr size_t WS_BT1 = 2 * MiB;
constexpr size_t WS_BT2 = 12 * MiB;
constexpr size_t WS_AGGA = 16 * MiB;
constexpr size_t WS_AGGB = 16 * MiB + 1536 * 1024;
constexpr size_t WS_SSQ = 19 * MiB;
constexpr size_t WS_SSQ1 = 21 * MiB;
constexpr size_t WS_A16 = 23 * MiB;
constexpr size_t WS_B16 = 28 * MiB;
constexpr size_t WS_H = 73 * MiB;
constexpr size_t WS_Y = 56 * MiB;
constexpr size_t WS_MIXIN = 73 * MiB;
constexpr size_t WS_U = 106 * MiB;
constexpr size_t WS_MIX = 189 * MiB;
constexpr size_t WS_END = 255 * MiB;

constexpr int LDS_BYTES = 158720;
constexpr int MISC_OFF = 157696;

#define LAS __attribute__((address_space(3)))
typedef unsigned short bf16;
typedef unsigned v4u __attribute__((ext_vector_type(4)));
typedef unsigned v2u __attribute__((ext_vector_type(2)));
typedef float f32x4 __attribute__((ext_vector_type(4)));
typedef short bf16x8 __attribute__((ext_vector_type(8)));
typedef float f32x2v __attribute__((ext_vector_type(2)));
#define LDS_WAIT() asm volatile("s_waitcnt lgkmcnt(0)" ::: "memory")

__device__ __forceinline__ unsigned f2bf(float f) { unsigned u = __builtin_bit_cast(unsigned, f); return (u + 0x7fffu + ((u >> 16) & 1u)) >> 16; }
__device__ __forceinline__ unsigned pk2(float lo, float hi) { return f2bf(lo) | (f2bf(hi) << 16); }
__device__ __forceinline__ unsigned cvtpk(float lo, float hi) { unsigned r; asm volatile("v_cvt_pk_bf16_f32 %0, %1, %2" : "=v"(r) : "v"(lo), "v"(hi)); return r; }
__device__ __forceinline__ float bflo(unsigned u) { return __builtin_bit_cast(float, u << 16); }
__device__ __forceinline__ float bfhi(unsigned u) { return __builtin_bit_cast(float, u & 0xffff0000u); }
__device__ __forceinline__ float sigmoidf_(float x) { return 1.0f / (1.0f + __expf(-x)); }
__device__ __forceinline__ float siluf_(float x) { return x * __builtin_amdgcn_rcpf(1.0f + __builtin_amdgcn_exp2f(-1.44269504f * x)); }
__device__ __forceinline__ float wave_sum(float v) {
#pragma unroll
    for (int o = 1; o < 64; o <<= 1) v += __shfl_xor(v, o);
    return v;
}

struct Args {
    const float* in[21]; float* out; unsigned char* ws; int ph_lo, ph_hi, coop, pad;
};
enum { I_X = 0, I_C, I_CTX, I_CCTX, I_WMOD, I_BMOD, I_GPRE, I_GPOST, I_WIN, I_CAW, I_CAB, I_WR, I_BR, I_WI, I_BI, I_LAM, I_DWW, I_DWB, I_LNG, I_LNB, I_WOUT };

namespace pg8 {
__device__ __forceinline__ void st16_wt(void* p, u32x4 w) { asm volatile("global_store_dwordx4 %0, %1, off sc1\n\ts_nop 1" :: "v"(p), "v"(w) : "memory"); }
struct EpiU {
    static constexpr bool PERM = true, AFTER_DRAIN = false;
    bf16_t* O;
    __device__ __forceinline__ void operator()(const f32x4 (&acc)[2][2][4][2], const Unit& u, int wr, int wc, int fr, int fq) const {
        const int row0 = u.pm * BM + wr * 64 + fr;
        if (u.pn >= 4 && u.pn < 8) {
            const int col0 = 1024 + 128 * (u.pn - 4) + wc * 32 + 8 * fq;
#pragma unroll
            for (int ai = 0; ai < 2; ++ai)
#pragma unroll
                for (int m = 0; m < 4; ++m) { f32x4 v0 = acc[ai][0][m][0], v1 = acc[ai][0][m][1]; const f32x4 g0 = acc[ai][1][m][0], g1 = acc[ai][1][m][1];
#pragma unroll
                    for (int e = 0; e < 4; ++e) { v0[e] = v0[e] * __builtin_amdgcn_rcpf(1.0f + __builtin_amdgcn_exp2f(-1.44269504f * g0[e])); v1[e] = v1[e] * __builtin_amdgcn_rcpf(1.0f + __builtin_amdgcn_exp2f(-1.44269504f * g1[e])); }
                    u32x4 w; w.x = cvt_pk_bf16(v0[0], v0[1]); w.y = cvt_pk_bf16(v0[2], v0[3]); w.z = cvt_pk_bf16(v1[0], v1[1]); w.w = cvt_pk_bf16(v1[2], v1[3]);
                    *(u32x4*)(O + (size_t)(row0 + ai * HALF + m * 16) * 2560 + col0) = w; }
            return;
        }
        const int col0 = u.pn * BM + wc * 32 + 8 * fq;
        const bool act = (u.pn == 2 || u.pn == 3 || u.pn >= 8);
#pragma unroll
        for (int ai = 0; ai < 2; ++ai)
#pragma unroll
            for (int m = 0; m < 4; ++m) { bf16_t* rowp = O + (size_t)(row0 + ai * HALF + m * 16) * 2560 + col0;
#pragma unroll
                for (int bj = 0; bj < 2; ++bj) { f32x4 v0 = acc[ai][bj][m][0], v1 = acc[ai][bj][m][1];
                    if (act) {
#pragma unroll
                        for (int e = 0; e < 4; ++e) { v0[e] = v0[e] * __builtin_amdgcn_rcpf(1.0f + __builtin_amdgcn_exp2f(-1.44269504f * v0[e])); v1[e] = v1[e] * __builtin_amdgcn_rcpf(1.0f + __builtin_amdgcn_exp2f(-1.44269504f * v1[e])); }
                    }
                    u32x4 w; w.x = cvt_pk_bf16(v0[0], v0[1]); w.y = cvt_pk_bf16(v0[2], v0[3]); w.z = cvt_pk_bf16(v1[0], v1[1]); w.w = cvt_pk_bf16(v1[2], v1[3]);
                    *(u32x4*)(rowp + bj * HALF) = w; } }
    }
};
struct EpiMix {
    static constexpr bool PERM = true, AFTER_DRAIN = false;
    bf16_t* O; unsigned* cnt;
    __device__ __forceinline__ void operator()(const f32x4 (&acc)[2][2][4][2], const Unit& u, int wr, int wc, int fr, int fq) const {
        const int col0 = u.pn * BM + wc * 32 + 8 * fq;
#pragma unroll
        for (int ai = 0; ai < 2; ++ai)
#pragma unroll
            for (int m = 0; m < 4; ++m) { const int r = u.pm * BM + ai * HALF + wr * 64 + m * 16 + fr; bf16_t* rowp = O + (size_t)r * 1024 + col0;
#pragma unroll
                for (int bj = 0; bj < 2; ++bj) { const f32x4 v0 = acc[ai][bj][m][0], v1 = acc[ai][bj][m][1];
                    u32x4 w; w.x = cvt_pk_bf16(v0[0], v0[1]); w.y = cvt_pk_bf16(v0[2], v0[3]); w.z = cvt_pk_bf16(v1[0], v1[1]); w.w = cvt_pk_bf16(v1[2], v1[3]);
                    if (cnt) st16_wt(rowp + bj * HALF, w); else *(u32x4*)(rowp + bj * HALF) = w; } }
        if (cnt) { asm volatile("s_waitcnt vmcnt(0)" ::: "memory");
            if (fr == 0 && fq == 0) __hip_atomic_fetch_add(cnt + 64 * u.pm, 1u, __ATOMIC_RELAXED, __HIP_MEMORY_SCOPE_AGENT); }
    }
};
}

__device__ __forceinline__ void p0_transpose_item(const float* W, int K, int N, bf16* WT, LAS float* scr, int item, int lane, bool glu_remap) {
    const int nblk = N / 32, kb = item / nblk, nb = item % nblk, k0 = 64 * kb, n0 = 32 * nb;
    int nd = n0;
    if (glu_remap) { if (n0 >= 1024 && n0 < 1536) nd = 1024 + 256 * ((n0 - 1024) >> 7) + ((n0 - 1024) & 127); else if (n0 >= 1536 && n0 < 2048) nd = 1024 + 256 * ((n0 - 1536) >> 7) + 128 + ((n0 - 1536) & 127); }
#pragma unroll 8
    for (int i = 0; i < 32; ++i) { const int kk = 2 * i + (lane >> 5); scr[kk * 33 + (lane & 31)] = W[(size_t)(k0 + kk) * N + n0 + (lane & 31)]; }
    LDS_WAIT(); asm volatile("" ::: "memory");
    const int c = lane & 7;
#pragma unroll
    for (int j = 0; j < 4; ++j) { const int n = (lane >> 3) + 8 * j; const LAS float* s = scr + (8 * c) * 33 + n;
        v4u o; o.x = pk2(s[0 * 33], s[1 * 33]); o.y = pk2(s[2 * 33], s[3 * 33]); o.z = pk2(s[4 * 33], s[5 * 33]); o.w = pk2(s[6 * 33], s[7 * 33]);
        *(v4u*)(WT + (size_t)(nd + n) * K + k0 + 8 * c) = o; }
    LDS_WAIT(); asm volatile("" ::: "memory");
}

__device__ __forceinline__ void p0_prologue(const Args& a, LAS unsigned char* lds, int tid, int lane, int wave) {
    const int G = gridDim.x, bx = blockIdx.x;
    unsigned char* ws = a.ws;
    {
        LAS float* part = (LAS float*)lds;
        float* MOD = (float*)(ws + WS_MOD);
        const float* c = a.in[I_C]; const float* cctx = a.in[I_CCTX];
        for (int un = bx; un < 192; un += G) {
            const int l = un / 96, n0 = (un % 96) * 32, cq = tid & 7, ks = tid >> 3;
            const float* wm = a.in[I_WMOD] + (size_t)l * 1024 * 3072 + n0 + cq * 4;
            f32x4 acc0 = {0.f, 0.f, 0.f, 0.f}, acc1 = acc0, acc2 = acc0;
#pragma unroll 4
            for (int kk = 0; kk < 16; ++kk) { const int k = ks * 16 + kk; const f32x4 w = *(const f32x4*)(wm + (size_t)k * 3072);
                const float a0 = siluf_(c[k]), a1 = siluf_(c[1024 + k]), a2 = siluf_(cctx[k]);
                acc0 += w * a0; acc1 += w * a1; acc2 += w * a2; }
            *(LAS f32x4*)(part + (0 * 64 + ks) * 32 + cq * 4) = acc0;
            *(LAS f32x4*)(part + (1 * 64 + ks) * 32 + cq * 4) = acc1;
            *(LAS f32x4*)(part + (2 * 64 + ks) * 32 + cq * 4) = acc2;
            __syncthreads();
            if (tid < 96) { const int v = tid >> 5, col = tid & 31; float s = a.in[I_BMOD][l * 3072 + n0 + col];
                for (int k2 = 0; k2 < 64; ++k2) s += part[(v * 64 + k2) * 32 + col];
                MOD[(l * 3 + v) * 3072 + n0 + col] = s; }
            __syncthreads();
        }
    }
    { float* SP8 = (float*)(ws + WS_SP8); for (int idx = bx * NTHR + tid; idx < 2048; idx += G * NTHR) SP8[idx] = -8.0f * log1pf(__expf(-a.in[I_LAM][idx])); }
    {
        v4u* GWF = (v4u*)(ws + WS_GWF);
        for (int idx = bx * NTHR + tid; idx < 32768; idx += G * NTHR) {
            const int ln = idx & 63, kk = (idx >> 6) & 1, ct = (idx >> 7) & 3, h = (idx >> 9) & 7, g = (idx >> 12) & 1, d = (idx >> 13) & 1, l = idx >> 14;
            const float* W = (g == 0 ? a.in[I_WR] : a.in[I_WI]) + (size_t)(((l * 2 + d) * 8 + h) * 64) * 64;
            const int k0 = 32 * kk + 8 * (ln >> 4), col = 16 * ct + (ln & 15);
            float e[8];
#pragma unroll
            for (int j = 0; j < 8; ++j) e[j] = W[(k0 + j) * 64 + col];
            v4u o; o.x = pk2(e[0], e[1]); o.y = pk2(e[2], e[3]); o.z = pk2(e[4], e[5]); o.w = pk2(e[6], e[7]);
            GWF[idx] = o;
        }
    }
    {
        LAS float* scr = (LAS float*)(lds + wave * 16384);
        const int gw = bx * NWAVES + wave, NGW = G * NWAVES;
        constexpr int I_1 = (1024 / 64) * (NIN / 32), I_2 = (1024 / 64) * (1024 / 32), NITEMS = 2 * (I_1 + I_2);
        bf16* BT1 = (bf16*)(ws + WS_BT1); bf16* BT2 = (bf16*)(ws + WS_BT2);
        for (int it = gw; it < NITEMS; it += NGW) {
            int r = it;
            if (r < I_1) { p0_transpose_item(a.in[I_WIN], 1024, NIN, BT1, scr, r, lane, true); continue; } r -= I_1;
            if (r < I_1) { p0_transpose_item(a.in[I_WIN] + (size_t)1024 * NIN, 1024, NIN, BT1 + (size_t)NIN * 1024, scr, r, lane, true); continue; } r -= I_1;
            if (r < I_2) { p0_transpose_item(a.in[I_WOUT], 1024, 1024, BT2, scr, r, lane, false); continue; } r -= I_2;
            p0_transpose_item(a.in[I_WOUT] + (size_t)1024 * 1024, 1024, 1024, BT2 + (size_t)1024 * 1024, scr, r, lane, false);
        }
    }
}

__device__ __forceinline__ void norm_phase(const Args& a, int mode, int lane, int wave) {
    unsigned char* ws = a.ws;
    const float* MOD = (const float*)(ws + WS_MOD); bf16* H = (bf16*)(ws + WS_H);
    const int gw = blockIdx.x * NWAVES + wave, NGW = gridDim.x * NWAVES;
    const int nrows = (mode == 2) ? MLAT : MROWS, ln = (mode == 0) ? 0 : 1;
    int cur = -1;
    f32x4 pg0[4], pg1[4], pa[4], ps[4];
#pragma unroll
    for (int j = 0; j < 4; ++j) { pg0[j] = pg1[j] = pa[j] = ps[j] = (f32x4){0.f, 0.f, 0.f, 0.f}; }
    for (int row = gw; row < nrows; row += NGW) {
        const int vsel = row < MLAT ? (row >> 13) : 2;
        const float* src = row < MLAT ? a.in[I_X] + (size_t)row * 1024 : a.in[I_CTX] + (size_t)(row - MLAT) * 1024;
        f32x4 v[4];
#pragma unroll
        for (int j = 0; j < 4; ++j) v[j] = *((const f32x4*)src + lane + 64 * j);
        if (vsel != cur) { cur = vsel;
            if (mode >= 1) { const float* gate = MOD + (0 * 3 + vsel) * 3072 + 2048; const float* gp = a.in[I_GPOST];
#pragma unroll
                for (int j = 0; j < 4; ++j) pg0[j] = *((const f32x4*)gate + lane + 64 * j) * *((const f32x4*)gp + lane + 64 * j); }
            if (mode == 2) { const float* gate = MOD + (1 * 3 + vsel) * 3072 + 2048; const float* gp = a.in[I_GPOST] + 1024;
#pragma unroll
                for (int j = 0; j < 4; ++j) pg1[j] = *((const f32x4*)gate + lane + 64 * j) * *((const f32x4*)gp + lane + 64 * j); }
            if (mode <= 1) { const float* shift = MOD + (ln * 3 + vsel) * 3072; const float* scale = shift + 1024; const float* gpre = a.in[I_GPRE] + ln * 1024;
#pragma unroll
                for (int j = 0; j < 4; ++j) { pa[j] = *((const f32x4*)gpre + lane + 64 * j) * (*((const f32x4*)scale + lane + 64 * j) + 1.0f); ps[j] = *((const f32x4*)shift + lane + 64 * j); } }
        }
#pragma unroll
        for (int lu = 0; lu < 2; ++lu) if (lu < mode) {
            const bf16* MIX = (const bf16*)(ws + WS_MIX) + (size_t)lu * MROWS * 1024;
            f32x4 mx[4]; float sp = 0.f;
#pragma unroll
            for (int j = 0; j < 4; ++j) { const v2u mq = *((const v2u*)(MIX + (size_t)row * 1024) + lane + 64 * j); mx[j] = (f32x4){bflo(mq.x), bfhi(mq.x), bflo(mq.y), bfhi(mq.y)};
                sp += (mx[j].x * mx[j].x + mx[j].y * mx[j].y) + (mx[j].z * mx[j].z + mx[j].w * mx[j].w); }
            const float rstd = rsqrtf(wave_sum(sp) * (1.0f / 1024.0f) + EPSF);
#pragma unroll
            for (int j = 0; j < 4; ++j) v[j] += (lu ? pg1[j] : pg0[j]) * (mx[j] * rstd);
        }
        if (mode == 2) {
            float* dst = a.out + (size_t)row * 1024;
#pragma unroll
            for (int j = 0; j < 4; ++j) *((f32x4*)dst + lane + 64 * j) = v[j];
        } else {
            float s2 = 0.f;
#pragma unroll
            for (int j = 0; j < 4; ++j) s2 += (v[j].x * v[j].x + v[j].y * v[j].y) + (v[j].z * v[j].z + v[j].w * v[j].w);
            const float r = rsqrtf(wave_sum(s2) * (1.0f / 1024.0f) + EPSF);
            v2u* o8 = (v2u*)(H + (size_t)row * 1024);
#pragma unroll
            for (int j = 0; j < 4; ++j) { const f32x4 hv = v[j] * r * pa[j] + ps[j];
                v2u w; w.x = cvtpk(hv.x, hv.y); w.y = cvtpk(hv.z, hv.w); o8[lane + 64 * j] = w; }
        }
    }
}

__device__ __forceinline__ void conv16(const LAS unsigned* vt, const f32x2v (&w2)[31], const f32x2v b2, bf16* ybase, size_t ystride) {
#pragma unroll 1
    for (int tq = 0; tq < 4; ++tq) {
        const LAS unsigned* vq = vt + tq * 4 * 128;
        f32x2v acc[4];
#pragma unroll
        for (int t = 0; t < 4; ++t) acc[t] = b2;
#pragma unroll
        for (int rr = 0; rr < 34; ++rr) { const unsigned u = vq[rr * 128]; const f32x2v x = {bflo(u), bfhi(u)};
#pragma unroll
            for (int t = 0; t < 4; ++t) { const int k = rr - t; if (k >= 0 && k < 31) acc[t] += w2[k] * x; }
            if ((rr & 7) == 7) asm volatile("" ::: "memory"); }
#pragma unroll
        for (int t = 0; t < 4; ++t) *(unsigned*)(ybase + (size_t)(tq * 4 + t) * ystride) = cvtpk(acc[t].x, acc[t].y);
    }
}
__device__ __forceinline__ v4u glu8(const v4u vq, const v4u gq) {
    v4u o;
    o.x = pk2(bflo(vq.x) * sigmoidf_(bflo(gq.x)), bfhi(vq.x) * sigmoidf_(bfhi(gq.x)));
    o.y = pk2(bflo(vq.y) * sigmoidf_(bflo(gq.y)), bfhi(vq.y) * sigmoidf_(bfhi(gq.y)));
    o.z = pk2(bflo(vq.z) * sigmoidf_(bflo(gq.z)), bfhi(vq.z) * sigmoidf_(bfhi(gq.z)));
    o.w = pk2(bflo(vq.w) * sigmoidf_(bflo(gq.w)), bfhi(vq.w) * sigmoidf_(bfhi(gq.w)));
    return o;
}
__device__ __forceinline__ void conv_unit(const Args& a, LAS unsigned char* lds, int l, int grow0, int gstride, int vlo, int vhi, int coff, int cbase, int nrows, int ncall, int orow0, int ostride, int tid) {
    const bf16* U = (const bf16*)(a.ws + WS_U); bf16* Y = (bf16*)(a.ws + WS_Y);
    LAS unsigned* VT = (LAS unsigned*)lds;
    int p = tid & 127; asm volatile("" : "+v"(p));
    const int tg = tid >> 7, c0 = cbase + 2 * p;
    f32x2v w2[31];
#pragma unroll
    for (int k = 0; k < 31; ++k) w2[k] = *(const f32x2v*)(a.in[I_DWW] + (size_t)(l * 31 + k) * 512 + c0);
    const f32x2v b2 = *(const f32x2v*)(a.in[I_DWB] + l * 512 + c0);
    const int nchunk = nrows * 32;
#pragma unroll 1
    for (int i0 = tid; i0 < nchunk; i0 += 3 * NTHR) {
        v4u vq[3];
#pragma unroll
        for (int it = 0; it < 3; ++it) { const int i = i0 + it * NTHR, rr = i >> 5, ch = i & 31, row = grow0 + rr * gstride; const bool ok = i < nchunk && row >= vlo && row < vhi;
            vq[it] = (v4u){0u, 0u, 0u, 0u}; if (ok) vq[it] = *(const v4u*)(U + (size_t)row * NIN + coff + ch * 8); }
#pragma unroll
        for (int it = 0; it < 3; ++it) { const int i = i0 + it * NTHR, rr = i >> 5, ch = i & 31, row = grow0 + rr * gstride; const bool ok = row >= vlo && row < vhi;
            if (i < nchunk) { const v4u z = {0u, 0u, 0u, 0u}; *(LAS v4u*)(VT + rr * 128 + ch * 4) = ok ? vq[it] : z; } }
    }
    __syncthreads();
#pragma unroll 1
    for (int hc = 0; hc < ncall; ++hc) { const int tb = (tg * ncall + hc) * 16;
        conv16(VT + tb * 128 + p, w2, b2, Y + (size_t)(orow0 + tb * ostride) * 512 + c0, (size_t)ostride * 512); }
    __syncthreads();
}
__device__ __forceinline__ void ln_rows(const Args& a, int l, int nrows, int lane, int wave, int nblk) {
    const bf16* U = (const bf16*)(a.ws + WS_U); const bf16* Y = (const bf16*)(a.ws + WS_Y); bf16* MIXIN = (bf16*)(a.ws + WS_MIXIN);
    if ((int)blockIdx.x >= nblk) return;
    const int gw = blockIdx.x * NWAVES + wave, NGW = nblk * NWAVES, c0 = lane * 8;
    float lg[8], lb[8];
#pragma unroll
    for (int e = 0; e < 8; ++e) { lg[e] = a.in[I_LNG][l * 512 + c0 + e]; lb[e] = a.in[I_LNB][l * 512 + c0 + e]; }
    for (int row = gw; row < nrows; row += NGW) {
        const v4u yq = *(const v4u*)(Y + (size_t)row * 512 + c0); const v4u gq = *(const v4u*)(U + (size_t)row * NIN + 2048 + c0);
        float y[8] = {bflo(yq.x), bfhi(yq.x), bflo(yq.y), bfhi(yq.y), bflo(yq.z), bfhi(yq.z), bflo(yq.w), bfhi(yq.w)};
        const float gt[8] = {bflo(gq.x), bfhi(gq.x), bflo(gq.y), bfhi(gq.y), bflo(gq.z), bfhi(gq.z), bflo(gq.w), bfhi(gq.w)};
        float s = 0.f;
#pragma unroll
        for (int e = 0; e < 8; ++e) s += y[e];
        const float mean = wave_sum(s) * (1.0f / 512.0f); float q = 0.f;
#pragma unroll
        for (int e = 0; e < 8; ++e) { y[e] -= mean; q += y[e] * y[e]; }
        const float rstd = rsqrtf(wave_sum(q) * (1.0f / 512.0f) + EPSF);
        float o[8];
#pragma unroll
        for (int e = 0; e < 8; ++e) o[e] = siluf_(y[e] * rstd * lg[e] + lb[e]) * gt[e];
        v4u w; w.x = pk2(o[0], o[1]); w.y = pk2(o[2], o[3]); w.z = pk2(o[4], o[5]); w.w = pk2(o[6], o[7]);
        *(v4u*)(MIXIN + (size_t)row * 1024 + 512 + c0) = w;
    }
}

constexpr int RG_GW = 0, RG_FOLD = 32768, RG_F8 = 36864, RG_CAR = 40960, RG_WAVE = 57344, RG_WAVE_BYTES = 12544;
constexpr int NP16 = 4 * NPJ;
__device__ __forceinline__ float fsig(float x) { return __builtin_amdgcn_rcpf(1.0f + __expf(-x)); }

template <bool FINAL, bool FASTP>
__device__ __forceinline__ void rg_sweep(const Args& a, LAS unsigned char* lds, LAS unsigned char* wl, int l, int b, int h, int r0, int seg_lo, int seg_hi, int pj, bool is_ctx, int w, int lane, const int D) {
    const bf16* U = (const bf16*)(a.ws + WS_U); bf16* MIXIN = (bf16*)(a.ws + WS_MIXIN);
    float* AGGA = (float*)(a.ws + WS_AGGA); float* AGGB = (float*)(a.ws + WS_AGGB); float* A16 = (float*)(a.ws + WS_A16); float* B16 = (float*)(a.ws + WS_B16);
    LAS float* VCW = (LAS float*)wl; LAS unsigned* HBW = (LAS unsigned*)(wl + 4352);
    const LAS v4u* GWL = (const LAS v4u*)(lds + RG_GW) + (D * 2) * 8 * 64 + lane;
    const LAS float* CAR = (const LAS float*)(lds + RG_CAR);
    const int fr = lane & 15, fq = lane >> 4, cp = lane & 31, rh = lane >> 5;
    const int rbase = D ? r0 + 63 : r0, rsign = D ? -1 : 1;
    float2 cw[4];
#pragma unroll
    for (int k = 0; k < 4; ++k) cw[k] = *(const float2*)(a.in[I_CAW] + (size_t)((l * 2 + D) * 4 + (D ? 3 - k : k)) * 512 + 64 * h + 2 * cp);
    const float2 cbv = *(const float2*)(a.in[I_CAB] + (l * 2 + D) * 512 + 64 * h + 2 * cp);
    float brv[4], biv[4], sp8[4], Hc[4], Ac[4];
    const int p16own = 4 * pj + fq;
#pragma unroll
    for (int ct = 0; ct < 4; ++ct) { const int c = 16 * ct + fr, pidx = (l * 2 + D) * 512 + 64 * h + c;
        brv[ct] = a.in[I_BR][pidx]; biv[ct] = a.in[I_BI][pidx]; sp8[ct] = ((const float*)(a.ws + WS_SP8))[pidx];
        Hc[ct] = 0.f; Ac[ct] = 1.f;
        if (FINAL) {
            if (is_ctx) { const size_t base = (size_t)((b * 2 + D) * NP16) * 512 + 64 * h + c; float S = 0.f;
                for (int i = 0; i < p16own; ++i) S = A16[base + (size_t)i * 512] * S + B16[base + (size_t)i * 512];
                Hc[ct] = S; }
            else Hc[ct] = CAR[(D * 32 + 4 * (D ? 7 - w : w) + fq) * 64 + c];
        } }
    const bf16* ub = U + 64 * h + 2 * cp;
    unsigned Wd[2][7], nx[2][4];
#pragma unroll
    for (int q = 0; q < 2; ++q) { const int g = 2 * rh + q;
#pragma unroll
        for (int j = 0; j < 3; ++j) { const int row = rbase + rsign * (16 * g - 3 + j); const bool ok = row >= seg_lo && row < seg_hi; const int rc = ok ? row : r0;
            const unsigned v = *(const unsigned*)(ub + (size_t)rc * NIN); Wd[q][4 + j] = ok ? v : 0u; }
#pragma unroll
        for (int j = 0; j < 4; ++j) nx[q][j] = *(const unsigned*)(ub + (size_t)(rbase + rsign * (16 * g + j)) * NIN); }
#pragma unroll 1
    for (int ti = 0; ti < 4; ++ti) {
        const int tile = ti;
        int zo = 0; asm volatile("" : "+v"(zo));
        const LAS v4u* GWLt = GWL + zo;
        v4u g0 = {0u, 0u, 0u, 0u}, g1 = g0; size_t orow = 0;
        if (FINAL && D == 0) { orow = (size_t)(r0 + 16 * (fr >> 2) + 4 * tile + (fr & 3)); const bf16* gp = U + orow * NIN + 512 + 64 * h + 16 * fq; g0 = *(const v4u*)gp; g1 = *(const v4u*)(gp + 8); }
#pragma unroll
        for (int q = 0; q < 2; ++q) {
            Wd[q][0] = Wd[q][4]; Wd[q][1] = Wd[q][5]; Wd[q][2] = Wd[q][6]; Wd[q][3] = nx[q][0]; Wd[q][4] = nx[q][1]; Wd[q][5] = nx[q][2]; Wd[q][6] = nx[q][3]; }
        if (ti < 3) { const int tn = ti + 1;
#pragma unroll
            for (int q = 0; q < 2; ++q)
#pragma unroll
                for (int j = 0; j < 4; ++j) nx[q][j] = *(const unsigned*)(ub + (size_t)(rbase + rsign * (16 * (2 * rh + q) + 4 * tn + j)) * NIN); }
#pragma unroll
        for (int q = 0; q < 2; ++q)
#pragma unroll
            for (int jj = 0; jj < 4; ++jj) { float v0 = cbv.x, v1 = cbv.y;
#pragma unroll
                for (int k = 0; k < 4; ++k) { const unsigned u = Wd[q][jj + k]; v0 += cw[k].x * bflo(u); v1 += cw[k].y * bfhi(u); }
                *(LAS f32x2v*)(VCW + (4 * (2 * rh + q) + jj) * 68 + 2 * cp) = (f32x2v){v0, v1}; }
        bf16x8 af[2];
#pragma unroll
        for (int kk = 0; kk < 2; ++kk) { const LAS float* vp = VCW + fr * 68 + 32 * kk + 8 * fq; const f32x4 x0 = *(const LAS f32x4*)vp, x1 = *(const LAS f32x4*)(vp + 4);
            v4u pk; pk.x = cvtpk(x0.x, x0.y); pk.y = cvtpk(x0.z, x0.w); pk.z = cvtpk(x1.x, x1.y); pk.w = cvtpk(x1.z, x1.w); af[kk] = __builtin_bit_cast(bf16x8, pk); }
        float vcv[4][4];
#pragma unroll
        for (int ct = 0; ct < 4; ++ct)
#pragma unroll
            for (int jj = 0; jj < 4; ++jj) vcv[ct][jj] = VCW[(4 * fq + jj) * 68 + 16 * ct + fr];
        f32x4 accr[4], acci[4];
#pragma unroll
        for (int ct = 0; ct < 4; ++ct) { accr[ct] = (f32x4){0.f, 0.f, 0.f, 0.f}; acci[ct] = accr[ct];
#pragma unroll
            for (int kk = 0; kk < 2; ++kk) { const bf16x8 br = __builtin_bit_cast(bf16x8, GWLt[(ct * 2 + kk) * 64]), bi = __builtin_bit_cast(bf16x8, GWLt[(8 + ct * 2 + kk) * 64]);
                accr[ct] = __builtin_amdgcn_mfma_f32_16x16x32_bf16(af[kk], br, accr[ct], 0, 0, 0); acci[ct] = __builtin_amdgcn_mfma_f32_16x16x32_bf16(af[kk], bi, acci[ct], 0, 0, 0); } }
        float hsum[4][4];
#pragma unroll
        for (int ct = 0; ct < 4; ++ct) { float aa[4], bb[4];
            const float nbr = -1.44269504f * brv[ct], nbi = -1.44269504f * biv[ct];
#pragma unroll
            for (int p = 0; p < 2; ++p) {
                f32x2v xr = (f32x2v){accr[ct][2 * p], accr[ct][2 * p + 1]} * -1.44269504f + nbr, xi = (f32x2v){acci[ct][2 * p], acci[ct][2 * p + 1]} * -1.44269504f + nbi;
                xr = __builtin_elementwise_min(xr, (f32x2v){60.f, 60.f}); xi = __builtin_elementwise_min(xi, (f32x2v){60.f, 60.f});
                f32x2v d1, d2; d1.x = __builtin_amdgcn_exp2f(xr.x); d1.y = __builtin_amdgcn_exp2f(xr.y); d2.x = __builtin_amdgcn_exp2f(xi.x); d2.y = __builtin_amdgcn_exp2f(xi.y);
                d1 = d1 + 1.0f; d2 = d2 + 1.0f; const f32x2v m = d1 * d2; f32x2v inv; inv.x = __builtin_amdgcn_rcpf(m.x); inv.y = __builtin_amdgcn_rcpf(m.y);
                const f32x2v r = d2 * inv, ig = d1 * inv, la = r * sp8[ct], x2 = la + la, le = la * 1.44269504f;
                f32x2v av, om;
                if (FASTP) { const f32x2v q = la * (la * (la * (la * (la * 0.0083333338f + 0.041666668f) + 0.16666667f) + 0.5f) + 1.0f);
                    av = q + 1.0f; om = -q * (q + 2.0f); }
                else { const f32x2v pom = -x2 * (x2 * (x2 * (x2 * (x2 * 0.0083333338f + 0.041666668f) + 0.16666667f) + 0.5f) + 1.0f);
                    av.x = __builtin_amdgcn_exp2f(le.x); av.y = __builtin_amdgcn_exp2f(le.y);
                    const f32x2v o2 = 1.0f - av * av; om.x = x2.x > -0.25f ? pom.x : o2.x; om.y = x2.y > -0.25f ? pom.y : o2.y;
                    om = __builtin_elementwise_max(om, (f32x2v){0.f, 0.f}); }
                f32x2v sq; sq.x = __builtin_amdgcn_sqrtf(om.x); sq.y = __builtin_amdgcn_sqrtf(om.y);
                const f32x2v bv = sq * (ig * (f32x2v){vcv[ct][2 * p], vcv[ct][2 * p + 1]});
                aa[2 * p] = av.x; aa[2 * p + 1] = av.y; bb[2 * p] = bv.x; bb[2 * p + 1] = bv.y; }
            float hh = Hc[ct], A4 = 1.f;
#pragma unroll
            for (int jj = 0; jj < 4; ++jj) { hh = aa[jj] * hh + bb[jj]; A4 *= aa[jj]; hsum[ct][jj] = hh; }
            Hc[ct] = hh; if (!FINAL) Ac[ct] *= A4; }
        if (FINAL) {
            if (D == 1) {
#pragma unroll
                for (int ct = 0; ct < 4; ++ct)
#pragma unroll
                    for (int jp = 0; jp < 2; ++jp) HBW[(tile * 8 + ct * 2 + jp) * 64 + lane] = cvtpk(hsum[ct][2 * jp], hsum[ct][2 * jp + 1]);
            } else {
#pragma unroll
                for (int ct = 0; ct < 4; ++ct)
#pragma unroll
                    for (int jp = 0; jp < 2; ++jp) {
                        const unsigned hb = HBW[((3 - tile) * 8 + ct * 2 + (1 - jp)) * 64 + fr + 16 * (3 - fq)];
                        VCW[(4 * fq + 2 * jp) * 68 + 16 * ct + fr] = hsum[ct][2 * jp] + bfhi(hb); VCW[(4 * fq + 2 * jp + 1) * 68 + 16 * ct + fr] = hsum[ct][2 * jp + 1] + bflo(hb); }
                const size_t row = orow;
                const f32x4 s0 = *(const LAS f32x4*)(VCW + fr * 68 + 16 * fq), s1 = *(const LAS f32x4*)(VCW + fr * 68 + 16 * fq + 4), s2 = *(const LAS f32x4*)(VCW + fr * 68 + 16 * fq + 8), s3 = *(const LAS f32x4*)(VCW + fr * 68 + 16 * fq + 12);
                v4u o0, o1;
                o0.x = cvtpk(s0.x * bflo(g0.x), s0.y * bfhi(g0.x)); o0.y = cvtpk(s0.z * bflo(g0.y), s0.w * bfhi(g0.y)); o0.z = cvtpk(s1.x * bflo(g0.z), s1.y * bfhi(g0.z)); o0.w = cvtpk(s1.z * bflo(g0.w), s1.w * bfhi(g0.w));
                o1.x = cvtpk(s2.x * bflo(g1.x), s2.y * bfhi(g1.x)); o1.y = cvtpk(s2.z * bflo(g1.y), s2.w * bfhi(g1.y)); o1.z = cvtpk(s3.x * bflo(g1.z), s3.y * bfhi(g1.z)); o1.w = cvtpk(s3.z * bflo(g1.w), s3.w * bfhi(g1.w));
                bf16* op = MIXIN + row * 1024 + 64 * h + 16 * fq; *(v4u*)op = o0; *(v4u*)(op + 8) = o1;
            }
        }
    }
    if (!FINAL) {
#pragma unroll
        for (int ct = 0; ct < 4; ++ct) { const int c = 16 * ct + fr;
            const size_t i16 = (size_t)((b * 2 + D) * NP16 + p16own) * 512 + 64 * h + c; A16[i16] = Ac[ct]; B16[i16] = Hc[ct];
            float Ag[4], Bg[4];
#pragma unroll
            for (int g = 0; g < 4; ++g) { Ag[g] = __shfl(Ac[ct], fr + 16 * g); Bg[g] = __shfl(Hc[ct], fr + 16 * g); }
            float run = 0.f;
#pragma unroll
            for (int g = 0; g < 4; ++g) run = Ag[g] * run + Bg[g];
            if (fq == 0) { const size_t idx = (size_t)((b * 2 + D) * NPJ + pj) * 512 + 64 * h + c; AGGA[idx] = (Ag[0] * Ag[1]) * (Ag[2] * Ag[3]); AGGB[idx] = run; } }
    }
}

template <bool FINAL>
__device__ __forceinline__ void rg_run(const Args& a, LAS unsigned char* lds, int l, int rn, int tid, int lane, int wave) {
    const bool is_ctx = rn >= 256; const int bh = is_ctx ? rn - 256 : rn >> 4, b = bh >> 3, h = bh & 7, cgp = is_ctx ? 0 : (rn & 15);
    { const v4u* GWF = (const v4u*)(a.ws + WS_GWF); LAS v4u* GWL = (LAS v4u*)(lds + RG_GW);
#pragma unroll
      for (int i = tid; i < 2048; i += NTHR) { const int d = i >> 10, g = (i >> 9) & 1, rest = i & 511; GWL[i] = GWF[(size_t)((((l * 2 + d) * 2 + g) * 8 + h) * 8) * 64 + rest]; } }
    const int P0f = 4 + 8 * cgp, P0b = 124 - 8 * cgp;
    if (FINAL && !is_ctx) {
        const float* AGGA = (const float*)(a.ws + WS_AGGA); const float* AGGB = (const float*)(a.ws + WS_AGGB); const float* A16 = (const float*)(a.ws + WS_A16); const float* B16 = (const float*)(a.ws + WS_B16);
        const int d = tid >> 8, s = (tid >> 6) & 3, c = tid & 63, P0 = d ? P0b : P0f, lo = (P0 * s) >> 2, hi = (P0 * (s + 1)) >> 2;
        const size_t b16 = (size_t)((b * 2 + d) * NP16 + 4 * P0 + 8 * s) * 512 + 64 * h + c; float ai8[8], bi8[8];
#pragma unroll
        for (int i = 0; i < 8; ++i) { ai8[i] = A16[b16 + (size_t)i * 512]; bi8[i] = B16[b16 + (size_t)i * 512]; }
        const size_t base = (size_t)((b * 2 + d) * NPJ) * 512 + 64 * h + c; float A = 1.f, Bv = 0.f;
#pragma unroll 8
        for (int i = lo; i < hi; ++i) { const float ai = AGGA[base + (size_t)i * 512], bi = AGGB[base + (size_t)i * 512]; Bv = ai * Bv + bi; A *= ai; }
        LAS float* FO = (LAS float*)(lds + RG_FOLD); LAS float* F8 = (LAS float*)(lds + RG_F8); LAS float* CAR = (LAS float*)(lds + RG_CAR);
        FO[((d * 4 + s) * 64 + c) * 2] = A; FO[((d * 4 + s) * 64 + c) * 2 + 1] = Bv;
        float A8 = 1.f, B8 = 0.f;
#pragma unroll
        for (int i = 0; i < 8; ++i) { B8 = ai8[i] * B8 + bi8[i]; A8 *= ai8[i]; }
        F8[((d * 4 + s) * 64 + c) * 2] = A8; F8[((d * 4 + s) * 64 + c) * 2 + 1] = B8;
        __syncthreads();
        float S = 0.f;
#pragma unroll
        for (int s2 = 0; s2 < 4; ++s2) S = FO[((d * 4 + s2) * 64 + c) * 2] * S + FO[((d * 4 + s2) * 64 + c) * 2 + 1];
#pragma unroll
        for (int s2 = 0; s2 < 3; ++s2) if (s2 < s) S = F8[((d * 4 + s2) * 64 + c) * 2] * S + F8[((d * 4 + s2) * 64 + c) * 2 + 1];
#pragma unroll
        for (int i = 0; i < 8; ++i) { CAR[(d * 32 + 8 * s + i) * 64 + c] = S; S = ai8[i] * S + bi8[i]; }
    }
    __syncthreads();
    if (wave < (is_ctx ? 4 : 8)) {
        const int j = is_ctx ? wave : 8 * cgp + wave;
        const int seg_lo = is_ctx ? MLAT + b * CTXL : b * SEQ, seg_hi = seg_lo + (is_ctx ? CTXL : SEQ), r0 = seg_lo + 64 * j;
        const int pjf = is_ctx ? j : 4 + j, pjb = is_ctx ? 3 - j : 131 - j;
        LAS unsigned char* wl = lds + RG_WAVE + wave * RG_WAVE_BYTES;
        const float* SP8 = (const float*)(a.ws + WS_SP8);
        const bool fast1 = !__any(SP8[(l * 2 + 1) * 512 + 64 * h + lane] < -0.25f), fast0 = !__any(SP8[(l * 2 + 0) * 512 + 64 * h + lane] < -0.25f);
#pragma unroll 1
        for (int it = 0; it < 2; ++it) { const int D = 1 - it, pj = D ? pjb : pjf; const bool fast = D ? fast1 : fast0;
            if (fast) rg_sweep<FINAL, true>(a, lds, wl, l, b, h, r0, seg_lo, seg_hi, pj, is_ctx, wave, lane, D); else rg_sweep<FINAL, false>(a, lds, wl, l, b, h, r0, seg_lo, seg_hi, pj, is_ctx, wave, lane, D); }
    }
    __syncthreads();
}

#define RLX_AGENT __ATOMIC_RELAXED, __HIP_MEMORY_SCOPE_AGENT


#define XB_TMO      128
#define XB_XCNT(j)  (256  + 64 * (j))
#define XB_XSUB(j)  (1280 + 64 * (j))
#define XB_XGEN(j)  (2304 + 64 * (j))
#define XB_TOP      3328
#define XB_TOPGEN   3392
#define XCD_BAR_WORDS 3456
#define XB_SPIN_CAP (1u << 18)

__device__ __forceinline__ unsigned xb_ld(unsigned* p)              { return __hip_atomic_load(p, __ATOMIC_RELAXED, __HIP_MEMORY_SCOPE_AGENT); }
__device__ __forceinline__ unsigned xb_add(unsigned* p, unsigned v) { return __hip_atomic_fetch_add(p, v, __ATOMIC_RELAXED, __HIP_MEMORY_SCOPE_AGENT); }
__device__ __forceinline__ unsigned xb_xcc_id() { return (unsigned)__builtin_amdgcn_s_getreg((3 << 11) | 20) & 0xFu; }
#define XB_SPIN(cond, bar) do { unsigned _sp = 0; while (cond) { __builtin_amdgcn_s_sleep(1); \
    if ((++_sp & 255u) == 0u) { if (xb_ld(&(bar)[XB_TMO])) break; if (_sp > XB_SPIN_CAP) { atomicAdd(&(bar)[XB_TMO], 1u); break; } } } } while (0)

struct XcdBarrier {
    unsigned* bar; unsigned x;
    volatile LAS unsigned* st;
};

__device__ __forceinline__ XcdBarrier xcd_barrier_post(unsigned* bar, volatile LAS unsigned* st) {
    XcdBarrier b; b.bar = bar; b.x = xb_xcc_id(); b.st = st;
    if (threadIdx.x == 0) (void)xb_add(&bar[XB_XCNT(b.x)], 1u);
    return b;
}
__device__ __forceinline__ void xcd_barrier_complete(unsigned* bar, unsigned x, unsigned& nloc, unsigned& nx) {
    const unsigned G = gridDim.x * gridDim.y * gridDim.z;
    unsigned sum, cnt, mine, sp = 0u;
    for (;;) {
        sum = 0u; cnt = 0u; mine = 0u;
#pragma unroll
        for (unsigned j = 0; j < 16; ++j) { const unsigned c = xb_ld(&bar[XB_XCNT(j)]); sum += c; cnt += (c > 0u) ? 1u : 0u; mine = (j == x) ? c : mine; }
        if (sum == G) break;
        __builtin_amdgcn_s_sleep(1);
        if ((++sp & 255u) == 0u) { if (xb_ld(&bar[XB_TMO])) break; if (sp > XB_SPIN_CAP) { atomicAdd(&bar[XB_TMO], 1u); break; } }
    }
    nloc = mine > 0u ? mine : 1u; nx = cnt > 0u ? cnt : 1u;
}

__device__ __forceinline__ void xcd_barrier(const XcdBarrier& b) {
    asm volatile("s_waitcnt vmcnt(0)" ::: "memory");
    __syncthreads();
    if (threadIdx.x == 0) {
        unsigned* bar = b.bar;
        __builtin_amdgcn_s_waitcnt(0);
        unsigned nloc = b.st[0], nx = b.st[1];
        if (nloc == 0u) { xcd_barrier_complete(bar, b.x, nloc, nx); b.st[0] = nloc; b.st[1] = nx; }
        const unsigned old = xb_add(&bar[XB_XSUB(b.x)], 1u);
        const unsigned gen = old / nloc;
        if (old + 1u == (gen + 1u) * nloc) {
            __builtin_amdgcn_fence(__ATOMIC_RELEASE, "agent");
            asm volatile("s_waitcnt vmcnt(0)" ::: "memory");
            const unsigned og = xb_add(&bar[XB_TOP], 1u);
            const unsigned tg = og / nx;
            if (og + 1u == (tg + 1u) * nx) xb_add(&bar[XB_TOPGEN], 1u);
            else XB_SPIN(xb_ld(&bar[XB_TOPGEN]) == tg, bar);
            __builtin_amdgcn_fence(__ATOMIC_ACQUIRE, "agent");
            xb_add(&bar[XB_XGEN(b.x)], 1u);
            asm volatile("s_waitcnt vmcnt(0)" ::: "memory");
        } else {
            XB_SPIN(xb_ld(&bar[XB_XGEN(b.x)]) == gen, bar);
            __builtin_amdgcn_fence(__ATOMIC_ACQUIRE, "agent");
            asm volatile("s_waitcnt vmcnt(0)" ::: "memory");
        }
    }
    __syncthreads();
}

__device__ __forceinline__ void ctx_mix_tiles(const Args& a, int lane, int wave) {
    const bf16* MIXIN = (const bf16*)(a.ws + WS_MIXIN); const bf16* BT2 = (const bf16*)(a.ws + WS_BT2); bf16* MIX = (bf16*)(a.ws + WS_MIX);
    const int NGW = gridDim.x * NWAVES, fr = lane & 15, fq = lane >> 4;
    for (int t = blockIdx.x * NWAVES + wave; t < 32 * 64; t += NGW) {
        const int rg = t >> 6, cg = t & 63;
        const bf16* ap = MIXIN + (size_t)(MLAT + 16 * rg + fr) * 1024 + 8 * fq;
        const bf16* bp = BT2 + (size_t)(16 * cg + fr) * 1024 + 8 * fq;
        f32x4 acc = {0.f, 0.f, 0.f, 0.f};
#pragma unroll 1
        for (int k0 = 0; k0 < 32; k0 += 8) { v4u av[8], bv[8];
#pragma unroll
            for (int i = 0; i < 8; ++i) { av[i] = *(const v4u*)(ap + 32 * (k0 + i)); bv[i] = *(const v4u*)(bp + 32 * (k0 + i)); }
#pragma unroll
            for (int i = 0; i < 8; ++i) acc = __builtin_amdgcn_mfma_f32_16x16x32_bf16(__builtin_bit_cast(bf16x8, av[i]), __builtin_bit_cast(bf16x8, bv[i]), acc, 0, 0, 0); }
        bf16* op = MIX + (size_t)(MLAT + 16 * rg + 4 * fq) * 1024 + 16 * cg + fr;
#pragma unroll
        for (int j = 0; j < 4; ++j) op[(size_t)j * 1024] = (bf16)(cvtpk(acc[j], acc[j]) & 0xffffu);
    }
}

__device__ __forceinline__ void layer_phases(int l, const Args& args, LAS unsigned char* lds, const int tid0, const int lo, const int hi, const XcdBarrier& xbar) {
    const int G = gridDim.x; unsigned char* ws = args.ws;
    const int pb = 1 + 5 * l;
#define LAUNDER() int tid = tid0; asm volatile("" : "+v"(tid)); const int lane = tid & 63, wave = __builtin_amdgcn_readfirstlane(tid >> 6); int bx = blockIdx.x; asm volatile("" : "+s"(bx)); (void)lane; (void)wave; (void)bx
#define IN(k) (lo <= (k) && (k) < hi)
#define SEAM(k) do { if (IN(k) && IN((k) + 1)) { xcd_barrier(xbar); } } while (0)
        if (IN(pb)) { LAUNDER(); norm_phase(args, l, lane, wave); }
        SEAM(pb);
        if (IN(pb + 1)) { LAUNDER();
            pg8::Gemm g{(const pg8::bf16_t*)(ws + WS_H), (const pg8::bf16_t*)(ws + WS_BT1) + (size_t)l * NIN * 1024, MROWS, NIN, 1024};
            pg8::StaticOrder S; S.init(MROWS, NIN, G, bx);
            pg8::EpiU E{(pg8::bf16_t*)(ws + WS_U)};
            pg8::gemm_phase<pg8::EpiU, pg8::StaticOrder, true, true>(lds, g, S, E);
        }
        SEAM(pb + 1);
        if (IN(pb + 2)) { LAUNDER();
            const int nrun = (bx >= G - 16) ? 2 : 1;
#pragma unroll 1
            for (int k = 0; k < nrun; ++k) rg_run<false>(args, lds, l, k == 0 ? bx : 256 + (G - 1 - bx), tid, lane, wave);
            const int n_h = 256 + (l == 0 ? 16 : 0), n_conv = 128 + n_h;
            const int GC = G - 16;
            for (int un = bx; un < n_conv && bx < GC; un += GC) {
                int grow0, gstride, vlo, vhi, coff, cbase, nrows, ncall, orow0, ostride;
                if (un < 128) { const int bb = un >> 6, w = un & 63; vlo = bb * SEQ + w; vhi = vlo + SEQ; grow0 = vlo - 15 * 64; gstride = 64; coff = 1024 + 256; cbase = 256; nrows = 158; ncall = 2; orow0 = vlo; ostride = 64; }
                else { const int hu = un - 128; int r0, g;
                    if (hu < 256) { r0 = hu * 64; g = 0; vlo = r0; vhi = r0 + 64; }
                    else { const int cu = hu - 256, cc = cu >> 1, bb = cc >> 2; g = cu & 1; r0 = MLAT + cc * 64; vlo = MLAT + bb * CTXL; vhi = vlo + CTXL; }
                    grow0 = r0 - 15; gstride = 1; coff = 1024 + g * 256; cbase = g * 256; nrows = 94; ncall = 1; orow0 = r0; ostride = 1; }
                conv_unit(args, lds, l, grow0, gstride, vlo, vhi, coff, cbase, nrows, ncall, orow0, ostride, tid);
            }
        }
        SEAM(pb + 2);
        if (IN(pb + 3)) { LAUNDER();
            const int nrun = (l == 0 && bx >= G - 16) ? 2 : 1;
#pragma unroll 1
            for (int k = 0; k < nrun; ++k) rg_run<true>(args, lds, l, k == 0 ? bx : 256 + (G - 1 - bx), tid, lane, wave);
            ln_rows(args, l, (l == 0) ? MROWS : MLAT, lane, wave, (l == 0) ? G - 16 : G);
        }
        SEAM(pb + 3);
        if (IN(pb + 4)) { LAUNDER();
            const int M2 = MLAT;
            if (l == 0) ctx_mix_tiles(args, lane, wave);
            pg8::Gemm g{(const pg8::bf16_t*)(ws + WS_MIXIN), (const pg8::bf16_t*)(ws + WS_BT2) + (size_t)l * 1024 * 1024, M2, 1024, 1024};
            pg8::StaticOrder S; S.init(M2, 1024, G, bx);
            pg8::EpiMix E{(pg8::bf16_t*)(ws + WS_MIX) + (size_t)l * MROWS * 1024, nullptr};
            pg8::gemm_phase<pg8::EpiMix, pg8::StaticOrder, true, true>(lds, g, S, E);
        }
        SEAM(pb + 4);
#undef IN
#undef SEAM
#undef LAUNDER
}

__global__ void __launch_bounds__(NTHR, 2) fwd_megakernel(Args args) {
    extern __shared__ __attribute__((aligned(16))) unsigned char lds_raw[];
    LAS unsigned char* lds = (LAS unsigned char*)lds_raw;
    const int tid = threadIdx.x, lane = tid & 63, wave = __builtin_amdgcn_readfirstlane(tid >> 6);
    const int G = gridDim.x, bx = blockIdx.x;
    unsigned char* ws = args.ws;
    const int lo = args.ph_lo, hi = args.ph_hi;
    if (args.coop == 2) cg::this_grid().sync();
    volatile LAS unsigned* MISC = (volatile LAS unsigned*)(lds + MISC_OFF);
    if (tid < 64) MISC[tid] = 0u;
    __syncthreads();
    XcdBarrier xbar; xbar.bar = (unsigned*)(ws + WS_CTL); xbar.x = 0; xbar.st = nullptr;
    if (args.coop == 1) xbar = xcd_barrier_post((unsigned*)(ws + WS_CTL), MISC + 8);
#define IN(k) (lo <= (k) && (k) < hi)
#define SEAM(k) do { if (IN(k) && IN((k) + 1)) { xcd_barrier(xbar); } } while (0)

    if (IN(0)) { p0_prologue(args, lds, tid, lane, wave); }
    SEAM(0);
#pragma unroll 1
    for (int l = 0; l < 2; ++l) { int lo_ = l; asm volatile("" : "+s"(lo_)); layer_phases(lo_, args, lds, tid, lo, hi, xbar); }
    if (IN(11)) { norm_phase(args, 2, lane, wave); }
#undef IN
#undef SEAM
}

#ifndef MK_PER_PHASE
#define MK_PER_PHASE 0
#endif
extern "C" void kernel_launch(void* const* d_in, const int* in_sizes, int n_in, void* d_out, int out_size, void* d_ws, size_t ws_size, hipStream_t stream) {
    static int grid = 0;
    if (grid == 0) {
        if (n_in != 21 || out_size != MLAT * DM || ws_size < WS_END) { fprintf(stderr, "kernel_launch: unexpected shapes (n_in %d, out %d, ws %zu)\n", n_in, out_size, ws_size); grid = -1; return; }
        int dev = 0, cus = 0, per_cu = 0;
        if (hipGetDevice(&dev) != hipSuccess || hipDeviceGetAttribute(&cus, hipDeviceAttributeMultiprocessorCount, dev) != hipSuccess) { grid = -1; return; }
        if (hipFuncSetAttribute((const void*)fwd_megakernel, hipFuncAttributeMaxDynamicSharedMemorySize, LDS_BYTES) != hipSuccess) { fprintf(stderr, "kernel_launch: hipFuncSetAttribute failed\n"); grid = -1; return; }
        if (hipOccupancyMaxActiveBlocksPerMultiprocessor(&per_cu, (const void*)fwd_megakernel, NTHR, LDS_BYTES) != hipSuccess || per_cu < 1) { fprintf(stderr, "kernel_launch: occupancy query says %d\n", per_cu); per_cu = 1; }
        (void)hipGetLastError();
        grid = cus;
    }
    if (grid < 0) return;
    if (hipMemsetAsync((char*)d_ws + WS_CTL, 0, CTL_ZERO_BYTES, stream) != hipSuccess) { fprintf(stderr, "kernel_launch: memset failed\n"); return; }
    Args a{};
    for (int i = 0; i < 21; ++i) a.in[i] = (const float*)d_in[i];
    a.out = (float*)d_out; a.ws = (unsigned char*)d_ws;
#if MK_PER_PHASE
    for (int ph = 0; ph < 12; ++ph) { a.ph_lo = ph; a.ph_hi = ph + 1; a.coop = 0;
        hipLaunchKernelGGL(fwd_megakernel, dim3(grid), dim3(NTHR), LDS_BYTES, stream, a); }
#else
    a.ph_lo = 0; a.ph_hi = 12; a.coop = 1;
    void* kargs[] = {&a};
    hipError_t e = hipLaunchCooperativeKernel((const void*)fwd_megakernel, dim3(grid), dim3(NTHR), kargs, LDS_BYTES, stream);
    if (e != hipSuccess) fprintf(stderr, "cooperative launch failed: %s (grid %d)\n", hipGetErrorString(e), grid);
#endif
}
```

```cpp
#include <hip/hip_runtime.h>
#include <hip/hip_cooperative_groups.h>
#include <cstdio>
#include <cstdint>
namespace cg = cooperative_groups;
#define MK_PER_PHASE 0
namespace pg8 {
#define PG8_LAS __attribute__((address_space(3)))
typedef unsigned short bf16_t;
typedef short bf16x8 __attribute__((ext_vector_type(8)));
typedef float f32x4 __attribute__((ext_vector_type(4)));
typedef unsigned u32x4 __attribute__((ext_vector_type(4)));
constexpr int BM = 256, BK = 64, HALF = 128, HTB = HALF * BK * 2  , STAGE_BYTES = 8 * HTB, NXCD = 8, WGM = 8;

__host__ __device__ __forceinline__ int lds_byte(int r, int c) { const int st = (r >> 4) * 2 + (c >> 5), rr = r & 15, cc = c & 31, ob = rr * 64 + cc * 2; return st * 1024 + (ob ^ (((ob >> 9) & 1) << 5)); }
__host__ __device__ __forceinline__ void stage_rc(int b, int& R, int& C) { const int st = b / 1024, sb = b % 1024, swz = sb ^ (((sb >> 9) & 1) << 5); R = (st >> 1) * 16 + swz / 64; C = (st & 1) * 32 + (swz % 64) / 2; }
__host__ __device__ __forceinline__ int perm32(int rho) { const int n = rho >> 4, i = rho & 15; return 8 * (i >> 2) + 4 * n + (i & 3); }

struct Unit { int pm, pn; };
struct Gemm { const bf16_t* A; const bf16_t* Bt; int M, N, K; };

struct StaticOrder {
    int nM, nN, nwg, G, c;
    __host__ __device__ void init(int M, int N, int G_, int c_) { nM = M / BM; nN = N / BM; nwg = nM * nN; G = G_; c = c_; }
    __host__ __device__ bool next(int i, Unit& u) const {
        const long L = (long)i * G + c; if (L >= nwg) return false;
        int wgid = (int)L; { const int q = nwg / NXCD, r = nwg % NXCD, xcd = wgid % NXCD, off = wgid / NXCD; wgid = (xcd < r ? xcd * (q + 1) : r * (q + 1) + (xcd - r) * q) + off; }
        const int nig = WGM * nN, gid = wgid / nig, fm = gid * WGM, gsz = (nM - fm) < WGM ? (nM - fm) : WGM;
        u.pm = fm + ((wgid % nig) % gsz); u.pn = (wgid % nig) / gsz; return true;
    }
    __device__ __forceinline__ void a_ready(const Unit&) const {}
    __device__ __forceinline__ void done(const Unit&) const {}
};
__device__ __forceinline__ unsigned cvt_pk_bf16(float lo, float hi) { unsigned r; asm volatile("v_cvt_pk_bf16_f32 %0, %1, %2" : "=v"(r) : "v"(lo), "v"(hi)); return r; }
typedef float f32x2 __attribute__((ext_vector_type(2)));
template <class Epi, class Sched, bool ALIGN_EPI = false, bool SP2 = false>
__device__ __forceinline__ void gemm_phase(PG8_LAS unsigned char* lds, const Gemm g, const Sched& S, const Epi& E) {
    const int tid = threadIdx.x, wid = __builtin_amdgcn_readfirstlane(tid >> 6), lane = tid & 63, wr = wid >> 2, wc = wid & 3, fr = lane & 15, fq = lane >> 4;
    const int K = g.K, nt = K / BK;
    unsigned voffA[2], voffB[2];
#pragma unroll
    for (int i = 0; i < 2; ++i) { int R, C; stage_rc(tid * 16 + i * 8192, R, C); const int Rb = Epi::PERM ? ((R & ~31) + perm32(R & 31)) : R;
        voffA[i] = (unsigned)(R * K + C) * 2u; voffB[i] = (unsigned)(Rb * K + C) * 2u; }
    const size_t kstep = (size_t)(BK * 2);
    const size_t hstep = (size_t)HALF * K * 2;
    const size_t tstep = 2 * hstep;
    const unsigned ldsw = (unsigned)wid * 1024u;
    const int aoff = lds_byte(wr * 64 + fr, fq * 8), boff = lds_byte(wc * 32 + fr, fq * 8);
#define PG8_SA(b, h) (((b) * 2 + (h)) * HTB)
#define PG8_SB(b, h) ((4 + (b) * 2 + (h)) * HTB)
#define PG8_STAGE(bufoff, gbase, voff) do { _Pragma("unroll") for (int _i = 0; _i < 2; ++_i) \
        __builtin_amdgcn_global_load_lds((const unsigned*)((const char*)(gbase) + (voff)[_i]), (PG8_LAS unsigned*)(lds + (bufoff) + ldsw + _i * 8192), 16, 0, 0); } while (0)
#define PG8_LDA(dst, b, h) do { _Pragma("unroll") for (int m = 0; m < 4; ++m) _Pragma("unroll") for (int k = 0; k < 2; ++k) dst[m][k] = *(const PG8_LAS bf16x8*)(lds + PG8_SA(b, h) + aoff + m * 2048 + k * 1024); } while (0)
#define PG8_LDB(dst, b, h) do { _Pragma("unroll") for (int n = 0; n < 2; ++n) _Pragma("unroll") for (int k = 0; k < 2; ++k) dst[n][k] = *(const PG8_LAS bf16x8*)(lds + PG8_SB(b, h) + boff + n * 2048 + k * 1024); } while (0)
#define PG8_MMA(ai, bj, At, Bt) do { __builtin_amdgcn_s_setprio(1); _Pragma("unroll") for (int m = 0; m < 4; ++m) _Pragma("unroll") for (int n = 0; n < 2; ++n) _Pragma("unroll") for (int k = 0; k < 2; ++k) \
        acc[ai][bj][m][n] = __builtin_amdgcn_mfma_f32_16x16x32_bf16(Bt[n][k], At[m][k], acc[ai][bj][m][n], 0, 0, 0); __builtin_amdgcn_s_setprio(0); } while (0)
#define PG8_WAIT_V(n) asm volatile("s_waitcnt vmcnt(" #n ")" ::: "memory")
#define PG8_WAIT_L(n) asm volatile("s_waitcnt lgkmcnt(" #n ")" ::: "memory")
#define PG8_BAR __builtin_amdgcn_s_barrier()
#define PG8_SCHED __builtin_amdgcn_sched_barrier(0)
    Unit cur, nxt; int ui = 0;
    if (!S.next(0, cur)) return;
    f32x4 acc[2][2][4][2];
#pragma unroll
    for (int a = 0; a < 2; ++a)
#pragma unroll
        for (int b = 0; b < 2; ++b)
#pragma unroll
            for (int m = 0; m < 4; ++m)
#pragma unroll
                for (int n = 0; n < 2; ++n) acc[a][b][m][n] = (f32x4){0.f, 0.f, 0.f, 0.f};
    bf16x8 At[4][2], B0[2][2], B1[2][2];
    const char* cA = (const char*)g.A + (size_t)cur.pm * tstep; const char* cB = (const char*)g.Bt + (size_t)cur.pn * tstep;
    S.a_ready(cur);
    if constexpr (SP2) {
        PG8_STAGE(PG8_SB(0, 0), cB, voffB); PG8_STAGE(PG8_SB(0, 1), cB + hstep, voffB); PG8_STAGE(PG8_SA(0, 0), cA, voffA); PG8_STAGE(PG8_SA(0, 1), cA + hstep, voffA);
        if (wr == 1) PG8_BAR;
        PG8_WAIT_V(2); PG8_BAR;
        PG8_STAGE(PG8_SB(1, 0), cB + kstep, voffB); PG8_STAGE(PG8_SA(1, 0), cA + kstep, voffA); PG8_STAGE(PG8_SB(1, 1), cB + hstep + kstep, voffB);
        PG8_WAIT_V(6); PG8_BAR;
    } else {
        PG8_STAGE(PG8_SB(0, 0), cB, voffB); PG8_STAGE(PG8_SA(0, 0), cA, voffA); PG8_STAGE(PG8_SB(0, 1), cB + hstep, voffB); PG8_STAGE(PG8_SA(0, 1), cA + hstep, voffA);
        if (wr == 1) PG8_BAR;
        PG8_WAIT_V(4); PG8_BAR;
        PG8_STAGE(PG8_SB(1, 0), cB + kstep, voffB); PG8_STAGE(PG8_SA(1, 0), cA + kstep, voffA); PG8_STAGE(PG8_SB(1, 1), cB + hstep + kstep, voffB);
        PG8_WAIT_V(6); PG8_BAR;
    }
    for (;;) {
        const bool has_next = S.next(ui + 1, nxt);
        const char* nA = has_next ? (const char*)g.A + (size_t)nxt.pm * tstep : cA; const char* nB = has_next ? (const char*)g.Bt + (size_t)nxt.pn * tstep : cB;
        for (int t = 0; t < nt; t += 2) {
            const bool last = (t == nt - 2);
            const char* a1 = cA + (size_t)(t + 1) * kstep;
            const char* a2 = last ? nA : cA + (size_t)(t + 2) * kstep; const char* b2 = last ? nB : cB + (size_t)(t + 2) * kstep;
            const char* a3 = a2 + kstep; const char* b3 = b2 + kstep;
            if (last && has_next) S.a_ready(nxt);
            if constexpr (SP2) {
            PG8_LDB(B0, 0, 0); PG8_LDB(B1, 0, 1); PG8_SCHED; PG8_LDA(At, 0, 0); PG8_STAGE(PG8_SA(1, 1), a1 + hstep, voffA);
            PG8_WAIT_V(8); PG8_WAIT_L(0); PG8_BAR; PG8_MMA(0, 0, At, B0); PG8_MMA(0, 1, At, B1); PG8_BAR; PG8_SCHED;
            PG8_LDA(At, 0, 1); PG8_STAGE(PG8_SB(0, 0), b2, voffB); PG8_STAGE(PG8_SB(0, 1), b2 + hstep, voffB); PG8_STAGE(PG8_SA(0, 0), a2, voffA);
            PG8_WAIT_V(8); PG8_WAIT_L(0); PG8_BAR; PG8_MMA(1, 0, At, B0); PG8_MMA(1, 1, At, B1); PG8_BAR; PG8_SCHED;
            PG8_LDB(B0, 1, 0); PG8_LDB(B1, 1, 1); PG8_SCHED; PG8_LDA(At, 1, 0); PG8_STAGE(PG8_SA(0, 1), a2 + hstep, voffA);
            PG8_WAIT_V(8); PG8_WAIT_L(0); PG8_BAR; PG8_MMA(0, 0, At, B0); PG8_MMA(0, 1, At, B1); PG8_BAR; PG8_SCHED;
            PG8_LDA(At, 1, 1); PG8_STAGE(PG8_SB(1, 0), b3, voffB); PG8_STAGE(PG8_SB(1, 1), b3 + hstep, voffB); PG8_STAGE(PG8_SA(1, 0), a3, voffA);
            PG8_WAIT_V(8); PG8_WAIT_L(0); PG8_BAR; PG8_MMA(1, 0, At, B0); PG8_MMA(1, 1, At, B1); PG8_BAR; PG8_SCHED;
            } else {
            PG8_LDB(B0, 0, 0); PG8_SCHED; PG8_LDA(At, 0, 0); PG8_STAGE(PG8_SA(1, 1), a1 + hstep, voffA);
            PG8_WAIT_L(8); PG8_BAR; PG8_WAIT_L(0); PG8_MMA(0, 0, At, B0); PG8_BAR; PG8_SCHED;
            PG8_LDB(B1, 0, 1); PG8_STAGE(PG8_SB(0, 0), b2, voffB);
            PG8_BAR; PG8_WAIT_L(0); PG8_MMA(0, 1, At, B1); PG8_BAR;
            PG8_LDA(At, 0, 1); PG8_STAGE(PG8_SA(0, 0), a2, voffA);
            PG8_BAR; PG8_WAIT_L(0); PG8_MMA(1, 0, At, B0); PG8_BAR; PG8_SCHED;
            PG8_STAGE(PG8_SB(0, 1), b2 + hstep, voffB);
            PG8_WAIT_V(6); PG8_BAR; PG8_MMA(1, 1, At, B1); PG8_BAR;
            PG8_LDB(B0, 1, 0); PG8_SCHED; PG8_LDA(At, 1, 0); PG8_STAGE(PG8_SA(0, 1), a2 + hstep, voffA);
            PG8_WAIT_L(8); PG8_BAR; PG8_WAIT_L(0); PG8_MMA(0, 0, At, B0); PG8_BAR; PG8_SCHED;
            PG8_LDB(B1, 1, 1); PG8_STAGE(PG8_SB(1, 0), b3, voffB);
            PG8_BAR; PG8_WAIT_L(0); PG8_MMA(0, 1, At, B1); PG8_BAR;
            PG8_LDA(At, 1, 1); PG8_STAGE(PG8_SA(1, 0), a3, voffA);
            PG8_BAR; PG8_WAIT_L(0); PG8_MMA(1, 0, At, B0); PG8_BAR; PG8_SCHED;
            PG8_STAGE(PG8_SB(1, 1), b3 + hstep, voffB);
            PG8_WAIT_V(6); PG8_BAR; PG8_MMA(1, 1, At, B1); PG8_BAR;
            }
        }
        if constexpr (ALIGN_EPI) { if (wr == 0) PG8_BAR; }
        if constexpr (!Epi::AFTER_DRAIN) { E(acc, cur, wr, wc, fr, fq); S.done(cur); }
        if (!has_next) break;
#pragma unroll
        for (int a = 0; a < 2; ++a)
#pragma unroll
            for (int b = 0; b < 2; ++b)
#pragma unroll
                for (int m = 0; m < 4; ++m)
#pragma unroll
                    for (int n = 0; n < 2; ++n) acc[a][b][m][n] = (f32x4){0.f, 0.f, 0.f, 0.f};
        cur = nxt; cA = nA; cB = nB; ++ui;
        if constexpr (ALIGN_EPI) { if (wr == 1) PG8_BAR; }
    }
    PG8_WAIT_V(0);
    if constexpr (!ALIGN_EPI) { if (wr == 0) PG8_BAR; }
    PG8_BAR;
    if constexpr (Epi::AFTER_DRAIN) { E.fused(acc, cur, wr, wc, fr, fq, lds, wid, lane); S.done(cur); }
#undef PG8_SA
#undef PG8_SB
#undef PG8_STAGE
#undef PG8_LDA
#undef PG8_LDB
#undef PG8_MMA
#undef PG8_WAIT_V
#undef PG8_WAIT_L
#undef PG8_BAR
#undef PG8_SCHED
}
}

constexpr int DM = 1024, NB = 2, SEQ = 8192, CTXL = 256, MLAT = NB * SEQ, MCTX = NB * CTXL, MROWS = MLAT + MCTX;
constexpr int NIN = 2560, NCHUNK = MROWS / 64  , NPJ = 132  ;
constexpr float EPSF = 1e-6f;
constexpr int NWAVES = 8, NTHR = 512;

constexpr size_t MiB = 1u << 20;
constexpr size_t WS_CTL = 0, CTL_ZERO_BYTES = 64 * 1024;
constexpr size_t WS_MOD = 1 * MiB;
constexpr size_t WS_SP8 = 1 * MiB + 128 * 1024;
constexpr size_t WS_GWF = 1 * MiB + 256 * 1024;
constexpr size_t WS_BT1 = 2 * MiB;
constexpr size_t WS_BT2 = 12 * MiB;
constexpr size_t WS_AGGA = 16 * MiB;
constexpr size_t WS_AGGB = 16 * MiB + 1536 * 1024;
constexpr size_t WS_SSQ = 19 * MiB;
constexpr size_t WS_SSQ1 = 21 * MiB;
constexpr size_t WS_A16 = 23 * MiB;
constexpr size_t WS_B16 = 28 * MiB;
constexpr size_t WS_H = 73 * MiB;
constexpr size_t WS_Y = 56 * MiB;
constexpr size_t WS_MIXIN = 73 * MiB;
constexpr size_t WS_U = 106 * MiB;
constexpr size_t WS_MIX = 189 * MiB;
constexpr size_t WS_END = 255 * MiB;

constexpr int LDS_BYTES = 158720;
constexpr int MISC_OFF = 157696;

#define LAS __attribute__((address_space(3)))
typedef unsigned short bf16;
typedef unsigned v4u __attribute__((ext_vector_type(4)));
typedef unsigned v2u __attribute__((ext_vector_type(2)));
typedef float f32x4 __attribute__((ext_vector_type(4)));
typedef short bf16x8 __attribute__((ext_vector_type(8)));
typedef float f32x2v __attribute__((ext_vector_type(2)));
#define LDS_WAIT() asm volatile("s_waitcnt lgkmcnt(0)" ::: "memory")

__device__ __forceinline__ unsigned f2bf(float f) { unsigned u = __builtin_bit_cast(unsigned, f); return (u + 0x7fffu + ((u >> 16) & 1u)) >> 16; }
__device__ __forceinline__ unsigned pk2(float lo, float hi) { return f2bf(lo) | (f2bf(hi) << 16); }
__device__ __forceinline__ unsigned cvtpk(float lo, float hi) { unsigned r; asm volatile("v_cvt_pk_bf16_f32 %0, %1, %2" : "=v"(r) : "v"(lo), "v"(hi)); return r; }
__device__ __forceinline__ float bflo(unsigned u) { return __builtin_bit_cast(float, u << 16); }
__device__ __forceinline__ float bfhi(unsigned u) { return __builtin_bit_cast(float, u & 0xffff0000u); }
__device__ __forceinline__ float sigmoidf_(float x) { return 1.0f / (1.0f + __expf(-x)); }
__device__ __forceinline__ float siluf_(float x) { return x * __builtin_amdgcn_rcpf(1.0f + __builtin_amdgcn_exp2f(-1.44269504f * x)); }
__device__ __forceinline__ float wave_sum(float v) {
#pragma unroll
    for (int o = 1; o < 64; o <<= 1) v += __shfl_xor(v, o);
    return v;
}

struct Args {
    const float* in[21]; float* out; unsigned char* ws; int ph_lo, ph_hi, coop, pad;
};
enum { I_X = 0, I_C, I_CTX, I_CCTX, I_WMOD, I_BMOD, I_GPRE, I_GPOST, I_WIN, I_CAW, I_CAB, I_WR, I_BR, I_WI, I_BI, I_LAM, I_DWW, I_DWB, I_LNG, I_LNB, I_WOUT };

namespace pg8 {
__device__ __forceinline__ void st16_wt(void* p, u32x4 w) { asm volatile("global_store_dwordx4 %0, %1, off sc1\n\ts_nop 1" :: "v"(p), "v"(w) : "memory"); }
struct EpiU {
    static constexpr bool PERM = true, AFTER_DRAIN = false;
    bf16_t* O;
    __device__ __forceinline__ void operator()(const f32x4 (&acc)[2][2][4][2], const Unit& u, int wr, int wc, int fr, int fq) const {
        const int row0 = u.pm * BM + wr * 64 + fr;
        if (u.pn >= 4 && u.pn < 8) {
            const int col0 = 1024 + 128 * (u.pn - 4) + wc * 32 + 8 * fq;
#pragma unroll
            for (int ai = 0; ai < 2; ++ai)
#pragma unroll
                for (int m = 0; m < 4; ++m) { f32x4 v0 = acc[ai][0][m][0], v1 = acc[ai][0][m][1]; const f32x4 g0 = acc[ai][1][m][0], g1 = acc[ai][1][m][1];
#pragma unroll
                    for (int e = 0; e < 4; ++e) { v0[e] = v0[e] * __builtin_amdgcn_rcpf(1.0f + __builtin_amdgcn_exp2f(-1.44269504f * g0[e])); v1[e] = v1[e] * __builtin_amdgcn_rcpf(1.0f + __builtin_amdgcn_exp2f(-1.44269504f * g1[e])); }
                    u32x4 w; w.x = cvt_pk_bf16(v0[0], v0[1]); w.y = cvt_pk_bf16(v0[2], v0[3]); w.z = cvt_pk_bf16(v1[0], v1[1]); w.w = cvt_pk_bf16(v1[2], v1[3]);
                    *(u32x4*)(O + (size_t)(row0 + ai * HALF + m * 16) * 2560 + col0) = w; }
            return;
        }
        const int col0 = u.pn * BM + wc * 32 + 8 * fq;
        const bool act = (u.pn == 2 || u.pn == 3 || u.pn >= 8);
#pragma unroll
        for (int ai = 0; ai < 2; ++ai)
#pragma unroll
            for (int m = 0; m < 4; ++m) { bf16_t* rowp = O + (size_t)(row0 + ai * HALF + m * 16) * 2560 + col0;
#pragma unroll
                for (int bj = 0; bj < 2; ++bj) { f32x4 v0 = acc[ai][bj][m][0], v1 = acc[ai][bj][m][1];
                    if (act) {
#pragma unroll
                        for (int e = 0; e < 4; ++e) { v0[e] = v0[e] * __builtin_amdgcn_rcpf(1.0f + __builtin_amdgcn_exp2f(-1.44269504f * v0[e])); v1[e] = v1[e] * __builtin_amdgcn_rcpf(1.0f + __builtin_amdgcn_exp2f(-1.44269504f * v1[e])); }
                    }
                    u32x4 w; w.x = cvt_pk_bf16(v0[0], v0[1]); w.y = cvt_pk_bf16(v0[2], v0[3]); w.z = cvt_pk_bf16(v1[0], v1[1]); w.w = cvt_pk_bf16(v1[2], v1[3]);
                    *(u32x4*)(rowp + bj * HALF) = w; } }
    }
};
struct EpiMix {
    static constexpr bool PERM = true, AFTER_DRAIN = false;
    bf16_t* O; unsigned* cnt;
    __device__ __forceinline__ void operator()(const f32x4 (&acc)[2][2][4][2], const Unit& u, int wr, int wc, int fr, int fq) const {
        const int col0 = u.pn * BM + wc * 32 + 8 * fq;
#pragma unroll
        for (int ai = 0; ai < 2; ++ai)
#pragma unroll
            for (int m = 0; m < 4; ++m) { const int r = u.pm * BM + ai * HALF + wr * 64 + m * 16 + fr; bf16_t* rowp = O + (size_t)r * 1024 + col0;
#pragma unroll
                for (int bj = 0; bj < 2; ++bj) { const f32x4 v0 = acc[ai][bj][m][0], v1 = acc[ai][bj][m][1];
                    u32x4 w; w.x = cvt_pk_bf16(v0[0], v0[1]); w.y = cvt_pk_bf16(v0[2], v0[3]); w.z = cvt_pk_bf16(v1[0], v1[1]); w.w = cvt_pk_bf16(v1[2], v1[3]);
                    if (cnt) st16_wt(rowp + bj * HALF, w); else *(u32x4*)(rowp + bj * HALF) = w; } }
        if (cnt) { asm volatile("s_waitcnt vmcnt(0)" ::: "memory");
            if (fr == 0 && fq == 0) __hip_atomic_fetch_add(cnt + 64 * u.pm, 1u, __ATOMIC_RELAXED, __HIP_MEMORY_SCOPE_AGENT); }
    }
};
}

__device__ __forceinline__ void p0_transpose_item(const float* W, int K, int N, bf16* WT, LAS float* scr, int item, int lane, bool glu_remap) {
    const int nblk = N / 32, kb = item / nblk, nb = item % nblk, k0 = 64 * kb, n0 = 32 * nb;
    int nd = n0;
    if (glu_remap) { if (n0 >= 1024 && n0 < 1536) nd = 1024 + 256 * ((n0 - 1024) >> 7) + ((n0 - 1024) & 127); else if (n0 >= 1536 && n0 < 2048) nd = 1024 + 256 * ((n0 - 1536) >> 7) + 128 + ((n0 - 1536) & 127); }
#pragma unroll 16
    for (int i = 0; i < 32; ++i) { const int kk = 2 * i + (lane >> 5); scr[kk * 33 + (lane & 31)] = W[(size_t)(k0 + kk) * N + n0 + (lane & 31)]; }
    LDS_WAIT(); asm volatile("" ::: "memory");
    const int c = lane & 7;
#pragma unroll
    for (int j = 0; j < 4; ++j) { const int n = (lane >> 3) + 8 * j; const LAS float* s = scr + (8 * c) * 33 + n;
        v4u o; o.x = pk2(s[0 * 33], s[1 * 33]); o.y = pk2(s[2 * 33], s[3 * 33]); o.z = pk2(s[4 * 33], s[5 * 33]); o.w = pk2(s[6 * 33], s[7 * 33]);
        *(v4u*)(WT + (size_t)(nd + n) * K + k0 + 8 * c) = o; }
    LDS_WAIT(); asm volatile("" ::: "memory");
}

__device__ __forceinline__ void p0_prologue(const Args& a, LAS unsigned char* lds, int tid, int lane, int wave) {
    const int G = gridDim.x, bx = blockIdx.x;
    unsigned char* ws = a.ws;
    {
        LAS float* part = (LAS float*)lds;
        float* MOD = (float*)(ws + WS_MOD);
        const float* c = a.in[I_C]; const float* cctx = a.in[I_CCTX];
        for (int un = bx; un < 192; un += G) {
            const int l = un / 96, n0 = (un % 96) * 32, cq = tid & 7, ks = tid >> 3;
            const float* wm = a.in[I_WMOD] + (size_t)l * 1024 * 3072 + n0 + cq * 4;
            f32x4 acc0 = {0.f, 0.f, 0.f, 0.f}, acc1 = acc0, acc2 = acc0;
#pragma unroll 4
            for (int kk = 0; kk < 16; ++kk) { const int k = ks * 16 + kk; const f32x4 w = *(const f32x4*)(wm + (size_t)k * 3072);
                const float a0 = siluf_(c[k]), a1 = siluf_(c[1024 + k]), a2 = siluf_(cctx[k]);
                acc0 += w * a0; acc1 += w * a1; acc2 += w * a2; }
            *(LAS f32x4*)(part + (0 * 64 + ks) * 32 + cq * 4) = acc0;
            *(LAS f32x4*)(part + (1 * 64 + ks) * 32 + cq * 4) = acc1;
            *(LAS f32x4*)(part + (2 * 64 + ks) * 32 + cq * 4) = acc2;
            __syncthreads();
            if (tid < 96) { const int v = tid >> 5, col = tid & 31; float s = a.in[I_BMOD][l * 3072 + n0 + col];
                for (int k2 = 0; k2 < 64; ++k2) s += part[(v * 64 + k2) * 32 + col];
                MOD[(l * 3 + v) * 3072 + n0 + col] = s; }
            __syncthreads();
        }
    }
    { float* SP8 = (float*)(ws + WS_SP8); for (int idx = bx * NTHR + tid; idx < 2048; idx += G * NTHR) SP8[idx] = -8.0f * log1pf(__expf(-a.in[I_LAM][idx])); }
    {
        v4u* GWF = (v4u*)(ws + WS_GWF);
        for (int idx = bx * NTHR + tid; idx < 32768; idx += G * NTHR) {
            const int ln = idx & 63, kk = (idx >> 6) & 1, ct = (idx >> 7) & 3, h = (idx >> 9) & 7, g = (idx >> 12) & 1, d = (idx >> 13) & 1, l = idx >> 14;
            const float* W = (g == 0 ? a.in[I_WR] : a.in[I_WI]) + (size_t)(((l * 2 + d) * 8 + h) * 64) * 64;
            const int k0 = 32 * kk + 8 * (ln >> 4), col = 16 * ct + (ln & 15);
            float e[8];
#pragma unroll
            for (int j = 0; j < 8; ++j) e[j] = W[(k0 + j) * 64 + col];
            v4u o; o.x = pk2(e[0], e[1]); o.y = pk2(e[2], e[3]); o.z = pk2(e[4], e[5]); o.w = pk2(e[6], e[7]);
            GWF[idx] = o;
        }
    }
    {
        LAS float* scr = (LAS float*)(lds + wave * 16384);
        const int gw = bx * NWAVES + wave, NGW = G * NWAVES;
        constexpr int I_1 = (1024 / 64) * (NIN / 32), I_2 = (1024 / 64) * (1024 / 32), NITEMS = 2 * (I_1 + I_2);
        bf16* BT1 = (bf16*)(ws + WS_BT1); bf16* BT2 = (bf16*)(ws + WS_BT2);
        for (int it = gw; it < NITEMS; it += NGW) {
            int r = it;
            if (r < I_1) { p0_transpose_item(a.in[I_WIN], 1024, NIN, BT1, scr, r, lane, true); continue; } r -= I_1;
            if (r < I_1) { p0_transpose_item(a.in[I_WIN] + (size_t)1024 * NIN, 1024, NIN, BT1 + (size_t)NIN * 1024, scr, r, lane, true); continue; } r -= I_1;
            if (r < I_2) { p0_transpose_item(a.in[I_WOUT], 1024, 1024, BT2, scr, r, lane, false); continue; } r -= I_2;
            p0_transpose_item(a.in[I_WOUT] + (size_t)1024 * 1024, 1024, 1024, BT2 + (size_t)1024 * 1024, scr, r, lane, false);
        }
    }
}

__device__ __forceinline__ void norm_phase(const Args& a, int mode, int lane, int wave) {
    unsigned char* ws = a.ws;
    const float* MOD = (const float*)(ws + WS_MOD); bf16* H = (bf16*)(ws + WS_H);
    const int gw = blockIdx.x * NWAVES + wave, NGW = gridDim.x * NWAVES;
    const int nrows = (mode == 2) ? MLAT : MROWS, ln = (mode == 0) ? 0 : 1;
    int cur = -1;
    f32x4 pg0[4], pg1[4], pa[4], ps[4];
#pragma unroll
    for (int j = 0; j < 4; ++j) { pg0[j] = pg1[j] = pa[j] = ps[j] = (f32x4){0.f, 0.f, 0.f, 0.f}; }
    for (int row = gw; row < nrows; row += NGW) {
        const int vsel = row < MLAT ? (row >> 13) : 2;
        const float* src = row < MLAT ? a.in[I_X] + (size_t)row * 1024 : a.in[I_CTX] + (size_t)(row - MLAT) * 1024;
        f32x4 v[4];
#pragma unroll
        for (int j = 0; j < 4; ++j) v[j] = *((const f32x4*)src + lane + 64 * j);
        if (vsel != cur) { cur = vsel;
            if (mode >= 1) { const float* gate = MOD + (0 * 3 + vsel) * 3072 + 2048; const float* gp = a.in[I_GPOST];
#pragma unroll
                for (int j = 0; j < 4; ++j) pg0[j] = *((const f32x4*)gate + lane + 64 * j) * *((const f32x4*)gp + lane + 64 * j); }
            if (mode == 2) { const float* gate = MOD + (1 * 3 + vsel) * 3072 + 2048; const float* gp = a.in[I_GPOST] + 1024;
#pragma unroll
                for (int j = 0; j < 4; ++j) pg1[j] = *((const f32x4*)gate + lane + 64 * j) * *((const f32x4*)gp + lane + 64 * j); }
            if (mode <= 1) { const float* shift = MOD + (ln * 3 + vsel) * 3072; const float* scale = shift + 1024; const float* gpre = a.in[I_GPRE] + ln * 1024;
#pragma unroll
                for (int j = 0; j < 4; ++j) { pa[j] = *((const f32x4*)gpre + lane + 64 * j) * (*((const f32x4*)scale + lane + 64 * j) + 1.0f); ps[j] = *((const f32x4*)shift + lane + 64 * j); } }
        }
#pragma unroll
        for (int lu = 0; lu < 2; ++lu) if (lu < mode) {
            const bf16* MIX = (const bf16*)(ws + WS_MIX) + (size_t)lu * MROWS * 1024;
            f32x4 mx[4]; float sp = 0.f;
#pragma unroll
            for (int j = 0; j < 4; ++j) { const v2u mq = *((const v2u*)(MIX + (size_t)row * 1024) + lane + 64 * j); mx[j] = (f32x4){bflo(mq.x), bfhi(mq.x), bflo(mq.y), bfhi(mq.y)};
                sp += (mx[j].x * mx[j].x + mx[j].y * mx[j].y) + (mx[j].z * mx[j].z + mx[j].w * mx[j].w); }
            const float rstd = rsqrtf(wave_sum(sp) * (1.0f / 1024.0f) + EPSF);
#pragma unroll
            for (int j = 0; j < 4; ++j) v[j] += (lu ? pg1[j] : pg0[j]) * (mx[j] * rstd);
        }
        if (mode == 2) {
            float* dst = a.out + (size_t)row * 1024;
#pragma unroll
            for (int j = 0; j < 4; ++j) *((f32x4*)dst + lane + 64 * j) = v[j];
        } else {
            float s2 = 0.f;
#pragma unroll
            for (int j = 0; j < 4; ++j) s2 += (v[j].x * v[j].x + v[j].y * v[j].y) + (v[j].z * v[j].z + v[j].w * v[j].w);
            const float r = rsqrtf(wave_sum(s2) * (1.0f / 1024.0f) + EPSF);
            v2u* o8 = (v2u*)(H + (size_t)row * 1024);
#pragma unroll
            for (int j = 0; j < 4; ++j) { const f32x4 hv = v[j] * r * pa[j] + ps[j];
                v2u w; w.x = cvtpk(hv.x, hv.y); w.y = cvtpk(hv.z, hv.w); o8[lane + 64 * j] = w; }
        }
    }
}

__device__ __forceinline__ void conv16(const LAS unsigned* vt, const f32x2v (&w2)[31], const f32x2v b2, bf16* ybase, size_t ystride) {
#pragma unroll 1
    for (int tq = 0; tq < 4; ++tq) {
        const LAS unsigned* vq = vt + tq * 4 * 128;
        f32x2v acc[4];
#pragma unroll
        for (int t = 0; t < 4; ++t) acc[t] = b2;
#pragma unroll
        for (int rr = 0; rr < 34; ++rr) { const unsigned u = vq[rr * 128]; const f32x2v x = {bflo(u), bfhi(u)};
#pragma unroll
            for (int t = 0; t < 4; ++t) { const int k = rr - t; if (k >= 0 && k < 31) acc[t] += w2[k] * x; }
            if ((rr & 7) == 7) asm volatile("" ::: "memory"); }
#pragma unroll
        for (int t = 0; t < 4; ++t) *(unsigned*)(ybase + (size_t)(tq * 4 + t) * ystride) = cvtpk(acc[t].x, acc[t].y);
    }
}
__device__ __forceinline__ v4u glu8(const v4u vq, const v4u gq) {
    v4u o;
    o.x = pk2(bflo(vq.x) * sigmoidf_(bflo(gq.x)), bfhi(vq.x) * sigmoidf_(bfhi(gq.x)));
    o.y = pk2(bflo(vq.y) * sigmoidf_(bflo(gq.y)), bfhi(vq.y) * sigmoidf_(bfhi(gq.y)));
    o.z = pk2(bflo(vq.z) * sigmoidf_(bflo(gq.z)), bfhi(vq.z) * sigmoidf_(bfhi(gq.z)));
    o.w = pk2(bflo(vq.w) * sigmoidf_(bflo(gq.w)), bfhi(vq.w) * sigmoidf_(bfhi(gq.w)));
    return o;
}
__device__ __forceinline__ void conv_unit(const Args& a, LAS unsigned char* lds, int l, int grow0, int gstride, int vlo, int vhi, int coff, int cbase, int nrows, int ncall, int orow0, int ostride, int tid) {
    const bf16* U = (const bf16*)(a.ws + WS_U); bf16* Y = (bf16*)(a.ws + WS_Y);
    LAS unsigned* VT = (LAS unsigned*)lds;
    int p = tid & 127; asm volatile("" : "+v"(p));
    const int tg = tid >> 7, c0 = cbase + 2 * p;
    f32x2v w2[31];
#pragma unroll
    for (int k = 0; k < 31; ++k) w2[k] = *(const f32x2v*)(a.in[I_DWW] + (size_t)(l * 31 + k) * 512 + c0);
    const f32x2v b2 = *(const f32x2v*)(a.in[I_DWB] + l * 512 + c0);
    const int nchunk = nrows * 32;
#pragma unroll 1
    for (int i0 = tid; i0 < nchunk; i0 += 3 * NTHR) {
        v4u vq[3];
#pragma unroll
        for (int it = 0; it < 3; ++it) { const int i = i0 + it * NTHR, rr = i >> 5, ch = i & 31, row = grow0 + rr * gstride; const bool ok = i < nchunk && row >= vlo && row < vhi;
            vq[it] = (v4u){0u, 0u, 0u, 0u}; if (ok) vq[it] = *(const v4u*)(U + (size_t)row * NIN + coff + ch * 8); }
#pragma unroll
        for (int it = 0; it < 3; ++it) { const int i = i0 + it * NTHR, rr = i >> 5, ch = i & 31, row = grow0 + rr * gstride; const bool ok = row >= vlo && row < vhi;
            if (i < nchunk) { const v4u z = {0u, 0u, 0u, 0u}; *(LAS v4u*)(VT + rr * 128 + ch * 4) = ok ? vq[it] : z; } }
    }
    __syncthreads();
#pragma unroll 1
    for (int hc = 0; hc < ncall; ++hc) { const int tb = (tg * ncall + hc) * 16;
        conv16(VT + tb * 128 + p, w2, b2, Y + (size_t)(orow0 + tb * ostride) * 512 + c0, (size_t)ostride * 512); }
    __syncthreads();
}
__device__ __forceinline__ void ln_rows(const Args& a, int l, int nrows, int lane, int wave, int nblk) {
    const bf16* U = (const bf16*)(a.ws + WS_U); const bf16* Y = (const bf16*)(a.ws + WS_Y); bf16* MIXIN = (bf16*)(a.ws + WS_MIXIN);
    if ((int)blockIdx.x >= nblk) return;
    const int gw = blockIdx.x * NWAVES + wave, NGW = nblk * NWAVES, c0 = lane * 8;
    float lg[8], lb[8];
#pragma unroll
    for (int e = 0; e < 8; ++e) { lg[e] = a.in[I_LNG][l * 512 + c0 + e]; lb[e] = a.in[I_LNB][l * 512 + c0 + e]; }
    for (int row = gw; row < nrows; row += NGW) {
        const v4u yq = *(const v4u*)(Y + (size_t)row * 512 + c0); const v4u gq = *(const v4u*)(U + (size_t)row * NIN + 2048 + c0);
        float y[8] = {bflo(yq.x), bfhi(yq.x), bflo(yq.y), bfhi(yq.y), bflo(yq.z), bfhi(yq.z), bflo(yq.w), bfhi(yq.w)};
        const float gt[8] = {bflo(gq.x), bfhi(gq.x), bflo(gq.y), bfhi(gq.y), bflo(gq.z), bfhi(gq.z), bflo(gq.w), bfhi(gq.w)};
        float s = 0.f;
#pragma unroll
        for (int e = 0; e < 8; ++e) s += y[e];
        const float mean = wave_sum(s) * (1.0f / 512.0f); float q = 0.f;
#pragma unroll
        for (int e = 0; e < 8; ++e) { y[e] -= mean; q += y[e] * y[e]; }
        const float rstd = rsqrtf(wave_sum(q) * (1.0f / 512.0f) + EPSF);
        float o[8];
#pragma unroll
        for (int e = 0; e < 8; ++e) o[e] = siluf_(y[e] * rstd * lg[e] + lb[e]) * gt[e];
        v4u w; w.x = pk2(o[0], o[1]); w.y = pk2(o[2], o[3]); w.z = pk2(o[4], o[5]); w.w = pk2(o[6], o[7]);
        *(v4u*)(MIXIN + (size_t)row * 1024 + 512 + c0) = w;
    }
}

constexpr int RG_GW = 0, RG_FOLD = 32768, RG_F8 = 36864, RG_CAR = 40960, RG_WAVE = 57344, RG_WAVE_BYTES = 12544;
constexpr int NP16 = 4 * NPJ;
__device__ __forceinline__ float fsig(float x) { return __builtin_amdgcn_rcpf(1.0f + __expf(-x)); }

template <bool FINAL, bool FASTP>
__device__ __forceinline__ void rg_sweep(const Args& a, LAS unsigned char* lds, LAS unsigned char* wl, int l, int b, int h, int r0, int seg_lo, int seg_hi, int pj, bool is_ctx, int w, int lane, const int D) {
    const bf16* U = (const bf16*)(a.ws + WS_U); bf16* MIXIN = (bf16*)(a.ws + WS_MIXIN);
    float* AGGA = (float*)(a.ws + WS_AGGA); float* AGGB = (float*)(a.ws + WS_AGGB); float* A16 = (float*)(a.ws + WS_A16); float* B16 = (float*)(a.ws + WS_B16);
    LAS float* VCW = (LAS float*)wl; LAS unsigned* HBW = (LAS unsigned*)(wl + 4352);
    const LAS v4u* GWL = (const LAS v4u*)(lds + RG_GW) + (D * 2) * 8 * 64 + lane;
    const LAS float* CAR = (const LAS float*)(lds + RG_CAR);
    const int fr = lane & 15, fq = lane >> 4, cp = lane & 31, rh = lane >> 5;
    const int rbase = D ? r0 + 63 : r0, rsign = D ? -1 : 1;
    float2 cw[4];
#pragma unroll
    for (int k = 0; k < 4; ++k) cw[k] = *(const float2*)(a.in[I_CAW] + (size_t)((l * 2 + D) * 4 + (D ? 3 - k : k)) * 512 + 64 * h + 2 * cp);
    const float2 cbv = *(const float2*)(a.in[I_CAB] + (l * 2 + D) * 512 + 64 * h + 2 * cp);
    float brv[4], biv[4], sp8[4], Hc[4], Ac[4];
    const int p16own = 4 * pj + fq;
#pragma unroll
    for (int ct = 0; ct < 4; ++ct) { const int c = 16 * ct + fr, pidx = (l * 2 + D) * 512 + 64 * h + c;
        brv[ct] = a.in[I_BR][pidx]; biv[ct] = a.in[I_BI][pidx]; sp8[ct] = ((const float*)(a.ws + WS_SP8))[pidx];
        Hc[ct] = 0.f; Ac[ct] = 1.f;
        if (FINAL) {
            if (is_ctx) { const size_t base = (size_t)((b * 2 + D) * NP16) * 512 + 64 * h + c; float S = 0.f;
                for (int i = 0; i < p16own; ++i) S = A16[base + (size_t)i * 512] * S + B16[base + (size_t)i * 512];
                Hc[ct] = S; }
            else Hc[ct] = CAR[(D * 32 + 4 * (D ? 7 - w : w) + fq) * 64 + c];
        } }
    const bf16* ub = U + 64 * h + 2 * cp;
    unsigned Wd[2][7], nx[2][4];
#pragma unroll
    for (int q = 0; q < 2; ++q) { const int g = 2 * rh + q;
#pragma unroll
        for (int j = 0; j < 3; ++j) { const int row = rbase + rsign * (16 * g - 3 + j); const bool ok = row >= seg_lo && row < seg_hi; const int rc = ok ? row : r0;
            const unsigned v = *(const unsigned*)(ub + (size_t)rc * NIN); Wd[q][4 + j] = ok ? v : 0u; }
#pragma unroll
        for (int j = 0; j < 4; ++j) nx[q][j] = *(const unsigned*)(ub + (size_t)(rbase + rsign * (16 * g + j)) * NIN); }
#pragma unroll 1
    for (int ti = 0; ti < 4; ++ti) {
        const int tile = ti;
        int zo = 0; asm volatile("" : "+v"(zo));
        const LAS v4u* GWLt = GWL + zo;
        v4u g0 = {0u, 0u, 0u, 0u}, g1 = g0; size_t orow = 0;
        if (FINAL && D == 0) { orow = (size_t)(r0 + 16 * (fr >> 2) + 4 * tile + (fr & 3)); const bf16* gp = U + orow * NIN + 512 + 64 * h + 16 * fq; g0 = *(const v4u*)gp; g1 = *(const v4u*)(gp + 8); }
#pragma unroll
        for (int q = 0; q < 2; ++q) {
            Wd[q][0] = Wd[q][4]; Wd[q][1] = Wd[q][5]; Wd[q][2] = Wd[q][6]; Wd[q][3] = nx[q][0]; Wd[q][4] = nx[q][1]; Wd[q][5] = nx[q][2]; Wd[q][6] = nx[q][3]; }
        if (ti < 3) { const int tn = ti + 1;
#pragma unroll
            for (int q = 0; q < 2; ++q)
#pragma unroll
                for (int j = 0; j < 4; ++j) nx[q][j] = *(const unsigned*)(ub + (size_t)(rbase + rsign * (16 * (2 * rh + q) + 4 * tn + j)) * NIN); }
#pragma unroll
        for (int q = 0; q < 2; ++q)
#pragma unroll
            for (int jj = 0; jj < 4; ++jj) { float v0 = cbv.x, v1 = cbv.y;
#pragma unroll
                for (int k = 0; k < 4; ++k) { const unsigned u = Wd[q][jj + k]; v0 += cw[k].x * bflo(u); v1 += cw[k].y * bfhi(u); }
                *(LAS f32x2v*)(VCW + (4 * (2 * rh + q) + jj) * 68 + 2 * cp) = (f32x2v){v0, v1}; }
        bf16x8 af[2];
#pragma unroll
        for (int kk = 0; kk < 2; ++kk) { const LAS float* vp = VCW + fr * 68 + 32 * kk + 8 * fq; const f32x4 x0 = *(const LAS f32x4*)vp, x1 = *(const LAS f32x4*)(vp + 4);
            v4u pk; pk.x = cvtpk(x0.x, x0.y); pk.y = cvtpk(x0.z, x0.w); pk.z = cvtpk(x1.x, x1.y); pk.w = cvtpk(x1.z, x1.w); af[kk] = __builtin_bit_cast(bf16x8, pk); }
        float vcv[4][4];
#pragma unroll
        for (int ct = 0; ct < 4; ++ct)
#pragma unroll
            for (int jj = 0; jj < 4; ++jj) vcv[ct][jj] = VCW[(4 * fq + jj) * 68 + 16 * ct + fr];
        f32x4 accr[4], acci[4];
#pragma unroll
        for (int ct = 0; ct < 4; ++ct) { accr[ct] = (f32x4){0.f, 0.f, 0.f, 0.f}; acci[ct] = accr[ct];
#pragma unroll
            for (int kk = 0; kk < 2; ++kk) { const bf16x8 br = __builtin_bit_cast(bf16x8, GWLt[(ct * 2 + kk) * 64]), bi = __builtin_bit_cast(bf16x8, GWLt[(8 + ct * 2 + kk) * 64]);
                accr[ct] = __builtin_amdgcn_mfma_f32_16x16x32_bf16(af[kk], br, accr[ct], 0, 0, 0); acci[ct] = __builtin_amdgcn_mfma_f32_16x16x32_bf16(af[kk], bi, acci[ct], 0, 0, 0); } }
        float hsum[4][4];
#pragma unroll
        for (int ct = 0; ct < 4; ++ct) { float aa[4], bb[4];
            const float nbr = -1.44269504f * brv[ct], nbi = -1.44269504f * biv[ct];
#pragma unroll
            for (int p = 0; p < 2; ++p) {
                f32x2v xr = (f32x2v){accr[ct][2 * p], accr[ct][2 * p + 1]} * -1.44269504f + nbr, xi = (f32x2v){acci[ct][2 * p], acci[ct][2 * p + 1]} * -1.44269504f + nbi;
                xr = __builtin_elementwise_min(xr, (f32x2v){60.f, 60.f}); xi = __builtin_elementwise_min(xi, (f32x2v){60.f, 60.f});
                f32x2v d1, d2; d1.x = __builtin_amdgcn_exp2f(xr.x); d1.y = __builtin_amdgcn_exp2f(xr.y); d2.x = __builtin_amdgcn_exp2f(xi.x); d2.y = __builtin_amdgcn_exp2f(xi.y);
                d1 = d1 + 1.0f; d2 = d2 + 1.0f; const f32x2v m = d1 * d2; f32x2v inv; inv.x = __builtin_amdgcn_rcpf(m.x); inv.y = __builtin_amdgcn_rcpf(m.y);
                const f32x2v r = d2 * inv, ig = d1 * inv, la = r * sp8[ct], x2 = la + la, le = la * 1.44269504f;
                f32x2v av, om;
                if (FASTP) { const f32x2v q = la * (la * (la * (la * (la * 0.0083333338f + 0.041666668f) + 0.16666667f) + 0.5f) + 1.0f);
                    av = q + 1.0f; om = -q * (q + 2.0f); }
                else { const f32x2v pom = -x2 * (x2 * (x2 * (x2 * (x2 * 0.0083333338f + 0.041666668f) + 0.16666667f) + 0.5f) + 1.0f);
                    av.x = __builtin_amdgcn_exp2f(le.x); av.y = __builtin_amdgcn_exp2f(le.y);
                    const f32x2v o2 = 1.0f - av * av; om.x = x2.x > -0.25f ? pom.x : o2.x; om.y = x2.y > -0.25f ? pom.y : o2.y;
                    om = __builtin_elementwise_max(om, (f32x2v){0.f, 0.f}); }
                f32x2v sq; sq.x = __builtin_amdgcn_sqrtf(om.x); sq.y = __builtin_amdgcn_sqrtf(om.y);
                const f32x2v bv = sq * (ig * (f32x2v){vcv[ct][2 * p], vcv[ct][2 * p + 1]});
                aa[2 * p] = av.x; aa[2 * p + 1] = av.y; bb[2 * p] = bv.x; bb[2 * p + 1] = bv.y; }
            float hh = Hc[ct], A4 = 1.f;
#pragma unroll
            for (int jj = 0; jj < 4; ++jj) { hh = aa[jj] * hh + bb[jj]; A4 *= aa[jj]; hsum[ct][jj] = hh; }
            Hc[ct] = hh; if (!FINAL) Ac[ct] *= A4; }
        if (FINAL) {
            if (D == 1) {
#pragma unroll
                for (int ct = 0; ct < 4; ++ct)
#pragma unroll
                    for (int jp = 0; jp < 2; ++jp) HBW[(tile * 8 + ct * 2 + jp) * 64 + lane] = cvtpk(hsum[ct][2 * jp], hsum[ct][2 * jp + 1]);
            } else {
#pragma unroll
                for (int ct = 0; ct < 4; ++ct)
#pragma unroll
                    for (int jp = 0; jp < 2; ++jp) {
                        const unsigned hb = HBW[((3 - tile) * 8 + ct * 2 + (1 - jp)) * 64 + fr + 16 * (3 - fq)];
                        VCW[(4 * fq + 2 * jp) * 68 + 16 * ct + fr] = hsum[ct][2 * jp] + bfhi(hb); VCW[(4 * fq + 2 * jp + 1) * 68 + 16 * ct + fr] = hsum[ct][2 * jp + 1] + bflo(hb); }
                const size_t row = orow;
                const f32x4 s0 = *(const LAS f32x4*)(VCW + fr * 68 + 16 * fq), s1 = *(const LAS f32x4*)(VCW + fr * 68 + 16 * fq + 4), s2 = *(const LAS f32x4*)(VCW + fr * 68 + 16 * fq + 8), s3 = *(const LAS f32x4*)(VCW + fr * 68 + 16 * fq + 12);
                v4u o0, o1;
                o0.x = cvtpk(s0.x * bflo(g0.x), s0.y * bfhi(g0.x)); o0.y = cvtpk(s0.z * bflo(g0.y), s0.w * bfhi(g0.y)); o0.z = cvtpk(s1.x * bflo(g0.z), s1.y * bfhi(g0.z)); o0.w = cvtpk(s1.z * bflo(g0.w), s1.w * bfhi(g0.w));
                o1.x = cvtpk(s2.x * bflo(g1.x), s2.y * bfhi(g1.x)); o1.y = cvtpk(s2.z * bflo(g1.y), s2.w * bfhi(g1.y)); o1.z = cvtpk(s3.x * bflo(g1.z), s3.y * bfhi(g1.z)); o1.w = cvtpk(s3.z * bflo(g1.w), s3.w * bfhi(g1.w));
                bf16* op = MIXIN + row * 1024 + 64 * h + 16 * fq; *(v4u*)op = o0; *(v4u*)(op + 8) = o1;
            }
        }
    }
    if (!FINAL) {
#pragma unroll
        for (int ct = 0; ct < 4; ++ct) { const int c = 16 * ct + fr;
            const size_t i16 = (size_t)((b * 2 + D) * NP16 + p16own) * 512 + 64 * h + c; A16[i16] = Ac[ct]; B16[i16] = Hc[ct];
            float Ag[4], Bg[4];
#pragma unroll
            for (int g = 0; g < 4; ++g) { Ag[g] = __shfl(Ac[ct], fr + 16 * g); Bg[g] = __shfl(Hc[ct], fr + 16 * g); }
            float run = 0.f;
#pragma unroll
            for (int g = 0; g < 4; ++g) run = Ag[g] * run + Bg[g];
            if (fq == 0) { const size_t idx = (size_t)((b * 2 + D) * NPJ + pj) * 512 + 64 * h + c; AGGA[idx] = (Ag[0] * Ag[1]) * (Ag[2] * Ag[3]); AGGB[idx] = run; } }
    }
}

template <bool FINAL>
__device__ __forceinline__ void rg_run(const Args& a, LAS unsigned char* lds, int l, int rn, int tid, int lane, int wave) {
    const bool is_ctx = rn >= 256; const int bh = is_ctx ? rn - 256 : rn >> 4, b = bh >> 3, h = bh & 7, cgp = is_ctx ? 0 : (rn & 15);
    { const v4u* GWF = (const v4u*)(a.ws + WS_GWF); LAS v4u* GWL = (LAS v4u*)(lds + RG_GW);
#pragma unroll
      for (int i = tid; i < 2048; i += NTHR) { const int d = i >> 10, g = (i >> 9) & 1, rest = i & 511; GWL[i] = GWF[(size_t)((((l * 2 + d) * 2 + g) * 8 + h) * 8) * 64 + rest]; } }
    const int P0f = 4 + 8 * cgp, P0b = 124 - 8 * cgp;
    if (FINAL && !is_ctx) {
        const float* AGGA = (const float*)(a.ws + WS_AGGA); const float* AGGB = (const float*)(a.ws + WS_AGGB); const float* A16 = (const float*)(a.ws + WS_A16); const float* B16 = (const float*)(a.ws + WS_B16);
        const int d = tid >> 8, s = (tid >> 6) & 3, c = tid & 63, P0 = d ? P0b : P0f, lo = (P0 * s) >> 2, hi = (P0 * (s + 1)) >> 2;
        const size_t b16 = (size_t)((b * 2 + d) * NP16 + 4 * P0 + 8 * s) * 512 + 64 * h + c; float ai8[8], bi8[8];
#pragma unroll
        for (int i = 0; i < 8; ++i) { ai8[i] = A16[b16 + (size_t)i * 512]; bi8[i] = B16[b16 + (size_t)i * 512]; }
        const size_t base = (size_t)((b * 2 + d) * NPJ) * 512 + 64 * h + c; float A = 1.f, Bv = 0.f;
#pragma unroll 8
        for (int i = lo; i < hi; ++i) { const float ai = AGGA[base + (size_t)i * 512], bi = AGGB[base + (size_t)i * 512]; Bv = ai * Bv + bi; A *= ai; }
        LAS float* FO = (LAS float*)(lds + RG_FOLD); LAS float* F8 = (LAS float*)(lds + RG_F8); LAS float* CAR = (LAS float*)(lds + RG_CAR);
        FO[((d * 4 + s) * 64 + c) * 2] = A; FO[((d * 4 + s) * 64 + c) * 2 + 1] = Bv;
        float A8 = 1.f, B8 = 0.f;
#pragma unroll
        for (int i = 0; i < 8; ++i) { B8 = ai8[i] * B8 + bi8[i]; A8 *= ai8[i]; }
        F8[((d * 4 + s) * 64 + c) * 2] = A8; F8[((d * 4 + s) * 64 + c) * 2 + 1] = B8;
        __syncthreads();
        float S = 0.f;
#pragma unroll
        for (int s2 = 0; s2 < 4; ++s2) S = FO[((d * 4 + s2) * 64 + c) * 2] * S + FO[((d * 4 + s2) * 64 + c) * 2 + 1];
#pragma unroll
        for (int s2 = 0; s2 < 3; ++s2) if (s2 < s) S = F8[((d * 4 + s2) * 64 + c) * 2] * S + F8[((d * 4 + s2) * 64 + c) * 2 + 1];
#pragma unroll
        for (int i = 0; i < 8; ++i) { CAR[(d * 32 + 8 * s + i) * 64 + c] = S; S = ai8[i] * S + bi8[i]; }
    }
    __syncthreads();
    if (wave < (is_ctx ? 4 : 8)) {
        const int j = is_ctx ? wave : 8 * cgp + wave;
        const int seg_lo = is_ctx ? MLAT + b * CTXL : b * SEQ, seg_hi = seg_lo + (is_ctx ? CTXL : SEQ), r0 = seg_lo + 64 * j;
        const int pjf = is_ctx ? j : 4 + j, pjb = is_ctx ? 3 - j : 131 - j;
        LAS unsigned char* wl = lds + RG_WAVE + wave * RG_WAVE_BYTES;
        const float* SP8 = (const float*)(a.ws + WS_SP8);
        const bool fast1 = !__any(SP8[(l * 2 + 1) * 512 + 64 * h + lane] < -0.25f), fast0 = !__any(SP8[(l * 2 + 0) * 512 + 64 * h + lane] < -0.25f);
#pragma unroll 1
        for (int it = 0; it < 2; ++it) { const int D = 1 - it, pj = D ? pjb : pjf; const bool fast = D ? fast1 : fast0;
            if (fast) rg_sweep<FINAL, true>(a, lds, wl, l, b, h, r0, seg_lo, seg_hi, pj, is_ctx, wave, lane, D); else rg_sweep<FINAL, false>(a, lds, wl, l, b, h, r0, seg_lo, seg_hi, pj, is_ctx, wave, lane, D); }
    }
    __syncthreads();
}

#define RLX_AGENT __ATOMIC_RELAXED, __HIP_MEMORY_SCOPE_AGENT


#define XB_TMO      128
#define XB_XCNT(j)  (256  + 64 * (j))
#define XB_XSUB(j)  (1280 + 64 * (j))
#define XB_XGEN(j)  (2304 + 64 * (j))
#define XB_TOP      3328
#define XB_TOPGEN   3392
#define XCD_BAR_WORDS 3456
#define XB_SPIN_CAP (1u << 18)

__device__ __forceinline__ unsigned xb_ld(unsigned* p)              { return __hip_atomic_load(p, __ATOMIC_RELAXED, __HIP_MEMORY_SCOPE_AGENT); }
__device__ __forceinline__ unsigned xb_add(unsigned* p, unsigned v) { return __hip_atomic_fetch_add(p, v, __ATOMIC_RELAXED, __HIP_MEMORY_SCOPE_AGENT); }
__device__ __forceinline__ unsigned xb_xcc_id() { return (unsigned)__builtin_amdgcn_s_getreg((3 << 11) | 20) & 0xFu; }
#define XB_SPIN(cond, bar) do { unsigned _sp = 0; while (cond) { __builtin_amdgcn_s_sleep(1); \
    if ((++_sp & 255u) == 0u) { if (xb_ld(&(bar)[XB_TMO])) break; if (_sp > XB_SPIN_CAP) { atomicAdd(&(bar)[XB_TMO], 1u); break; } } } } while (0)

struct XcdBarrier {
    unsigned* bar; unsigned x;
    volatile LAS unsigned* st;
};

__device__ __forceinline__ XcdBarrier xcd_barrier_post(unsigned* bar, volatile LAS unsigned* st) {
    XcdBarrier b; b.bar = bar; b.x = xb_xcc_id(); b.st = st;
    if (threadIdx.x == 0) (void)xb_add(&bar[XB_XCNT(b.x)], 1u);
    return b;
}
__device__ __forceinline__ void xcd_barrier_complete(unsigned* bar, unsigned x, unsigned& nloc, unsigned& nx) {
    const unsigned G = gridDim.x * gridDim.y * gridDim.z;
    unsigned sum, cnt, mine, sp = 0u;
    for (;;) {
        sum = 0u; cnt = 0u; mine = 0u;
#pragma unroll
        for (unsigned j = 0; j < 16; ++j) { const unsigned c = xb_ld(&bar[XB_XCNT(j)]); sum += c; cnt += (c > 0u) ? 1u : 0u; mine = (j == x) ? c : mine; }
        if (sum == G) break;
        __builtin_amdgcn_s_sleep(1);
        if ((++sp & 255u) == 0u) { if (xb_ld(&bar[XB_TMO])) break; if (sp > XB_SPIN_CAP) { atomicAdd(&bar[XB_TMO], 1u); break; } }
    }
    nloc = mine > 0u ? mine : 1u; nx = cnt > 0u ? cnt : 1u;
}

__device__ __forceinline__ void xcd_barrier(const XcdBarrier& b) {
    asm volatile("s_waitcnt vmcnt(0)" ::: "memory");
    __syncthreads();
    if (threadIdx.x == 0) {
        unsigned* bar = b.bar;
        __builtin_amdgcn_s_waitcnt(0);
        unsigned nloc = b.st[0], nx = b.st[1];
        if (nloc == 0u) { xcd_barrier_complete(bar, b.x, nloc, nx); b.st[0] = nloc; b.st[1] = nx; }
        const unsigned old = xb_add(&bar[XB_XSUB(b.x)], 1u);
        const unsigned gen = old / nloc;
        if (old + 1u == (gen + 1u) * nloc) {
            __builtin_amdgcn_fence(__ATOMIC_RELEASE, "agent");
            asm volatile("s_waitcnt vmcnt(0)" ::: "memory");
            const unsigned og = xb_add(&bar[XB_TOP], 1u);
            const unsigned tg = og / nx;
            if (og + 1u == (tg + 1u) * nx) xb_add(&bar[XB_TOPGEN], 1u);
            else XB_SPIN(xb_ld(&bar[XB_TOPGEN]) == tg, bar);
            __builtin_amdgcn_fence(__ATOMIC_ACQUIRE, "agent");
            xb_add(&bar[XB_XGEN(b.x)], 1u);
            asm volatile("s_waitcnt vmcnt(0)" ::: "memory");
        } else {
            XB_SPIN(xb_ld(&bar[XB_XGEN(b.x)]) == gen, bar);
            __builtin_amdgcn_fence(__ATOMIC_ACQUIRE, "agent");
            asm volatile("s_waitcnt vmcnt(0)" ::: "memory");
        }
    }
    __syncthreads();
}

__device__ __forceinline__ void ctx_mix_tiles(const Args& a, int lane, int wave) {
    const bf16* MIXIN = (const bf16*)(a.ws + WS_MIXIN); const bf16* BT2 = (const bf16*)(a.ws + WS_BT2); bf16* MIX = (bf16*)(a.ws + WS_MIX);
    const int NGW = gridDim.x * NWAVES, fr = lane & 15, fq = lane >> 4;
    for (int t = blockIdx.x * NWAVES + wave; t < 32 * 64; t += NGW) {
        const int rg = t >> 6, cg = t & 63;
        const bf16* ap = MIXIN + (size_t)(MLAT + 16 * rg + fr) * 1024 + 8 * fq;
        const bf16* bp = BT2 + (size_t)(16 * cg + fr) * 1024 + 8 * fq;
        f32x4 acc = {0.f, 0.f, 0.f, 0.f};
#pragma unroll 1
        for (int k0 = 0; k0 < 32; k0 += 8) { v4u av[8], bv[8];
#pragma unroll
            for (int i = 0; i < 8; ++i) { av[i] = *(const v4u*)(ap + 32 * (k0 + i)); bv[i] = *(const v4u*)(bp + 32 * (k0 + i)); }
#pragma unroll
            for (int i = 0; i < 8; ++i) acc = __builtin_amdgcn_mfma_f32_16x16x32_bf16(__builtin_bit_cast(bf16x8, av[i]), __builtin_bit_cast(bf16x8, bv[i]), acc, 0, 0, 0); }
        bf16* op = MIX + (size_t)(MLAT + 16 * rg + 4 * fq) * 1024 + 16 * cg + fr;
#pragma unroll
        for (int j = 0; j < 4; ++j) op[(size_t)j * 1024] = (bf16)(cvtpk(acc[j], acc[j]) & 0xffffu);
    }
}

__device__ __forceinline__ void layer_phases(int l, const Args& args, LAS unsigned char* lds, const int tid0, const int lo, const int hi, const XcdBarrier& xbar) {
    const int G = gridDim.x; unsigned char* ws = args.ws;
    const int pb = 1 + 5 * l;
#define LAUNDER() int tid = tid0; asm volatile("" : "+v"(tid)); const int lane = tid & 63, wave = __builtin_amdgcn_readfirstlane(tid >> 6); int bx = blockIdx.x; asm volatile("" : "+s"(bx)); (void)lane; (void)wave; (void)bx
#define IN(k) (lo <= (k) && (k) < hi)
#define SEAM(k) do { if (IN(k) && IN((k) + 1)) { xcd_barrier(xbar); } } while (0)
        if (IN(pb)) { LAUNDER(); norm_phase(args, l, lane, wave); }
        SEAM(pb);
        if (IN(pb + 1)) { LAUNDER();
            pg8::Gemm g{(const pg8::bf16_t*)(ws + WS_H), (const pg8::bf16_t*)(ws + WS_BT1) + (size_t)l * NIN * 1024, MROWS, NIN, 1024};
            pg8::StaticOrder S; S.init(MROWS, NIN, G, bx);
            pg8::EpiU E{(pg8::bf16_t*)(ws + WS_U)};
            pg8::gemm_phase<pg8::EpiU, pg8::StaticOrder, true, true>(lds, g, S, E);
        }
        SEAM(pb + 1);
        if (IN(pb + 2)) { LAUNDER();
            const int nrun = (bx >= G - 16) ? 2 : 1;
#pragma unroll 1
            for (int k = 0; k < nrun; ++k) rg_run<false>(args, lds, l, k == 0 ? bx : 256 + (G - 1 - bx), tid, lane, wave);
            const int n_h = 256 + (l == 0 ? 16 : 0), n_conv = 128 + n_h;
            const int GC = G - 16;
            for (int un = bx; un < n_conv && bx < GC; un += GC) {
                int grow0, gstride, vlo, vhi, coff, cbase, nrows, ncall, orow0, ostride;
                if (un < 128) { const int bb = un >> 6, w = un & 63; vlo = bb * SEQ + w; vhi = vlo + SEQ; grow0 = vlo - 15 * 64; gstride = 64; coff = 1024 + 256; cbase = 256; nrows = 158; ncall = 2; orow0 = vlo; ostride = 64; }
                else { const int hu = un - 128; int r0, g;
                    if (hu < 256) { r0 = hu * 64; g = 0; vlo = r0; vhi = r0 + 64; }
                    else { const int cu = hu - 256, cc = cu >> 1, bb = cc >> 2; g = cu & 1; r0 = MLAT + cc * 64; vlo = MLAT + bb * CTXL; vhi = vlo + CTXL; }
                    grow0 = r0 - 15; gstride = 1; coff = 1024 + g * 256; cbase = g * 256; nrows = 94; ncall = 1; orow0 = r0; ostride = 1; }
                conv_unit(args, lds, l, grow0, gstride, vlo, vhi, coff, cbase, nrows, ncall, orow0, ostride, tid);
            }
        }
        SEAM(pb + 2);
        if (IN(pb + 3)) { LAUNDER();
            const int nrun = (l == 0 && bx >= G - 16) ? 2 : 1;
#pragma unroll 1
            for (int k = 0; k < nrun; ++k) rg_run<true>(args, lds, l, k == 0 ? bx : 256 + (G - 1 - bx), tid, lane, wave);
            ln_rows(args, l, (l == 0) ? MROWS : MLAT, lane, wave, (l == 0) ? G - 16 : G);
        }
        SEAM(pb + 3);
        if (IN(pb + 4)) { LAUNDER();
            const int M2 = MLAT;
            if (l == 0) ctx_mix_tiles(args, lane, wave);
            pg8::Gemm g{(const pg8::bf16_t*)(ws + WS_MIXIN), (const pg8::bf16_t*)(ws + WS_BT2) + (size_t)l * 1024 * 1024, M2, 1024, 1024};
            pg8::StaticOrder S; S.init(M2, 1024, G, bx);
            pg8::EpiMix E{(pg8::bf16_t*)(ws + WS_MIX) + (size_t)l * MROWS * 1024, nullptr};
            pg8::gemm_phase<pg8::EpiMix, pg8::StaticOrder, true, true>(lds, g, S, E);
        }
        SEAM(pb + 4);
#undef IN
#undef SEAM
#undef LAUNDER
}

__global__ void __launch_bounds__(NTHR, 2) fwd_megakernel(Args args) {
    extern __shared__ __attribute__((aligned(16))) unsigned char lds_raw[];
    LAS unsigned char* lds = (LAS unsigned char*)lds_raw;
    const int tid = threadIdx.x, lane = tid & 63, wave = __builtin_amdgcn_readfirstlane(tid >> 6);
    const int G = gridDim.x, bx = blockIdx.x;
    unsigned char* ws = args.ws;
    const int lo = args.ph_lo, hi = args.ph_hi;
    if (args.coop == 2) cg::this_grid().sync();
    volatile LAS unsigned* MISC = (volatile LAS unsigned*)(lds + MISC_OFF);
    if (tid < 64) MISC[tid] = 0u;
    __syncthreads();
    XcdBarrier xbar; xbar.bar = (unsigned*)(ws + WS_CTL); xbar.x = 0; xbar.st = nullptr;
    if (args.coop == 1) xbar = xcd_barrier_post((unsigned*)(ws + WS_CTL), MISC + 8);
#define IN(k) (lo <= (k) && (k) < hi)
#define SEAM(k) do { if (IN(k) && IN((k) + 1)) { xcd_barrier(xbar); } } while (0)

    if (IN(0)) { p0_prologue(args, lds, tid, lane, wave); }
    SEAM(0);
#pragma unroll 1
    for (int l = 0; l < 2; ++l) { int lo_ = l; asm volatile("" : "+s"(lo_)); layer_phases(lo_, args, lds, tid, lo, hi, xbar); }
    if (IN(11)) { norm_phase(args, 2, lane, wave); }
#undef IN
#undef SEAM
}

#ifndef MK_PER_PHASE
#define MK_PER_PHASE 0
#endif
extern "C" void kernel_launch(void* const* d_in, const int* in_sizes, int n_in, void* d_out, int out_size, void* d_ws, size_t ws_size, hipStream_t stream) {
    static int grid = 0;
    if (grid == 0) {
        if (n_in != 21 || out_size != MLAT * DM || ws_size < WS_END) { fprintf(stderr, "kernel_launch: unexpected shapes (n_in %d, out %d, ws %zu)\n", n_in, out_size, ws_size); grid = -1; return; }
        int dev = 0, cus = 0, per_cu = 0;
        if (hipGetDevice(&dev) != hipSuccess || hipDeviceGetAttribute(&cus, hipDeviceAttributeMultiprocessorCount, dev) != hipSuccess) { grid = -1; return; }
        if (hipFuncSetAttribute((const void*)fwd_megakernel, hipFuncAttributeMaxDynamicSharedMemorySize, LDS_BYTES) != hipSuccess) { fprintf(stderr, "kernel_launch: hipFuncSetAttribute failed\n"); grid = -1; return; }
        if (hipOccupancyMaxActiveBlocksPerMultiprocessor(&per_cu, (const void*)fwd_megakernel, NTHR, LDS_BYTES) != hipSuccess || per_cu < 1) { fprintf(stderr, "kernel_launch: occupancy query says %d\n", per_cu); per_cu = 1; }
        (void)hipGetLastError();
        grid = cus;
    }
    if (grid < 0) return;
    if (hipMemsetAsync((char*)d_ws + WS_CTL, 0, CTL_ZERO_BYTES, stream) != hipSuccess) { fprintf(stderr, "kernel_launch: memset failed\n"); return; }
    Args a{};
    for (int i = 0; i < 21; ++i) a.in[i] = (const float*)d_in[i];
    a.out = (float*)d_out; a.ws = (unsigned char*)d_ws;
#if MK_PER_PHASE
    for (int ph = 0; ph < 12; ++ph) { a.ph_lo = ph; a.ph_hi = ph + 1; a.coop = 0;
        hipLaunchKernelGGL(fwd_megakernel, dim3(grid), dim3(NTHR), LDS_BYTES, stream, a); }
#else
    a.ph_lo = 0; a.ph_hi = 12; a.coop = 1;
    void* kargs[] = {&a};
    hipError_t e = hipLaunchCooperativeKernel((const void*)fwd_megakernel, dim3(grid), dim3(NTHR), kargs, LDS_BYTES, stream);
    if (e != hipSuccess) fprintf(stderr, "cooperative launch failed: %s (grid %d)\n", hipGetErrorString(e), grid);
#endif
}
```

```cpp
#include <hip/hip_runtime.h>
#include <hip/hip_cooperative_groups.h>
#include <cstdio>
#include <cstdint>
namespace cg = cooperative_groups;
#define MK_PER_PHASE 0
namespace pg8 {
#define PG8_LAS __attribute__((address_space(3)))
typedef unsigned short bf16_t;
typedef short bf16x8 __attribute__((ext_vector_type(8)));
typedef float f32x4 __attribute__((ext_vector_type(4)));
typedef unsigned u32x4 __attribute__((ext_vector_type(4)));
constexpr int BM = 256, BK = 64, HALF = 128, HTB = HALF * BK * 2  , STAGE_BYTES = 8 * HTB, NXCD = 8, WGM = 8;

__host__ __device__ __forceinline__ int lds_byte(int r, int c) { const int st = (r >> 4) * 2 + (c >> 5), rr = r & 15, cc = c & 31, ob = rr * 64 + cc * 2; return st * 1024 + (ob ^ (((ob >> 9) & 1) << 5)); }
__host__ __device__ __forceinline__ void stage_rc(int b, int& R, int& C) { const int st = b / 1024, sb = b % 1024, swz = sb ^ (((sb >> 9) & 1) << 5); R = (st >> 1) * 16 + swz / 64; C = (st & 1) * 32 + (swz % 64) / 2; }
__host__ __device__ __forceinline__ int perm32(int rho) { const int n = rho >> 4, i = rho & 15; return 8 * (i >> 2) + 4 * n + (i & 3); }

struct Unit { int pm, pn; };
struct Gemm { const bf16_t* A; const bf16_t* Bt; int M, N, K; };

struct StaticOrder {
    int nM, nN, nwg, G, c;
    __host__ __device__ void init(int M, int N, int G_, int c_) { nM = M / BM; nN = N / BM; nwg = nM * nN; G = G_; c = c_; }
    __host__ __device__ bool next(int i, Unit& u) const {
        const long L = (long)i * G + c; if (L >= nwg) return false;
        int wgid = (int)L; { const int q = nwg / NXCD, r = nwg % NXCD, xcd = wgid % NXCD, off = wgid / NXCD; wgid = (xcd < r ? xcd * (q + 1) : r * (q + 1) + (xcd - r) * q) + off; }
        const int nig = WGM * nN, gid = wgid / nig, fm = gid * WGM, gsz = (nM - fm) < WGM ? (nM - fm) : WGM;
        u.pm = fm + ((wgid % nig) % gsz); u.pn = (wgid % nig) / gsz; return true;
    }
    __device__ __forceinline__ void a_ready(const Unit&) const {}
    __device__ __forceinline__ void done(const Unit&) const {}
};
__device__ __forceinline__ unsigned cvt_pk_bf16(float lo, float hi) { unsigned r; asm volatile("v_cvt_pk_bf16_f32 %0, %1, %2" : "=v"(r) : "v"(lo), "v"(hi)); return r; }
typedef float f32x2 __attribute__((ext_vector_type(2)));
template <class Epi, class Sched, bool ALIGN_EPI = false, bool SP2 = false>
__device__ __forceinline__ void gemm_phase(PG8_LAS unsigned char* lds, const Gemm g, const Sched& S, const Epi& E) {
    const int tid = threadIdx.x, wid = __builtin_amdgcn_readfirstlane(tid >> 6), lane = tid & 63, wr = wid >> 2, wc = wid & 3, fr = lane & 15, fq = lane >> 4;
    const int K = g.K, nt = K / BK;
    unsigned voffA[2], voffB[2];
#pragma unroll
    for (int i = 0; i < 2; ++i) { int R, C; stage_rc(tid * 16 + i * 8192, R, C); const int Rb = Epi::PERM ? ((R & ~31) + perm32(R & 31)) : R;
        voffA[i] = (unsigned)(R * K + C) * 2u; voffB[i] = (unsigned)(Rb * K + C) * 2u; }
    const size_t kstep = (size_t)(BK * 2);
    const size_t hstep = (size_t)HALF * K * 2;
    const size_t tstep = 2 * hstep;
    const unsigned ldsw = (unsigned)wid * 1024u;
    const int aoff = lds_byte(wr * 64 + fr, fq * 8), boff = lds_byte(wc * 32 + fr, fq * 8);
#define PG8_SA(b, h) (((b) * 2 + (h)) * HTB)
#define PG8_SB(b, h) ((4 + (b) * 2 + (h)) * HTB)
#define PG8_STAGE(bufoff, gbase, voff) do { _Pragma("unroll") for (int _i = 0; _i < 2; ++_i) \
        __builtin_amdgcn_global_load_lds((const unsigned*)((const char*)(gbase) + (voff)[_i]), (PG8_LAS unsigned*)(lds + (bufoff) + ldsw + _i * 8192), 16, 0, 0); } while (0)
#define PG8_LDA(dst, b, h) do { _Pragma("unroll") for (int m = 0; m < 4; ++m) _Pragma("unroll") for (int k = 0; k < 2; ++k) dst[m][k] = *(const PG8_LAS bf16x8*)(lds + PG8_SA(b, h) + aoff + m * 2048 + k * 1024); } while (0)
#define PG8_LDB(dst, b, h) do { _Pragma("unroll") for (int n = 0; n < 2; ++n) _Pragma("unroll") for (int k = 0; k < 2; ++k) dst[n][k] = *(const PG8_LAS bf16x8*)(lds + PG8_SB(b, h) + boff + n * 2048 + k * 1024); } while (0)
#define PG8_MMA(ai, bj, At, Bt) do { __builtin_amdgcn_s_setprio(1); _Pragma("unroll") for (int m = 0; m < 4; ++m) _Pragma("unroll") for (int n = 0; n < 2; ++n) _Pragma("unroll") for (int k = 0; k < 2; ++k) \
        acc[ai][bj][m][n] = __builtin_amdgcn_mfma_f32_16x16x32_bf16(Bt[n][k], At[m][k], acc[ai][bj][m][n], 0, 0, 0); __builtin_amdgcn_s_setprio(0); } while (0)
#define PG8_WAIT_V(n) asm volatile("s_waitcnt vmcnt(" #n ")" ::: "memory")
#define PG8_WAIT_L(n) asm volatile("s_waitcnt lgkmcnt(" #n ")" ::: "memory")
#define PG8_BAR __builtin_amdgcn_s_barrier()
#define PG8_SCHED __builtin_amdgcn_sched_barrier(0)
    Unit cur, nxt; int ui = 0;
    if (!S.next(0, cur)) return;
    f32x4 acc[2][2][4][2];
#pragma unroll
    for (int a = 0; a < 2; ++a)
#pragma unroll
        for (int b = 0; b < 2; ++b)
#pragma unroll
            for (int m = 0; m < 4; ++m)
#pragma unroll
                for (int n = 0; n < 2; ++n) acc[a][b][m][n] = (f32x4){0.f, 0.f, 0.f, 0.f};
    bf16x8 At[4][2], B0[2][2], B1[2][2];
    const char* cA = (const char*)g.A + (size_t)cur.pm * tstep; const char* cB = (const char*)g.Bt + (size_t)cur.pn * tstep;
    S.a_ready(cur);
    if constexpr (SP2) {
        PG8_STAGE(PG8_SB(0, 0), cB, voffB); PG8_STAGE(PG8_SB(0, 1), cB + hstep, voffB); PG8_STAGE(PG8_SA(0, 0), cA, voffA); PG8_STAGE(PG8_SA(0, 1), cA + hstep, voffA);
        if (wr == 1) PG8_BAR;
        PG8_WAIT_V(2); PG8_BAR;
        PG8_STAGE(PG8_SB(1, 0), cB + kstep, voffB); PG8_STAGE(PG8_SA(1, 0), cA + kstep, voffA); PG8_STAGE(PG8_SB(1, 1), cB + hstep + kstep, voffB);
        PG8_WAIT_V(6); PG8_BAR;
    } else {
        PG8_STAGE(PG8_SB(0, 0), cB, voffB); PG8_STAGE(PG8_SA(0, 0), cA, voffA); PG8_STAGE(PG8_SB(0, 1), cB + hstep, voffB); PG8_STAGE(PG8_SA(0, 1), cA + hstep, voffA);
        if (wr == 1) PG8_BAR;
        PG8_WAIT_V(4); PG8_BAR;
        PG8_STAGE(PG8_SB(1, 0), cB + kstep, voffB); PG8_STAGE(PG8_SA(1, 0), cA + kstep, voffA); PG8_STAGE(PG8_SB(1, 1), cB + hstep + kstep, voffB);
        PG8_WAIT_V(6); PG8_BAR;
    }
    for (;;) {
        const bool has_next = S.next(ui + 1, nxt);
        const char* nA = has_next ? (const char*)g.A + (size_t)nxt.pm * tstep : cA; const char* nB = has_next ? (const char*)g.Bt + (size_t)nxt.pn * tstep : cB;
        for (int t = 0; t < nt; t += 2) {
            const bool last = (t == nt - 2);
            const char* a1 = cA + (size_t)(t + 1) * kstep;
            const char* a2 = last ? nA : cA + (size_t)(t + 2) * kstep; const char* b2 = last ? nB : cB + (size_t)(t + 2) * kstep;
            const char* a3 = a2 + kstep; const char* b3 = b2 + kstep;
            if (last && has_next) S.a_ready(nxt);
            if constexpr (SP2) {
            PG8_LDB(B0, 0, 0); PG8_LDB(B1, 0, 1); PG8_SCHED; PG8_LDA(At, 0, 0); PG8_STAGE(PG8_SA(1, 1), a1 + hstep, voffA);
            PG8_WAIT_V(8); PG8_WAIT_L(0); PG8_BAR; PG8_MMA(0, 0, At, B0); PG8_MMA(0, 1, At, B1); PG8_BAR; PG8_SCHED;
            PG8_LDA(At, 0, 1); PG8_STAGE(PG8_SB(0, 0), b2, voffB); PG8_STAGE(PG8_SB(0, 1), b2 + hstep, voffB); PG8_STAGE(PG8_SA(0, 0), a2, voffA);
            PG8_WAIT_V(8); PG8_WAIT_L(0); PG8_BAR; PG8_MMA(1, 0, At, B0); PG8_MMA(1, 1, At, B1); PG8_BAR; PG8_SCHED;
            PG8_LDB(B0, 1, 0); PG8_LDB(B1, 1, 1); PG8_SCHED; PG8_LDA(At, 1, 0); PG8_STAGE(PG8_SA(0, 1), a2 + hstep, voffA);
            PG8_WAIT_V(8); PG8_WAIT_L(0); PG8_BAR; PG8_MMA(0, 0, At, B0); PG8_MMA(0, 1, At, B1); PG8_BAR; PG8_SCHED;
            PG8_LDA(At, 1, 1); PG8_STAGE(PG8_SB(1, 0), b3, voffB); PG8_STAGE(PG8_SB(1, 1), b3 + hstep, voffB); PG8_STAGE(PG8_SA(1, 0), a3, voffA);
            PG8_WAIT_V(8); PG8_WAIT_L(0); PG8_BAR; PG8_MMA(1, 0, At, B0); PG8_MMA(1, 1, At, B1); PG8_BAR; PG8_SCHED;
            } else {
            PG8_LDB(B0, 0, 0); PG8_SCHED; PG8_LDA(At, 0, 0); PG8_STAGE(PG8_SA(1, 1), a1 + hstep, voffA);
            PG8_WAIT_L(8); PG8_BAR; PG8_WAIT_L(0); PG8_MMA(0, 0, At, B0); PG8_BAR; PG8_SCHED;
            PG8_LDB(B1, 0, 1); PG8_STAGE(PG8_SB(0, 0), b2, voffB);
            PG8_BAR; PG8_WAIT_L(0); PG8_MMA(0, 1, At, B1); PG8_BAR;
            PG8_LDA(At, 0, 1); PG8_STAGE(PG8_SA(0, 0), a2, voffA);
            PG8_BAR; PG8_WAIT_L(0); PG8_MMA(1, 0, At, B0); PG8_BAR; PG8_SCHED;
            PG8_STAGE(PG8_SB(0, 1), b2 + hstep, voffB);
            PG8_WAIT_V(6); PG8_BAR; PG8_MMA(1, 1, At, B1); PG8_BAR;
            PG8_LDB(B0, 1, 0); PG8_SCHED; PG8_LDA(At, 1, 0); PG8_STAGE(PG8_SA(0, 1), a2 + hstep, voffA);
            PG8_WAIT_L(8); PG8_BAR; PG8_WAIT_L(0); PG8_MMA(0, 0, At, B0); PG8_BAR; PG8_SCHED;
            PG8_LDB(B1, 1, 1); PG8_STAGE(PG8_SB(1, 0), b3, voffB);
            PG8_BAR; PG8_WAIT_L(0); PG8_MMA(0, 1, At, B1); PG8_BAR;
            PG8_LDA(At, 1, 1); PG8_STAGE(PG8_SA(1, 0), a3, voffA);
            PG8_BAR; PG8_WAIT_L(0); PG8_MMA(1, 0, At, B0); PG8_BAR; PG8_SCHED;
            PG8_STAGE(PG8_SB(1, 1), b3 + hstep, voffB);
            PG8_WAIT_V(6); PG8_BAR; PG8_MMA(1, 1, At, B1); PG8_BAR;
            }
        }
        if constexpr (ALIGN_EPI) { if (wr == 0) PG8_BAR; }
        if constexpr (!Epi::AFTER_DRAIN) { E(acc, cur, wr, wc, fr, fq); S.done(cur); }
        if (!has_next) break;
#pragma unroll
        for (int a = 0; a < 2; ++a)
#pragma unroll
            for (int b = 0; b < 2; ++b)
#pragma unroll
                for (int m = 0; m < 4; ++m)
#pragma unroll
                    for (int n = 0; n < 2; ++n) acc[a][b][m][n] = (f32x4){0.f, 0.f, 0.f, 0.f};
        cur = nxt; cA = nA; cB = nB; ++ui;
        if constexpr (ALIGN_EPI) { if (wr == 1) PG8_BAR; }
    }
    PG8_WAIT_V(0);
    if constexpr (!ALIGN_EPI) { if (wr == 0) PG8_BAR; }
    PG8_BAR;
    if constexpr (Epi::AFTER_DRAIN) { E.fused(acc, cur, wr, wc, fr, fq, lds, wid, lane); S.done(cur); }
#undef PG8_SA
#undef PG8_SB
#undef PG8_STAGE
#undef PG8_LDA
#undef PG8_LDB
#undef PG8_MMA
#undef PG8_WAIT_V
#undef PG8_WAIT_L
#undef PG8_BAR
#undef PG8_SCHED
}
}

constexpr int DM = 1024, NB = 2, SEQ = 8192, CTXL = 256, MLAT = NB * SEQ, MCTX = NB * CTXL, MROWS = MLAT + MCTX;
constexpr int NIN = 2560, NCHUNK = MROWS / 64  , NPJ = 132  ;
constexpr float EPSF = 1e-6f;
constexpr int NWAVES = 8, NTHR = 512;

constexpr size_t MiB = 1u << 20;
constexpr size_t WS_CTL = 0, CTL_ZERO_BYTES = 64 * 1024;
constexpr size_t WS_MOD = 1 * MiB;
constexpr size_t WS_SP8 = 1 * MiB + 128 * 1024;
constexpr size_t WS_GWF = 1 * MiB + 256 * 1024;
constexpr size_t WS_BT1 = 2 * MiB;
constexpr size_t WS_BT2 = 12 * MiB;
constexpr size_t WS_AGGA = 16 * MiB;
constexpr size_t WS_AGGB = 16 * MiB + 1536 * 1024;
constexpr size_t WS_SSQ = 19 * MiB;
constexpr size_t WS_SSQ1 = 21 * MiB;
constexpr size_t WS_A16 = 23 * MiB;
constexpr size_t WS_B16 = 28 * MiB;
constexpr size_t WS_H = 73 * MiB;
constexpr size_t WS_Y = 56 * MiB;
constexpr size_t WS_MIXIN = 73 * MiB;
constexpr size_t WS_U = 106 * MiB;
constexpr size_t WS_MIX = 189 * MiB;
constexpr size_t WS_END = 255 * MiB;

constexpr int LDS_BYTES = 158720;
constexpr int MISC_OFF = 157696;

#define LAS __attribute__((address_space(3)))
typedef unsigned short bf16;
typedef unsigned v4u __attribute__((ext_vector_type(4)));
typedef unsigned v2u __attribute__((ext_vector_type(2)));
typedef float f32x4 __attribute__((ext_vector_type(4)));
typedef short bf16x8 __attribute__((ext_vector_type(8)));
typedef float f32x2v __attribute__((ext_vector_type(2)));
#define LDS_WAIT() asm volatile("s_waitcnt lgkmcnt(0)" ::: "memory")

__device__ __forceinline__ unsigned f2bf(float f) { unsigned u = __builtin_bit_cast(unsigned, f); return (u + 0x7fffu + ((u >> 16) & 1u)) >> 16; }
__device__ __forceinline__ unsigned pk2(float lo, float hi) { return f2bf(lo) | (f2bf(hi) << 16); }
__device__ __forceinline__ unsigned cvtpk(float lo, float hi) { unsigned r; asm volatile("v_cvt_pk_bf16_f32 %0, %1, %2" : "=v"(r) : "v"(lo), "v"(hi)); return r; }
__device__ __forceinline__ float bflo(unsigned u) { return __builtin_bit_cast(float, u << 16); }
__device__ __forceinline__ float bfhi(unsigned u) { return __builtin_bit_cast(float, u & 0xffff0000u); }
__device__ __forceinline__ float sigmoidf_(float x) { return 1.0f / (1.0f + __expf(-x)); }
__device__ __forceinline__ float siluf_(float x) { return x * __builtin_amdgcn_rcpf(1.0f + __builtin_amdgcn_exp2f(-1.44269504f * x)); }
__device__ __forceinline__ float wave_sum(float v) {
#pragma unroll
    for (int o = 1; o < 64; o <<= 1) v += __shfl_xor(v, o);
    return v;
}

struct Args {
    const float* in[21]; float* out; unsigned char* ws; int ph_lo, ph_hi, coop, pad;
};
enum { I_X = 0, I_C, I_CTX, I_CCTX, I_WMOD, I_BMOD, I_GPRE, I_GPOST, I_WIN, I_CAW, I_CAB, I_WR, I_BR, I_WI, I_BI, I_LAM, I_DWW, I_DWB, I_LNG, I_LNB, I_WOUT };

namespace pg8 {
__device__ __forceinline__ void st16_wt(void* p, u32x4 w) { asm volatile("global_store_dwordx4 %0, %1, off sc1\n\ts_nop 1" :: "v"(p), "v"(w) : "memory"); }
struct EpiU {
    static constexpr bool PERM = true, AFTER_DRAIN = false;
    bf16_t* O;
    __device__ __forceinline__ void operator()(const f32x4 (&acc)[2][2][4][2], const Unit& u, int wr, int wc, int fr, int fq) const {
        const int row0 = u.pm * BM + wr * 64 + fr;
        if (u.pn >= 4 && u.pn < 8) {
            const int col0 = 1024 + 128 * (u.pn - 4) + wc * 32 + 8 * fq;
#pragma unroll
            for (int ai = 0; ai < 2; ++ai)
#pragma unroll
                for (int m = 0; m < 4; ++m) { f32x4 v0 = acc[ai][0][m][0], v1 = acc[ai][0][m][1]; const f32x4 g0 = acc[ai][1][m][0], g1 = acc[ai][1][m][1];
#pragma unroll
                    for (int e = 0; e < 4; ++e) { v0[e] = v0[e] * __builtin_amdgcn_rcpf(1.0f + __builtin_amdgcn_exp2f(-1.44269504f * g0[e])); v1[e] = v1[e] * __builtin_amdgcn_rcpf(1.0f + __builtin_amdgcn_exp2f(-1.44269504f * g1[e])); }
                    u32x4 w; w.x = cvt_pk_bf16(v0[0], v0[1]); w.y = cvt_pk_bf16(v0[2], v0[3]); w.z = cvt_pk_bf16(v1[0], v1[1]); w.w = cvt_pk_bf16(v1[2], v1[3]);
                    *(u32x4*)(O + (size_t)(row0 + ai * HALF + m * 16) * 2560 + col0) = w; }
            return;
        }
        const int col0 = u.pn * BM + wc * 32 + 8 * fq;
        const bool act = (u.pn == 2 || u.pn == 3 || u.pn >= 8);
#pragma unroll
        for (int ai = 0; ai < 2; ++ai)
#pragma unroll
            for (int m = 0; m < 4; ++m) { bf16_t* rowp = O + (size_t)(row0 + ai * HALF + m * 16) * 2560 + col0;
#pragma unroll
                for (int bj = 0; bj < 2; ++bj) { f32x4 v0 = acc[ai][bj][m][0], v1 = acc[ai][bj][m][1];
                    if (act) {
#pragma unroll
                        for (int e = 0; e < 4; ++e) { v0[e] = v0[e] * __builtin_amdgcn_rcpf(1.0f + __builtin_amdgcn_exp2f(-1.44269504f * v0[e])); v1[e] = v1[e] * __builtin_amdgcn_rcpf(1.0f + __builtin_amdgcn_exp2f(-1.44269504f * v1[e])); }
                    }
                    u32x4 w; w.x = cvt_pk_bf16(v0[0], v0[1]); w.y = cvt_pk_bf16(v0[2], v0[3]); w.z = cvt_pk_bf16(v1[0], v1[1]); w.w = cvt_pk_bf16(v1[2], v1[3]);
                    *(u32x4*)(rowp + bj * HALF) = w; } }
    }
};
struct EpiMix {
    static constexpr bool PERM = true, AFTER_DRAIN = false;
    bf16_t* O; unsigned* cnt;
    __device__ __forceinline__ void operator()(const f32x4 (&acc)[2][2][4][2], const Unit& u, int wr, int wc, int fr, int fq) const {
        const int col0 = u.pn * BM + wc * 32 + 8 * fq;
#pragma unroll
        for (int ai = 0; ai < 2; ++ai)
#pragma unroll
            for (int m = 0; m < 4; ++m) { const int r = u.pm * BM + ai * HALF + wr * 64 + m * 16 + fr; bf16_t* rowp = O + (size_t)r * 1024 + col0;
#pragma unroll
                for (int bj = 0; bj < 2; ++bj) { const f32x4 v0 = acc[ai][bj][m][0], v1 = acc[ai][bj][m][1];
                    u32x4 w; w.x = cvt_pk_bf16(v0[0], v0[1]); w.y = cvt_pk_bf16(v0[2], v0[3]); w.z = cvt_pk_bf16(v1[0], v1[1]); w.w = cvt_pk_bf16(v1[2], v1[3]);
                    if (cnt) st16_wt(rowp + bj * HALF, w); else *(u32x4*)(rowp + bj * HALF) = w; } }
        if (cnt) { asm volatile("s_waitcnt vmcnt(0)" ::: "memory");
            if (fr == 0 && fq == 0) __hip_atomic_fetch_add(cnt + 64 * u.pm, 1u, __ATOMIC_RELAXED, __HIP_MEMORY_SCOPE_AGENT); }
    }
};
}

__device__ __forceinline__ void p0_transpose_item(const float* W, int K, int N, bf16* WT, LAS float* scr, int item, int lane, bool glu_remap) {
    const int nblk = N / 32, kb = item / nblk, nb = item % nblk, k0 = 64 * kb, n0 = 32 * nb;
    int nd = n0;
    if (glu_remap) { if (n0 >= 1024 && n0 < 1536) nd = 1024 + 256 * ((n0 - 1024) >> 7) + ((n0 - 1024) & 127); else if (n0 >= 1536 && n0 < 2048) nd = 1024 + 256 * ((n0 - 1536) >> 7) + 128 + ((n0 - 1536) & 127); }
#pragma unroll 32
    for (int i = 0; i < 32; ++i) { const int kk = 2 * i + (lane >> 5); scr[kk * 33 + (lane & 31)] = W[(size_t)(k0 + kk) * N + n0 + (lane & 31)]; }
    LDS_WAIT(); asm volatile("" ::: "memory");
    const int c = lane & 7;
#pragma unroll
    for (int j = 0; j < 4; ++j) { const int n = (lane >> 3) + 8 * j; const LAS float* s = scr + (8 * c) * 33 + n;
        v4u o; o.x = pk2(s[0 * 33], s[1 * 33]); o.y = pk2(s[2 * 33], s[3 * 33]); o.z = pk2(s[4 * 33], s[5 * 33]); o.w = pk2(s[6 * 33], s[7 * 33]);
        *(v4u*)(WT + (size_t)(nd + n) * K + k0 + 8 * c) = o; }
    LDS_WAIT(); asm volatile("" ::: "memory");
}

__device__ __forceinline__ void p0_prologue(const Args& a, LAS unsigned char* lds, int tid, int lane, int wave) {
    const int G = gridDim.x, bx = blockIdx.x;
    unsigned char* ws = a.ws;
    {
        LAS float* part = (LAS float*)lds;
        float* MOD = (float*)(ws + WS_MOD);
        const float* c = a.in[I_C]; const float* cctx = a.in[I_CCTX];
        for (int un = bx; un < 192; un += G) {
            const int l = un / 96, n0 = (un % 96) * 32, cq = tid & 7, ks = tid >> 3;
            const float* wm = a.in[I_WMOD] + (size_t)l * 1024 * 3072 + n0 + cq * 4;
            f32x4 acc0 = {0.f, 0.f, 0.f, 0.f}, acc1 = acc0, acc2 = acc0;
#pragma unroll 4
            for (int kk = 0; kk < 16; ++kk) { const int k = ks * 16 + kk; const f32x4 w = *(const f32x4*)(wm + (size_t)k * 3072);
                const float a0 = siluf_(c[k]), a1 = siluf_(c[1024 + k]), a2 = siluf_(cctx[k]);
                acc0 += w * a0; acc1 += w * a1; acc2 += w * a2; }
            *(LAS f32x4*)(part + (0 * 64 + ks) * 32 + cq * 4) = acc0;
            *(LAS f32x4*)(part + (1 * 64 + ks) * 32 + cq * 4) = acc1;
            *(LAS f32x4*)(part + (2 * 64 + ks) * 32 + cq * 4) = acc2;
            __syncthreads();
            if (tid < 96) { const int v = tid >> 5, col = tid & 31; float s = a.in[I_BMOD][l * 3072 + n0 + col];
                for (int k2 = 0; k2 < 64; ++k2) s += part[(v * 64 + k2) * 32 + col];
                MOD[(l * 3 + v) * 3072 + n0 + col] = s; }
            __syncthreads();
        }
    }
    { float* SP8 = (float*)(ws + WS_SP8); for (int idx = bx * NTHR + tid; idx < 2048; idx += G * NTHR) SP8[idx] = -8.0f * log1pf(__expf(-a.in[I_LAM][idx])); }
    {
        v4u* GWF = (v4u*)(ws + WS_GWF);
        for (int idx = bx * NTHR + tid; idx < 32768; idx += G * NTHR) {
            const int ln = idx & 63, kk = (idx >> 6) & 1, ct = (idx >> 7) & 3, h = (idx >> 9) & 7, g = (idx >> 12) & 1, d = (idx >> 13) & 1, l = idx >> 14;
            const float* W = (g == 0 ? a.in[I_WR] : a.in[I_WI]) + (size_t)(((l * 2 + d) * 8 + h) * 64) * 64;
            const int k0 = 32 * kk + 8 * (ln >> 4), col = 16 * ct + (ln & 15);
            float e[8];
#pragma unroll
            for (int j = 0; j < 8; ++j) e[j] = W[(k0 + j) * 64 + col];
            v4u o; o.x = pk2(e[0], e[1]); o.y = pk2(e[2], e[3]); o.z = pk2(e[4], e[5]); o.w = pk2(e[6], e[7]);
            GWF[idx] = o;
        }
    }
    {
        LAS float* scr = (LAS float*)(lds + wave * 16384);
        const int gw = bx * NWAVES + wave, NGW = G * NWAVES;
        constexpr int I_1 = (1024 / 64) * (NIN / 32), I_2 = (1024 / 64) * (1024 / 32), NITEMS = 2 * (I_1 + I_2);
        bf16* BT1 = (bf16*)(ws + WS_BT1); bf16* BT2 = (bf16*)(ws + WS_BT2);
        for (int it = gw; it < NITEMS; it += NGW) {
            int r = it;
            if (r < I_1) { p0_transpose_item(a.in[I_WIN], 1024, NIN, BT1, scr, r, lane, true); continue; } r -= I_1;
            if (r < I_1) { p0_transpose_item(a.in[I_WIN] + (size_t)1024 * NIN, 1024, NIN, BT1 + (size_t)NIN * 1024, scr, r, lane, true); continue; } r -= I_1;
            if (r < I_2) { p0_transpose_item(a.in[I_WOUT], 1024, 1024, BT2, scr, r, lane, false); continue; } r -= I_2;
            p0_transpose_item(a.in[I_WOUT] + (size_t)1024 * 1024, 1024, 1024, BT2 + (size_t)1024 * 1024, scr, r, lane, false);
        }
    }
}

__device__ __forceinline__ void norm_phase(const Args& a, int mode, int lane, int wave) {
    unsigned char* ws = a.ws;
    const float* MOD = (const float*)(ws + WS_MOD); bf16* H = (bf16*)(ws + WS_H);
    const int gw = blockIdx.x * NWAVES + wave, NGW = gridDim.x * NWAVES;
    const int nrows = (mode == 2) ? MLAT : MROWS, ln = (mode == 0) ? 0 : 1;
    int cur = -1;
    f32x4 pg0[4], pg1[4], pa[4], ps[4];
#pragma unroll
    for (int j = 0; j < 4; ++j) { pg0[j] = pg1[j] = pa[j] = ps[j] = (f32x4){0.f, 0.f, 0.f, 0.f}; }
    for (int row = gw; row < nrows; row += NGW) {
        const int vsel = row < MLAT ? (row >> 13) : 2;
        const float* src = row < MLAT ? a.in[I_X] + (size_t)row * 1024 : a.in[I_CTX] + (size_t)(row - MLAT) * 1024;
        f32x4 v[4];
#pragma unroll
        for (int j = 0; j < 4; ++j) v[j] = *((const f32x4*)src + lane + 64 * j);
        if (vsel != cur) { cur = vsel;
            if (mode >= 1) { const float* gate = MOD + (0 * 3 + vsel) * 3072 + 2048; const float* gp = a.in[I_GPOST];
#pragma unroll
                for (int j = 0; j < 4; ++j) pg0[j] = *((const f32x4*)gate + lane + 64 * j) * *((const f32x4*)gp + lane + 64 * j); }
            if (mode == 2) { const float* gate = MOD + (1 * 3 + vsel) * 3072 + 2048; const float* gp = a.in[I_GPOST] + 1024;
#pragma unroll
                for (int j = 0; j < 4; ++j) pg1[j] = *((const f32x4*)gate + lane + 64 * j) * *((const f32x4*)gp + lane + 64 * j); }
            if (mode <= 1) { const float* shift = MOD + (ln * 3 + vsel) * 3072; const float* scale = shift + 1024; const float* gpre = a.in[I_GPRE] + ln * 1024;
#pragma unroll
                for (int j = 0; j < 4; ++j) { pa[j] = *((const f32x4*)gpre + lane + 64 * j) * (*((const f32x4*)scale + lane + 64 * j) + 1.0f); ps[j] = *((const f32x4*)shift + lane + 64 * j); } }
        }
#pragma unroll
        for (int lu = 0; lu < 2; ++lu) if (lu < mode) {
            const bf16* MIX = (const bf16*)(ws + WS_MIX) + (size_t)lu * MROWS * 1024;
            f32x4 mx[4]; float sp = 0.f;
#pragma unroll
            for (int j = 0; j < 4; ++j) { const v2u mq = *((const v2u*)(MIX + (size_t)row * 1024) + lane + 64 * j); mx[j] = (f32x4){bflo(mq.x), bfhi(mq.x), bflo(mq.y), bfhi(mq.y)};
                sp += (mx[j].x * mx[j].x + mx[j].y * mx[j].y) + (mx[j].z * mx[j].z + mx[j].w * mx[j].w); }
            const float rstd = rsqrtf(wave_sum(sp) * (1.0f / 1024.0f) + EPSF);
#pragma unroll
            for (int j = 0; j < 4; ++j) v[j] += (lu ? pg1[j] : pg0[j]) * (mx[j] * rstd);
        }
        if (mode == 2) {
            float* dst = a.out + (size_t)row * 1024;
#pragma unroll
            for (int j = 0; j < 4; ++j) *((f32x4*)dst + lane + 64 * j) = v[j];
        } else {
            float s2 = 0.f;
#pragma unroll
            for (int j = 0; j < 4; ++j) s2 += (v[j].x * v[j].x + v[j].y * v[j].y) + (v[j].z * v[j].z + v[j].w * v[j].w);
            const float r = rsqrtf(wave_sum(s2) * (1.0f / 1024.0f) + EPSF);
            v2u* o8 = (v2u*)(H + (size_t)row * 1024);
#pragma unroll
            for (int j = 0; j < 4; ++j) { const f32x4 hv = v[j] * r * pa[j] + ps[j];
                v2u w; w.x = cvtpk(hv.x, hv.y); w.y = cvtpk(hv.z, hv.w); o8[lane + 64 * j] = w; }
        }
    }
}

__device__ __forceinline__ void conv16(const LAS unsigned* vt, const f32x2v (&w2)[31], const f32x2v b2, bf16* ybase, size_t ystride) {
#pragma unroll 1
    for (int tq = 0; tq < 4; ++tq) {
        const LAS unsigned* vq = vt + tq * 4 * 128;
        f32x2v acc[4];
#pragma unroll
        for (int t = 0; t < 4; ++t) acc[t] = b2;
#pragma unroll
        for (int rr = 0; rr < 34; ++rr) { const unsigned u = vq[rr * 128]; const f32x2v x = {bflo(u), bfhi(u)};
#pragma unroll
            for (int t = 0; t < 4; ++t) { const int k = rr - t; if (k >= 0 && k < 31) acc[t] += w2[k] * x; }
            if ((rr & 7) == 7) asm volatile("" ::: "memory"); }
#pragma unroll
        for (int t = 0; t < 4; ++t) *(unsigned*)(ybase + (size_t)(tq * 4 + t) * ystride) = cvtpk(acc[t].x, acc[t].y);
    }
}
__device__ __forceinline__ v4u glu8(const v4u vq, const v4u gq) {
    v4u o;
    o.x = pk2(bflo(vq.x) * sigmoidf_(bflo(gq.x)), bfhi(vq.x) * sigmoidf_(bfhi(gq.x)));
    o.y = pk2(bflo(vq.y) * sigmoidf_(bflo(gq.y)), bfhi(vq.y) * sigmoidf_(bfhi(gq.y)));
    o.z = pk2(bflo(vq.z) * sigmoidf_(bflo(gq.z)), bfhi(vq.z) * sigmoidf_(bfhi(gq.z)));
    o.w = pk2(bflo(vq.w) * sigmoidf_(bflo(gq.w)), bfhi(vq.w) * sigmoidf_(bfhi(gq.w)));
    return o;
}
__device__ __forceinline__ void conv_unit(const Args& a, LAS unsigned char* lds, int l, int grow0, int gstride, int vlo, int vhi, int coff, int cbase, int nrows, int ncall, int orow0, int ostride, int tid) {
    const bf16* U = (const bf16*)(a.ws + WS_U); bf16* Y = (bf16*)(a.ws + WS_Y);
    LAS unsigned* VT = (LAS unsigned*)lds;
    int p = tid & 127; asm volatile("" : "+v"(p));
    const int tg = tid >> 7, c0 = cbase + 2 * p;
    f32x2v w2[31];
#pragma unroll
    for (int k = 0; k < 31; ++k) w2[k] = *(const f32x2v*)(a.in[I_DWW] + (size_t)(l * 31 + k) * 512 + c0);
    const f32x2v b2 = *(const f32x2v*)(a.in[I_DWB] + l * 512 + c0);
    const int nchunk = nrows * 32;
#pragma unroll 1
    for (int i0 = tid; i0 < nchunk; i0 += 3 * NTHR) {
        v4u vq[3];
#pragma unroll
        for (int it = 0; it < 3; ++it) { const int i = i0 + it * NTHR, rr = i >> 5, ch = i & 31, row = grow0 + rr * gstride; const bool ok = i < nchunk && row >= vlo && row < vhi;
            vq[it] = (v4u){0u, 0u, 0u, 0u}; if (ok) vq[it] = *(const v4u*)(U + (size_t)row * NIN + coff + ch * 8); }
#pragma unroll
        for (int it = 0; it < 3; ++it) { const int i = i0 + it * NTHR, rr = i >> 5, ch = i & 31, row = grow0 + rr * gstride; const bool ok = row >= vlo && row < vhi;
            if (i < nchunk) { const v4u z = {0u, 0u, 0u, 0u}; *(LAS v4u*)(VT + rr * 128 + ch * 4) = ok ? vq[it] : z; } }
    }
    __syncthreads();
#pragma unroll 1
    for (int hc = 0; hc < ncall; ++hc) { const int tb = (tg * ncall + hc) * 16;
        conv16(VT + tb * 128 + p, w2, b2, Y + (size_t)(orow0 + tb * ostride) * 512 + c0, (size_t)ostride * 512); }
    __syncthreads();
}
__device__ __forceinline__ void ln_rows(const Args& a, int l, int nrows, int lane, int wave, int nblk) {
    const bf16* U = (const bf16*)(a.ws + WS_U); const bf16* Y = (const bf16*)(a.ws + WS_Y); bf16* MIXIN = (bf16*)(a.ws + WS_MIXIN);
    if ((int)blockIdx.x >= nblk) return;
    const int gw = blockIdx.x * NWAVES + wave, NGW = nblk * NWAVES, c0 = lane * 8;
    float lg[8], lb[8];
#pragma unroll
    for (int e = 0; e < 8; ++e) { lg[e] = a.in[I_LNG][l * 512 + c0 + e]; lb[e] = a.in[I_LNB][l * 512 + c0 + e]; }
    for (int row = gw; row < nrows; row += NGW) {
        const v4u yq = *(const v4u*)(Y + (size_t)row * 512 + c0); const v4u gq = *(const v4u*)(U + (size_t)row * NIN + 2048 + c0);
        float y[8] = {bflo(yq.x), bfhi(yq.x), bflo(yq.y), bfhi(yq.y), bflo(yq.z), bfhi(yq.z), bflo(yq.w), bfhi(yq.w)};
        const float gt[8] = {bflo(gq.x), bfhi(gq.x), bflo(gq.y), bfhi(gq.y), bflo(gq.z), bfhi(gq.z), bflo(gq.w), bfhi(gq.w)};
        float s = 0.f;
#pragma unroll
        for (int e = 0; e < 8; ++e) s += y[e];
        const float mean = wave_sum(s) * (1.0f / 512.0f); float q = 0.f;
#pragma unroll
        for (int e = 0; e < 8; ++e) { y[e] -= mean; q += y[e] * y[e]; }
        const float rstd = rsqrtf(wave_sum(q) * (1.0f / 512.0f) + EPSF);
        float o[8];
#pragma unroll
        for (int e = 0; e < 8; ++e) o[e] = siluf_(y[e] * rstd * lg[e] + lb[e]) * gt[e];
        v4u w; w.x = pk2(o[0], o[1]); w.y = pk2(o[2], o[3]); w.z = pk2(o[4], o[5]); w.w = pk2(o[6], o[7]);
        *(v4u*)(MIXIN + (size_t)row * 1024 + 512 + c0) = w;
    }
}

constexpr int RG_GW = 0, RG_FOLD = 32768, RG_F8 = 36864, RG_CAR = 40960, RG_WAVE = 57344, RG_WAVE_BYTES = 12544;
constexpr int NP16 = 4 * NPJ;
__device__ __forceinline__ float fsig(float x) { return __builtin_amdgcn_rcpf(1.0f + __expf(-x)); }

template <bool FINAL, bool FASTP>
__device__ __forceinline__ void rg_sweep(const Args& a, LAS unsigned char* lds, LAS unsigned char* wl, int l, int b, int h, int r0, int seg_lo, int seg_hi, int pj, bool is_ctx, int w, int lane, const int D) {
    const bf16* U = (const bf16*)(a.ws + WS_U); bf16* MIXIN = (bf16*)(a.ws + WS_MIXIN);
    float* AGGA = (float*)(a.ws + WS_AGGA); float* AGGB = (float*)(a.ws + WS_AGGB); float* A16 = (float*)(a.ws + WS_A16); float* B16 = (float*)(a.ws + WS_B16);
    LAS float* VCW = (LAS float*)wl; LAS unsigned* HBW = (LAS unsigned*)(wl + 4352);
    const LAS v4u* GWL = (const LAS v4u*)(lds + RG_GW) + (D * 2) * 8 * 64 + lane;
    const LAS float* CAR = (const LAS float*)(lds + RG_CAR);
    const int fr = lane & 15, fq = lane >> 4, cp = lane & 31, rh = lane >> 5;
    const int rbase = D ? r0 + 63 : r0, rsign = D ? -1 : 1;
    float2 cw[4];
#pragma unroll
    for (int k = 0; k < 4; ++k) cw[k] = *(const float2*)(a.in[I_CAW] + (size_t)((l * 2 + D) * 4 + (D ? 3 - k : k)) * 512 + 64 * h + 2 * cp);
    const float2 cbv = *(const float2*)(a.in[I_CAB] + (l * 2 + D) * 512 + 64 * h + 2 * cp);
    float brv[4], biv[4], sp8[4], Hc[4], Ac[4];
    const int p16own = 4 * pj + fq;
#pragma unroll
    for (int ct = 0; ct < 4; ++ct) { const int c = 16 * ct + fr, pidx = (l * 2 + D) * 512 + 64 * h + c;
        brv[ct] = a.in[I_BR][pidx]; biv[ct] = a.in[I_BI][pidx]; sp8[ct] = ((const float*)(a.ws + WS_SP8))[pidx];
        Hc[ct] = 0.f; Ac[ct] = 1.f;
        if (FINAL) {
            if (is_ctx) { const size_t base = (size_t)((b * 2 + D) * NP16) * 512 + 64 * h + c; float S = 0.f;
                for (int i = 0; i < p16own; ++i) S = A16[base + (size_t)i * 512] * S + B16[base + (size_t)i * 512];
                Hc[ct] = S; }
            else Hc[ct] = CAR[(D * 32 + 4 * (D ? 7 - w : w) + fq) * 64 + c];
        } }
    const bf16* ub = U + 64 * h + 2 * cp;
    unsigned Wd[2][7], nx[2][4];
#pragma unroll
    for (int q = 0; q < 2; ++q) { const int g = 2 * rh + q;
#pragma unroll
        for (int j = 0; j < 3; ++j) { const int row = rbase + rsign * (16 * g - 3 + j); const bool ok = row >= seg_lo && row < seg_hi; const int rc = ok ? row : r0;
            const unsigned v = *(const unsigned*)(ub + (size_t)rc * NIN); Wd[q][4 + j] = ok ? v : 0u; }
#pragma unroll
        for (int j = 0; j < 4; ++j) nx[q][j] = *(const unsigned*)(ub + (size_t)(rbase + rsign * (16 * g + j)) * NIN); }
#pragma unroll 1
    for (int ti = 0; ti < 4; ++ti) {
        const int tile = ti;
        int zo = 0; asm volatile("" : "+v"(zo));
        const LAS v4u* GWLt = GWL + zo;
        v4u g0 = {0u, 0u, 0u, 0u}, g1 = g0; size_t orow = 0;
        if (FINAL && D == 0) { orow = (size_t)(r0 + 16 * (fr >> 2) + 4 * tile + (fr & 3)); const bf16* gp = U + orow * NIN + 512 + 64 * h + 16 * fq; g0 = *(const v4u*)gp; g1 = *(const v4u*)(gp + 8); }
#pragma unroll
        for (int q = 0; q < 2; ++q) {
            Wd[q][0] = Wd[q][4]; Wd[q][1] = Wd[q][5]; Wd[q][2] = Wd[q][6]; Wd[q][3] = nx[q][0]; Wd[q][4] = nx[q][1]; Wd[q][5] = nx[q][2]; Wd[q][6] = nx[q][3]; }
        if (ti < 3) { const int tn = ti + 1;
#pragma unroll
            for (int q = 0; q < 2; ++q)
#pragma unroll
                for (int j = 0; j < 4; ++j) nx[q][j] = *(const unsigned*)(ub + (size_t)(rbase + rsign * (16 * (2 * rh + q) + 4 * tn + j)) * NIN); }
#pragma unroll
        for (int q = 0; q < 2; ++q)
#pragma unroll
            for (int jj = 0; jj < 4; ++jj) { float v0 = cbv.x, v1 = cbv.y;
#pragma unroll
                for (int k = 0; k < 4; ++k) { const unsigned u = Wd[q][jj + k]; v0 += cw[k].x * bflo(u); v1 += cw[k].y * bfhi(u); }
                *(LAS f32x2v*)(VCW + (4 * (2 * rh + q) + jj) * 68 + 2 * cp) = (f32x2v){v0, v1}; }
        bf16x8 af[2];
#pragma unroll
        for (int kk = 0; kk < 2; ++kk) { const LAS float* vp = VCW + fr * 68 + 32 * kk + 8 * fq; const f32x4 x0 = *(const LAS f32x4*)vp, x1 = *(const LAS f32x4*)(vp + 4);
            v4u pk; pk.x = cvtpk(x0.x, x0.y); pk.y = cvtpk(x0.z, x0.w); pk.z = cvtpk(x1.x, x1.y); pk.w = cvtpk(x1.z, x1.w); af[kk] = __builtin_bit_cast(bf16x8, pk); }
        float vcv[4][4];
#pragma unroll
        for (int ct = 0; ct < 4; ++ct)
#pragma unroll
            for (int jj = 0; jj < 4; ++jj) vcv[ct][jj] = VCW[(4 * fq + jj) * 68 + 16 * ct + fr];
        f32x4 accr[4], acci[4];
#pragma unroll
        for (int ct = 0; ct < 4; ++ct) { accr[ct] = (f32x4){0.f, 0.f, 0.f, 0.f}; acci[ct] = accr[ct];
#pragma unroll
            for (int kk = 0; kk < 2; ++kk) { const bf16x8 br = __builtin_bit_cast(bf16x8, GWLt[(ct * 2 + kk) * 64]), bi = __builtin_bit_cast(bf16x8, GWLt[(8 + ct * 2 + kk) * 64]);
                accr[ct] = __builtin_amdgcn_mfma_f32_16x16x32_bf16(af[kk], br, accr[ct], 0, 0, 0); acci[ct] = __builtin_amdgcn_mfma_f32_16x16x32_bf16(af[kk], bi, acci[ct], 0, 0, 0); } }
        float hsum[4][4];
#pragma unroll
        for (int ct = 0; ct < 4; ++ct) { float aa[4], bb[4];
            const float nbr = -1.44269504f * brv[ct], nbi = -1.44269504f * biv[ct];
#pragma unroll
            for (int p = 0; p < 2; ++p) {
                f32x2v xr = (f32x2v){accr[ct][2 * p], accr[ct][2 * p + 1]} * -1.44269504f + nbr, xi = (f32x2v){acci[ct][2 * p], acci[ct][2 * p + 1]} * -1.44269504f + nbi;
                xr = __builtin_elementwise_min(xr, (f32x2v){60.f, 60.f}); xi = __builtin_elementwise_min(xi, (f32x2v){60.f, 60.f});
                f32x2v d1, d2; d1.x = __builtin_amdgcn_exp2f(xr.x); d1.y = __builtin_amdgcn_exp2f(xr.y); d2.x = __builtin_amdgcn_exp2f(xi.x); d2.y = __builtin_amdgcn_exp2f(xi.y);
                d1 = d1 + 1.0f; d2 = d2 + 1.0f; const f32x2v m = d1 * d2; f32x2v inv; inv.x = __builtin_amdgcn_rcpf(m.x); inv.y = __builtin_amdgcn_rcpf(m.y);
                const f32x2v r = d2 * inv, ig = d1 * inv, la = r * sp8[ct], x2 = la + la, le = la * 1.44269504f;
                f32x2v av, om;
                if (FASTP) { const f32x2v q = la * (la * (la * (la * (la * 0.0083333338f + 0.041666668f) + 0.16666667f) + 0.5f) + 1.0f);
                    av = q + 1.0f; om = -q * (q + 2.0f); }
                else { const f32x2v pom = -x2 * (x2 * (x2 * (x2 * (x2 * 0.0083333338f + 0.041666668f) + 0.16666667f) + 0.5f) + 1.0f);
                    av.x = __builtin_amdgcn_exp2f(le.x); av.y = __builtin_amdgcn_exp2f(le.y);
                    const f32x2v o2 = 1.0f - av * av; om.x = x2.x > -0.25f ? pom.x : o2.x; om.y = x2.y > -0.25f ? pom.y : o2.y;
                    om = __builtin_elementwise_max(om, (f32x2v){0.f, 0.f}); }
                f32x2v sq; sq.x = __builtin_amdgcn_sqrtf(om.x); sq.y = __builtin_amdgcn_sqrtf(om.y);
                const f32x2v bv = sq * (ig * (f32x2v){vcv[ct][2 * p], vcv[ct][2 * p + 1]});
                aa[2 * p] = av.x; aa[2 * p + 1] = av.y; bb[2 * p] = bv.x; bb[2 * p + 1] = bv.y; }
            float hh = Hc[ct], A4 = 1.f;
#pragma unroll
            for (int jj = 0; jj < 4; ++jj) { hh = aa[jj] * hh + bb[jj]; A4 *= aa[jj]; hsum[ct][jj] = hh; }
            Hc[ct] = hh; if (!FINAL) Ac[ct] *= A4; }
        if (FINAL) {
            if (D == 1) {
#pragma unroll
                for (int ct = 0; ct < 4; ++ct)
#pragma unroll
                    for (int jp = 0; jp < 2; ++jp) HBW[(tile * 8 + ct * 2 + jp) * 64 + lane] = cvtpk(hsum[ct][2 * jp], hsum[ct][2 * jp + 1]);
            } else {
#pragma unroll
                for (int ct = 0; ct < 4; ++ct)
#pragma unroll
                    for (int jp = 0; jp < 2; ++jp) {
                        const unsigned hb = HBW[((3 - tile) * 8 + ct * 2 + (1 - jp)) * 64 + fr + 16 * (3 - fq)];
                        VCW[(4 * fq + 2 * jp) * 68 + 16 * ct + fr] = hsum[ct][2 * jp] + bfhi(hb); VCW[(4 * fq + 2 * jp + 1) * 68 + 16 * ct + fr] = hsum[ct][2 * jp + 1] + bflo(hb); }
                const size_t row = orow;
                const f32x4 s0 = *(const LAS f32x4*)(VCW + fr * 68 + 16 * fq), s1 = *(const LAS f32x4*)(VCW + fr * 68 + 16 * fq + 4), s2 = *(const LAS f32x4*)(VCW + fr * 68 + 16 * fq + 8), s3 = *(const LAS f32x4*)(VCW + fr * 68 + 16 * fq + 12);
                v4u o0, o1;
                o0.x = cvtpk(s0.x * bflo(g0.x), s0.y * bfhi(g0.x)); o0.y = cvtpk(s0.z * bflo(g0.y), s0.w * bfhi(g0.y)); o0.z = cvtpk(s1.x * bflo(g0.z), s1.y * bfhi(g0.z)); o0.w = cvtpk(s1.z * bflo(g0.w), s1.w * bfhi(g0.w));
                o1.x = cvtpk(s2.x * bflo(g1.x), s2.y * bfhi(g1.x)); o1.y = cvtpk(s2.z * bflo(g1.y), s2.w * bfhi(g1.y)); o1.z = cvtpk(s3.x * bflo(g1.z), s3.y * bfhi(g1.z)); o1.w = cvtpk(s3.z * bflo(g1.w), s3.w * bfhi(g1.w));
                bf16* op = MIXIN + row * 1024 + 64 * h + 16 * fq; *(v4u*)op = o0; *(v4u*)(op + 8) = o1;
            }
        }
    }
    if (!FINAL) {
#pragma unroll
        for (int ct = 0; ct < 4; ++ct) { const int c = 16 * ct + fr;
            const size_t i16 = (size_t)((b * 2 + D) * NP16 + p16own) * 512 + 64 * h + c; A16[i16] = Ac[ct]; B16[i16] = Hc[ct];
            float Ag[4], Bg[4];
#pragma unroll
            for (int g = 0; g < 4; ++g) { Ag[g] = __shfl(Ac[ct], fr + 16 * g); Bg[g] = __shfl(Hc[ct], fr + 16 * g); }
            float run = 0.f;
#pragma unroll
            for (int g = 0; g < 4; ++g) run = Ag[g] * run + Bg[g];
            if (fq == 0) { const size_t idx = (size_t)((b * 2 + D) * NPJ + pj) * 512 + 64 * h + c; AGGA[idx] = (Ag[0] * Ag[1]) * (Ag[2] * Ag[3]); AGGB[idx] = run; } }
    }
}

template <bool FINAL>
__device__ __forceinline__ void rg_run(const Args& a, LAS unsigned char* lds, int l, int rn, int tid, int lane, int wave) {
    const bool is_ctx = rn >= 256; const int bh = is_ctx ? rn - 256 : rn >> 4, b = bh >> 3, h = bh & 7, cgp = is_ctx ? 0 : (rn & 15);
    { const v4u* GWF = (const v4u*)(a.ws + WS_GWF); LAS v4u* GWL = (LAS v4u*)(lds + RG_GW);
#pragma unroll
      for (int i = tid; i < 2048; i += NTHR) { const int d = i >> 10, g = (i >> 9) & 1, rest = i & 511; GWL[i] = GWF[(size_t)((((l * 2 + d) * 2 + g) * 8 + h) * 8) * 64 + rest]; } }
    const int P0f = 4 + 8 * cgp, P0b = 124 - 8 * cgp;
    if (FINAL && !is_ctx) {
        const float* AGGA = (const float*)(a.ws + WS_AGGA); const float* AGGB = (const float*)(a.ws + WS_AGGB); const float* A16 = (const float*)(a.ws + WS_A16); const float* B16 = (const float*)(a.ws + WS_B16);
        const int d = tid >> 8, s = (tid >> 6) & 3, c = tid & 63, P0 = d ? P0b : P0f, lo = (P0 * s) >> 2, hi = (P0 * (s + 1)) >> 2;
        const size_t b16 = (size_t)((b * 2 + d) * NP16 + 4 * P0 + 8 * s) * 512 + 64 * h + c; float ai8[8], bi8[8];
#pragma unroll
        for (int i = 0; i < 8; ++i) { ai8[i] = A16[b16 + (size_t)i * 512]; bi8[i] = B16[b16 + (size_t)i * 512]; }
        const size_t base = (size_t)((b * 2 + d) * NPJ) * 512 + 64 * h + c; float A = 1.f, Bv = 0.f;
#pragma unroll 8
        for (int i = lo; i < hi; ++i) { const float ai = AGGA[base + (size_t)i * 512], bi = AGGB[base + (size_t)i * 512]; Bv = ai * Bv + bi; A *= ai; }
        LAS float* FO = (LAS float*)(lds + RG_FOLD); LAS float* F8 = (LAS float*)(lds + RG_F8); LAS float* CAR = (LAS float*)(lds + RG_CAR);
        FO[((d * 4 + s) * 64 + c) * 2] = A; FO[((d * 4 + s) * 64 + c) * 2 + 1] = Bv;
        float A8 = 1.f, B8 = 0.f;
#pragma unroll
        for (int i = 0; i < 8; ++i) { B8 = ai8[i] * B8 + bi8[i]; A8 *= ai8[i]; }
        F8[((d * 4 + s) * 64 + c) * 2] = A8; F8[((d * 4 + s) * 64 + c) * 2 + 1] = B8;
        __syncthreads();
        float S = 0.f;
#pragma unroll
        for (int s2 = 0; s2 < 4; ++s2) S = FO[((d * 4 + s2) * 64 + c) * 2] * S + FO[((d * 4 + s2) * 64 + c) * 2 + 1];
#pragma unroll
        for (int s2 = 0; s2 < 3; ++s2) if (s2 < s) S = F8[((d * 4 + s2) * 64 + c) * 2] * S + F8[((d * 4 + s2) * 64 + c) * 2 + 1];
#pragma unroll
        for (int i = 0; i < 8; ++i) { CAR[(d * 32 + 8 * s + i) * 64 + c] = S; S = ai8[i] * S + bi8[i]; }
    }
    __syncthreads();
    if (wave < (is_ctx ? 4 : 8)) {
        const int j = is_ctx ? wave : 8 * cgp + wave;
        const int seg_lo = is_ctx ? MLAT + b * CTXL : b * SEQ, seg_hi = seg_lo + (is_ctx ? CTXL : SEQ), r0 = seg_lo + 64 * j;
        const int pjf = is_ctx ? j : 4 + j, pjb = is_ctx ? 3 - j : 131 - j;
        LAS unsigned char* wl = lds + RG_WAVE + wave * RG_WAVE_BYTES;
        const float* SP8 = (const float*)(a.ws + WS_SP8);
        const bool fast1 = !__any(SP8[(l * 2 + 1) * 512 + 64 * h + lane] < -0.25f), fast0 = !__any(SP8[(l * 2 + 0) * 512 + 64 * h + lane] < -0.25f);
#pragma unroll 1
        for (int it = 0; it < 2; ++it) { const int D = 1 - it, pj = D ? pjb : pjf; const bool fast = D ? fast1 : fast0;
            if (fast) rg_sweep<FINAL, true>(a, lds, wl, l, b, h, r0, seg_lo, seg_hi, pj, is_ctx, wave, lane, D); else rg_sweep<FINAL, false>(a, lds, wl, l, b, h, r0, seg_lo, seg_hi, pj, is_ctx, wave, lane, D); }
    }
    __syncthreads();
}

#define RLX_AGENT __ATOMIC_RELAXED, __HIP_MEMORY_SCOPE_AGENT


#define XB_TMO      128
#define XB_XCNT(j)  (256  + 64 * (j))
#define XB_XSUB(j)  (1280 + 64 * (j))
#define XB_XGEN(j)  (2304 + 64 * (j))
#define XB_TOP      3328
#define XB_TOPGEN   3392
#define XCD_BAR_WORDS 3456
#define XB_SPIN_CAP (1u << 18)

__device__ __forceinline__ unsigned xb_ld(unsigned* p)              { return __hip_atomic_load(p, __ATOMIC_RELAXED, __HIP_MEMORY_SCOPE_AGENT); }
__device__ __forceinline__ unsigned xb_add(unsigned* p, unsigned v) { return __hip_atomic_fetch_add(p, v, __ATOMIC_RELAXED, __HIP_MEMORY_SCOPE_AGENT); }
__device__ __forceinline__ unsigned xb_xcc_id() { return (unsigned)__builtin_amdgcn_s_getreg((3 << 11) | 20) & 0xFu; }
#define XB_SPIN(cond, bar) do { unsigned _sp = 0; while (cond) { __builtin_amdgcn_s_sleep(1); \
    if ((++_sp & 255u) == 0u) { if (xb_ld(&(bar)[XB_TMO])) break; if (_sp > XB_SPIN_CAP) { atomicAdd(&(bar)[XB_TMO], 1u); break; } } } } while (0)

struct XcdBarrier {
    unsigned* bar; unsigned x;
    volatile LAS unsigned* st;
};

__device__ __forceinline__ XcdBarrier xcd_barrier_post(unsigned* bar, volatile LAS unsigned* st) {
    XcdBarrier b; b.bar = bar; b.x = xb_xcc_id(); b.st = st;
    if (threadIdx.x == 0) (void)xb_add(&bar[XB_XCNT(b.x)], 1u);
    return b;
}
__device__ __forceinline__ void xcd_barrier_complete(unsigned* bar, unsigned x, unsigned& nloc, unsigned& nx) {
    const unsigned G = gridDim.x * gridDim.y * gridDim.z;
    unsigned sum, cnt, mine, sp = 0u;
    for (;;) {
        sum = 0u; cnt = 0u; mine = 0u;
#pragma unroll
        for (unsigned j = 0; j < 16; ++j) { const unsigned c = xb_ld(&bar[XB_XCNT(j)]); sum += c; cnt += (c > 0u) ? 1u : 0u; mine = (j == x) ? c : mine; }
        if (sum == G) break;
        __builtin_amdgcn_s_sleep(1);
        if ((++sp & 255u) == 0u) { if (xb_ld(&bar[XB_TMO])) break; if (sp > XB_SPIN_CAP) { atomicAdd(&bar[XB_TMO], 1u); break; } }
    }
    nloc = mine > 0u ? mine : 1u; nx = cnt > 0u ? cnt : 1u;
}

__device__ __forceinline__ void xcd_barrier(const XcdBarrier& b) {
    asm volatile("s_waitcnt vmcnt(0)" ::: "memory");
    __syncthreads();
    if (threadIdx.x == 0) {
        unsigned* bar = b.bar;
        __builtin_amdgcn_s_waitcnt(0);
        unsigned nloc = b.st[0], nx = b.st[1];
        if (nloc == 0u) { xcd_barrier_complete(bar, b.x, nloc, nx); b.st[0] = nloc; b.st[1] = nx; }
        const unsigned old = xb_add(&bar[XB_XSUB(b.x)], 1u);
        const unsigned gen = old / nloc;
        if (old + 1u == (gen + 1u) * nloc) {
            __builtin_amdgcn_fence(__ATOMIC_RELEASE, "agent");
            asm volatile("s_waitcnt vmcnt(0)" ::: "memory");
            const unsigned og = xb_add(&bar[XB_TOP], 1u);
            const unsigned tg = og / nx;
            if (og + 1u == (tg + 1u) * nx) xb_add(&bar[XB_TOPGEN], 1u);
            else XB_SPIN(xb_ld(&bar[XB_TOPGEN]) == tg, bar);
            __builtin_amdgcn_fence(__ATOMIC_ACQUIRE, "agent");
            xb_add(&bar[XB_XGEN(b.x)], 1u);
            asm volatile("s_waitcnt vmcnt(0)" ::: "memory");
        } else {
            XB_SPIN(xb_ld(&bar[XB_XGEN(b.x)]) == gen, bar);
            __builtin_amdgcn_fence(__ATOMIC_ACQUIRE, "agent");
            asm volatile("s_waitcnt vmcnt(0)" ::: "memory");
        }
    }
    __syncthreads();
}

__device__ __forceinline__ void ctx_mix_tiles(const Args& a, int lane, int wave) {
    const bf16* MIXIN = (const bf16*)(a.ws + WS_MIXIN); const bf16* BT2 = (const bf16*)(a.ws + WS_BT2); bf16* MIX = (bf16*)(a.ws + WS_MIX);
    const int NGW = gridDim.x * NWAVES, fr = lane & 15, fq = lane >> 4;
    for (int t = blockIdx.x * NWAVES + wave; t < 32 * 64; t += NGW) {
        const int rg = t >> 6, cg = t & 63;
        const bf16* ap = MIXIN + (size_t)(MLAT + 16 * rg + fr) * 1024 + 8 * fq;
        const bf16* bp = BT2 + (size_t)(16 * cg + fr) * 1024 + 8 * fq;
        f32x4 acc = {0.f, 0.f, 0.f, 0.f};
#pragma unroll 1
        for (int k0 = 0; k0 < 32; k0 += 8) { v4u av[8], bv[8];
#pragma unroll
            for (int i = 0; i < 8; ++i) { av[i] = *(const v4u*)(ap + 32 * (k0 + i)); bv[i] = *(const v4u*)(bp + 32 * (k0 + i)); }
#pragma unroll
            for (int i = 0; i < 8; ++i) acc = __builtin_amdgcn_mfma_f32_16x16x32_bf16(__builtin_bit_cast(bf16x8, av[i]), __builtin_bit_cast(bf16x8, bv[i]), acc, 0, 0, 0); }
        bf16* op = MIX + (size_t)(MLAT + 16 * rg + 4 * fq) * 1024 + 16 * cg + fr;
#pragma unroll
        for (int j = 0; j < 4; ++j) op[(size_t)j * 1024] = (bf16)(cvtpk(acc[j], acc[j]) & 0xffffu);
    }
}

__device__ __forceinline__ void layer_phases(int l, const Args& args, LAS unsigned char* lds, const int tid0, const int lo, const int hi, const XcdBarrier& xbar) {
    const int G = gridDim.x; unsigned char* ws = args.ws;
    const int pb = 1 + 5 * l;
#define LAUNDER() int tid = tid0; asm volatile("" : "+v"(tid)); const int lane = tid & 63, wave = __builtin_amdgcn_readfirstlane(tid >> 6); int bx = blockIdx.x; asm volatile("" : "+s"(bx)); (void)lane; (void)wave; (void)bx
#define IN(k) (lo <= (k) && (k) < hi)
#define SEAM(k) do { if (IN(k) && IN((k) + 1)) { xcd_barrier(xbar); } } while (0)
        if (IN(pb)) { LAUNDER(); norm_phase(args, l, lane, wave); }
        SEAM(pb);
        if (IN(pb + 1)) { LAUNDER();
            pg8::Gemm g{(const pg8::bf16_t*)(ws + WS_H), (const pg8::bf16_t*)(ws + WS_BT1) + (size_t)l * NIN * 1024, MROWS, NIN, 1024};
            pg8::StaticOrder S; S.init(MROWS, NIN, G, bx);
            pg8::EpiU E{(pg8::bf16_t*)(ws + WS_U)};
            pg8::gemm_phase<pg8::EpiU, pg8::StaticOrder, true, true>(lds, g, S, E);
        }
        SEAM(pb + 1);
        if (IN(pb + 2)) { LAUNDER();
            const int nrun = (bx >= G - 16) ? 2 : 1;
#pragma unroll 1
            for (int k = 0; k < nrun; ++k) rg_run<false>(args, lds, l, k == 0 ? bx : 256 + (G - 1 - bx), tid, lane, wave);
            const int n_h = 256 + (l == 0 ? 16 : 0), n_conv = 128 + n_h;
            const int GC = G - 16;
            for (int un = bx; un < n_conv && bx < GC; un += GC) {
                int grow0, gstride, vlo, vhi, coff, cbase, nrows, ncall, orow0, ostride;
                if (un < 128) { const int bb = un >> 6, w = un & 63; vlo = bb * SEQ + w; vhi = vlo + SEQ; grow0 = vlo - 15 * 64; gstride = 64; coff = 1024 + 256; cbase = 256; nrows = 158; ncall = 2; orow0 = vlo; ostride = 64; }
                else { const int hu = un - 128; int r0, g;
                    if (hu < 256) { r0 = hu * 64; g = 0; vlo = r0; vhi = r0 + 64; }
                    else { const int cu = hu - 256, cc = cu >> 1, bb = cc >> 2; g = cu & 1; r0 = MLAT + cc * 64; vlo = MLAT + bb * CTXL; vhi = vlo + CTXL; }
                    grow0 = r0 - 15; gstride = 1; coff = 1024 + g * 256; cbase = g * 256; nrows = 94; ncall = 1; orow0 = r0; ostride = 1; }
                conv_unit(args, lds, l, grow0, gstride, vlo, vhi, coff, cbase, nrows, ncall, orow0, ostride, tid);
            }
        }
        SEAM(pb + 2);
        if (IN(pb + 3)) { LAUNDER();
            const int nrun = (l == 0 && bx >= G - 16) ? 2 : 1;
#pragma unroll 1
            for (int k = 0; k < nrun; ++k) rg_run<true>(args, lds, l, k == 0 ? bx : 256 + (G - 1 - bx), tid, lane, wave);
            ln_rows(args, l, (l == 0) ? MROWS : MLAT, lane, wave, (l == 0) ? G - 16 : G);
        }
        SEAM(pb + 3);
        if (IN(pb + 4)) { LAUNDER();
            const int M2 = MLAT;
            if (l == 0) ctx_mix_tiles(args, lane, wave);
            pg8::Gemm g{(const pg8::bf16_t*)(ws + WS_MIXIN), (const pg8::bf16_t*)(ws + WS_BT2) + (size_t)l * 1024 * 1024, M2, 1024, 1024};
            pg8::StaticOrder S; S.init(M2, 1024, G, bx);
            pg8::EpiMix E{(pg8::bf16_t*)(ws + WS_MIX) + (size_t)l * MROWS * 1024, nullptr};
            pg8::gemm_phase<pg8::EpiMix, pg8::StaticOrder, true, true>(lds, g, S, E);
        }
        SEAM(pb + 4);
#undef IN
#undef SEAM
#undef LAUNDER
}

__global__ void __launch_bounds__(NTHR, 2) fwd_megakernel(Args args) {
    extern __shared__ __attribute__((aligned(16))) unsigned char lds_raw[];
    LAS unsigned char* lds = (LAS unsigned char*)lds_raw;
    const int tid = threadIdx.x, lane = tid & 63, wave = __builtin_amdgcn_readfirstlane(tid >> 6);
    const int G = gridDim.x, bx = blockIdx.x;
    unsigned char* ws = args.ws;
    const int lo = args.ph_lo, hi = args.ph_hi;
    if (args.coop == 2) cg::this_grid().sync();
    volatile LAS unsigned* MISC = (volatile LAS unsigned*)(lds + MISC_OFF);
    if (tid < 64) MISC[tid] = 0u;
    __syncthreads();
    XcdBarrier xbar; xbar.bar = (unsigned*)(ws + WS_CTL); xbar.x = 0; xbar.st = nullptr;
    if (args.coop == 1) xbar = xcd_barrier_post((unsigned*)(ws + WS_CTL), MISC + 8);
#define IN(k) (lo <= (k) && (k) < hi)
#define SEAM(k) do { if (IN(k) && IN((k) + 1)) { xcd_barrier(xbar); } } while (0)

    if (IN(0)) { p0_prologue(args, lds, tid, lane, wave); }
    SEAM(0);
#pragma unroll 1
    for (int l = 0; l < 2; ++l) { int lo_ = l; asm volatile("" : "+s"(lo_)); layer_phases(lo_, args, lds, tid, lo, hi, xbar); }
    if (IN(11)) { norm_phase(args, 2, lane, wave); }
#undef IN
#undef SEAM
}

#ifndef MK_PER_PHASE
#define MK_PER_PHASE 0
#endif
extern "C" void kernel_launch(void* const* d_in, const int* in_sizes, int n_in, void* d_out, int out_size, void* d_ws, size_t ws_size, hipStream_t stream) {
    static int grid = 0;
    if (grid == 0) {
        if (n_in != 21 || out_size != MLAT * DM || ws_size < WS_END) { fprintf(stderr, "kernel_launch: unexpected shapes (n_in %d, out %d, ws %zu)\n", n_in, out_size, ws_size); grid = -1; return; }
        int dev = 0, cus = 0, per_cu = 0;
        if (hipGetDevice(&dev) != hipSuccess || hipDeviceGetAttribute(&cus, hipDeviceAttributeMultiprocessorCount, dev) != hipSuccess) { grid = -1; return; }
        if (hipFuncSetAttribute((const void*)fwd_megakernel, hipFuncAttributeMaxDynamicSharedMemorySize, LDS_BYTES) != hipSuccess) { fprintf(stderr, "kernel_launch: hipFuncSetAttribute failed\n"); grid = -1; return; }
        if (hipOccupancyMaxActiveBlocksPerMultiprocessor(&per_cu, (const void*)fwd_megakernel, NTHR, LDS_BYTES) != hipSuccess || per_cu < 1) { fprintf(stderr, "kernel_launch: occupancy query says %d\n", per_cu); per_cu = 1; }
        (void)hipGetLastError();
        grid = cus;
    }
    if (grid < 0) return;
    if (hipMemsetAsync((char*)d_ws + WS_CTL, 0, CTL_ZERO_BYTES, stream) != hipSuccess) { fprintf(stderr, "kernel_launch: memset failed\n"); return; }
    Args a{};
    for (int i = 0; i < 21; ++i) a.in[i] = (const float*)d_in[i];
    a.out = (float*)d_out; a.ws = (unsigned char*)d_ws;
#if MK_PER_PHASE
    for (int ph = 0; ph < 12; ++ph) { a.ph_lo = ph; a.ph_hi = ph + 1; a.coop = 0;
        hipLaunchKernelGGL(fwd_megakernel, dim3(grid), dim3(NTHR), LDS_BYTES, stream, a); }
#else
    a.ph_lo = 0; a.ph_hi = 12; a.coop = 1;
    void* kargs[] = {&a};
    hipError_t e = hipLaunchCooperativeKernel((const void*)fwd_megakernel, dim3(grid), dim3(NTHR), kargs, LDS_BYTES, stream);
    if (e != hipSuccess) fprintf(stderr, "cooperative launch failed: %s (grid %d)\n", hipGetErrorString(e), grid);
#endif
}
```
